# Optimizing an MI355X kernel written in HIP

```python
import jax, jax.numpy as jnp
from jax import lax
import numpy as np

D_MODEL = 2048
BATCH = 2
SEQ = 4096
DEPTH = 2

GLA_HEADS = 4
GLA_DK = 128
GLA_DV = 256
GLA_GATE_RANK = 16
GLA_GATE_TAU = 16.0
GLA_CHUNK = 64
FOX_HEADS = 8
FOX_DH = 128
DSA_Q_HEADS = 16
DSA_KV_HEADS = 4
DSA_DH = 128
IDX_HEADS = 16
IDX_DH = 64
DSA_TOPK_MAX = 256
N_GROUPS = 4
EXPERTS_PER_GROUP = 8
EXPERT_FF = 512
TOP_GROUPS = 1
TOP_EXPERTS = 2
Q_BLOCK = 128
ROPE_THETA = 10000.0
LN_EPS = 1e-5
DN_ALPHA = (2 * DEPTH) ** 0.25
DN_BETA = (8 * DEPTH) ** -0.25
MIX_WIDTH = GLA_HEADS * GLA_DV + FOX_HEADS * FOX_DH
DSA_WIDTH = DSA_Q_HEADS * DSA_DH

kernel_name = "hybrid_gla_fox_dsa_hmoe"

F32 = jnp.float32


def _even_sizes():
    return [GLA_HEADS * GLA_DK, GLA_HEADS * GLA_DK, GLA_HEADS * GLA_DV, GLA_HEADS * GLA_DV,
            GLA_GATE_RANK, FOX_HEADS * FOX_DH, FOX_HEADS * FOX_DH, FOX_HEADS * FOX_DH, FOX_HEADS]


def _odd_sizes():
    return [DSA_Q_HEADS * DSA_DH, DSA_KV_HEADS * DSA_DH, DSA_KV_HEADS * DSA_DH,
            IDX_HEADS * IDX_DH, IDX_DH, IDX_HEADS]


def _split(t, sizes):
    return jnp.split(t, np.cumsum(sizes)[:-1].tolist(), axis=-1)


def layer_norm(x, g, b):
    xf = x.astype(F32)
    mu = jnp.mean(xf, axis=-1, keepdims=True)
    var = jnp.mean(jnp.square(xf - mu), axis=-1, keepdims=True)
    y = (xf - mu) * lax.rsqrt(var + LN_EPS) * g.astype(F32) + b.astype(F32)
    return y.astype(x.dtype)


def rms_norm(x, g):
    xf = x.astype(F32)
    return xf * lax.rsqrt(jnp.mean(jnp.square(xf), axis=-1, keepdims=True) + LN_EPS) * g.astype(F32)


def rope(x, pos):
    half = x.shape[-1] // 2
    inv = ROPE_THETA ** (-jnp.arange(half, dtype=F32) / half)
    ang = pos.astype(F32)[:, None] * inv[None, :]
    cos = jnp.cos(ang)[None, :, None, :]
    sin = jnp.sin(ang)[None, :, None, :]
    x1, x2 = x[..., :half], x[..., half:]
    return jnp.concatenate([x1 * cos - x2 * sin, x2 * cos + x1 * sin], axis=-1)


def gla_chunked(q, k, v, log_a):
    B, S, H, DK = q.shape
    DV = v.shape[-1]
    C = GLA_CHUNK
    N = S // C

    def chunks(t):
        return t.reshape(B, N, C, H, t.shape[-1]).transpose(0, 3, 1, 2, 4)

    q, k, v, log_a = chunks(q * DK ** -0.5), chunks(k), chunks(v), chunks(log_a)
    b = jnp.cumsum(log_a, axis=3)
    b_last = b[:, :, :, -1:, :]
    q_dec = q * jnp.exp(b)
    k_inv = k * jnp.exp(-b)
    k_end = k * jnp.exp(b_last - b)
    causal = jnp.tril(jnp.ones((C, C), dtype=bool))
    scores = jnp.where(causal, jnp.einsum('bhnid,bhnjd->bhnij', q_dec, k_inv), 0.0)
    o_intra = jnp.einsum('bhnij,bhnjv->bhniv', scores, v)
    chunk_state = jnp.einsum('bhncd,bhncv->bhndv', k_end, v)
    chunk_decay = jnp.exp(b_last[:, :, :, 0, :])

    def step(state, inp):
        ds, dec = inp
        return dec[..., None] * state + ds, state

    init = jnp.zeros((B, H, DK, DV), F32)
    _, prev = lax.scan(step, init, (jnp.moveaxis(chunk_state, 2, 0), jnp.moveaxis(chunk_decay, 2, 0)))
    prev = jnp.moveaxis(prev, 0, 2)
    o = o_intra + jnp.einsum('bhncd,bhndv->bhncv', q_dec, prev)
    return o.transpose(0, 2, 3, 1, 4).reshape(B, S, H, DV)


def fox_attention(q, k, v, log_f):
    B, S, H, D = q.shape
    c = jnp.cumsum(log_f, axis=1).transpose(0, 2, 1)
    key_pos = jnp.arange(S)
    scale = D ** -0.5

    def block(i):
        start = i * Q_BLOCK
        qb = lax.dynamic_slice_in_dim(q, start, Q_BLOCK, axis=1)
        cb = lax.dynamic_slice_in_dim(c, start, Q_BLOCK, axis=2)
        q_pos = start + jnp.arange(Q_BLOCK)
        logits = jnp.einsum('bqhd,bshd->bhqs', qb, k) * scale + cb[..., None] - c[:, :, None, :]
        logits = jnp.where(key_pos[None, :] <= q_pos[:, None], logits, -jnp.inf)
        p = jax.nn.softmax(logits, axis=-1)
        return jnp.einsum('bhqs,bshd->bqhd', p, v)

    out = lax.map(block, jnp.arange(S // Q_BLOCK))
    return jnp.moveaxis(out, 0, 1).reshape(B, S, H, D)


def dsa_attention(q, k, v, iq, ik, iw):
    B, S, HQ, D = q.shape
    HKV = k.shape[2]
    G = HQ // HKV
    top_k = min(DSA_TOPK_MAX, S // 4)
    key_pos = jnp.arange(S)
    gather = jax.vmap(lambda seq, idx: seq[idx])

    def block(i):
        start = i * Q_BLOCK
        q_pos = start + jnp.arange(Q_BLOCK)
        iqb = lax.dynamic_slice_in_dim(iq, start, Q_BLOCK, axis=1)
        iwb = lax.dynamic_slice_in_dim(iw, start, Q_BLOCK, axis=1)
        rel = jax.nn.relu(jnp.einsum('bqhd,bsd->bqhs', iqb, ik)) * IDX_DH ** -0.5
        score = jnp.einsum('bqh,bqhs->bqs', iwb, rel)
        score = jnp.where(key_pos[None, :] <= q_pos[:, None], score, -jnp.inf)
        _, idx = lax.top_k(score, top_k)
        valid = idx <= q_pos[None, :, None]
        kg = gather(k, idx)
        vg = gather(v, idx)
        qb = lax.dynamic_slice_in_dim(q, start, Q_BLOCK, axis=1).reshape(B, Q_BLOCK, HKV, G, D)
        logits = jnp.einsum('bqhgd,bqkhd->bhgqk', qb, kg) * D ** -0.5
        logits = jnp.where(valid[:, None, None], logits, -jnp.inf)
        p = jax.nn.softmax(logits, axis=-1)
        o = jnp.einsum('bhgqk,bqkhd->bqhgd', p, vg)
        return o.reshape(B, Q_BLOCK, HQ, D)

    out = lax.map(block, jnp.arange(S // Q_BLOCK))
    return jnp.moveaxis(out, 0, 1).reshape(B, S, HQ, D)


def even_mixer(x, w_in, gate_w2, gate_b, gla_norm_g, fox_gate_b, w_out):
    B, S, _ = x.shape
    gq, gk, gv, gr, glr, fq, fk, fv, ff = _split(x @ w_in, _even_sizes())
    log_a = jax.nn.log_sigmoid((glr @ gate_w2).astype(F32) + gate_b.astype(F32)) / GLA_GATE_TAU
    hk = lambda t, d: t.reshape(B, S, -1, d).astype(F32)
    o_a = gla_chunked(hk(gq, GLA_DK), hk(gk, GLA_DK), hk(gv, GLA_DV), hk(log_a, GLA_DK))
    o_a = rms_norm(o_a, gla_norm_g) * jax.nn.silu(hk(gr, GLA_DV))
    log_f = jax.nn.log_sigmoid(ff.astype(F32) + fox_gate_b.astype(F32))
    o_b = fox_attention(hk(fq, FOX_DH), hk(fk, FOX_DH), hk(fv, FOX_DH), log_f)
    o = jnp.concatenate([o_a.reshape(B, S, -1), o_b.reshape(B, S, -1)], axis=-1)
    return o.astype(x.dtype) @ w_out


def odd_mixer(x, w_in, w_out):
    B, S, _ = x.shape
    q, k, v, iq, ik, iw = _split(x @ w_in, _odd_sizes())
    pos = jnp.arange(S)
    q = rope(q.reshape(B, S, DSA_Q_HEADS, DSA_DH).astype(F32), pos)
    k = rope(k.reshape(B, S, DSA_KV_HEADS, DSA_DH).astype(F32), pos)
    v = v.reshape(B, S, DSA_KV_HEADS, DSA_DH).astype(F32)
    iq = rope(iq.reshape(B, S, IDX_HEADS, IDX_DH).astype(F32), pos)
    ik = rope(ik.reshape(B, S, 1, IDX_DH).astype(F32), pos)[:, :, 0]
    iw = iw.astype(F32) * IDX_HEADS ** -0.5
    o = dsa_attention(q, k, v, iq, ik, iw)
    return o.reshape(B, S, -1).astype(x.dtype) @ w_out


def hier_moe(x, wg, bg, we, be, w_gate, w_up, w_down):
    B, S, D = x.shape
    t = x.reshape(B * S, D)
    group_prob = jax.nn.softmax((t @ wg).astype(F32) + bg.astype(F32), axis=-1)
    g_prob, g_idx = lax.top_k(group_prob, TOP_GROUPS)
    expert_logits = jnp.einsum('td,gde->tge', t, we).astype(F32) + be.astype(F32)
    chosen = jnp.take_along_axis(expert_logits, g_idx[:, :, None], axis=1)[:, 0]
    e_val, e_idx = lax.top_k(chosen, TOP_EXPERTS)
    e_w = jax.nn.softmax(e_val, axis=-1) * g_prob
    within = jnp.sum(jax.nn.one_hot(e_idx, EXPERTS_PER_GROUP, dtype=F32) * e_w[..., None], axis=1)
    combine = jax.nn.one_hot(g_idx[:, 0], N_GROUPS, dtype=F32)[:, :, None] * within[:, None, :]
    out = jnp.zeros((B * S, D), F32)
    for g in range(N_GROUPS):
        h = jax.nn.silu(jnp.einsum('td,edf->tef', t, w_gate[g])) * jnp.einsum('td,edf->tef', t, w_up[g])
        h = h * combine[:, g, :, None].astype(h.dtype)
        out = out + jnp.einsum('tef,efd->td', h, w_down[g]).astype(F32)
    return out.reshape(B, S, D).astype(x.dtype)


def setup_inputs(seed: int = 0) -> dict:
    key = jax.random.key(seed)
    ks = iter(jax.random.split(key, 32))
    nrm = lambda shape, scale: jax.random.normal(next(ks), shape, F32) * scale
    ne, no = (DEPTH + 1) // 2, DEPTH // 2
    even_cols = int(sum(_even_sizes()))
    odd_cols = int(sum(_odd_sizes()))
    G, E, F, D = N_GROUPS, EXPERTS_PER_GROUP, EXPERT_FF, D_MODEL
    return {
        'x': nrm((BATCH, SEQ, D), 1.0),
        'a_w_in': nrm((ne, D, even_cols), D ** -0.5),
        'a_gla_gate_w2': nrm((ne, GLA_GATE_RANK, GLA_HEADS * GLA_DK), GLA_GATE_RANK ** -0.5),
        'a_gla_gate_b': nrm((ne, GLA_HEADS * GLA_DK), 0.1),
        'a_gla_norm_g': 1.0 + nrm((ne, GLA_DV), 0.02),
        'a_fox_gate_b': jax.random.uniform(next(ks), (ne, FOX_HEADS), F32, 1.0, 4.0),
        'a_w_out': nrm((ne, MIX_WIDTH, D), MIX_WIDTH ** -0.5 * DN_BETA),
        'c_w_in': nrm((no, D, odd_cols), D ** -0.5),
        'c_w_out': nrm((no, DSA_WIDTH, D), DSA_WIDTH ** -0.5 * DN_BETA),
        'ln_mix_g': 1.0 + nrm((DEPTH, D), 0.02),
        'ln_mix_b': nrm((DEPTH, D), 0.02),
        'ln_ffn_g': 1.0 + nrm((DEPTH, D), 0.02),
        'ln_ffn_b': nrm((DEPTH, D), 0.02),
        'moe_group_w': nrm((DEPTH, D, G), D ** -0.5),
        'moe_group_b': nrm((DEPTH, G), 0.01),
        'moe_expert_w': nrm((DEPTH, G, D, E), D ** -0.5),
        'moe_expert_b': nrm((DEPTH, G, E), 0.01),
        'moe_w_gate': nrm((DEPTH, G, E, D, F), D ** -0.5),
        'moe_w_up': nrm((DEPTH, G, E, D, F), D ** -0.5),
        'moe_w_down': nrm((DEPTH, G, E, F, D), F ** -0.5 * DN_BETA),
    }


def reference(x, a_w_in, a_gla_gate_w2, a_gla_gate_b, a_gla_norm_g, a_fox_gate_b, a_w_out,
              c_w_in, c_w_out, ln_mix_g, ln_mix_b, ln_ffn_g, ln_ffn_b,
              moe_group_w, moe_group_b, moe_expert_w, moe_expert_b,
              moe_w_gate, moe_w_up, moe_w_down):
    for layer in range(DEPTH):
        j = layer // 2
        if layer % 2 == 0:
            h = even_mixer(x, a_w_in[j], a_gla_gate_w2[j], a_gla_gate_b[j], a_gla_norm_g[j],
                           a_fox_gate_b[j], a_w_out[j])
        else:
            h = odd_mixer(x, c_w_in[j], c_w_out[j])
        x = layer_norm(DN_ALPHA * x + h, ln_mix_g[layer], ln_mix_b[layer])
        h = hier_moe(x, moe_group_w[layer], moe_group_b[layer], moe_expert_w[layer], moe_expert_b[layer],
                     moe_w_gate[layer], moe_w_up[layer], moe_w_down[layer])
        x = layer_norm(DN_ALPHA * x + h, ln_ffn_g[layer], ln_ffn_b[layer])
    return x
```

```cpp
#include <hip/hip_runtime.h>
#include <cstdio>
#include <cstdint>
namespace pg8 {
#define PG8_LAS __attribute__((address_space(3)))
typedef unsigned short bf16_t;
typedef short bf16x8 __attribute__((ext_vector_type(8)));
typedef float f32x4 __attribute__((ext_vector_type(4)));
typedef unsigned u32x4 __attribute__((ext_vector_type(4)));
constexpr int BM = 256, BK = 64, HALF = 128, HTB = HALF * BK * 2  , STAGE_BYTES = 8 * HTB, NXCD = 8, WGM = 8;

__host__ __device__ __forceinline__ int lds_byte(int r, int c) { const int st = (r >> 4) * 2 + (c >> 5), rr = r & 15, cc = c & 31, ob = rr * 64 + cc * 2; return st * 1024 + (ob ^ (((ob >> 9) & 1) << 5)); }
__host__ __device__ __forceinline__ void stage_rc(int b, int& R, int& C) { const int st = b / 1024, sb = b % 1024, swz = sb ^ (((sb >> 9) & 1) << 5); R = (st >> 1) * 16 + swz / 64; C = (st & 1) * 32 + (swz % 64) / 2; }
__host__ __device__ __forceinline__ int perm32(int rho) { const int n = rho >> 4, i = rho & 15; return 8 * (i >> 2) + 4 * n + (i & 3); }

struct Unit { int pm, pn; };
struct Gemm { const bf16_t* A; const bf16_t* Bt; int M, N, K; };

struct StaticOrder {
    int nM, nN, nwg, G, c;
    __host__ __device__ void init(int M, int N, int G_, int c_) { nM = M / BM; nN = N / BM; nwg = nM * nN; G = G_; c = c_; }
    __host__ __device__ bool next(int i, Unit& u) const {
        const long L = (long)i * G + c; if (L >= nwg) return false;
        int wgid = (int)L; { const int q = nwg / NXCD, r = nwg % NXCD, xcd = wgid % NXCD, off = wgid / NXCD; wgid = (xcd < r ? xcd * (q + 1) : r * (q + 1) + (xcd - r) * q) + off; }
        const int nig = WGM * nN, gid = wgid / nig, fm = gid * WGM, gsz = (nM - fm) < WGM ? (nM - fm) : WGM;
        u.pm = fm + ((wgid % nig) % gsz); u.pn = (wgid % nig) / gsz; return true;
    }
    __device__ __forceinline__ void a_ready(const Unit&) const {}
    __device__ __forceinline__ void done(const Unit&) const {}
};

__device__ __forceinline__ unsigned cvt_pk_bf16(float lo, float hi) { unsigned r; asm volatile("v_cvt_pk_bf16_f32 %0, %1, %2" : "=v"(r) : "v"(lo), "v"(hi)); return r; }
typedef float f32x2 __attribute__((ext_vector_type(2)));
struct EpiBf16Plain {
    static constexpr bool PERM = true, AFTER_DRAIN = false;
    bf16_t* O; int ldc; int pn_mask;
    __device__ __forceinline__ void operator()(const f32x4 (&acc)[2][2][4][2], const Unit& u, int wr, int wc, int fr, int fq) const {
        const int row0 = u.pm * BM + wr * 64 + fr, col0 = (u.pn & pn_mask) * BM + wc * 32 + 8 * fq;
#pragma unroll
        for (int ai = 0; ai < 2; ++ai)
#pragma unroll
            for (int m = 0; m < 4; ++m) { bf16_t* rowp = O + (size_t)(row0 + ai * HALF + m * 16) * ldc + col0;
#pragma unroll
                for (int bj = 0; bj < 2; ++bj) { const f32x4 v0 = acc[ai][bj][m][0], v1 = acc[ai][bj][m][1];
                    u32x4 w; w.x = cvt_pk_bf16(v0[0], v0[1]); w.y = cvt_pk_bf16(v0[2], v0[3]); w.z = cvt_pk_bf16(v1[0], v1[1]); w.w = cvt_pk_bf16(v1[2], v1[3]);
                    *(u32x4*)(rowp + bj * HALF) = w; } }
    }
};
struct EpiResid {
    static constexpr bool PERM = false, AFTER_DRAIN = false;
    const float* base; float* out; float alpha;
    __device__ __forceinline__ void operator()(const f32x4 (&acc)[2][2][4][2], const Unit& u, int wr, int wc, int fr, int fq) const {
        const int row0 = u.pm * BM + wr * 64 + fr, col0 = u.pn * BM + wc * 32 + 4 * fq;
#pragma unroll
        for (int ai = 0; ai < 2; ++ai)
#pragma unroll
            for (int m = 0; m < 4; ++m) { const size_t off = (size_t)(row0 + ai * HALF + m * 16) * 2048 + col0;
#pragma unroll
                for (int bj = 0; bj < 2; ++bj)
#pragma unroll
                    for (int n = 0; n < 2; ++n) { const size_t o = off + bj * HALF + n * 16; const f32x4 b = *(const f32x4*)(base + o); *(f32x4*)(out + o) = b * alpha + acc[ai][bj][m][n]; } }
    }
};
struct EpiGLU {
    static constexpr bool PERM = true, AFTER_DRAIN = false;
    bf16_t* H; const float* roww;
    __device__ __forceinline__ void operator()(const f32x4 (&acc)[2][2][4][2], const Unit& u, int wr, int wc, int fr, int fq) const {
        const int row0 = u.pm * BM + wr * 64 + fr, f0 = (u.pn & 3) * 128 + wc * 32 + 8 * fq;
#pragma unroll
        for (int ai = 0; ai < 2; ++ai)
#pragma unroll
            for (int m = 0; m < 4; ++m) { const int row = row0 + ai * HALF + m * 16; const float w = roww[row];
                float h[8];
#pragma unroll
                for (int n = 0; n < 2; ++n)
#pragma unroll
                    for (int e = 0; e < 4; ++e) { const float g = acc[ai][0][m][n][e], up = acc[ai][1][m][n][e]; h[n * 4 + e] = g * __builtin_amdgcn_rcpf(1.0f + __expf(-g)) * up * w; }
                u32x4 o; o.x = cvt_pk_bf16(h[0], h[1]); o.y = cvt_pk_bf16(h[2], h[3]); o.z = cvt_pk_bf16(h[4], h[5]); o.w = cvt_pk_bf16(h[6], h[7]);
                *(u32x4*)(H + (size_t)row * 512 + f0) = o; }
    }
};
struct EpiRope {
    static constexpr bool PERM = true, AFTER_DRAIN = false;
    bf16_t* O; const float* c128; const float* s128; const float* c64; const float* s64;
    __device__ __forceinline__ void operator()(const f32x4 (&acc)[2][2][4][2], const Unit& u, int wr, int wc, int fr, int fq) const {
        const int row0 = u.pm * BM + wr * 64 + fr, jj = wc * 32 + 8 * fq;
        const int pn = u.pn;
        if (pn == 10 || pn == 11) {
#pragma unroll
            for (int ai = 0; ai < 2; ++ai)
#pragma unroll
                for (int m = 0; m < 4; ++m) { bf16_t* rowp = O + (size_t)(row0 + ai * HALF + m * 16) * 4096 + pn * 256 + jj;
#pragma unroll
                    for (int bj = 0; bj < 2; ++bj) { const f32x4 v0 = acc[ai][bj][m][0], v1 = acc[ai][bj][m][1];
                        u32x4 w; w.x = cvt_pk_bf16(v0[0], v0[1]); w.y = cvt_pk_bf16(v0[2], v0[3]); w.z = cvt_pk_bf16(v1[0], v1[1]); w.w = cvt_pk_bf16(v1[2], v1[3]);
                        *(u32x4*)(rowp + bj * HALF) = w; } }
            return;
        }
        const bool idx = pn >= 12;
        const int half = idx ? 32 : 64;
        const int hl = idx ? (jj >> 5) : (jj >> 6), i0 = jj & (half - 1);
        const int colbase = idx ? (3072 + ((pn - 12) * 4 + hl) * 64) : (pn * 256 + hl * 128);
        const float* ct = idx ? c64 : c128; const float* st = idx ? s64 : s128;
#pragma unroll
        for (int ai = 0; ai < 2; ++ai)
#pragma unroll
            for (int m = 0; m < 4; ++m) { const int row = row0 + ai * HALF + m * 16; const int pos = row & 4095;
                const float* cp = ct + (size_t)pos * half + i0; const float* sp = st + (size_t)pos * half + i0;
                const f32x4 c0 = *(const f32x4*)cp, c1 = *(const f32x4*)(cp + 4), s0 = *(const f32x4*)sp, s1 = *(const f32x4*)(sp + 4);
                const f32x4 a0 = acc[ai][0][m][0], a1 = acc[ai][0][m][1], b0 = acc[ai][1][m][0], b1 = acc[ai][1][m][1];
                const f32x4 x0 = a0 * c0 - b0 * s0, x1 = a1 * c1 - b1 * s1, y0 = b0 * c0 + a0 * s0, y1 = b1 * c1 + a1 * s1;
                bf16_t* rowp = O + (size_t)row * 4096 + colbase + i0;
                u32x4 w; w.x = cvt_pk_bf16(x0[0], x0[1]); w.y = cvt_pk_bf16(x0[2], x0[3]); w.z = cvt_pk_bf16(x1[0], x1[1]); w.w = cvt_pk_bf16(x1[2], x1[3]);
                *(u32x4*)rowp = w;
                u32x4 z; z.x = cvt_pk_bf16(y0[0], y0[1]); z.y = cvt_pk_bf16(y0[2], y0[3]); z.z = cvt_pk_bf16(y1[0], y1[1]); z.w = cvt_pk_bf16(y1[2], y1[3]);
                *(u32x4*)(rowp + half) = z; }
    }
};
struct MoeOrder {
    int G, c, ntn, Tm; const PG8_LAS int* tend;
    __device__ __forceinline__ bool next(int i, Unit& u) const {
        const int L = i * G + c; const int t = L / ntn; if (t >= Tm) return false;
        int e = 0;
#pragma unroll 1
        for (int k = 0; k < 32; ++k) e += (t >= tend[k]) ? 1 : 0;
        u.pm = t; u.pn = e * ntn + (L - t * ntn); return true;
    }
    __device__ __forceinline__ void a_ready(const Unit&) const {}
    __device__ __forceinline__ void done(const Unit&) const {}
};
template <class Epi, class Sched, bool ALIGN_EPI = false, bool SP2 = false>
__device__ __forceinline__ void gemm_phase(PG8_LAS unsigned char* lds, const Gemm g, const Sched& S, const Epi& E) {
    const int tid = threadIdx.x, wid = __builtin_amdgcn_readfirstlane(tid >> 6), lane = tid & 63, wr = wid >> 2, wc = wid & 3, fr = lane & 15, fq = lane >> 4;
    const int K = g.K, nt = K / BK;
    unsigned voffA[2], voffB[2];
#pragma unroll
    for (int i = 0; i < 2; ++i) { int R, C; stage_rc(tid * 16 + i * 8192, R, C); const int Rb = Epi::PERM ? ((R & ~31) + perm32(R & 31)) : R;
        voffA[i] = (unsigned)(R * K + C) * 2u; voffB[i] = (unsigned)(Rb * K + C) * 2u; }
    const size_t kstep = (size_t)(BK * 2);
    const size_t hstep = (size_t)HALF * K * 2;
    const size_t tstep = 2 * hstep;
    const unsigned ldsw = (unsigned)wid * 1024u;
    const int aoff = lds_byte(wr * 64 + fr, fq * 8), boff = lds_byte(wc * 32 + fr, fq * 8);
#define PG8_SA(b, h) (((b) * 2 + (h)) * HTB)
#define PG8_SB(b, h) ((4 + (b) * 2 + (h)) * HTB)
#define PG8_STAGE(bufoff, gbase, voff) do { _Pragma("unroll") for (int _i = 0; _i < 2; ++_i) \
        __builtin_amdgcn_global_load_lds((const unsigned*)((const char*)(gbase) + (voff)[_i]), (PG8_LAS unsigned*)(lds + (bufoff) + ldsw + _i * 8192), 16, 0, 0); } while (0)
#define PG8_LDA(dst, b, h) do { _Pragma("unroll") for (int m = 0; m < 4; ++m) _Pragma("unroll") for (int k = 0; k < 2; ++k) dst[m][k] = *(const PG8_LAS bf16x8*)(lds + PG8_SA(b, h) + aoff + m * 2048 + k * 1024); } while (0)
#define PG8_LDB(dst, b, h) do { _Pragma("unroll") for (int n = 0; n < 2; ++n) _Pragma("unroll") for (int k = 0; k < 2; ++k) dst[n][k] = *(const PG8_LAS bf16x8*)(lds + PG8_SB(b, h) + boff + n * 2048 + k * 1024); } while (0)
#define PG8_MMA(ai, bj, At, Bt) do { __builtin_amdgcn_s_setprio(1); _Pragma("unroll") for (int m = 0; m < 4; ++m) _Pragma("unroll") for (int n = 0; n < 2; ++n) _Pragma("unroll") for (int k = 0; k < 2; ++k) \
        acc[ai][bj][m][n] = __builtin_amdgcn_mfma_f32_16x16x32_bf16(Bt[n][k], At[m][k], acc[ai][bj][m][n], 0, 0, 0); __builtin_amdgcn_s_setprio(0); } while (0)
#define PG8_WAIT_V(n) asm volatile("s_waitcnt vmcnt(" #n ")" ::: "memory")
#define PG8_WAIT_L(n) asm volatile("s_waitcnt lgkmcnt(" #n ")" ::: "memory")
#define PG8_BAR __builtin_amdgcn_s_barrier()
#define PG8_SCHED __builtin_amdgcn_sched_barrier(0)
    Unit cur, nxt; int ui = 0;
    if (!S.next(0, cur)) return;
    f32x4 acc[2][2][4][2];
#pragma unroll
    for (int a = 0; a < 2; ++a)
#pragma unroll
        for (int b = 0; b < 2; ++b)
#pragma unroll
            for (int m = 0; m < 4; ++m)
#pragma unroll
                for (int n = 0; n < 2; ++n) acc[a][b][m][n] = (f32x4){0.f, 0.f, 0.f, 0.f};
    bf16x8 At[4][2], B0[2][2], B1[2][2];
    const char* cA = (const char*)g.A + (size_t)cur.pm * tstep; const char* cB = (const char*)g.Bt + (size_t)cur.pn * tstep;
    S.a_ready(cur);
    if constexpr (SP2) {
        PG8_STAGE(PG8_SB(0, 0), cB, voffB); PG8_STAGE(PG8_SB(0, 1), cB + hstep, voffB); PG8_STAGE(PG8_SA(0, 0), cA, voffA); PG8_STAGE(PG8_SA(0, 1), cA + hstep, voffA);
        if (wr == 1) PG8_BAR;
        PG8_WAIT_V(2); PG8_BAR;
        PG8_STAGE(PG8_SB(1, 0), cB + kstep, voffB); PG8_STAGE(PG8_SA(1, 0), cA + kstep, voffA); PG8_STAGE(PG8_SB(1, 1), cB + hstep + kstep, voffB);
        PG8_WAIT_V(6); PG8_BAR;
    } else {
        PG8_STAGE(PG8_SB(0, 0), cB, voffB); PG8_STAGE(PG8_SA(0, 0), cA, voffA); PG8_STAGE(PG8_SB(0, 1), cB + hstep, voffB); PG8_STAGE(PG8_SA(0, 1), cA + hstep, voffA);
        if (wr == 1) PG8_BAR;
        PG8_WAIT_V(4); PG8_BAR;
        PG8_STAGE(PG8_SB(1, 0), cB + kstep, voffB); PG8_STAGE(PG8_SA(1, 0), cA + kstep, voffA); PG8_STAGE(PG8_SB(1, 1), cB + hstep + kstep, voffB);
        PG8_WAIT_V(6); PG8_BAR;
    }
    for (;;) {
        const bool has_next = S.next(ui + 1, nxt);
        const char* nA = has_next ? (const char*)g.A + (size_t)nxt.pm * tstep : cA; const char* nB = has_next ? (const char*)g.Bt + (size_t)nxt.pn * tstep : cB;
        for (int t = 0; t < nt; t += 2) {
            const bool last = (t == nt - 2);
            const char* a1 = cA + (size_t)(t + 1) * kstep;
            const char* a2 = last ? nA : cA + (size_t)(t + 2) * kstep; const char* b2 = last ? nB : cB + (size_t)(t + 2) * kstep;
            const char* a3 = a2 + kstep; const char* b3 = b2 + kstep;
            if (last && has_next) S.a_ready(nxt);
            if constexpr (SP2) {
            PG8_LDB(B0, 0, 0); PG8_LDB(B1, 0, 1); PG8_SCHED; PG8_LDA(At, 0, 0); PG8_STAGE(PG8_SA(1, 1), a1 + hstep, voffA);
            PG8_WAIT_V(8); PG8_WAIT_L(0); PG8_BAR; PG8_MMA(0, 0, At, B0); PG8_MMA(0, 1, At, B1); PG8_BAR; PG8_SCHED;
            PG8_LDA(At, 0, 1); PG8_STAGE(PG8_SB(0, 0), b2, voffB); PG8_STAGE(PG8_SB(0, 1), b2 + hstep, voffB); PG8_STAGE(PG8_SA(0, 0), a2, voffA);
            PG8_WAIT_V(8); PG8_WAIT_L(0); PG8_BAR; PG8_MMA(1, 0, At, B0); PG8_MMA(1, 1, At, B1); PG8_BAR; PG8_SCHED;
            PG8_LDB(B0, 1, 0); PG8_LDB(B1, 1, 1); PG8_SCHED; PG8_LDA(At, 1, 0); PG8_STAGE(PG8_SA(0, 1), a2 + hstep, voffA);
            PG8_WAIT_V(8); PG8_WAIT_L(0); PG8_BAR; PG8_MMA(0, 0, At, B0); PG8_MMA(0, 1, At, B1); PG8_BAR; PG8_SCHED;
            PG8_LDA(At, 1, 1); PG8_STAGE(PG8_SB(1, 0), b3, voffB); PG8_STAGE(PG8_SB(1, 1), b3 + hstep, voffB); PG8_STAGE(PG8_SA(1, 0), a3, voffA);
            PG8_WAIT_V(8); PG8_WAIT_L(0); PG8_BAR; PG8_MMA(1, 0, At, B0); PG8_MMA(1, 1, At, B1); PG8_BAR; PG8_SCHED;
            } else {
            PG8_LDB(B0, 0, 0); PG8_SCHED; PG8_LDA(At, 0, 0); PG8_STAGE(PG8_SA(1, 1), a1 + hstep, voffA);
            PG8_WAIT_L(8); PG8_BAR; PG8_WAIT_L(0); PG8_MMA(0, 0, At, B0); PG8_BAR; PG8_SCHED;
            PG8_LDB(B1, 0, 1); PG8_STAGE(PG8_SB(0, 0), b2, voffB);
            PG8_BAR; PG8_WAIT_L(0); PG8_MMA(0, 1, At, B1); PG8_BAR;
            PG8_LDA(At, 0, 1); PG8_STAGE(PG8_SA(0, 0), a2, voffA);
            PG8_BAR; PG8_WAIT_L(0); PG8_MMA(1, 0, At, B0); PG8_BAR; PG8_SCHED;
            PG8_STAGE(PG8_SB(0, 1), b2 + hstep, voffB);
            PG8_WAIT_V(6); PG8_BAR; PG8_MMA(1, 1, At, B1); PG8_BAR;
            PG8_LDB(B0, 1, 0); PG8_SCHED; PG8_LDA(At, 1, 0); PG8_STAGE(PG8_SA(0, 1), a2 + hstep, voffA);
            PG8_WAIT_L(8); PG8_BAR; PG8_WAIT_L(0); PG8_MMA(0, 0, At, B0); PG8_BAR; PG8_SCHED;
            PG8_LDB(B1, 1, 1); PG8_STAGE(PG8_SB(1, 0), b3, voffB);
            PG8_BAR; PG8_WAIT_L(0); PG8_MMA(0, 1, At, B1); PG8_BAR;
            PG8_LDA(At, 1, 1); PG8_STAGE(PG8_SA(1, 0), a3, voffA);
            PG8_BAR; PG8_WAIT_L(0); PG8_MMA(1, 0, At, B0); PG8_BAR; PG8_SCHED;
            PG8_STAGE(PG8_SB(1, 1), b3 + hstep, voffB);
            PG8_WAIT_V(6); PG8_BAR; PG8_MMA(1, 1, At, B1); PG8_BAR;
            }
        }
        if constexpr (ALIGN_EPI) { if (wr == 0) PG8_BAR; }
        if constexpr (!Epi::AFTER_DRAIN) { E(acc, cur, wr, wc, fr, fq); S.done(cur); }
        if (!has_next) break;
#pragma unroll
        for (int a = 0; a < 2; ++a)
#pragma unroll
            for (int b = 0; b < 2; ++b)
#pragma unroll
                for (int m = 0; m < 4; ++m)
#pragma unroll
                    for (int n = 0; n < 2; ++n) acc[a][b][m][n] = (f32x4){0.f, 0.f, 0.f, 0.f};
        cur = nxt; cA = nA; cB = nB; ++ui;
        if constexpr (ALIGN_EPI) { if (wr == 1) PG8_BAR; }
    }
    PG8_WAIT_V(0);
    if constexpr (!ALIGN_EPI) { if (wr == 0) PG8_BAR; }
    PG8_BAR;
    if constexpr (Epi::AFTER_DRAIN) { E.fused(acc, cur, wr, wc, fr, fq, lds, wid, lane); S.done(cur); }
#undef PG8_SA
#undef PG8_SB
#undef PG8_STAGE
#undef PG8_LDA
#undef PG8_LDB
#undef PG8_MMA
#undef PG8_WAIT_V
#undef PG8_WAIT_L
#undef PG8_BAR
#undef PG8_SCHED
}
}
constexpr int BATCH = 2, SEQ = 4096, DM = 2048, MTOK = BATCH * SEQ;
constexpr int NE0 = 6168, NE1 = 4176;
constexpr int NP0 = 6144, NP1 = 4096;
constexpr float LN_EPS = 1e-5f;
constexpr float DN_ALPHA = 1.41421356237309515f;
constexpr float ATT_SCALE = 0.08838834764831845f;
constexpr int RPAD = 24576;
constexpr size_t MiB = 1u << 20;
constexpr size_t WS_CTL = 0, CTL_ZERO_BYTES = 1 * MiB;
constexpr size_t WS_ROPE = 1 * MiB;
constexpr size_t WS_WSM = 4 * MiB;
constexpr size_t WS_SK0 = 6 * MiB;
constexpr size_t WS_IK = 7 * MiB;
constexpr size_t WS_IW = 8 * MiB + 512 * 1024;
constexpr size_t WS_FBIAS = 10 * MiB;
constexpr size_t WS_ROUTE = 11 * MiB;
constexpr size_t WS_MASK = 12 * MiB;
constexpr size_t WS_WINA = 16 * MiB, WS_WOA = 40 * MiB, WS_WINC = 48 * MiB, WS_WOC = 64 * MiB;
constexpr size_t WS_WGU = 72 * MiB;
constexpr size_t WS_WD = 328 * MiB;
constexpr size_t WS_XB = 456 * MiB;
constexpr size_t WS_XR = 488 * MiB;
constexpr size_t WS_PROJ = 552 * MiB;
constexpr size_t WS_CST = 648 * MiB;
constexpr size_t WS_PREVT = 712 * MiB;
constexpr size_t WS_OMIX = 744 * MiB;
constexpr size_t WS_GB = 776 * MiB;
constexpr size_t WS_DEC = 792 * MiB;
constexpr size_t WS_ROWW = 793 * MiB;
constexpr size_t WS_SC = 800 * MiB;
constexpr size_t WS_END = 928 * MiB;
constexpr int CW_CNT = 1024;
constexpr int CW_BAR = 4096;

#define GAS __attribute__((address_space(1)))
#define LAS __attribute__((address_space(3)))
typedef unsigned short bf16;
typedef unsigned v4u __attribute__((ext_vector_type(4)));
typedef float f32x4 __attribute__((ext_vector_type(4)));
typedef short bf16x8 __attribute__((ext_vector_type(8)));
#define LDS_WAIT() asm volatile("s_waitcnt lgkmcnt(0)" ::: "memory")
#define VM_WAIT() asm volatile("s_waitcnt vmcnt(0)" ::: "memory")
__device__ __forceinline__ unsigned f2bf(float f) { unsigned u = __builtin_bit_cast(unsigned, f); return (u + 0x7fffu + ((u >> 16) & 1u)) >> 16; }
__device__ __forceinline__ unsigned pk2(float lo, float hi) { return f2bf(lo) | (f2bf(hi) << 16); }
__device__ __forceinline__ float bf2f(unsigned short b) { return __builtin_bit_cast(float, ((unsigned)b) << 16); }
__device__ __forceinline__ float wave_sum(float v) {
#pragma unroll
    for (int o = 1; o < 64; o <<= 1) v += __shfl_xor(v, o);
    return v;
}
__device__ __forceinline__ float logsigmoidf(float z) { return fminf(z, 0.f) - log1pf(__expf(-fabsf(z))); }
#define XB_TMO      128
#define XB_XCNT(j)  (256  + 64 * (j))
#define XB_XSUB(j)  (1280 + 64 * (j))
#define XB_XGEN(j)  (2304 + 64 * (j))
#define XB_TOP      3328
#define XB_TOPGEN   3392
#define XCD_BAR_WORDS 3456
#define XB_SPIN_CAP (1u << 18)

__device__ __forceinline__ unsigned xb_ld(unsigned* p)              { return __hip_atomic_load(p, __ATOMIC_RELAXED, __HIP_MEMORY_SCOPE_AGENT); }
__device__ __forceinline__ unsigned xb_add(unsigned* p, unsigned v) { return __hip_atomic_fetch_add(p, v, __ATOMIC_RELAXED, __HIP_MEMORY_SCOPE_AGENT); }
__device__ __forceinline__ unsigned xb_xcc_id() { return (unsigned)__builtin_amdgcn_s_getreg((3 << 11) | 20) & 0xFu; }
#define XB_SPIN(cond, bar) do { unsigned _sp = 0; while (cond) { __builtin_amdgcn_s_sleep(1); \
    if ((++_sp & 255u) == 0u) { if (xb_ld(&(bar)[XB_TMO])) break; if (_sp > XB_SPIN_CAP) { atomicAdd(&(bar)[XB_TMO], 1u); break; } } } } while (0)

struct XcdBarrier {
    unsigned* bar; unsigned x;
    volatile LAS unsigned* st;
};

__device__ __forceinline__ XcdBarrier xcd_barrier_post(unsigned* bar, volatile LAS unsigned* st) {
    XcdBarrier b; b.bar = bar; b.x = xb_xcc_id(); b.st = st;
    if (threadIdx.x == 0) (void)xb_add(&bar[XB_XCNT(b.x)], 1u);
    return b;
}
__device__ __forceinline__ void xcd_barrier_complete(unsigned* bar, unsigned x, unsigned& nloc, unsigned& nx) {
    const unsigned G = gridDim.x * gridDim.y * gridDim.z;
    unsigned sum, cnt, mine, sp = 0u;
    for (;;) {
        sum = 0u; cnt = 0u; mine = 0u;
#pragma unroll
        for (unsigned j = 0; j < 16; ++j) { const unsigned c = xb_ld(&bar[XB_XCNT(j)]); sum += c; cnt += (c > 0u) ? 1u : 0u; mine = (j == x) ? c : mine; }
        if (sum == G) break;
        __builtin_amdgcn_s_sleep(1);
        if ((++sp & 255u) == 0u) { if (xb_ld(&bar[XB_TMO])) break; if (sp > XB_SPIN_CAP) { atomicAdd(&bar[XB_TMO], 1u); break; } }
    }
    nloc = mine > 0u ? mine : 1u; nx = cnt > 0u ? cnt : 1u;
}

__device__ __forceinline__ void xcd_barrier(const XcdBarrier& b) {
    asm volatile("s_waitcnt vmcnt(0)" ::: "memory");
    __syncthreads();
    if (threadIdx.x == 0) {
        unsigned* bar = b.bar;
        __builtin_amdgcn_s_waitcnt(0);
        unsigned nloc = b.st[0], nx = b.st[1];
        if (nloc == 0u) { xcd_barrier_complete(bar, b.x, nloc, nx); b.st[0] = nloc; b.st[1] = nx; }
        const unsigned old = xb_add(&bar[XB_XSUB(b.x)], 1u);
        const unsigned gen = old / nloc;
        if (old + 1u == (gen + 1u) * nloc) {
            __builtin_amdgcn_fence(__ATOMIC_RELEASE, "agent");
            asm volatile("s_waitcnt vmcnt(0)" ::: "memory");
            const unsigned og = xb_add(&bar[XB_TOP], 1u);
            const unsigned tg = og / nx;
            if (og + 1u == (tg + 1u) * nx) xb_add(&bar[XB_TOPGEN], 1u);
            else XB_SPIN(xb_ld(&bar[XB_TOPGEN]) == tg, bar);
            __builtin_amdgcn_fence(__ATOMIC_ACQUIRE, "agent");
            xb_add(&bar[XB_XGEN(b.x)], 1u);
            asm volatile("s_waitcnt vmcnt(0)" ::: "memory");
        } else {
            XB_SPIN(xb_ld(&bar[XB_XGEN(b.x)]) == gen, bar);
            __builtin_amdgcn_fence(__ATOMIC_ACQUIRE, "agent");
            asm volatile("s_waitcnt vmcnt(0)" ::: "memory");
        }
    }
    __syncthreads();
}

constexpr int NWAVES = 8;
constexpr int RING_BYTES = 131072;
constexpr int LDSCTL_OFF = RING_BYTES;
constexpr int LDS_BYTES = 147456;
struct Frame {
    LAS unsigned char* lds; volatile LAS unsigned* MISC; unsigned* ctl;
    int tid, lane, wave, G, gw, NGW;
    unsigned char* ws;
};
struct Args { const float* in[20]; float* out; unsigned char* ws; int ph_lo, ph_hi; };

__device__ __forceinline__ void transpose_item(const float* W, int ldw, int c0, int K, bf16* WT, int n0, int k0, LAS float* scr, int lane) {
#pragma unroll 8
    for (int i = 0; i < 32; ++i) { const int kk = 2 * i + (lane >> 5); scr[kk * 33 + (lane & 31)] = W[(size_t)(k0 + kk) * ldw + c0 + (lane & 31)]; }
    LDS_WAIT(); asm volatile("" ::: "memory");
    const int c = lane & 7;
#pragma unroll
    for (int j = 0; j < 4; ++j) { const int n = (lane >> 3) + 8 * j; const LAS float* s = scr + (8 * c) * 33 + n;
        v4u o; o.x = pk2(s[0 * 33], s[1 * 33]); o.y = pk2(s[2 * 33], s[3 * 33]); o.z = pk2(s[4 * 33], s[5 * 33]); o.w = pk2(s[6 * 33], s[7 * 33]);
        *(v4u*)(WT + (size_t)(n0 + n) * K + k0 + 8 * c) = o; }
    LDS_WAIT(); asm volatile("" ::: "memory");
}
__device__ __forceinline__ int l1_src_col(int n) {
    const int pn = n >> 8, j = n & 255, jh = j & 127, second = j >> 7;
    if (pn == 10 || pn == 11) return n;
    if (pn < 10) return pn * 256 + (jh >> 6) * 128 + second * 64 + (jh & 63);
    return 3072 + ((pn - 12) * 4 + (jh >> 5)) * 64 + second * 32 + (jh & 31);
}
template <int NJ> __device__ __forceinline__ float row_dots(LAS float* scr, const f32x4 (&xv)[8], const float* W, int ld, int lane) {
#pragma unroll
    for (int j = 0; j < 8; ++j) *(LAS f32x4*)(scr + 256 * j + 4 * lane) = xv[j];
    LDS_WAIT(); asm volatile("" ::: "memory");
    float acc[NJ];
#pragma unroll
    for (int jj = 0; jj < NJ; ++jj) acc[jj] = 0.f;
#pragma unroll 2
    for (int c = 0; c < 32; ++c) { const int k = c * 64 + lane; const float xs = scr[k]; const float* wr = W + (size_t)k * ld;
#pragma unroll
        for (int q4 = 0; q4 < NJ / 4; ++q4) { const f32x4 w = *(const f32x4*)(wr + 4 * q4);
            acc[4 * q4 + 0] += xs * w[0]; acc[4 * q4 + 1] += xs * w[1]; acc[4 * q4 + 2] += xs * w[2]; acc[4 * q4 + 3] += xs * w[3]; } }
    LDS_WAIT(); asm volatile("" ::: "memory");
#pragma unroll
    for (int jj = 0; jj < NJ; ++jj) scr[jj * 65 + lane] = acc[jj];
    LDS_WAIT(); asm volatile("" ::: "memory");
    float s = 0.f;
    if (lane < NJ) {
#pragma unroll 8
        for (int l = 0; l < 64; ++l) s += scr[lane * 65 + l]; }
    LDS_WAIT(); asm volatile("" ::: "memory");
    return s;
}
__device__ __forceinline__ void ln_row(f32x4 (&v)[8], const float* g, const float* b, int lane) {
    float s = 0.f;
#pragma unroll
    for (int j = 0; j < 8; ++j) s += (v[j][0] + v[j][1]) + (v[j][2] + v[j][3]);
    const float mean = wave_sum(s) * (1.f / DM); float s2 = 0.f;
#pragma unroll
    for (int j = 0; j < 8; ++j) { v[j] = v[j] - mean; s2 += (v[j][0] * v[j][0] + v[j][1] * v[j][1]) + (v[j][2] * v[j][2] + v[j][3] * v[j][3]); }
    const float rstd = 1.f / sqrtf(wave_sum(s2) * (1.f / DM) + LN_EPS);
#pragma unroll
    for (int j = 0; j < 8; ++j) { const f32x4 gg = *(const f32x4*)(g + 256 * j + 4 * lane), bb = *(const f32x4*)(b + 256 * j + 4 * lane); v[j] = v[j] * rstd * gg + bb; }
}
__device__ __forceinline__ void store_row_bf16(bf16* dst, const f32x4 (&v)[8], int lane) {
#pragma unroll
    for (int j = 0; j < 8; ++j) { uint2 o; o.x = pk2(v[j][0], v[j][1]); o.y = pk2(v[j][2], v[j][3]); *(uint2*)(dst + 256 * j + 4 * lane) = o; }
}
__device__ __forceinline__ void topk_mask_row(const float* sc, int qpos, unsigned long long* mrow, int lane) {
    unsigned u[64];
#pragma unroll
    for (int i = 0; i < 64; ++i) { const int s = 64 * i + lane; const bool ok = s <= qpos; const float f = ok ? sc[s] : 0.f; const unsigned b = __builtin_bit_cast(unsigned, f);
        const unsigned key = b ^ ((b >> 31) ? 0xFFFFFFFFu : 0x80000000u); u[i] = ok ? key : 0u; }
    if (qpos + 1 <= 256) {
#pragma unroll
        for (int i = 0; i < 64; ++i) { const unsigned long long w = __ballot(64 * i + lane <= qpos); if (lane == 0) mrow[i] = w; }
        return;
    }
    unsigned T = 0u;
#pragma unroll 1
    for (int bit = 31; bit >= 0; --bit) { const unsigned cand = T | (1u << bit); int cnt = 0;
#pragma unroll
        for (int i = 0; i < 64; ++i) cnt += __builtin_popcountll(__ballot(u[i] >= cand));
        if (cnt >= 256) T = cand; }
    int cgt = 0;
#pragma unroll
    for (int i = 0; i < 64; ++i) cgt += __builtin_popcountll(__ballot(u[i] > T));
    const int need = 256 - cgt; int run = 0; const unsigned long long below = (1ull << lane) - 1ull;
#pragma unroll
    for (int i = 0; i < 64; ++i) { const bool gt = u[i] > T, eq = u[i] == T; const unsigned long long eqm = __ballot(eq);
        const int rank = run + __builtin_popcountll(eqm & below); const bool sel = gt || (eq && rank < need); run += __builtin_popcountll(eqm);
        const unsigned long long w = __ballot(sel); if (lane == 0) mrow[i] = w; }
}

__device__ __forceinline__ void p0_prologue(Frame& F, const Args& a) {
    LAS float* scr = (LAS float*)(F.lds + F.wave * 16384);
    const int gw = F.gw, NGW = F.NGW, lane = F.lane;
    unsigned char* ws = F.ws;
    {
        const float* W = a.in[1]; bf16* WT = (bf16*)(ws + WS_WINA);
        for (int it = gw; it < (2048 / 64) * (NP0 / 32); it += NGW) { const int kb = it / (NP0 / 32), nb = it % (NP0 / 32), n0 = nb * 32; transpose_item(W, NE0, n0 < 3072 ? n0 : n0 + 16, 2048, WT, n0, kb * 64, scr, lane); }
    }
    {
        for (int it = gw; it < 2 * 32 * 64; it += NGW) { const int w = it / (32 * 64), r = it % (32 * 64), kb = r / 64, nb = r % 64;
            transpose_item(w ? a.in[8] : a.in[6], 2048, nb * 32, 2048, (bf16*)(ws + (w ? WS_WOC : WS_WOA)), nb * 32, kb * 64, scr, lane); }
    }
    {
        const float* W = a.in[7]; bf16* WT = (bf16*)(ws + WS_WINC);
        for (int it = gw; it < 32 * (NP1 / 32); it += NGW) { const int kb = it / (NP1 / 32), nb = it % (NP1 / 32), n0 = nb * 32; transpose_item(W, NE1, l1_src_col(n0), 2048, WT, n0, kb * 64, scr, lane); }
    }
    {
        const int per = 32 * 32;
        for (int it = gw; it < 64 * per; it += NGW) { const int ex = it / per, r = it % per, kb = r / 32, nb = r % 32, n0 = nb * 32, tile = n0 >> 8, j = n0 & 255;
            const float* W = (j < 128 ? a.in[17] : a.in[18]) + (size_t)ex * 2048 * 512;
            transpose_item(W, 512, 128 * tile + (j & 127), 2048, (bf16*)(ws + WS_WGU) + (size_t)ex * 1024 * 2048, n0, kb * 64, scr, lane); }
    }
    {
        const int per = 8 * 64;
        for (int it = gw; it < 64 * per; it += NGW) { const int ex = it / per, r = it % per, kb = r / 64, nb = r % 64;
            transpose_item(a.in[19] + (size_t)ex * 512 * 2048, 2048, nb * 32, 512, (bf16*)(ws + WS_WD) + (size_t)ex * 2048 * 512, nb * 32, kb * 64, scr, lane); }
    }
    const int gt = blockIdx.x * (NWAVES * 64) + F.tid, NGT = F.G * NWAVES * 64;
    {   float* c128 = (float*)(ws + WS_ROPE); float* s128 = c128 + 4096 * 64; float* c64 = s128 + 4096 * 64; float* s64 = c64 + 4096 * 32;
        for (int i = gt; i < 4096 * 96; i += NGT) { int pos, idx, half; float* cp; float* sp;
            if (i < 4096 * 64) { pos = i >> 6; idx = i & 63; half = 64; cp = c128 + i; sp = s128 + i; } else { const int r = i - 4096 * 64; pos = r >> 5; idx = r & 31; half = 32; cp = c64 + r; sp = s64 + r; }
            const float inv = exp2f(-(float)idx / (float)half * 13.287712379549449f);
            const float ang = (float)pos * inv;
            double rv = (double)ang * 0.15915494309189535; rv -= rint(rv);
            const float rf = (float)rv;
            *cp = __builtin_amdgcn_cosf(rf); *sp = __builtin_amdgcn_sinf(rf); }
    }
    {   float* RT = (float*)(ws + WS_WSM);
        for (int i = gt; i < 2 * 2048 * 40; i += NGT) { const int l = i / (2048 * 40), r = i % (2048 * 40), k = r / 40, c = r % 40; float v = 0.f;
            if (c < 4) v = a.in[13][((size_t)l * 2048 + k) * 4 + c]; else if (c < 36) { const int g = (c - 4) >> 3, e = (c - 4) & 7; v = a.in[15][(((size_t)l * 4 + g) * 2048 + k) * 8 + e]; }
            RT[i] = v; }
        float* SKW1 = RT + 2 * 2048 * 40;
        for (int i = gt; i < 2048 * 80; i += NGT) { const int k = i / 80, c = i % 80; SKW1[i] = a.in[7][(size_t)k * NE1 + 4096 + c]; }
    }
    {   const float* x = a.in[0]; bf16* XB = (bf16*)(ws + WS_XB); float* SK0 = (float*)(ws + WS_SK0); const float* W = a.in[1];
        for (int m = gw; m < MTOK; m += NGW) { f32x4 v[8];
#pragma unroll
            for (int j = 0; j < 8; ++j) v[j] = *(const f32x4*)(x + (size_t)m * DM + 256 * j + 4 * lane);
            store_row_bf16(XB + (size_t)m * DM, v, lane);
            const float m16 = row_dots<16>(scr, v, W + 3072, NE0, lane); const float m8 = row_dots<8>(scr, v, W + 6160, NE0, lane);
            const float m8s = __shfl(m8, (lane - 16) & 63); if (lane < 16) SK0[(size_t)m * 24 + lane] = m16; else if (lane < 24) SK0[(size_t)m * 24 + lane] = m8s; }
    }
}
__device__ __forceinline__ void p_fox_bias(Frame& F, const Args& a) {
    if (F.gw >= 16) return;
    const int bh = F.gw, b = bh >> 3, h = bh & 7, lane = F.lane; const float gb = a.in[5][h];
    const float* SK0 = (const float*)(F.ws + WS_SK0); float* FB = (float*)(F.ws + WS_FBIAS) + (size_t)bh * SEQ;
    float tot = 0.f;
    for (int i = 0; i < 64; ++i) { const int s = lane * 64 + i; tot += logsigmoidf(SK0[(size_t)(b * SEQ + s) * 24 + 16 + h] + gb); }
    float incl = tot;
#pragma unroll
    for (int o = 1; o < 64; o <<= 1) { const float t = __shfl_up(incl, o); if (lane >= o) incl += t; }
    float run = incl - tot;
    for (int i = 0; i < 64; ++i) { const int s = lane * 64 + i; run += logsigmoidf(SK0[(size_t)(b * SEQ + s) * 24 + 16 + h] + gb); FB[s] = -run * (1.0f / ATT_SCALE); }
}
__device__ __forceinline__ void p_ln_route(Frame& F, const Args& a, int layer) {
    float* XR = (float*)(F.ws + WS_XR); bf16* XB = (bf16*)(F.ws + WS_XB); const int lane = F.lane;
    const float* g = a.in[9] + layer * DM; const float* bb = a.in[10] + layer * DM;
    const float* RT = (const float*)(F.ws + WS_WSM) + (size_t)layer * 2048 * 40;
    const float* bg = a.in[14] + layer * 4; const float* be = a.in[16] + layer * 32;
    int4* ROUTE = (int4*)(F.ws + WS_ROUTE); unsigned* cnt = F.ctl + CW_CNT + layer * 64;
    for (int m = F.gw; m < MTOK; m += F.NGW) { f32x4 v[8];
#pragma unroll
        for (int j = 0; j < 8; ++j) v[j] = *(const f32x4*)(XR + (size_t)m * DM + 256 * j + 4 * lane);
        ln_row(v, g, bb, lane);
#pragma unroll
        for (int j = 0; j < 8; ++j) *(f32x4*)(XR + (size_t)m * DM + 256 * j + 4 * lane) = v[j];
        store_row_bf16(XB + (size_t)m * DM, v, lane);
        const float mine = row_dots<36>((LAS float*)(F.lds + F.wave * 16384), v, RT, 40, lane);
        float gl[4];
#pragma unroll
        for (int i = 0; i < 4; ++i) gl[i] = __shfl(mine, i) + bg[i];
        int gi = 0; float gm = gl[0];
#pragma unroll
        for (int i = 1; i < 4; ++i) if (gl[i] > gm) { gm = gl[i]; gi = i; }
        float gs = 0.f;
#pragma unroll
        for (int i = 0; i < 4; ++i) gs += __expf(gl[i] - gm);
        const float gp = 1.0f / gs;
        float el[8];
#pragma unroll
        for (int e = 0; e < 8; ++e) el[e] = __shfl(mine, 4 + 8 * gi + e) + be[gi * 8 + e];
        int e1 = 0; float v1 = el[0];
#pragma unroll
        for (int e = 1; e < 8; ++e) if (el[e] > v1) { v1 = el[e]; e1 = e; }
        int e2 = -1; float v2 = -3.0e38f;
#pragma unroll
        for (int e = 0; e < 8; ++e) if (e != e1 && el[e] > v2) { v2 = el[e]; e2 = e; }
        const float w1 = gp / (1.0f + __expf(v2 - v1)), w2 = gp - w1;
        if (lane == 0) { const int ge1 = gi * 8 + e1, ge2 = gi * 8 + e2;
            const int p1 = (int)atomicAdd(cnt + ge1, 1u), p2 = (int)atomicAdd(cnt + ge2, 1u);
            ROUTE[(size_t)m * 2 + 0] = make_int4(ge1, p1, __builtin_bit_cast(int, w1), 0);
            ROUTE[(size_t)m * 2 + 1] = make_int4(ge2, p2, __builtin_bit_cast(int, w2), 0); }
    }
}
__device__ __forceinline__ int moe_offsets(const unsigned* cnt, int lane, int* tiles_incl) {
    const int c = lane < 32 ? (int)cnt[lane] : 0; const int t = (c + 255) >> 8; int incl = t;
#pragma unroll
    for (int o = 1; o < 32; o <<= 1) { const int x = __shfl_up(incl, o); if ((lane & 31) >= o) incl += x; }
    *tiles_incl = incl; return (incl - t) * 256;
}
__device__ __forceinline__ void p_gather(Frame& F, int layer) {
    const int lane = F.lane; const unsigned* cnt = F.ctl + CW_CNT + layer * 64; int ti; const int off = moe_offsets(cnt, lane, &ti);
    const bf16* XB = (const bf16*)(F.ws + WS_XB); bf16* XG = (bf16*)(F.ws + WS_PROJ); float* ROWW = (float*)(F.ws + WS_ROWW); int4* ROUTE = (int4*)(F.ws + WS_ROUTE);
    for (int m = F.gw; m < MTOK; m += F.NGW) {
#pragma unroll
        for (int s = 0; s < 2; ++s) { int4 r = ROUTE[(size_t)m * 2 + s]; const int dst = __shfl(off, r.x) + r.y;
            const v4u* src = (const v4u*)(XB + (size_t)m * DM); v4u* d = (v4u*)(XG + (size_t)dst * DM);
#pragma unroll
            for (int j = 0; j < 4; ++j) d[64 * j + lane] = src[64 * j + lane];
            if (lane == 0) { ROWW[dst] = __builtin_bit_cast(float, r.z); r.w = dst; ROUTE[(size_t)m * 2 + s] = r; } }
    }
}
__device__ __forceinline__ void p_ln_ffn(Frame& F, const Args& a, int layer) {
    float* XR = (float*)(F.ws + WS_XR); bf16* XB = (bf16*)(F.ws + WS_XB); const int lane = F.lane; const bf16* YG = (const bf16*)(F.ws + WS_CST);
    const float* g = a.in[11] + layer * DM; const float* bb = a.in[12] + layer * DM; const int4* ROUTE = (const int4*)(F.ws + WS_ROUTE);
    float* dst = layer == 1 ? a.out : XR;
    const float* SKW1 = (const float*)(F.ws + WS_WSM) + 2 * 2048 * 40;
    const float* c64 = (const float*)(F.ws + WS_ROPE) + 2 * 4096 * 64; const float* s64 = c64 + 4096 * 32;
    bf16* IK = (bf16*)(F.ws + WS_IK); float* IW = (float*)(F.ws + WS_IW);
    for (int m = F.gw; m < MTOK; m += F.NGW) { f32x4 v[8];
        const int r0 = ROUTE[(size_t)m * 2].w, r1 = ROUTE[(size_t)m * 2 + 1].w;
#pragma unroll
        for (int j = 0; j < 8; ++j) { v[j] = *(const f32x4*)(XR + (size_t)m * DM + 256 * j + 4 * lane) * DN_ALPHA;
            const uint2 y0 = *(const uint2*)(YG + (size_t)r0 * DM + 256 * j + 4 * lane), y1 = *(const uint2*)(YG + (size_t)r1 * DM + 256 * j + 4 * lane);
            v[j][0] += bf2f(y0.x & 0xffff) + bf2f(y1.x & 0xffff); v[j][1] += bf2f(y0.x >> 16) + bf2f(y1.x >> 16);
            v[j][2] += bf2f(y0.y & 0xffff) + bf2f(y1.y & 0xffff); v[j][3] += bf2f(y0.y >> 16) + bf2f(y1.y >> 16); }
        ln_row(v, g, bb, lane);
#pragma unroll
        for (int j = 0; j < 8; ++j) *(f32x4*)(dst + (size_t)m * DM + 256 * j + 4 * lane) = v[j];
        if (layer == 0) {
            store_row_bf16(XB + (size_t)m * DM, v, lane);
            LAS float* scr = (LAS float*)(F.lds + F.wave * 16384); const float mA = row_dots<40>(scr, v, SKW1, 80, lane), mB = row_dots<40>(scr, v, SKW1 + 40, 80, lane);
            const float mBs = __shfl(mB, (lane - 40) & 63); const float mine = lane < 40 ? mA : mBs;
            const float wv = __shfl(mB, (lane + 24) & 63);
            const float part = __shfl(mine, lane ^ 32);
            const int pos = m & 4095, i = lane & 31; const float c = c64[pos * 32 + i], s = s64[pos * 32 + i];
            const float r = lane < 32 ? (mine * c - part * s) : (mine * c + part * s);
            IK[(size_t)m * 64 + lane] = (bf16)f2bf(r);
            if (lane < 16) IW[(size_t)m * 16 + lane] = wv * 0.25f * 0.125f; }
    }
}
__global__ void __launch_bounds__(NWAVES * 64, 2) mk_fwd(Args args) {
    extern __shared__ __attribute__((aligned(16))) unsigned char lds[];
    Frame F;
    F.lds = (LAS unsigned char*)lds; F.MISC = (volatile LAS unsigned*)(F.lds + LDSCTL_OFF);
    F.tid = threadIdx.x; F.lane = F.tid & 63; F.wave = __builtin_amdgcn_readfirstlane(F.tid >> 6);
    F.G = gridDim.x; F.gw = blockIdx.x * NWAVES + F.wave; F.NGW = F.G * NWAVES;
    F.ws = args.ws; F.ctl = (unsigned*)(args.ws + WS_CTL);
    for (int u = F.tid; u < (LDS_BYTES - LDSCTL_OFF) / 4; u += NWAVES * 64) ((LAS unsigned*)(F.lds + LDSCTL_OFF))[u] = 0u;
    __syncthreads();
    const int lo = args.ph_lo, hi = args.ph_hi;
    XcdBarrier bar; bar.bar = F.ctl + CW_BAR; bar.x = 0; bar.st = nullptr;
    if (hi - lo > 1) bar = xcd_barrier_post(F.ctl + CW_BAR, F.MISC);
#define IN(k) (lo <= (k) && (k) < hi)
#define SEAM(k) do { if (hi > (k) + 1) xcd_barrier(bar); } while (0)
    unsigned char* ws = args.ws;

    if (IN(0)) { p0_prologue(F, args); SEAM(0); }
            if (IN(1)) {
                pg8::Gemm g{(const bf16*)(ws + WS_XB), (const bf16*)(ws + WS_WINA), MTOK, NP0, DM}; pg8::StaticOrder S; S.init(MTOK, NP0, F.G, (int)blockIdx.x);
                pg8::EpiBf16Plain E{(bf16*)(ws + WS_PROJ), NP0, 0x7fffffff};
                pg8::gemm_phase<pg8::EpiBf16Plain, pg8::StaticOrder, true, true>(F.lds, g, S, E);
                SEAM(1);
            }
            if (IN(2)) { p_fox_bias(F, args); SEAM(2); }
        if (IN(0 + 5)) {
            pg8::Gemm g{(const bf16*)(ws + WS_OMIX), (const bf16*)(ws + (0 ? WS_WOC : WS_WOA)), MTOK, DM, DM}; pg8::StaticOrder S; S.init(MTOK, DM, F.G, (int)blockIdx.x);
            pg8::EpiResid E{0 ? (const float*)(ws + WS_XR) : args.in[0], (float*)(ws + WS_XR), DN_ALPHA};
            pg8::gemm_phase<pg8::EpiResid, pg8::StaticOrder, true, true>(F.lds, g, S, E);
            SEAM(0 + 5);
        }
        if (IN(0 + 6)) { p_ln_route(F, args, 0); SEAM(0 + 6); }
        if (IN(0 + 7)) { p_gather(F, 0); SEAM(0 + 7); }
        if (IN(0 + 8) || IN(0 + 9)) {
            if (F.wave == 0) { int ti; (void)moe_offsets(F.ctl + CW_CNT + 0 * 64, F.lane, &ti); if (F.lane < 32) F.MISC[64 + F.lane] = (unsigned)ti; if (F.lane == 31) F.MISC[96] = (unsigned)ti; }
            __syncthreads();
        }
        if (IN(0 + 8)) {
            pg8::Gemm g{(const bf16*)(ws + WS_PROJ), (const bf16*)(ws + WS_WGU) + (size_t)0 * 32 * 1024 * 2048, RPAD, 32 * 1024, DM};
            pg8::MoeOrder S{F.G, (int)blockIdx.x, 4, (int)F.MISC[96], (const LAS int*)(F.lds + LDSCTL_OFF + 64 * 4)};
            pg8::EpiGLU E{(bf16*)(ws + WS_OMIX), (const float*)(ws + WS_ROWW)};
            pg8::gemm_phase<pg8::EpiGLU, pg8::MoeOrder, true, true>(F.lds, g, S, E);
            SEAM(0 + 8);
        }
        if (IN(0 + 9)) {
            pg8::Gemm g{(const bf16*)(ws + WS_OMIX), (const bf16*)(ws + WS_WD) + (size_t)0 * 32 * 2048 * 512, RPAD, 32 * 2048, 512};
            pg8::MoeOrder S{F.G, (int)blockIdx.x, 8, (int)F.MISC[96], (const LAS int*)(F.lds + LDSCTL_OFF + 64 * 4)};
            pg8::EpiBf16Plain E{(bf16*)(ws + WS_CST), DM, 7};
            pg8::gemm_phase<pg8::EpiBf16Plain, pg8::MoeOrder, true, true>(F.lds, g, S, E);
            SEAM(0 + 9);
        }
        if (IN(0 + 10)) { p_ln_ffn(F, args, 0); SEAM(0 + 10); }
                if (IN(11)) {
                pg8::Gemm g{(const bf16*)(ws + WS_XB), (const bf16*)(ws + WS_WINC), MTOK, NP1, DM}; pg8::StaticOrder S; S.init(MTOK, NP1, F.G, (int)blockIdx.x);
                const float* c128 = (const float*)(ws + WS_ROPE);
                pg8::EpiRope E{(bf16*)(ws + WS_PROJ), c128, c128 + 4096 * 64, c128 + 2 * 4096 * 64, c128 + 2 * 4096 * 64 + 4096 * 32};
                pg8::gemm_phase<pg8::EpiRope, pg8::StaticOrder, true, true>(F.lds, g, S, E);
                SEAM(11);
            }
            if (IN(12)) {
                const float* SC = (const float*)(ws + WS_SC); unsigned long long* MASK = (unsigned long long*)(ws + WS_MASK);
                for (int m = F.gw; m < MTOK; m += F.NGW) topk_mask_row(SC + (size_t)m * SEQ, m & 4095, MASK + (size_t)m * 64, F.lane);
                SEAM(12);
            }
                if (IN(10 + 5)) {
            pg8::Gemm g{(const bf16*)(ws + WS_OMIX), (const bf16*)(ws + (1 ? WS_WOC : WS_WOA)), MTOK, DM, DM}; pg8::StaticOrder S; S.init(MTOK, DM, F.G, (int)blockIdx.x);
            pg8::EpiResid E{1 ? (const float*)(ws + WS_XR) : args.in[0], (float*)(ws + WS_XR), DN_ALPHA};
            pg8::gemm_phase<pg8::EpiResid, pg8::StaticOrder, true, true>(F.lds, g, S, E);
            SEAM(10 + 5);
        }
        if (IN(10 + 6)) { p_ln_route(F, args, 1); SEAM(10 + 6); }
        if (IN(10 + 7)) { p_gather(F, 1); SEAM(10 + 7); }
        if (IN(10 + 8) || IN(10 + 9)) {
            if (F.wave == 0) { int ti; (void)moe_offsets(F.ctl + CW_CNT + 1 * 64, F.lane, &ti); if (F.lane < 32) F.MISC[64 + F.lane] = (unsigned)ti; if (F.lane == 31) F.MISC[96] = (unsigned)ti; }
            __syncthreads();
        }
        if (IN(10 + 8)) {
            pg8::Gemm g{(const bf16*)(ws + WS_PROJ), (const bf16*)(ws + WS_WGU) + (size_t)1 * 32 * 1024 * 2048, RPAD, 32 * 1024, DM};
            pg8::MoeOrder S{F.G, (int)blockIdx.x, 4, (int)F.MISC[96], (const LAS int*)(F.lds + LDSCTL_OFF + 64 * 4)};
            pg8::EpiGLU E{(bf16*)(ws + WS_OMIX), (const float*)(ws + WS_ROWW)};
            pg8::gemm_phase<pg8::EpiGLU, pg8::MoeOrder, true, true>(F.lds, g, S, E);
            SEAM(10 + 8);
        }
        if (IN(10 + 9)) {
            pg8::Gemm g{(const bf16*)(ws + WS_OMIX), (const bf16*)(ws + WS_WD) + (size_t)1 * 32 * 2048 * 512, RPAD, 32 * 2048, 512};
            pg8::MoeOrder S{F.G, (int)blockIdx.x, 8, (int)F.MISC[96], (const LAS int*)(F.lds + LDSCTL_OFF + 64 * 4)};
            pg8::EpiBf16Plain E{(bf16*)(ws + WS_CST), DM, 7};
            pg8::gemm_phase<pg8::EpiBf16Plain, pg8::MoeOrder, true, true>(F.lds, g, S, E);
            SEAM(10 + 9);
        }
        if (IN(10 + 10)) { p_ln_ffn(F, args, 1); SEAM(10 + 10); }
    #undef IN
#undef SEAM
}

__global__ void __launch_bounds__(128) k_gla_b(const float* SK0, const float* w2, const float* gbias, float* GB, float* DEC) {
    const int unit = blockIdx.x, n = unit & 63, bh = unit >> 6, b = bh >> 2, h = bh & 3, d = threadIdx.x, t0 = b * SEQ + n * 64;
    float w[16];
#pragma unroll
    for (int r = 0; r < 16; ++r) w[r] = w2[r * 512 + h * 128 + d];
    const float gb = gbias[h * 128 + d]; float run = 0.f;
    for (int c = 0; c < 64; ++c) { const int t = t0 + c; float z = gb;
#pragma unroll
        for (int r = 0; r < 16; ++r) z += SK0[(size_t)t * 24 + r] * w[r];
        run += logsigmoidf(z) * (1.0f / 16.0f); GB[(size_t)t * 512 + h * 128 + d] = run; }
    DEC[unit * 128 + d] = __expf(run);
}
__global__ void __launch_bounds__(256) k_gla_state(const bf16* PROJ, const float* GB, float* CST) {
    const int unit = blockIdx.x, d = blockIdx.y, v = threadIdx.x, n = unit & 63, bh = unit >> 6, b = bh >> 2, h = bh & 3, t0 = b * SEQ + n * 64;
    const float blast = GB[(size_t)(t0 + 63) * 512 + h * 128 + d]; float acc = 0.f;
    for (int c = 0; c < 64; ++c) { const size_t t = t0 + c; const float kk = bf2f(PROJ[t * NP0 + 512 + h * 128 + d]) * __expf(blast - GB[t * 512 + h * 128 + d]);
        acc += kk * bf2f(PROJ[t * NP0 + 1024 + h * 256 + v]); }
    CST[((size_t)unit * 256 + v) * 128 + d] = acc;
}
__global__ void __launch_bounds__(256) k_gla_scan(const float* CST, const float* DEC, bf16* PREVT) {
    const int idx = blockIdx.x * 256 + threadIdx.x, bh = idx >> 15, vd = idx & 32767, d = vd & 127; float S = 0.f;
    for (int n = 0; n < 64; ++n) { const int unit = bh * 64 + n; PREVT[(size_t)unit * 32768 + vd] = (bf16)f2bf(S); S = DEC[unit * 128 + d] * S + CST[(size_t)unit * 32768 + vd]; }
}
__global__ void __launch_bounds__(256) k_gla_out(const bf16* PROJ, const float* GB, const bf16* PREVT, const float* normg, bf16* OMIX) {
    extern __shared__ __attribute__((aligned(16))) unsigned char sm[];
    float* qd = (float*)sm; float* ki = qd + 64 * 128; float* sc = ki + 64 * 128; float* red = sc + 64 * 64;
    const int unit = blockIdx.x, n = unit & 63, bh = unit >> 6, b = bh >> 2, h = bh & 3, t0 = b * SEQ + n * 64, tid = threadIdx.x;
    for (int i = tid; i < 64 * 128; i += 256) { const int c = i >> 7, d = i & 127; const size_t t = t0 + c; const float bb = GB[t * 512 + h * 128 + d];
        qd[i] = bf2f(PROJ[t * NP0 + h * 128 + d]) * ATT_SCALE * __expf(bb); ki[i] = bf2f(PROJ[t * NP0 + 512 + h * 128 + d]) * __expf(-bb); }
    __syncthreads();
    for (int p = tid; p < 64 * 64; p += 256) { const int i = p >> 6, j = p & 63; float s = 0.f;
        if (j <= i) for (int d = 0; d < 128; ++d) s += qd[i * 128 + d] * ki[j * 128 + d];
        sc[p] = s; }
    __syncthreads();
    const int v = tid; const bf16* pv = PREVT + ((size_t)unit * 256 + v) * 128; const float gv = normg[v];
    for (int i = 0; i < 64; ++i) { float acc = 0.f;
        for (int j = 0; j <= i; ++j) acc += sc[i * 64 + j] * bf2f(PROJ[(size_t)(t0 + j) * NP0 + 1024 + h * 256 + v]);
        for (int d = 0; d < 128; ++d) acc += qd[i * 128 + d] * bf2f(pv[d]);
        float ss = wave_sum(acc * acc); if ((tid & 63) == 0) red[tid >> 6] = ss; __syncthreads();
        const float ms = (red[0] + red[1] + red[2] + red[3]) * (1.0f / 256.0f); __syncthreads();
        const float gr = bf2f(PROJ[(size_t)(t0 + i) * NP0 + 2048 + h * 256 + v]);
        const float o = acc * (1.0f / sqrtf(ms + LN_EPS)) * gv * (gr / (1.0f + __expf(-gr)));
        OMIX[(size_t)(t0 + i) * DM + h * 256 + v] = (bf16)f2bf(o); }
}
template <int MODE  >
__global__ void __launch_bounds__(256) k_attn_naive(const bf16* Qb, int ldq, int qc0, const bf16* Kb, int ldk, int kc0, const bf16* Vb, int ldv, int vc0, int group,
                                                    const float* fbias, const unsigned long long* mask, bf16* O, int oc0) {
    __shared__ __attribute__((aligned(16))) bf16 Ks[64 * 128]; __shared__ __attribute__((aligned(16))) bf16 Vs[64 * 128];
    const int qb = blockIdx.x, h = blockIdx.y, b = blockIdx.z, tid = threadIdx.x, qi = tid >> 2, part = tid & 3, kvh = h / group;
    const int qpos = qb * 64 + qi; const size_t row = (size_t)b * SEQ + qpos;
    float qv[32], o[32];
#pragma unroll
    for (int d = 0; d < 32; ++d) { qv[d] = bf2f(Qb[row * ldq + qc0 + h * 128 + part * 32 + d]); o[d] = 0.f; }
    float mrun = -1e30f, l = 0.f;
    const float* fb = MODE == 0 ? fbias + (size_t)(b * 8 + h) * SEQ : nullptr;
    for (int kt = 0; kt <= qb; ++kt) {
        __syncthreads();
        for (int i = tid; i < 64 * 16; i += 256) { const int r = i >> 4, c8 = (i & 15) * 8; const size_t kr = (size_t)b * SEQ + kt * 64 + r;
            *(v4u*)(Ks + r * 128 + c8) = *(const v4u*)(Kb + kr * ldk + kc0 + kvh * 128 + c8); *(v4u*)(Vs + r * 128 + c8) = *(const v4u*)(Vb + kr * ldv + vc0 + kvh * 128 + c8); }
        __syncthreads();
        unsigned long long mw = ~0ull; if (MODE == 1) mw = mask[row * 64 + kt];
        for (int s = 0; s < 64; ++s) { const int key = kt * 64 + s; float p = 0.f;
#pragma unroll
            for (int d = 0; d < 32; ++d) p += qv[d] * bf2f(Ks[s * 128 + part * 32 + d]);
            p += __shfl_xor(p, 1); p += __shfl_xor(p, 2);
            const bool valid = key <= qpos && ((mw >> s) & 1ull);
            if (valid) { const float logit = (p + (MODE == 0 ? fb[key] : 0.f)) * ATT_SCALE; const float mn = fmaxf(mrun, logit), al = __expf(mrun - mn), pp = __expf(logit - mn);
                l = l * al + pp; mrun = mn;
#pragma unroll
                for (int d = 0; d < 32; ++d) o[d] = o[d] * al + pp * bf2f(Vs[s * 128 + part * 32 + d]); } }
    }
    const float il = 1.0f / l;
#pragma unroll
    for (int d = 0; d < 32; ++d) O[row * DM + oc0 + h * 128 + part * 32 + d] = (bf16)f2bf(o[d] * il);
}
__global__ void __launch_bounds__(256) k_idx_scores(const bf16* PROJ1, const bf16* IK, const float* IW, float* SC) {
    __shared__ float q[16 * 64]; __shared__ float w[16];
    const int m = blockIdx.x, pos = m & 4095, b = m >> 12, tid = threadIdx.x;
    for (int i = tid; i < 1024; i += 256) q[i] = bf2f(PROJ1[(size_t)m * NP1 + 3072 + i]);
    if (tid < 16) w[tid] = IW[(size_t)m * 16 + tid];
    __syncthreads();
    for (int s = tid; s <= pos; s += 256) { const bf16* kr = IK + ((size_t)b * SEQ + s) * 64; float kk[64];
#pragma unroll
        for (int d = 0; d < 64; ++d) kk[d] = bf2f(kr[d]);
        float sc = 0.f;
#pragma unroll 1
        for (int hh = 0; hh < 16; ++hh) { float dsum = 0.f;
#pragma unroll
            for (int d = 0; d < 64; ++d) dsum += q[hh * 64 + d] * kk[d];
            sc += w[hh] * fmaxf(dsum, 0.f); }
        SC[(size_t)m * SEQ + s] = sc; }
}
static void launch_mk(const Args& base, int lo, int hi, int grid, hipStream_t stream) {
    Args a = base; a.ph_lo = lo; a.ph_hi = hi;
    hipLaunchKernelGGL(mk_fwd, dim3(grid), dim3(NWAVES * 64), LDS_BYTES, stream, a);
}
extern "C" void kernel_launch(void* const* d_in, const int* in_sizes, int n_in, void* d_out, int out_size, void* d_ws, size_t ws_size, hipStream_t stream) {
    static int grid = 0;
    constexpr int GLA_OUT_LDS = (64 * 128 * 2 + 64 * 64 + 16) * 4;
    if (grid == 0) {
        if (n_in != 20 || out_size != MTOK * DM || ws_size < WS_END) { fprintf(stderr, "kernel_launch: unexpected shapes (n_in %d, out %d, ws %zu < %zu)\n", n_in, out_size, ws_size, (size_t)WS_END); grid = -1; return; }
        int dev = 0, cus = 0;
        if (hipGetDevice(&dev) != hipSuccess || hipDeviceGetAttribute(&cus, hipDeviceAttributeMultiprocessorCount, dev) != hipSuccess) { grid = -1; return; }
        if (hipFuncSetAttribute((const void*)mk_fwd, hipFuncAttributeMaxDynamicSharedMemorySize, LDS_BYTES) != hipSuccess) { fprintf(stderr, "kernel_launch: hipFuncSetAttribute failed\n"); grid = -1; return; }
        if (hipFuncSetAttribute((const void*)k_gla_out, hipFuncAttributeMaxDynamicSharedMemorySize, GLA_OUT_LDS) != hipSuccess) { fprintf(stderr, "kernel_launch: hipFuncSetAttribute(gla) failed\n"); grid = -1; return; }
        (void)hipGetLastError();
        grid = cus;
    }
    if (grid < 0) return;
    (void)in_sizes;
    if (hipMemsetAsync((char*)d_ws + WS_CTL, 0, CTL_ZERO_BYTES, stream) != hipSuccess) return;
    Args a{};
    for (int i = 0; i < 20; ++i) a.in[i] = (const float*)d_in[i];
    a.out = (float*)d_out; a.ws = (unsigned char*)d_ws;
    unsigned char* ws = (unsigned char*)d_ws;
    launch_mk(a, 0, 1, grid, stream);
    launch_mk(a, 1, 2, grid, stream);
    launch_mk(a, 2, 3, grid, stream);
    hipLaunchKernelGGL(k_gla_b, dim3(512), dim3(128), 0, stream, (const float*)(ws + WS_SK0), a.in[2], a.in[3], (float*)(ws + WS_GB), (float*)(ws + WS_DEC));
    hipLaunchKernelGGL(k_gla_state, dim3(512, 128), dim3(256), 0, stream, (const bf16*)(ws + WS_PROJ), (const float*)(ws + WS_GB), (float*)(ws + WS_CST));
    hipLaunchKernelGGL(k_gla_scan, dim3(1024), dim3(256), 0, stream, (const float*)(ws + WS_CST), (const float*)(ws + WS_DEC), (bf16*)(ws + WS_PREVT));
    hipLaunchKernelGGL(k_gla_out, dim3(512), dim3(256), GLA_OUT_LDS, stream, (const bf16*)(ws + WS_PROJ), (const float*)(ws + WS_GB), (const bf16*)(ws + WS_PREVT), a.in[4], (bf16*)(ws + WS_OMIX));
    hipLaunchKernelGGL(k_attn_naive<0>, dim3(SEQ / 64, 8, BATCH), dim3(256), 0, stream, (const bf16*)(ws + WS_PROJ), NP0, 3072, (const bf16*)(ws + WS_PROJ), NP0, 4096, (const bf16*)(ws + WS_PROJ), NP0, 5120, 1,
                       (const float*)(ws + WS_FBIAS), (const unsigned long long*)nullptr, (bf16*)(ws + WS_OMIX), 1024);
    for (int p = 5; p <= 10; ++p) launch_mk(a, p, p + 1, grid, stream);
    launch_mk(a, 11, 12, grid, stream);
    hipLaunchKernelGGL(k_idx_scores, dim3(MTOK), dim3(256), 0, stream, (const bf16*)(ws + WS_PROJ), (const bf16*)(ws + WS_IK), (const float*)(ws + WS_IW), (float*)(ws + WS_SC));
    launch_mk(a, 12, 13, grid, stream);
    hipLaunchKernelGGL(k_attn_naive<1>, dim3(SEQ / 64, 16, BATCH), dim3(256), 0, stream, (const bf16*)(ws + WS_PROJ), NP1, 0, (const bf16*)(ws + WS_PROJ), NP1, 2048, (const bf16*)(ws + WS_PROJ), NP1, 2560, 4,
                       (const float*)nullptr, (const unsigned long long*)(ws + WS_MASK), (bf16*)(ws + WS_OMIX), 0);
    for (int p = 15; p <= 20; ++p) launch_mk(a, p, p + 1, grid, stream);
}
```

```cpp
#include <hip/hip_runtime.h>
#include <cstdio>
#include <cstdint>
namespace pg8 {
#define PG8_LAS __attribute__((address_space(3)))
typedef unsigned short bf16_t;
typedef short bf16x8 __attribute__((ext_vector_type(8)));
typedef float f32x4 __attribute__((ext_vector_type(4)));
typedef unsigned u32x4 __attribute__((ext_vector_type(4)));
constexpr int BM = 256, BK = 64, HALF = 128, HTB = HALF * BK * 2  , STAGE_BYTES = 8 * HTB, NXCD = 8, WGM = 8;

__host__ __device__ __forceinline__ int lds_byte(int r, int c) { const int st = (r >> 4) * 2 + (c >> 5), rr = r & 15, cc = c & 31, ob = rr * 64 + cc * 2; return st * 1024 + (ob ^ (((ob >> 9) & 1) << 5)); }
__host__ __device__ __forceinline__ void stage_rc(int b, int& R, int& C) { const int st = b / 1024, sb = b % 1024, swz = sb ^ (((sb >> 9) & 1) << 5); R = (st >> 1) * 16 + swz / 64; C = (st & 1) * 32 + (swz % 64) / 2; }
__host__ __device__ __forceinline__ int perm32(int rho) { const int n = rho >> 4, i = rho & 15; return 8 * (i >> 2) + 4 * n + (i & 3); }

struct Unit { int pm, pn; };
struct Gemm { const bf16_t* A; const bf16_t* Bt; int M, N, K; };

struct StaticOrder {
    int nM, nN, nwg, G, c;
    __host__ __device__ void init(int M, int N, int G_, int c_) { nM = M / BM; nN = N / BM; nwg = nM * nN; G = G_; c = c_; }
    __host__ __device__ bool next(int i, Unit& u) const {
        const long L = (long)i * G + c; if (L >= nwg) return false;
        int wgid = (int)L; { const int q = nwg / NXCD, r = nwg % NXCD, xcd = wgid % NXCD, off = wgid / NXCD; wgid = (xcd < r ? xcd * (q + 1) : r * (q + 1) + (xcd - r) * q) + off; }
        const int nig = WGM * nN, gid = wgid / nig, fm = gid * WGM, gsz = (nM - fm) < WGM ? (nM - fm) : WGM;
        u.pm = fm + ((wgid % nig) % gsz); u.pn = (wgid % nig) / gsz; return true;
    }
    __device__ __forceinline__ void a_ready(const Unit&) const {}
    __device__ __forceinline__ void done(const Unit&) const {}
};

__device__ __forceinline__ unsigned cvt_pk_bf16(float lo, float hi) { unsigned r; asm volatile("v_cvt_pk_bf16_f32 %0, %1, %2" : "=v"(r) : "v"(lo), "v"(hi)); return r; }
typedef float f32x2 __attribute__((ext_vector_type(2)));
struct EpiBf16Plain {
    static constexpr bool PERM = true, AFTER_DRAIN = false;
    bf16_t* O; int ldc; int pn_mask;
    __device__ __forceinline__ void operator()(const f32x4 (&acc)[2][2][4][2], const Unit& u, int wr, int wc, int fr, int fq) const {
        const int row0 = u.pm * BM + wr * 64 + fr, col0 = (u.pn & pn_mask) * BM + wc * 32 + 8 * fq;
#pragma unroll
        for (int ai = 0; ai < 2; ++ai)
#pragma unroll
            for (int m = 0; m < 4; ++m) { bf16_t* rowp = O + (size_t)(row0 + ai * HALF + m * 16) * ldc + col0;
#pragma unroll
                for (int bj = 0; bj < 2; ++bj) { const f32x4 v0 = acc[ai][bj][m][0], v1 = acc[ai][bj][m][1];
                    u32x4 w; w.x = cvt_pk_bf16(v0[0], v0[1]); w.y = cvt_pk_bf16(v0[2], v0[3]); w.z = cvt_pk_bf16(v1[0], v1[1]); w.w = cvt_pk_bf16(v1[2], v1[3]);
                    *(u32x4*)(rowp + bj * HALF) = w; } }
    }
};
struct EpiResid {
    static constexpr bool PERM = false, AFTER_DRAIN = false;
    const float* base; float* out; float alpha;
    __device__ __forceinline__ void operator()(const f32x4 (&acc)[2][2][4][2], const Unit& u, int wr, int wc, int fr, int fq) const {
        const int row0 = u.pm * BM + wr * 64 + fr, col0 = u.pn * BM + wc * 32 + 4 * fq;
#pragma unroll
        for (int ai = 0; ai < 2; ++ai)
#pragma unroll
            for (int m = 0; m < 4; ++m) { const size_t off = (size_t)(row0 + ai * HALF + m * 16) * 2048 + col0;
#pragma unroll
                for (int bj = 0; bj < 2; ++bj)
#pragma unroll
                    for (int n = 0; n < 2; ++n) { const size_t o = off + bj * HALF + n * 16; const f32x4 b = *(const f32x4*)(base + o); *(f32x4*)(out + o) = b * alpha + acc[ai][bj][m][n]; } }
    }
};
struct EpiGLU {
    static constexpr bool PERM = true, AFTER_DRAIN = false;
    bf16_t* H; const float* roww;
    __device__ __forceinline__ void operator()(const f32x4 (&acc)[2][2][4][2], const Unit& u, int wr, int wc, int fr, int fq) const {
        const int row0 = u.pm * BM + wr * 64 + fr, f0 = (u.pn & 3) * 128 + wc * 32 + 8 * fq;
#pragma unroll
        for (int ai = 0; ai < 2; ++ai)
#pragma unroll
            for (int m = 0; m < 4; ++m) { const int row = row0 + ai * HALF + m * 16; const float w = roww[row];
                float h[8];
#pragma unroll
                for (int n = 0; n < 2; ++n)
#pragma unroll
                    for (int e = 0; e < 4; ++e) { const float g = acc[ai][0][m][n][e], up = acc[ai][1][m][n][e]; h[n * 4 + e] = g * __builtin_amdgcn_rcpf(1.0f + __expf(-g)) * up * w; }
                u32x4 o; o.x = cvt_pk_bf16(h[0], h[1]); o.y = cvt_pk_bf16(h[2], h[3]); o.z = cvt_pk_bf16(h[4], h[5]); o.w = cvt_pk_bf16(h[6], h[7]);
                *(u32x4*)(H + (size_t)row * 512 + f0) = o; }
    }
};
struct EpiRope {
    static constexpr bool PERM = true, AFTER_DRAIN = false;
    bf16_t* O; const float* c128; const float* s128; const float* c64; const float* s64;
    __device__ __forceinline__ void operator()(const f32x4 (&acc)[2][2][4][2], const Unit& u, int wr, int wc, int fr, int fq) const {
        const int row0 = u.pm * BM + wr * 64 + fr, jj = wc * 32 + 8 * fq;
        const int pn = u.pn;
        if (pn == 10 || pn == 11) {
#pragma unroll
            for (int ai = 0; ai < 2; ++ai)
#pragma unroll
                for (int m = 0; m < 4; ++m) { bf16_t* rowp = O + (size_t)(row0 + ai * HALF + m * 16) * 4096 + pn * 256 + jj;
#pragma unroll
                    for (int bj = 0; bj < 2; ++bj) { const f32x4 v0 = acc[ai][bj][m][0], v1 = acc[ai][bj][m][1];
                        u32x4 w; w.x = cvt_pk_bf16(v0[0], v0[1]); w.y = cvt_pk_bf16(v0[2], v0[3]); w.z = cvt_pk_bf16(v1[0], v1[1]); w.w = cvt_pk_bf16(v1[2], v1[3]);
                        *(u32x4*)(rowp + bj * HALF) = w; } }
            return;
        }
        const bool idx = pn >= 12;
        const int half = idx ? 32 : 64;
        const int hl = idx ? (jj >> 5) : (jj >> 6), i0 = jj & (half - 1);
        const int colbase = idx ? (3072 + ((pn - 12) * 4 + hl) * 64) : (pn * 256 + hl * 128);
        const float* ct = idx ? c64 : c128; const float* st = idx ? s64 : s128;
#pragma unroll
        for (int ai = 0; ai < 2; ++ai)
#pragma unroll
            for (int m = 0; m < 4; ++m) { const int row = row0 + ai * HALF + m * 16; const int pos = row & 4095;
                const float* cp = ct + (size_t)pos * half + i0; const float* sp = st + (size_t)pos * half + i0;
                const f32x4 c0 = *(const f32x4*)cp, c1 = *(const f32x4*)(cp + 4), s0 = *(const f32x4*)sp, s1 = *(const f32x4*)(sp + 4);
                const f32x4 a0 = acc[ai][0][m][0], a1 = acc[ai][0][m][1], b0 = acc[ai][1][m][0], b1 = acc[ai][1][m][1];
                const f32x4 x0 = a0 * c0 - b0 * s0, x1 = a1 * c1 - b1 * s1, y0 = b0 * c0 + a0 * s0, y1 = b1 * c1 + a1 * s1;
                bf16_t* rowp = O + (size_t)row * 4096 + colbase + i0;
                u32x4 w; w.x = cvt_pk_bf16(x0[0], x0[1]); w.y = cvt_pk_bf16(x0[2], x0[3]); w.z = cvt_pk_bf16(x1[0], x1[1]); w.w = cvt_pk_bf16(x1[2], x1[3]);
                *(u32x4*)rowp = w;
                u32x4 z; z.x = cvt_pk_bf16(y0[0], y0[1]); z.y = cvt_pk_bf16(y0[2], y0[3]); z.z = cvt_pk_bf16(y1[0], y1[1]); z.w = cvt_pk_bf16(y1[2], y1[3]);
                *(u32x4*)(rowp + half) = z; }
    }
};
struct MoeOrder {
    int G, c, ntn, Tm; const PG8_LAS int* tend;
    __device__ __forceinline__ bool next(int i, Unit& u) const {
        const int L = i * G + c; const int t = L / ntn; if (t >= Tm) return false;
        int e = 0;
#pragma unroll 1
        for (int k = 0; k < 32; ++k) e += (t >= tend[k]) ? 1 : 0;
        u.pm = t; u.pn = e * ntn + (L - t * ntn); return true;
    }
    __device__ __forceinline__ void a_ready(const Unit&) const {}
    __device__ __forceinline__ void done(const Unit&) const {}
};
template <class Epi, class Sched, bool ALIGN_EPI = false, bool SP2 = false>
__device__ __forceinline__ void gemm_phase(PG8_LAS unsigned char* lds, const Gemm g, const Sched& S, const Epi& E) {
    const int tid = threadIdx.x, wid = __builtin_amdgcn_readfirstlane(tid >> 6), lane = tid & 63, wr = wid >> 2, wc = wid & 3, fr = lane & 15, fq = lane >> 4;
    const int K = g.K, nt = K / BK;
    unsigned voffA[2], voffB[2];
#pragma unroll
    for (int i = 0; i < 2; ++i) { int R, C; stage_rc(tid * 16 + i * 8192, R, C); const int Rb = Epi::PERM ? ((R & ~31) + perm32(R & 31)) : R;
        voffA[i] = (unsigned)(R * K + C) * 2u; voffB[i] = (unsigned)(Rb * K + C) * 2u; }
    const size_t kstep = (size_t)(BK * 2);
    const size_t hstep = (size_t)HALF * K * 2;
    const size_t tstep = 2 * hstep;
    const unsigned ldsw = (unsigned)wid * 1024u;
    const int aoff = lds_byte(wr * 64 + fr, fq * 8), boff = lds_byte(wc * 32 + fr, fq * 8);
#define PG8_SA(b, h) (((b) * 2 + (h)) * HTB)
#define PG8_SB(b, h) ((4 + (b) * 2 + (h)) * HTB)
#define PG8_STAGE(bufoff, gbase, voff) do { _Pragma("unroll") for (int _i = 0; _i < 2; ++_i) \
        __builtin_amdgcn_global_load_lds((const unsigned*)((const char*)(gbase) + (voff)[_i]), (PG8_LAS unsigned*)(lds + (bufoff) + ldsw + _i * 8192), 16, 0, 0); } while (0)
#define PG8_LDA(dst, b, h) do { _Pragma("unroll") for (int m = 0; m < 4; ++m) _Pragma("unroll") for (int k = 0; k < 2; ++k) dst[m][k] = *(const PG8_LAS bf16x8*)(lds + PG8_SA(b, h) + aoff + m * 2048 + k * 1024); } while (0)
#define PG8_LDB(dst, b, h) do { _Pragma("unroll") for (int n = 0; n < 2; ++n) _Pragma("unroll") for (int k = 0; k < 2; ++k) dst[n][k] = *(const PG8_LAS bf16x8*)(lds + PG8_SB(b, h) + boff + n * 2048 + k * 1024); } while (0)
#define PG8_MMA(ai, bj, At, Bt) do { __builtin_amdgcn_s_setprio(1); _Pragma("unroll") for (int m = 0; m < 4; ++m) _Pragma("unroll") for (int n = 0; n < 2; ++n) _Pragma("unroll") for (int k = 0; k < 2; ++k) \
        acc[ai][bj][m][n] = __builtin_amdgcn_mfma_f32_16x16x32_bf16(Bt[n][k], At[m][k], acc[ai][bj][m][n], 0, 0, 0); __builtin_amdgcn_s_setprio(0); } while (0)
#define PG8_WAIT_V(n) asm volatile("s_waitcnt vmcnt(" #n ")" ::: "memory")
#define PG8_WAIT_L(n) asm volatile("s_waitcnt lgkmcnt(" #n ")" ::: "memory")
#define PG8_BAR __builtin_amdgcn_s_barrier()
#define PG8_SCHED __builtin_amdgcn_sched_barrier(0)
    Unit cur, nxt; int ui = 0;
    if (!S.next(0, cur)) return;
    f32x4 acc[2][2][4][2];
#pragma unroll
    for (int a = 0; a < 2; ++a)
#pragma unroll
        for (int b = 0; b < 2; ++b)
#pragma unroll
            for (int m = 0; m < 4; ++m)
#pragma unroll
                for (int n = 0; n < 2; ++n) acc[a][b][m][n] = (f32x4){0.f, 0.f, 0.f, 0.f};
    bf16x8 At[4][2], B0[2][2], B1[2][2];
    const char* cA = (const char*)g.A + (size_t)cur.pm * tstep; const char* cB = (const char*)g.Bt + (size_t)cur.pn * tstep;
    S.a_ready(cur);
    if constexpr (SP2) {
        PG8_STAGE(PG8_SB(0, 0), cB, voffB); PG8_STAGE(PG8_SB(0, 1), cB + hstep, voffB); PG8_STAGE(PG8_SA(0, 0), cA, voffA); PG8_STAGE(PG8_SA(0, 1), cA + hstep, voffA);
        if (wr == 1) PG8_BAR;
        PG8_WAIT_V(2); PG8_BAR;
        PG8_STAGE(PG8_SB(1, 0), cB + kstep, voffB); PG8_STAGE(PG8_SA(1, 0), cA + kstep, voffA); PG8_STAGE(PG8_SB(1, 1), cB + hstep + kstep, voffB);
        PG8_WAIT_V(6); PG8_BAR;
    } else {
        PG8_STAGE(PG8_SB(0, 0), cB, voffB); PG8_STAGE(PG8_SA(0, 0), cA, voffA); PG8_STAGE(PG8_SB(0, 1), cB + hstep, voffB); PG8_STAGE(PG8_SA(0, 1), cA + hstep, voffA);
        if (wr == 1) PG8_BAR;
        PG8_WAIT_V(4); PG8_BAR;
        PG8_STAGE(PG8_SB(1, 0), cB + kstep, voffB); PG8_STAGE(PG8_SA(1, 0), cA + kstep, voffA); PG8_STAGE(PG8_SB(1, 1), cB + hstep + kstep, voffB);
        PG8_WAIT_V(6); PG8_BAR;
    }
    for (;;) {
        const bool has_next = S.next(ui + 1, nxt);
        const char* nA = has_next ? (const char*)g.A + (size_t)nxt.pm * tstep : cA; const char* nB = has_next ? (const char*)g.Bt + (size_t)nxt.pn * tstep : cB;
        for (int t = 0; t < nt; t += 2) {
            const bool last = (t == nt - 2);
            const char* a1 = cA + (size_t)(t + 1) * kstep;
            const char* a2 = last ? nA : cA + (size_t)(t + 2) * kstep; const char* b2 = last ? nB : cB + (size_t)(t + 2) * kstep;
            const char* a3 = a2 + kstep; const char* b3 = b2 + kstep;
            if (last && has_next) S.a_ready(nxt);
            if constexpr (SP2) {
            PG8_LDB(B0, 0, 0); PG8_LDB(B1, 0, 1); PG8_SCHED; PG8_LDA(At, 0, 0); PG8_STAGE(PG8_SA(1, 1), a1 + hstep, voffA);
            PG8_WAIT_V(8); PG8_WAIT_L(0); PG8_BAR; PG8_MMA(0, 0, At, B0); PG8_MMA(0, 1, At, B1); PG8_BAR; PG8_SCHED;
            PG8_LDA(At, 0, 1); PG8_STAGE(PG8_SB(0, 0), b2, voffB); PG8_STAGE(PG8_SB(0, 1), b2 + hstep, voffB); PG8_STAGE(PG8_SA(0, 0), a2, voffA);
            PG8_WAIT_V(8); PG8_WAIT_L(0); PG8_BAR; PG8_MMA(1, 0, At, B0); PG8_MMA(1, 1, At, B1); PG8_BAR; PG8_SCHED;
            PG8_LDB(B0, 1, 0); PG8_LDB(B1, 1, 1); PG8_SCHED; PG8_LDA(At, 1, 0); PG8_STAGE(PG8_SA(0, 1), a2 + hstep, voffA);
            PG8_WAIT_V(8); PG8_WAIT_L(0); PG8_BAR; PG8_MMA(0, 0, At, B0); PG8_MMA(0, 1, At, B1); PG8_BAR; PG8_SCHED;
            PG8_LDA(At, 1, 1); PG8_STAGE(PG8_SB(1, 0), b3, voffB); PG8_STAGE(PG8_SB(1, 1), b3 + hstep, voffB); PG8_STAGE(PG8_SA(1, 0), a3, voffA);
            PG8_WAIT_V(8); PG8_WAIT_L(0); PG8_BAR; PG8_MMA(1, 0, At, B0); PG8_MMA(1, 1, At, B1); PG8_BAR; PG8_SCHED;
            } else {
            PG8_LDB(B0, 0, 0); PG8_SCHED; PG8_LDA(At, 0, 0); PG8_STAGE(PG8_SA(1, 1), a1 + hstep, voffA);
            PG8_WAIT_L(8); PG8_BAR; PG8_WAIT_L(0); PG8_MMA(0, 0, At, B0); PG8_BAR; PG8_SCHED;
            PG8_LDB(B1, 0, 1); PG8_STAGE(PG8_SB(0, 0), b2, voffB);
            PG8_BAR; PG8_WAIT_L(0); PG8_MMA(0, 1, At, B1); PG8_BAR;
            PG8_LDA(At, 0, 1); PG8_STAGE(PG8_SA(0, 0), a2, voffA);
            PG8_BAR; PG8_WAIT_L(0); PG8_MMA(1, 0, At, B0); PG8_BAR; PG8_SCHED;
            PG8_STAGE(PG8_SB(0, 1), b2 + hstep, voffB);
            PG8_WAIT_V(6); PG8_BAR; PG8_MMA(1, 1, At, B1); PG8_BAR;
            PG8_LDB(B0, 1, 0); PG8_SCHED; PG8_LDA(At, 1, 0); PG8_STAGE(PG8_SA(0, 1), a2 + hstep, voffA);
            PG8_WAIT_L(8); PG8_BAR; PG8_WAIT_L(0); PG8_MMA(0, 0, At, B0); PG8_BAR; PG8_SCHED;
            PG8_LDB(B1, 1, 1); PG8_STAGE(PG8_SB(1, 0), b3, voffB);
            PG8_BAR; PG8_WAIT_L(0); PG8_MMA(0, 1, At, B1); PG8_BAR;
            PG8_LDA(At, 1, 1); PG8_STAGE(PG8_SA(1, 0), a3, voffA);
            PG8_BAR; PG8_WAIT_L(0); PG8_MMA(1, 0, At, B0); PG8_BAR; PG8_SCHED;
            PG8_STAGE(PG8_SB(1, 1), b3 + hstep, voffB);
            PG8_WAIT_V(6); PG8_BAR; PG8_MMA(1, 1, At, B1); PG8_BAR;
            }
        }
        if constexpr (ALIGN_EPI) { if (wr == 0) PG8_BAR; }
        if constexpr (!Epi::AFTER_DRAIN) { E(acc, cur, wr, wc, fr, fq); S.done(cur); }
        if (!has_next) break;
#pragma unroll
        for (int a = 0; a < 2; ++a)
#pragma unroll
            for (int b = 0; b < 2; ++b)
#pragma unroll
                for (int m = 0; m < 4; ++m)
#pragma unroll
                    for (int n = 0; n < 2; ++n) acc[a][b][m][n] = (f32x4){0.f, 0.f, 0.f, 0.f};
        cur = nxt; cA = nA; cB = nB; ++ui;
        if constexpr (ALIGN_EPI) { if (wr == 1) PG8_BAR; }
    }
    PG8_WAIT_V(0);
    if constexpr (!ALIGN_EPI) { if (wr == 0) PG8_BAR; }
    PG8_BAR;
    if constexpr (Epi::AFTER_DRAIN) { E.fused(acc, cur, wr, wc, fr, fq, lds, wid, lane); S.done(cur); }
#undef PG8_SA
#undef PG8_SB
#undef PG8_STAGE
#undef PG8_LDA
#undef PG8_LDB
#undef PG8_MMA
#undef PG8_WAIT_V
#undef PG8_WAIT_L
#undef PG8_BAR
#undef PG8_SCHED
}
}
constexpr int BATCH = 2, SEQ = 4096, DM = 2048, MTOK = BATCH * SEQ;
constexpr int NE0 = 6168, NE1 = 4176;
constexpr int NP0 = 6144, NP1 = 4096;
constexpr float LN_EPS = 1e-5f;
constexpr float DN_ALPHA = 1.41421356237309515f;
constexpr float ATT_SCALE = 0.08838834764831845f;
constexpr int RPAD = 24576;
constexpr size_t MiB = 1u << 20;
constexpr size_t WS_CTL = 0, CTL_ZERO_BYTES = 1 * MiB;
constexpr size_t WS_ROPE = 1 * MiB;
constexpr size_t WS_WSM = 4 * MiB;
constexpr size_t WS_SK0 = 6 * MiB;
constexpr size_t WS_IK = 7 * MiB;
constexpr size_t WS_IW = 8 * MiB + 512 * 1024;
constexpr size_t WS_FBIAS = 10 * MiB;
constexpr size_t WS_ROUTE = 11 * MiB;
constexpr size_t WS_MASK = 12 * MiB;
constexpr size_t WS_WINA = 16 * MiB, WS_WOA = 40 * MiB, WS_WINC = 48 * MiB, WS_WOC = 64 * MiB;
constexpr size_t WS_WGU = 72 * MiB;
constexpr size_t WS_WD = 328 * MiB;
constexpr size_t WS_XB = 456 * MiB;
constexpr size_t WS_XR = 488 * MiB;
constexpr size_t WS_PROJ = 552 * MiB;
constexpr size_t WS_CST = 648 * MiB;
constexpr size_t WS_PREVT = 712 * MiB;
constexpr size_t WS_OMIX = 744 * MiB;
constexpr size_t WS_GB = 776 * MiB;
constexpr size_t WS_DEC = 792 * MiB;
constexpr size_t WS_ROWW = 793 * MiB;
constexpr size_t WS_SC = 800 * MiB;
constexpr size_t WS_END = 928 * MiB;
constexpr int CW_CNT = 1024;
constexpr int CW_BAR = 4096;

#define GAS __attribute__((address_space(1)))
#define LAS __attribute__((address_space(3)))
typedef unsigned short bf16;
typedef unsigned v4u __attribute__((ext_vector_type(4)));
typedef float f32x4 __attribute__((ext_vector_type(4)));
typedef short bf16x8 __attribute__((ext_vector_type(8)));
#define LDS_WAIT() asm volatile("s_waitcnt lgkmcnt(0)" ::: "memory")
#define VM_WAIT() asm volatile("s_waitcnt vmcnt(0)" ::: "memory")
__device__ __forceinline__ unsigned f2bf(float f) { unsigned u = __builtin_bit_cast(unsigned, f); return (u + 0x7fffu + ((u >> 16) & 1u)) >> 16; }
__device__ __forceinline__ unsigned pk2(float lo, float hi) { return f2bf(lo) | (f2bf(hi) << 16); }
__device__ __forceinline__ float bf2f(unsigned short b) { return __builtin_bit_cast(float, ((unsigned)b) << 16); }
__device__ __forceinline__ float wave_sum(float v) {
#pragma unroll
    for (int o = 1; o < 64; o <<= 1) v += __shfl_xor(v, o);
    return v;
}
__device__ __forceinline__ float logsigmoidf(float z) { return fminf(z, 0.f) - log1pf(__expf(-fabsf(z))); }
#define XB_TMO      128
#define XB_XCNT(j)  (256  + 64 * (j))
#define XB_XSUB(j)  (1280 + 64 * (j))
#define XB_XGEN(j)  (2304 + 64 * (j))
#define XB_TOP      3328
#define XB_TOPGEN   3392
#define XCD_BAR_WORDS 3456
#define XB_SPIN_CAP (1u << 21)

__device__ __forceinline__ unsigned xb_ld(unsigned* p)              { return __hip_atomic_load(p, __ATOMIC_RELAXED, __HIP_MEMORY_SCOPE_AGENT); }
__device__ __forceinline__ unsigned xb_add(unsigned* p, unsigned v) { return __hip_atomic_fetch_add(p, v, __ATOMIC_RELAXED, __HIP_MEMORY_SCOPE_AGENT); }
__device__ __forceinline__ unsigned xb_xcc_id() { return (unsigned)__builtin_amdgcn_s_getreg((3 << 11) | 20) & 0xFu; }
#define XB_SPIN(cond, bar) do { unsigned _sp = 0; while (cond) { __builtin_amdgcn_s_sleep(1); \
    if ((++_sp & 255u) == 0u) { if (xb_ld(&(bar)[XB_TMO])) break; if (_sp > XB_SPIN_CAP) { atomicAdd(&(bar)[XB_TMO], 1u); break; } } } } while (0)

struct XcdBarrier {
    unsigned* bar; unsigned x;
    volatile LAS unsigned* st;
};

__device__ __forceinline__ XcdBarrier xcd_barrier_post(unsigned* bar, volatile LAS unsigned* st) {
    XcdBarrier b; b.bar = bar; b.x = xb_xcc_id(); b.st = st;
    if (threadIdx.x == 0) (void)xb_add(&bar[XB_XCNT(b.x)], 1u);
    return b;
}
__device__ __forceinline__ void xcd_barrier_complete(unsigned* bar, unsigned x, unsigned& nloc, unsigned& nx) {
    const unsigned G = gridDim.x * gridDim.y * gridDim.z;
    unsigned sum, cnt, mine, sp = 0u;
    for (;;) {
        sum = 0u; cnt = 0u; mine = 0u;
#pragma unroll
        for (unsigned j = 0; j < 16; ++j) { const unsigned c = xb_ld(&bar[XB_XCNT(j)]); sum += c; cnt += (c > 0u) ? 1u : 0u; mine = (j == x) ? c : mine; }
        if (sum == G) break;
        __builtin_amdgcn_s_sleep(1);
        if ((++sp & 255u) == 0u) { if (xb_ld(&bar[XB_TMO])) break; if (sp > XB_SPIN_CAP) { atomicAdd(&bar[XB_TMO], 1u); break; } }
    }
    nloc = mine > 0u ? mine : 1u; nx = cnt > 0u ? cnt : 1u;
}

__device__ __forceinline__ void xcd_barrier(const XcdBarrier& b) {
    asm volatile("s_waitcnt vmcnt(0)" ::: "memory");
    __syncthreads();
    if (threadIdx.x == 0) {
        unsigned* bar = b.bar;
        __builtin_amdgcn_s_waitcnt(0);
        unsigned nloc = b.st[0], nx = b.st[1];
        if (nloc == 0u) { xcd_barrier_complete(bar, b.x, nloc, nx); b.st[0] = nloc; b.st[1] = nx; }
        const unsigned old = xb_add(&bar[XB_XSUB(b.x)], 1u);
        const unsigned gen = old / nloc;
        if (old + 1u == (gen + 1u) * nloc) {
            __builtin_amdgcn_fence(__ATOMIC_RELEASE, "agent");
            asm volatile("s_waitcnt vmcnt(0)" ::: "memory");
            const unsigned og = xb_add(&bar[XB_TOP], 1u);
            const unsigned tg = og / nx;
            if (og + 1u == (tg + 1u) * nx) xb_add(&bar[XB_TOPGEN], 1u);
            else XB_SPIN(xb_ld(&bar[XB_TOPGEN]) == tg, bar);
            __builtin_amdgcn_fence(__ATOMIC_ACQUIRE, "agent");
            xb_add(&bar[XB_XGEN(b.x)], 1u);
            asm volatile("s_waitcnt vmcnt(0)" ::: "memory");
        } else {
            XB_SPIN(xb_ld(&bar[XB_XGEN(b.x)]) == gen, bar);
            __builtin_amdgcn_fence(__ATOMIC_ACQUIRE, "agent");
            asm volatile("s_waitcnt vmcnt(0)" ::: "memory");
        }
    }
    __syncthreads();
}

constexpr int NWAVES = 8;
constexpr int RING_BYTES = 131072;
constexpr int LDSCTL_OFF = RING_BYTES;
constexpr int LDS_BYTES = 147456;
struct Frame {
    LAS unsigned char* lds; volatile LAS unsigned* MISC; unsigned* ctl;
    int tid, lane, wave, G, gw, NGW;
    unsigned char* ws;
};
struct Args { const float* in[20]; float* out; unsigned char* ws; int ph_lo, ph_hi; };

__device__ __forceinline__ void transpose_item(const float* W, int ldw, int c0, int K, bf16* WT, int n0, int k0, LAS float* scr, int lane) {
#pragma unroll 8
    for (int i = 0; i < 32; ++i) { const int kk = 2 * i + (lane >> 5); scr[kk * 33 + (lane & 31)] = W[(size_t)(k0 + kk) * ldw + c0 + (lane & 31)]; }
    LDS_WAIT(); asm volatile("" ::: "memory");
    const int c = lane & 7;
#pragma unroll
    for (int j = 0; j < 4; ++j) { const int n = (lane >> 3) + 8 * j; const LAS float* s = scr + (8 * c) * 33 + n;
        v4u o; o.x = pk2(s[0 * 33], s[1 * 33]); o.y = pk2(s[2 * 33], s[3 * 33]); o.z = pk2(s[4 * 33], s[5 * 33]); o.w = pk2(s[6 * 33], s[7 * 33]);
        *(v4u*)(WT + (size_t)(n0 + n) * K + k0 + 8 * c) = o; }
    LDS_WAIT(); asm volatile("" ::: "memory");
}
__device__ __forceinline__ int l1_src_col(int n) {
    const int pn = n >> 8, j = n & 255, jh = j & 127, second = j >> 7;
    if (pn == 10 || pn == 11) return n;
    if (pn < 10) return pn * 256 + (jh >> 6) * 128 + second * 64 + (jh & 63);
    return 3072 + ((pn - 12) * 4 + (jh >> 5)) * 64 + second * 32 + (jh & 31);
}
template <int NJ> __device__ __forceinline__ float row_dots(LAS float* scr, const f32x4 (&xv)[8], const float* W, int ld, int lane) {
#pragma unroll
    for (int j = 0; j < 8; ++j) *(LAS f32x4*)(scr + 256 * j + 4 * lane) = xv[j];
    LDS_WAIT(); asm volatile("" ::: "memory");
    float acc[NJ];
#pragma unroll
    for (int jj = 0; jj < NJ; ++jj) acc[jj] = 0.f;
#pragma unroll 2
    for (int c = 0; c < 32; ++c) { const int k = c * 64 + lane; const float xs = scr[k]; const float* wr = W + (size_t)k * ld;
#pragma unroll
        for (int q4 = 0; q4 < NJ / 4; ++q4) { const f32x4 w = *(const f32x4*)(wr + 4 * q4);
            acc[4 * q4 + 0] += xs * w[0]; acc[4 * q4 + 1] += xs * w[1]; acc[4 * q4 + 2] += xs * w[2]; acc[4 * q4 + 3] += xs * w[3]; } }
    LDS_WAIT(); asm volatile("" ::: "memory");
#pragma unroll
    for (int jj = 0; jj < NJ; ++jj) scr[jj * 65 + lane] = acc[jj];
    LDS_WAIT(); asm volatile("" ::: "memory");
    float s = 0.f;
    if (lane < NJ) {
#pragma unroll 8
        for (int l = 0; l < 64; ++l) s += scr[lane * 65 + l]; }
    LDS_WAIT(); asm volatile("" ::: "memory");
    return s;
}
__device__ __forceinline__ void ln_row(f32x4 (&v)[8], const float* g, const float* b, int lane) {
    float s = 0.f;
#pragma unroll
    for (int j = 0; j < 8; ++j) s += (v[j][0] + v[j][1]) + (v[j][2] + v[j][3]);
    const float mean = wave_sum(s) * (1.f / DM); float s2 = 0.f;
#pragma unroll
    for (int j = 0; j < 8; ++j) { v[j] = v[j] - mean; s2 += (v[j][0] * v[j][0] + v[j][1] * v[j][1]) + (v[j][2] * v[j][2] + v[j][3] * v[j][3]); }
    const float rstd = 1.f / sqrtf(wave_sum(s2) * (1.f / DM) + LN_EPS);
#pragma unroll
    for (int j = 0; j < 8; ++j) { const f32x4 gg = *(const f32x4*)(g + 256 * j + 4 * lane), bb = *(const f32x4*)(b + 256 * j + 4 * lane); v[j] = v[j] * rstd * gg + bb; }
}
__device__ __forceinline__ void store_row_bf16(bf16* dst, const f32x4 (&v)[8], int lane) {
#pragma unroll
    for (int j = 0; j < 8; ++j) { uint2 o; o.x = pk2(v[j][0], v[j][1]); o.y = pk2(v[j][2], v[j][3]); *(uint2*)(dst + 256 * j + 4 * lane) = o; }
}
__device__ __forceinline__ void topk_mask_row(const float* sc, int qpos, unsigned long long* mrow, int lane) {
    unsigned u[64];
#pragma unroll
    for (int i = 0; i < 64; ++i) { const int s = 64 * i + lane; const bool ok = s <= qpos; const float f = ok ? sc[s] : 0.f; const unsigned b = __builtin_bit_cast(unsigned, f);
        const unsigned key = b ^ ((b >> 31) ? 0xFFFFFFFFu : 0x80000000u); u[i] = ok ? key : 0u; }
    if (qpos + 1 <= 256) {
#pragma unroll
        for (int i = 0; i < 64; ++i) { const unsigned long long w = __ballot(64 * i + lane <= qpos); if (lane == 0) mrow[i] = w; }
        return;
    }
    unsigned T = 0u;
#pragma unroll 1
    for (int bit = 31; bit >= 0; --bit) { const unsigned cand = T | (1u << bit); int cnt = 0;
#pragma unroll
        for (int i = 0; i < 64; ++i) cnt += __builtin_popcountll(__ballot(u[i] >= cand));
        if (cnt >= 256) T = cand; }
    int cgt = 0;
#pragma unroll
    for (int i = 0; i < 64; ++i) cgt += __builtin_popcountll(__ballot(u[i] > T));
    const int need = 256 - cgt; int run = 0; const unsigned long long below = (1ull << lane) - 1ull;
#pragma unroll
    for (int i = 0; i < 64; ++i) { const bool gt = u[i] > T, eq = u[i] == T; const unsigned long long eqm = __ballot(eq);
        const int rank = run + __builtin_popcountll(eqm & below); const bool sel = gt || (eq && rank < need); run += __builtin_popcountll(eqm);
        const unsigned long long w = __ballot(sel); if (lane == 0) mrow[i] = w; }
}

__device__ __forceinline__ void p0_prologue(Frame& F, const Args& a) {
    LAS float* scr = (LAS float*)(F.lds + F.wave * 16384);
    const int gw = F.gw, NGW = F.NGW, lane = F.lane;
    unsigned char* ws = F.ws;
    {
        const float* W = a.in[1]; bf16* WT = (bf16*)(ws + WS_WINA);
        for (int it = gw; it < (2048 / 64) * (NP0 / 32); it += NGW) { const int kb = it / (NP0 / 32), nb = it % (NP0 / 32), n0 = nb * 32; transpose_item(W, NE0, n0 < 3072 ? n0 : n0 + 16, 2048, WT, n0, kb * 64, scr, lane); }
    }
    {
        for (int it = gw; it < 2 * 32 * 64; it += NGW) { const int w = it / (32 * 64), r = it % (32 * 64), kb = r / 64, nb = r % 64;
            transpose_item(w ? a.in[8] : a.in[6], 2048, nb * 32, 2048, (bf16*)(ws + (w ? WS_WOC : WS_WOA)), nb * 32, kb * 64, scr, lane); }
    }
    {
        const float* W = a.in[7]; bf16* WT = (bf16*)(ws + WS_WINC);
        for (int it = gw; it < 32 * (NP1 / 32); it += NGW) { const int kb = it / (NP1 / 32), nb = it % (NP1 / 32), n0 = nb * 32; transpose_item(W, NE1, l1_src_col(n0), 2048, WT, n0, kb * 64, scr, lane); }
    }
    {
        const int per = 32 * 32;
        for (int it = gw; it < 64 * per; it += NGW) { const int ex = it / per, r = it % per, kb = r / 32, nb = r % 32, n0 = nb * 32, tile = n0 >> 8, j = n0 & 255;
            const float* W = (j < 128 ? a.in[17] : a.in[18]) + (size_t)ex * 2048 * 512;
            transpose_item(W, 512, 128 * tile + (j & 127), 2048, (bf16*)(ws + WS_WGU) + (size_t)ex * 1024 * 2048, n0, kb * 64, scr, lane); }
    }
    {
        const int per = 8 * 64;
        for (int it = gw; it < 64 * per; it += NGW) { const int ex = it / per, r = it % per, kb = r / 64, nb = r % 64;
            transpose_item(a.in[19] + (size_t)ex * 512 * 2048, 2048, nb * 32, 512, (bf16*)(ws + WS_WD) + (size_t)ex * 2048 * 512, nb * 32, kb * 64, scr, lane); }
    }
    const int gt = blockIdx.x * (NWAVES * 64) + F.tid, NGT = F.G * NWAVES * 64;
    {   float* c128 = (float*)(ws + WS_ROPE); float* s128 = c128 + 4096 * 64; float* c64 = s128 + 4096 * 64; float* s64 = c64 + 4096 * 32;
        for (int i = gt; i < 4096 * 96; i += NGT) { int pos, idx, half; float* cp; float* sp;
            if (i < 4096 * 64) { pos = i >> 6; idx = i & 63; half = 64; cp = c128 + i; sp = s128 + i; } else { const int r = i - 4096 * 64; pos = r >> 5; idx = r & 31; half = 32; cp = c64 + r; sp = s64 + r; }
            const float inv = exp2f(-(float)idx / (float)half * 13.287712379549449f);
            const float ang = (float)pos * inv;
            double rv = (double)ang * 0.15915494309189535; rv -= rint(rv);
            const float rf = (float)rv;
            *cp = __builtin_amdgcn_cosf(rf); *sp = __builtin_amdgcn_sinf(rf); }
    }
    {   float* RT = (float*)(ws + WS_WSM);
        for (int i = gt; i < 2 * 2048 * 40; i += NGT) { const int l = i / (2048 * 40), r = i % (2048 * 40), k = r / 40, c = r % 40; float v = 0.f;
            if (c < 4) v = a.in[13][((size_t)l * 2048 + k) * 4 + c]; else if (c < 36) { const int g = (c - 4) >> 3, e = (c - 4) & 7; v = a.in[15][(((size_t)l * 4 + g) * 2048 + k) * 8 + e]; }
            RT[i] = v; }
        float* SKW1 = RT + 2 * 2048 * 40;
        for (int i = gt; i < 2048 * 80; i += NGT) { const int k = i / 80, c = i % 80; SKW1[i] = a.in[7][(size_t)k * NE1 + 4096 + c]; }
    }
    {   const float* x = a.in[0]; bf16* XB = (bf16*)(ws + WS_XB); float* SK0 = (float*)(ws + WS_SK0); const float* W = a.in[1];
        for (int m = gw; m < MTOK; m += NGW) { f32x4 v[8];
#pragma unroll
            for (int j = 0; j < 8; ++j) v[j] = *(const f32x4*)(x + (size_t)m * DM + 256 * j + 4 * lane);
            store_row_bf16(XB + (size_t)m * DM, v, lane);
            const float m16 = row_dots<16>(scr, v, W + 3072, NE0, lane); const float m8 = row_dots<8>(scr, v, W + 6160, NE0, lane);
            const float m8s = __shfl(m8, (lane - 16) & 63); if (lane < 16) SK0[(size_t)m * 24 + lane] = m16; else if (lane < 24) SK0[(size_t)m * 24 + lane] = m8s; }
    }
}
__device__ __forceinline__ void p_fox_bias(Frame& F, const Args& a) {
    if (F.gw >= 16) return;
    const int bh = F.gw, b = bh >> 3, h = bh & 7, lane = F.lane; const float gb = a.in[5][h];
    const float* SK0 = (const float*)(F.ws + WS_SK0); float* FB = (float*)(F.ws + WS_FBIAS) + (size_t)bh * SEQ;
    float tot = 0.f;
    for (int i = 0; i < 64; ++i) { const int s = lane * 64 + i; tot += logsigmoidf(SK0[(size_t)(b * SEQ + s) * 24 + 16 + h] + gb); }
    float incl = tot;
#pragma unroll
    for (int o = 1; o < 64; o <<= 1) { const float t = __shfl_up(incl, o); if (lane >= o) incl += t; }
    float run = incl - tot;
    for (int i = 0; i < 64; ++i) { const int s = lane * 64 + i; run += logsigmoidf(SK0[(size_t)(b * SEQ + s) * 24 + 16 + h] + gb); FB[s] = -run * (1.0f / ATT_SCALE); }
}
__device__ __forceinline__ void p_ln_route(Frame& F, const Args& a, int layer) {
    float* XR = (float*)(F.ws + WS_XR); bf16* XB = (bf16*)(F.ws + WS_XB); const int lane = F.lane;
    const float* g = a.in[9] + layer * DM; const float* bb = a.in[10] + layer * DM;
    const float* RT = (const float*)(F.ws + WS_WSM) + (size_t)layer * 2048 * 40;
    const float* bg = a.in[14] + layer * 4; const float* be = a.in[16] + layer * 32;
    int4* ROUTE = (int4*)(F.ws + WS_ROUTE); unsigned* cnt = F.ctl + CW_CNT + layer * 64;
    for (int m = F.gw; m < MTOK; m += F.NGW) { f32x4 v[8];
#pragma unroll
        for (int j = 0; j < 8; ++j) v[j] = *(const f32x4*)(XR + (size_t)m * DM + 256 * j + 4 * lane);
        ln_row(v, g, bb, lane);
#pragma unroll
        for (int j = 0; j < 8; ++j) *(f32x4*)(XR + (size_t)m * DM + 256 * j + 4 * lane) = v[j];
        store_row_bf16(XB + (size_t)m * DM, v, lane);
        const float mine = row_dots<36>((LAS float*)(F.lds + F.wave * 16384), v, RT, 40, lane);
        float gl[4];
#pragma unroll
        for (int i = 0; i < 4; ++i) gl[i] = __shfl(mine, i) + bg[i];
        int gi = 0; float gm = gl[0];
#pragma unroll
        for (int i = 1; i < 4; ++i) if (gl[i] > gm) { gm = gl[i]; gi = i; }
        float gs = 0.f;
#pragma unroll
        for (int i = 0; i < 4; ++i) gs += __expf(gl[i] - gm);
        const float gp = 1.0f / gs;
        float el[8];
#pragma unroll
        for (int e = 0; e < 8; ++e) el[e] = __shfl(mine, 4 + 8 * gi + e) + be[gi * 8 + e];
        int e1 = 0; float v1 = el[0];
#pragma unroll
        for (int e = 1; e < 8; ++e) if (el[e] > v1) { v1 = el[e]; e1 = e; }
        int e2 = -1; float v2 = -3.0e38f;
#pragma unroll
        for (int e = 0; e < 8; ++e) if (e != e1 && el[e] > v2) { v2 = el[e]; e2 = e; }
        const float w1 = gp / (1.0f + __expf(v2 - v1)), w2 = gp - w1;
        if (lane == 0) { const int ge1 = gi * 8 + e1, ge2 = gi * 8 + e2;
            const int p1 = (int)atomicAdd(cnt + ge1, 1u), p2 = (int)atomicAdd(cnt + ge2, 1u);
            ROUTE[(size_t)m * 2 + 0] = make_int4(ge1, p1, __builtin_bit_cast(int, w1), 0);
            ROUTE[(size_t)m * 2 + 1] = make_int4(ge2, p2, __builtin_bit_cast(int, w2), 0); }
    }
}
__device__ __forceinline__ int moe_offsets(const unsigned* cnt, int lane, int* tiles_incl) {
    const int c = lane < 32 ? (int)cnt[lane] : 0; const int t = (c + 255) >> 8; int incl = t;
#pragma unroll
    for (int o = 1; o < 32; o <<= 1) { const int x = __shfl_up(incl, o); if ((lane & 31) >= o) incl += x; }
    *tiles_incl = incl; return (incl - t) * 256;
}
__device__ __forceinline__ void p_gather(Frame& F, int layer) {
    const int lane = F.lane; const unsigned* cnt = F.ctl + CW_CNT + layer * 64; int ti; const int off = moe_offsets(cnt, lane, &ti);
    const bf16* XB = (const bf16*)(F.ws + WS_XB); bf16* XG = (bf16*)(F.ws + WS_PROJ); float* ROWW = (float*)(F.ws + WS_ROWW); int4* ROUTE = (int4*)(F.ws + WS_ROUTE);
    for (int m = F.gw; m < MTOK; m += F.NGW) {
#pragma unroll
        for (int s = 0; s < 2; ++s) { int4 r = ROUTE[(size_t)m * 2 + s]; const int dst = __shfl(off, r.x) + r.y;
            const v4u* src = (const v4u*)(XB + (size_t)m * DM); v4u* d = (v4u*)(XG + (size_t)dst * DM);
#pragma unroll
            for (int j = 0; j < 4; ++j) d[64 * j + lane] = src[64 * j + lane];
            if (lane == 0) { ROWW[dst] = __builtin_bit_cast(float, r.z); r.w = dst; ROUTE[(size_t)m * 2 + s] = r; } }
    }
}
__device__ __forceinline__ void p_ln_ffn(Frame& F, const Args& a, int layer) {
    float* XR = (float*)(F.ws + WS_XR); bf16* XB = (bf16*)(F.ws + WS_XB); const int lane = F.lane; const bf16* YG = (const bf16*)(F.ws + WS_CST);
    const float* g = a.in[11] + layer * DM; const float* bb = a.in[12] + layer * DM; const int4* ROUTE = (const int4*)(F.ws + WS_ROUTE);
    float* dst = layer == 1 ? a.out : XR;
    const float* SKW1 = (const float*)(F.ws + WS_WSM) + 2 * 2048 * 40;
    const float* c64 = (const float*)(F.ws + WS_ROPE) + 2 * 4096 * 64; const float* s64 = c64 + 4096 * 32;
    bf16* IK = (bf16*)(F.ws + WS_IK); float* IW = (float*)(F.ws + WS_IW);
    for (int m = F.gw; m < MTOK; m += F.NGW) { f32x4 v[8];
        const int r0 = ROUTE[(size_t)m * 2].w, r1 = ROUTE[(size_t)m * 2 + 1].w;
#pragma unroll
        for (int j = 0; j < 8; ++j) { v[j] = *(const f32x4*)(XR + (size_t)m * DM + 256 * j + 4 * lane) * DN_ALPHA;
            const uint2 y0 = *(const uint2*)(YG + (size_t)r0 * DM + 256 * j + 4 * lane), y1 = *(const uint2*)(YG + (size_t)r1 * DM + 256 * j + 4 * lane);
            v[j][0] += bf2f(y0.x & 0xffff) + bf2f(y1.x & 0xffff); v[j][1] += bf2f(y0.x >> 16) + bf2f(y1.x >> 16);
            v[j][2] += bf2f(y0.y & 0xffff) + bf2f(y1.y & 0xffff); v[j][3] += bf2f(y0.y >> 16) + bf2f(y1.y >> 16); }
        ln_row(v, g, bb, lane);
#pragma unroll
        for (int j = 0; j < 8; ++j) *(f32x4*)(dst + (size_t)m * DM + 256 * j + 4 * lane) = v[j];
        if (layer == 0) {
            store_row_bf16(XB + (size_t)m * DM, v, lane);
            LAS float* scr = (LAS float*)(F.lds + F.wave * 16384); const float mA = row_dots<40>(scr, v, SKW1, 80, lane), mB = row_dots<40>(scr, v, SKW1 + 40, 80, lane);
            const float mBs = __shfl(mB, (lane - 40) & 63); const float mine = lane < 40 ? mA : mBs;
            const float wv = __shfl(mB, (lane + 24) & 63);
            const float part = __shfl(mine, lane ^ 32);
            const int pos = m & 4095, i = lane & 31; const float c = c64[pos * 32 + i], s = s64[pos * 32 + i];
            const float r = lane < 32 ? (mine * c - part * s) : (mine * c + part * s);
            IK[(size_t)m * 64 + lane] = (bf16)f2bf(r);
            if (lane < 16) IW[(size_t)m * 16 + lane] = wv * 0.25f * 0.125f; }
    }
}
__device__ __forceinline__ void ph_gla_b(Frame& F, const Args& a) {
    const float* SK0 = (const float*)(F.ws + WS_SK0); const float* w2 = a.in[2]; const float* gbias = a.in[3]; float* GB = (float*)(F.ws + WS_GB); float* DEC = (float*)(F.ws + WS_DEC);
    for (int u4 = blockIdx.x; u4 < 128; u4 += F.G) {
        const int unit = u4 * 4 + (F.tid >> 7), n = unit & 63, bh = unit >> 6, b = bh >> 2, h = bh & 3, d = F.tid & 127, t0 = b * SEQ + n * 64;
        float w[16];
#pragma unroll
        for (int r = 0; r < 16; ++r) w[r] = w2[r * 512 + h * 128 + d];
        const float gb = gbias[h * 128 + d]; float run = 0.f;
        for (int c = 0; c < 64; ++c) { const int t = t0 + c; float z = gb;
#pragma unroll
            for (int r = 0; r < 16; ++r) z += SK0[(size_t)t * 24 + r] * w[r];
            run += logsigmoidf(z) * (1.0f / 16.0f); GB[(size_t)t * 512 + h * 128 + d] = run; }
        DEC[unit * 128 + d] = __expf(run);
    }
}
__device__ __forceinline__ void ph_gla_state(Frame& F) {
    const bf16* PROJ = (const bf16*)(F.ws + WS_PROJ); const float* GB = (const float*)(F.ws + WS_GB); float* CST = (float*)(F.ws + WS_CST);
    for (int vb = blockIdx.x; vb < 512 * 64; vb += F.G) {
        const int unit = vb >> 6, d = (vb & 63) * 2 + (F.tid >> 8), v = F.tid & 255, n = unit & 63, bh = unit >> 6, b = bh >> 2, h = bh & 3, t0 = b * SEQ + n * 64;
        const float blast = GB[(size_t)(t0 + 63) * 512 + h * 128 + d]; float acc = 0.f;
        for (int c = 0; c < 64; ++c) { const size_t t = t0 + c; const float kk = bf2f(PROJ[t * NP0 + 512 + h * 128 + d]) * __expf(blast - GB[t * 512 + h * 128 + d]);
            acc += kk * bf2f(PROJ[t * NP0 + 1024 + h * 256 + v]); }
        CST[((size_t)unit * 256 + v) * 128 + d] = acc;
    }
}
__device__ __forceinline__ void ph_gla_scan(Frame& F) {
    const float* CST = (const float*)(F.ws + WS_CST); const float* DEC = (const float*)(F.ws + WS_DEC); bf16* PREVT = (bf16*)(F.ws + WS_PREVT);
    for (int idx = blockIdx.x * 512 + F.tid; idx < 8 * 32768; idx += F.G * 512) { const int bh = idx >> 15, vd = idx & 32767, d = vd & 127; float S = 0.f;
        for (int n = 0; n < 64; ++n) { const int unit = bh * 64 + n; PREVT[(size_t)unit * 32768 + vd] = (bf16)f2bf(S); S = DEC[unit * 128 + d] * S + CST[(size_t)unit * 32768 + vd]; } }
}
__device__ __forceinline__ void ph_gla_out(Frame& F, const Args& a) {
    const bf16* PROJ = (const bf16*)(F.ws + WS_PROJ); const float* GB = (const float*)(F.ws + WS_GB); const bf16* PREVT = (const bf16*)(F.ws + WS_PREVT); const float* normg = a.in[4]; bf16* OMIX = (bf16*)(F.ws + WS_OMIX);
    LAS float* qd = (LAS float*)F.lds; LAS float* ki = qd + 64 * 128; LAS float* sc = ki + 64 * 128; LAS float* red = sc + 64 * 64;
    const int tid = F.tid; const bool act = tid < 256;
    for (int unit = blockIdx.x; unit < 512; unit += F.G) {
        const int n = unit & 63, bh = unit >> 6, b = bh >> 2, h = bh & 3, t0 = b * SEQ + n * 64;
        __syncthreads();
        for (int i = tid; i < 64 * 128; i += 512) { const int c = i >> 7, d = i & 127; const size_t t = t0 + c; const float bb = GB[t * 512 + h * 128 + d];
            qd[i] = bf2f(PROJ[t * NP0 + h * 128 + d]) * ATT_SCALE * __expf(bb); ki[i] = bf2f(PROJ[t * NP0 + 512 + h * 128 + d]) * __expf(-bb); }
        __syncthreads();
        for (int p = tid; p < 64 * 64; p += 512) { const int i = p >> 6, j = p & 63; float s = 0.f;
            if (j <= i) for (int d = 0; d < 128; ++d) s += qd[i * 128 + d] * ki[j * 128 + d];
            sc[p] = s; }
        __syncthreads();
        const int v = tid & 255; const bf16* pv = PREVT + ((size_t)unit * 256 + v) * 128; const float gv = normg[v];
        for (int i = 0; i < 64; ++i) { float acc = 0.f;
            if (act) { for (int j = 0; j <= i; ++j) acc += sc[i * 64 + j] * bf2f(PROJ[(size_t)(t0 + j) * NP0 + 1024 + h * 256 + v]);
                for (int d = 0; d < 128; ++d) acc += qd[i * 128 + d] * bf2f(pv[d]);
                const float ss = wave_sum(acc * acc); if ((tid & 63) == 0) red[tid >> 6] = ss; }
            __syncthreads();
            const float ms = (red[0] + red[1] + red[2] + red[3]) * (1.0f / 256.0f); __syncthreads();
            if (act) { const float gr = bf2f(PROJ[(size_t)(t0 + i) * NP0 + 2048 + h * 256 + v]);
                const float o = acc * (1.0f / sqrtf(ms + LN_EPS)) * gv * (gr / (1.0f + __expf(-gr)));
                OMIX[(size_t)(t0 + i) * DM + h * 256 + v] = (bf16)f2bf(o); } }
    }
}
template <int MODE  >
__device__ __forceinline__ void ph_attn_naive(Frame& F, const bf16* Qb, int ldq, int qc0, const bf16* Kb, int ldk, int kc0, const bf16* Vb, int ldv, int vc0, int nheads, int group,
                                              const float* fbias, const unsigned long long* mask, bf16* O, int oc0) {
    const int half = F.tid >> 8, tid = F.tid & 255, qi = tid >> 2, part = tid & 3;
    LAS bf16* Ks = (LAS bf16*)(F.lds + half * 32768); LAS bf16* Vs = Ks + 64 * 128;
    const int nvb = (SEQ / 64) * (nheads / 2) * BATCH;
    for (int vb = blockIdx.x; vb < nvb; vb += F.G) {
        const int cc = vb >> 6, qb = ((vb & 63) + cc * 17) & 63, hp = cc % (nheads / 2), b = cc / (nheads / 2), h = hp * 2 + half, kvh = h / group;
        const int qpos = qb * 64 + qi; const size_t row = (size_t)b * SEQ + qpos;
        float qv[32], o[32];
#pragma unroll
        for (int d = 0; d < 32; ++d) { qv[d] = bf2f(Qb[row * ldq + qc0 + h * 128 + part * 32 + d]); o[d] = 0.f; }
        float mrun = -1e30f, l = 0.f;
        const float* fb = MODE == 0 ? fbias + (size_t)(b * 8 + h) * SEQ : nullptr;
        for (int kt = 0; kt <= qb; ++kt) {
            __syncthreads();
            for (int i = tid; i < 64 * 16; i += 256) { const int r = i >> 4, c8 = (i & 15) * 8; const size_t kr = (size_t)b * SEQ + kt * 64 + r;
                *(LAS v4u*)(Ks + r * 128 + c8) = *(const v4u*)(Kb + kr * ldk + kc0 + kvh * 128 + c8); *(LAS v4u*)(Vs + r * 128 + c8) = *(const v4u*)(Vb + kr * ldv + vc0 + kvh * 128 + c8); }
            __syncthreads();
            unsigned long long mw = ~0ull; if (MODE == 1) mw = mask[row * 64 + kt];
            for (int s = 0; s < 64; ++s) { const int key = kt * 64 + s; float p = 0.f;
#pragma unroll
                for (int d = 0; d < 32; ++d) p += qv[d] * bf2f(Ks[s * 128 + part * 32 + d]);
                p += __shfl_xor(p, 1); p += __shfl_xor(p, 2);
                const bool valid = key <= qpos && ((mw >> s) & 1ull);
                if (valid) { const float logit = (p + (MODE == 0 ? fb[key] : 0.f)) * ATT_SCALE; const float mn = fmaxf(mrun, logit), al = __expf(mrun - mn), pp = __expf(logit - mn);
                    l = l * al + pp; mrun = mn;
#pragma unroll
                    for (int d = 0; d < 32; ++d) o[d] = o[d] * al + pp * bf2f(Vs[s * 128 + part * 32 + d]); } }
        }
        const float il = 1.0f / l;
#pragma unroll
        for (int d = 0; d < 32; ++d) O[row * DM + oc0 + h * 128 + part * 32 + d] = (bf16)f2bf(o[d] * il);
    }
    __syncthreads();
}
__device__ __forceinline__ void ph_idx_scores(Frame& F) {
    const bf16* PROJ1 = (const bf16*)(F.ws + WS_PROJ); const bf16* IK = (const bf16*)(F.ws + WS_IK); const float* IW = (const float*)(F.ws + WS_IW); float* SC = (float*)(F.ws + WS_SC);
    LAS float* q = (LAS float*)F.lds; LAS float* w = q + 1024; const int tid = F.tid;
    for (int m = blockIdx.x; m < MTOK; m += F.G) { const int pos = m & 4095, b = m >> 12;
        __syncthreads();
        for (int i = tid; i < 1024; i += 512) q[i] = bf2f(PROJ1[(size_t)m * NP1 + 3072 + i]);
        if (tid < 16) w[tid] = IW[(size_t)m * 16 + tid];
        __syncthreads();
        for (int s = tid; s <= pos; s += 512) { const bf16* kr = IK + ((size_t)b * SEQ + s) * 64; float kk[64];
#pragma unroll
            for (int d = 0; d < 64; ++d) kk[d] = bf2f(kr[d]);
            float sc = 0.f;
#pragma unroll 1
            for (int hh = 0; hh < 16; ++hh) { float dsum = 0.f;
#pragma unroll
                for (int d = 0; d < 64; ++d) dsum += q[hh * 64 + d] * kk[d];
                sc += w[hh] * fmaxf(dsum, 0.f); }
            SC[(size_t)m * SEQ + s] = sc; }
    }
    __syncthreads();
}
#define IN(k) (lo <= (k) && (k) < hi)
#define SEAM(k) do { if (hi > (k) + 1) xcd_barrier(bar); } while (0)
template <int LAYER, int BASE>
__device__ __forceinline__ void common_phases(Frame& F, const Args& args, const int lo, const int hi, const XcdBarrier& bar) {
    unsigned char* ws = args.ws;
    if (IN(BASE + 0)) {
        pg8::Gemm g{(const bf16*)(ws + WS_OMIX), (const bf16*)(ws + (LAYER ? WS_WOC : WS_WOA)), MTOK, DM, DM}; pg8::StaticOrder S; S.init(MTOK, DM, F.G, (int)blockIdx.x);
        pg8::EpiResid E{LAYER ? (const float*)(ws + WS_XR) : args.in[0], (float*)(ws + WS_XR), DN_ALPHA};
        pg8::gemm_phase<pg8::EpiResid, pg8::StaticOrder, true, true>(F.lds, g, S, E);
        SEAM(BASE + 0);
    }
    if (IN(BASE + 1)) { p_ln_route(F, args, LAYER); SEAM(BASE + 1); }
    if (IN(BASE + 2)) { p_gather(F, LAYER); SEAM(BASE + 2); }
    if (IN(BASE + 3) || IN(BASE + 4)) {
        if (F.wave == 0) { int ti; (void)moe_offsets(F.ctl + CW_CNT + LAYER * 64, F.lane, &ti); if (F.lane < 32) F.MISC[64 + F.lane] = (unsigned)ti; if (F.lane == 31) F.MISC[96] = (unsigned)ti; }
        __syncthreads();
    }
    if (IN(BASE + 3)) {
        pg8::Gemm g{(const bf16*)(ws + WS_PROJ), (const bf16*)(ws + WS_WGU) + (size_t)LAYER * 32 * 1024 * 2048, RPAD, 32 * 1024, DM};
        pg8::MoeOrder S{F.G, (int)blockIdx.x, 4, (int)F.MISC[96], (const LAS int*)(F.lds + LDSCTL_OFF + 64 * 4)};
        pg8::EpiGLU E{(bf16*)(ws + WS_OMIX), (const float*)(ws + WS_ROWW)};
        pg8::gemm_phase<pg8::EpiGLU, pg8::MoeOrder, true, true>(F.lds, g, S, E);
        SEAM(BASE + 3);
    }
    if (IN(BASE + 4)) {
        pg8::Gemm g{(const bf16*)(ws + WS_OMIX), (const bf16*)(ws + WS_WD) + (size_t)LAYER * 32 * 2048 * 512, RPAD, 32 * 2048, 512};
        pg8::MoeOrder S{F.G, (int)blockIdx.x, 8, (int)F.MISC[96], (const LAS int*)(F.lds + LDSCTL_OFF + 64 * 4)};
        pg8::EpiBf16Plain E{(bf16*)(ws + WS_CST), DM, 7};
        pg8::gemm_phase<pg8::EpiBf16Plain, pg8::MoeOrder, true, true>(F.lds, g, S, E);
        SEAM(BASE + 4);
    }
    if (IN(BASE + 5)) { p_ln_ffn(F, args, LAYER); SEAM(BASE + 5); }
}
__global__ void __launch_bounds__(NWAVES * 64, 2) mk_fwd(Args args) {
    extern __shared__ __attribute__((aligned(16))) unsigned char lds[];
    Frame F;
    F.lds = (LAS unsigned char*)lds; F.MISC = (volatile LAS unsigned*)(F.lds + LDSCTL_OFF);
    F.tid = threadIdx.x; F.lane = F.tid & 63; F.wave = __builtin_amdgcn_readfirstlane(F.tid >> 6);
    F.G = gridDim.x; F.gw = blockIdx.x * NWAVES + F.wave; F.NGW = F.G * NWAVES;
    F.ws = args.ws; F.ctl = (unsigned*)(args.ws + WS_CTL);
    for (int u = F.tid; u < (LDS_BYTES - LDSCTL_OFF) / 4; u += NWAVES * 64) ((LAS unsigned*)(F.lds + LDSCTL_OFF))[u] = 0u;
    __syncthreads();
    const int lo = args.ph_lo, hi = args.ph_hi;
    XcdBarrier bar; bar.bar = F.ctl + CW_BAR; bar.x = 0; bar.st = nullptr;
    if (hi - lo > 1) bar = xcd_barrier_post(F.ctl + CW_BAR, F.MISC);
    unsigned char* ws = args.ws;

    if (IN(0)) { p0_prologue(F, args); SEAM(0); }
    if (IN(1)) {
        pg8::Gemm g{(const bf16*)(ws + WS_XB), (const bf16*)(ws + WS_WINA), MTOK, NP0, DM}; pg8::StaticOrder S; S.init(MTOK, NP0, F.G, (int)blockIdx.x);
        pg8::EpiBf16Plain E{(bf16*)(ws + WS_PROJ), NP0, 0x7fffffff};
        pg8::gemm_phase<pg8::EpiBf16Plain, pg8::StaticOrder, true, true>(F.lds, g, S, E);
        SEAM(1);
    }
    if (IN(2)) { p_fox_bias(F, args); ph_gla_b(F, args); SEAM(2); }
    if (IN(3)) { ph_gla_state(F); SEAM(3); }
    if (IN(4)) { ph_gla_scan(F);
        ph_attn_naive<0>(F, (const bf16*)(ws + WS_PROJ), NP0, 3072, (const bf16*)(ws + WS_PROJ), NP0, 4096, (const bf16*)(ws + WS_PROJ), NP0, 5120, 8, 1,
                         (const float*)(ws + WS_FBIAS), (const unsigned long long*)nullptr, (bf16*)(ws + WS_OMIX), 1024);
        SEAM(4); }
    if (IN(5)) { ph_gla_out(F, args); SEAM(5); }
    common_phases<0, 6>(F, args, lo, hi, bar);
    if (IN(12)) {
        pg8::Gemm g{(const bf16*)(ws + WS_XB), (const bf16*)(ws + WS_WINC), MTOK, NP1, DM}; pg8::StaticOrder S; S.init(MTOK, NP1, F.G, (int)blockIdx.x);
        const float* c128 = (const float*)(ws + WS_ROPE);
        pg8::EpiRope E{(bf16*)(ws + WS_PROJ), c128, c128 + 4096 * 64, c128 + 2 * 4096 * 64, c128 + 2 * 4096 * 64 + 4096 * 32};
        pg8::gemm_phase<pg8::EpiRope, pg8::StaticOrder, true, true>(F.lds, g, S, E);
        SEAM(12);
    }
    if (IN(13)) { ph_idx_scores(F); SEAM(13); }
    if (IN(14)) {
        const float* SC = (const float*)(ws + WS_SC); unsigned long long* MASK = (unsigned long long*)(ws + WS_MASK);
        for (int m = F.gw; m < MTOK; m += F.NGW) topk_mask_row(SC + (size_t)m * SEQ, m & 4095, MASK + (size_t)m * 64, F.lane);
        SEAM(14);
    }
    if (IN(15)) {
        ph_attn_naive<1>(F, (const bf16*)(ws + WS_PROJ), NP1, 0, (const bf16*)(ws + WS_PROJ), NP1, 2048, (const bf16*)(ws + WS_PROJ), NP1, 2560, 16, 4,
                         (const float*)nullptr, (const unsigned long long*)(ws + WS_MASK), (bf16*)(ws + WS_OMIX), 0);
        SEAM(15); }
    common_phases<1, 16>(F, args, lo, hi, bar);
}
#undef IN
#undef SEAM
constexpr int N_PHASE_IDS = 22;
static void launch_mk(const Args& base, int lo, int hi, int grid, hipStream_t stream) {
    Args a = base; a.ph_lo = lo; a.ph_hi = hi;
    hipLaunchKernelGGL(mk_fwd, dim3(grid), dim3(NWAVES * 64), LDS_BYTES, stream, a);
}
extern "C" void kernel_launch(void* const* d_in, const int* in_sizes, int n_in, void* d_out, int out_size, void* d_ws, size_t ws_size, hipStream_t stream) {
    static int grid = 0;
    if (grid == 0) {
        if (n_in != 20 || out_size != MTOK * DM || ws_size < WS_END) { fprintf(stderr, "kernel_launch: unexpected shapes (n_in %d, out %d, ws %zu < %zu)\n", n_in, out_size, ws_size, (size_t)WS_END); grid = -1; return; }
        int dev = 0, cus = 0, per_cu = 0;
        if (hipGetDevice(&dev) != hipSuccess || hipDeviceGetAttribute(&cus, hipDeviceAttributeMultiprocessorCount, dev) != hipSuccess) { grid = -1; return; }
        if (hipFuncSetAttribute((const void*)mk_fwd, hipFuncAttributeMaxDynamicSharedMemorySize, LDS_BYTES) != hipSuccess) { fprintf(stderr, "kernel_launch: hipFuncSetAttribute failed\n"); grid = -1; return; }
        if (hipOccupancyMaxActiveBlocksPerMultiprocessor(&per_cu, (const void*)mk_fwd, NWAVES * 64, LDS_BYTES) != hipSuccess || per_cu < 1) { fprintf(stderr, "kernel_launch: occupancy query reports %d workgroups per CU\n", per_cu); }
        (void)hipGetLastError();
        grid = cus;
    }
    if (grid < 0) return;
    (void)in_sizes;
    if (hipMemsetAsync((char*)d_ws + WS_CTL, 0, CTL_ZERO_BYTES, stream) != hipSuccess) return;
    Args a{};
    for (int i = 0; i < 20; ++i) a.in[i] = (const float*)d_in[i];
    a.out = (float*)d_out; a.ws = (unsigned char*)d_ws;
    launch_mk(a, 0, N_PHASE_IDS, grid, stream);
}
```

```cpp
#include <hip/hip_runtime.h>
#include <cstdio>
#include <cstdint>
namespace pg8 {
#define PG8_LAS __attribute__((address_space(3)))
typedef unsigned short bf16_t;
typedef short bf16x8 __attribute__((ext_vector_type(8)));
typedef float f32x4 __attribute__((ext_vector_type(4)));
typedef unsigned u32x4 __attribute__((ext_vector_type(4)));
constexpr int BM = 256, BK = 64, HALF = 128, HTB = HALF * BK * 2  , STAGE_BYTES = 8 * HTB, NXCD = 8, WGM = 8;

__host__ __device__ __forceinline__ int lds_byte(int r, int c) { const int st = (r >> 4) * 2 + (c >> 5), rr = r & 15, cc = c & 31, ob = rr * 64 + cc * 2; return st * 1024 + (ob ^ (((ob >> 9) & 1) << 5)); }
__host__ __device__ __forceinline__ void stage_rc(int b, int& R, int& C) { const int st = b / 1024, sb = b % 1024, swz = sb ^ (((sb >> 9) & 1) << 5); R = (st >> 1) * 16 + swz / 64; C = (st & 1) * 32 + (swz % 64) / 2; }
__host__ __device__ __forceinline__ int perm32(int rho) { const int n = rho >> 4, i = rho & 15; return 8 * (i >> 2) + 4 * n + (i & 3); }

struct Unit { int pm, pn; };
struct Gemm { const bf16_t* A; const bf16_t* Bt; int M, N, K; };

struct StaticOrder {
    int nM, nN, nwg, G, c;
    __host__ __device__ void init(int M, int N, int G_, int c_) { nM = M / BM; nN = N / BM; nwg = nM * nN; G = G_; c = c_; }
    __host__ __device__ bool next(int i, Unit& u) const {
        const long L = (long)i * G + c; if (L >= nwg) return false;
        int wgid = (int)L; { const int q = nwg / NXCD, r = nwg % NXCD, xcd = wgid % NXCD, off = wgid / NXCD; wgid = (xcd < r ? xcd * (q + 1) : r * (q + 1) + (xcd - r) * q) + off; }
        const int nig = WGM * nN, gid = wgid / nig, fm = gid * WGM, gsz = (nM - fm) < WGM ? (nM - fm) : WGM;
        u.pm = fm + ((wgid % nig) % gsz); u.pn = (wgid % nig) / gsz; return true;
    }
    __device__ __forceinline__ void a_ready(const Unit&) const {}
    __device__ __forceinline__ void done(const Unit&) const {}
};

__device__ __forceinline__ unsigned cvt_pk_bf16(float lo, float hi) { unsigned r; asm volatile("v_cvt_pk_bf16_f32 %0, %1, %2" : "=v"(r) : "v"(lo), "v"(hi)); return r; }
typedef float f32x2 __attribute__((ext_vector_type(2)));
struct EpiBf16Plain {
    static constexpr bool PERM = true, AFTER_DRAIN = false;
    bf16_t* O; int ldc; int pn_mask;
    __device__ __forceinline__ void operator()(const f32x4 (&acc)[2][2][4][2], const Unit& u, int wr, int wc, int fr, int fq) const {
        const int row0 = u.pm * BM + wr * 64 + fr, col0 = (u.pn & pn_mask) * BM + wc * 32 + 8 * fq;
#pragma unroll
        for (int ai = 0; ai < 2; ++ai)
#pragma unroll
            for (int m = 0; m < 4; ++m) { bf16_t* rowp = O + (size_t)(row0 + ai * HALF + m * 16) * ldc + col0;
#pragma unroll
                for (int bj = 0; bj < 2; ++bj) { const f32x4 v0 = acc[ai][bj][m][0], v1 = acc[ai][bj][m][1];
                    u32x4 w; w.x = cvt_pk_bf16(v0[0], v0[1]); w.y = cvt_pk_bf16(v0[2], v0[3]); w.z = cvt_pk_bf16(v1[0], v1[1]); w.w = cvt_pk_bf16(v1[2], v1[3]);
                    *(u32x4*)(rowp + bj * HALF) = w; } }
    }
};
struct EpiResid {
    static constexpr bool PERM = false, AFTER_DRAIN = false;
    const float* base; float* out; float alpha;
    __device__ __forceinline__ void operator()(const f32x4 (&acc)[2][2][4][2], const Unit& u, int wr, int wc, int fr, int fq) const {
        const int row0 = u.pm * BM + wr * 64 + fr, col0 = u.pn * BM + wc * 32 + 4 * fq;
#pragma unroll
        for (int ai = 0; ai < 2; ++ai)
#pragma unroll
            for (int m = 0; m < 4; ++m) { const size_t off = (size_t)(row0 + ai * HALF + m * 16) * 2048 + col0;
#pragma unroll
                for (int bj = 0; bj < 2; ++bj)
#pragma unroll
                    for (int n = 0; n < 2; ++n) { const size_t o = off + bj * HALF + n * 16; const f32x4 b = *(const f32x4*)(base + o); *(f32x4*)(out + o) = b * alpha + acc[ai][bj][m][n]; } }
    }
};
struct EpiGLU {
    static constexpr bool PERM = true, AFTER_DRAIN = false;
    bf16_t* H; const float* roww;
    __device__ __forceinline__ void operator()(const f32x4 (&acc)[2][2][4][2], const Unit& u, int wr, int wc, int fr, int fq) const {
        const int row0 = u.pm * BM + wr * 64 + fr, f0 = (u.pn & 3) * 128 + wc * 32 + 8 * fq;
#pragma unroll
        for (int ai = 0; ai < 2; ++ai)
#pragma unroll
            for (int m = 0; m < 4; ++m) { const int row = row0 + ai * HALF + m * 16; const float w = roww[row];
                float h[8];
#pragma unroll
                for (int n = 0; n < 2; ++n)
#pragma unroll
                    for (int e = 0; e < 4; ++e) { const float g = acc[ai][0][m][n][e], up = acc[ai][1][m][n][e]; h[n * 4 + e] = g * __builtin_amdgcn_rcpf(1.0f + __expf(-g)) * up * w; }
                u32x4 o; o.x = cvt_pk_bf16(h[0], h[1]); o.y = cvt_pk_bf16(h[2], h[3]); o.z = cvt_pk_bf16(h[4], h[5]); o.w = cvt_pk_bf16(h[6], h[7]);
                *(u32x4*)(H + (size_t)row * 512 + f0) = o; }
    }
};
struct EpiRope {
    static constexpr bool PERM = true, AFTER_DRAIN = false;
    bf16_t* O; const float* c128; const float* s128; const float* c64; const float* s64;
    __device__ __forceinline__ void operator()(const f32x4 (&acc)[2][2][4][2], const Unit& u, int wr, int wc, int fr, int fq) const {
        const int row0 = u.pm * BM + wr * 64 + fr, jj = wc * 32 + 8 * fq;
        const int pn = u.pn;
        if (pn == 10 || pn == 11) {
#pragma unroll
            for (int ai = 0; ai < 2; ++ai)
#pragma unroll
                for (int m = 0; m < 4; ++m) { bf16_t* rowp = O + (size_t)(row0 + ai * HALF + m * 16) * 4096 + pn * 256 + jj;
#pragma unroll
                    for (int bj = 0; bj < 2; ++bj) { const f32x4 v0 = acc[ai][bj][m][0], v1 = acc[ai][bj][m][1];
                        u32x4 w; w.x = cvt_pk_bf16(v0[0], v0[1]); w.y = cvt_pk_bf16(v0[2], v0[3]); w.z = cvt_pk_bf16(v1[0], v1[1]); w.w = cvt_pk_bf16(v1[2], v1[3]);
                        *(u32x4*)(rowp + bj * HALF) = w; } }
            return;
        }
        const bool idx = pn >= 12;
        const int half = idx ? 32 : 64;
        const int hl = idx ? (jj >> 5) : (jj >> 6), i0 = jj & (half - 1);
        const int colbase = idx ? (3072 + ((pn - 12) * 4 + hl) * 64) : (pn * 256 + hl * 128);
        const float* ct = idx ? c64 : c128; const float* st = idx ? s64 : s128;
#pragma unroll
        for (int ai = 0; ai < 2; ++ai)
#pragma unroll
            for (int m = 0; m < 4; ++m) { const int row = row0 + ai * HALF + m * 16; const int pos = row & 4095;
                const float* cp = ct + (size_t)pos * half + i0; const float* sp = st + (size_t)pos * half + i0;
                const f32x4 c0 = *(const f32x4*)cp, c1 = *(const f32x4*)(cp + 4), s0 = *(const f32x4*)sp, s1 = *(const f32x4*)(sp + 4);
                const f32x4 a0 = acc[ai][0][m][0], a1 = acc[ai][0][m][1], b0 = acc[ai][1][m][0], b1 = acc[ai][1][m][1];
                const f32x4 x0 = a0 * c0 - b0 * s0, x1 = a1 * c1 - b1 * s1, y0 = b0 * c0 + a0 * s0, y1 = b1 * c1 + a1 * s1;
                bf16_t* rowp = O + (size_t)row * 4096 + colbase + i0;
                u32x4 w; w.x = cvt_pk_bf16(x0[0], x0[1]); w.y = cvt_pk_bf16(x0[2], x0[3]); w.z = cvt_pk_bf16(x1[0], x1[1]); w.w = cvt_pk_bf16(x1[2], x1[3]);
                *(u32x4*)rowp = w;
                u32x4 z; z.x = cvt_pk_bf16(y0[0], y0[1]); z.y = cvt_pk_bf16(y0[2], y0[3]); z.z = cvt_pk_bf16(y1[0], y1[1]); z.w = cvt_pk_bf16(y1[2], y1[3]);
                *(u32x4*)(rowp + half) = z; }
    }
};
struct MoeOrder {
    int G, c, ntn, Tm; const PG8_LAS int* tend;
    __device__ __forceinline__ bool next(int i, Unit& u) const {
        const int L = i * G + c; const int t = L / ntn; if (t >= Tm) return false;
        int e = 0;
#pragma unroll 1
        for (int k = 0; k < 32; ++k) e += (t >= tend[k]) ? 1 : 0;
        u.pm = t; u.pn = e * ntn + (L - t * ntn); return true;
    }
    __device__ __forceinline__ void a_ready(const Unit&) const {}
    __device__ __forceinline__ void done(const Unit&) const {}
};
template <class Epi, class Sched, bool ALIGN_EPI = false, bool SP2 = false>
__device__ __forceinline__ void gemm_phase(PG8_LAS unsigned char* lds, const Gemm g, const Sched& S, const Epi& E) {
    const int tid = threadIdx.x, wid = __builtin_amdgcn_readfirstlane(tid >> 6), lane = tid & 63, wr = wid >> 2, wc = wid & 3, fr = lane & 15, fq = lane >> 4;
    const int K = g.K, nt = K / BK;
    unsigned voffA[2], voffB[2];
#pragma unroll
    for (int i = 0; i < 2; ++i) { int R, C; stage_rc(tid * 16 + i * 8192, R, C); const int Rb = Epi::PERM ? ((R & ~31) + perm32(R & 31)) : R;
        voffA[i] = (unsigned)(R * K + C) * 2u; voffB[i] = (unsigned)(Rb * K + C) * 2u; }
    const size_t kstep = (size_t)(BK * 2);
    const size_t hstep = (size_t)HALF * K * 2;
    const size_t tstep = 2 * hstep;
    const unsigned ldsw = (unsigned)wid * 1024u;
    const int aoff = lds_byte(wr * 64 + fr, fq * 8), boff = lds_byte(wc * 32 + fr, fq * 8);
#define PG8_SA(b, h) (((b) * 2 + (h)) * HTB)
#define PG8_SB(b, h) ((4 + (b) * 2 + (h)) * HTB)
#define PG8_STAGE(bufoff, gbase, voff) do { _Pragma("unroll") for (int _i = 0; _i < 2; ++_i) \
        __builtin_amdgcn_global_load_lds((const unsigned*)((const char*)(gbase) + (voff)[_i]), (PG8_LAS unsigned*)(lds + (bufoff) + ldsw + _i * 8192), 16, 0, 0); } while (0)
#define PG8_LDA(dst, b, h) do { _Pragma("unroll") for (int m = 0; m < 4; ++m) _Pragma("unroll") for (int k = 0; k < 2; ++k) dst[m][k] = *(const PG8_LAS bf16x8*)(lds + PG8_SA(b, h) + aoff + m * 2048 + k * 1024); } while (0)
#define PG8_LDB(dst, b, h) do { _Pragma("unroll") for (int n = 0; n < 2; ++n) _Pragma("unroll") for (int k = 0; k < 2; ++k) dst[n][k] = *(const PG8_LAS bf16x8*)(lds + PG8_SB(b, h) + boff + n * 2048 + k * 1024); } while (0)
#define PG8_MMA(ai, bj, At, Bt) do { __builtin_amdgcn_s_setprio(1); _Pragma("unroll") for (int m = 0; m < 4; ++m) _Pragma("unroll") for (int n = 0; n < 2; ++n) _Pragma("unroll") for (int k = 0; k < 2; ++k) \
        acc[ai][bj][m][n] = __builtin_amdgcn_mfma_f32_16x16x32_bf16(Bt[n][k], At[m][k], acc[ai][bj][m][n], 0, 0, 0); __builtin_amdgcn_s_setprio(0); } while (0)
#define PG8_WAIT_V(n) asm volatile("s_waitcnt vmcnt(" #n ")" ::: "memory")
#define PG8_WAIT_L(n) asm volatile("s_waitcnt lgkmcnt(" #n ")" ::: "memory")
#define PG8_BAR __builtin_amdgcn_s_barrier()
#define PG8_SCHED __builtin_amdgcn_sched_barrier(0)
    Unit cur, nxt; int ui = 0;
    if (!S.next(0, cur)) return;
    f32x4 acc[2][2][4][2];
#pragma unroll
    for (int a = 0; a < 2; ++a)
#pragma unroll
        for (int b = 0; b < 2; ++b)
#pragma unroll
            for (int m = 0; m < 4; ++m)
#pragma unroll
                for (int n = 0; n < 2; ++n) acc[a][b][m][n] = (f32x4){0.f, 0.f, 0.f, 0.f};
    bf16x8 At[4][2], B0[2][2], B1[2][2];
    const char* cA = (const char*)g.A + (size_t)cur.pm * tstep; const char* cB = (const char*)g.Bt + (size_t)cur.pn * tstep;
    S.a_ready(cur);
    if constexpr (SP2) {
        PG8_STAGE(PG8_SB(0, 0), cB, voffB); PG8_STAGE(PG8_SB(0, 1), cB + hstep, voffB); PG8_STAGE(PG8_SA(0, 0), cA, voffA); PG8_STAGE(PG8_SA(0, 1), cA + hstep, voffA);
        if (wr == 1) PG8_BAR;
        PG8_WAIT_V(2); PG8_BAR;
        PG8_STAGE(PG8_SB(1, 0), cB + kstep, voffB); PG8_STAGE(PG8_SA(1, 0), cA + kstep, voffA); PG8_STAGE(PG8_SB(1, 1), cB + hstep + kstep, voffB);
        PG8_WAIT_V(6); PG8_BAR;
    } else {
        PG8_STAGE(PG8_SB(0, 0), cB, voffB); PG8_STAGE(PG8_SA(0, 0), cA, voffA); PG8_STAGE(PG8_SB(0, 1), cB + hstep, voffB); PG8_STAGE(PG8_SA(0, 1), cA + hstep, voffA);
        if (wr == 1) PG8_BAR;
        PG8_WAIT_V(4); PG8_BAR;
        PG8_STAGE(PG8_SB(1, 0), cB + kstep, voffB); PG8_STAGE(PG8_SA(1, 0), cA + kstep, voffA); PG8_STAGE(PG8_SB(1, 1), cB + hstep + kstep, voffB);
        PG8_WAIT_V(6); PG8_BAR;
    }
    for (;;) {
        const bool has_next = S.next(ui + 1, nxt);
        const char* nA = has_next ? (const char*)g.A + (size_t)nxt.pm * tstep : cA; const char* nB = has_next ? (const char*)g.Bt + (size_t)nxt.pn * tstep : cB;
        for (int t = 0; t < nt; t += 2) {
            const bool last = (t == nt - 2);
            const char* a1 = cA + (size_t)(t + 1) * kstep;
            const char* a2 = last ? nA : cA + (size_t)(t + 2) * kstep; const char* b2 = last ? nB : cB + (size_t)(t + 2) * kstep;
            const char* a3 = a2 + kstep; const char* b3 = b2 + kstep;
            if (last && has_next) S.a_ready(nxt);
            if constexpr (SP2) {
            PG8_LDB(B0, 0, 0); PG8_LDB(B1, 0, 1); PG8_SCHED; PG8_LDA(At, 0, 0); PG8_STAGE(PG8_SA(1, 1), a1 + hstep, voffA);
            PG8_WAIT_V(8); PG8_WAIT_L(0); PG8_BAR; PG8_MMA(0, 0, At, B0); PG8_MMA(0, 1, At, B1); PG8_BAR; PG8_SCHED;
            PG8_LDA(At, 0, 1); PG8_STAGE(PG8_SB(0, 0), b2, voffB); PG8_STAGE(PG8_SB(0, 1), b2 + hstep, voffB); PG8_STAGE(PG8_SA(0, 0), a2, voffA);
            PG8_WAIT_V(8); PG8_WAIT_L(0); PG8_BAR; PG8_MMA(1, 0, At, B0); PG8_MMA(1, 1, At, B1); PG8_BAR; PG8_SCHED;
            PG8_LDB(B0, 1, 0); PG8_LDB(B1, 1, 1); PG8_SCHED; PG8_LDA(At, 1, 0); PG8_STAGE(PG8_SA(0, 1), a2 + hstep, voffA);
            PG8_WAIT_V(8); PG8_WAIT_L(0); PG8_BAR; PG8_MMA(0, 0, At, B0); PG8_MMA(0, 1, At, B1); PG8_BAR; PG8_SCHED;
            PG8_LDA(At, 1, 1); PG8_STAGE(PG8_SB(1, 0), b3, voffB); PG8_STAGE(PG8_SB(1, 1), b3 + hstep, voffB); PG8_STAGE(PG8_SA(1, 0), a3, voffA);
            PG8_WAIT_V(8); PG8_WAIT_L(0); PG8_BAR; PG8_MMA(1, 0, At, B0); PG8_MMA(1, 1, At, B1); PG8_BAR; PG8_SCHED;
            } else {
            PG8_LDB(B0, 0, 0); PG8_SCHED; PG8_LDA(At, 0, 0); PG8_STAGE(PG8_SA(1, 1), a1 + hstep, voffA);
            PG8_WAIT_L(8); PG8_BAR; PG8_WAIT_L(0); PG8_MMA(0, 0, At, B0); PG8_BAR; PG8_SCHED;
            PG8_LDB(B1, 0, 1); PG8_STAGE(PG8_SB(0, 0), b2, voffB);
            PG8_BAR; PG8_WAIT_L(0); PG8_MMA(0, 1, At, B1); PG8_BAR;
            PG8_LDA(At, 0, 1); PG8_STAGE(PG8_SA(0, 0), a2, voffA);
            PG8_BAR; PG8_WAIT_L(0); PG8_MMA(1, 0, At, B0); PG8_BAR; PG8_SCHED;
            PG8_STAGE(PG8_SB(0, 1), b2 + hstep, voffB);
            PG8_WAIT_V(6); PG8_BAR; PG8_MMA(1, 1, At, B1); PG8_BAR;
            PG8_LDB(B0, 1, 0); PG8_SCHED; PG8_LDA(At, 1, 0); PG8_STAGE(PG8_SA(0, 1), a2 + hstep, voffA);
            PG8_WAIT_L(8); PG8_BAR; PG8_WAIT_L(0); PG8_MMA(0, 0, At, B0); PG8_BAR; PG8_SCHED;
            PG8_LDB(B1, 1, 1); PG8_STAGE(PG8_SB(1, 0), b3, voffB);
            PG8_BAR; PG8_WAIT_L(0); PG8_MMA(0, 1, At, B1); PG8_BAR;
            PG8_LDA(At, 1, 1); PG8_STAGE(PG8_SA(1, 0), a3, voffA);
            PG8_BAR; PG8_WAIT_L(0); PG8_MMA(1, 0, At, B0); PG8_BAR; PG8_SCHED;
            PG8_STAGE(PG8_SB(1, 1), b3 + hstep, voffB);
            PG8_WAIT_V(6); PG8_BAR; PG8_MMA(1, 1, At, B1); PG8_BAR;
            }
        }
        if constexpr (ALIGN_EPI) { if (wr == 0) PG8_BAR; }
        if constexpr (!Epi::AFTER_DRAIN) { E(acc, cur, wr, wc, fr, fq); S.done(cur); }
        if (!has_next) break;
#pragma unroll
        for (int a = 0; a < 2; ++a)
#pragma unroll
            for (int b = 0; b < 2; ++b)
#pragma unroll
                for (int m = 0; m < 4; ++m)
#pragma unroll
                    for (int n = 0; n < 2; ++n) acc[a][b][m][n] = (f32x4){0.f, 0.f, 0.f, 0.f};
        cur = nxt; cA = nA; cB = nB; ++ui;
        if constexpr (ALIGN_EPI) { if (wr == 1) PG8_BAR; }
    }
    PG8_WAIT_V(0);
    if constexpr (!ALIGN_EPI) { if (wr == 0) PG8_BAR; }
    PG8_BAR;
    if constexpr (Epi::AFTER_DRAIN) { E.fused(acc, cur, wr, wc, fr, fq, lds, wid, lane); S.done(cur); }
#undef PG8_SA
#undef PG8_SB
#undef PG8_STAGE
#undef PG8_LDA
#undef PG8_LDB
#undef PG8_MMA
#undef PG8_WAIT_V
#undef PG8_WAIT_L
#undef PG8_BAR
#undef PG8_SCHED
}
}
constexpr int BATCH = 2, SEQ = 4096, DM = 2048, MTOK = BATCH * SEQ;
constexpr int NE0 = 6168, NE1 = 4176;
constexpr int NP0 = 6144, NP1 = 4096;
constexpr float LN_EPS = 1e-5f;
constexpr float DN_ALPHA = 1.41421356237309515f;
constexpr float ATT_SCALE = 0.08838834764831845f;
constexpr int RPAD = 24576;
constexpr size_t MiB = 1u << 20;
constexpr size_t WS_CTL = 0, CTL_ZERO_BYTES = 1 * MiB;
constexpr size_t WS_ROPE = 1 * MiB;
constexpr size_t WS_WSM = 4 * MiB;
constexpr size_t WS_SK0 = 6 * MiB;
constexpr size_t WS_IK = 7 * MiB;
constexpr size_t WS_IW = 8 * MiB + 512 * 1024;
constexpr size_t WS_FBIAS = 10 * MiB;
constexpr size_t WS_ROUTE = 11 * MiB;
constexpr size_t WS_MASK = 12 * MiB;
constexpr size_t WS_WINA = 16 * MiB, WS_WOA = 40 * MiB, WS_WINC = 48 * MiB, WS_WOC = 64 * MiB;
constexpr size_t WS_WGU = 72 * MiB;
constexpr size_t WS_WD = 328 * MiB;
constexpr size_t WS_XB = 456 * MiB;
constexpr size_t WS_XR = 488 * MiB;
constexpr size_t WS_PROJ = 552 * MiB;
constexpr size_t WS_CST = 648 * MiB;
constexpr size_t WS_PREVT = 712 * MiB;
constexpr size_t WS_OMIX = 744 * MiB;
constexpr size_t WS_GB = 776 * MiB;
constexpr size_t WS_DEC = 792 * MiB;
constexpr size_t WS_ROWW = 793 * MiB;
constexpr size_t WS_SC = 800 * MiB;
constexpr size_t WS_END = 928 * MiB;
constexpr int CW_CNT = 1024;
constexpr int CW_BAR = 4096;

#define GAS __attribute__((address_space(1)))
#define LAS __attribute__((address_space(3)))
typedef unsigned short bf16;
typedef unsigned v4u __attribute__((ext_vector_type(4)));
typedef float f32x4 __attribute__((ext_vector_type(4)));
typedef short bf16x8 __attribute__((ext_vector_type(8)));
#define LDS_WAIT() asm volatile("s_waitcnt lgkmcnt(0)" ::: "memory")
#define VM_WAIT() asm volatile("s_waitcnt vmcnt(0)" ::: "memory")
__device__ __forceinline__ unsigned f2bf(float f) { unsigned u = __builtin_bit_cast(unsigned, f); return (u + 0x7fffu + ((u >> 16) & 1u)) >> 16; }
__device__ __forceinline__ unsigned pk2(float lo, float hi) { return f2bf(lo) | (f2bf(hi) << 16); }
__device__ __forceinline__ float bf2f(unsigned short b) { return __builtin_bit_cast(float, ((unsigned)b) << 16); }
__device__ __forceinline__ float wave_sum(float v) {
#pragma unroll
    for (int o = 1; o < 64; o <<= 1) v += __shfl_xor(v, o);
    return v;
}
__device__ __forceinline__ float logsigmoidf(float z) { return fminf(z, 0.f) - log1pf(__expf(-fabsf(z))); }
#define XB_TMO      128
#define XB_XCNT(j)  (256  + 64 * (j))
#define XB_XSUB(j)  (1280 + 64 * (j))
#define XB_XGEN(j)  (2304 + 64 * (j))
#define XB_TOP      3328
#define XB_TOPGEN   3392
#define XCD_BAR_WORDS 3456
#define XB_SPIN_CAP (1u << 21)

__device__ __forceinline__ unsigned xb_ld(unsigned* p)              { return __hip_atomic_load(p, __ATOMIC_RELAXED, __HIP_MEMORY_SCOPE_AGENT); }
__device__ __forceinline__ unsigned xb_add(unsigned* p, unsigned v) { return __hip_atomic_fetch_add(p, v, __ATOMIC_RELAXED, __HIP_MEMORY_SCOPE_AGENT); }
__device__ __forceinline__ unsigned xb_xcc_id() { return (unsigned)__builtin_amdgcn_s_getreg((3 << 11) | 20) & 0xFu; }
#define XB_SPIN(cond, bar) do { unsigned _sp = 0; while (cond) { __builtin_amdgcn_s_sleep(1); \
    if ((++_sp & 255u) == 0u) { if (xb_ld(&(bar)[XB_TMO])) break; if (_sp > XB_SPIN_CAP) { atomicAdd(&(bar)[XB_TMO], 1u); break; } } } } while (0)

struct XcdBarrier {
    unsigned* bar; unsigned x;
    volatile LAS unsigned* st;
};

__device__ __forceinline__ XcdBarrier xcd_barrier_post(unsigned* bar, volatile LAS unsigned* st) {
    XcdBarrier b; b.bar = bar; b.x = xb_xcc_id(); b.st = st;
    if (threadIdx.x == 0) (void)xb_add(&bar[XB_XCNT(b.x)], 1u);
    return b;
}
__device__ __forceinline__ void xcd_barrier_complete(unsigned* bar, unsigned x, unsigned& nloc, unsigned& nx) {
    const unsigned G = gridDim.x * gridDim.y * gridDim.z;
    unsigned sum, cnt, mine, sp = 0u;
    for (;;) {
        sum = 0u; cnt = 0u; mine = 0u;
#pragma unroll
        for (unsigned j = 0; j < 16; ++j) { const unsigned c = xb_ld(&bar[XB_XCNT(j)]); sum += c; cnt += (c > 0u) ? 1u : 0u; mine = (j == x) ? c : mine; }
        if (sum == G) break;
        __builtin_amdgcn_s_sleep(1);
        if ((++sp & 255u) == 0u) { if (xb_ld(&bar[XB_TMO])) break; if (sp > XB_SPIN_CAP) { atomicAdd(&bar[XB_TMO], 1u); break; } }
    }
    nloc = mine > 0u ? mine : 1u; nx = cnt > 0u ? cnt : 1u;
}

__device__ __forceinline__ void xcd_barrier(const XcdBarrier& b) {
    asm volatile("s_waitcnt vmcnt(0)" ::: "memory");
    __syncthreads();
    if (threadIdx.x == 0) {
        unsigned* bar = b.bar;
        __builtin_amdgcn_s_waitcnt(0);
        unsigned nloc = b.st[0], nx = b.st[1];
        if (nloc == 0u) { xcd_barrier_complete(bar, b.x, nloc, nx); b.st[0] = nloc; b.st[1] = nx; }
        const unsigned old = xb_add(&bar[XB_XSUB(b.x)], 1u);
        const unsigned gen = old / nloc;
        if (old + 1u == (gen + 1u) * nloc) {
            __builtin_amdgcn_fence(__ATOMIC_RELEASE, "agent");
            asm volatile("s_waitcnt vmcnt(0)" ::: "memory");
            const unsigned og = xb_add(&bar[XB_TOP], 1u);
            const unsigned tg = og / nx;
            if (og + 1u == (tg + 1u) * nx) xb_add(&bar[XB_TOPGEN], 1u);
            else XB_SPIN(xb_ld(&bar[XB_TOPGEN]) == tg, bar);
            __builtin_amdgcn_fence(__ATOMIC_ACQUIRE, "agent");
            xb_add(&bar[XB_XGEN(b.x)], 1u);
            asm volatile("s_waitcnt vmcnt(0)" ::: "memory");
        } else {
            XB_SPIN(xb_ld(&bar[XB_XGEN(b.x)]) == gen, bar);
            __builtin_amdgcn_fence(__ATOMIC_ACQUIRE, "agent");
            asm volatile("s_waitcnt vmcnt(0)" ::: "memory");
        }
    }
    __syncthreads();
}

constexpr int NWAVES = 8;
constexpr int RING_BYTES = 131072;
constexpr int LDSCTL_OFF = RING_BYTES;
constexpr int LDS_BYTES = 147456;
struct Frame {
    LAS unsigned char* lds; volatile LAS unsigned* MISC; unsigned* ctl;
    int tid, lane, wave, G, gw, NGW;
    unsigned char* ws;
};
struct Args { const float* in[20]; float* out; unsigned char* ws; int ph_lo, ph_hi; };

__device__ __forceinline__ void transpose_item(const float* W, int ldw, int c0, int K, bf16* WT, int n0, int k0, LAS float* scr, int lane) {
#pragma unroll 8
    for (int i = 0; i < 32; ++i) { const int kk = 2 * i + (lane >> 5); scr[kk * 33 + (lane & 31)] = W[(size_t)(k0 + kk) * ldw + c0 + (lane & 31)]; }
    LDS_WAIT(); asm volatile("" ::: "memory");
    const int c = lane & 7;
#pragma unroll
    for (int j = 0; j < 4; ++j) { const int n = (lane >> 3) + 8 * j; const LAS float* s = scr + (8 * c) * 33 + n;
        v4u o; o.x = pk2(s[0 * 33], s[1 * 33]); o.y = pk2(s[2 * 33], s[3 * 33]); o.z = pk2(s[4 * 33], s[5 * 33]); o.w = pk2(s[6 * 33], s[7 * 33]);
        *(v4u*)(WT + (size_t)(n0 + n) * K + k0 + 8 * c) = o; }
    LDS_WAIT(); asm volatile("" ::: "memory");
}
__device__ __forceinline__ int l1_src_col(int n) {
    const int pn = n >> 8, j = n & 255, jh = j & 127, second = j >> 7;
    if (pn == 10 || pn == 11) return n;
    if (pn < 10) return pn * 256 + (jh >> 6) * 128 + second * 64 + (jh & 63);
    return 3072 + ((pn - 12) * 4 + (jh >> 5)) * 64 + second * 32 + (jh & 31);
}
template <int NJ> __device__ __forceinline__ float row_dots(LAS float* scr, const f32x4 (&xv)[8], const float* W, int ld, int lane) {
#pragma unroll
    for (int j = 0; j < 8; ++j) *(LAS f32x4*)(scr + 256 * j + 4 * lane) = xv[j];
    LDS_WAIT(); asm volatile("" ::: "memory");
    float acc[NJ];
#pragma unroll
    for (int jj = 0; jj < NJ; ++jj) acc[jj] = 0.f;
#pragma unroll 2
    for (int c = 0; c < 32; ++c) { const int k = c * 64 + lane; const float xs = scr[k]; const float* wr = W + (size_t)k * ld;
#pragma unroll
        for (int q4 = 0; q4 < NJ / 4; ++q4) { const f32x4 w = *(const f32x4*)(wr + 4 * q4);
            acc[4 * q4 + 0] += xs * w[0]; acc[4 * q4 + 1] += xs * w[1]; acc[4 * q4 + 2] += xs * w[2]; acc[4 * q4 + 3] += xs * w[3]; } }
    LDS_WAIT(); asm volatile("" ::: "memory");
#pragma unroll
    for (int jj = 0; jj < NJ; ++jj) scr[jj * 65 + lane] = acc[jj];
    LDS_WAIT(); asm volatile("" ::: "memory");
    float s = 0.f;
    if (lane < NJ) {
#pragma unroll 8
        for (int l = 0; l < 64; ++l) s += scr[lane * 65 + l]; }
    LDS_WAIT(); asm volatile("" ::: "memory");
    return s;
}
__device__ __forceinline__ void ln_row(f32x4 (&v)[8], const float* g, const float* b, int lane) {
    float s = 0.f;
#pragma unroll
    for (int j = 0; j < 8; ++j) s += (v[j][0] + v[j][1]) + (v[j][2] + v[j][3]);
    const float mean = wave_sum(s) * (1.f / DM); float s2 = 0.f;
#pragma unroll
    for (int j = 0; j < 8; ++j) { v[j] = v[j] - mean; s2 += (v[j][0] * v[j][0] + v[j][1] * v[j][1]) + (v[j][2] * v[j][2] + v[j][3] * v[j][3]); }
    const float rstd = 1.f / sqrtf(wave_sum(s2) * (1.f / DM) + LN_EPS);
#pragma unroll
    for (int j = 0; j < 8; ++j) { const f32x4 gg = *(const f32x4*)(g + 256 * j + 4 * lane), bb = *(const f32x4*)(b + 256 * j + 4 * lane); v[j] = v[j] * rstd * gg + bb; }
}
__device__ __forceinline__ void store_row_bf16(bf16* dst, const f32x4 (&v)[8], int lane) {
#pragma unroll
    for (int j = 0; j < 8; ++j) { uint2 o; o.x = pk2(v[j][0], v[j][1]); o.y = pk2(v[j][2], v[j][3]); *(uint2*)(dst + 256 * j + 4 * lane) = o; }
}
__device__ __forceinline__ void topk_mask_row(const float* sc, int qpos, unsigned long long* mrow, int lane) {
    unsigned u[64];
#pragma unroll
    for (int i = 0; i < 64; ++i) { const int s = 64 * i + lane; const bool ok = s <= qpos; const float f = ok ? sc[s] : 0.f; const unsigned b = __builtin_bit_cast(unsigned, f);
        const unsigned key = b ^ ((b >> 31) ? 0xFFFFFFFFu : 0x80000000u); u[i] = ok ? key : 0u; }
    if (qpos + 1 <= 256) {
#pragma unroll
        for (int i = 0; i < 64; ++i) { const unsigned long long w = __ballot(64 * i + lane <= qpos); if (lane == 0) mrow[i] = w; }
        return;
    }
    unsigned T = 0u;
#pragma unroll 1
    for (int bit = 31; bit >= 0; --bit) { const unsigned cand = T | (1u << bit); int cnt = 0;
#pragma unroll
        for (int g = 0; g < 8; ++g) { if (512 * g <= qpos) {
#pragma unroll
            for (int i = 8 * g; i < 8 * g + 8; ++i) cnt += __builtin_popcountll(__ballot(u[i] >= cand)); } }
        if (cnt >= 256) T = cand; }
    int cgt = 0;
#pragma unroll
    for (int i = 0; i < 64; ++i) cgt += __builtin_popcountll(__ballot(u[i] > T));
    const int need = 256 - cgt; int run = 0; const unsigned long long below = (1ull << lane) - 1ull;
#pragma unroll
    for (int i = 0; i < 64; ++i) { const bool gt = u[i] > T, eq = u[i] == T; const unsigned long long eqm = __ballot(eq);
        const int rank = run + __builtin_popcountll(eqm & below); const bool sel = gt || (eq && rank < need); run += __builtin_popcountll(eqm);
        const unsigned long long w = __ballot(sel); if (lane == 0) mrow[i] = w; }
}

__device__ __forceinline__ void p0_prologue(Frame& F, const Args& a) {
    LAS float* scr = (LAS float*)(F.lds + F.wave * 16384);
    const int gw = F.gw, NGW = F.NGW, lane = F.lane;
    unsigned char* ws = F.ws;
    {
        const float* W = a.in[1]; bf16* WT = (bf16*)(ws + WS_WINA);
        for (int it = gw; it < (2048 / 64) * (NP0 / 32); it += NGW) { const int kb = it / (NP0 / 32), nb = it % (NP0 / 32), n0 = nb * 32; transpose_item(W, NE0, n0 < 3072 ? n0 : n0 + 16, 2048, WT, n0, kb * 64, scr, lane); }
    }
    {
        for (int it = gw; it < 2 * 32 * 64; it += NGW) { const int w = it / (32 * 64), r = it % (32 * 64), kb = r / 64, nb = r % 64;
            transpose_item(w ? a.in[8] : a.in[6], 2048, nb * 32, 2048, (bf16*)(ws + (w ? WS_WOC : WS_WOA)), nb * 32, kb * 64, scr, lane); }
    }
    {
        const float* W = a.in[7]; bf16* WT = (bf16*)(ws + WS_WINC);
        for (int it = gw; it < 32 * (NP1 / 32); it += NGW) { const int kb = it / (NP1 / 32), nb = it % (NP1 / 32), n0 = nb * 32; transpose_item(W, NE1, l1_src_col(n0), 2048, WT, n0, kb * 64, scr, lane); }
    }
    {
        const int per = 32 * 32;
        for (int it = gw; it < 64 * per; it += NGW) { const int ex = it / per, r = it % per, kb = r / 32, nb = r % 32, n0 = nb * 32, tile = n0 >> 8, j = n0 & 255;
            const float* W = (j < 128 ? a.in[17] : a.in[18]) + (size_t)ex * 2048 * 512;
            transpose_item(W, 512, 128 * tile + (j & 127), 2048, (bf16*)(ws + WS_WGU) + (size_t)ex * 1024 * 2048, n0, kb * 64, scr, lane); }
    }
    {
        const int per = 8 * 64;
        for (int it = gw; it < 64 * per; it += NGW) { const int ex = it / per, r = it % per, kb = r / 64, nb = r % 64;
            transpose_item(a.in[19] + (size_t)ex * 512 * 2048, 2048, nb * 32, 512, (bf16*)(ws + WS_WD) + (size_t)ex * 2048 * 512, nb * 32, kb * 64, scr, lane); }
    }
    const int gt = blockIdx.x * (NWAVES * 64) + F.tid, NGT = F.G * NWAVES * 64;
    {   float* c128 = (float*)(ws + WS_ROPE); float* s128 = c128 + 4096 * 64; float* c64 = s128 + 4096 * 64; float* s64 = c64 + 4096 * 32;
        for (int i = gt; i < 4096 * 96; i += NGT) { int pos, idx, half; float* cp; float* sp;
            if (i < 4096 * 64) { pos = i >> 6; idx = i & 63; half = 64; cp = c128 + i; sp = s128 + i; } else { const int r = i - 4096 * 64; pos = r >> 5; idx = r & 31; half = 32; cp = c64 + r; sp = s64 + r; }
            const float inv = exp2f(-(float)idx / (float)half * 13.287712379549449f);
            const float ang = (float)pos * inv;
            double rv = (double)ang * 0.15915494309189535; rv -= rint(rv);
            const float rf = (float)rv;
            *cp = __builtin_amdgcn_cosf(rf); *sp = __builtin_amdgcn_sinf(rf); }
    }
    {   float* RT = (float*)(ws + WS_WSM);
        for (int i = gt; i < 2 * 2048 * 40; i += NGT) { const int l = i / (2048 * 40), r = i % (2048 * 40), k = r / 40, c = r % 40; float v = 0.f;
            if (c < 4) v = a.in[13][((size_t)l * 2048 + k) * 4 + c]; else if (c < 36) { const int g = (c - 4) >> 3, e = (c - 4) & 7; v = a.in[15][(((size_t)l * 4 + g) * 2048 + k) * 8 + e]; }
            RT[i] = v; }
        float* SKW1 = RT + 2 * 2048 * 40;
        for (int i = gt; i < 2048 * 80; i += NGT) { const int k = i / 80, c = i % 80; SKW1[i] = a.in[7][(size_t)k * NE1 + 4096 + c]; }
    }
    {   const float* x = a.in[0]; bf16* XB = (bf16*)(ws + WS_XB); float* SK0 = (float*)(ws + WS_SK0); const float* W = a.in[1];
        for (int m = gw; m < MTOK; m += NGW) { f32x4 v[8];
#pragma unroll
            for (int j = 0; j < 8; ++j) v[j] = *(const f32x4*)(x + (size_t)m * DM + 256 * j + 4 * lane);
            store_row_bf16(XB + (size_t)m * DM, v, lane);
            const float m16 = row_dots<16>(scr, v, W + 3072, NE0, lane); const float m8 = row_dots<8>(scr, v, W + 6160, NE0, lane);
            const float m8s = __shfl(m8, (lane - 16) & 63); if (lane < 16) SK0[(size_t)m * 24 + lane] = m16; else if (lane < 24) SK0[(size_t)m * 24 + lane] = m8s; }
    }
}
__device__ __forceinline__ void p_fox_bias(Frame& F, const Args& a) {
    if (F.gw >= 16) return;
    const int bh = F.gw, b = bh >> 3, h = bh & 7, lane = F.lane; const float gb = a.in[5][h];
    const float* SK0 = (const float*)(F.ws + WS_SK0); float* FB = (float*)(F.ws + WS_FBIAS) + (size_t)bh * SEQ;
    float tot = 0.f;
    for (int i = 0; i < 64; ++i) { const int s = lane * 64 + i; tot += logsigmoidf(SK0[(size_t)(b * SEQ + s) * 24 + 16 + h] + gb); }
    float incl = tot;
#pragma unroll
    for (int o = 1; o < 64; o <<= 1) { const float t = __shfl_up(incl, o); if (lane >= o) incl += t; }
    float run = incl - tot;
    for (int i = 0; i < 64; ++i) { const int s = lane * 64 + i; run += logsigmoidf(SK0[(size_t)(b * SEQ + s) * 24 + 16 + h] + gb); FB[s] = -run * (1.0f / ATT_SCALE); }
}
__device__ __forceinline__ void p_ln_route(Frame& F, const Args& a, int layer) {
    float* XR = (float*)(F.ws + WS_XR); bf16* XB = (bf16*)(F.ws + WS_XB); const int lane = F.lane;
    const float* g = a.in[9] + layer * DM; const float* bb = a.in[10] + layer * DM;
    const float* RT = (const float*)(F.ws + WS_WSM) + (size_t)layer * 2048 * 40;
    const float* bg = a.in[14] + layer * 4; const float* be = a.in[16] + layer * 32;
    int4* ROUTE = (int4*)(F.ws + WS_ROUTE); unsigned* cnt = F.ctl + CW_CNT + layer * 64;
    for (int m = F.gw; m < MTOK; m += F.NGW) { f32x4 v[8];
#pragma unroll
        for (int j = 0; j < 8; ++j) v[j] = *(const f32x4*)(XR + (size_t)m * DM + 256 * j + 4 * lane);
        ln_row(v, g, bb, lane);
#pragma unroll
        for (int j = 0; j < 8; ++j) *(f32x4*)(XR + (size_t)m * DM + 256 * j + 4 * lane) = v[j];
        store_row_bf16(XB + (size_t)m * DM, v, lane);
        const float mine = row_dots<36>((LAS float*)(F.lds + F.wave * 16384), v, RT, 40, lane);
        float gl[4];
#pragma unroll
        for (int i = 0; i < 4; ++i) gl[i] = __shfl(mine, i) + bg[i];
        int gi = 0; float gm = gl[0];
#pragma unroll
        for (int i = 1; i < 4; ++i) if (gl[i] > gm) { gm = gl[i]; gi = i; }
        float gs = 0.f;
#pragma unroll
        for (int i = 0; i < 4; ++i) gs += __expf(gl[i] - gm);
        const float gp = 1.0f / gs;
        float el[8];
#pragma unroll
        for (int e = 0; e < 8; ++e) el[e] = __shfl(mine, 4 + 8 * gi + e) + be[gi * 8 + e];
        int e1 = 0; float v1 = el[0];
#pragma unroll
        for (int e = 1; e < 8; ++e) if (el[e] > v1) { v1 = el[e]; e1 = e; }
        int e2 = -1; float v2 = -3.0e38f;
#pragma unroll
        for (int e = 0; e < 8; ++e) if (e != e1 && el[e] > v2) { v2 = el[e]; e2 = e; }
        const float w1 = gp / (1.0f + __expf(v2 - v1)), w2 = gp - w1;
        if (lane == 0) { const int ge1 = gi * 8 + e1, ge2 = gi * 8 + e2;
            const int p1 = (int)atomicAdd(cnt + ge1, 1u), p2 = (int)atomicAdd(cnt + ge2, 1u);
            ROUTE[(size_t)m * 2 + 0] = make_int4(ge1, p1, __builtin_bit_cast(int, w1), 0);
            ROUTE[(size_t)m * 2 + 1] = make_int4(ge2, p2, __builtin_bit_cast(int, w2), 0); }
    }
}
__device__ __forceinline__ int moe_offsets(const unsigned* cnt, int lane, int* tiles_incl) {
    const int c = lane < 32 ? (int)cnt[lane] : 0; const int t = (c + 255) >> 8; int incl = t;
#pragma unroll
    for (int o = 1; o < 32; o <<= 1) { const int x = __shfl_up(incl, o); if ((lane & 31) >= o) incl += x; }
    *tiles_incl = incl; return (incl - t) * 256;
}
__device__ __forceinline__ void p_gather(Frame& F, int layer) {
    const int lane = F.lane; const unsigned* cnt = F.ctl + CW_CNT + layer * 64; int ti; const int off = moe_offsets(cnt, lane, &ti);
    const bf16* XB = (const bf16*)(F.ws + WS_XB); bf16* XG = (bf16*)(F.ws + WS_PROJ); float* ROWW = (float*)(F.ws + WS_ROWW); int4* ROUTE = (int4*)(F.ws + WS_ROUTE);
    for (int m = F.gw; m < MTOK; m += F.NGW) {
#pragma unroll
        for (int s = 0; s < 2; ++s) { int4 r = ROUTE[(size_t)m * 2 + s]; const int dst = __shfl(off, r.x) + r.y;
            const v4u* src = (const v4u*)(XB + (size_t)m * DM); v4u* d = (v4u*)(XG + (size_t)dst * DM);
#pragma unroll
            for (int j = 0; j < 4; ++j) d[64 * j + lane] = src[64 * j + lane];
            if (lane == 0) { ROWW[dst] = __builtin_bit_cast(float, r.z); r.w = dst; ROUTE[(size_t)m * 2 + s] = r; } }
    }
}
__device__ __forceinline__ void p_ln_ffn(Frame& F, const Args& a, int layer) {
    float* XR = (float*)(F.ws + WS_XR); bf16* XB = (bf16*)(F.ws + WS_XB); const int lane = F.lane; const bf16* YG = (const bf16*)(F.ws + WS_CST);
    const float* g = a.in[11] + layer * DM; const float* bb = a.in[12] + layer * DM; const int4* ROUTE = (const int4*)(F.ws + WS_ROUTE);
    float* dst = layer == 1 ? a.out : XR;
    const float* SKW1 = (const float*)(F.ws + WS_WSM) + 2 * 2048 * 40;
    const float* c64 = (const float*)(F.ws + WS_ROPE) + 2 * 4096 * 64; const float* s64 = c64 + 4096 * 32;
    bf16* IK = (bf16*)(F.ws + WS_IK); float* IW = (float*)(F.ws + WS_IW);
    for (int m = F.gw; m < MTOK; m += F.NGW) { f32x4 v[8];
        const int r0 = ROUTE[(size_t)m * 2].w, r1 = ROUTE[(size_t)m * 2 + 1].w;
#pragma unroll
        for (int j = 0; j < 8; ++j) { v[j] = *(const f32x4*)(XR + (size_t)m * DM + 256 * j + 4 * lane) * DN_ALPHA;
            const uint2 y0 = *(const uint2*)(YG + (size_t)r0 * DM + 256 * j + 4 * lane), y1 = *(const uint2*)(YG + (size_t)r1 * DM + 256 * j + 4 * lane);
            v[j][0] += bf2f(y0.x & 0xffff) + bf2f(y1.x & 0xffff); v[j][1] += bf2f(y0.x >> 16) + bf2f(y1.x >> 16);
            v[j][2] += bf2f(y0.y & 0xffff) + bf2f(y1.y & 0xffff); v[j][3] += bf2f(y0.y >> 16) + bf2f(y1.y >> 16); }
        ln_row(v, g, bb, lane);
#pragma unroll
        for (int j = 0; j < 8; ++j) *(f32x4*)(dst + (size_t)m * DM + 256 * j + 4 * lane) = v[j];
        if (layer == 0) {
            store_row_bf16(XB + (size_t)m * DM, v, lane);
            LAS float* scr = (LAS float*)(F.lds + F.wave * 16384); const float mA = row_dots<40>(scr, v, SKW1, 80, lane), mB = row_dots<40>(scr, v, SKW1 + 40, 80, lane);
            const float mBs = __shfl(mB, (lane - 40) & 63); const float mine = lane < 40 ? mA : mBs;
            const float wv = __shfl(mB, (lane + 24) & 63);
            const float part = __shfl(mine, lane ^ 32);
            const int pos = m & 4095, i = lane & 31; const float c = c64[pos * 32 + i], s = s64[pos * 32 + i];
            const float r = lane < 32 ? (mine * c - part * s) : (mine * c + part * s);
            IK[(size_t)m * 64 + lane] = (bf16)f2bf(r);
            if (lane < 16) IW[(size_t)m * 16 + lane] = wv * 0.25f * 0.125f; }
    }
}
__device__ __forceinline__ void ph_gla_b(Frame& F, const Args& a) {
    const float* SK0 = (const float*)(F.ws + WS_SK0); const float* w2 = a.in[2]; const float* gbias = a.in[3]; float* GB = (float*)(F.ws + WS_GB); float* DEC = (float*)(F.ws + WS_DEC);
    for (int u4 = blockIdx.x; u4 < 128; u4 += F.G) {
        const int unit = u4 * 4 + (F.tid >> 7), n = unit & 63, bh = unit >> 6, b = bh >> 2, h = bh & 3, d = F.tid & 127, t0 = b * SEQ + n * 64;
        float w[16];
#pragma unroll
        for (int r = 0; r < 16; ++r) w[r] = w2[r * 512 + h * 128 + d];
        const float gb = gbias[h * 128 + d]; float run = 0.f;
        for (int c = 0; c < 64; ++c) { const int t = t0 + c; float z = gb;
#pragma unroll
            for (int r = 0; r < 16; ++r) z += SK0[(size_t)t * 24 + r] * w[r];
            run += logsigmoidf(z) * (1.0f / 16.0f); GB[(size_t)t * 512 + h * 128 + d] = run; }
        DEC[unit * 128 + d] = __expf(run);
    }
}
__device__ __forceinline__ void ph_gla_state(Frame& F) {
    const bf16* PROJ = (const bf16*)(F.ws + WS_PROJ); const float* GB = (const float*)(F.ws + WS_GB); float* CST = (float*)(F.ws + WS_CST);
    for (int vb = blockIdx.x; vb < 512 * 64; vb += F.G) {
        const int unit = vb >> 6, d = (vb & 63) * 2 + (F.tid >> 8), v = F.tid & 255, n = unit & 63, bh = unit >> 6, b = bh >> 2, h = bh & 3, t0 = b * SEQ + n * 64;
        const float blast = GB[(size_t)(t0 + 63) * 512 + h * 128 + d]; float acc = 0.f;
        for (int c = 0; c < 64; ++c) { const size_t t = t0 + c; const float kk = bf2f(PROJ[t * NP0 + 512 + h * 128 + d]) * __expf(blast - GB[t * 512 + h * 128 + d]);
            acc += kk * bf2f(PROJ[t * NP0 + 1024 + h * 256 + v]); }
        CST[((size_t)unit * 256 + v) * 128 + d] = acc;
    }
}
__device__ __forceinline__ void ph_gla_scan(Frame& F) {
    const float* CST = (const float*)(F.ws + WS_CST); const float* DEC = (const float*)(F.ws + WS_DEC); bf16* PREVT = (bf16*)(F.ws + WS_PREVT);
    for (int idx = blockIdx.x * 512 + F.tid; idx < 8 * 32768; idx += F.G * 512) { const int bh = idx >> 15, vd = idx & 32767, d = vd & 127; float S = 0.f;
        for (int n = 0; n < 64; ++n) { const int unit = bh * 64 + n; PREVT[(size_t)unit * 32768 + vd] = (bf16)f2bf(S); S = DEC[unit * 128 + d] * S + CST[(size_t)unit * 32768 + vd]; } }
}
__device__ __forceinline__ void ph_gla_out(Frame& F, const Args& a) {
    const bf16* PROJ = (const bf16*)(F.ws + WS_PROJ); const float* GB = (const float*)(F.ws + WS_GB); const bf16* PREVT = (const bf16*)(F.ws + WS_PREVT); const float* normg = a.in[4]; bf16* OMIX = (bf16*)(F.ws + WS_OMIX);
    LAS float* qd = (LAS float*)F.lds; LAS float* ki = qd + 64 * 128; LAS float* sc = ki + 64 * 128; LAS float* red = sc + 64 * 64;
    const int tid = F.tid; const bool act = tid < 256;
    for (int unit = blockIdx.x; unit < 512; unit += F.G) {
        const int n = unit & 63, bh = unit >> 6, b = bh >> 2, h = bh & 3, t0 = b * SEQ + n * 64;
        __syncthreads();
        for (int i = tid; i < 64 * 128; i += 512) { const int c = i >> 7, d = i & 127; const size_t t = t0 + c; const float bb = GB[t * 512 + h * 128 + d];
            qd[i] = bf2f(PROJ[t * NP0 + h * 128 + d]) * ATT_SCALE * __expf(bb); ki[i] = bf2f(PROJ[t * NP0 + 512 + h * 128 + d]) * __expf(-bb); }
        __syncthreads();
        for (int p = tid; p < 64 * 64; p += 512) { const int i = p >> 6, j = p & 63; float s = 0.f;
            if (j <= i) for (int d = 0; d < 128; ++d) s += qd[i * 128 + d] * ki[j * 128 + d];
            sc[p] = s; }
        __syncthreads();
        const int v = tid & 255; const bf16* pv = PREVT + ((size_t)unit * 256 + v) * 128; const float gv = normg[v];
        for (int i = 0; i < 64; ++i) { float acc = 0.f;
            if (act) { for (int j = 0; j <= i; ++j) acc += sc[i * 64 + j] * bf2f(PROJ[(size_t)(t0 + j) * NP0 + 1024 + h * 256 + v]);
                for (int d = 0; d < 128; ++d) acc += qd[i * 128 + d] * bf2f(pv[d]);
                const float ss = wave_sum(acc * acc); if ((tid & 63) == 0) red[tid >> 6] = ss; }
            __syncthreads();
            const float ms = (red[0] + red[1] + red[2] + red[3]) * (1.0f / 256.0f); __syncthreads();
            if (act) { const float gr = bf2f(PROJ[(size_t)(t0 + i) * NP0 + 2048 + h * 256 + v]);
                const float o = acc * (1.0f / sqrtf(ms + LN_EPS)) * gv * (gr / (1.0f + __expf(-gr)));
                OMIX[(size_t)(t0 + i) * DM + h * 256 + v] = (bf16)f2bf(o); } }
    }
}
template <int MODE  >
__device__ __forceinline__ void ph_attn_naive(Frame& F, const bf16* Qb, int ldq, int qc0, const bf16* Kb, int ldk, int kc0, const bf16* Vb, int ldv, int vc0, int nheads, int group,
                                              const float* fbias, const unsigned long long* mask, bf16* O, int oc0) {
    const int half = F.tid >> 8, tid = F.tid & 255, qi = tid >> 2, part = tid & 3;
    LAS bf16* Ks = (LAS bf16*)(F.lds + half * 32768); LAS bf16* Vs = Ks + 64 * 128;
    const int nvb = (SEQ / 64) * (nheads / 2) * BATCH;
    for (int vb = blockIdx.x; vb < nvb; vb += F.G) {
        const int cc = vb >> 6, qb = ((vb & 63) + cc * 17) & 63, hp = cc % (nheads / 2), b = cc / (nheads / 2), h = hp * 2 + half, kvh = h / group;
        const int qpos = qb * 64 + qi; const size_t row = (size_t)b * SEQ + qpos;
        float qv[32], o[32];
#pragma unroll
        for (int d = 0; d < 32; ++d) { qv[d] = bf2f(Qb[row * ldq + qc0 + h * 128 + part * 32 + d]); o[d] = 0.f; }
        float mrun = -1e30f, l = 0.f;
        const float* fb = MODE == 0 ? fbias + (size_t)(b * 8 + h) * SEQ : nullptr;
        for (int kt = 0; kt <= qb; ++kt) {
            __syncthreads();
            for (int i = tid; i < 64 * 16; i += 256) { const int r = i >> 4, c8 = (i & 15) * 8; const size_t kr = (size_t)b * SEQ + kt * 64 + r;
                *(LAS v4u*)(Ks + r * 128 + c8) = *(const v4u*)(Kb + kr * ldk + kc0 + kvh * 128 + c8); *(LAS v4u*)(Vs + r * 128 + c8) = *(const v4u*)(Vb + kr * ldv + vc0 + kvh * 128 + c8); }
            __syncthreads();
            unsigned long long mw = ~0ull; if (MODE == 1) mw = mask[row * 64 + kt];
            for (int s = 0; s < 64; ++s) { const int key = kt * 64 + s; float p = 0.f;
#pragma unroll
                for (int d = 0; d < 32; ++d) p += qv[d] * bf2f(Ks[s * 128 + part * 32 + d]);
                p += __shfl_xor(p, 1); p += __shfl_xor(p, 2);
                const bool valid = key <= qpos && ((mw >> s) & 1ull);
                if (valid) { const float logit = (p + (MODE == 0 ? fb[key] : 0.f)) * ATT_SCALE; const float mn = fmaxf(mrun, logit), al = __expf(mrun - mn), pp = __expf(logit - mn);
                    l = l * al + pp; mrun = mn;
#pragma unroll
                    for (int d = 0; d < 32; ++d) o[d] = o[d] * al + pp * bf2f(Vs[s * 128 + part * 32 + d]); } }
        }
        const float il = 1.0f / l;
#pragma unroll
        for (int d = 0; d < 32; ++d) O[row * DM + oc0 + h * 128 + part * 32 + d] = (bf16)f2bf(o[d] * il);
    }
    __syncthreads();
}
__device__ __forceinline__ void ph_idx_scores(Frame& F) {
    const bf16* PROJ1 = (const bf16*)(F.ws + WS_PROJ); const bf16* IK = (const bf16*)(F.ws + WS_IK); const float* IW = (const float*)(F.ws + WS_IW); float* SC = (float*)(F.ws + WS_SC);
    LAS float* q = (LAS float*)F.lds; LAS float* w = q + 1024; const int tid = F.tid;
    for (int m = blockIdx.x; m < MTOK; m += F.G) { const int pos = m & 4095, b = m >> 12;
        __syncthreads();
        for (int i = tid; i < 1024; i += 512) q[i] = bf2f(PROJ1[(size_t)m * NP1 + 3072 + i]);
        if (tid < 16) w[tid] = IW[(size_t)m * 16 + tid];
        __syncthreads();
        for (int s = tid; s <= pos; s += 512) { const bf16* kr = IK + ((size_t)b * SEQ + s) * 64; float kk[64];
#pragma unroll
            for (int d = 0; d < 64; ++d) kk[d] = bf2f(kr[d]);
            float sc = 0.f;
#pragma unroll 1
            for (int hh = 0; hh < 16; ++hh) { float dsum = 0.f;
#pragma unroll
                for (int d = 0; d < 64; ++d) dsum += q[hh * 64 + d] * kk[d];
                sc += w[hh] * fmaxf(dsum, 0.f); }
            SC[(size_t)m * SEQ + s] = sc; }
    }
    __syncthreads();
}
namespace attn {
constexpr int D = 128, NW = 8, QBLK = 32, KVBLK = 64, QB = NW * QBLK;
constexpr int SHM_V = KVBLK * D * 2, SHM_K = KVBLK * D * 2;
constexpr int OFF_WS = 2 * SHM_V + 2 * SHM_K, OFF_BIAS = OFF_WS + NW * 64 * 4, LDS_NEED = OFF_BIAS + 2 * 16384;
constexpr float SCALE = 0.08838834764831845f, THR = 8.f;
typedef short s16x4 __attribute__((ext_vector_type(4)));
typedef float f32x16 __attribute__((ext_vector_type(16)));
typedef unsigned u32x4 __attribute__((ext_vector_type(4)));
#define KSWZ(row, colB) ((row) * 256 + ((colB) ^ (((row) & 7) << 4)))
#define SBAR() __builtin_amdgcn_sched_barrier(0)
__device__ __forceinline__ int v_st(int k, int c) { const int kk = (k & ~0xC) | ((k & 4) << 1) | ((k & 8) >> 1); return ((kk >> 3) * 4 + (c >> 5)) * 512 + ((kk & 7) * 32 + (c & 31)) * 2; }
__device__ __forceinline__ int v_rd_base(int lane) { return ((lane & 3) << 3) | (((lane >> 2) & 3) << 6) | (((lane >> 4) & 1) << 5) | (((lane >> 5) & 1) << 8); }
constexpr int v_rd_off(int d0, int ks, int half) { return d0 * 512 + ks * 4096 + half * 2048; }
__device__ __forceinline__ int crow(int r, int hi) { return (r & 3) + 8 * (r >> 2) + 4 * hi; }
__device__ __forceinline__ unsigned cvtpk(float lo, float hi) { unsigned r; asm volatile("v_cvt_pk_bf16_f32 %0, %1, %2" : "=v"(r) : "v"(lo), "v"(hi)); return r; }
__device__ __forceinline__ bf16x8 load8(const bf16* p) { return *reinterpret_cast<const bf16x8*>(p); }
__device__ __forceinline__ void mask_tile(f32x16& p0, f32x16& p1, int dq) {
    const float NEG = -__builtin_inff();
#pragma unroll
    for (int r = 0; r < 16; ++r) { const int c = (r & 3) + 8 * (r >> 2); if (dq - c < 0) p0[r] = NEG; if (dq - c - 32 < 0) p1[r] = NEG; }
}
__device__ __forceinline__ void mask_bits(f32x16& p0, f32x16& p1, unsigned w0, unsigned w1) {
    const float NEG = -__builtin_inff();
#pragma unroll
    for (int r = 0; r < 16; ++r) { const unsigned c = (r & 3) + 8 * (r >> 2); if (!(w0 & (1u << c))) p0[r] = NEG; if (!(w1 & (1u << c))) p1[r] = NEG; }
}
__device__ __forceinline__ void partialSM(f32x16& p0, f32x16& p1, float& m_reg, float& mn, float& alpha) {
    float pmax = p0[0]; for (int r = 1; r < 16; ++r) pmax = fmaxf(pmax, p0[r]); for (int r = 0; r < 16; ++r) pmax = fmaxf(pmax, p1[r]);
    { auto rr = __builtin_amdgcn_permlane32_swap(__float_as_uint(pmax), __float_as_uint(pmax), false, false);
      pmax = fmaxf(__uint_as_float(rr[0]), __uint_as_float(rr[1])); }
    constexpr float C2 = 1.4426950408889634f * SCALE;
    if (__builtin_expect(__all((pmax - m_reg) * SCALE <= THR), 1)) { mn = m_reg; alpha = 1.f; }
    else { mn = fmaxf(m_reg, pmax); alpha = __builtin_amdgcn_exp2f((m_reg - mn) * C2); m_reg = mn; }
    const float mnL = -mn * C2;
    for (int r = 0; r < 16; ++r) p0[r] = fmaf(p0[r], C2, mnL); for (int r = 0; r < 16; ++r) p1[r] = fmaf(p1[r], C2, mnL);
    for (int r = 0; r < 16; ++r) p0[r] = __builtin_amdgcn_exp2f(p0[r]);
}
__device__ __forceinline__ void finishSM(f32x16& p0, f32x16& p1, float alpha, float& l_reg, bf16x8& pa0, bf16x8& pa1, bf16x8& pa2, bf16x8& pa3) {
    for (int r = 0; r < 16; ++r) p1[r] = __builtin_amdgcn_exp2f(p1[r]);
    float ps = 0; for (int r = 0; r < 16; ++r) ps += p0[r]; for (int r = 0; r < 16; ++r) ps += p1[r];
    { auto rr = __builtin_amdgcn_permlane32_swap(__float_as_uint(ps), __float_as_uint(ps), false, false);
      ps = __uint_as_float(rr[0]) + __uint_as_float(rr[1]); }
    l_reg = l_reg * alpha + ps;
#define PK4(P, B_, OUT) do { unsigned a0 = cvtpk(P[B_+0], P[B_+1]), a1 = cvtpk(P[B_+2], P[B_+3]);                          \
        unsigned b0 = cvtpk(P[B_+4], P[B_+5]), b1 = cvtpk(P[B_+6], P[B_+7]);                                             \
        auto r0 = __builtin_amdgcn_permlane32_swap(a0, b0, false, false); auto r1 = __builtin_amdgcn_permlane32_swap(a1, b1, false, false); \
        u32x4 w = {r0[0], r1[0], r0[1], r1[1]}; OUT = *reinterpret_cast<bf16x8*>(&w); } while (0)
    PK4(p0, 0, pa0); PK4(p0, 8, pa1); PK4(p1, 0, pa2); PK4(p1, 8, pa3);
#undef PK4
}
template <int KB, bool BIAS>
__device__ __forceinline__ void qkt(f32x16& p0, f32x16& p1, const char* K_lds, int r32, int hi, const bf16x8* qr, const char* bl) {
    p0 = f32x16{}; p1 = f32x16{}; (void)bl;
    const char* kb[4];
#pragma unroll
    for (int dd = 0; dd < 4; ++dd) kb[dd] = K_lds + KB * SHM_K + KSWZ(r32, (dd * 16 + hi * 8) * 2);
#pragma unroll
    for (int d0 = 0; d0 < 8; ++d0) { const char* a = kb[d0 & 3] + (d0 >> 2) * 128;
        bf16x8 b0 = *reinterpret_cast<const bf16x8*>(a);
        bf16x8 b1 = *reinterpret_cast<const bf16x8*>(a + 32 * 256);
        p0 = __builtin_amdgcn_mfma_f32_32x32x16_bf16(b0, qr[d0], p0, 0, 0, 0);
        p1 = __builtin_amdgcn_mfma_f32_32x32x16_bf16(b1, qr[d0], p1, 0, 0, 0); }
}
template <int VB>
__device__ __forceinline__ void pv_tile(f32x16* o, int vb0, bf16x8 pa0, bf16x8 pa1, bf16x8 pa2, bf16x8 pa3) {
#define TRRD(dst, off) asm volatile("ds_read_b64_tr_b16 %0, %1 offset:%2" : "=&v"(dst) : "v"(vb0), "i"(off) : "memory")
#define PV_D0(d0) do { s16x4 l0, l1, l2, l3, h0, h1, h2, h3; constexpr int b_ = VB * SHM_V + v_rd_off(d0, 0, 0); \
        TRRD(l0, b_); TRRD(h0, b_ + 2048); TRRD(l1, b_ + 4096); TRRD(h1, b_ + 6144); TRRD(l2, b_ + 8192); TRRD(h2, b_ + 10240); TRRD(l3, b_ + 12288); TRRD(h3, b_ + 14336); \
        asm volatile("s_waitcnt lgkmcnt(0)" ::: "memory"); SBAR();   \
        o[d0] = __builtin_amdgcn_mfma_f32_32x32x16_bf16(pa0, (bf16x8){l0[0], l0[1], l0[2], l0[3], h0[0], h0[1], h0[2], h0[3]}, o[d0], 0, 0, 0);   \
        o[d0] = __builtin_amdgcn_mfma_f32_32x32x16_bf16(pa1, (bf16x8){l1[0], l1[1], l1[2], l1[3], h1[0], h1[1], h1[2], h1[3]}, o[d0], 0, 0, 0);   \
        o[d0] = __builtin_amdgcn_mfma_f32_32x32x16_bf16(pa2, (bf16x8){l2[0], l2[1], l2[2], l2[3], h2[0], h2[1], h2[2], h2[3]}, o[d0], 0, 0, 0);   \
        o[d0] = __builtin_amdgcn_mfma_f32_32x32x16_bf16(pa3, (bf16x8){l3[0], l3[1], l3[2], l3[3], h3[0], h3[1], h3[2], h3[3]}, o[d0], 0, 0, 0); } while (0)
    PV_D0(0); PV_D0(1); PV_D0(2); PV_D0(3);
#undef PV_D0
#undef TRRD
}
struct BlockRef { const bf16* Q; const bf16* K; const bf16* V; bf16* O; int P0; const float* fb; const unsigned long long* mrow; };
struct Seam { bf16x8 qr[8]; bf16x8 st_v0, st_v1, st_k0, st_k1; };
#define VMW() asm volatile("s_waitcnt vmcnt(0)" ::: "memory")
#define VMWN(n) asm volatile("s_waitcnt vmcnt(%0)" :: "i"(n) : "memory")
#define SLOAD_H(Kp, Vp, k0) do { const bf16* kt_ = (Kp) + (size_t)(k0) * KS; const bf16* vt_ = (Vp) + (size_t)(k0) * KS; S.st_v0 = load8(vt_ + koff); S.st_v1 = load8(vt_ + koff + 32 * KS); S.st_k0 = load8(kt_ + koff); S.st_k1 = load8(kt_ + koff + 32 * KS); } while (0)
#define SWRITE_HK(bf) do { *(bf16x8*)(K_lds + (bf) * SHM_K + kws) = S.st_k0; *(bf16x8*)(K_lds + (bf) * SHM_K + kws + 32 * 256) = S.st_k1; } while (0)
#define SWRITE_HV(bf) do { *(bf16x8*)(V_lds + (bf) * SHM_V + vst0) = S.st_v0; *(bf16x8*)(V_lds + (bf) * SHM_V + vst1) = S.st_v1; } while (0)
#define SWRITE_H(bf) do { SWRITE_HV(bf); SWRITE_HK(bf); } while (0)
template <bool BIAS, bool BITMASK, int QS, int KS, int OS>
__device__ __forceinline__ void attn_block(const BlockRef& cur, char* lds, LAS unsigned char* ldsl) {
    int tid_ = threadIdx.x; asm volatile("" : "+v"(tid_));
    const int tid = tid_, wid = __builtin_amdgcn_readfirstlane(tid >> 6), lane = tid & 63, r32 = lane & 31, hi = lane >> 5;
    const int NT = (cur.P0 + QB - 1) / KVBLK + 1;
    const int qlo = cur.P0 + wid * QBLK, qm = qlo + r32 - 4 * hi;
    char* V_lds = lds; char* K_lds = lds + 2 * SHM_V;
    float* ws = (float*)(lds + OFF_WS) + wid * 64; float* li_l = ws, * al_l = ws + 32;
    const LAS unsigned char* bl0 = ldsl + OFF_BIAS + hi * 16;
    float m_reg = -1e30f, l_reg = 0; f32x16 o[4] = {};
    const int sr = tid >> 4, sc = (tid & 15) * 8, vst0 = v_st(sr, sc), vst1 = v_st(32 + sr, sc), kws = KSWZ(sr, sc * 2);
    const int vb0 = (int)(uintptr_t)V_lds + v_rd_base(lane);
    const bf16* Kh = cur.K; const bf16* Vh = cur.V;
    const int moff = (wid * QBLK + r32) * 64, koff = sr * KS + sc, qoff = (wid * QBLK + r32) * QS + hi * 8;
    Seam S;
#pragma unroll
    for (int d0 = 0; d0 < 8; ++d0) S.qr[d0] = load8(cur.Q + qoff + d0 * 16);
    if constexpr (BIAS) { const f32x4 b0_ = *(const f32x4*)(cur.fb + tid * 8), b1_ = *(const f32x4*)(cur.fb + tid * 8 + 4);
        *(LAS f32x4*)(ldsl + OFF_BIAS + tid * 32) = b0_; *(LAS f32x4*)(ldsl + OFF_BIAS + tid * 32 + 16) = b1_; }
    SLOAD_H(Kh, Vh, 0); VMW(); SWRITE_HK(0); SWRITE_HV(0); SBAR();
#define RESC(a) do { if (__any((a) < 1.f)) { if (hi == 0) al_l[r32] = (a); asm volatile("s_waitcnt lgkmcnt(0)" ::: "memory");              \
                     for (int d_ = 0; d_ < 4; ++d_) for (int r = 0; r < 16; ++r) o[d_][r] *= al_l[crow(r, hi)]; } } while (0)
#define KBASE(t) ((t) * KVBLK)
#define MLOAD(MW, t) do { if constexpr (BITMASK) MW = (cur.mrow + (t))[moff]; } while (0)
#define MASKT(P0_, P1_, MW, t) do { if constexpr (BIAS) { const LAS unsigned char* bl_ = bl0 + KBASE(t) * 4; _Pragma("unroll") for (int g = 0; g < 4; ++g) { const f32x4 a_ = *(const LAS f32x4*)(bl_ + g * 32), b_ = *(const LAS f32x4*)(bl_ + 128 + g * 32); \
            P0_[4 * g] += a_[0]; P0_[4 * g + 1] += a_[1]; P0_[4 * g + 2] += a_[2]; P0_[4 * g + 3] += a_[3]; P1_[4 * g] += b_[0]; P1_[4 * g + 1] += b_[1]; P1_[4 * g + 2] += b_[2]; P1_[4 * g + 3] += b_[3]; } } \
        if constexpr (BITMASK) { mask_bits(P0_, P1_, (unsigned)(MW) >> (4 * hi), (unsigned)((MW) >> 32) >> (4 * hi)); } \
        else { const int kb_ = KBASE(t); if (kb_ + KVBLK - 1 > qlo) mask_tile(P0_, P1_, qm - kb_); } } while (0)
    f32x16 pA0, pA1, pB0, pB1; float mnA, mnB, alA, alB; bf16x8 pa0, pa1, pa2, pa3; unsigned long long mwA = 0, mwB = 0;
    MLOAD(mwA, 0);
    SLOAD_H(Kh, Vh, KBASE(1)); MLOAD(mwB, 1);
    __syncthreads();
    SBAR(); qkt<0, BIAS>(pA0, pA1, K_lds, r32, hi, S.qr, nullptr);
    MASKT(pA0, pA1, mwA, 0); partialSM(pA0, pA1, m_reg, mnA, alA);
    VMW(); SWRITE_H(1);
    __syncthreads();
#define HALF_STEP(PX0, PX1, mnX, alX, MWX, PY0, PY1, alY, MWY, t, KB, VB, SB) do {                                            \
        SBAR(); qkt<KB, BIAS>(PX0, PX1, K_lds, r32, hi, S.qr, nullptr);                                                       \
        finishSM(PY0, PY1, alY, l_reg, pa0, pa1, pa2, pa3); SBAR();                                                           \
        if ((t) + 1 < NT) { SLOAD_H(Kh, Vh, KBASE((t) + 1)); MLOAD(MWY, (t) + 1); SBAR(); }                                   \
        pv_tile<VB>(o, vb0, pa0, pa1, pa2, pa3); MASKT(PX0, PX1, MWX, (t)); partialSM(PX0, PX1, m_reg, mnX, alX);             \
        __syncthreads();                                                                                                      \
        if ((t) + 1 < NT) { VMW(); SWRITE_H(SB); }                                                                            \
        RESC(alX); __syncthreads(); } while (0)
    for (int t = 1; t + 1 < NT; t += 2) {
        HALF_STEP(pB0, pB1, mnB, alB, mwB, pA0, pA1, alA, mwA, t, 1, 0, 0);
        HALF_STEP(pA0, pA1, mnA, alA, mwA, pB0, pB1, alB, mwB, t + 1, 0, 1, 1);
    }
    SBAR(); qkt<1, BIAS>(pB0, pB1, K_lds, r32, hi, S.qr, nullptr); SBAR();
    finishSM(pA0, pA1, alA, l_reg, pa0, pa1, pa2, pa3); SBAR();
    pv_tile<0>(o, vb0, pa0, pa1, pa2, pa3);
    MASKT(pB0, pB1, mwB, NT - 1); partialSM(pB0, pB1, m_reg, mnB, alB); __syncthreads(); RESC(alB);
    finishSM(pB0, pB1, alB, l_reg, pa0, pa1, pa2, pa3); SBAR(); pv_tile<1>(o, vb0, pa0, pa1, pa2, pa3);
    SBAR();
    if (hi == 0) li_l[r32] = l_reg; asm volatile("s_waitcnt lgkmcnt(0)" ::: "memory");
    float rli[16];
#pragma unroll
    for (int r = 0; r < 16; ++r) rli[r] = __builtin_amdgcn_rcpf(li_l[crow(r, hi)]);
    int tid2_ = threadIdx.x; asm volatile("" : "+v"(tid2_));
    const int r32e = tid2_ & 31, hie = (tid2_ >> 5) & 1, ooff = (wid * QBLK + 4 * hie) * OS + r32e;
#pragma unroll
    for (int r = 0; r < 16; ++r) {
#pragma unroll
        for (int d0 = 0; d0 < 4; ++d0) { const float v = o[d0][r] * rli[r]; const float vn = __shfl_xor(v, 1);
            if ((r32e & 1) == 0) *(unsigned*)(cur.O + ((r & 3) + 8 * (r >> 2)) * OS + d0 * 32 + ooff) = cvtpk(v, vn); } }
    __syncthreads();
#undef RESC
#undef KBASE
#undef MLOAD
#undef MASKT
#undef HALF_STEP
}
#undef ROWK
#undef VMW
#undef VMWN
#undef SLOAD_H
#undef SWRITE_HK
#undef SWRITE_HV
#undef SWRITE_H
#undef KSWZ
#undef SBAR
template <bool BIAS, bool BITMASK, int NH, int GROUP, bool PAIR, int QS, int KS, int OS>
__device__ __forceinline__ void attn_phase(char* lds, LAS unsigned char* ldsl, const bf16* Q, const bf16* K, const bf16* V, bf16* O, const float* fbias, const unsigned long long* mask, int G, int bid) {
    constexpr int NBLK = BATCH * NH * 16, NITEM = PAIR ? NBLK / 2 : NBLK, PER = PAIR ? 8 : 16, SETH = BATCH * NH / 8;
    for (int L = bid; L < NITEM; L += G) {
#pragma unroll 1
        for (int pass = 0; pass < (PAIR ? 2 : 1); ++pass) {
            const int g = L & 7, k = L >> 3, hs = k / PER, x = k % PER; const int bh = g * SETH + hs, b = bh / NH, h = bh % NH;
            const int qb = PAIR ? (pass ? 15 - x : x) : 15 - x; BlockRef r; const size_t row0 = (size_t)b * SEQ + (size_t)qb * QB;
            r.Q = Q + row0 * QS + h * D; r.O = O + row0 * OS + h * D; r.K = K + (size_t)b * SEQ * KS + (h / GROUP) * D; r.V = V + (size_t)b * SEQ * KS + (h / GROUP) * D; r.P0 = qb * QB;
            r.fb = BIAS ? fbias + (size_t)bh * SEQ : nullptr; r.mrow = BITMASK ? mask + row0 * 64 : nullptr;
            attn_block<BIAS, BITMASK, QS, KS, OS>(r, lds, ldsl);
        }
    }
}
}
__device__ __forceinline__ float fast_silu(float g) { return g * __builtin_amdgcn_rcpf(1.0f + __expf(-g)); }
__device__ __forceinline__ void ph_gla_a(Frame& F, const Args& a) {
    const float* SK0 = (const float*)(F.ws + WS_SK0); const float* w2 = a.in[2]; const float* gbias = a.in[3]; float* GB = (float*)(F.ws + WS_GB); float* DEC = (float*)(F.ws + WS_DEC);
    const bf16* PROJ = (const bf16*)(F.ws + WS_PROJ); float* CST = (float*)(F.ws + WS_CST);
    LAS float* BSH = (LAS float*)F.lds; LAS float* TOT = BSH + 64 * 128; LAS bf16* VT = (LAS bf16*)(F.lds + 36864); LAS bf16* KET = (LAS bf16*)(F.lds + 73728);
    const int tid = F.tid, lane = F.lane, l15 = lane & 15, quad = lane >> 4, w = F.wave;
    for (int unit = blockIdx.x; unit < 512; unit += F.G) {
        const int n = unit & 63, bh = unit >> 6, b = bh >> 2, h = bh & 3, t0 = b * SEQ + n * 64;
        __syncthreads();
        {
            const int d = tid & 127, cg = tid >> 7; float wv[16];
#pragma unroll
            for (int r = 0; r < 16; ++r) wv[r] = w2[r * 512 + h * 128 + d];
            const float gb = gbias[h * 128 + d]; float run = 0.f;
            for (int cc = 0; cc < 16; ++cc) { const int c = cg * 16 + cc; const float* sk = SK0 + (size_t)(t0 + c) * 24; float z = gb;
#pragma unroll
                for (int r = 0; r < 16; ++r) z += sk[r] * wv[r];
                run += logsigmoidf(z) * (1.0f / 16.0f); BSH[c * 128 + d] = run; }
            TOT[cg * 128 + d] = run;
            __syncthreads();
            float pre = 0.f;
            for (int g = 0; g < cg; ++g) pre += TOT[g * 128 + d];
            for (int cc = 0; cc < 16; ++cc) { const int c = cg * 16 + cc; const float v = BSH[c * 128 + d] + pre; BSH[c * 128 + d] = v; GB[(size_t)(t0 + c) * 512 + h * 128 + d] = v; }
        }
        __syncthreads();
        {
            const int c = tid & 63, g8 = tid >> 6; const size_t t = (size_t)(t0 + c);
            const bf16* kp = PROJ + t * NP0 + 512 + h * 128 + g8 * 16;
            const v4u k0 = *(const v4u*)kp, k1 = *(const v4u*)(kp + 8);
            const unsigned kw[8] = {k0.x, k0.y, k0.z, k0.w, k1.x, k1.y, k1.z, k1.w};
#pragma unroll
            for (int i = 0; i < 8; ++i) { const int d = g8 * 16 + 2 * i; const float e0 = __expf(BSH[63 * 128 + d] - BSH[c * 128 + d]), e1 = __expf(BSH[63 * 128 + d + 1] - BSH[c * 128 + d + 1]);
                KET[d * 72 + c] = (bf16)f2bf(bf2f(kw[i] & 0xffff) * e0); KET[(d + 1) * 72 + c] = (bf16)f2bf(bf2f(kw[i] >> 16) * e1); }
            const bf16* vp = PROJ + t * NP0 + 1024 + h * 256 + g8 * 32;
#pragma unroll
            for (int q = 0; q < 4; ++q) { const v4u vv = *(const v4u*)(vp + 8 * q); const unsigned vw[4] = {vv.x, vv.y, vv.z, vv.w};
#pragma unroll
                for (int i = 0; i < 4; ++i) { const int v = g8 * 32 + q * 8 + 2 * i; VT[v * 72 + c] = (bf16)(vw[i] & 0xffff); VT[(v + 1) * 72 + c] = (bf16)(vw[i] >> 16); } }
            if (tid < 128) DEC[unit * 128 + tid] = __expf(BSH[63 * 128 + tid]);
        }
        __syncthreads();
        {
            pg8::f32x4 acc[2][8];
#pragma unroll
            for (int i = 0; i < 2; ++i)
#pragma unroll
                for (int nn = 0; nn < 8; ++nn) acc[i][nn] = (pg8::f32x4){0.f, 0.f, 0.f, 0.f};
#pragma unroll
            for (int kk = 0; kk < 64; kk += 32) {
                const bf16x8 a0 = *(const LAS bf16x8*)(VT + (32 * w + l15) * 72 + kk + quad * 8), a1 = *(const LAS bf16x8*)(VT + (32 * w + 16 + l15) * 72 + kk + quad * 8);
#pragma unroll
                for (int nn = 0; nn < 8; ++nn) { const bf16x8 bb = *(const LAS bf16x8*)(KET + (16 * nn + l15) * 72 + kk + quad * 8);
                    acc[0][nn] = __builtin_amdgcn_mfma_f32_16x16x32_bf16(a0, bb, acc[0][nn], 0, 0, 0); acc[1][nn] = __builtin_amdgcn_mfma_f32_16x16x32_bf16(a1, bb, acc[1][nn], 0, 0, 0); } }
            float* cp = CST + (size_t)unit * 32768;
#pragma unroll
            for (int i = 0; i < 2; ++i)
#pragma unroll
                for (int nn = 0; nn < 8; ++nn)
#pragma unroll
                    for (int j = 0; j < 4; ++j) cp[(32 * w + 16 * i + quad * 4 + j) * 128 + 16 * nn + l15] = acc[i][nn][j];
        }
    }
    __syncthreads();
}
__device__ __forceinline__ void ph_gla_c(Frame& F, const Args& a) {
    const bf16* PROJ = (const bf16*)(F.ws + WS_PROJ); const float* GB = (const float*)(F.ws + WS_GB); const bf16* PREVT = (const bf16*)(F.ws + WS_PREVT); const float* normg = a.in[4]; bf16* OMIX = (bf16*)(F.ws + WS_OMIX);
    LAS bf16* QD = (LAS bf16*)(F.lds + 32768); LAS bf16* KI = (LAS bf16*)(F.lds + 50176); LAS bf16* P = (LAS bf16*)(F.lds + 67584); LAS bf16* VT = (LAS bf16*)(F.lds + 76800); LAS float* RED = (LAS float*)(F.lds + 113664);
    const int tid = F.tid, lane = F.lane, l15 = lane & 15, quad = lane >> 4, w = F.wave;
    for (int unit = blockIdx.x; unit < 512; unit += F.G) {
        const int n = unit & 63, bh = unit >> 6, b = bh >> 2, h = bh & 3, t0 = b * SEQ + n * 64;
        __syncthreads();
        {
            const int c = tid >> 3, dg = tid & 7; const size_t t = (size_t)(t0 + c);
            const float* bp = GB + t * 512 + h * 128 + dg * 16; const bf16* qp = PROJ + t * NP0 + h * 128 + dg * 16; const bf16* kp = PROJ + t * NP0 + 512 + h * 128 + dg * 16;
#pragma unroll
            for (int q8 = 0; q8 < 2; ++q8) { const v4u qq = *(const v4u*)(qp + 8 * q8), kk = *(const v4u*)(kp + 8 * q8); const f32x4 b0 = *(const f32x4*)(bp + 8 * q8), b1 = *(const f32x4*)(bp + 8 * q8 + 4);
                const unsigned qw[4] = {qq.x, qq.y, qq.z, qq.w}, kw[4] = {kk.x, kk.y, kk.z, kk.w}; const float bv[8] = {b0[0], b0[1], b0[2], b0[3], b1[0], b1[1], b1[2], b1[3]};
                v4u oq, ok; unsigned* oqp = (unsigned*)&oq; unsigned* okp = (unsigned*)&ok;
#pragma unroll
                for (int i = 0; i < 4; ++i) { const float e0 = __expf(bv[2 * i]), e1 = __expf(bv[2 * i + 1]);
                    oqp[i] = pk2(bf2f(qw[i] & 0xffff) * ATT_SCALE * e0, bf2f(qw[i] >> 16) * ATT_SCALE * e1);
                    okp[i] = pk2(bf2f(kw[i] & 0xffff) * __builtin_amdgcn_rcpf(e0), bf2f(kw[i] >> 16) * __builtin_amdgcn_rcpf(e1)); }
                *(LAS v4u*)(QD + c * 136 + dg * 16 + 8 * q8) = oq; *(LAS v4u*)(KI + c * 136 + dg * 16 + 8 * q8) = ok; }
            const int c2 = tid & 63, g8 = tid >> 6; const bf16* vp = PROJ + (size_t)(t0 + c2) * NP0 + 1024 + h * 256 + g8 * 32;
#pragma unroll
            for (int q = 0; q < 4; ++q) { const v4u vv = *(const v4u*)(vp + 8 * q); const unsigned vw[4] = {vv.x, vv.y, vv.z, vv.w};
#pragma unroll
                for (int i = 0; i < 4; ++i) { const int v = g8 * 32 + q * 8 + 2 * i; VT[v * 72 + c2] = (bf16)(vw[i] & 0xffff); VT[(v + 1) * 72 + c2] = (bf16)(vw[i] >> 16); } }
        }
        __syncthreads();
        {
            const int ti = w >> 1;
#pragma unroll
            for (int s = 0; s < 2; ++s) { const int tj = 2 * (w & 1) + s; pg8::f32x4 acc = (pg8::f32x4){0.f, 0.f, 0.f, 0.f};
                if (tj <= ti) {
#pragma unroll
                    for (int kk = 0; kk < 128; kk += 32) { const bf16x8 aa = *(const LAS bf16x8*)(QD + (16 * ti + l15) * 136 + kk + quad * 8), bb = *(const LAS bf16x8*)(KI + (16 * tj + l15) * 136 + kk + quad * 8);
                        acc = __builtin_amdgcn_mfma_f32_16x16x32_bf16(aa, bb, acc, 0, 0, 0); } }
#pragma unroll
                for (int j = 0; j < 4; ++j) { const int i = 16 * ti + quad * 4 + j, jj = 16 * tj + l15; P[i * 72 + jj] = (bf16)f2bf(jj <= i ? acc[j] : 0.f); } }
        }
        __syncthreads();
        {
            const int ti = w >> 1, half = w & 1; pg8::f32x4 acc[8];
#pragma unroll
            for (int nn = 0; nn < 8; ++nn) acc[nn] = (pg8::f32x4){0.f, 0.f, 0.f, 0.f};
#pragma unroll
            for (int kk = 0; kk < 64; kk += 32) { const bf16x8 aa = *(const LAS bf16x8*)(P + (16 * ti + l15) * 72 + kk + quad * 8);
#pragma unroll
                for (int nn = 0; nn < 8; ++nn) { const bf16x8 bb = *(const LAS bf16x8*)(VT + (128 * half + 16 * nn + l15) * 72 + kk + quad * 8); acc[nn] = __builtin_amdgcn_mfma_f32_16x16x32_bf16(aa, bb, acc[nn], 0, 0, 0); } }
            const bf16* pv = PREVT + (size_t)unit * 32768 + (size_t)(128 * half + l15) * 128 + quad * 8;
#pragma unroll
            for (int kk = 0; kk < 128; kk += 32) { const bf16x8 aa = *(const LAS bf16x8*)(QD + (16 * ti + l15) * 136 + kk + quad * 8);
#pragma unroll
                for (int nn = 0; nn < 8; ++nn) { const bf16x8 bb = *(const bf16x8*)(pv + (size_t)(16 * nn) * 128 + kk); acc[nn] = __builtin_amdgcn_mfma_f32_16x16x32_bf16(aa, bb, acc[nn], 0, 0, 0); } }
            float ss[4];
#pragma unroll
            for (int j = 0; j < 4; ++j) { float s = 0.f;
#pragma unroll
                for (int nn = 0; nn < 8; ++nn) s += acc[nn][j] * acc[nn][j];
                s += __shfl_xor(s, 1); s += __shfl_xor(s, 2); s += __shfl_xor(s, 4); s += __shfl_xor(s, 8); ss[j] = s; }
            if (l15 == 0) {
#pragma unroll
                for (int j = 0; j < 4; ++j) RED[(16 * ti + quad * 4 + j) * 2 + half] = ss[j]; }
            __syncthreads();
#pragma unroll
            for (int j = 0; j < 4; ++j) { const int i = 16 * ti + quad * 4 + j; const float ms = (RED[i * 2] + RED[i * 2 + 1]) * (1.0f / 256.0f); const float rs = 1.0f / sqrtf(ms + LN_EPS);
                const size_t t = (size_t)(t0 + i);
#pragma unroll
                for (int nn = 0; nn < 8; ++nn) { const int v = 128 * half + 16 * nn + l15; const float gr = bf2f(PROJ[t * NP0 + 2048 + h * 256 + v]);
                    OMIX[t * DM + h * 256 + v] = (bf16)f2bf(acc[nn][j] * rs * normg[v] * fast_silu(gr)); } }
        }
    }
    __syncthreads();
}
__device__ __forceinline__ void ph_indexer(Frame& F, unsigned char* lds_generic) {
    typedef float f32x16 __attribute__((ext_vector_type(16)));
    const bf16* PROJ1 = (const bf16*)(F.ws + WS_PROJ); const bf16* IK = (const bf16*)(F.ws + WS_IK); const float* IW = (const float*)(F.ws + WS_IW); unsigned long long* MASK = (unsigned long long*)(F.ws + WS_MASK);
    LAS float* SCL = (LAS float*)F.lds;
    const int lane = F.lane, w = F.wave, c32 = lane & 31, hi = lane >> 5, rt = w & 3, kpar = w >> 2;
    for (int it = blockIdx.x; it < 512; it += F.G) {
#pragma unroll 1
        for (int pass = 0; pass < 2; ++pass) {
            const int unit = pass ? 1023 - it : it, m0 = unit * 8, b = m0 >> 12, qmax = (m0 & 4095) + 7;
            __syncthreads();
            {
                const int qa = m0 + 2 * rt + ((c32 >> 2) & 1), ha = (c32 & 3) + 4 * (c32 >> 3);
                const bf16* ap = PROJ1 + (size_t)qa * NP1 + 3072 + ha * 64 + 8 * hi;
                bf16x8 af[4];
#pragma unroll
                for (int ks = 0; ks < 4; ++ks) af[ks] = *(const bf16x8*)(ap + 16 * ks);
                const float* wp = IW + (size_t)(m0 + 2 * rt + hi) * 16; float wv[16];
#pragma unroll
                for (int q4 = 0; q4 < 4; ++q4) { const f32x4 t4 = *(const f32x4*)(wp + 4 * q4); wv[4 * q4] = t4[0]; wv[4 * q4 + 1] = t4[1]; wv[4 * q4 + 2] = t4[2]; wv[4 * q4 + 3] = t4[3]; }
                LAS float* srow = SCL + (2 * rt + hi) * 4096 + c32;
                const bf16* kbase = IK + (size_t)b * SEQ * 64 + (size_t)c32 * 64 + 8 * hi;
                for (int t = kpar; t * 32 <= qmax; t += 2) {
                    const bf16* kp = kbase + (size_t)t * 32 * 64; f32x16 acc = {};
#pragma unroll
                    for (int ks = 0; ks < 4; ++ks) { const bf16x8 bfr = *(const bf16x8*)(kp + 16 * ks); acc = __builtin_amdgcn_mfma_f32_32x32x16_bf16(af[ks], bfr, acc, 0, 0, 0); }
                    float s = 0.f;
#pragma unroll
                    for (int r = 0; r < 16; ++r) s += wv[r] * fmaxf(acc[r], 0.f);
                    srow[t * 32] = s; }
            }
            __syncthreads();
            { const int m = m0 + w; topk_mask_row((const float*)(lds_generic + w * 16384), m & 4095, MASK + (size_t)m * 64, lane); }
        }
    }
    __syncthreads();
}
#define IN(k) (lo <= (k) && (k) < hi)
#define SEAM(k) do { if (hi > (k) + 1) xcd_barrier(bar); } while (0)
template <int LAYER, int BASE>
__device__ __forceinline__ void common_phases(Frame& F, const Args& args, const int lo, const int hi, const XcdBarrier& bar) {
    unsigned char* ws = args.ws;
    if (IN(BASE + 0)) {
        pg8::Gemm g{(const bf16*)(ws + WS_OMIX), (const bf16*)(ws + (LAYER ? WS_WOC : WS_WOA)), MTOK, DM, DM}; pg8::StaticOrder S; S.init(MTOK, DM, F.G, (int)blockIdx.x);
        pg8::EpiResid E{LAYER ? (const float*)(ws + WS_XR) : args.in[0], (float*)(ws + WS_XR), DN_ALPHA};
        pg8::gemm_phase<pg8::EpiResid, pg8::StaticOrder, true, true>(F.lds, g, S, E);
        SEAM(BASE + 0);
    }
    if (IN(BASE + 1)) { p_ln_route(F, args, LAYER); SEAM(BASE + 1); }
    if (IN(BASE + 2)) { p_gather(F, LAYER); SEAM(BASE + 2); }
    if (IN(BASE + 3) || IN(BASE + 4)) {
        if (F.wave == 0) { int ti; (void)moe_offsets(F.ctl + CW_CNT + LAYER * 64, F.lane, &ti); if (F.lane < 32) F.MISC[64 + F.lane] = (unsigned)ti; if (F.lane == 31) F.MISC[96] = (unsigned)ti; }
        __syncthreads();
    }
    if (IN(BASE + 3)) {
        pg8::Gemm g{(const bf16*)(ws + WS_PROJ), (const bf16*)(ws + WS_WGU) + (size_t)LAYER * 32 * 1024 * 2048, RPAD, 32 * 1024, DM};
        pg8::MoeOrder S{F.G, (int)blockIdx.x, 4, (int)F.MISC[96], (const LAS int*)(F.lds + LDSCTL_OFF + 64 * 4)};
        pg8::EpiGLU E{(bf16*)(ws + WS_OMIX), (const float*)(ws + WS_ROWW)};
        pg8::gemm_phase<pg8::EpiGLU, pg8::MoeOrder, true, true>(F.lds, g, S, E);
        SEAM(BASE + 3);
    }
    if (IN(BASE + 4)) {
        pg8::Gemm g{(const bf16*)(ws + WS_OMIX), (const bf16*)(ws + WS_WD) + (size_t)LAYER * 32 * 2048 * 512, RPAD, 32 * 2048, 512};
        pg8::MoeOrder S{F.G, (int)blockIdx.x, 8, (int)F.MISC[96], (const LAS int*)(F.lds + LDSCTL_OFF + 64 * 4)};
        pg8::EpiBf16Plain E{(bf16*)(ws + WS_CST), DM, 7};
        pg8::gemm_phase<pg8::EpiBf16Plain, pg8::MoeOrder, true, true>(F.lds, g, S, E);
        SEAM(BASE + 4);
    }
    if (IN(BASE + 5)) { p_ln_ffn(F, args, LAYER); SEAM(BASE + 5); }
}
__global__ void __launch_bounds__(NWAVES * 64, 2) mk_fwd(Args args) {
    extern __shared__ __attribute__((aligned(16))) unsigned char lds[];
    Frame F;
    F.lds = (LAS unsigned char*)lds; F.MISC = (volatile LAS unsigned*)(F.lds + LDSCTL_OFF);
    F.tid = threadIdx.x; F.lane = F.tid & 63; F.wave = __builtin_amdgcn_readfirstlane(F.tid >> 6);
    F.G = gridDim.x; F.gw = blockIdx.x * NWAVES + F.wave; F.NGW = F.G * NWAVES;
    F.ws = args.ws; F.ctl = (unsigned*)(args.ws + WS_CTL);
    for (int u = F.tid; u < (LDS_BYTES - LDSCTL_OFF) / 4; u += NWAVES * 64) ((LAS unsigned*)(F.lds + LDSCTL_OFF))[u] = 0u;
    __syncthreads();
    const int lo = args.ph_lo, hi = args.ph_hi;
    XcdBarrier bar; bar.bar = F.ctl + CW_BAR; bar.x = 0; bar.st = nullptr;
    if (hi - lo > 1) bar = xcd_barrier_post(F.ctl + CW_BAR, F.MISC);
    unsigned char* ws = args.ws;

    if (IN(0)) { p0_prologue(F, args); SEAM(0); }
    if (IN(1)) {
        pg8::Gemm g{(const bf16*)(ws + WS_XB), (const bf16*)(ws + WS_WINA), MTOK, NP0, DM}; pg8::StaticOrder S; S.init(MTOK, NP0, F.G, (int)blockIdx.x);
        pg8::EpiBf16Plain E{(bf16*)(ws + WS_PROJ), NP0, 0x7fffffff};
        pg8::gemm_phase<pg8::EpiBf16Plain, pg8::StaticOrder, true, true>(F.lds, g, S, E);
        SEAM(1);
    }
    if (IN(2)) { p_fox_bias(F, args); ph_gla_a(F, args); SEAM(2); }
    if (IN(4)) { ph_gla_scan(F); __syncthreads();
        attn::attn_phase<true, false, 8, 1, false, NP0, NP0, DM>((char*)lds, F.lds, (const bf16*)(ws + WS_PROJ) + 3072, (const bf16*)(ws + WS_PROJ) + 4096, (const bf16*)(ws + WS_PROJ) + 5120,
                                                               (bf16*)(ws + WS_OMIX) + 1024, (const float*)(ws + WS_FBIAS), (const unsigned long long*)nullptr, F.G, (int)blockIdx.x);
        SEAM(4); }
    if (IN(5)) { ph_gla_c(F, args); SEAM(5); }
    common_phases<0, 6>(F, args, lo, hi, bar);
    if (IN(12)) {
        pg8::Gemm g{(const bf16*)(ws + WS_XB), (const bf16*)(ws + WS_WINC), MTOK, NP1, DM}; pg8::StaticOrder S; S.init(MTOK, NP1, F.G, (int)blockIdx.x);
        const float* c128 = (const float*)(ws + WS_ROPE);
        pg8::EpiRope E{(bf16*)(ws + WS_PROJ), c128, c128 + 4096 * 64, c128 + 2 * 4096 * 64, c128 + 2 * 4096 * 64 + 4096 * 32};
        pg8::gemm_phase<pg8::EpiRope, pg8::StaticOrder, true, true>(F.lds, g, S, E);
        SEAM(12);
    }
    if (IN(13)) { ph_indexer(F, lds); SEAM(13); }
    if (IN(15)) {
        attn::attn_phase<false, true, 16, 4, true, NP1, NP1, DM>((char*)lds, F.lds, (const bf16*)(ws + WS_PROJ), (const bf16*)(ws + WS_PROJ) + 2048, (const bf16*)(ws + WS_PROJ) + 2560,
                                                               (bf16*)(ws + WS_OMIX), (const float*)nullptr, (const unsigned long long*)(ws + WS_MASK), F.G, (int)blockIdx.x);
        SEAM(15); }
    common_phases<1, 16>(F, args, lo, hi, bar);
}
#undef IN
#undef SEAM
constexpr int N_PHASE_IDS = 22;
static void launch_mk(const Args& base, int lo, int hi, int grid, hipStream_t stream) {
    Args a = base; a.ph_lo = lo; a.ph_hi = hi;
    hipLaunchKernelGGL(mk_fwd, dim3(grid), dim3(NWAVES * 64), LDS_BYTES, stream, a);
}
extern "C" void kernel_launch(void* const* d_in, const int* in_sizes, int n_in, void* d_out, int out_size, void* d_ws, size_t ws_size, hipStream_t stream) {
    static int grid = 0;
    if (grid == 0) {
        if (n_in != 20 || out_size != MTOK * DM || ws_size < WS_END) { fprintf(stderr, "kernel_launch: unexpected shapes (n_in %d, out %d, ws %zu < %zu)\n", n_in, out_size, ws_size, (size_t)WS_END); grid = -1; return; }
        int dev = 0, cus = 0, per_cu = 0;
        if (hipGetDevice(&dev) != hipSuccess || hipDeviceGetAttribute(&cus, hipDeviceAttributeMultiprocessorCount, dev) != hipSuccess) { grid = -1; return; }
        if (hipFuncSetAttribute((const void*)mk_fwd, hipFuncAttributeMaxDynamicSharedMemorySize, LDS_BYTES) != hipSuccess) { fprintf(stderr, "kernel_launch: hipFuncSetAttribute failed\n"); grid = -1; return; }
        if (hipOccupancyMaxActiveBlocksPerMultiprocessor(&per_cu, (const void*)mk_fwd, NWAVES * 64, LDS_BYTES) != hipSuccess || per_cu < 1) { fprintf(stderr, "kernel_launch: occupancy query reports %d workgroups per CU\n", per_cu); }
        (void)hipGetLastError();
        grid = cus;
    }
    if (grid < 0) return;
    (void)in_sizes;
    if (hipMemsetAsync((char*)d_ws + WS_CTL, 0, CTL_ZERO_BYTES, stream) != hipSuccess) return;
    Args a{};
    for (int i = 0; i < 20; ++i) a.in[i] = (const float*)d_in[i];
    a.out = (float*)d_out; a.ws = (unsigned char*)d_ws;
    launch_mk(a, 0, N_PHASE_IDS, grid, stream);
}
```

```cpp
#include <hip/hip_runtime.h>
#include <cstdio>
#include <cstdint>
namespace pg8 {
#define PG8_LAS __attribute__((address_space(3)))
typedef unsigned short bf16_t;
typedef short bf16x8 __attribute__((ext_vector_type(8)));
typedef float f32x4 __attribute__((ext_vector_type(4)));
typedef unsigned u32x4 __attribute__((ext_vector_type(4)));
constexpr int BM = 256, BK = 64, HALF = 128, HTB = HALF * BK * 2  , STAGE_BYTES = 8 * HTB, NXCD = 8, WGM = 8;

__host__ __device__ __forceinline__ int lds_byte(int r, int c) { const int st = (r >> 4) * 2 + (c >> 5), rr = r & 15, cc = c & 31, ob = rr * 64 + cc * 2; return st * 1024 + (ob ^ (((ob >> 9) & 1) << 5)); }
__host__ __device__ __forceinline__ void stage_rc(int b, int& R, int& C) { const int st = b / 1024, sb = b % 1024, swz = sb ^ (((sb >> 9) & 1) << 5); R = (st >> 1) * 16 + swz / 64; C = (st & 1) * 32 + (swz % 64) / 2; }
__host__ __device__ __forceinline__ int perm32(int rho) { const int n = rho >> 4, i = rho & 15; return 8 * (i >> 2) + 4 * n + (i & 3); }

struct Unit { int pm, pn; };
struct Gemm { const bf16_t* A; const bf16_t* Bt; int M, N, K; };

struct StaticOrder {
    int nM, nN, nwg, G, c;
    __host__ __device__ void init(int M, int N, int G_, int c_) { nM = M / BM; nN = N / BM; nwg = nM * nN; G = G_; c = c_; }
    __host__ __device__ bool next(int i, Unit& u) const {
        const long L = (long)i * G + c; if (L >= nwg) return false;
        int wgid = (int)L; { const int q = nwg / NXCD, r = nwg % NXCD, xcd = wgid % NXCD, off = wgid / NXCD; wgid = (xcd < r ? xcd * (q + 1) : r * (q + 1) + (xcd - r) * q) + off; }
        const int nig = WGM * nN, gid = wgid / nig, fm = gid * WGM, gsz = (nM - fm) < WGM ? (nM - fm) : WGM;
        u.pm = fm + ((wgid % nig) % gsz); u.pn = (wgid % nig) / gsz; return true;
    }
    __device__ __forceinline__ void a_ready(const Unit&) const {}
    __device__ __forceinline__ void done(const Unit&) const {}
};

__device__ __forceinline__ unsigned cvt_pk_bf16(float lo, float hi) { unsigned r; asm volatile("v_cvt_pk_bf16_f32 %0, %1, %2" : "=v"(r) : "v"(lo), "v"(hi)); return r; }
typedef float f32x2 __attribute__((ext_vector_type(2)));
struct EpiBf16Plain {
    static constexpr bool PERM = true, AFTER_DRAIN = false;
    bf16_t* O; int ldc; int pn_mask;
    __device__ __forceinline__ void operator()(const f32x4 (&acc)[2][2][4][2], const Unit& u, int wr, int wc, int fr, int fq) const {
        const int row0 = u.pm * BM + wr * 64 + fr, col0 = (u.pn & pn_mask) * BM + wc * 32 + 8 * fq;
#pragma unroll
        for (int ai = 0; ai < 2; ++ai)
#pragma unroll
            for (int m = 0; m < 4; ++m) { bf16_t* rowp = O + (size_t)(row0 + ai * HALF + m * 16) * ldc + col0;
#pragma unroll
                for (int bj = 0; bj < 2; ++bj) { const f32x4 v0 = acc[ai][bj][m][0], v1 = acc[ai][bj][m][1];
                    u32x4 w; w.x = cvt_pk_bf16(v0[0], v0[1]); w.y = cvt_pk_bf16(v0[2], v0[3]); w.z = cvt_pk_bf16(v1[0], v1[1]); w.w = cvt_pk_bf16(v1[2], v1[3]);
                    *(u32x4*)(rowp + bj * HALF) = w; } }
    }
};
struct EpiResid {
    static constexpr bool PERM = false, AFTER_DRAIN = false;
    const float* base; float* out; float alpha;
    __device__ __forceinline__ void operator()(const f32x4 (&acc)[2][2][4][2], const Unit& u, int wr, int wc, int fr, int fq) const {
        const int row0 = u.pm * BM + wr * 64 + fr, col0 = u.pn * BM + wc * 32 + 4 * fq;
#pragma unroll
        for (int ai = 0; ai < 2; ++ai)
#pragma unroll
            for (int m = 0; m < 4; ++m) { const size_t off = (size_t)(row0 + ai * HALF + m * 16) * 2048 + col0;
#pragma unroll
                for (int bj = 0; bj < 2; ++bj)
#pragma unroll
                    for (int n = 0; n < 2; ++n) { const size_t o = off + bj * HALF + n * 16; const f32x4 b = *(const f32x4*)(base + o); *(f32x4*)(out + o) = b * alpha + acc[ai][bj][m][n]; } }
    }
};
struct EpiGLU {
    static constexpr bool PERM = true, AFTER_DRAIN = false;
    bf16_t* H; const float* roww;
    __device__ __forceinline__ void operator()(const f32x4 (&acc)[2][2][4][2], const Unit& u, int wr, int wc, int fr, int fq) const {
        const int row0 = u.pm * BM + wr * 64 + fr, f0 = (u.pn & 3) * 128 + wc * 32 + 8 * fq;
#pragma unroll
        for (int ai = 0; ai < 2; ++ai)
#pragma unroll
            for (int m = 0; m < 4; ++m) { const int row = row0 + ai * HALF + m * 16; const float w = roww[row];
                float h[8];
#pragma unroll
                for (int n = 0; n < 2; ++n)
#pragma unroll
                    for (int e = 0; e < 4; ++e) { const float g = acc[ai][0][m][n][e], up = acc[ai][1][m][n][e]; h[n * 4 + e] = g * __builtin_amdgcn_rcpf(1.0f + __expf(-g)) * up * w; }
                u32x4 o; o.x = cvt_pk_bf16(h[0], h[1]); o.y = cvt_pk_bf16(h[2], h[3]); o.z = cvt_pk_bf16(h[4], h[5]); o.w = cvt_pk_bf16(h[6], h[7]);
                *(u32x4*)(H + (size_t)row * 512 + f0) = o; }
    }
};
struct EpiRope {
    static constexpr bool PERM = true, AFTER_DRAIN = false;
    bf16_t* O; const float* c128; const float* s128; const float* c64; const float* s64;
    __device__ __forceinline__ void operator()(const f32x4 (&acc)[2][2][4][2], const Unit& u, int wr, int wc, int fr, int fq) const {
        const int row0 = u.pm * BM + wr * 64 + fr, jj = wc * 32 + 8 * fq;
        const int pn = u.pn;
        if (pn == 10 || pn == 11) {
#pragma unroll
            for (int ai = 0; ai < 2; ++ai)
#pragma unroll
                for (int m = 0; m < 4; ++m) { bf16_t* rowp = O + (size_t)(row0 + ai * HALF + m * 16) * 4096 + pn * 256 + jj;
#pragma unroll
                    for (int bj = 0; bj < 2; ++bj) { const f32x4 v0 = acc[ai][bj][m][0], v1 = acc[ai][bj][m][1];
                        u32x4 w; w.x = cvt_pk_bf16(v0[0], v0[1]); w.y = cvt_pk_bf16(v0[2], v0[3]); w.z = cvt_pk_bf16(v1[0], v1[1]); w.w = cvt_pk_bf16(v1[2], v1[3]);
                        *(u32x4*)(rowp + bj * HALF) = w; } }
            return;
        }
        const bool idx = pn >= 12;
        const int half = idx ? 32 : 64;
        const int hl = idx ? (jj >> 5) : (jj >> 6), i0 = jj & (half - 1);
        const int colbase = idx ? (3072 + ((pn - 12) * 4 + hl) * 64) : (pn * 256 + hl * 128);
        const float* ct = idx ? c64 : c128; const float* st = idx ? s64 : s128;
#pragma unroll
        for (int ai = 0; ai < 2; ++ai)
#pragma unroll
            for (int m = 0; m < 4; ++m) { const int row = row0 + ai * HALF + m * 16; const int pos = row & 4095;
                const float* cp = ct + (size_t)pos * half + i0; const float* sp = st + (size_t)pos * half + i0;
                const f32x4 c0 = *(const f32x4*)cp, c1 = *(const f32x4*)(cp + 4), s0 = *(const f32x4*)sp, s1 = *(const f32x4*)(sp + 4);
                const f32x4 a0 = acc[ai][0][m][0], a1 = acc[ai][0][m][1], b0 = acc[ai][1][m][0], b1 = acc[ai][1][m][1];
                const f32x4 x0 = a0 * c0 - b0 * s0, x1 = a1 * c1 - b1 * s1, y0 = b0 * c0 + a0 * s0, y1 = b1 * c1 + a1 * s1;
                bf16_t* rowp = O + (size_t)row * 4096 + colbase + i0;
                u32x4 w; w.x = cvt_pk_bf16(x0[0], x0[1]); w.y = cvt_pk_bf16(x0[2], x0[3]); w.z = cvt_pk_bf16(x1[0], x1[1]); w.w = cvt_pk_bf16(x1[2], x1[3]);
                *(u32x4*)rowp = w;
                u32x4 z; z.x = cvt_pk_bf16(y0[0], y0[1]); z.y = cvt_pk_bf16(y0[2], y0[3]); z.z = cvt_pk_bf16(y1[0], y1[1]); z.w = cvt_pk_bf16(y1[2], y1[3]);
                *(u32x4*)(rowp + half) = z; }
    }
};
struct MoeOrder {
    int G, c, ntn, Tm; const PG8_LAS int* tend;
    __device__ __forceinline__ bool next(int i, Unit& u) const {
        const int L = i * G + c; const int t = L / ntn; if (t >= Tm) return false;
        int e = 0;
#pragma unroll 1
        for (int k = 0; k < 32; ++k) e += (t >= tend[k]) ? 1 : 0;
        u.pm = t; u.pn = e * ntn + (L - t * ntn); return true;
    }
    __device__ __forceinline__ void a_ready(const Unit&) const {}
    __device__ __forceinline__ void done(const Unit&) const {}
};
template <class Epi, class Sched, bool ALIGN_EPI = false, bool SP2 = false>
__device__ __forceinline__ void gemm_phase(PG8_LAS unsigned char* lds, const Gemm g, const Sched& S, const Epi& E) {
    const int tid = threadIdx.x, wid = __builtin_amdgcn_readfirstlane(tid >> 6), lane = tid & 63, wr = wid >> 2, wc = wid & 3, fr = lane & 15, fq = lane >> 4;
    const int K = g.K, nt = K / BK;
    unsigned voffA[2], voffB[2];
#pragma unroll
    for (int i = 0; i < 2; ++i) { int R, C; stage_rc(tid * 16 + i * 8192, R, C); const int Rb = Epi::PERM ? ((R & ~31) + perm32(R & 31)) : R;
        voffA[i] = (unsigned)(R * K + C) * 2u; voffB[i] = (unsigned)(Rb * K + C) * 2u; }
    const size_t kstep = (size_t)(BK * 2);
    const size_t hstep = (size_t)HALF * K * 2;
    const size_t tstep = 2 * hstep;
    const unsigned ldsw = (unsigned)wid * 1024u;
    const int aoff = lds_byte(wr * 64 + fr, fq * 8), boff = lds_byte(wc * 32 + fr, fq * 8);
#define PG8_SA(b, h) (((b) * 2 + (h)) * HTB)
#define PG8_SB(b, h) ((4 + (b) * 2 + (h)) * HTB)
#define PG8_STAGE(bufoff, gbase, voff) do { _Pragma("unroll") for (int _i = 0; _i < 2; ++_i) \
        __builtin_amdgcn_global_load_lds((const unsigned*)((const char*)(gbase) + (voff)[_i]), (PG8_LAS unsigned*)(lds + (bufoff) + ldsw + _i * 8192), 16, 0, 0); } while (0)
#define PG8_LDA(dst, b, h) do { _Pragma("unroll") for (int m = 0; m < 4; ++m) _Pragma("unroll") for (int k = 0; k < 2; ++k) dst[m][k] = *(const PG8_LAS bf16x8*)(lds + PG8_SA(b, h) + aoff + m * 2048 + k * 1024); } while (0)
#define PG8_LDB(dst, b, h) do { _Pragma("unroll") for (int n = 0; n < 2; ++n) _Pragma("unroll") for (int k = 0; k < 2; ++k) dst[n][k] = *(const PG8_LAS bf16x8*)(lds + PG8_SB(b, h) + boff + n * 2048 + k * 1024); } while (0)
#define PG8_MMA(ai, bj, At, Bt) do { __builtin_amdgcn_s_setprio(1); _Pragma("unroll") for (int m = 0; m < 4; ++m) _Pragma("unroll") for (int n = 0; n < 2; ++n) _Pragma("unroll") for (int k = 0; k < 2; ++k) \
        acc[ai][bj][m][n] = __builtin_amdgcn_mfma_f32_16x16x32_bf16(Bt[n][k], At[m][k], acc[ai][bj][m][n], 0, 0, 0); __builtin_amdgcn_s_setprio(0); } while (0)
#define PG8_WAIT_V(n) asm volatile("s_waitcnt vmcnt(" #n ")" ::: "memory")
#define PG8_WAIT_L(n) asm volatile("s_waitcnt lgkmcnt(" #n ")" ::: "memory")
#define PG8_BAR __builtin_amdgcn_s_barrier()
#define PG8_SCHED __builtin_amdgcn_sched_barrier(0)
    Unit cur, nxt; int ui = 0;
    if (!S.next(0, cur)) return;
    f32x4 acc[2][2][4][2];
#pragma unroll
    for (int a = 0; a < 2; ++a)
#pragma unroll
        for (int b = 0; b < 2; ++b)
#pragma unroll
            for (int m = 0; m < 4; ++m)
#pragma unroll
                for (int n = 0; n < 2; ++n) acc[a][b][m][n] = (f32x4){0.f, 0.f, 0.f, 0.f};
    bf16x8 At[4][2], B0[2][2], B1[2][2];
    const char* cA = (const char*)g.A + (size_t)cur.pm * tstep; const char* cB = (const char*)g.Bt + (size_t)cur.pn * tstep;
    S.a_ready(cur);
    if constexpr (SP2) {
        PG8_STAGE(PG8_SB(0, 0), cB, voffB); PG8_STAGE(PG8_SB(0, 1), cB + hstep, voffB); PG8_STAGE(PG8_SA(0, 0), cA, voffA); PG8_STAGE(PG8_SA(0, 1), cA + hstep, voffA);
        if (wr == 1) PG8_BAR;
        PG8_WAIT_V(2); PG8_BAR;
        PG8_STAGE(PG8_SB(1, 0), cB + kstep, voffB); PG8_STAGE(PG8_SA(1, 0), cA + kstep, voffA); PG8_STAGE(PG8_SB(1, 1), cB + hstep + kstep, voffB);
        PG8_WAIT_V(6); PG8_BAR;
    } else {
        PG8_STAGE(PG8_SB(0, 0), cB, voffB); PG8_STAGE(PG8_SA(0, 0), cA, voffA); PG8_STAGE(PG8_SB(0, 1), cB + hstep, voffB); PG8_STAGE(PG8_SA(0, 1), cA + hstep, voffA);
        if (wr == 1) PG8_BAR;
        PG8_WAIT_V(4); PG8_BAR;
        PG8_STAGE(PG8_SB(1, 0), cB + kstep, voffB); PG8_STAGE(PG8_SA(1, 0), cA + kstep, voffA); PG8_STAGE(PG8_SB(1, 1), cB + hstep + kstep, voffB);
        PG8_WAIT_V(6); PG8_BAR;
    }
    for (;;) {
        const bool has_next = S.next(ui + 1, nxt);
        const char* nA = has_next ? (const char*)g.A + (size_t)nxt.pm * tstep : cA; const char* nB = has_next ? (const char*)g.Bt + (size_t)nxt.pn * tstep : cB;
        for (int t = 0; t < nt; t += 2) {
            const bool last = (t == nt - 2);
            const char* a1 = cA + (size_t)(t + 1) * kstep;
            const char* a2 = last ? nA : cA + (size_t)(t + 2) * kstep; const char* b2 = last ? nB : cB + (size_t)(t + 2) * kstep;
            const char* a3 = a2 + kstep; const char* b3 = b2 + kstep;
            if (last && has_next) S.a_ready(nxt);
            if constexpr (SP2) {
            PG8_LDB(B0, 0, 0); PG8_LDB(B1, 0, 1); PG8_SCHED; PG8_LDA(At, 0, 0); PG8_STAGE(PG8_SA(1, 1), a1 + hstep, voffA);
            PG8_WAIT_V(8); PG8_WAIT_L(0); PG8_BAR; PG8_MMA(0, 0, At, B0); PG8_MMA(0, 1, At, B1); PG8_BAR; PG8_SCHED;
            PG8_LDA(At, 0, 1); PG8_STAGE(PG8_SB(0, 0), b2, voffB); PG8_STAGE(PG8_SB(0, 1), b2 + hstep, voffB); PG8_STAGE(PG8_SA(0, 0), a2, voffA);
            PG8_WAIT_V(8); PG8_WAIT_L(0); PG8_BAR; PG8_MMA(1, 0, At, B0); PG8_MMA(1, 1, At, B1); PG8_BAR; PG8_SCHED;
            PG8_LDB(B0, 1, 0); PG8_LDB(B1, 1, 1); PG8_SCHED; PG8_LDA(At, 1, 0); PG8_STAGE(PG8_SA(0, 1), a2 + hstep, voffA);
            PG8_WAIT_V(8); PG8_WAIT_L(0); PG8_BAR; PG8_MMA(0, 0, At, B0); PG8_MMA(0, 1, At, B1); PG8_BAR; PG8_SCHED;
            PG8_LDA(At, 1, 1); PG8_STAGE(PG8_SB(1, 0), b3, voffB); PG8_STAGE(PG8_SB(1, 1), b3 + hstep, voffB); PG8_STAGE(PG8_SA(1, 0), a3, voffA);
            PG8_WAIT_V(8); PG8_WAIT_L(0); PG8_BAR; PG8_MMA(1, 0, At, B0); PG8_MMA(1, 1, At, B1); PG8_BAR; PG8_SCHED;
            } else {
            PG8_LDB(B0, 0, 0); PG8_SCHED; PG8_LDA(At, 0, 0); PG8_STAGE(PG8_SA(1, 1), a1 + hstep, voffA);
            PG8_WAIT_L(8); PG8_BAR; PG8_WAIT_L(0); PG8_MMA(0, 0, At, B0); PG8_BAR; PG8_SCHED;
            PG8_LDB(B1, 0, 1); PG8_STAGE(PG8_SB(0, 0), b2, voffB);
            PG8_BAR; PG8_WAIT_L(0); PG8_MMA(0, 1, At, B1); PG8_BAR;
            PG8_LDA(At, 0, 1); PG8_STAGE(PG8_SA(0, 0), a2, voffA);
            PG8_BAR; PG8_WAIT_L(0); PG8_MMA(1, 0, At, B0); PG8_BAR; PG8_SCHED;
            PG8_STAGE(PG8_SB(0, 1), b2 + hstep, voffB);
            PG8_WAIT_V(6); PG8_BAR; PG8_MMA(1, 1, At, B1); PG8_BAR;
            PG8_LDB(B0, 1, 0); PG8_SCHED; PG8_LDA(At, 1, 0); PG8_STAGE(PG8_SA(0, 1), a2 + hstep, voffA);
            PG8_WAIT_L(8); PG8_BAR; PG8_WAIT_L(0); PG8_MMA(0, 0, At, B0); PG8_BAR; PG8_SCHED;
            PG8_LDB(B1, 1, 1); PG8_STAGE(PG8_SB(1, 0), b3, voffB);
            PG8_BAR; PG8_WAIT_L(0); PG8_MMA(0, 1, At, B1); PG8_BAR;
            PG8_LDA(At, 1, 1); PG8_STAGE(PG8_SA(1, 0), a3, voffA);
            PG8_BAR; PG8_WAIT_L(0); PG8_MMA(1, 0, At, B0); PG8_BAR; PG8_SCHED;
            PG8_STAGE(PG8_SB(1, 1), b3 + hstep, voffB);
            PG8_WAIT_V(6); PG8_BAR; PG8_MMA(1, 1, At, B1); PG8_BAR;
            }
        }
        if constexpr (ALIGN_EPI) { if (wr == 0) PG8_BAR; }
        if constexpr (!Epi::AFTER_DRAIN) { E(acc, cur, wr, wc, fr, fq); S.done(cur); }
        if (!has_next) break;
#pragma unroll
        for (int a = 0; a < 2; ++a)
#pragma unroll
            for (int b = 0; b < 2; ++b)
#pragma unroll
                for (int m = 0; m < 4; ++m)
#pragma unroll
                    for (int n = 0; n < 2; ++n) acc[a][b][m][n] = (f32x4){0.f, 0.f, 0.f, 0.f};
        cur = nxt; cA = nA; cB = nB; ++ui;
        if constexpr (ALIGN_EPI) { if (wr == 1) PG8_BAR; }
    }
    PG8_WAIT_V(0);
    if constexpr (!ALIGN_EPI) { if (wr == 0) PG8_BAR; }
    PG8_BAR;
    if constexpr (Epi::AFTER_DRAIN) { E.fused(acc, cur, wr, wc, fr, fq, lds, wid, lane); S.done(cur); }
#undef PG8_SA
#undef PG8_SB
#undef PG8_STAGE
#undef PG8_LDA
#undef PG8_LDB
#undef PG8_MMA
#undef PG8_WAIT_V
#undef PG8_WAIT_L
#undef PG8_BAR
#undef PG8_SCHED
}
}
constexpr int BATCH = 2, SEQ = 4096, DM = 2048, MTOK = BATCH * SEQ;
constexpr int NE0 = 6168, NE1 = 4176;
constexpr int NP0 = 6144, NP1 = 4096;
constexpr float LN_EPS = 1e-5f;
constexpr float DN_ALPHA = 1.41421356237309515f;
constexpr float ATT_SCALE = 0.08838834764831845f;
constexpr int RPAD = 24576;
constexpr size_t MiB = 1u << 20;
constexpr size_t WS_CTL = 0, CTL_ZERO_BYTES = 1 * MiB;
constexpr size_t WS_ROPE = 1 * MiB;
constexpr size_t WS_WSM = 4 * MiB;
constexpr size_t WS_SK0 = 6 * MiB;
constexpr size_t WS_IK = 7 * MiB;
constexpr size_t WS_IW = 8 * MiB + 512 * 1024;
constexpr size_t WS_FBIAS = 10 * MiB;
constexpr size_t WS_ROUTE = 11 * MiB;
constexpr size_t WS_MASK = 12 * MiB;
constexpr size_t WS_WINA = 16 * MiB, WS_WOA = 40 * MiB, WS_WINC = 48 * MiB, WS_WOC = 64 * MiB;
constexpr size_t WS_WGU = 72 * MiB;
constexpr size_t WS_WD = 328 * MiB;
constexpr size_t WS_XB = 456 * MiB;
constexpr size_t WS_XR = 488 * MiB;
constexpr size_t WS_PROJ = 552 * MiB;
constexpr size_t WS_CST = 648 * MiB;
constexpr size_t WS_PREVT = 712 * MiB;
constexpr size_t WS_OMIX = 744 * MiB;
constexpr size_t WS_GB = 776 * MiB;
constexpr size_t WS_DEC = 792 * MiB;
constexpr size_t WS_ROWW = 793 * MiB;
constexpr size_t WS_SC = 800 * MiB;
constexpr size_t WS_END = 928 * MiB;
constexpr int CW_CNT = 1024;
constexpr int CW_FILL = 2048;
constexpr int CW_BAR = 4096;

#define GAS __attribute__((address_space(1)))
#define LAS __attribute__((address_space(3)))
typedef unsigned short bf16;
typedef unsigned v4u __attribute__((ext_vector_type(4)));
typedef unsigned v2u __attribute__((ext_vector_type(2)));
typedef float f32x4 __attribute__((ext_vector_type(4)));
typedef short bf16x8 __attribute__((ext_vector_type(8)));
#define LDS_WAIT() asm volatile("s_waitcnt lgkmcnt(0)" ::: "memory")
#define VM_WAIT() asm volatile("s_waitcnt vmcnt(0)" ::: "memory")
__device__ __forceinline__ unsigned f2bf(float f) { unsigned u = __builtin_bit_cast(unsigned, f); return (u + 0x7fffu + ((u >> 16) & 1u)) >> 16; }
__device__ __forceinline__ unsigned pk2(float lo, float hi) { return f2bf(lo) | (f2bf(hi) << 16); }
__device__ __forceinline__ float bf2f(unsigned short b) { return __builtin_bit_cast(float, ((unsigned)b) << 16); }
__device__ __forceinline__ float wave_sum(float v) {
#pragma unroll
    for (int o = 1; o < 64; o <<= 1) v += __shfl_xor(v, o);
    return v;
}
__device__ __forceinline__ float logsigmoidf(float z) { return fminf(z, 0.f) - log1pf(__expf(-fabsf(z))); }
#define XB_TMO      128
#define XB_XCNT(j)  (256  + 64 * (j))
#define XB_XSUB(j)  (1280 + 64 * (j))
#define XB_XGEN(j)  (2304 + 64 * (j))
#define XB_TOP      3328
#define XB_TOPGEN   3392
#define XCD_BAR_WORDS 3456
#define XB_SPIN_CAP (1u << 21)

__device__ __forceinline__ unsigned xb_ld(unsigned* p)              { return __hip_atomic_load(p, __ATOMIC_RELAXED, __HIP_MEMORY_SCOPE_AGENT); }
__device__ __forceinline__ unsigned xb_add(unsigned* p, unsigned v) { return __hip_atomic_fetch_add(p, v, __ATOMIC_RELAXED, __HIP_MEMORY_SCOPE_AGENT); }
__device__ __forceinline__ unsigned xb_xcc_id() { return (unsigned)__builtin_amdgcn_s_getreg((3 << 11) | 20) & 0xFu; }
#define XB_SPIN(cond, bar) do { unsigned _sp = 0; while (cond) { __builtin_amdgcn_s_sleep(1); \
    if ((++_sp & 255u) == 0u) { if (xb_ld(&(bar)[XB_TMO])) break; if (_sp > XB_SPIN_CAP) { atomicAdd(&(bar)[XB_TMO], 1u); break; } } } } while (0)

struct XcdBarrier {
    unsigned* bar; unsigned x;
    volatile LAS unsigned* st;
};

__device__ __forceinline__ XcdBarrier xcd_barrier_post(unsigned* bar, volatile LAS unsigned* st) {
    XcdBarrier b; b.bar = bar; b.x = xb_xcc_id(); b.st = st;
    if (threadIdx.x == 0) (void)xb_add(&bar[XB_XCNT(b.x)], 1u);
    return b;
}
__device__ __forceinline__ void xcd_barrier_complete(unsigned* bar, unsigned x, unsigned& nloc, unsigned& nx) {
    const unsigned G = gridDim.x * gridDim.y * gridDim.z;
    unsigned sum, cnt, mine, sp = 0u;
    for (;;) {
        sum = 0u; cnt = 0u; mine = 0u;
#pragma unroll
        for (unsigned j = 0; j < 16; ++j) { const unsigned c = xb_ld(&bar[XB_XCNT(j)]); sum += c; cnt += (c > 0u) ? 1u : 0u; mine = (j == x) ? c : mine; }
        if (sum == G) break;
        __builtin_amdgcn_s_sleep(1);
        if ((++sp & 255u) == 0u) { if (xb_ld(&bar[XB_TMO])) break; if (sp > XB_SPIN_CAP) { atomicAdd(&bar[XB_TMO], 1u); break; } }
    }
    nloc = mine > 0u ? mine : 1u; nx = cnt > 0u ? cnt : 1u;
}

__device__ __forceinline__ void xcd_barrier(const XcdBarrier& b) {
    asm volatile("s_waitcnt vmcnt(0)" ::: "memory");
    __syncthreads();
    if (threadIdx.x == 0) {
        unsigned* bar = b.bar;
        __builtin_amdgcn_s_waitcnt(0);
        unsigned nloc = b.st[0], nx = b.st[1];
        if (nloc == 0u) { xcd_barrier_complete(bar, b.x, nloc, nx); b.st[0] = nloc; b.st[1] = nx; }
        const unsigned old = xb_add(&bar[XB_XSUB(b.x)], 1u);
        const unsigned gen = old / nloc;
        if (old + 1u == (gen + 1u) * nloc) {
            __builtin_amdgcn_fence(__ATOMIC_RELEASE, "agent");
            asm volatile("s_waitcnt vmcnt(0)" ::: "memory");
            const unsigned og = xb_add(&bar[XB_TOP], 1u);
            const unsigned tg = og / nx;
            if (og + 1u == (tg + 1u) * nx) xb_add(&bar[XB_TOPGEN], 1u);
            else XB_SPIN(xb_ld(&bar[XB_TOPGEN]) == tg, bar);
            __builtin_amdgcn_fence(__ATOMIC_ACQUIRE, "agent");
            xb_add(&bar[XB_XGEN(b.x)], 1u);
            asm volatile("s_waitcnt vmcnt(0)" ::: "memory");
        } else {
            XB_SPIN(xb_ld(&bar[XB_XGEN(b.x)]) == gen, bar);
            __builtin_amdgcn_fence(__ATOMIC_ACQUIRE, "agent");
            asm volatile("s_waitcnt vmcnt(0)" ::: "memory");
        }
    }
    __syncthreads();
}

constexpr int NWAVES = 8;
constexpr int RING_BYTES = 131072;
constexpr int LDSCTL_OFF = RING_BYTES;
constexpr int LDS_BYTES = 147456;
struct Frame {
    LAS unsigned char* lds; volatile LAS unsigned* MISC; unsigned* ctl;
    int tid, lane, wave, G, gw, NGW;
    unsigned char* ws;
};
struct Args { const float* in[20]; float* out; unsigned char* ws; int ph_lo, ph_hi, bar_region, pad; };

__device__ __forceinline__ void transpose_item64(const float* W, int ldw, int c0, int c1  , int K, bf16* WT, int n0, int k0, LAS bf16* T, int lane) {
    const int nq = lane & 15, kr = lane >> 4;
    const float* src = W + (size_t)(k0 + kr) * ldw + (nq < 8 ? c0 : c1 - 32) + 4 * nq;
    f32x4 r[16];
#pragma unroll
    for (int i = 0; i < 16; ++i) r[i] = *(const f32x4*)(src + (size_t)(4 * i) * ldw);
#pragma unroll
    for (int i = 0; i < 16; ++i) { const int kk = 4 * i + kr;
#pragma unroll
        for (int e = 0; e < 4; ++e) T[(4 * nq + e) * 68 + kk] = (bf16)f2bf(r[i][e]); }
    LDS_WAIT(); asm volatile("" ::: "memory");
    const int c = lane & 7;
#pragma unroll
    for (int j = 0; j < 8; ++j) { const int n = (lane >> 3) + 8 * j; const v2u lo = *(const LAS v2u*)(T + n * 68 + 8 * c), hi = *(const LAS v2u*)(T + n * 68 + 8 * c + 4);
        v4u o; o.x = lo.x; o.y = lo.y; o.z = hi.x; o.w = hi.y;
        *(v4u*)(WT + (size_t)(n0 + n) * K + k0 + 8 * c) = o; }
    LDS_WAIT(); asm volatile("" ::: "memory");
}
__device__ __forceinline__ int l1_src_col(int n) {
    const int pn = n >> 8, j = n & 255, jh = j & 127, second = j >> 7;
    if (pn == 10 || pn == 11) return n;
    if (pn < 10) return pn * 256 + (jh >> 6) * 128 + second * 64 + (jh & 63);
    return 3072 + ((pn - 12) * 4 + (jh >> 5)) * 64 + second * 32 + (jh & 31);
}
constexpr int SK_ROUTE0 = 0, SK_ROUTE1 = 48, SK_SK0 = 96, SK_SK1 = 128, SK_NCOL = 208;
constexpr int SK_PART_OFF = 0, SK_LG_OFF = 65536;
template <int NT> __device__ __forceinline__ void skinny_partials(LAS unsigned char* ldsb, const float* X, const bf16* WH, const bf16* WL, int w, int lane) {
    const int tile = w >> 2, kq = w & 3, l15 = lane & 15, quad = lane >> 4;
    const float* xp = X + (size_t)(16 * tile + l15) * DM + kq * 512 + quad * 8;
    const bf16* hp = WH + (size_t)l15 * 2048 + kq * 512 + quad * 8; const bf16* lp = WL + (size_t)l15 * 2048 + kq * 512 + quad * 8;
    pg8::f32x4 acc[NT];
#pragma unroll
    for (int n = 0; n < NT; ++n) acc[n] = (pg8::f32x4){0.f, 0.f, 0.f, 0.f};
#pragma unroll 2
    for (int ks = 0; ks < 16; ++ks) {
        const f32x4 x0 = *(const f32x4*)(xp + 32 * ks), x1 = *(const f32x4*)(xp + 32 * ks + 4);
        v4u hw, lw;
        hw.x = pg8::cvt_pk_bf16(x0[0], x0[1]); hw.y = pg8::cvt_pk_bf16(x0[2], x0[3]); hw.z = pg8::cvt_pk_bf16(x1[0], x1[1]); hw.w = pg8::cvt_pk_bf16(x1[2], x1[3]);
        lw.x = pg8::cvt_pk_bf16(x0[0] - bf2f(hw.x & 0xffff), x0[1] - bf2f(hw.x >> 16)); lw.y = pg8::cvt_pk_bf16(x0[2] - bf2f(hw.y & 0xffff), x0[3] - bf2f(hw.y >> 16));
        lw.z = pg8::cvt_pk_bf16(x1[0] - bf2f(hw.z & 0xffff), x1[1] - bf2f(hw.z >> 16)); lw.w = pg8::cvt_pk_bf16(x1[2] - bf2f(hw.w & 0xffff), x1[3] - bf2f(hw.w >> 16));
        const bf16x8 ah = __builtin_bit_cast(bf16x8, hw), al = __builtin_bit_cast(bf16x8, lw);
#pragma unroll
        for (int n = 0; n < NT; ++n) { const bf16x8 bh = *(const bf16x8*)(hp + (size_t)n * 16 * 2048 + 32 * ks), bl = *(const bf16x8*)(lp + (size_t)n * 16 * 2048 + 32 * ks);
            acc[n] = __builtin_amdgcn_mfma_f32_16x16x32_bf16(ah, bh, acc[n], 0, 0, 0); acc[n] = __builtin_amdgcn_mfma_f32_16x16x32_bf16(ah, bl, acc[n], 0, 0, 0);
            acc[n] = __builtin_amdgcn_mfma_f32_16x16x32_bf16(al, bh, acc[n], 0, 0, 0); }
    }
    LAS float* PART = (LAS float*)(ldsb + SK_PART_OFF);
#pragma unroll
    for (int n = 0; n < NT; ++n) *(LAS pg8::f32x4*)(PART + ((((tile * 4 + kq) * NT + n) * 64 + lane) * 4)) = acc[n];
}
template <int NT> __device__ __forceinline__ void skinny_reduce(LAS unsigned char* ldsb, int tid) {
    const LAS float* PART = (const LAS float*)(ldsb + SK_PART_OFF); LAS float* LG = (LAS float*)(ldsb + SK_LG_OFF);
    for (int idx = tid; idx < 32 * 16 * NT; idx += NWAVES * 64) { const int row = idx / (16 * NT), col = idx % (16 * NT), tile = row >> 4, rr = row & 15, ln = (rr >> 2) * 16 + (col & 15), n = col >> 4, j = rr & 3;
        float s = 0.f;
#pragma unroll
        for (int kq = 0; kq < 4; ++kq) s += PART[(((tile * 4 + kq) * NT + n) * 64 + ln) * 4 + j];
        LG[row * (16 * NT) + col] = s; }
}
__device__ __forceinline__ void ln_row(f32x4 (&v)[8], const float* g, const float* b, int lane) {
    float s = 0.f;
#pragma unroll
    for (int j = 0; j < 8; ++j) s += (v[j][0] + v[j][1]) + (v[j][2] + v[j][3]);
    const float mean = wave_sum(s) * (1.f / DM); float s2 = 0.f;
#pragma unroll
    for (int j = 0; j < 8; ++j) { v[j] = v[j] - mean; s2 += (v[j][0] * v[j][0] + v[j][1] * v[j][1]) + (v[j][2] * v[j][2] + v[j][3] * v[j][3]); }
    const float rstd = 1.f / sqrtf(wave_sum(s2) * (1.f / DM) + LN_EPS);
#pragma unroll
    for (int j = 0; j < 8; ++j) { const f32x4 gg = *(const f32x4*)(g + 256 * j + 4 * lane), bb = *(const f32x4*)(b + 256 * j + 4 * lane); v[j] = v[j] * rstd * gg + bb; }
}
__device__ __forceinline__ void store_row_bf16(bf16* dst, const f32x4 (&v)[8], int lane) {
#pragma unroll
    for (int j = 0; j < 8; ++j) { uint2 o; o.x = pk2(v[j][0], v[j][1]); o.y = pk2(v[j][2], v[j][3]); *(uint2*)(dst + 256 * j + 4 * lane) = o; }
}
#define TK_FOR_VALID(...) _Pragma("unroll") for (int g_ = 0; g_ < 8; ++g_) { if (512 * g_ <= qpos) { _Pragma("unroll") for (int i = 8 * g_; i < 8 * g_ + 8; ++i) { __VA_ARGS__ } } }
__device__ __forceinline__ void topk_mask_row(const LAS float* sc, int qpos, unsigned long long* mrow, int lane, LAS unsigned* cbuf) {
    unsigned u[64];
#pragma unroll
    for (int i = 0; i < 64; ++i) { const int s = 64 * i + lane; const bool ok = s <= qpos; const float f = ok ? sc[s] : 0.f; const unsigned b = __builtin_bit_cast(unsigned, f);
        const unsigned key = b ^ ((b >> 31) ? 0xFFFFFFFFu : 0x80000000u); u[i] = ok ? key : 0u; }
    unsigned long long mword = 0ull;
    if (qpos + 1 <= 256) {
#pragma unroll
        for (int i = 0; i < 4; ++i) { const unsigned long long w = __ballot(64 * i + lane <= qpos); mword = (lane == i) ? w : mword; }
        mrow[lane] = mword; return;
    }
    const unsigned long long below = (1ull << lane) - 1ull;
    unsigned T = 0u;
#pragma unroll 1
    for (int bit = 31; bit >= 20; --bit) { const unsigned cand = T | (1u << bit); int cnt = 0;
        TK_FOR_VALID( cnt += __builtin_popcountll(__ballot(u[i] >= cand)); )
        if (cnt >= 256) T = cand; }
    const unsigned pre = T >> 20; int cgt = 0, nc = 0;
    TK_FOR_VALID( { const unsigned p_ = u[i] >> 20; const unsigned long long gm = __ballot(p_ > pre), em = __ballot(p_ == pre); cgt += __builtin_popcountll(gm);
        const int pos_ = nc + __builtin_popcountll(em & below); if (p_ == pre && pos_ < 256) cbuf[pos_] = u[i]; nc += __builtin_popcountll(em); } )
    int kneed = 256 - cgt;
    if (nc <= 256) {
        asm volatile("s_waitcnt lgkmcnt(0)" ::: "memory");
        unsigned c0 = lane < nc ? cbuf[lane] : 0u, c1 = 64 + lane < nc ? cbuf[64 + lane] : 0u, c2 = 128 + lane < nc ? cbuf[128 + lane] : 0u, c3 = 192 + lane < nc ? cbuf[192 + lane] : 0u;
#pragma unroll 1
        for (int bit = 19; bit >= 0; --bit) { const unsigned cand = T | (1u << bit);
            int cnt = __builtin_popcountll(__ballot(c0 >= cand));
            if (nc > 64) cnt += __builtin_popcountll(__ballot(c1 >= cand));
            if (nc > 128) cnt += __builtin_popcountll(__ballot(c2 >= cand)) + __builtin_popcountll(__ballot(c3 >= cand));
            if (cnt >= kneed) T = cand; }
        const int cg2 = __builtin_popcountll(__ballot(c0 > T)) + __builtin_popcountll(__ballot(c1 > T)) + __builtin_popcountll(__ballot(c2 > T)) + __builtin_popcountll(__ballot(c3 > T));
        kneed -= cg2;
    } else {
#pragma unroll 1
        for (int bit = 19; bit >= 0; --bit) { const unsigned cand = T | (1u << bit); int cnt = 0;
            TK_FOR_VALID( cnt += __builtin_popcountll(__ballot(u[i] >= cand)); )
            if (cnt >= 256) T = cand; }
        int cg2 = 0;
        TK_FOR_VALID( cg2 += __builtin_popcountll(__ballot(u[i] > T)); )
        kneed = 256 - cg2;
    }
    int run = 0;
#pragma unroll
    for (int i = 0; i < 64; ++i) { const bool gt = u[i] > T, eq = u[i] == T; const unsigned long long eqm = __ballot(eq);
        const int rank = run + __builtin_popcountll(eqm & below); const bool sel = gt || (eq && rank < kneed); run += __builtin_popcountll(eqm);
        const unsigned long long w = __ballot(sel); mword = (lane == i) ? w : mword; }
    mrow[lane] = mword;
}
#undef TK_FOR_VALID
constexpr int CONV_MOE_ITEMS = 32 * (32 * 16) + 32 * (8 * 32);
constexpr int CONV_LATE_ITEMS = 32 * (NP1 / 64) + 32 * 32 + CONV_MOE_ITEMS;
__device__ __forceinline__ void conv_moe_item(const Args& a, unsigned char* ws, int layer, int it, LAS bf16* T, int lane) {
    if (it < 32 * 512) {
        const int ex = layer * 32 + it / 512, r = it % 512, kb = r / 16, nb = r % 16, n0 = nb * 64, tile = n0 >> 8, j = n0 & 255;
        const float* W = (j < 128 ? a.in[17] : a.in[18]) + (size_t)ex * 2048 * 512;
        transpose_item64(W, 512, 128 * tile + (j & 127), 128 * tile + (j & 127) + 32, 2048, (bf16*)(ws + WS_WGU) + (size_t)ex * 1024 * 2048, n0, kb * 64, T, lane);
    } else {
        const int i2 = it - 32 * 512, ex = layer * 32 + i2 / 256, r = i2 % 256, kb = r / 32, nb = r % 32;
        transpose_item64(a.in[19] + (size_t)ex * 512 * 2048, 2048, nb * 64, nb * 64 + 32, 512, (bf16*)(ws + WS_WD) + (size_t)ex * 2048 * 512, nb * 64, kb * 64, T, lane);
    }
}
__device__ __forceinline__ void conv_late_item(const Args& a, unsigned char* ws, int it, LAS bf16* T, int lane) {
    if (it < 32 * (NP1 / 64)) { const int kb = it / (NP1 / 64), nb = it % (NP1 / 64), n0 = nb * 64;
        transpose_item64(a.in[7], NE1, l1_src_col(n0), l1_src_col(n0 + 32), 2048, (bf16*)(ws + WS_WINC), n0, kb * 64, T, lane); return; }
    it -= 32 * (NP1 / 64);
    if (it < 32 * 32) { const int kb = it / 32, nb = it % 32; transpose_item64(a.in[8], 2048, nb * 64, nb * 64 + 32, 2048, (bf16*)(ws + WS_WOC), nb * 64, kb * 64, T, lane); return; }
    conv_moe_item(a, ws, 1, it - 32 * 32, T, lane);
}
__device__ __forceinline__ void late_conv_items(Frame& F, const Args& a) {
    LAS bf16* T = (LAS bf16*)(F.lds + F.wave * 16384); volatile LAS int* slot = (volatile LAS int*)(F.lds + 131072 + 512);
    for (;;) {
        __syncthreads();
        if (F.tid == 0) *slot = (int)atomicAdd(F.ctl + CW_FILL, 8u);
        __syncthreads();
        const int base = *slot;
        if (base >= CONV_LATE_ITEMS) break;
        const int it = base + F.wave;
        if (it < CONV_LATE_ITEMS) conv_late_item(a, F.ws, it, T, F.lane);
    }
    __syncthreads();
}
__device__ __forceinline__ void p0_prologue(Frame& F, const Args& a) {
    const int gw = F.gw, NGW = F.NGW, lane = F.lane;
    unsigned char* ws = F.ws;
    LAS bf16* T = (LAS bf16*)(F.lds + F.wave * 16384);
    {
        const float* W = a.in[1]; bf16* WT = (bf16*)(ws + WS_WINA);
        for (int it = gw; it < 32 * (NP0 / 64); it += NGW) { const int kb = it / (NP0 / 64), nb = it % (NP0 / 64), n0 = nb * 64; const int c0 = n0 < 3072 ? n0 : n0 + 16; transpose_item64(W, NE0, c0, c0 + 32, 2048, WT, n0, kb * 64, T, lane); }
    }
    {
        for (int it = gw; it < 32 * 32; it += NGW) { const int kb = it / 32, nb = it % 32; transpose_item64(a.in[6], 2048, nb * 64, nb * 64 + 32, 2048, (bf16*)(ws + WS_WOA), nb * 64, kb * 64, T, lane); }
    }
    for (int it = gw; it < CONV_MOE_ITEMS; it += NGW) conv_moe_item(a, ws, 0, it, T, lane);
    const int gt = blockIdx.x * (NWAVES * 64) + F.tid, NGT = F.G * NWAVES * 64;
    {   float* c128 = (float*)(ws + WS_ROPE); float* s128 = c128 + 4096 * 64; float* c64 = s128 + 4096 * 64; float* s64 = c64 + 4096 * 32;
        for (int i = gt; i < 4096 * 96; i += NGT) { int pos, idx, half; float* cp; float* sp;
            if (i < 4096 * 64) { pos = i >> 6; idx = i & 63; half = 64; cp = c128 + i; sp = s128 + i; } else { const int r = i - 4096 * 64; pos = r >> 5; idx = r & 31; half = 32; cp = c64 + r; sp = s64 + r; }
            const float inv = exp2f(-(float)idx / (float)half * 13.287712379549449f);
            const float ang = (float)pos * inv;
            double rv = (double)ang * 0.15915494309189535; rv -= rint(rv);
            const float rf = (float)rv;
            *cp = __builtin_amdgcn_cosf(rf); *sp = __builtin_amdgcn_sinf(rf); }
    }
    {   bf16* SKH = (bf16*)(ws + WS_WSM); bf16* SKL = SKH + (size_t)SK_NCOL * 2048;
        for (int i = gt; i < 2048 * SK_NCOL; i += NGT) { const int k = i / SK_NCOL, c = i % SK_NCOL; float v = 0.f;
            if (c < 96) { const int l = c / 48, j = c % 48; if (j < 4) v = a.in[13][((size_t)l * 2048 + k) * 4 + j]; else if (j < 36) { const int g = (j - 4) >> 3, e = (j - 4) & 7; v = a.in[15][(((size_t)l * 4 + g) * 2048 + k) * 8 + e]; } }
            else if (c < 128) { const int j = c - 96; if (j < 16) v = a.in[1][(size_t)k * NE0 + 3072 + j]; else if (j < 24) v = a.in[1][(size_t)k * NE0 + 6160 + j - 16]; }
            else v = a.in[7][(size_t)k * NE1 + 4096 + c - 128];
            const unsigned h = f2bf(v); SKH[(size_t)c * 2048 + k] = (bf16)h; SKL[(size_t)c * 2048 + k] = (bf16)f2bf(v - bf2f((unsigned short)h)); }
    }
    {   const float* x = a.in[0]; bf16* XB = (bf16*)(ws + WS_XB);
        for (int m = gw; m < MTOK; m += NGW) { f32x4 v[8];
#pragma unroll
            for (int j = 0; j < 8; ++j) v[j] = *(const f32x4*)(x + (size_t)m * DM + 256 * j + 4 * lane);
            store_row_bf16(XB + (size_t)m * DM, v, lane); }
    }
}
__device__ __forceinline__ void p_skinny0(Frame& F, const Args& a) {
    const bf16* SKH = (const bf16*)(F.ws + WS_WSM) + (size_t)SK_SK0 * 2048; const bf16* SKL = SKH + (size_t)SK_NCOL * 2048; float* SK0 = (float*)(F.ws + WS_SK0);
    const LAS float* LG = (const LAS float*)(F.lds + SK_LG_OFF);
    for (int blk = blockIdx.x; blk < MTOK / 32; blk += F.G) { const int R0 = blk * 32;
        __syncthreads();
        skinny_partials<2>(F.lds, a.in[0] + (size_t)R0 * DM, SKH, SKL, F.wave, F.lane);
        __syncthreads();
        skinny_reduce<2>(F.lds, F.tid);
        __syncthreads();
        for (int idx = F.tid; idx < 32 * 24; idx += NWAVES * 64) { const int row = idx / 24, c = idx % 24; SK0[(size_t)(R0 + row) * 24 + c] = LG[row * 32 + c]; }
    }
    __syncthreads();
}
__device__ __forceinline__ void p_fox_bias(Frame& F, const Args& a) {
    if (blockIdx.x >= 16) return;
    const int bh = blockIdx.x, b = bh >> 3, h = bh & 7, lane = F.lane, tid = F.tid; const float gb = a.in[5][h];
    const float* SK0 = (const float*)(F.ws + WS_SK0); float* FB = (float*)(F.ws + WS_FBIAS) + (size_t)bh * SEQ; LAS float* wt = (LAS float*)(F.lds + 120000);
    float lf[8], tot = 0.f;
#pragma unroll
    for (int i = 0; i < 8; ++i) lf[i] = SK0[(size_t)(b * SEQ + tid * 8 + i) * 24 + 16 + h];
#pragma unroll
    for (int i = 0; i < 8; ++i) { tot += logsigmoidf(lf[i] + gb); lf[i] = tot; }
    float incl = tot;
#pragma unroll
    for (int o = 1; o < 64; o <<= 1) { const float t = __shfl_up(incl, o); if (lane >= o) incl += t; }
    if (lane == 63) wt[F.wave] = incl;
    __syncthreads();
    float pre = incl - tot;
    for (int w = 0; w < F.wave; ++w) pre += wt[w];
#pragma unroll
    for (int i = 0; i < 8; ++i) FB[tid * 8 + i] = -(pre + lf[i]) * (1.0f / ATT_SCALE);
    __syncthreads();
}
__device__ __forceinline__ void p_ln_route(Frame& F, const Args& a, int layer) {
    float* XR = (float*)(F.ws + WS_XR); bf16* XB = (bf16*)(F.ws + WS_XB); const int lane = F.lane;
    const float* g = a.in[9] + layer * DM; const float* bb = a.in[10] + layer * DM;
    const bf16* SKH = (const bf16*)(F.ws + WS_WSM) + (size_t)(layer ? SK_ROUTE1 : SK_ROUTE0) * 2048; const bf16* SKL = SKH + (size_t)SK_NCOL * 2048;
    const float* bg = a.in[14] + layer * 4; const float* be = a.in[16] + layer * 32;
    int4* ROUTE = (int4*)(F.ws + WS_ROUTE); unsigned* cnt = F.ctl + CW_CNT + layer * 64;
    const LAS float* LG = (const LAS float*)(F.lds + SK_LG_OFF);
    for (int blk = blockIdx.x; blk < MTOK / 32; blk += F.G) { const int R0 = blk * 32;
#pragma unroll 1
        for (int i = 0; i < 4; ++i) { const int m = R0 + 4 * F.wave + i; f32x4 v[8];
#pragma unroll
            for (int j = 0; j < 8; ++j) v[j] = *(const f32x4*)(XR + (size_t)m * DM + 256 * j + 4 * lane);
            ln_row(v, g, bb, lane);
#pragma unroll
            for (int j = 0; j < 8; ++j) *(f32x4*)(XR + (size_t)m * DM + 256 * j + 4 * lane) = v[j];
            store_row_bf16(XB + (size_t)m * DM, v, lane); }
        __syncthreads();
        skinny_partials<3>(F.lds, XR + (size_t)R0 * DM, SKH, SKL, F.wave, lane);
        __syncthreads();
        skinny_reduce<3>(F.lds, F.tid);
        __syncthreads();
        if (F.tid < 32) { const int m = R0 + F.tid; const LAS float* l = LG + F.tid * 48;
            float gl[4];
#pragma unroll
            for (int i = 0; i < 4; ++i) gl[i] = l[i] + bg[i];
            int gi = 0; float gm = gl[0];
#pragma unroll
            for (int i = 1; i < 4; ++i) if (gl[i] > gm) { gm = gl[i]; gi = i; }
            float gs = 0.f;
#pragma unroll
            for (int i = 0; i < 4; ++i) gs += __expf(gl[i] - gm);
            const float gp = 1.0f / gs;
            float el[8];
#pragma unroll
            for (int e = 0; e < 8; ++e) el[e] = l[4 + 8 * gi + e] + be[gi * 8 + e];
            int e1 = 0; float v1 = el[0];
#pragma unroll
            for (int e = 1; e < 8; ++e) if (el[e] > v1) { v1 = el[e]; e1 = e; }
            int e2 = -1; float v2 = -3.0e38f;
#pragma unroll
            for (int e = 0; e < 8; ++e) if (e != e1 && el[e] > v2) { v2 = el[e]; e2 = e; }
            const float w1 = gp / (1.0f + __expf(v2 - v1)), w2 = gp - w1;
            const int ge1 = gi * 8 + e1, ge2 = gi * 8 + e2;
            const int p1 = (int)atomicAdd(cnt + ge1, 1u), p2 = (int)atomicAdd(cnt + ge2, 1u);
            ROUTE[(size_t)m * 2 + 0] = make_int4(ge1, p1, __builtin_bit_cast(int, w1), 0);
            ROUTE[(size_t)m * 2 + 1] = make_int4(ge2, p2, __builtin_bit_cast(int, w2), 0); }
    }
    __syncthreads();
}
__device__ __forceinline__ int moe_offsets(const unsigned* cnt, int lane, int* tiles_incl) {
    const int c = lane < 32 ? (int)cnt[lane] : 0; const int t = (c + 255) >> 8; int incl = t;
#pragma unroll
    for (int o = 1; o < 32; o <<= 1) { const int x = __shfl_up(incl, o); if ((lane & 31) >= o) incl += x; }
    *tiles_incl = incl; return (incl - t) * 256;
}
__device__ __forceinline__ void p_gather(Frame& F, int layer) {
    const int lane = F.lane; const unsigned* cnt = F.ctl + CW_CNT + layer * 64; int ti; const int off = moe_offsets(cnt, lane, &ti);
    const bf16* XB = (const bf16*)(F.ws + WS_XB); bf16* XG = (bf16*)(F.ws + WS_PROJ); float* ROWW = (float*)(F.ws + WS_ROWW); int4* ROUTE = (int4*)(F.ws + WS_ROUTE);
    for (int m = F.gw; m < MTOK; m += F.NGW) {
#pragma unroll
        for (int s = 0; s < 2; ++s) { int4 r = ROUTE[(size_t)m * 2 + s]; const int dst = __shfl(off, r.x) + r.y;
            const v4u* src = (const v4u*)(XB + (size_t)m * DM); v4u* d = (v4u*)(XG + (size_t)dst * DM);
#pragma unroll
            for (int j = 0; j < 4; ++j) d[64 * j + lane] = src[64 * j + lane];
            if (lane == 0) { ROWW[dst] = __builtin_bit_cast(float, r.z); r.w = dst; ROUTE[(size_t)m * 2 + s] = r; } }
    }
}
__device__ __forceinline__ void p_ln_ffn(Frame& F, const Args& a, int layer) {
    float* XR = (float*)(F.ws + WS_XR); bf16* XB = (bf16*)(F.ws + WS_XB); const int lane = F.lane; const bf16* YG = (const bf16*)(F.ws + WS_CST);
    const float* g = a.in[11] + layer * DM; const float* bb = a.in[12] + layer * DM; const int4* ROUTE = (const int4*)(F.ws + WS_ROUTE);
    float* dst = layer == 1 ? a.out : XR;
    const bf16* SKH = (const bf16*)(F.ws + WS_WSM) + (size_t)SK_SK1 * 2048; const bf16* SKL = SKH + (size_t)SK_NCOL * 2048;
    const float* c64 = (const float*)(F.ws + WS_ROPE) + 2 * 4096 * 64; const float* s64 = c64 + 4096 * 32;
    bf16* IK = (bf16*)(F.ws + WS_IK); float* IW = (float*)(F.ws + WS_IW);
    const LAS float* LG = (const LAS float*)(F.lds + SK_LG_OFF);
    for (int blk = blockIdx.x; blk < MTOK / 32; blk += F.G) { const int R0 = blk * 32;
#pragma unroll 1
        for (int i = 0; i < 4; ++i) { const int m = R0 + 4 * F.wave + i; f32x4 v[8];
            const int r0 = ROUTE[(size_t)m * 2].w, r1 = ROUTE[(size_t)m * 2 + 1].w;
#pragma unroll
            for (int j = 0; j < 8; ++j) { v[j] = *(const f32x4*)(XR + (size_t)m * DM + 256 * j + 4 * lane) * DN_ALPHA;
                const uint2 y0 = *(const uint2*)(YG + (size_t)r0 * DM + 256 * j + 4 * lane), y1 = *(const uint2*)(YG + (size_t)r1 * DM + 256 * j + 4 * lane);
                v[j][0] += bf2f(y0.x & 0xffff) + bf2f(y1.x & 0xffff); v[j][1] += bf2f(y0.x >> 16) + bf2f(y1.x >> 16);
                v[j][2] += bf2f(y0.y & 0xffff) + bf2f(y1.y & 0xffff); v[j][3] += bf2f(y0.y >> 16) + bf2f(y1.y >> 16); }
            ln_row(v, g, bb, lane);
#pragma unroll
            for (int j = 0; j < 8; ++j) *(f32x4*)(dst + (size_t)m * DM + 256 * j + 4 * lane) = v[j];
            if (layer == 0) store_row_bf16(XB + (size_t)m * DM, v, lane); }
        if (layer == 0) {
            __syncthreads();
            skinny_partials<5>(F.lds, XR + (size_t)R0 * DM, SKH, SKL, F.wave, lane);
            __syncthreads();
            skinny_reduce<5>(F.lds, F.tid);
            __syncthreads();
            for (int idx = F.tid; idx < 32 * 80; idx += NWAVES * 64) { const int row = idx / 80, c = idx % 80, m = R0 + row; const float v = LG[row * 80 + c];
                if (c < 64) { const float part = LG[row * 80 + (c ^ 32)]; const int pos = m & 4095, i = c & 31; const float cs = c64[pos * 32 + i], sn = s64[pos * 32 + i];
                    const int bq = m >> 12, sq = m & 4095; IK[((((size_t)bq * 128 + (sq >> 5)) * 4 + (c >> 4)) * 64 + ((c >> 3) & 1) * 32 + (sq & 31)) * 8 + (c & 7)] = (bf16)f2bf(c < 32 ? (v * cs - part * sn) : (v * cs + part * sn)); }
                else IW[(size_t)m * 16 + c - 64] = v * 0.25f * 0.125f; }
        }
    }
    __syncthreads();
}
__device__ __forceinline__ void ph_gla_b(Frame& F, const Args& a) {
    const float* SK0 = (const float*)(F.ws + WS_SK0); const float* w2 = a.in[2]; const float* gbias = a.in[3]; float* GB = (float*)(F.ws + WS_GB); float* DEC = (float*)(F.ws + WS_DEC);
    for (int u4 = blockIdx.x; u4 < 128; u4 += F.G) {
        const int unit = u4 * 4 + (F.tid >> 7), n = unit & 63, bh = unit >> 6, b = bh >> 2, h = bh & 3, d = F.tid & 127, t0 = b * SEQ + n * 64;
        float w[16];
#pragma unroll
        for (int r = 0; r < 16; ++r) w[r] = w2[r * 512 + h * 128 + d];
        const float gb = gbias[h * 128 + d]; float run = 0.f;
        for (int c = 0; c < 64; ++c) { const int t = t0 + c; float z = gb;
#pragma unroll
            for (int r = 0; r < 16; ++r) z += SK0[(size_t)t * 24 + r] * w[r];
            run += logsigmoidf(z) * (1.0f / 16.0f); GB[(size_t)t * 512 + h * 128 + d] = run; }
        DEC[unit * 128 + d] = __expf(run);
    }
}
__device__ __forceinline__ void ph_gla_state(Frame& F) {
    const bf16* PROJ = (const bf16*)(F.ws + WS_PROJ); const float* GB = (const float*)(F.ws + WS_GB); float* CST = (float*)(F.ws + WS_CST);
    for (int vb = blockIdx.x; vb < 512 * 64; vb += F.G) {
        const int unit = vb >> 6, d = (vb & 63) * 2 + (F.tid >> 8), v = F.tid & 255, n = unit & 63, bh = unit >> 6, b = bh >> 2, h = bh & 3, t0 = b * SEQ + n * 64;
        const float blast = GB[(size_t)(t0 + 63) * 512 + h * 128 + d]; float acc = 0.f;
        for (int c = 0; c < 64; ++c) { const size_t t = t0 + c; const float kk = bf2f(PROJ[t * NP0 + 512 + h * 128 + d]) * __expf(blast - GB[t * 512 + h * 128 + d]);
            acc += kk * bf2f(PROJ[t * NP0 + 1024 + h * 256 + v]); }
        CST[((size_t)unit * 256 + v) * 128 + d] = acc;
    }
}
__device__ __forceinline__ void ph_gla_scan(Frame& F) {
    const float* CST = (const float*)(F.ws + WS_CST); const float* DEC = (const float*)(F.ws + WS_DEC); bf16* PREVT = (bf16*)(F.ws + WS_PREVT);
    for (int idx = blockIdx.x * 512 + F.tid; idx < 8 * 32768; idx += F.G * 512) { const int bh = idx >> 15, vd = idx & 32767, d = vd & 127; float S = 0.f;
        for (int n = 0; n < 64; ++n) { const int unit = bh * 64 + n; PREVT[(size_t)unit * 32768 + vd] = (bf16)f2bf(S); S = DEC[unit * 128 + d] * S + CST[(size_t)unit * 32768 + vd]; } }
}
__device__ __forceinline__ void ph_gla_out(Frame& F, const Args& a) {
    const bf16* PROJ = (const bf16*)(F.ws + WS_PROJ); const float* GB = (const float*)(F.ws + WS_GB); const bf16* PREVT = (const bf16*)(F.ws + WS_PREVT); const float* normg = a.in[4]; bf16* OMIX = (bf16*)(F.ws + WS_OMIX);
    LAS float* qd = (LAS float*)F.lds; LAS float* ki = qd + 64 * 128; LAS float* sc = ki + 64 * 128; LAS float* red = sc + 64 * 64;
    const int tid = F.tid; const bool act = tid < 256;
    for (int unit = blockIdx.x; unit < 512; unit += F.G) {
        const int n = unit & 63, bh = unit >> 6, b = bh >> 2, h = bh & 3, t0 = b * SEQ + n * 64;
        __syncthreads();
        for (int i = tid; i < 64 * 128; i += 512) { const int c = i >> 7, d = i & 127; const size_t t = t0 + c; const float bb = GB[t * 512 + h * 128 + d];
            qd[i] = bf2f(PROJ[t * NP0 + h * 128 + d]) * ATT_SCALE * __expf(bb); ki[i] = bf2f(PROJ[t * NP0 + 512 + h * 128 + d]) * __expf(-bb); }
        __syncthreads();
        for (int p = tid; p < 64 * 64; p += 512) { const int i = p >> 6, j = p & 63; float s = 0.f;
            if (j <= i) for (int d = 0; d < 128; ++d) s += qd[i * 128 + d] * ki[j * 128 + d];
            sc[p] = s; }
        __syncthreads();
        const int v = tid & 255; const bf16* pv = PREVT + ((size_t)unit * 256 + v) * 128; const float gv = normg[v];
        for (int i = 0; i < 64; ++i) { float acc = 0.f;
            if (act) { for (int j = 0; j <= i; ++j) acc += sc[i * 64 + j] * bf2f(PROJ[(size_t)(t0 + j) * NP0 + 1024 + h * 256 + v]);
                for (int d = 0; d < 128; ++d) acc += qd[i * 128 + d] * bf2f(pv[d]);
                const float ss = wave_sum(acc * acc); if ((tid & 63) == 0) red[tid >> 6] = ss; }
            __syncthreads();
            const float ms = (red[0] + red[1] + red[2] + red[3]) * (1.0f / 256.0f); __syncthreads();
            if (act) { const float gr = bf2f(PROJ[(size_t)(t0 + i) * NP0 + 2048 + h * 256 + v]);
                const float o = acc * (1.0f / sqrtf(ms + LN_EPS)) * gv * (gr / (1.0f + __expf(-gr)));
                OMIX[(size_t)(t0 + i) * DM + h * 256 + v] = (bf16)f2bf(o); } }
    }
}
template <int MODE  >
__device__ __forceinline__ void ph_attn_naive(Frame& F, const bf16* Qb, int ldq, int qc0, const bf16* Kb, int ldk, int kc0, const bf16* Vb, int ldv, int vc0, int nheads, int group,
                                              const float* fbias, const unsigned long long* mask, bf16* O, int oc0) {
    const int half = F.tid >> 8, tid = F.tid & 255, qi = tid >> 2, part = tid & 3;
    LAS bf16* Ks = (LAS bf16*)(F.lds + half * 32768); LAS bf16* Vs = Ks + 64 * 128;
    const int nvb = (SEQ / 64) * (nheads / 2) * BATCH;
    for (int vb = blockIdx.x; vb < nvb; vb += F.G) {
        const int cc = vb >> 6, qb = ((vb & 63) + cc * 17) & 63, hp = cc % (nheads / 2), b = cc / (nheads / 2), h = hp * 2 + half, kvh = h / group;
        const int qpos = qb * 64 + qi; const size_t row = (size_t)b * SEQ + qpos;
        float qv[32], o[32];
#pragma unroll
        for (int d = 0; d < 32; ++d) { qv[d] = bf2f(Qb[row * ldq + qc0 + h * 128 + part * 32 + d]); o[d] = 0.f; }
        float mrun = -1e30f, l = 0.f;
        const float* fb = MODE == 0 ? fbias + (size_t)(b * 8 + h) * SEQ : nullptr;
        for (int kt = 0; kt <= qb; ++kt) {
            __syncthreads();
            for (int i = tid; i < 64 * 16; i += 256) { const int r = i >> 4, c8 = (i & 15) * 8; const size_t kr = (size_t)b * SEQ + kt * 64 + r;
                *(LAS v4u*)(Ks + r * 128 + c8) = *(const v4u*)(Kb + kr * ldk + kc0 + kvh * 128 + c8); *(LAS v4u*)(Vs + r * 128 + c8) = *(const v4u*)(Vb + kr * ldv + vc0 + kvh * 128 + c8); }
            __syncthreads();
            unsigned long long mw = ~0ull; if (MODE == 1) mw = mask[row * 64 + kt];
            for (int s = 0; s < 64; ++s) { const int key = kt * 64 + s; float p = 0.f;
#pragma unroll
                for (int d = 0; d < 32; ++d) p += qv[d] * bf2f(Ks[s * 128 + part * 32 + d]);
                p += __shfl_xor(p, 1); p += __shfl_xor(p, 2);
                const bool valid = key <= qpos && ((mw >> s) & 1ull);
                if (valid) { const float logit = (p + (MODE == 0 ? fb[key] : 0.f)) * ATT_SCALE; const float mn = fmaxf(mrun, logit), al = __expf(mrun - mn), pp = __expf(logit - mn);
                    l = l * al + pp; mrun = mn;
#pragma unroll
                    for (int d = 0; d < 32; ++d) o[d] = o[d] * al + pp * bf2f(Vs[s * 128 + part * 32 + d]); } }
        }
        const float il = 1.0f / l;
#pragma unroll
        for (int d = 0; d < 32; ++d) O[row * DM + oc0 + h * 128 + part * 32 + d] = (bf16)f2bf(o[d] * il);
    }
    __syncthreads();
}
__device__ __forceinline__ void ph_idx_scores(Frame& F) {
    const bf16* PROJ1 = (const bf16*)(F.ws + WS_PROJ); const bf16* IK = (const bf16*)(F.ws + WS_IK); const float* IW = (const float*)(F.ws + WS_IW); float* SC = (float*)(F.ws + WS_SC);
    LAS float* q = (LAS float*)F.lds; LAS float* w = q + 1024; const int tid = F.tid;
    for (int m = blockIdx.x; m < MTOK; m += F.G) { const int pos = m & 4095, b = m >> 12;
        __syncthreads();
        for (int i = tid; i < 1024; i += 512) q[i] = bf2f(PROJ1[(size_t)m * NP1 + 3072 + i]);
        if (tid < 16) w[tid] = IW[(size_t)m * 16 + tid];
        __syncthreads();
        for (int s = tid; s <= pos; s += 512) { const bf16* kr = IK + ((size_t)b * SEQ + s) * 64; float kk[64];
#pragma unroll
            for (int d = 0; d < 64; ++d) kk[d] = bf2f(kr[d]);
            float sc = 0.f;
#pragma unroll 1
            for (int hh = 0; hh < 16; ++hh) { float dsum = 0.f;
#pragma unroll
                for (int d = 0; d < 64; ++d) dsum += q[hh * 64 + d] * kk[d];
                sc += w[hh] * fmaxf(dsum, 0.f); }
            SC[(size_t)m * SEQ + s] = sc; }
    }
    __syncthreads();
}
namespace attn {
constexpr int D = 128, NW = 8, QBLK = 32, KVBLK = 64, QB = NW * QBLK;
constexpr int SHM_V = KVBLK * D * 2, SHM_K = KVBLK * D * 2;
constexpr int OFF_WS = 2 * SHM_V + 2 * SHM_K, OFF_BIAS = OFF_WS + NW * 64 * 4, LDS_NEED = OFF_BIAS + 2 * 16384;
constexpr float SCALE = 0.08838834764831845f, THR = 8.f;
typedef short s16x4 __attribute__((ext_vector_type(4)));
typedef float f32x16 __attribute__((ext_vector_type(16)));
typedef unsigned u32x4 __attribute__((ext_vector_type(4)));
#define KSWZ(row, colB) ((row) * 256 + ((colB) ^ (((row) & 7) << 4)))
#define SBAR() __builtin_amdgcn_sched_barrier(0)
__device__ __forceinline__ int v_st(int k, int c) { const int kk = (k & ~0xC) | ((k & 4) << 1) | ((k & 8) >> 1); return ((kk >> 3) * 4 + (c >> 5)) * 512 + ((kk & 7) * 32 + (c & 31)) * 2; }
__device__ __forceinline__ int v_rd_base(int lane) { return ((lane & 3) << 3) | (((lane >> 2) & 3) << 6) | (((lane >> 4) & 1) << 5) | (((lane >> 5) & 1) << 8); }
constexpr int v_rd_off(int d0, int ks, int half) { return d0 * 512 + ks * 4096 + half * 2048; }
__device__ __forceinline__ int crow(int r, int hi) { return (r & 3) + 8 * (r >> 2) + 4 * hi; }
__device__ __forceinline__ unsigned cvtpk(float lo, float hi) { unsigned r; asm volatile("v_cvt_pk_bf16_f32 %0, %1, %2" : "=v"(r) : "v"(lo), "v"(hi)); return r; }
__device__ __forceinline__ bf16x8 load8(const bf16* p) { return *reinterpret_cast<const bf16x8*>(p); }
__device__ __forceinline__ void mask_tile(f32x16& p0, f32x16& p1, int dq) {
    const float NEG = -__builtin_inff();
#pragma unroll
    for (int r = 0; r < 16; ++r) { const int c = (r & 3) + 8 * (r >> 2); if (dq - c < 0) p0[r] = NEG; if (dq - c - 32 < 0) p1[r] = NEG; }
}
__device__ __forceinline__ void mask_bits(f32x16& p0, f32x16& p1, unsigned w0, unsigned w1) {
    const float NEG = -__builtin_inff();
#pragma unroll
    for (int r = 0; r < 16; ++r) { const unsigned c = (r & 3) + 8 * (r >> 2); if (!(w0 & (1u << c))) p0[r] = NEG; if (!(w1 & (1u << c))) p1[r] = NEG; }
}
__device__ __forceinline__ void partialSM(f32x16& p0, f32x16& p1, float& m_reg, float& mn, float& alpha) {
    float pmax = p0[0]; for (int r = 1; r < 16; ++r) pmax = fmaxf(pmax, p0[r]); for (int r = 0; r < 16; ++r) pmax = fmaxf(pmax, p1[r]);
    { auto rr = __builtin_amdgcn_permlane32_swap(__float_as_uint(pmax), __float_as_uint(pmax), false, false);
      pmax = fmaxf(__uint_as_float(rr[0]), __uint_as_float(rr[1])); }
    constexpr float C2 = 1.4426950408889634f * SCALE;
    if (__builtin_expect(__all((pmax - m_reg) * SCALE <= THR), 1)) { mn = m_reg; alpha = 1.f; }
    else { mn = fmaxf(m_reg, pmax); alpha = __builtin_amdgcn_exp2f((m_reg - mn) * C2); m_reg = mn; }
    const float mnL = -mn * C2;
    for (int r = 0; r < 16; ++r) p0[r] = fmaf(p0[r], C2, mnL); for (int r = 0; r < 16; ++r) p1[r] = fmaf(p1[r], C2, mnL);
    for (int r = 0; r < 16; ++r) p0[r] = __builtin_amdgcn_exp2f(p0[r]);
}
__device__ __forceinline__ void finishSM(f32x16& p0, f32x16& p1, float alpha, float& l_reg, bf16x8& pa0, bf16x8& pa1, bf16x8& pa2, bf16x8& pa3) {
    for (int r = 0; r < 16; ++r) p1[r] = __builtin_amdgcn_exp2f(p1[r]);
    float ps = 0; for (int r = 0; r < 16; ++r) ps += p0[r]; for (int r = 0; r < 16; ++r) ps += p1[r];
    { auto rr = __builtin_amdgcn_permlane32_swap(__float_as_uint(ps), __float_as_uint(ps), false, false);
      ps = __uint_as_float(rr[0]) + __uint_as_float(rr[1]); }
    l_reg = l_reg * alpha + ps;
#define PK4(P, B_, OUT) do { unsigned a0 = cvtpk(P[B_+0], P[B_+1]), a1 = cvtpk(P[B_+2], P[B_+3]);                          \
        unsigned b0 = cvtpk(P[B_+4], P[B_+5]), b1 = cvtpk(P[B_+6], P[B_+7]);                                             \
        auto r0 = __builtin_amdgcn_permlane32_swap(a0, b0, false, false); auto r1 = __builtin_amdgcn_permlane32_swap(a1, b1, false, false); \
        u32x4 w = {r0[0], r1[0], r0[1], r1[1]}; OUT = *reinterpret_cast<bf16x8*>(&w); } while (0)
    PK4(p0, 0, pa0); PK4(p0, 8, pa1); PK4(p1, 0, pa2); PK4(p1, 8, pa3);
#undef PK4
}
template <int KB, bool BIAS>
__device__ __forceinline__ void qkt(f32x16& p0, f32x16& p1, const char* K_lds, int r32, int hi, const bf16x8* qr, const char* bl) {
    p0 = f32x16{}; p1 = f32x16{}; (void)bl;
    const char* kb[4];
#pragma unroll
    for (int dd = 0; dd < 4; ++dd) kb[dd] = K_lds + KB * SHM_K + KSWZ(r32, (dd * 16 + hi * 8) * 2);
#pragma unroll
    for (int d0 = 0; d0 < 8; ++d0) { const char* a = kb[d0 & 3] + (d0 >> 2) * 128;
        bf16x8 b0 = *reinterpret_cast<const bf16x8*>(a);
        bf16x8 b1 = *reinterpret_cast<const bf16x8*>(a + 32 * 256);
        p0 = __builtin_amdgcn_mfma_f32_32x32x16_bf16(b0, qr[d0], p0, 0, 0, 0);
        p1 = __builtin_amdgcn_mfma_f32_32x32x16_bf16(b1, qr[d0], p1, 0, 0, 0); }
}
template <int VB>
__device__ __forceinline__ void pv_tile(f32x16* o, int vb0, bf16x8 pa0, bf16x8 pa1, bf16x8 pa2, bf16x8 pa3) {
#define TRRD(dst, off) asm volatile("ds_read_b64_tr_b16 %0, %1 offset:%2" : "=&v"(dst) : "v"(vb0), "i"(off) : "memory")
#define PV_D0(d0) do { s16x4 l0, l1, l2, l3, h0, h1, h2, h3; constexpr int b_ = VB * SHM_V + v_rd_off(d0, 0, 0); \
        TRRD(l0, b_); TRRD(h0, b_ + 2048); TRRD(l1, b_ + 4096); TRRD(h1, b_ + 6144); TRRD(l2, b_ + 8192); TRRD(h2, b_ + 10240); TRRD(l3, b_ + 12288); TRRD(h3, b_ + 14336); \
        asm volatile("s_waitcnt lgkmcnt(0)" ::: "memory"); SBAR();   \
        o[d0] = __builtin_amdgcn_mfma_f32_32x32x16_bf16(pa0, (bf16x8){l0[0], l0[1], l0[2], l0[3], h0[0], h0[1], h0[2], h0[3]}, o[d0], 0, 0, 0);   \
        o[d0] = __builtin_amdgcn_mfma_f32_32x32x16_bf16(pa1, (bf16x8){l1[0], l1[1], l1[2], l1[3], h1[0], h1[1], h1[2], h1[3]}, o[d0], 0, 0, 0);   \
        o[d0] = __builtin_amdgcn_mfma_f32_32x32x16_bf16(pa2, (bf16x8){l2[0], l2[1], l2[2], l2[3], h2[0], h2[1], h2[2], h2[3]}, o[d0], 0, 0, 0);   \
        o[d0] = __builtin_amdgcn_mfma_f32_32x32x16_bf16(pa3, (bf16x8){l3[0], l3[1], l3[2], l3[3], h3[0], h3[1], h3[2], h3[3]}, o[d0], 0, 0, 0); } while (0)
    PV_D0(0); PV_D0(1); PV_D0(2); PV_D0(3);
#undef PV_D0
#undef TRRD
}
struct BlockRef { const bf16* Q; const bf16* K; const bf16* V; bf16* O; int P0; const float* fb; const unsigned long long* mrow; };
struct Seam { bf16x8 qr[8]; bf16x8 st_v0, st_v1, st_k0, st_k1; };
#define VMW() asm volatile("s_waitcnt vmcnt(0)" ::: "memory")
#define VMWN(n) asm volatile("s_waitcnt vmcnt(%0)" :: "i"(n) : "memory")
#define SLOAD_H(Kp, Vp, k0) do { const bf16* kt_ = (Kp) + (size_t)(k0) * KS; const bf16* vt_ = (Vp) + (size_t)(k0) * KS; S.st_v0 = load8(vt_ + koff); S.st_v1 = load8(vt_ + koff + 32 * KS); S.st_k0 = load8(kt_ + koff); S.st_k1 = load8(kt_ + koff + 32 * KS); } while (0)
#define SWRITE_HK(bf) do { *(bf16x8*)(K_lds + (bf) * SHM_K + kws) = S.st_k0; *(bf16x8*)(K_lds + (bf) * SHM_K + kws + 32 * 256) = S.st_k1; } while (0)
#define SWRITE_HV(bf) do { *(bf16x8*)(V_lds + (bf) * SHM_V + vst0) = S.st_v0; *(bf16x8*)(V_lds + (bf) * SHM_V + vst1) = S.st_v1; } while (0)
#define SWRITE_H(bf) do { SWRITE_HV(bf); SWRITE_HK(bf); } while (0)
template <bool BIAS, bool BITMASK, int QS, int KS, int OS>
__device__ __forceinline__ void attn_block(const BlockRef& cur, char* lds, LAS unsigned char* ldsl) {
    int tid_ = threadIdx.x; asm volatile("" : "+v"(tid_));
    const int tid = tid_, wid = __builtin_amdgcn_readfirstlane(tid >> 6), lane = tid & 63, r32 = lane & 31, hi = lane >> 5;
    const int NT = (cur.P0 + QB - 1) / KVBLK + 1;
    const int qlo = cur.P0 + wid * QBLK, qm = qlo + r32 - 4 * hi;
    char* V_lds = lds; char* K_lds = lds + 2 * SHM_V;
    float* ws = (float*)(lds + OFF_WS) + wid * 64; float* li_l = ws, * al_l = ws + 32;
    const LAS unsigned char* bl0 = ldsl + OFF_BIAS + hi * 16;
    float m_reg = -1e30f, l_reg = 0; f32x16 o[4] = {};
    const int sr = tid >> 4, sc = (tid & 15) * 8, vst0 = v_st(sr, sc), vst1 = v_st(32 + sr, sc), kws = KSWZ(sr, sc * 2);
    const int vb0 = (int)(uintptr_t)V_lds + v_rd_base(lane);
    const bf16* Kh = cur.K; const bf16* Vh = cur.V;
    const int moff = (wid * QBLK + r32) * 64, koff = sr * KS + sc, qoff = (wid * QBLK + r32) * QS + hi * 8;
    Seam S;
#pragma unroll
    for (int d0 = 0; d0 < 8; ++d0) S.qr[d0] = load8(cur.Q + qoff + d0 * 16);
    if constexpr (BIAS) { const f32x4 b0_ = *(const f32x4*)(cur.fb + tid * 8), b1_ = *(const f32x4*)(cur.fb + tid * 8 + 4);
        *(LAS f32x4*)(ldsl + OFF_BIAS + tid * 32) = b0_; *(LAS f32x4*)(ldsl + OFF_BIAS + tid * 32 + 16) = b1_; }
    SLOAD_H(Kh, Vh, 0); VMW(); SWRITE_HK(0); SWRITE_HV(0); SBAR();
#define RESC(a) do { if (__any((a) < 1.f)) { if (hi == 0) al_l[r32] = (a); asm volatile("s_waitcnt lgkmcnt(0)" ::: "memory");              \
                     for (int d_ = 0; d_ < 4; ++d_) for (int r = 0; r < 16; ++r) o[d_][r] *= al_l[crow(r, hi)]; } } while (0)
#define KBASE(t) ((t) * KVBLK)
#define MLOAD(MW, t) do { if constexpr (BITMASK) MW = (cur.mrow + (t))[moff]; } while (0)
#define MASKT(P0_, P1_, MW, t) do { if constexpr (BIAS) { const LAS unsigned char* bl_ = bl0 + KBASE(t) * 4; _Pragma("unroll") for (int g = 0; g < 4; ++g) { const f32x4 a_ = *(const LAS f32x4*)(bl_ + g * 32), b_ = *(const LAS f32x4*)(bl_ + 128 + g * 32); \
            P0_[4 * g] += a_[0]; P0_[4 * g + 1] += a_[1]; P0_[4 * g + 2] += a_[2]; P0_[4 * g + 3] += a_[3]; P1_[4 * g] += b_[0]; P1_[4 * g + 1] += b_[1]; P1_[4 * g + 2] += b_[2]; P1_[4 * g + 3] += b_[3]; } } \
        if constexpr (BITMASK) { mask_bits(P0_, P1_, (unsigned)(MW) >> (4 * hi), (unsigned)((MW) >> 32) >> (4 * hi)); } \
        else { const int kb_ = KBASE(t); if (kb_ + KVBLK - 1 > qlo) mask_tile(P0_, P1_, qm - kb_); } } while (0)
    f32x16 pA0, pA1, pB0, pB1; float mnA, mnB, alA, alB; bf16x8 pa0, pa1, pa2, pa3; unsigned long long mwA = 0, mwB = 0;
    MLOAD(mwA, 0);
    SLOAD_H(Kh, Vh, KBASE(1)); MLOAD(mwB, 1);
    __syncthreads();
    SBAR(); qkt<0, BIAS>(pA0, pA1, K_lds, r32, hi, S.qr, nullptr);
    MASKT(pA0, pA1, mwA, 0); partialSM(pA0, pA1, m_reg, mnA, alA);
    VMW(); SWRITE_H(1);
    __syncthreads();
#define HALF_STEP(PX0, PX1, mnX, alX, MWX, PY0, PY1, alY, MWY, t, KB, VB, SB) do {                                            \
        SBAR(); qkt<KB, BIAS>(PX0, PX1, K_lds, r32, hi, S.qr, nullptr);                                                       \
        finishSM(PY0, PY1, alY, l_reg, pa0, pa1, pa2, pa3); SBAR();                                                           \
        if ((t) + 1 < NT) { SLOAD_H(Kh, Vh, KBASE((t) + 1)); MLOAD(MWY, (t) + 1); SBAR(); }                                   \
        pv_tile<VB>(o, vb0, pa0, pa1, pa2, pa3); MASKT(PX0, PX1, MWX, (t)); partialSM(PX0, PX1, m_reg, mnX, alX);             \
        __syncthreads();                                                                                                      \
        if ((t) + 1 < NT) { VMW(); SWRITE_H(SB); }                                                                            \
        RESC(alX); __syncthreads(); } while (0)
    for (int t = 1; t + 1 < NT; t += 2) {
        HALF_STEP(pB0, pB1, mnB, alB, mwB, pA0, pA1, alA, mwA, t, 1, 0, 0);
        HALF_STEP(pA0, pA1, mnA, alA, mwA, pB0, pB1, alB, mwB, t + 1, 0, 1, 1);
    }
    SBAR(); qkt<1, BIAS>(pB0, pB1, K_lds, r32, hi, S.qr, nullptr); SBAR();
    finishSM(pA0, pA1, alA, l_reg, pa0, pa1, pa2, pa3); SBAR();
    pv_tile<0>(o, vb0, pa0, pa1, pa2, pa3);
    MASKT(pB0, pB1, mwB, NT - 1); partialSM(pB0, pB1, m_reg, mnB, alB); __syncthreads(); RESC(alB);
    finishSM(pB0, pB1, alB, l_reg, pa0, pa1, pa2, pa3); SBAR(); pv_tile<1>(o, vb0, pa0, pa1, pa2, pa3);
    SBAR();
    if (hi == 0) li_l[r32] = l_reg; asm volatile("s_waitcnt lgkmcnt(0)" ::: "memory");
    float rli[16];
#pragma unroll
    for (int r = 0; r < 16; ++r) rli[r] = __builtin_amdgcn_rcpf(li_l[crow(r, hi)]);
    int tid2_ = threadIdx.x; asm volatile("" : "+v"(tid2_));
    const int r32e = tid2_ & 31, hie = (tid2_ >> 5) & 1, ooff = (wid * QBLK + 4 * hie) * OS + r32e;
#pragma unroll
    for (int r = 0; r < 16; ++r) {
#pragma unroll
        for (int d0 = 0; d0 < 4; ++d0) { const float v = o[d0][r] * rli[r]; const float vn = __shfl_xor(v, 1);
            if ((r32e & 1) == 0) *(unsigned*)(cur.O + ((r & 3) + 8 * (r >> 2)) * OS + d0 * 32 + ooff) = cvtpk(v, vn); } }
    __syncthreads();
#undef RESC
#undef KBASE
#undef MLOAD
#undef MASKT
#undef HALF_STEP
}
#undef ROWK
#undef VMW
#undef VMWN
#undef SLOAD_H
#undef SWRITE_HK
#undef SWRITE_HV
#undef SWRITE_H
#undef KSWZ
#undef SBAR
template <bool BIAS, bool BITMASK, int NH, int GROUP, bool PAIR, int QS, int KS, int OS>
__device__ __forceinline__ void attn_phase(char* lds, LAS unsigned char* ldsl, const bf16* Q, const bf16* K, const bf16* V, bf16* O, const float* fbias, const unsigned long long* mask, int G, int bid) {
    constexpr int NBLK = BATCH * NH * 16, NITEM = PAIR ? NBLK / 2 : NBLK, PER = PAIR ? 8 : 16, SETH = BATCH * NH / 8;
    for (int L = bid; L < NITEM; L += G) {
#pragma unroll 1
        for (int pass = 0; pass < (PAIR ? 2 : 1); ++pass) {
            const int g = L & 7, k = L >> 3, hs = k / PER, x = k % PER; const int bh = g * SETH + hs, b = bh / NH, h = bh % NH;
            const int qb = PAIR ? (pass ? 15 - x : x) : 15 - x; BlockRef r; const size_t row0 = (size_t)b * SEQ + (size_t)qb * QB;
            r.Q = Q + row0 * QS + h * D; r.O = O + row0 * OS + h * D; r.K = K + (size_t)b * SEQ * KS + (h / GROUP) * D; r.V = V + (size_t)b * SEQ * KS + (h / GROUP) * D; r.P0 = qb * QB;
            r.fb = BIAS ? fbias + (size_t)bh * SEQ : nullptr; r.mrow = BITMASK ? mask + row0 * 64 : nullptr;
            attn_block<BIAS, BITMASK, QS, KS, OS>(r, lds, ldsl);
        }
    }
}
}
__device__ __forceinline__ float fast_silu(float g) { return g * __builtin_amdgcn_rcpf(1.0f + __expf(-g)); }
__device__ __forceinline__ void ph_gla_a(Frame& F, const Args& a) {
    const float* SK0 = (const float*)(F.ws + WS_SK0); const float* w2 = a.in[2]; const float* gbias = a.in[3]; float* GB = (float*)(F.ws + WS_GB); float* DEC = (float*)(F.ws + WS_DEC);
    const bf16* PROJ = (const bf16*)(F.ws + WS_PROJ); float* CST = (float*)(F.ws + WS_CST);
    LAS float* BSH = (LAS float*)F.lds; LAS float* TOT = BSH + 64 * 128; LAS bf16* VT = (LAS bf16*)(F.lds + 36864); LAS bf16* KET = (LAS bf16*)(F.lds + 73728);
    const int tid = F.tid, lane = F.lane, l15 = lane & 15, quad = lane >> 4, w = F.wave;
    for (int unit = blockIdx.x; unit < 512; unit += F.G) {
        const int n = unit & 63, bh = unit >> 6, b = bh >> 2, h = bh & 3, t0 = b * SEQ + n * 64;
        __syncthreads();
        {
            const int d = tid & 127, cg = tid >> 7; float wv[16];
#pragma unroll
            for (int r = 0; r < 16; ++r) wv[r] = w2[r * 512 + h * 128 + d];
            const float gb = gbias[h * 128 + d]; float run = 0.f;
            for (int cc = 0; cc < 16; ++cc) { const int c = cg * 16 + cc; const float* sk = SK0 + (size_t)(t0 + c) * 24; float z = gb;
#pragma unroll
                for (int r = 0; r < 16; ++r) z += sk[r] * wv[r];
                run += logsigmoidf(z) * (1.0f / 16.0f); BSH[c * 128 + d] = run; }
            TOT[cg * 128 + d] = run;
            __syncthreads();
            float pre = 0.f;
            for (int g = 0; g < cg; ++g) pre += TOT[g * 128 + d];
            for (int cc = 0; cc < 16; ++cc) { const int c = cg * 16 + cc; const float v = BSH[c * 128 + d] + pre; BSH[c * 128 + d] = v; GB[(size_t)(t0 + c) * 512 + h * 128 + d] = v; }
        }
        __syncthreads();
        {
            const int c = tid & 63, g8 = tid >> 6; const size_t t = (size_t)(t0 + c);
            const bf16* kp = PROJ + t * NP0 + 512 + h * 128 + g8 * 16;
            const v4u k0 = *(const v4u*)kp, k1 = *(const v4u*)(kp + 8);
            const unsigned kw[8] = {k0.x, k0.y, k0.z, k0.w, k1.x, k1.y, k1.z, k1.w};
#pragma unroll
            for (int i = 0; i < 8; ++i) { const int d = g8 * 16 + 2 * i; const float e0 = __expf(BSH[63 * 128 + d] - BSH[c * 128 + d]), e1 = __expf(BSH[63 * 128 + d + 1] - BSH[c * 128 + d + 1]);
                KET[d * 72 + c] = (bf16)f2bf(bf2f(kw[i] & 0xffff) * e0); KET[(d + 1) * 72 + c] = (bf16)f2bf(bf2f(kw[i] >> 16) * e1); }
            const bf16* vp = PROJ + t * NP0 + 1024 + h * 256 + g8 * 32;
#pragma unroll
            for (int q = 0; q < 4; ++q) { const v4u vv = *(const v4u*)(vp + 8 * q); const unsigned vw[4] = {vv.x, vv.y, vv.z, vv.w};
#pragma unroll
                for (int i = 0; i < 4; ++i) { const int v = g8 * 32 + q * 8 + 2 * i; VT[v * 72 + c] = (bf16)(vw[i] & 0xffff); VT[(v + 1) * 72 + c] = (bf16)(vw[i] >> 16); } }
            if (tid < 128) DEC[unit * 128 + tid] = __expf(BSH[63 * 128 + tid]);
        }
        __syncthreads();
        {
            pg8::f32x4 acc[2][8];
#pragma unroll
            for (int i = 0; i < 2; ++i)
#pragma unroll
                for (int nn = 0; nn < 8; ++nn) acc[i][nn] = (pg8::f32x4){0.f, 0.f, 0.f, 0.f};
#pragma unroll
            for (int kk = 0; kk < 64; kk += 32) {
                const bf16x8 a0 = *(const LAS bf16x8*)(VT + (32 * w + l15) * 72 + kk + quad * 8), a1 = *(const LAS bf16x8*)(VT + (32 * w + 16 + l15) * 72 + kk + quad * 8);
#pragma unroll
                for (int nn = 0; nn < 8; ++nn) { const bf16x8 bb = *(const LAS bf16x8*)(KET + (16 * nn + l15) * 72 + kk + quad * 8);
                    acc[0][nn] = __builtin_amdgcn_mfma_f32_16x16x32_bf16(a0, bb, acc[0][nn], 0, 0, 0); acc[1][nn] = __builtin_amdgcn_mfma_f32_16x16x32_bf16(a1, bb, acc[1][nn], 0, 0, 0); } }
            float* cp = CST + (size_t)unit * 32768;
#pragma unroll
            for (int i = 0; i < 2; ++i)
#pragma unroll
                for (int nn = 0; nn < 8; ++nn)
#pragma unroll
                    for (int j = 0; j < 4; ++j) cp[(32 * w + 16 * i + quad * 4 + j) * 128 + 16 * nn + l15] = acc[i][nn][j];
        }
    }
    __syncthreads();
}
__device__ __forceinline__ void ph_gla_c(Frame& F, const Args& a) {
    const bf16* PROJ = (const bf16*)(F.ws + WS_PROJ); const float* GB = (const float*)(F.ws + WS_GB); const bf16* PREVT = (const bf16*)(F.ws + WS_PREVT); const float* normg = a.in[4]; bf16* OMIX = (bf16*)(F.ws + WS_OMIX);
    LAS bf16* QD = (LAS bf16*)(F.lds + 32768); LAS bf16* KI = (LAS bf16*)(F.lds + 50176); LAS bf16* P = (LAS bf16*)(F.lds + 67584); LAS bf16* VT = (LAS bf16*)(F.lds + 76800); LAS float* RED = (LAS float*)(F.lds + 113664);
    const int tid = F.tid, lane = F.lane, l15 = lane & 15, quad = lane >> 4, w = F.wave;
    for (int unit = blockIdx.x; unit < 512; unit += F.G) {
        const int n = unit & 63, bh = unit >> 6, b = bh >> 2, h = bh & 3, t0 = b * SEQ + n * 64;
        __syncthreads();
        {
            const int c = tid >> 3, dg = tid & 7; const size_t t = (size_t)(t0 + c);
            const float* bp = GB + t * 512 + h * 128 + dg * 16; const bf16* qp = PROJ + t * NP0 + h * 128 + dg * 16; const bf16* kp = PROJ + t * NP0 + 512 + h * 128 + dg * 16;
#pragma unroll
            for (int q8 = 0; q8 < 2; ++q8) { const v4u qq = *(const v4u*)(qp + 8 * q8), kk = *(const v4u*)(kp + 8 * q8); const f32x4 b0 = *(const f32x4*)(bp + 8 * q8), b1 = *(const f32x4*)(bp + 8 * q8 + 4);
                const unsigned qw[4] = {qq.x, qq.y, qq.z, qq.w}, kw[4] = {kk.x, kk.y, kk.z, kk.w}; const float bv[8] = {b0[0], b0[1], b0[2], b0[3], b1[0], b1[1], b1[2], b1[3]};
                v4u oq, ok; unsigned* oqp = (unsigned*)&oq; unsigned* okp = (unsigned*)&ok;
#pragma unroll
                for (int i = 0; i < 4; ++i) { const float e0 = __expf(bv[2 * i]), e1 = __expf(bv[2 * i + 1]);
                    oqp[i] = pk2(bf2f(qw[i] & 0xffff) * ATT_SCALE * e0, bf2f(qw[i] >> 16) * ATT_SCALE * e1);
                    okp[i] = pk2(bf2f(kw[i] & 0xffff) * __builtin_amdgcn_rcpf(e0), bf2f(kw[i] >> 16) * __builtin_amdgcn_rcpf(e1)); }
                *(LAS v4u*)(QD + c * 136 + dg * 16 + 8 * q8) = oq; *(LAS v4u*)(KI + c * 136 + dg * 16 + 8 * q8) = ok; }
            const int c2 = tid & 63, g8 = tid >> 6; const bf16* vp = PROJ + (size_t)(t0 + c2) * NP0 + 1024 + h * 256 + g8 * 32;
#pragma unroll
            for (int q = 0; q < 4; ++q) { const v4u vv = *(const v4u*)(vp + 8 * q); const unsigned vw[4] = {vv.x, vv.y, vv.z, vv.w};
#pragma unroll
                for (int i = 0; i < 4; ++i) { const int v = g8 * 32 + q * 8 + 2 * i; VT[v * 72 + c2] = (bf16)(vw[i] & 0xffff); VT[(v + 1) * 72 + c2] = (bf16)(vw[i] >> 16); } }
        }
        __syncthreads();
        {
            const int ti = w >> 1;
#pragma unroll
            for (int s = 0; s < 2; ++s) { const int tj = 2 * (w & 1) + s; pg8::f32x4 acc = (pg8::f32x4){0.f, 0.f, 0.f, 0.f};
                if (tj <= ti) {
#pragma unroll
                    for (int kk = 0; kk < 128; kk += 32) { const bf16x8 aa = *(const LAS bf16x8*)(QD + (16 * ti + l15) * 136 + kk + quad * 8), bb = *(const LAS bf16x8*)(KI + (16 * tj + l15) * 136 + kk + quad * 8);
                        acc = __builtin_amdgcn_mfma_f32_16x16x32_bf16(aa, bb, acc, 0, 0, 0); } }
#pragma unroll
                for (int j = 0; j < 4; ++j) { const int i = 16 * ti + quad * 4 + j, jj = 16 * tj + l15; P[i * 72 + jj] = (bf16)f2bf(jj <= i ? acc[j] : 0.f); } }
        }
        __syncthreads();
        {
            const int ti = w >> 1, half = w & 1; pg8::f32x4 acc[8];
#pragma unroll
            for (int nn = 0; nn < 8; ++nn) acc[nn] = (pg8::f32x4){0.f, 0.f, 0.f, 0.f};
#pragma unroll
            for (int kk = 0; kk < 64; kk += 32) { const bf16x8 aa = *(const LAS bf16x8*)(P + (16 * ti + l15) * 72 + kk + quad * 8);
#pragma unroll
                for (int nn = 0; nn < 8; ++nn) { const bf16x8 bb = *(const LAS bf16x8*)(VT + (128 * half + 16 * nn + l15) * 72 + kk + quad * 8); acc[nn] = __builtin_amdgcn_mfma_f32_16x16x32_bf16(aa, bb, acc[nn], 0, 0, 0); } }
            const bf16* pv = PREVT + (size_t)unit * 32768 + (size_t)(128 * half + l15) * 128 + quad * 8;
#pragma unroll
            for (int kk = 0; kk < 128; kk += 32) { const bf16x8 aa = *(const LAS bf16x8*)(QD + (16 * ti + l15) * 136 + kk + quad * 8);
#pragma unroll
                for (int nn = 0; nn < 8; ++nn) { const bf16x8 bb = *(const bf16x8*)(pv + (size_t)(16 * nn) * 128 + kk); acc[nn] = __builtin_amdgcn_mfma_f32_16x16x32_bf16(aa, bb, acc[nn], 0, 0, 0); } }
            float ss[4];
#pragma unroll
            for (int j = 0; j < 4; ++j) { float s = 0.f;
#pragma unroll
                for (int nn = 0; nn < 8; ++nn) s += acc[nn][j] * acc[nn][j];
                s += __shfl_xor(s, 1); s += __shfl_xor(s, 2); s += __shfl_xor(s, 4); s += __shfl_xor(s, 8); ss[j] = s; }
            if (l15 == 0) {
#pragma unroll
                for (int j = 0; j < 4; ++j) RED[(16 * ti + quad * 4 + j) * 2 + half] = ss[j]; }
            __syncthreads();
#pragma unroll
            for (int j = 0; j < 4; ++j) { const int i = 16 * ti + quad * 4 + j; const float ms = (RED[i * 2] + RED[i * 2 + 1]) * (1.0f / 256.0f); const float rs = 1.0f / sqrtf(ms + LN_EPS);
                const size_t t = (size_t)(t0 + i);
#pragma unroll
                for (int nn = 0; nn < 8; ++nn) { const int v = 128 * half + 16 * nn + l15; const float gr = bf2f(PROJ[t * NP0 + 2048 + h * 256 + v]);
                    OMIX[t * DM + h * 256 + v] = (bf16)f2bf(acc[nn][j] * rs * normg[v] * fast_silu(gr)); } }
        }
    }
    __syncthreads();
}
__device__ __forceinline__ void ph_indexer(Frame& F, unsigned char* lds_generic) {
    typedef float f32x16 __attribute__((ext_vector_type(16)));
    const bf16* PROJ1 = (const bf16*)(F.ws + WS_PROJ); const bf16* IK = (const bf16*)(F.ws + WS_IK); const float* IW = (const float*)(F.ws + WS_IW); unsigned long long* MASK = (unsigned long long*)(F.ws + WS_MASK);
    LAS float* SCL = (LAS float*)F.lds;
    const int lane = F.lane, w = F.wave, c32 = lane & 31, hi = lane >> 5, rt = w & 3, kpar = w >> 2;
    for (int it = blockIdx.x; it < 512; it += F.G) {
#pragma unroll 1
        for (int pass = 0; pass < 2; ++pass) {
            const int unit = pass ? 1023 - it : it, m0 = unit * 8, b = m0 >> 12, qmax = (m0 & 4095) + 7;
            __syncthreads();
            {
                const int qa = m0 + 2 * rt + ((c32 >> 2) & 1), ha = (c32 & 3) + 4 * (c32 >> 3);
                const bf16* ap = PROJ1 + (size_t)qa * NP1 + 3072 + ha * 64 + 8 * hi;
                bf16x8 af[4];
#pragma unroll
                for (int ks = 0; ks < 4; ++ks) af[ks] = *(const bf16x8*)(ap + 16 * ks);
                const float* wp = IW + (size_t)(m0 + 2 * rt + hi) * 16; float wv[16];
#pragma unroll
                for (int q4 = 0; q4 < 4; ++q4) { const f32x4 t4 = *(const f32x4*)(wp + 4 * q4); wv[4 * q4] = t4[0]; wv[4 * q4 + 1] = t4[1]; wv[4 * q4 + 2] = t4[2]; wv[4 * q4 + 3] = t4[3]; }
                LAS float* srow = SCL + (2 * rt + hi) * 4096 + c32;
                const bf16* kbase = IK + (size_t)b * SEQ * 64 + (size_t)lane * 8;
                bf16x8 bn[4];
#pragma unroll
                for (int ks = 0; ks < 4; ++ks) bn[ks] = *(const bf16x8*)(kbase + (size_t)(kpar * 4 + ks) * 512);
                for (int t = kpar; t * 32 <= qmax; t += 2) {
                    bf16x8 bc[4];
#pragma unroll
                    for (int ks = 0; ks < 4; ++ks) bc[ks] = bn[ks];
                    const int tn = (t + 2) * 32 <= qmax ? t + 2 : t;
#pragma unroll
                    for (int ks = 0; ks < 4; ++ks) bn[ks] = *(const bf16x8*)(kbase + (size_t)(tn * 4 + ks) * 512);
                    f32x16 acc = {};
#pragma unroll
                    for (int ks = 0; ks < 4; ++ks) acc = __builtin_amdgcn_mfma_f32_32x32x16_bf16(af[ks], bc[ks], acc, 0, 0, 0);
                    float s = 0.f;
#pragma unroll
                    for (int r = 0; r < 16; ++r) s += wv[r] * fmaxf(acc[r], 0.f);
                    srow[t * 32] = s; }
            }
            __syncthreads();
            { const int m = m0 + w; topk_mask_row((const LAS float*)(F.lds + w * 16384), m & 4095, MASK + (size_t)m * 64, lane, (LAS unsigned*)(F.lds + LDSCTL_OFF + 4096 + w * 1024)); }
        }
    }
    __syncthreads();
}
#define IN(k) (lo <= (k) && (k) < hi)
#define SEAM(k) do { if (hi > (k) + 1) xcd_barrier(bar); } while (0)
template <int LAYER, int BASE>
__device__ __forceinline__ void common_phases(Frame& F, const Args& args, const int lo, const int hi, const XcdBarrier& bar) {
    unsigned char* ws = args.ws;
    if (IN(BASE + 0)) {
        pg8::Gemm g{(const bf16*)(ws + WS_OMIX), (const bf16*)(ws + (LAYER ? WS_WOC : WS_WOA)), MTOK, DM, DM}; pg8::StaticOrder S; S.init(MTOK, DM, F.G, (int)blockIdx.x);
        pg8::EpiResid E{LAYER ? (const float*)(ws + WS_XR) : args.in[0], (float*)(ws + WS_XR), DN_ALPHA};
        pg8::gemm_phase<pg8::EpiResid, pg8::StaticOrder, true, true>(F.lds, g, S, E);
        SEAM(BASE + 0);
    }
    if (IN(BASE + 1)) { p_ln_route(F, args, LAYER); SEAM(BASE + 1); }
    if (IN(BASE + 2)) { p_gather(F, LAYER); SEAM(BASE + 2); }
    if (IN(BASE + 3) || IN(BASE + 4)) {
        if (F.wave == 0) { int ti; (void)moe_offsets(F.ctl + CW_CNT + LAYER * 64, F.lane, &ti); if (F.lane < 32) F.MISC[64 + F.lane] = (unsigned)ti; if (F.lane == 31) F.MISC[96] = (unsigned)ti; }
        __syncthreads();
    }
    if (IN(BASE + 3)) {
        pg8::Gemm g{(const bf16*)(ws + WS_PROJ), (const bf16*)(ws + WS_WGU) + (size_t)LAYER * 32 * 1024 * 2048, RPAD, 32 * 1024, DM};
        pg8::MoeOrder S{F.G, (int)blockIdx.x, 4, (int)F.MISC[96], (const LAS int*)(F.lds + LDSCTL_OFF + 64 * 4)};
        pg8::EpiGLU E{(bf16*)(ws + WS_OMIX), (const float*)(ws + WS_ROWW)};
        pg8::gemm_phase<pg8::EpiGLU, pg8::MoeOrder, true, true>(F.lds, g, S, E);
        SEAM(BASE + 3);
    }
    if (IN(BASE + 4)) {
        pg8::Gemm g{(const bf16*)(ws + WS_OMIX), (const bf16*)(ws + WS_WD) + (size_t)LAYER * 32 * 2048 * 512, RPAD, 32 * 2048, 512};
        pg8::MoeOrder S{F.G, (int)blockIdx.x, 8, (int)F.MISC[96], (const LAS int*)(F.lds + LDSCTL_OFF + 64 * 4)};
        pg8::EpiBf16Plain E{(bf16*)(ws + WS_CST), DM, 7};
        pg8::gemm_phase<pg8::EpiBf16Plain, pg8::MoeOrder, true, true>(F.lds, g, S, E);
        SEAM(BASE + 4);
    }
    if (IN(BASE + 5)) { p_ln_ffn(F, args, LAYER); SEAM(BASE + 5); }
}
__global__ void __launch_bounds__(NWAVES * 64, 2) mk_fwd(Args args) {
    extern __shared__ __attribute__((aligned(16))) unsigned char lds[];
    Frame F;
    F.lds = (LAS unsigned char*)lds; F.MISC = (volatile LAS unsigned*)(F.lds + LDSCTL_OFF);
    F.tid = threadIdx.x; F.lane = F.tid & 63; F.wave = __builtin_amdgcn_readfirstlane(F.tid >> 6);
    F.G = gridDim.x; F.gw = blockIdx.x * NWAVES + F.wave; F.NGW = F.G * NWAVES;
    F.ws = args.ws; F.ctl = (unsigned*)(args.ws + WS_CTL);
    for (int u = F.tid; u < (LDS_BYTES - LDSCTL_OFF) / 4; u += NWAVES * 64) ((LAS unsigned*)(F.lds + LDSCTL_OFF))[u] = 0u;
    __syncthreads();
    const int lo = args.ph_lo, hi = args.ph_hi;
    XcdBarrier bar; bar.bar = F.ctl + CW_BAR + args.bar_region * XCD_BAR_WORDS; bar.x = 0; bar.st = nullptr;
    if (hi - lo > 1) bar = xcd_barrier_post(F.ctl + CW_BAR + args.bar_region * XCD_BAR_WORDS, F.MISC);
    unsigned char* ws = args.ws;

    if (IN(0)) { p0_prologue(F, args); SEAM(0); }
    if (IN(1)) {
        pg8::Gemm g{(const bf16*)(ws + WS_XB), (const bf16*)(ws + WS_WINA), MTOK, NP0, DM}; pg8::StaticOrder S; S.init(MTOK, NP0, F.G, (int)blockIdx.x);
        pg8::EpiBf16Plain E{(bf16*)(ws + WS_PROJ), NP0, 0x7fffffff};
        pg8::gemm_phase<pg8::EpiBf16Plain, pg8::StaticOrder, true, true>(F.lds, g, S, E);
        p_skinny0(F, args);
        SEAM(1);
    }
    if (IN(2)) { p_fox_bias(F, args); ph_gla_a(F, args); SEAM(2); }
    if (IN(4)) { ph_gla_scan(F); __syncthreads();
        attn::attn_phase<true, false, 8, 1, false, NP0, NP0, DM>((char*)lds, F.lds, (const bf16*)(ws + WS_PROJ) + 3072, (const bf16*)(ws + WS_PROJ) + 4096, (const bf16*)(ws + WS_PROJ) + 5120,
                                                               (bf16*)(ws + WS_OMIX) + 1024, (const float*)(ws + WS_FBIAS), (const unsigned long long*)nullptr, F.G, (int)blockIdx.x);
        late_conv_items(F, args);
        SEAM(4); }
    if (IN(5)) { ph_gla_c(F, args); SEAM(5); }
    common_phases<0, 6>(F, args, lo, hi, bar);
    if (IN(12)) {
        pg8::Gemm g{(const bf16*)(ws + WS_XB), (const bf16*)(ws + WS_WINC), MTOK, NP1, DM}; pg8::StaticOrder S; S.init(MTOK, NP1, F.G, (int)blockIdx.x);
        const float* c128 = (const float*)(ws + WS_ROPE);
        pg8::EpiRope E{(bf16*)(ws + WS_PROJ), c128, c128 + 4096 * 64, c128 + 2 * 4096 * 64, c128 + 2 * 4096 * 64 + 4096 * 32};
        pg8::gemm_phase<pg8::EpiRope, pg8::StaticOrder, true, true>(F.lds, g, S, E);
        SEAM(12);
    }
    if (IN(13)) { ph_indexer(F, lds); SEAM(13); }
    if (IN(15)) {
        attn::attn_phase<false, true, 16, 4, true, NP1, NP1, DM>((char*)lds, F.lds, (const bf16*)(ws + WS_PROJ), (const bf16*)(ws + WS_PROJ) + 2048, (const bf16*)(ws + WS_PROJ) + 2560,
                                                               (bf16*)(ws + WS_OMIX), (const float*)nullptr, (const unsigned long long*)(ws + WS_MASK), F.G, (int)blockIdx.x);
        SEAM(15); }
    common_phases<1, 16>(F, args, lo, hi, bar);
}
#undef IN
#undef SEAM
constexpr int N_PHASE_IDS = 22;
static void launch_mk(const Args& base, int lo, int hi, int grid, hipStream_t stream, int region = 0) {
    Args a = base; a.ph_lo = lo; a.ph_hi = hi; a.bar_region = region; a.pad = 0;
    hipLaunchKernelGGL(mk_fwd, dim3(grid), dim3(NWAVES * 64), LDS_BYTES, stream, a);
}
extern "C" void kernel_launch(void* const* d_in, const int* in_sizes, int n_in, void* d_out, int out_size, void* d_ws, size_t ws_size, hipStream_t stream) {
    static int grid = 0;
    if (grid == 0) {
        if (n_in != 20 || out_size != MTOK * DM || ws_size < WS_END) { fprintf(stderr, "kernel_launch: unexpected shapes (n_in %d, out %d, ws %zu < %zu)\n", n_in, out_size, ws_size, (size_t)WS_END); grid = -1; return; }
        int dev = 0, cus = 0, per_cu = 0;
        if (hipGetDevice(&dev) != hipSuccess || hipDeviceGetAttribute(&cus, hipDeviceAttributeMultiprocessorCount, dev) != hipSuccess) { grid = -1; return; }
        if (hipFuncSetAttribute((const void*)mk_fwd, hipFuncAttributeMaxDynamicSharedMemorySize, LDS_BYTES) != hipSuccess) { fprintf(stderr, "kernel_launch: hipFuncSetAttribute failed\n"); grid = -1; return; }
        if (hipOccupancyMaxActiveBlocksPerMultiprocessor(&per_cu, (const void*)mk_fwd, NWAVES * 64, LDS_BYTES) != hipSuccess || per_cu < 1) { fprintf(stderr, "kernel_launch: occupancy query reports %d workgroups per CU\n", per_cu); }
        (void)hipGetLastError();
        grid = cus;
    }
    if (grid < 0) return;
    (void)in_sizes;
    if (hipMemsetAsync((char*)d_ws + WS_CTL, 0, CTL_ZERO_BYTES, stream) != hipSuccess) return;
    Args a{};
    for (int i = 0; i < 20; ++i) a.in[i] = (const float*)d_in[i];
    a.out = (float*)d_out; a.ws = (unsigned char*)d_ws;
#ifdef PROBE_LO
    launch_mk(a, 0, PROBE_HI + 1, grid, stream, 0); launch_mk(a, PROBE_LO, N_PHASE_IDS, grid, stream, 1);
#else
    launch_mk(a, 0, N_PHASE_IDS, grid, stream);
#endif
}
```

```cpp
#include <hip/hip_runtime.h>
#include <cstdio>
#include <cstdint>
namespace pg8 {
#define PG8_LAS __attribute__((address_space(3)))
typedef unsigned short bf16_t;
typedef short bf16x8 __attribute__((ext_vector_type(8)));
typedef float f32x4 __attribute__((ext_vector_type(4)));
typedef unsigned u32x4 __attribute__((ext_vector_type(4)));
constexpr int BM = 256, BK = 64, HALF = 128, HTB = HALF * BK * 2  , STAGE_BYTES = 8 * HTB, NXCD = 8, WGM = 8;

__host__ __device__ __forceinline__ int lds_byte(int r, int c) { const int st = (r >> 4) * 2 + (c >> 5), rr = r & 15, cc = c & 31, ob = rr * 64 + cc * 2; return st * 1024 + (ob ^ (((ob >> 9) & 1) << 5)); }
__host__ __device__ __forceinline__ void stage_rc(int b, int& R, int& C) { const int st = b / 1024, sb = b % 1024, swz = sb ^ (((sb >> 9) & 1) << 5); R = (st >> 1) * 16 + swz / 64; C = (st & 1) * 32 + (swz % 64) / 2; }
__host__ __device__ __forceinline__ int perm32(int rho) { const int n = rho >> 4, i = rho & 15; return 8 * (i >> 2) + 4 * n + (i & 3); }

struct Unit { int pm, pn, inv0, nvalid; };
struct Gemm { const bf16_t* A; const bf16_t* Bt; int M, N, K, lda, ldb; };

struct StaticOrder {
    int nM, nN, nwg, G, c;
    __host__ __device__ void init(int M, int N, int G_, int c_) { nM = M / BM; nN = N / BM; nwg = nM * nN; G = G_; c = c_; }
    __host__ __device__ bool next(int i, Unit& u) const {
        const long L = (long)i * G + c; if (L >= nwg) return false;
        int wgid = (int)L; { const int q = nwg / NXCD, r = nwg % NXCD, xcd = wgid % NXCD, off = wgid / NXCD; wgid = (xcd < r ? xcd * (q + 1) : r * (q + 1) + (xcd - r) * q) + off; }
        const int nig = WGM * nN, gid = wgid / nig, fm = gid * WGM, gsz = (nM - fm) < WGM ? (nM - fm) : WGM;
        u.pm = fm + ((wgid % nig) % gsz); u.pn = (wgid % nig) / gsz; return true;
    }
    __device__ __forceinline__ void a_ready(const Unit&) const {}
    __device__ __forceinline__ void done(const Unit&) const {}
};

__device__ __forceinline__ unsigned cvt_pk_bf16(float lo, float hi) { unsigned r; asm volatile("v_cvt_pk_bf16_f32 %0, %1, %2" : "=v"(r) : "v"(lo), "v"(hi)); return r; }
typedef float f32x2 __attribute__((ext_vector_type(2)));
struct EpiBf16Plain {
    static constexpr bool PERM = true, AFTER_DRAIN = false;
    bf16_t* O; int ldc; int pn_mask;
    __device__ __forceinline__ void operator()(const f32x4 (&acc)[2][2][4][2], const Unit& u, int wr, int wc, int fr, int fq) const {
        const int row0 = u.pm * BM + wr * 64 + fr, col0 = (u.pn & pn_mask) * BM + wc * 32 + 8 * fq;
#pragma unroll
        for (int ai = 0; ai < 2; ++ai)
#pragma unroll
            for (int m = 0; m < 4; ++m) { bf16_t* rowp = O + (size_t)(row0 + ai * HALF + m * 16) * ldc + col0;
#pragma unroll
                for (int bj = 0; bj < 2; ++bj) { const f32x4 v0 = acc[ai][bj][m][0], v1 = acc[ai][bj][m][1];
                    u32x4 w; w.x = cvt_pk_bf16(v0[0], v0[1]); w.y = cvt_pk_bf16(v0[2], v0[3]); w.z = cvt_pk_bf16(v1[0], v1[1]); w.w = cvt_pk_bf16(v1[2], v1[3]);
                    *(u32x4*)(rowp + bj * HALF) = w; } }
    }
};
struct EpiResid {
    static constexpr bool PERM = false, AFTER_DRAIN = false;
    const float* base; float* out; float alpha;
    __device__ __forceinline__ void operator()(const f32x4 (&acc)[2][2][4][2], const Unit& u, int wr, int wc, int fr, int fq) const {
        const int row0 = u.pm * BM + wr * 64 + fr, col0 = u.pn * BM + wc * 32 + 4 * fq;
#pragma unroll
        for (int ai = 0; ai < 2; ++ai)
#pragma unroll
            for (int m = 0; m < 4; ++m) { const size_t off = (size_t)(row0 + ai * HALF + m * 16) * 2048 + col0;
#pragma unroll
                for (int bj = 0; bj < 2; ++bj)
#pragma unroll
                    for (int n = 0; n < 2; ++n) { const size_t o = off + bj * HALF + n * 16; const f32x4 b = *(const f32x4*)(base + o); *(f32x4*)(out + o) = b * alpha + acc[ai][bj][m][n]; } }
    }
};
struct EpiGLU {
    static constexpr bool PERM = true, AFTER_DRAIN = false;
    bf16_t* H; const float* winv;
    __device__ __forceinline__ void operator()(const f32x4 (&acc)[2][2][4][2], const Unit& u, int wr, int wc, int fr, int fq) const {
        const int row0 = u.pm * BM + wr * 64 + fr, f0 = (u.pn & 3) * 128 + wc * 32 + 8 * fq;
#pragma unroll
        for (int ai = 0; ai < 2; ++ai)
#pragma unroll
            for (int m = 0; m < 4; ++m) { const int row = row0 + ai * HALF + m * 16; const float w = winv[u.inv0 + ai * HALF + wr * 64 + m * 16 + fr];
                float h[8];
#pragma unroll
                for (int n = 0; n < 2; ++n)
#pragma unroll
                    for (int e = 0; e < 4; ++e) { const float g = acc[ai][0][m][n][e], up = acc[ai][1][m][n][e]; h[n * 4 + e] = g * __builtin_amdgcn_rcpf(1.0f + __expf(-g)) * up * w; }
                u32x4 o; o.x = cvt_pk_bf16(h[0], h[1]); o.y = cvt_pk_bf16(h[2], h[3]); o.z = cvt_pk_bf16(h[4], h[5]); o.w = cvt_pk_bf16(h[6], h[7]);
                *(u32x4*)(H + (size_t)row * 512 + f0) = o; }
    }
};
struct EpiRope {
    static constexpr bool PERM = true, AFTER_DRAIN = false;
    bf16_t* O; const float* c128; const float* s128; const float* c64; const float* s64;
    __device__ __forceinline__ void operator()(const f32x4 (&acc)[2][2][4][2], const Unit& u, int wr, int wc, int fr, int fq) const {
        const int row0 = u.pm * BM + wr * 64 + fr, jj = wc * 32 + 8 * fq;
        const int pn = u.pn;
        if (pn == 10 || pn == 11) {
#pragma unroll
            for (int ai = 0; ai < 2; ++ai)
#pragma unroll
                for (int m = 0; m < 4; ++m) { bf16_t* rowp = O + (size_t)(row0 + ai * HALF + m * 16) * 4096 + pn * 256 + jj;
#pragma unroll
                    for (int bj = 0; bj < 2; ++bj) { const f32x4 v0 = acc[ai][bj][m][0], v1 = acc[ai][bj][m][1];
                        u32x4 w; w.x = cvt_pk_bf16(v0[0], v0[1]); w.y = cvt_pk_bf16(v0[2], v0[3]); w.z = cvt_pk_bf16(v1[0], v1[1]); w.w = cvt_pk_bf16(v1[2], v1[3]);
                        *(u32x4*)(rowp + bj * HALF) = w; } }
            return;
        }
        const bool idx = pn >= 12;
        const int half = idx ? 32 : 64;
        const int hl = idx ? (jj >> 5) : (jj >> 6), i0 = jj & (half - 1);
        const int colbase = idx ? (3072 + ((pn - 12) * 4 + hl) * 64) : (pn * 256 + hl * 128);
        const float* ct = idx ? c64 : c128; const float* st = idx ? s64 : s128;
#pragma unroll
        for (int ai = 0; ai < 2; ++ai)
#pragma unroll
            for (int m = 0; m < 4; ++m) { const int row = row0 + ai * HALF + m * 16; const int pos = row & 4095;
                const float* cp = ct + (size_t)pos * half + i0; const float* sp = st + (size_t)pos * half + i0;
                const f32x4 c0 = *(const f32x4*)cp, c1 = *(const f32x4*)(cp + 4), s0 = *(const f32x4*)sp, s1 = *(const f32x4*)(sp + 4);
                const f32x4 a0 = acc[ai][0][m][0], a1 = acc[ai][0][m][1], b0 = acc[ai][1][m][0], b1 = acc[ai][1][m][1];
                const f32x4 x0 = a0 * c0 - b0 * s0, x1 = a1 * c1 - b1 * s1, y0 = b0 * c0 + a0 * s0, y1 = b1 * c1 + a1 * s1;
                bf16_t* rowp = O + (size_t)row * 4096 + colbase + i0;
                u32x4 w; w.x = cvt_pk_bf16(x0[0], x0[1]); w.y = cvt_pk_bf16(x0[2], x0[3]); w.z = cvt_pk_bf16(x1[0], x1[1]); w.w = cvt_pk_bf16(x1[2], x1[3]);
                *(u32x4*)rowp = w;
                u32x4 z; z.x = cvt_pk_bf16(y0[0], y0[1]); z.y = cvt_pk_bf16(y0[2], y0[3]); z.z = cvt_pk_bf16(y1[0], y1[1]); z.w = cvt_pk_bf16(y1[2], y1[3]);
                *(u32x4*)(rowp + half) = z; }
    }
};
struct MoeOrder {
    int G, c, ntn, L0, Lend; const PG8_LAS int* tend; const PG8_LAS int* cnt;
    __device__ __forceinline__ bool next(int i, Unit& u) const {
        const int L = L0 + i * G + c; if (L >= Lend) return false;
        const int t = L / ntn; int e = 0;
#pragma unroll 1
        for (int k = 0; k < 32; ++k) e += (t >= tend[k]) ? 1 : 0;
        const int p0 = (t - (e ? tend[e - 1] : 0)) * BM, left = cnt[e] - p0;
        u.pm = t; u.pn = e * ntn + (L - t * ntn); u.inv0 = e * 8192 + p0; u.nvalid = left < BM ? left : BM; return true;
    }
    __device__ __forceinline__ void a_ready(const Unit&) const {}
    __device__ __forceinline__ void done(const Unit&) const {}
};
template <class Epi, class Sched, bool ALIGN_EPI = false, bool SP2 = false>
__device__ __forceinline__ void gemm_phase(PG8_LAS unsigned char* lds, const Gemm g, const Sched& S, const Epi& E) {
    const int tid = threadIdx.x, wid = __builtin_amdgcn_readfirstlane(tid >> 6), lane = tid & 63, wr = wid >> 2, wc = wid & 3, fr = lane & 15, fq = lane >> 4;
    const int K = g.K, nt = K / BK;
    unsigned voffA[2], voffB[2];
#pragma unroll
    for (int i = 0; i < 2; ++i) { int R, C; stage_rc(tid * 16 + i * 8192, R, C); const int Rb = Epi::PERM ? ((R & ~31) + perm32(R & 31)) : R;
        voffA[i] = (unsigned)(R * g.lda + C) * 2u; voffB[i] = (unsigned)(Rb * g.ldb + C) * 2u; }
    const size_t kstep = (size_t)(BK * 2);
    const size_t hstepA = (size_t)HALF * g.lda * 2, hstepB = (size_t)HALF * g.ldb * 2;
    const size_t tstepA = 2 * hstepA, tstepB = 2 * hstepB;
    const unsigned ldsw = (unsigned)wid * 1024u;
    const int aoff = lds_byte(wr * 64 + fr, fq * 8), boff = lds_byte(wc * 32 + fr, fq * 8);
#define PG8_SA(b, h) (((b) * 2 + (h)) * HTB)
#define PG8_SB(b, h) ((4 + (b) * 2 + (h)) * HTB)
#define PG8_STAGE(bufoff, gbase, voff) do { _Pragma("unroll") for (int _i = 0; _i < 2; ++_i) \
        __builtin_amdgcn_global_load_lds((const unsigned*)((const char*)(gbase) + (voff)[_i]), (PG8_LAS unsigned*)(lds + (bufoff) + ldsw + _i * 8192), 16, 0, 0); } while (0)
#define PG8_LDA(dst, b, h) do { _Pragma("unroll") for (int m = 0; m < 4; ++m) _Pragma("unroll") for (int k = 0; k < 2; ++k) dst[m][k] = *(const PG8_LAS bf16x8*)(lds + PG8_SA(b, h) + aoff + m * 2048 + k * 1024); } while (0)
#define PG8_LDB(dst, b, h) do { _Pragma("unroll") for (int n = 0; n < 2; ++n) _Pragma("unroll") for (int k = 0; k < 2; ++k) dst[n][k] = *(const PG8_LAS bf16x8*)(lds + PG8_SB(b, h) + boff + n * 2048 + k * 1024); } while (0)
#define PG8_MMA(ai, bj, At, Bt) do { __builtin_amdgcn_s_setprio(1); _Pragma("unroll") for (int m = 0; m < 4; ++m) _Pragma("unroll") for (int n = 0; n < 2; ++n) _Pragma("unroll") for (int k = 0; k < 2; ++k) \
        acc[ai][bj][m][n] = __builtin_amdgcn_mfma_f32_16x16x32_bf16(Bt[n][k], At[m][k], acc[ai][bj][m][n], 0, 0, 0); __builtin_amdgcn_s_setprio(0); } while (0)
#define PG8_WAIT_V(n) asm volatile("s_waitcnt vmcnt(" #n ")" ::: "memory")
#define PG8_WAIT_L(n) asm volatile("s_waitcnt lgkmcnt(" #n ")" ::: "memory")
#define PG8_BAR __builtin_amdgcn_s_barrier()
#define PG8_SCHED __builtin_amdgcn_sched_barrier(0)
    Unit cur, nxt; int ui = 0;
    if (!S.next(0, cur)) return;
    f32x4 acc[2][2][4][2];
#pragma unroll
    for (int a = 0; a < 2; ++a)
#pragma unroll
        for (int b = 0; b < 2; ++b)
#pragma unroll
            for (int m = 0; m < 4; ++m)
#pragma unroll
                for (int n = 0; n < 2; ++n) acc[a][b][m][n] = (f32x4){0.f, 0.f, 0.f, 0.f};
    bf16x8 At[4][2], B0[2][2], B1[2][2];
    const char* cA = (const char*)g.A + (size_t)cur.pm * tstepA; const char* cB = (const char*)g.Bt + (size_t)cur.pn * tstepB;
    S.a_ready(cur);
    if constexpr (SP2) {
        PG8_STAGE(PG8_SB(0, 0), cB, voffB); PG8_STAGE(PG8_SB(0, 1), cB + hstepB, voffB); PG8_STAGE(PG8_SA(0, 0), cA, voffA); PG8_STAGE(PG8_SA(0, 1), cA + hstepA, voffA);
        if (wr == 1) PG8_BAR;
        PG8_WAIT_V(2); PG8_BAR;
        PG8_STAGE(PG8_SB(1, 0), cB + kstep, voffB); PG8_STAGE(PG8_SA(1, 0), cA + kstep, voffA); PG8_STAGE(PG8_SB(1, 1), cB + hstepB + kstep, voffB);
        PG8_WAIT_V(6); PG8_BAR;
    } else {
        PG8_STAGE(PG8_SB(0, 0), cB, voffB); PG8_STAGE(PG8_SA(0, 0), cA, voffA); PG8_STAGE(PG8_SB(0, 1), cB + hstepB, voffB); PG8_STAGE(PG8_SA(0, 1), cA + hstepA, voffA);
        if (wr == 1) PG8_BAR;
        PG8_WAIT_V(4); PG8_BAR;
        PG8_STAGE(PG8_SB(1, 0), cB + kstep, voffB); PG8_STAGE(PG8_SA(1, 0), cA + kstep, voffA); PG8_STAGE(PG8_SB(1, 1), cB + hstepB + kstep, voffB);
        PG8_WAIT_V(6); PG8_BAR;
    }
    for (;;) {
        const bool has_next = S.next(ui + 1, nxt);
        const char* nA = has_next ? (const char*)g.A + (size_t)nxt.pm * tstepA : cA; const char* nB = has_next ? (const char*)g.Bt + (size_t)nxt.pn * tstepB : cB;
        for (int t = 0; t < nt; t += 2) {
            const bool last = (t == nt - 2);
            const char* a1 = cA + (size_t)(t + 1) * kstep;
            const char* a2 = last ? nA : cA + (size_t)(t + 2) * kstep; const char* b2 = last ? nB : cB + (size_t)(t + 2) * kstep;
            const char* a3 = a2 + kstep; const char* b3 = b2 + kstep;
            if (last && has_next) S.a_ready(nxt);
            if constexpr (SP2) {
            PG8_LDB(B0, 0, 0); PG8_LDB(B1, 0, 1); PG8_SCHED; PG8_LDA(At, 0, 0); PG8_STAGE(PG8_SA(1, 1), a1 + hstepA, voffA);
            PG8_WAIT_V(8); PG8_WAIT_L(0); PG8_BAR; PG8_MMA(0, 0, At, B0); PG8_MMA(0, 1, At, B1); PG8_BAR; PG8_SCHED;
            PG8_LDA(At, 0, 1); PG8_STAGE(PG8_SB(0, 0), b2, voffB); PG8_STAGE(PG8_SB(0, 1), b2 + hstepB, voffB); PG8_STAGE(PG8_SA(0, 0), a2, voffA);
            PG8_WAIT_V(8); PG8_WAIT_L(0); PG8_BAR; PG8_MMA(1, 0, At, B0); PG8_MMA(1, 1, At, B1); PG8_BAR; PG8_SCHED;
            PG8_LDB(B0, 1, 0); PG8_LDB(B1, 1, 1); PG8_SCHED; PG8_LDA(At, 1, 0); PG8_STAGE(PG8_SA(0, 1), a2 + hstepA, voffA);
            PG8_WAIT_V(8); PG8_WAIT_L(0); PG8_BAR; PG8_MMA(0, 0, At, B0); PG8_MMA(0, 1, At, B1); PG8_BAR; PG8_SCHED;
            PG8_LDA(At, 1, 1); PG8_STAGE(PG8_SB(1, 0), b3, voffB); PG8_STAGE(PG8_SB(1, 1), b3 + hstepB, voffB); PG8_STAGE(PG8_SA(1, 0), a3, voffA);
            PG8_WAIT_V(8); PG8_WAIT_L(0); PG8_BAR; PG8_MMA(1, 0, At, B0); PG8_MMA(1, 1, At, B1); PG8_BAR; PG8_SCHED;
            } else {
            PG8_LDB(B0, 0, 0); PG8_SCHED; PG8_LDA(At, 0, 0); PG8_STAGE(PG8_SA(1, 1), a1 + hstepA, voffA);
            PG8_WAIT_L(8); PG8_BAR; PG8_WAIT_L(0); PG8_MMA(0, 0, At, B0); PG8_BAR; PG8_SCHED;
            PG8_LDB(B1, 0, 1); PG8_STAGE(PG8_SB(0, 0), b2, voffB);
            PG8_BAR; PG8_WAIT_L(0); PG8_MMA(0, 1, At, B1); PG8_BAR;
            PG8_LDA(At, 0, 1); PG8_STAGE(PG8_SA(0, 0), a2, voffA);
            PG8_BAR; PG8_WAIT_L(0); PG8_MMA(1, 0, At, B0); PG8_BAR; PG8_SCHED;
            PG8_STAGE(PG8_SB(0, 1), b2 + hstepB, voffB);
            PG8_WAIT_V(6); PG8_BAR; PG8_MMA(1, 1, At, B1); PG8_BAR;
            PG8_LDB(B0, 1, 0); PG8_SCHED; PG8_LDA(At, 1, 0); PG8_STAGE(PG8_SA(0, 1), a2 + hstepA, voffA);
            PG8_WAIT_L(8); PG8_BAR; PG8_WAIT_L(0); PG8_MMA(0, 0, At, B0); PG8_BAR; PG8_SCHED;
            PG8_LDB(B1, 1, 1); PG8_STAGE(PG8_SB(1, 0), b3, voffB);
            PG8_BAR; PG8_WAIT_L(0); PG8_MMA(0, 1, At, B1); PG8_BAR;
            PG8_LDA(At, 1, 1); PG8_STAGE(PG8_SA(1, 0), a3, voffA);
            PG8_BAR; PG8_WAIT_L(0); PG8_MMA(1, 0, At, B0); PG8_BAR; PG8_SCHED;
            PG8_STAGE(PG8_SB(1, 1), b3 + hstepB, voffB);
            PG8_WAIT_V(6); PG8_BAR; PG8_MMA(1, 1, At, B1); PG8_BAR;
            }
        }
        if constexpr (ALIGN_EPI) { if (wr == 0) PG8_BAR; }
        if constexpr (!Epi::AFTER_DRAIN) { E(acc, cur, wr, wc, fr, fq); S.done(cur); }
        if (!has_next) break;
#pragma unroll
        for (int a = 0; a < 2; ++a)
#pragma unroll
            for (int b = 0; b < 2; ++b)
#pragma unroll
                for (int m = 0; m < 4; ++m)
#pragma unroll
                    for (int n = 0; n < 2; ++n) acc[a][b][m][n] = (f32x4){0.f, 0.f, 0.f, 0.f};
        cur = nxt; cA = nA; cB = nB; ++ui;
        if constexpr (ALIGN_EPI) { if (wr == 1) PG8_BAR; }
    }
    PG8_WAIT_V(0);
    if constexpr (!ALIGN_EPI) { if (wr == 0) PG8_BAR; }
    PG8_BAR;
    if constexpr (Epi::AFTER_DRAIN) { E.fused(acc, cur, wr, wc, fr, fq, lds, wid, lane); S.done(cur); }
#undef PG8_SA
#undef PG8_SB
#undef PG8_STAGE
#undef PG8_LDA
#undef PG8_LDB
#undef PG8_MMA
#undef PG8_WAIT_V
#undef PG8_WAIT_L
#undef PG8_BAR
#undef PG8_SCHED
}
template <class Epi, class Sched>
__device__ __forceinline__ void gemm_phase_g(PG8_LAS unsigned char* lds, const Gemm g, const Sched& S, const Epi& E, const int* inv) {
    constexpr bool ALIGN_EPI = true;
    const int tid = threadIdx.x, wid = __builtin_amdgcn_readfirstlane(tid >> 6), lane = tid & 63, wr = wid >> 2, wc = wid & 3, fr = lane & 15, fq = lane >> 4;
    const int K = g.K, nt = K / BK;
    unsigned voffA[2], voffB[2];
#pragma unroll
    for (int i = 0; i < 2; ++i) { int R, C; stage_rc(tid * 16 + i * 8192, R, C); const int Rb = Epi::PERM ? ((R & ~31) + perm32(R & 31)) : R;
        voffA[i] = (unsigned)(R * g.lda + C) * 2u; voffB[i] = (unsigned)(Rb * g.ldb + C) * 2u; }
    const size_t kstep = (size_t)(BK * 2);
    const size_t hstepA = (size_t)HALF * g.lda * 2, hstepB = (size_t)HALF * g.ldb * 2;
    const size_t tstepA = 2 * hstepA, tstepB = 2 * hstepB;
    const unsigned ldsw = (unsigned)wid * 1024u;
    const int aoff = lds_byte(wr * 64 + fr, fq * 8), boff = lds_byte(wc * 32 + fr, fq * 8);
#define PG8_SA(b, h) (((b) * 2 + (h)) * HTB)
#define PG8_SB(b, h) ((4 + (b) * 2 + (h)) * HTB)
#define PG8_STAGE(bufoff, gbase, voff) do { _Pragma("unroll") for (int _i = 0; _i < 2; ++_i) \
        __builtin_amdgcn_global_load_lds((const unsigned*)((const char*)(gbase) + (voff)[_i]), (PG8_LAS unsigned*)(lds + (bufoff) + ldsw + _i * 8192), 16, 0, 0); } while (0)
#define PG8_LDA(dst, b, h) do { _Pragma("unroll") for (int m = 0; m < 4; ++m) _Pragma("unroll") for (int k = 0; k < 2; ++k) dst[m][k] = *(const PG8_LAS bf16x8*)(lds + PG8_SA(b, h) + aoff + m * 2048 + k * 1024); } while (0)
#define PG8_LDB(dst, b, h) do { _Pragma("unroll") for (int n = 0; n < 2; ++n) _Pragma("unroll") for (int k = 0; k < 2; ++k) dst[n][k] = *(const PG8_LAS bf16x8*)(lds + PG8_SB(b, h) + boff + n * 2048 + k * 1024); } while (0)
#define PG8_MMA(ai, bj, At, Bt) do { __builtin_amdgcn_s_setprio(1); _Pragma("unroll") for (int m = 0; m < 4; ++m) _Pragma("unroll") for (int n = 0; n < 2; ++n) _Pragma("unroll") for (int k = 0; k < 2; ++k) \
        acc[ai][bj][m][n] = __builtin_amdgcn_mfma_f32_16x16x32_bf16(Bt[n][k], At[m][k], acc[ai][bj][m][n], 0, 0, 0); __builtin_amdgcn_s_setprio(0); } while (0)
#define PG8_WAIT_V(n) asm volatile("s_waitcnt vmcnt(" #n ")" ::: "memory")
#define PG8_WAIT_L(n) asm volatile("s_waitcnt lgkmcnt(" #n ")" ::: "memory")
#define PG8_BAR __builtin_amdgcn_s_barrier()
#define PG8_SCHED __builtin_amdgcn_sched_barrier(0)
    Unit cur, nxt; int ui = 0;
    if (!S.next(0, cur)) return;
    f32x4 acc[2][2][4][2];
#pragma unroll
    for (int a = 0; a < 2; ++a)
#pragma unroll
        for (int b = 0; b < 2; ++b)
#pragma unroll
            for (int m = 0; m < 4; ++m)
#pragma unroll
                for (int n = 0; n < 2; ++n) acc[a][b][m][n] = (f32x4){0.f, 0.f, 0.f, 0.f};
    bf16x8 At[4][2], B0[2][2], B1[2][2];
    const char* cA = (const char*)g.A; const char* cB = (const char*)g.Bt + (size_t)cur.pn * tstepB;
    S.a_ready(cur);
    unsigned vc[2][2], vn[2][2];
#define PG8_ROWS(u_, vo_) do { _Pragma("unroll") for (int h_ = 0; h_ < 2; ++h_) _Pragma("unroll") for (int i_ = 0; i_ < 2; ++i_) { int R_, C_; stage_rc(tid * 16 + i_ * 8192, R_, C_); const int r_ = h_ * HALF + R_; \
        const int tok_ = r_ < (u_).nvalid ? inv[(u_).inv0 + r_] : 0; vo_[h_][i_] = (unsigned)(tok_ * g.lda + C_) * 2u; } } while (0)
    PG8_ROWS(cur, vc);
    {
        PG8_STAGE(PG8_SB(0, 0), cB, voffB); PG8_STAGE(PG8_SB(0, 1), cB + hstepB, voffB); PG8_STAGE(PG8_SA(0, 0), cA, vc[0]); PG8_STAGE(PG8_SA(0, 1), cA, vc[1]);
        if (wr == 1) PG8_BAR;
        PG8_WAIT_V(2); PG8_BAR;
        PG8_STAGE(PG8_SB(1, 0), cB + kstep, voffB); PG8_STAGE(PG8_SA(1, 0), cA + kstep, vc[0]); PG8_STAGE(PG8_SB(1, 1), cB + hstepB + kstep, voffB);
        PG8_WAIT_V(6); PG8_BAR;
    }
    for (;;) {
        const bool has_next = S.next(ui + 1, nxt);
        if (has_next) { PG8_ROWS(nxt, vn); } else {
#pragma unroll
            for (int h_ = 0; h_ < 2; ++h_) { vn[h_][0] = vc[h_][0]; vn[h_][1] = vc[h_][1]; } }
        const char* nA = cA; const char* nB = has_next ? (const char*)g.Bt + (size_t)nxt.pn * tstepB : cB;
        for (int t = 0; t < nt; t += 2) {
            const bool last = (t == nt - 2);
            unsigned v2[2][2];
#pragma unroll
            for (int h_ = 0; h_ < 2; ++h_) { v2[h_][0] = last ? vn[h_][0] : vc[h_][0]; v2[h_][1] = last ? vn[h_][1] : vc[h_][1]; }
            const char* a1 = cA + (size_t)(t + 1) * kstep;
            const char* a2 = last ? nA : cA + (size_t)(t + 2) * kstep; const char* b2 = last ? nB : cB + (size_t)(t + 2) * kstep;
            const char* a3 = a2 + kstep; const char* b3 = b2 + kstep;
            if (last && has_next) S.a_ready(nxt);
            {
            PG8_LDB(B0, 0, 0); PG8_LDB(B1, 0, 1); PG8_SCHED; PG8_LDA(At, 0, 0); PG8_STAGE(PG8_SA(1, 1), a1, vc[1]);
            PG8_WAIT_V(8); PG8_WAIT_L(0); PG8_BAR; PG8_MMA(0, 0, At, B0); PG8_MMA(0, 1, At, B1); PG8_BAR; PG8_SCHED;
            PG8_LDA(At, 0, 1); PG8_STAGE(PG8_SB(0, 0), b2, voffB); PG8_STAGE(PG8_SB(0, 1), b2 + hstepB, voffB); PG8_STAGE(PG8_SA(0, 0), a2, v2[0]);
            PG8_WAIT_V(8); PG8_WAIT_L(0); PG8_BAR; PG8_MMA(1, 0, At, B0); PG8_MMA(1, 1, At, B1); PG8_BAR; PG8_SCHED;
            PG8_LDB(B0, 1, 0); PG8_LDB(B1, 1, 1); PG8_SCHED; PG8_LDA(At, 1, 0); PG8_STAGE(PG8_SA(0, 1), a2, v2[1]);
            PG8_WAIT_V(8); PG8_WAIT_L(0); PG8_BAR; PG8_MMA(0, 0, At, B0); PG8_MMA(0, 1, At, B1); PG8_BAR; PG8_SCHED;
            PG8_LDA(At, 1, 1); PG8_STAGE(PG8_SB(1, 0), b3, voffB); PG8_STAGE(PG8_SB(1, 1), b3 + hstepB, voffB); PG8_STAGE(PG8_SA(1, 0), a3, v2[0]);
            PG8_WAIT_V(8); PG8_WAIT_L(0); PG8_BAR; PG8_MMA(1, 0, At, B0); PG8_MMA(1, 1, At, B1); PG8_BAR; PG8_SCHED;
            }
        }
        if constexpr (ALIGN_EPI) { if (wr == 0) PG8_BAR; }
        if constexpr (!Epi::AFTER_DRAIN) { E(acc, cur, wr, wc, fr, fq); S.done(cur); }
        if (!has_next) break;
#pragma unroll
        for (int a = 0; a < 2; ++a)
#pragma unroll
            for (int b = 0; b < 2; ++b)
#pragma unroll
                for (int m = 0; m < 4; ++m)
#pragma unroll
                    for (int n = 0; n < 2; ++n) acc[a][b][m][n] = (f32x4){0.f, 0.f, 0.f, 0.f};
        cur = nxt; cA = nA; cB = nB; ++ui;
#pragma unroll
        for (int h_ = 0; h_ < 2; ++h_) { vc[h_][0] = vn[h_][0]; vc[h_][1] = vn[h_][1]; }
        if constexpr (ALIGN_EPI) { if (wr == 1) PG8_BAR; }
    }
    PG8_WAIT_V(0);
    if constexpr (!ALIGN_EPI) { if (wr == 0) PG8_BAR; }
    PG8_BAR;
    if constexpr (Epi::AFTER_DRAIN) { E.fused(acc, cur, wr, wc, fr, fq, lds, wid, lane); S.done(cur); }
#undef PG8_ROWS
#undef PG8_SA
#undef PG8_SB
#undef PG8_STAGE
#undef PG8_LDA
#undef PG8_LDB
#undef PG8_MMA
#undef PG8_WAIT_V
#undef PG8_WAIT_L
#undef PG8_BAR
#undef PG8_SCHED
}
}
constexpr int BATCH = 2, SEQ = 4096, DM = 2048, MTOK = BATCH * SEQ;
constexpr int NE0 = 6168, NE1 = 4176;
constexpr int NP0 = 6144, NP1 = 4096;
constexpr float LN_EPS = 1e-5f;
constexpr float DN_ALPHA = 1.41421356237309515f;
constexpr float ATT_SCALE = 0.08838834764831845f;
constexpr int RPAD = 24576;
constexpr size_t MiB = 1u << 20;
constexpr size_t WS_CTL = 0, CTL_ZERO_BYTES = 1 * MiB;
constexpr size_t WS_ROPE = 1 * MiB;
constexpr size_t WS_WSM = 4 * MiB;
constexpr size_t WS_SK0 = 6 * MiB;
constexpr size_t WS_IK = 7 * MiB;
constexpr size_t WS_IW = 8 * MiB + 512 * 1024;
constexpr size_t WS_FBIAS = 10 * MiB;
constexpr size_t WS_ROUTE = 11 * MiB;
constexpr size_t WS_MASK = 12 * MiB;
constexpr size_t WS_WINA = 16 * MiB, WS_WOA = 40 * MiB, WS_WINC = 48 * MiB, WS_WOC = 64 * MiB;
constexpr size_t WS_WGU = 72 * MiB;
constexpr size_t WS_WD = 328 * MiB;
constexpr size_t WS_XB = 456 * MiB;
constexpr size_t WS_XR = 488 * MiB;
constexpr size_t WS_PROJ = 552 * MiB;
constexpr size_t WS_CST = 648 * MiB;
constexpr size_t WS_PREVT = 712 * MiB;
constexpr size_t WS_OMIX = 744 * MiB;
constexpr size_t WS_GB = 776 * MiB;
constexpr size_t WS_DEC = 792 * MiB;
constexpr size_t WS_ROWW = 793 * MiB;
constexpr size_t WS_SC = 800 * MiB;
constexpr size_t WS_INV = 800 * MiB;
constexpr size_t WS_WINV = 801 * MiB;
constexpr size_t WS_END = 928 * MiB;
constexpr int CW_CNT = 1024;
constexpr int CW_FILL = 2048;
constexpr int CW_BAR = 4096;

#define GAS __attribute__((address_space(1)))
#define LAS __attribute__((address_space(3)))
typedef unsigned short bf16;
typedef unsigned v4u __attribute__((ext_vector_type(4)));
typedef unsigned v2u __attribute__((ext_vector_type(2)));
typedef float f32x4 __attribute__((ext_vector_type(4)));
typedef short bf16x8 __attribute__((ext_vector_type(8)));
#define LDS_WAIT() asm volatile("s_waitcnt lgkmcnt(0)" ::: "memory")
#define VM_WAIT() asm volatile("s_waitcnt vmcnt(0)" ::: "memory")
__device__ __forceinline__ unsigned f2bf(float f) { unsigned u = __builtin_bit_cast(unsigned, f); return (u + 0x7fffu + ((u >> 16) & 1u)) >> 16; }
__device__ __forceinline__ unsigned pk2(float lo, float hi) { return f2bf(lo) | (f2bf(hi) << 16); }
__device__ __forceinline__ float bf2f(unsigned short b) { return __builtin_bit_cast(float, ((unsigned)b) << 16); }
__device__ __forceinline__ float wave_sum(float v) {
#pragma unroll
    for (int o = 1; o < 64; o <<= 1) v += __shfl_xor(v, o);
    return v;
}
__device__ __forceinline__ float logsigmoidf(float z) { return fminf(z, 0.f) - log1pf(__expf(-fabsf(z))); }
#define XB_TMO      128
#define XB_XCNT(j)  (256  + 64 * (j))
#define XB_XSUB(j)  (1280 + 64 * (j))
#define XB_XGEN(j)  (2304 + 64 * (j))
#define XB_TOP      3328
#define XB_TOPGEN   3392
#define XCD_BAR_WORDS 3456
#define XB_SPIN_CAP (1u << 21)

__device__ __forceinline__ unsigned xb_ld(unsigned* p)              { return __hip_atomic_load(p, __ATOMIC_RELAXED, __HIP_MEMORY_SCOPE_AGENT); }
__device__ __forceinline__ unsigned xb_add(unsigned* p, unsigned v) { return __hip_atomic_fetch_add(p, v, __ATOMIC_RELAXED, __HIP_MEMORY_SCOPE_AGENT); }
__device__ __forceinline__ unsigned xb_xcc_id() { return (unsigned)__builtin_amdgcn_s_getreg((3 << 11) | 20) & 0xFu; }
#define XB_SPIN(cond, bar) do { unsigned _sp = 0; while (cond) { __builtin_amdgcn_s_sleep(1); \
    if ((++_sp & 255u) == 0u) { if (xb_ld(&(bar)[XB_TMO])) break; if (_sp > XB_SPIN_CAP) { atomicAdd(&(bar)[XB_TMO], 1u); break; } } } } while (0)

struct XcdBarrier {
    unsigned* bar; unsigned x;
    volatile LAS unsigned* st;
};

__device__ __forceinline__ XcdBarrier xcd_barrier_post(unsigned* bar, volatile LAS unsigned* st) {
    XcdBarrier b; b.bar = bar; b.x = xb_xcc_id(); b.st = st;
    if (threadIdx.x == 0) (void)xb_add(&bar[XB_XCNT(b.x)], 1u);
    return b;
}
__device__ __forceinline__ void xcd_barrier_complete(unsigned* bar, unsigned x, unsigned& nloc, unsigned& nx) {
    const unsigned G = gridDim.x * gridDim.y * gridDim.z;
    unsigned sum, cnt, mine, sp = 0u;
    for (;;) {
        sum = 0u; cnt = 0u; mine = 0u;
#pragma unroll
        for (unsigned j = 0; j < 16; ++j) { const unsigned c = xb_ld(&bar[XB_XCNT(j)]); sum += c; cnt += (c > 0u) ? 1u : 0u; mine = (j == x) ? c : mine; }
        if (sum == G) break;
        __builtin_amdgcn_s_sleep(1);
        if ((++sp & 255u) == 0u) { if (xb_ld(&bar[XB_TMO])) break; if (sp > XB_SPIN_CAP) { atomicAdd(&bar[XB_TMO], 1u); break; } }
    }
    nloc = mine > 0u ? mine : 1u; nx = cnt > 0u ? cnt : 1u;
}

__device__ __forceinline__ void xcd_barrier(const XcdBarrier& b) {
    asm volatile("s_waitcnt vmcnt(0)" ::: "memory");
    __syncthreads();
    if (threadIdx.x == 0) {
        unsigned* bar = b.bar;
        __builtin_amdgcn_s_waitcnt(0);
        unsigned nloc = b.st[0], nx = b.st[1];
        if (nloc == 0u) { xcd_barrier_complete(bar, b.x, nloc, nx); b.st[0] = nloc; b.st[1] = nx; }
        const unsigned old = xb_add(&bar[XB_XSUB(b.x)], 1u);
        const unsigned gen = old / nloc;
        if (old + 1u == (gen + 1u) * nloc) {
            __builtin_amdgcn_fence(__ATOMIC_RELEASE, "agent");
            asm volatile("s_waitcnt vmcnt(0)" ::: "memory");
            const unsigned og = xb_add(&bar[XB_TOP], 1u);
            const unsigned tg = og / nx;
            if (og + 1u == (tg + 1u) * nx) xb_add(&bar[XB_TOPGEN], 1u);
            else XB_SPIN(xb_ld(&bar[XB_TOPGEN]) == tg, bar);
            __builtin_amdgcn_fence(__ATOMIC_ACQUIRE, "agent");
            xb_add(&bar[XB_XGEN(b.x)], 1u);
            asm volatile("s_waitcnt vmcnt(0)" ::: "memory");
        } else {
            XB_SPIN(xb_ld(&bar[XB_XGEN(b.x)]) == gen, bar);
            __builtin_amdgcn_fence(__ATOMIC_ACQUIRE, "agent");
            asm volatile("s_waitcnt vmcnt(0)" ::: "memory");
        }
    }
    __syncthreads();
}

constexpr int NWAVES = 8;
constexpr int RING_BYTES = 131072;
constexpr int LDSCTL_OFF = RING_BYTES;
constexpr int LDS_BYTES = 147456;
struct Frame {
    LAS unsigned char* lds; volatile LAS unsigned* MISC; unsigned* ctl;
    int tid, lane, wave, G, gw, NGW;
    unsigned char* ws;
};
struct Args { const float* in[20]; float* out; unsigned char* ws; int ph_lo, ph_hi, bar_region, pad; };

struct TrItem { const float* W; bf16* WT; int ldw, c0, c1, K, n0, k0; };
__device__ __forceinline__ void tr64_load(const TrItem& t, f32x4 (&r)[16], int lane) {
    const int nq = lane & 15, kr = lane >> 4;
    const float* src = t.W + (size_t)(t.k0 + 2 * kr) * t.ldw + (nq < 8 ? t.c0 : t.c1 - 32) + 4 * nq;
#pragma unroll
    for (int i = 0; i < 8; ++i) { r[2 * i] = *(const f32x4*)(src + (size_t)(8 * i) * t.ldw); r[2 * i + 1] = *(const f32x4*)(src + (size_t)(8 * i + 1) * t.ldw); }
}
__device__ __forceinline__ void tr64_store(const TrItem& t, const f32x4 (&r)[16], LAS bf16* T, int lane) {
    const int nq = lane & 15, kr = lane >> 4;
#pragma unroll
    for (int i = 0; i < 8; ++i) { const int kk = 8 * i + 2 * kr;
#pragma unroll
        for (int e = 0; e < 4; ++e) *(LAS unsigned*)(T + (4 * nq + e) * 68 + kk) = pk2(r[2 * i][e], r[2 * i + 1][e]); }
    LDS_WAIT(); asm volatile("" ::: "memory");
    const int c = lane & 7;
#pragma unroll
    for (int j = 0; j < 8; ++j) { const int n = (lane >> 3) + 8 * j; const v2u lo = *(const LAS v2u*)(T + n * 68 + 8 * c), hi = *(const LAS v2u*)(T + n * 68 + 8 * c + 4);
        v4u o; o.x = lo.x; o.y = lo.y; o.z = hi.x; o.w = hi.y;
        *(v4u*)(t.WT + (size_t)(t.n0 + n) * t.K + t.k0 + 8 * c) = o; }
    LDS_WAIT(); asm volatile("" ::: "memory");
}
__device__ __forceinline__ void transpose_item64(const float* W, int ldw, int c0, int c1, int K, bf16* WT, int n0, int k0, LAS bf16* T, int lane) {
    const TrItem t{W, WT, ldw, c0, c1, K, n0, k0}; f32x4 r[16]; tr64_load(t, r, lane); tr64_store(t, r, T, lane);
}
__device__ __forceinline__ int l1_src_col(int n) {
    const int pn = n >> 8, j = n & 255, jh = j & 127, second = j >> 7;
    if (pn == 10 || pn == 11) return n;
    if (pn < 10) return pn * 256 + (jh >> 6) * 128 + second * 64 + (jh & 63);
    return 3072 + ((pn - 12) * 4 + (jh >> 5)) * 64 + second * 32 + (jh & 31);
}
constexpr int SK_ROUTE0 = 0, SK_ROUTE1 = 48, SK_SK0 = 96, SK_SK1 = 128, SK_NCOL = 208;
constexpr int SK_PART_OFF = 0, SK_LG_OFF = 65536;
template <int NT> __device__ __forceinline__ void skinny_partials(LAS unsigned char* ldsb, const float* X, const bf16* WH, const bf16* WL, int w, int lane) {
    const int tile = w >> 2, kq = w & 3, l15 = lane & 15, quad = lane >> 4;
    const float* xp = X + (size_t)(16 * tile + l15) * DM + kq * 512 + quad * 8;
    const bf16* hp = WH + (size_t)l15 * 2048 + kq * 512 + quad * 8; const bf16* lp = WL + (size_t)l15 * 2048 + kq * 512 + quad * 8;
    pg8::f32x4 acc[NT];
#pragma unroll
    for (int n = 0; n < NT; ++n) acc[n] = (pg8::f32x4){0.f, 0.f, 0.f, 0.f};
#pragma unroll 2
    for (int ks = 0; ks < 16; ++ks) {
        const f32x4 x0 = *(const f32x4*)(xp + 32 * ks), x1 = *(const f32x4*)(xp + 32 * ks + 4);
        v4u hw, lw;
        hw.x = pg8::cvt_pk_bf16(x0[0], x0[1]); hw.y = pg8::cvt_pk_bf16(x0[2], x0[3]); hw.z = pg8::cvt_pk_bf16(x1[0], x1[1]); hw.w = pg8::cvt_pk_bf16(x1[2], x1[3]);
        lw.x = pg8::cvt_pk_bf16(x0[0] - bf2f(hw.x & 0xffff), x0[1] - bf2f(hw.x >> 16)); lw.y = pg8::cvt_pk_bf16(x0[2] - bf2f(hw.y & 0xffff), x0[3] - bf2f(hw.y >> 16));
        lw.z = pg8::cvt_pk_bf16(x1[0] - bf2f(hw.z & 0xffff), x1[1] - bf2f(hw.z >> 16)); lw.w = pg8::cvt_pk_bf16(x1[2] - bf2f(hw.w & 0xffff), x1[3] - bf2f(hw.w >> 16));
        const bf16x8 ah = __builtin_bit_cast(bf16x8, hw), al = __builtin_bit_cast(bf16x8, lw);
#pragma unroll
        for (int n = 0; n < NT; ++n) { const bf16x8 bh = *(const bf16x8*)(hp + (size_t)n * 16 * 2048 + 32 * ks), bl = *(const bf16x8*)(lp + (size_t)n * 16 * 2048 + 32 * ks);
            acc[n] = __builtin_amdgcn_mfma_f32_16x16x32_bf16(ah, bh, acc[n], 0, 0, 0); acc[n] = __builtin_amdgcn_mfma_f32_16x16x32_bf16(ah, bl, acc[n], 0, 0, 0);
            acc[n] = __builtin_amdgcn_mfma_f32_16x16x32_bf16(al, bh, acc[n], 0, 0, 0); }
    }
    LAS float* PART = (LAS float*)(ldsb + SK_PART_OFF);
#pragma unroll
    for (int n = 0; n < NT; ++n) *(LAS pg8::f32x4*)(PART + ((((tile * 4 + kq) * NT + n) * 64 + lane) * 4)) = acc[n];
}
template <int NT> __device__ __forceinline__ void skinny_reduce(LAS unsigned char* ldsb, int tid) {
    const LAS float* PART = (const LAS float*)(ldsb + SK_PART_OFF); LAS float* LG = (LAS float*)(ldsb + SK_LG_OFF);
    for (int idx = tid; idx < 32 * 16 * NT; idx += NWAVES * 64) { const int row = idx / (16 * NT), col = idx % (16 * NT), tile = row >> 4, rr = row & 15, ln = (rr >> 2) * 16 + (col & 15), n = col >> 4, j = rr & 3;
        float s = 0.f;
#pragma unroll
        for (int kq = 0; kq < 4; ++kq) s += PART[(((tile * 4 + kq) * NT + n) * 64 + ln) * 4 + j];
        LG[row * (16 * NT) + col] = s; }
}
__device__ __forceinline__ void ln_row(f32x4 (&v)[8], const float* g, const float* b, int lane) {
    float s = 0.f;
#pragma unroll
    for (int j = 0; j < 8; ++j) s += (v[j][0] + v[j][1]) + (v[j][2] + v[j][3]);
    const float mean = wave_sum(s) * (1.f / DM); float s2 = 0.f;
#pragma unroll
    for (int j = 0; j < 8; ++j) { v[j] = v[j] - mean; s2 += (v[j][0] * v[j][0] + v[j][1] * v[j][1]) + (v[j][2] * v[j][2] + v[j][3] * v[j][3]); }
    const float rstd = 1.f / sqrtf(wave_sum(s2) * (1.f / DM) + LN_EPS);
#pragma unroll
    for (int j = 0; j < 8; ++j) { const f32x4 gg = *(const f32x4*)(g + 256 * j + 4 * lane), bb = *(const f32x4*)(b + 256 * j + 4 * lane); v[j] = v[j] * rstd * gg + bb; }
}
__device__ __forceinline__ void store_row_bf16(bf16* dst, const f32x4 (&v)[8], int lane) {
#pragma unroll
    for (int j = 0; j < 8; ++j) { uint2 o; o.x = pk2(v[j][0], v[j][1]); o.y = pk2(v[j][2], v[j][3]); *(uint2*)(dst + 256 * j + 4 * lane) = o; }
}
#define TK_FOR_VALID(...) _Pragma("unroll") for (int g_ = 0; g_ < 8; ++g_) { if (512 * g_ <= qpos) { _Pragma("unroll") for (int i = 8 * g_; i < 8 * g_ + 8; ++i) { __VA_ARGS__ } } }
__device__ __forceinline__ void topk_mask_row(const LAS float* sc, int qpos, unsigned long long* mrow, int lane, LAS unsigned* cbuf) {
    unsigned u[64];
#pragma unroll
    for (int i = 0; i < 64; ++i) { const int s = 64 * i + lane; const bool ok = s <= qpos; const float f = ok ? sc[s] : 0.f; const unsigned b = __builtin_bit_cast(unsigned, f);
        const unsigned key = b ^ ((b >> 31) ? 0xFFFFFFFFu : 0x80000000u); u[i] = ok ? key : 0u; }
    unsigned long long mword = 0ull;
    if (qpos + 1 <= 256) {
#pragma unroll
        for (int i = 0; i < 4; ++i) { const unsigned long long w = __ballot(64 * i + lane <= qpos); mword = (lane == i) ? w : mword; }
        mrow[lane] = mword; return;
    }
    const unsigned long long below = (1ull << lane) - 1ull;
    unsigned T = 0u;
#pragma unroll 1
    for (int bit = 31; bit >= 20; --bit) { const unsigned cand = T | (1u << bit); int cnt = 0;
        TK_FOR_VALID( cnt += __builtin_popcountll(__ballot(u[i] >= cand)); )
        if (cnt >= 256) T = cand; }
    const unsigned pre = T >> 20; int cgt = 0, nc = 0;
    TK_FOR_VALID( { const unsigned p_ = u[i] >> 20; const unsigned long long gm = __ballot(p_ > pre), em = __ballot(p_ == pre); cgt += __builtin_popcountll(gm);
        const int pos_ = nc + __builtin_popcountll(em & below); if (p_ == pre && pos_ < 256) cbuf[pos_] = u[i]; nc += __builtin_popcountll(em); } )
    int kneed = 256 - cgt;
    if (nc <= 256) {
        asm volatile("s_waitcnt lgkmcnt(0)" ::: "memory");
        unsigned c0 = lane < nc ? cbuf[lane] : 0u, c1 = 64 + lane < nc ? cbuf[64 + lane] : 0u, c2 = 128 + lane < nc ? cbuf[128 + lane] : 0u, c3 = 192 + lane < nc ? cbuf[192 + lane] : 0u;
#pragma unroll 1
        for (int bit = 19; bit >= 0; --bit) { const unsigned cand = T | (1u << bit);
            int cnt = __builtin_popcountll(__ballot(c0 >= cand));
            if (nc > 64) cnt += __builtin_popcountll(__ballot(c1 >= cand));
            if (nc > 128) cnt += __builtin_popcountll(__ballot(c2 >= cand)) + __builtin_popcountll(__ballot(c3 >= cand));
            if (cnt >= kneed) T = cand; }
        const int cg2 = __builtin_popcountll(__ballot(c0 > T)) + __builtin_popcountll(__ballot(c1 > T)) + __builtin_popcountll(__ballot(c2 > T)) + __builtin_popcountll(__ballot(c3 > T));
        kneed -= cg2;
    } else {
#pragma unroll 1
        for (int bit = 19; bit >= 0; --bit) { const unsigned cand = T | (1u << bit); int cnt = 0;
            TK_FOR_VALID( cnt += __builtin_popcountll(__ballot(u[i] >= cand)); )
            if (cnt >= 256) T = cand; }
        int cg2 = 0;
        TK_FOR_VALID( cg2 += __builtin_popcountll(__ballot(u[i] > T)); )
        kneed = 256 - cg2;
    }
    int run = 0;
#pragma unroll
    for (int i = 0; i < 64; ++i) { const bool gt = u[i] > T, eq = u[i] == T; const unsigned long long eqm = __ballot(eq);
        const int rank = run + __builtin_popcountll(eqm & below); const bool sel = gt || (eq && rank < kneed); run += __builtin_popcountll(eqm);
        const unsigned long long w = __ballot(sel); mword = (lane == i) ? w : mword; }
    mrow[lane] = mword;
}
#undef TK_FOR_VALID
constexpr int CONV_MOE_ITEMS = 32 * (32 * 16) + 32 * (8 * 32);
constexpr int CONV_LATE_ITEMS = CONV_MOE_ITEMS + 32 * (NP1 / 64) + 32 * 32 + CONV_MOE_ITEMS;
__device__ __forceinline__ TrItem conv_moe_desc(const Args& a, unsigned char* ws, int layer, int it) {
    if (it < 32 * 512) {
        const int ex = layer * 32 + it / 512, r = it % 512, kb = r / 16, nb = r % 16, n0 = nb * 64, tile = n0 >> 8, j = n0 & 255;
        const float* W = (j < 128 ? a.in[17] : a.in[18]) + (size_t)ex * 2048 * 512;
        return TrItem{W, (bf16*)(ws + WS_WGU) + (size_t)ex * 1024 * 2048, 512, 128 * tile + (j & 127), 128 * tile + (j & 127) + 32, 2048, n0, kb * 64};
    }
    const int i2 = it - 32 * 512, ex = layer * 32 + i2 / 256, r = i2 % 256, kb = r / 32, nb = r % 32;
    return TrItem{a.in[19] + (size_t)ex * 512 * 2048, (bf16*)(ws + WS_WD) + (size_t)ex * 2048 * 512, 2048, nb * 64, nb * 64 + 32, 512, nb * 64, kb * 64};
}
__device__ __forceinline__ TrItem conv_late_desc(const Args& a, unsigned char* ws, int it) {
    if (it < CONV_MOE_ITEMS) return conv_moe_desc(a, ws, 0, it);
    it -= CONV_MOE_ITEMS;
    if (it < 32 * (NP1 / 64)) { const int kb = it / (NP1 / 64), nb = it % (NP1 / 64), n0 = nb * 64;
        return TrItem{a.in[7], (bf16*)(ws + WS_WINC), NE1, l1_src_col(n0), l1_src_col(n0 + 32), 2048, n0, kb * 64}; }
    it -= 32 * (NP1 / 64);
    if (it < 32 * 32) { const int kb = it / 32, nb = it % 32; return TrItem{a.in[8], (bf16*)(ws + WS_WOC), 2048, nb * 64, nb * 64 + 32, 2048, nb * 64, kb * 64}; }
    return conv_moe_desc(a, ws, 1, it - 32 * 32);
}
__device__ __forceinline__ void late_conv_items(Frame& F, const Args& a) {
    constexpr int CHUNK = 32;
    LAS bf16* T = (LAS bf16*)(F.lds + F.wave * 16384); volatile LAS int* slot = (volatile LAS int*)(F.lds + 131072 + 512);
    for (;;) {
        __syncthreads();
        if (F.tid == 0) *slot = (int)atomicAdd(F.ctl + CW_FILL, (unsigned)CHUNK);
        __syncthreads();
        const int base = *slot;
        if (base >= CONV_LATE_ITEMS) break;
        f32x4 rA[16], rB[16];
        TrItem t0 = conv_late_desc(a, F.ws, base + F.wave); tr64_load(t0, rA, F.lane);
        TrItem t1 = conv_late_desc(a, F.ws, base + F.wave + 8); tr64_load(t1, rB, F.lane);
        tr64_store(t0, rA, T, F.lane);
        t0 = conv_late_desc(a, F.ws, base + F.wave + 16); tr64_load(t0, rA, F.lane);
        tr64_store(t1, rB, T, F.lane);
        t1 = conv_late_desc(a, F.ws, base + F.wave + 24); tr64_load(t1, rB, F.lane);
        tr64_store(t0, rA, T, F.lane);
        tr64_store(t1, rB, T, F.lane);
    }
    __syncthreads();
}
static_assert(CONV_LATE_ITEMS % 32 == 0, "filler chunks");
__device__ __forceinline__ void p0_prologue(Frame& F, const Args& a) {
    const int gw = F.gw, NGW = F.NGW, lane = F.lane;
    unsigned char* ws = F.ws;
    LAS bf16* T = (LAS bf16*)(F.lds + F.wave * 16384);
    {
        const float* W = a.in[1]; bf16* WT = (bf16*)(ws + WS_WINA);
        for (int it = gw; it < 32 * (NP0 / 64); it += NGW) { const int kb = it / (NP0 / 64), nb = it % (NP0 / 64), n0 = nb * 64; const int c0 = n0 < 3072 ? n0 : n0 + 16; transpose_item64(W, NE0, c0, c0 + 32, 2048, WT, n0, kb * 64, T, lane); }
    }
    {
        for (int it = gw; it < 32 * 32; it += NGW) { const int kb = it / 32, nb = it % 32; transpose_item64(a.in[6], 2048, nb * 64, nb * 64 + 32, 2048, (bf16*)(ws + WS_WOA), nb * 64, kb * 64, T, lane); }
    }
    const int gt = blockIdx.x * (NWAVES * 64) + F.tid, NGT = F.G * NWAVES * 64;
    {   float* c128 = (float*)(ws + WS_ROPE); float* s128 = c128 + 4096 * 64; float* c64 = s128 + 4096 * 64; float* s64 = c64 + 4096 * 32;
        for (int i = gt; i < 4096 * 96; i += NGT) { int pos, idx, half; float* cp; float* sp;
            if (i < 4096 * 64) { pos = i >> 6; idx = i & 63; half = 64; cp = c128 + i; sp = s128 + i; } else { const int r = i - 4096 * 64; pos = r >> 5; idx = r & 31; half = 32; cp = c64 + r; sp = s64 + r; }
            const float inv = exp2f(-(float)idx / (float)half * 13.287712379549449f);
            const float ang = (float)pos * inv;
            double rv = (double)ang * 0.15915494309189535; rv -= rint(rv);
            const float rf = (float)rv;
            *cp = __builtin_amdgcn_cosf(rf); *sp = __builtin_amdgcn_sinf(rf); }
    }
    {   bf16* SKH = (bf16*)(ws + WS_WSM); bf16* SKL = SKH + (size_t)SK_NCOL * 2048;
        for (int i = gt; i < 2048 * SK_NCOL; i += NGT) { const int k = i / SK_NCOL, c = i % SK_NCOL; float v = 0.f;
            if (c < 96) { const int l = c / 48, j = c % 48; if (j < 4) v = a.in[13][((size_t)l * 2048 + k) * 4 + j]; else if (j < 36) { const int g = (j - 4) >> 3, e = (j - 4) & 7; v = a.in[15][(((size_t)l * 4 + g) * 2048 + k) * 8 + e]; } }
            else if (c < 128) { const int j = c - 96; if (j < 16) v = a.in[1][(size_t)k * NE0 + 3072 + j]; else if (j < 24) v = a.in[1][(size_t)k * NE0 + 6160 + j - 16]; }
            else v = a.in[7][(size_t)k * NE1 + 4096 + c - 128];
            const unsigned h = f2bf(v); SKH[(size_t)c * 2048 + k] = (bf16)h; SKL[(size_t)c * 2048 + k] = (bf16)f2bf(v - bf2f((unsigned short)h)); }
    }
    {   const float* x = a.in[0]; bf16* XB = (bf16*)(ws + WS_XB);
        for (int m = gw; m < MTOK; m += NGW) { f32x4 v[8];
#pragma unroll
            for (int j = 0; j < 8; ++j) v[j] = *(const f32x4*)(x + (size_t)m * DM + 256 * j + 4 * lane);
            store_row_bf16(XB + (size_t)m * DM, v, lane); }
    }
}
__device__ __forceinline__ void p_skinny0(Frame& F, const Args& a) {
    const bf16* SKH = (const bf16*)(F.ws + WS_WSM) + (size_t)SK_SK0 * 2048; const bf16* SKL = SKH + (size_t)SK_NCOL * 2048; float* SK0 = (float*)(F.ws + WS_SK0);
    const LAS float* LG = (const LAS float*)(F.lds + SK_LG_OFF);
    for (int blk = blockIdx.x; blk < MTOK / 32; blk += F.G) { const int R0 = blk * 32;
        __syncthreads();
        skinny_partials<2>(F.lds, a.in[0] + (size_t)R0 * DM, SKH, SKL, F.wave, F.lane);
        __syncthreads();
        skinny_reduce<2>(F.lds, F.tid);
        __syncthreads();
        for (int idx = F.tid; idx < 32 * 24; idx += NWAVES * 64) { const int row = idx / 24, c = idx % 24; SK0[(size_t)(R0 + row) * 24 + c] = LG[row * 32 + c]; }
    }
    __syncthreads();
}
__device__ __forceinline__ void p_fox_bias(Frame& F, const Args& a) {
    if (blockIdx.x >= 16) return;
    const int bh = blockIdx.x, b = bh >> 3, h = bh & 7, lane = F.lane, tid = F.tid; const float gb = a.in[5][h];
    const float* SK0 = (const float*)(F.ws + WS_SK0); float* FB = (float*)(F.ws + WS_FBIAS) + (size_t)bh * SEQ; LAS float* wt = (LAS float*)(F.lds + 120000);
    float lf[8], tot = 0.f;
#pragma unroll
    for (int i = 0; i < 8; ++i) lf[i] = SK0[(size_t)(b * SEQ + tid * 8 + i) * 24 + 16 + h];
#pragma unroll
    for (int i = 0; i < 8; ++i) { tot += logsigmoidf(lf[i] + gb); lf[i] = tot; }
    float incl = tot;
#pragma unroll
    for (int o = 1; o < 64; o <<= 1) { const float t = __shfl_up(incl, o); if (lane >= o) incl += t; }
    if (lane == 63) wt[F.wave] = incl;
    __syncthreads();
    float pre = incl - tot;
    for (int w = 0; w < F.wave; ++w) pre += wt[w];
#pragma unroll
    for (int i = 0; i < 8; ++i) FB[tid * 8 + i] = -(pre + lf[i]) * (1.0f / ATT_SCALE);
    __syncthreads();
}
__device__ __forceinline__ void p_ln_route(Frame& F, const Args& a, int layer) {
    float* XR = (float*)(F.ws + WS_XR); bf16* XB = (bf16*)(F.ws + WS_XB); const int lane = F.lane;
    const float* g = a.in[9] + layer * DM; const float* bb = a.in[10] + layer * DM;
    const bf16* SKH = (const bf16*)(F.ws + WS_WSM) + (size_t)(layer ? SK_ROUTE1 : SK_ROUTE0) * 2048; const bf16* SKL = SKH + (size_t)SK_NCOL * 2048;
    const float* bg = a.in[14] + layer * 4; const float* be = a.in[16] + layer * 32;
    int4* ROUTE = (int4*)(F.ws + WS_ROUTE); unsigned* cnt = F.ctl + CW_CNT + layer * 64; int* INV = (int*)(F.ws + WS_INV); float* WINV = (float*)(F.ws + WS_WINV);
    const LAS float* LG = (const LAS float*)(F.lds + SK_LG_OFF);
    for (int blk = blockIdx.x; blk < MTOK / 32; blk += F.G) { const int R0 = blk * 32;
#pragma unroll 1
        for (int i = 0; i < 4; ++i) { const int m = R0 + 4 * F.wave + i; f32x4 v[8];
#pragma unroll
            for (int j = 0; j < 8; ++j) v[j] = *(const f32x4*)(XR + (size_t)m * DM + 256 * j + 4 * lane);
            ln_row(v, g, bb, lane);
#pragma unroll
            for (int j = 0; j < 8; ++j) *(f32x4*)(XR + (size_t)m * DM + 256 * j + 4 * lane) = v[j];
            store_row_bf16(XB + (size_t)m * DM, v, lane); }
        __syncthreads();
        skinny_partials<3>(F.lds, XR + (size_t)R0 * DM, SKH, SKL, F.wave, lane);
        __syncthreads();
        skinny_reduce<3>(F.lds, F.tid);
        __syncthreads();
        if (F.tid < 32) { const int m = R0 + F.tid; const LAS float* l = LG + F.tid * 48;
            float gl[4];
#pragma unroll
            for (int i = 0; i < 4; ++i) gl[i] = l[i] + bg[i];
            int gi = 0; float gm = gl[0];
#pragma unroll
            for (int i = 1; i < 4; ++i) if (gl[i] > gm) { gm = gl[i]; gi = i; }
            float gs = 0.f;
#pragma unroll
            for (int i = 0; i < 4; ++i) gs += __expf(gl[i] - gm);
            const float gp = 1.0f / gs;
            float el[8];
#pragma unroll
            for (int e = 0; e < 8; ++e) el[e] = l[4 + 8 * gi + e] + be[gi * 8 + e];
            int e1 = 0; float v1 = el[0];
#pragma unroll
            for (int e = 1; e < 8; ++e) if (el[e] > v1) { v1 = el[e]; e1 = e; }
            int e2 = -1; float v2 = -3.0e38f;
#pragma unroll
            for (int e = 0; e < 8; ++e) if (e != e1 && el[e] > v2) { v2 = el[e]; e2 = e; }
            const float w1 = gp / (1.0f + __expf(v2 - v1)), w2 = gp - w1;
            const int ge1 = gi * 8 + e1, ge2 = gi * 8 + e2;
            const int p1 = (int)atomicAdd(cnt + ge1, 1u), p2 = (int)atomicAdd(cnt + ge2, 1u);
            ROUTE[(size_t)m * 2 + 0] = make_int4(ge1, p1, 0, 0); ROUTE[(size_t)m * 2 + 1] = make_int4(ge2, p2, 0, 0);
            INV[ge1 * 8192 + p1] = m; INV[ge2 * 8192 + p2] = m; WINV[ge1 * 8192 + p1] = w1; WINV[ge2 * 8192 + p2] = w2; }
    }
    __syncthreads();
}
__device__ __forceinline__ int moe_offsets(const unsigned* cnt, int lane, int* tiles_incl) {
    const int c = lane < 32 ? (int)cnt[lane] : 0; const int t = (c + 255) >> 8; int incl = t;
#pragma unroll
    for (int o = 1; o < 32; o <<= 1) { const int x = __shfl_up(incl, o); if ((lane & 31) >= o) incl += x; }
    *tiles_incl = incl; return (incl - t) * 256;
}
__device__ __forceinline__ void p_ln_ffn(Frame& F, const Args& a, int layer) {
    float* XR = (float*)(F.ws + WS_XR); bf16* XB = (bf16*)(F.ws + WS_XB); const int lane = F.lane; const bf16* YG = (const bf16*)(F.ws + WS_CST);
    const float* g = a.in[11] + layer * DM; const float* bb = a.in[12] + layer * DM; const int4* ROUTE = (const int4*)(F.ws + WS_ROUTE);
    float* dst = layer == 1 ? a.out : XR;
    const bf16* SKH = (const bf16*)(F.ws + WS_WSM) + (size_t)SK_SK1 * 2048; const bf16* SKL = SKH + (size_t)SK_NCOL * 2048;
    const float* c64 = (const float*)(F.ws + WS_ROPE) + 2 * 4096 * 64; const float* s64 = c64 + 4096 * 32;
    bf16* IK = (bf16*)(F.ws + WS_IK); float* IW = (float*)(F.ws + WS_IW);
    const LAS float* LG = (const LAS float*)(F.lds + SK_LG_OFF);
    int ti_; const int eoff = moe_offsets(F.ctl + CW_CNT + layer * 64, lane, &ti_);
    for (int blk = blockIdx.x; blk < MTOK / 32; blk += F.G) { const int R0 = blk * 32;
#pragma unroll 1
        for (int i = 0; i < 4; ++i) { const int m = R0 + 4 * F.wave + i; f32x4 v[8];
            const int4 q0 = ROUTE[(size_t)m * 2], q1 = ROUTE[(size_t)m * 2 + 1]; const int r0 = __shfl(eoff, q0.x) + q0.y, r1 = __shfl(eoff, q1.x) + q1.y;
#pragma unroll
            for (int j = 0; j < 8; ++j) { v[j] = *(const f32x4*)(XR + (size_t)m * DM + 256 * j + 4 * lane) * DN_ALPHA;
                const uint2 y0 = *(const uint2*)(YG + (size_t)r0 * DM + 256 * j + 4 * lane), y1 = *(const uint2*)(YG + (size_t)r1 * DM + 256 * j + 4 * lane);
                v[j][0] += bf2f(y0.x & 0xffff) + bf2f(y1.x & 0xffff); v[j][1] += bf2f(y0.x >> 16) + bf2f(y1.x >> 16);
                v[j][2] += bf2f(y0.y & 0xffff) + bf2f(y1.y & 0xffff); v[j][3] += bf2f(y0.y >> 16) + bf2f(y1.y >> 16); }
            ln_row(v, g, bb, lane);
#pragma unroll
            for (int j = 0; j < 8; ++j) *(f32x4*)(dst + (size_t)m * DM + 256 * j + 4 * lane) = v[j];
            if (layer == 0) store_row_bf16(XB + (size_t)m * DM, v, lane); }
        if (layer == 0) {
            __syncthreads();
            skinny_partials<5>(F.lds, XR + (size_t)R0 * DM, SKH, SKL, F.wave, lane);
            __syncthreads();
            skinny_reduce<5>(F.lds, F.tid);
            __syncthreads();
            for (int idx = F.tid; idx < 32 * 80; idx += NWAVES * 64) { const int row = idx / 80, c = idx % 80, m = R0 + row; const float v = LG[row * 80 + c];
                if (c < 64) { const float part = LG[row * 80 + (c ^ 32)]; const int pos = m & 4095, i = c & 31; const float cs = c64[pos * 32 + i], sn = s64[pos * 32 + i];
                    const int bq = m >> 12, sq = m & 4095; IK[((((size_t)bq * 128 + (sq >> 5)) * 4 + (c >> 4)) * 64 + ((c >> 3) & 1) * 32 + (sq & 31)) * 8 + (c & 7)] = (bf16)f2bf(c < 32 ? (v * cs - part * sn) : (v * cs + part * sn)); }
                else IW[(size_t)m * 16 + c - 64] = v * 0.25f * 0.125f; }
        }
    }
    __syncthreads();
}
__device__ __forceinline__ void ph_gla_b(Frame& F, const Args& a) {
    const float* SK0 = (const float*)(F.ws + WS_SK0); const float* w2 = a.in[2]; const float* gbias = a.in[3]; float* GB = (float*)(F.ws + WS_GB); float* DEC = (float*)(F.ws + WS_DEC);
    for (int u4 = blockIdx.x; u4 < 128; u4 += F.G) {
        const int unit = u4 * 4 + (F.tid >> 7), n = unit & 63, bh = unit >> 6, b = bh >> 2, h = bh & 3, d = F.tid & 127, t0 = b * SEQ + n * 64;
        float w[16];
#pragma unroll
        for (int r = 0; r < 16; ++r) w[r] = w2[r * 512 + h * 128 + d];
        const float gb = gbias[h * 128 + d]; float run = 0.f;
        for (int c = 0; c < 64; ++c) { const int t = t0 + c; float z = gb;
#pragma unroll
            for (int r = 0; r < 16; ++r) z += SK0[(size_t)t * 24 + r] * w[r];
            run += logsigmoidf(z) * (1.0f / 16.0f); GB[(size_t)t * 512 + h * 128 + d] = run; }
        DEC[unit * 128 + d] = __expf(run);
    }
}
__device__ __forceinline__ void ph_gla_state(Frame& F) {
    const bf16* PROJ = (const bf16*)(F.ws + WS_PROJ); const float* GB = (const float*)(F.ws + WS_GB); float* CST = (float*)(F.ws + WS_CST);
    for (int vb = blockIdx.x; vb < 512 * 64; vb += F.G) {
        const int unit = vb >> 6, d = (vb & 63) * 2 + (F.tid >> 8), v = F.tid & 255, n = unit & 63, bh = unit >> 6, b = bh >> 2, h = bh & 3, t0 = b * SEQ + n * 64;
        const float blast = GB[(size_t)(t0 + 63) * 512 + h * 128 + d]; float acc = 0.f;
        for (int c = 0; c < 64; ++c) { const size_t t = t0 + c; const float kk = bf2f(PROJ[t * NP0 + 512 + h * 128 + d]) * __expf(blast - GB[t * 512 + h * 128 + d]);
            acc += kk * bf2f(PROJ[t * NP0 + 1024 + h * 256 + v]); }
        CST[((size_t)unit * 256 + v) * 128 + d] = acc;
    }
}
__device__ __forceinline__ void ph_gla_scan(Frame& F) {
    const float* CST = (const float*)(F.ws + WS_CST); const float* DEC = (const float*)(F.ws + WS_DEC); bf16* PREVT = (bf16*)(F.ws + WS_PREVT);
    for (int idx = blockIdx.x * 512 + F.tid; idx < 8 * 32768; idx += F.G * 512) { const int bh = idx >> 15, vd = idx & 32767, d = vd & 127; float S = 0.f;
        for (int n = 0; n < 64; ++n) { const int unit = bh * 64 + n; PREVT[(size_t)unit * 32768 + vd] = (bf16)f2bf(S); S = DEC[unit * 128 + d] * S + CST[(size_t)unit * 32768 + vd]; } }
}
__device__ __forceinline__ void ph_gla_out(Frame& F, const Args& a) {
    const bf16* PROJ = (const bf16*)(F.ws + WS_PROJ); const float* GB = (const float*)(F.ws + WS_GB); const bf16* PREVT = (const bf16*)(F.ws + WS_PREVT); const float* normg = a.in[4]; bf16* OMIX = (bf16*)(F.ws + WS_OMIX);
    LAS float* qd = (LAS float*)F.lds; LAS float* ki = qd + 64 * 128; LAS float* sc = ki + 64 * 128; LAS float* red = sc + 64 * 64;
    const int tid = F.tid; const bool act = tid < 256;
    for (int unit = blockIdx.x; unit < 512; unit += F.G) {
        const int n = unit & 63, bh = unit >> 6, b = bh >> 2, h = bh & 3, t0 = b * SEQ + n * 64;
        __syncthreads();
        for (int i = tid; i < 64 * 128; i += 512) { const int c = i >> 7, d = i & 127; const size_t t = t0 + c; const float bb = GB[t * 512 + h * 128 + d];
            qd[i] = bf2f(PROJ[t * NP0 + h * 128 + d]) * ATT_SCALE * __expf(bb); ki[i] = bf2f(PROJ[t * NP0 + 512 + h * 128 + d]) * __expf(-bb); }
        __syncthreads();
        for (int p = tid; p < 64 * 64; p += 512) { const int i = p >> 6, j = p & 63; float s = 0.f;
            if (j <= i) for (int d = 0; d < 128; ++d) s += qd[i * 128 + d] * ki[j * 128 + d];
            sc[p] = s; }
        __syncthreads();
        const int v = tid & 255; const bf16* pv = PREVT + ((size_t)unit * 256 + v) * 128; const float gv = normg[v];
        for (int i = 0; i < 64; ++i) { float acc = 0.f;
            if (act) { for (int j = 0; j <= i; ++j) acc += sc[i * 64 + j] * bf2f(PROJ[(size_t)(t0 + j) * NP0 + 1024 + h * 256 + v]);
                for (int d = 0; d < 128; ++d) acc += qd[i * 128 + d] * bf2f(pv[d]);
                const float ss = wave_sum(acc * acc); if ((tid & 63) == 0) red[tid >> 6] = ss; }
            __syncthreads();
            const float ms = (red[0] + red[1] + red[2] + red[3]) * (1.0f / 256.0f); __syncthreads();
            if (act) { const float gr = bf2f(PROJ[(size_t)(t0 + i) * NP0 + 2048 + h * 256 + v]);
                const float o = acc * (1.0f / sqrtf(ms + LN_EPS)) * gv * (gr / (1.0f + __expf(-gr)));
                OMIX[(size_t)(t0 + i) * DM + h * 256 + v] = (bf16)f2bf(o); } }
    }
}
template <int MODE  >
__device__ __forceinline__ void ph_attn_naive(Frame& F, const bf16* Qb, int ldq, int qc0, const bf16* Kb, int ldk, int kc0, const bf16* Vb, int ldv, int vc0, int nheads, int group,
                                              const float* fbias, const unsigned long long* mask, bf16* O, int oc0) {
    const int half = F.tid >> 8, tid = F.tid & 255, qi = tid >> 2, part = tid & 3;
    LAS bf16* Ks = (LAS bf16*)(F.lds + half * 32768); LAS bf16* Vs = Ks + 64 * 128;
    const int nvb = (SEQ / 64) * (nheads / 2) * BATCH;
    for (int vb = blockIdx.x; vb < nvb; vb += F.G) {
        const int cc = vb >> 6, qb = ((vb & 63) + cc * 17) & 63, hp = cc % (nheads / 2), b = cc / (nheads / 2), h = hp * 2 + half, kvh = h / group;
        const int qpos = qb * 64 + qi; const size_t row = (size_t)b * SEQ + qpos;
        float qv[32], o[32];
#pragma unroll
        for (int d = 0; d < 32; ++d) { qv[d] = bf2f(Qb[row * ldq + qc0 + h * 128 + part * 32 + d]); o[d] = 0.f; }
        float mrun = -1e30f, l = 0.f;
        const float* fb = MODE == 0 ? fbias + (size_t)(b * 8 + h) * SEQ : nullptr;
        for (int kt = 0; kt <= qb; ++kt) {
            __syncthreads();
            for (int i = tid; i < 64 * 16; i += 256) { const int r = i >> 4, c8 = (i & 15) * 8; const size_t kr = (size_t)b * SEQ + kt * 64 + r;
                *(LAS v4u*)(Ks + r * 128 + c8) = *(const v4u*)(Kb + kr * ldk + kc0 + kvh * 128 + c8); *(LAS v4u*)(Vs + r * 128 + c8) = *(const v4u*)(Vb + kr * ldv + vc0 + kvh * 128 + c8); }
            __syncthreads();
            unsigned long long mw = ~0ull; if (MODE == 1) mw = mask[row * 64 + kt];
            for (int s = 0; s < 64; ++s) { const int key = kt * 64 + s; float p = 0.f;
#pragma unroll
                for (int d = 0; d < 32; ++d) p += qv[d] * bf2f(Ks[s * 128 + part * 32 + d]);
                p += __shfl_xor(p, 1); p += __shfl_xor(p, 2);
                const bool valid = key <= qpos && ((mw >> s) & 1ull);
                if (valid) { const float logit = (p + (MODE == 0 ? fb[key] : 0.f)) * ATT_SCALE; const float mn = fmaxf(mrun, logit), al = __expf(mrun - mn), pp = __expf(logit - mn);
                    l = l * al + pp; mrun = mn;
#pragma unroll
                    for (int d = 0; d < 32; ++d) o[d] = o[d] * al + pp * bf2f(Vs[s * 128 + part * 32 + d]); } }
        }
        const float il = 1.0f / l;
#pragma unroll
        for (int d = 0; d < 32; ++d) O[row * DM + oc0 + h * 128 + part * 32 + d] = (bf16)f2bf(o[d] * il);
    }
    __syncthreads();
}
__device__ __forceinline__ void ph_idx_scores(Frame& F) {
    const bf16* PROJ1 = (const bf16*)(F.ws + WS_PROJ); const bf16* IK = (const bf16*)(F.ws + WS_IK); const float* IW = (const float*)(F.ws + WS_IW); float* SC = (float*)(F.ws + WS_SC);
    LAS float* q = (LAS float*)F.lds; LAS float* w = q + 1024; const int tid = F.tid;
    for (int m = blockIdx.x; m < MTOK; m += F.G) { const int pos = m & 4095, b = m >> 12;
        __syncthreads();
        for (int i = tid; i < 1024; i += 512) q[i] = bf2f(PROJ1[(size_t)m * NP1 + 3072 + i]);
        if (tid < 16) w[tid] = IW[(size_t)m * 16 + tid];
        __syncthreads();
        for (int s = tid; s <= pos; s += 512) { const bf16* kr = IK + ((size_t)b * SEQ + s) * 64; float kk[64];
#pragma unroll
            for (int d = 0; d < 64; ++d) kk[d] = bf2f(kr[d]);
            float sc = 0.f;
#pragma unroll 1
            for (int hh = 0; hh < 16; ++hh) { float dsum = 0.f;
#pragma unroll
                for (int d = 0; d < 64; ++d) dsum += q[hh * 64 + d] * kk[d];
                sc += w[hh] * fmaxf(dsum, 0.f); }
            SC[(size_t)m * SEQ + s] = sc; }
    }
    __syncthreads();
}
namespace attn {
constexpr int D = 128, NW = 8, QBLK = 32, KVBLK = 64, QB = NW * QBLK;
constexpr int SHM_V = KVBLK * D * 2, SHM_K = KVBLK * D * 2;
constexpr int OFF_WS = 2 * SHM_V + 2 * SHM_K, OFF_BIAS = OFF_WS + NW * 64 * 4, LDS_NEED = OFF_BIAS + 2 * 16384;
constexpr float SCALE = 0.08838834764831845f, THR = 8.f;
typedef short s16x4 __attribute__((ext_vector_type(4)));
typedef float f32x16 __attribute__((ext_vector_type(16)));
typedef unsigned u32x4 __attribute__((ext_vector_type(4)));
#define KSWZ(row, colB) ((row) * 256 + ((colB) ^ (((row) & 7) << 4)))
#define SBAR() __builtin_amdgcn_sched_barrier(0)
__device__ __forceinline__ int v_st(int k, int c) { const int kk = (k & ~0xC) | ((k & 4) << 1) | ((k & 8) >> 1); return ((kk >> 3) * 4 + (c >> 5)) * 512 + ((kk & 7) * 32 + (c & 31)) * 2; }
__device__ __forceinline__ int v_rd_base(int lane) { return ((lane & 3) << 3) | (((lane >> 2) & 3) << 6) | (((lane >> 4) & 1) << 5) | (((lane >> 5) & 1) << 8); }
constexpr int v_rd_off(int d0, int ks, int half) { return d0 * 512 + ks * 4096 + half * 2048; }
__device__ __forceinline__ int crow(int r, int hi) { return (r & 3) + 8 * (r >> 2) + 4 * hi; }
__device__ __forceinline__ unsigned cvtpk(float lo, float hi) { unsigned r; asm volatile("v_cvt_pk_bf16_f32 %0, %1, %2" : "=v"(r) : "v"(lo), "v"(hi)); return r; }
__device__ __forceinline__ bf16x8 load8(const bf16* p) { return *reinterpret_cast<const bf16x8*>(p); }
__device__ __forceinline__ void mask_tile(f32x16& p0, f32x16& p1, int dq) {
    const float NEG = -__builtin_inff();
#pragma unroll
    for (int r = 0; r < 16; ++r) { const int c = (r & 3) + 8 * (r >> 2); if (dq - c < 0) p0[r] = NEG; if (dq - c - 32 < 0) p1[r] = NEG; }
}
__device__ __forceinline__ void mask_bits(f32x16& p0, f32x16& p1, unsigned w0, unsigned w1) {
    const float NEG = -__builtin_inff();
#pragma unroll
    for (int r = 0; r < 16; ++r) { const unsigned c = (r & 3) + 8 * (r >> 2); if (!(w0 & (1u << c))) p0[r] = NEG; if (!(w1 & (1u << c))) p1[r] = NEG; }
}
__device__ __forceinline__ void partialSM(f32x16& p0, f32x16& p1, float& m_reg, float& mn, float& alpha) {
    float pmax = p0[0]; for (int r = 1; r < 16; ++r) pmax = fmaxf(pmax, p0[r]); for (int r = 0; r < 16; ++r) pmax = fmaxf(pmax, p1[r]);
    { auto rr = __builtin_amdgcn_permlane32_swap(__float_as_uint(pmax), __float_as_uint(pmax), false, false);
      pmax = fmaxf(__uint_as_float(rr[0]), __uint_as_float(rr[1])); }
    constexpr float C2 = 1.4426950408889634f * SCALE;
    if (__builtin_expect(__all((pmax - m_reg) * SCALE <= THR), 1)) { mn = m_reg; alpha = 1.f; }
    else { mn = fmaxf(m_reg, pmax); alpha = __builtin_amdgcn_exp2f((m_reg - mn) * C2); m_reg = mn; }
    const float mnL = -mn * C2;
    for (int r = 0; r < 16; ++r) p0[r] = fmaf(p0[r], C2, mnL); for (int r = 0; r < 16; ++r) p1[r] = fmaf(p1[r], C2, mnL);
    for (int r = 0; r < 16; ++r) p0[r] = __builtin_amdgcn_exp2f(p0[r]);
}
__device__ __forceinline__ void finishSM(f32x16& p0, f32x16& p1, float alpha, float& l_reg, bf16x8& pa0, bf16x8& pa1, bf16x8& pa2, bf16x8& pa3) {
    for (int r = 0; r < 16; ++r) p1[r] = __builtin_amdgcn_exp2f(p1[r]);
    float ps = 0; for (int r = 0; r < 16; ++r) ps += p0[r]; for (int r = 0; r < 16; ++r) ps += p1[r];
    { auto rr = __builtin_amdgcn_permlane32_swap(__float_as_uint(ps), __float_as_uint(ps), false, false);
      ps = __uint_as_float(rr[0]) + __uint_as_float(rr[1]); }
    l_reg = l_reg * alpha + ps;
#define PK4(P, B_, OUT) do { unsigned a0 = cvtpk(P[B_+0], P[B_+1]), a1 = cvtpk(P[B_+2], P[B_+3]);                          \
        unsigned b0 = cvtpk(P[B_+4], P[B_+5]), b1 = cvtpk(P[B_+6], P[B_+7]);                                             \
        auto r0 = __builtin_amdgcn_permlane32_swap(a0, b0, false, false); auto r1 = __builtin_amdgcn_permlane32_swap(a1, b1, false, false); \
        u32x4 w = {r0[0], r1[0], r0[1], r1[1]}; OUT = *reinterpret_cast<bf16x8*>(&w); } while (0)
    PK4(p0, 0, pa0); PK4(p0, 8, pa1); PK4(p1, 0, pa2); PK4(p1, 8, pa3);
#undef PK4
}
template <int KB, bool BIAS>
__device__ __forceinline__ void qkt(f32x16& p0, f32x16& p1, const char* K_lds, int r32, int hi, const bf16x8* qr, const char* bl) {
    p0 = f32x16{}; p1 = f32x16{}; (void)bl;
    const char* kb[4];
#pragma unroll
    for (int dd = 0; dd < 4; ++dd) kb[dd] = K_lds + KB * SHM_K + KSWZ(r32, (dd * 16 + hi * 8) * 2);
#pragma unroll
    for (int d0 = 0; d0 < 8; ++d0) { const char* a = kb[d0 & 3] + (d0 >> 2) * 128;
        bf16x8 b0 = *reinterpret_cast<const bf16x8*>(a);
        bf16x8 b1 = *reinterpret_cast<const bf16x8*>(a + 32 * 256);
        p0 = __builtin_amdgcn_mfma_f32_32x32x16_bf16(b0, qr[d0], p0, 0, 0, 0);
        p1 = __builtin_amdgcn_mfma_f32_32x32x16_bf16(b1, qr[d0], p1, 0, 0, 0); }
}
template <int VB>
__device__ __forceinline__ void pv_tile(f32x16* o, int vb0, bf16x8 pa0, bf16x8 pa1, bf16x8 pa2, bf16x8 pa3) {
#define TRRD(dst, off) asm volatile("ds_read_b64_tr_b16 %0, %1 offset:%2" : "=&v"(dst) : "v"(vb0), "i"(off) : "memory")
#define PV_D0(d0) do { s16x4 l0, l1, l2, l3, h0, h1, h2, h3; constexpr int b_ = VB * SHM_V + v_rd_off(d0, 0, 0); \
        TRRD(l0, b_); TRRD(h0, b_ + 2048); TRRD(l1, b_ + 4096); TRRD(h1, b_ + 6144); TRRD(l2, b_ + 8192); TRRD(h2, b_ + 10240); TRRD(l3, b_ + 12288); TRRD(h3, b_ + 14336); \
        asm volatile("s_waitcnt lgkmcnt(0)" ::: "memory"); SBAR();   \
        o[d0] = __builtin_amdgcn_mfma_f32_32x32x16_bf16(pa0, (bf16x8){l0[0], l0[1], l0[2], l0[3], h0[0], h0[1], h0[2], h0[3]}, o[d0], 0, 0, 0);   \
        o[d0] = __builtin_amdgcn_mfma_f32_32x32x16_bf16(pa1, (bf16x8){l1[0], l1[1], l1[2], l1[3], h1[0], h1[1], h1[2], h1[3]}, o[d0], 0, 0, 0);   \
        o[d0] = __builtin_amdgcn_mfma_f32_32x32x16_bf16(pa2, (bf16x8){l2[0], l2[1], l2[2], l2[3], h2[0], h2[1], h2[2], h2[3]}, o[d0], 0, 0, 0);   \
        o[d0] = __builtin_amdgcn_mfma_f32_32x32x16_bf16(pa3, (bf16x8){l3[0], l3[1], l3[2], l3[3], h3[0], h3[1], h3[2], h3[3]}, o[d0], 0, 0, 0); } while (0)
    PV_D0(0); PV_D0(1); PV_D0(2); PV_D0(3);
#undef PV_D0
#undef TRRD
}
struct BlockRef { const bf16* Q; const bf16* K; const bf16* V; bf16* O; int P0; const float* fb; const unsigned long long* mrow; };
struct Seam { bf16x8 qr[8]; bf16x8 st_v0, st_v1, st_k0, st_k1; };
#define VMW() asm volatile("s_waitcnt vmcnt(0)" ::: "memory")
#define VMWN(n) asm volatile("s_waitcnt vmcnt(%0)" :: "i"(n) : "memory")
#define SLOAD_H(Kp, Vp, k0) do { const bf16* kt_ = (Kp) + (size_t)(k0) * KS; const bf16* vt_ = (Vp) + (size_t)(k0) * KS; S.st_v0 = load8(vt_ + koff); S.st_v1 = load8(vt_ + koff + 32 * KS); S.st_k0 = load8(kt_ + koff); S.st_k1 = load8(kt_ + koff + 32 * KS); } while (0)
#define SWRITE_HK(bf) do { *(bf16x8*)(K_lds + (bf) * SHM_K + kws) = S.st_k0; *(bf16x8*)(K_lds + (bf) * SHM_K + kws + 32 * 256) = S.st_k1; } while (0)
#define SWRITE_HV(bf) do { *(bf16x8*)(V_lds + (bf) * SHM_V + vst0) = S.st_v0; *(bf16x8*)(V_lds + (bf) * SHM_V + vst1) = S.st_v1; } while (0)
#define SWRITE_H(bf) do { SWRITE_HV(bf); SWRITE_HK(bf); } while (0)
template <bool BIAS, bool BITMASK, int QS, int KS, int OS>
__device__ __forceinline__ void attn_block(const BlockRef& cur, char* lds, LAS unsigned char* ldsl) {
    int tid_ = threadIdx.x; asm volatile("" : "+v"(tid_));
    const int tid = tid_, wid = __builtin_amdgcn_readfirstlane(tid >> 6), lane = tid & 63, r32 = lane & 31, hi = lane >> 5;
    const int NT = (cur.P0 + QB - 1) / KVBLK + 1;
    const int qlo = cur.P0 + wid * QBLK, qm = qlo + r32 - 4 * hi;
    char* V_lds = lds; char* K_lds = lds + 2 * SHM_V;
    float* ws = (float*)(lds + OFF_WS) + wid * 64; float* li_l = ws, * al_l = ws + 32;
    const LAS unsigned char* bl0 = ldsl + OFF_BIAS + hi * 16;
    float m_reg = -1e30f, l_reg = 0; f32x16 o[4] = {};
    const int sr = tid >> 4, sc = (tid & 15) * 8, vst0 = v_st(sr, sc), vst1 = v_st(32 + sr, sc), kws = KSWZ(sr, sc * 2);
    const int vb0 = (int)(uintptr_t)V_lds + v_rd_base(lane);
    const bf16* Kh = cur.K; const bf16* Vh = cur.V;
    const int moff = (wid * QBLK + r32) * 64, koff = sr * KS + sc, qoff = (wid * QBLK + r32) * QS + hi * 8;
    Seam S;
#pragma unroll
    for (int d0 = 0; d0 < 8; ++d0) S.qr[d0] = load8(cur.Q + qoff + d0 * 16);
    if constexpr (BIAS) { const f32x4 b0_ = *(const f32x4*)(cur.fb + tid * 8), b1_ = *(const f32x4*)(cur.fb + tid * 8 + 4);
        *(LAS f32x4*)(ldsl + OFF_BIAS + tid * 32) = b0_; *(LAS f32x4*)(ldsl + OFF_BIAS + tid * 32 + 16) = b1_; }
    SLOAD_H(Kh, Vh, 0); VMW(); SWRITE_HK(0); SWRITE_HV(0); SBAR();
#define RESC(a) do { if (__any((a) < 1.f)) { if (hi == 0) al_l[r32] = (a); asm volatile("s_waitcnt lgkmcnt(0)" ::: "memory");              \
                     for (int d_ = 0; d_ < 4; ++d_) for (int r = 0; r < 16; ++r) o[d_][r] *= al_l[crow(r, hi)]; } } while (0)
#define KBASE(t) ((t) * KVBLK)
#define MLOAD(MW, t) do { if constexpr (BITMASK) MW = (cur.mrow + (t))[moff]; } while (0)
#define MASKT(P0_, P1_, MW, t) do { if constexpr (BIAS) { const LAS unsigned char* bl_ = bl0 + KBASE(t) * 4; _Pragma("unroll") for (int g = 0; g < 4; ++g) { const f32x4 a_ = *(const LAS f32x4*)(bl_ + g * 32), b_ = *(const LAS f32x4*)(bl_ + 128 + g * 32); \
            P0_[4 * g] += a_[0]; P0_[4 * g + 1] += a_[1]; P0_[4 * g + 2] += a_[2]; P0_[4 * g + 3] += a_[3]; P1_[4 * g] += b_[0]; P1_[4 * g + 1] += b_[1]; P1_[4 * g + 2] += b_[2]; P1_[4 * g + 3] += b_[3]; } } \
        if constexpr (BITMASK) { mask_bits(P0_, P1_, (unsigned)(MW) >> (4 * hi), (unsigned)((MW) >> 32) >> (4 * hi)); } \
        else { const int kb_ = KBASE(t); if (kb_ + KVBLK - 1 > qlo) mask_tile(P0_, P1_, qm - kb_); } } while (0)
    f32x16 pA0, pA1, pB0, pB1; float mnA, mnB, alA, alB; bf16x8 pa0, pa1, pa2, pa3; unsigned long long mwA = 0, mwB = 0;
    MLOAD(mwA, 0);
    SLOAD_H(Kh, Vh, KBASE(1)); MLOAD(mwB, 1);
    __syncthreads();
    SBAR(); qkt<0, BIAS>(pA0, pA1, K_lds, r32, hi, S.qr, nullptr);
    MASKT(pA0, pA1, mwA, 0); partialSM(pA0, pA1, m_reg, mnA, alA);
    VMW(); SWRITE_H(1);
    __syncthreads();
#define HALF_STEP(PX0, PX1, mnX, alX, MWX, PY0, PY1, alY, MWY, t, KB, VB, SB) do {                                            \
        SBAR(); qkt<KB, BIAS>(PX0, PX1, K_lds, r32, hi, S.qr, nullptr);                                                       \
        finishSM(PY0, PY1, alY, l_reg, pa0, pa1, pa2, pa3); SBAR();                                                           \
        if ((t) + 1 < NT) { SLOAD_H(Kh, Vh, KBASE((t) + 1)); MLOAD(MWY, (t) + 1); SBAR(); }                                   \
        pv_tile<VB>(o, vb0, pa0, pa1, pa2, pa3); MASKT(PX0, PX1, MWX, (t)); partialSM(PX0, PX1, m_reg, mnX, alX);             \
        __syncthreads();                                                                                                      \
        if ((t) + 1 < NT) { VMW(); SWRITE_H(SB); }                                                                            \
        RESC(alX); __syncthreads(); } while (0)
    for (int t = 1; t + 1 < NT; t += 2) {
        HALF_STEP(pB0, pB1, mnB, alB, mwB, pA0, pA1, alA, mwA, t, 1, 0, 0);
        HALF_STEP(pA0, pA1, mnA, alA, mwA, pB0, pB1, alB, mwB, t + 1, 0, 1, 1);
    }
    SBAR(); qkt<1, BIAS>(pB0, pB1, K_lds, r32, hi, S.qr, nullptr); SBAR();
    finishSM(pA0, pA1, alA, l_reg, pa0, pa1, pa2, pa3); SBAR();
    pv_tile<0>(o, vb0, pa0, pa1, pa2, pa3);
    MASKT(pB0, pB1, mwB, NT - 1); partialSM(pB0, pB1, m_reg, mnB, alB); __syncthreads(); RESC(alB);
    finishSM(pB0, pB1, alB, l_reg, pa0, pa1, pa2, pa3); SBAR(); pv_tile<1>(o, vb0, pa0, pa1, pa2, pa3);
    SBAR();
    if (hi == 0) li_l[r32] = l_reg; asm volatile("s_waitcnt lgkmcnt(0)" ::: "memory");
    float rli[16];
#pragma unroll
    for (int r = 0; r < 16; ++r) rli[r] = __builtin_amdgcn_rcpf(li_l[crow(r, hi)]);
    int tid2_ = threadIdx.x; asm volatile("" : "+v"(tid2_));
    const int r32e = tid2_ & 31, hie = (tid2_ >> 5) & 1, ooff = (wid * QBLK + 4 * hie) * OS + r32e;
#pragma unroll
    for (int r = 0; r < 16; ++r) {
#pragma unroll
        for (int d0 = 0; d0 < 4; ++d0) { const float v = o[d0][r] * rli[r]; const float vn = __shfl_xor(v, 1);
            if ((r32e & 1) == 0) *(unsigned*)(cur.O + ((r & 3) + 8 * (r >> 2)) * OS + d0 * 32 + ooff) = cvtpk(v, vn); } }
    __syncthreads();
#undef RESC
#undef KBASE
#undef MLOAD
#undef MASKT
#undef HALF_STEP
}
#undef ROWK
#undef VMW
#undef VMWN
#undef SLOAD_H
#undef SWRITE_HK
#undef SWRITE_HV
#undef SWRITE_H
#undef KSWZ
#undef SBAR
template <bool BIAS, bool BITMASK, int NH, int GROUP, bool PAIR, int QS, int KS, int OS>
__device__ __forceinline__ void attn_phase(char* lds, LAS unsigned char* ldsl, const bf16* Q, const bf16* K, const bf16* V, bf16* O, const float* fbias, const unsigned long long* mask, int G, int bid) {
    constexpr int NBLK = BATCH * NH * 16, NITEM = PAIR ? NBLK / 2 : NBLK, PER = PAIR ? 8 : 16, SETH = BATCH * NH / 8;
    for (int L = bid; L < NITEM; L += G) {
#pragma unroll 1
        for (int pass = 0; pass < (PAIR ? 2 : 1); ++pass) {
            const int g = L & 7, k = L >> 3, hs = k / PER, x = k % PER; const int bh = g * SETH + hs, b = bh / NH, h = bh % NH;
            const int qb = PAIR ? (pass ? 15 - x : x) : 15 - x; BlockRef r; const size_t row0 = (size_t)b * SEQ + (size_t)qb * QB;
            r.Q = Q + row0 * QS + h * D; r.O = O + row0 * OS + h * D; r.K = K + (size_t)b * SEQ * KS + (h / GROUP) * D; r.V = V + (size_t)b * SEQ * KS + (h / GROUP) * D; r.P0 = qb * QB;
            r.fb = BIAS ? fbias + (size_t)bh * SEQ : nullptr; r.mrow = BITMASK ? mask + row0 * 64 : nullptr;
            attn_block<BIAS, BITMASK, QS, KS, OS>(r, lds, ldsl);
        }
    }
}
}
__device__ __forceinline__ float fast_silu(float g) { return g * __builtin_amdgcn_rcpf(1.0f + __expf(-g)); }
__device__ __forceinline__ void ph_gla_a(Frame& F, const Args& a) {
    const float* SK0 = (const float*)(F.ws + WS_SK0); const float* w2 = a.in[2]; const float* gbias = a.in[3]; float* GB = (float*)(F.ws + WS_GB); float* DEC = (float*)(F.ws + WS_DEC);
    const bf16* PROJ = (const bf16*)(F.ws + WS_PROJ); float* CST = (float*)(F.ws + WS_CST);
    LAS float* BSH = (LAS float*)F.lds; LAS float* TOT = BSH + 64 * 128; LAS bf16* VT = (LAS bf16*)(F.lds + 36864); LAS bf16* KET = (LAS bf16*)(F.lds + 73728);
    const int tid = F.tid, lane = F.lane, l15 = lane & 15, quad = lane >> 4, w = F.wave;
    for (int unit = blockIdx.x; unit < 512; unit += F.G) {
        const int n = unit & 63, bh = unit >> 6, b = bh >> 2, h = bh & 3, t0 = b * SEQ + n * 64;
        __syncthreads();
        {
            const int d = tid & 127, cg = tid >> 7; float wv[16];
#pragma unroll
            for (int r = 0; r < 16; ++r) wv[r] = w2[r * 512 + h * 128 + d];
            const float gb = gbias[h * 128 + d]; float run = 0.f;
            for (int cc = 0; cc < 16; ++cc) { const int c = cg * 16 + cc; const float* sk = SK0 + (size_t)(t0 + c) * 24; float z = gb;
#pragma unroll
                for (int r = 0; r < 16; ++r) z += sk[r] * wv[r];
                run += logsigmoidf(z) * (1.0f / 16.0f); BSH[c * 128 + d] = run; }
            TOT[cg * 128 + d] = run;
            __syncthreads();
            float pre = 0.f;
            for (int g = 0; g < cg; ++g) pre += TOT[g * 128 + d];
            for (int cc = 0; cc < 16; ++cc) { const int c = cg * 16 + cc; const float v = BSH[c * 128 + d] + pre; BSH[c * 128 + d] = v; GB[(size_t)(t0 + c) * 512 + h * 128 + d] = v; }
        }
        __syncthreads();
        {
            const int c = tid & 63, g8 = tid >> 6; const size_t t = (size_t)(t0 + c);
            const bf16* kp = PROJ + t * NP0 + 512 + h * 128 + g8 * 16;
            const v4u k0 = *(const v4u*)kp, k1 = *(const v4u*)(kp + 8);
            const unsigned kw[8] = {k0.x, k0.y, k0.z, k0.w, k1.x, k1.y, k1.z, k1.w};
#pragma unroll
            for (int i = 0; i < 8; ++i) { const int d = g8 * 16 + 2 * i; const float e0 = __expf(BSH[63 * 128 + d] - BSH[c * 128 + d]), e1 = __expf(BSH[63 * 128 + d + 1] - BSH[c * 128 + d + 1]);
                KET[d * 72 + c] = (bf16)f2bf(bf2f(kw[i] & 0xffff) * e0); KET[(d + 1) * 72 + c] = (bf16)f2bf(bf2f(kw[i] >> 16) * e1); }
            const bf16* vp = PROJ + t * NP0 + 1024 + h * 256 + g8 * 32;
#pragma unroll
            for (int q = 0; q < 4; ++q) { const v4u vv = *(const v4u*)(vp + 8 * q); const unsigned vw[4] = {vv.x, vv.y, vv.z, vv.w};
#pragma unroll
                for (int i = 0; i < 4; ++i) { const int v = g8 * 32 + q * 8 + 2 * i; VT[v * 72 + c] = (bf16)(vw[i] & 0xffff); VT[(v + 1) * 72 + c] = (bf16)(vw[i] >> 16); } }
            if (tid < 128) DEC[unit * 128 + tid] = __expf(BSH[63 * 128 + tid]);
        }
        __syncthreads();
        {
            pg8::f32x4 acc[2][8];
#pragma unroll
            for (int i = 0; i < 2; ++i)
#pragma unroll
                for (int nn = 0; nn < 8; ++nn) acc[i][nn] = (pg8::f32x4){0.f, 0.f, 0.f, 0.f};
#pragma unroll
            for (int kk = 0; kk < 64; kk += 32) {
                const bf16x8 a0 = *(const LAS bf16x8*)(VT + (32 * w + l15) * 72 + kk + quad * 8), a1 = *(const LAS bf16x8*)(VT + (32 * w + 16 + l15) * 72 + kk + quad * 8);
#pragma unroll
                for (int nn = 0; nn < 8; ++nn) { const bf16x8 bb = *(const LAS bf16x8*)(KET + (16 * nn + l15) * 72 + kk + quad * 8);
                    acc[0][nn] = __builtin_amdgcn_mfma_f32_16x16x32_bf16(a0, bb, acc[0][nn], 0, 0, 0); acc[1][nn] = __builtin_amdgcn_mfma_f32_16x16x32_bf16(a1, bb, acc[1][nn], 0, 0, 0); } }
            float* cp = CST + (size_t)unit * 32768;
#pragma unroll
            for (int i = 0; i < 2; ++i)
#pragma unroll
                for (int nn = 0; nn < 8; ++nn)
#pragma unroll
                    for (int j = 0; j < 4; ++j) cp[(32 * w + 16 * i + quad * 4 + j) * 128 + 16 * nn + l15] = acc[i][nn][j];
        }
    }
    __syncthreads();
}
__device__ __forceinline__ void ph_gla_c(Frame& F, const Args& a) {
    const bf16* PROJ = (const bf16*)(F.ws + WS_PROJ); const float* GB = (const float*)(F.ws + WS_GB); const bf16* PREVT = (const bf16*)(F.ws + WS_PREVT); const float* normg = a.in[4]; bf16* OMIX = (bf16*)(F.ws + WS_OMIX);
    LAS bf16* QD = (LAS bf16*)(F.lds + 32768); LAS bf16* KI = (LAS bf16*)(F.lds + 50176); LAS bf16* P = (LAS bf16*)(F.lds + 67584); LAS bf16* VT = (LAS bf16*)(F.lds + 76800); LAS float* RED = (LAS float*)(F.lds + 113664);
    const int tid = F.tid, lane = F.lane, l15 = lane & 15, quad = lane >> 4, w = F.wave;
    for (int unit = blockIdx.x; unit < 512; unit += F.G) {
        const int n = unit & 63, bh = unit >> 6, b = bh >> 2, h = bh & 3, t0 = b * SEQ + n * 64;
        __syncthreads();
        {
            const int c = tid >> 3, dg = tid & 7; const size_t t = (size_t)(t0 + c);
            const float* bp = GB + t * 512 + h * 128 + dg * 16; const bf16* qp = PROJ + t * NP0 + h * 128 + dg * 16; const bf16* kp = PROJ + t * NP0 + 512 + h * 128 + dg * 16;
#pragma unroll
            for (int q8 = 0; q8 < 2; ++q8) { const v4u qq = *(const v4u*)(qp + 8 * q8), kk = *(const v4u*)(kp + 8 * q8); const f32x4 b0 = *(const f32x4*)(bp + 8 * q8), b1 = *(const f32x4*)(bp + 8 * q8 + 4);
                const unsigned qw[4] = {qq.x, qq.y, qq.z, qq.w}, kw[4] = {kk.x, kk.y, kk.z, kk.w}; const float bv[8] = {b0[0], b0[1], b0[2], b0[3], b1[0], b1[1], b1[2], b1[3]};
                v4u oq, ok; unsigned* oqp = (unsigned*)&oq; unsigned* okp = (unsigned*)&ok;
#pragma unroll
                for (int i = 0; i < 4; ++i) { const float e0 = __expf(bv[2 * i]), e1 = __expf(bv[2 * i + 1]);
                    oqp[i] = pk2(bf2f(qw[i] & 0xffff) * ATT_SCALE * e0, bf2f(qw[i] >> 16) * ATT_SCALE * e1);
                    okp[i] = pk2(bf2f(kw[i] & 0xffff) * __builtin_amdgcn_rcpf(e0), bf2f(kw[i] >> 16) * __builtin_amdgcn_rcpf(e1)); }
                *(LAS v4u*)(QD + c * 136 + dg * 16 + 8 * q8) = oq; *(LAS v4u*)(KI + c * 136 + dg * 16 + 8 * q8) = ok; }
            const int c2 = tid & 63, g8 = tid >> 6; const bf16* vp = PROJ + (size_t)(t0 + c2) * NP0 + 1024 + h * 256 + g8 * 32;
#pragma unroll
            for (int q = 0; q < 4; ++q) { const v4u vv = *(const v4u*)(vp + 8 * q); const unsigned vw[4] = {vv.x, vv.y, vv.z, vv.w};
#pragma unroll
                for (int i = 0; i < 4; ++i) { const int v = g8 * 32 + q * 8 + 2 * i; VT[v * 72 + c2] = (bf16)(vw[i] & 0xffff); VT[(v + 1) * 72 + c2] = (bf16)(vw[i] >> 16); } }
        }
        __syncthreads();
        {
            const int ti = w >> 1;
#pragma unroll
            for (int s = 0; s < 2; ++s) { const int tj = 2 * (w & 1) + s; pg8::f32x4 acc = (pg8::f32x4){0.f, 0.f, 0.f, 0.f};
                if (tj <= ti) {
#pragma unroll
                    for (int kk = 0; kk < 128; kk += 32) { const bf16x8 aa = *(const LAS bf16x8*)(QD + (16 * ti + l15) * 136 + kk + quad * 8), bb = *(const LAS bf16x8*)(KI + (16 * tj + l15) * 136 + kk + quad * 8);
                        acc = __builtin_amdgcn_mfma_f32_16x16x32_bf16(aa, bb, acc, 0, 0, 0); } }
#pragma unroll
                for (int j = 0; j < 4; ++j) { const int i = 16 * ti + quad * 4 + j, jj = 16 * tj + l15; P[i * 72 + jj] = (bf16)f2bf(jj <= i ? acc[j] : 0.f); } }
        }
        __syncthreads();
        {
            const int ti = w >> 1, half = w & 1; pg8::f32x4 acc[8];
#pragma unroll
            for (int nn = 0; nn < 8; ++nn) acc[nn] = (pg8::f32x4){0.f, 0.f, 0.f, 0.f};
#pragma unroll
            for (int kk = 0; kk < 64; kk += 32) { const bf16x8 aa = *(const LAS bf16x8*)(P + (16 * ti + l15) * 72 + kk + quad * 8);
#pragma unroll
                for (int nn = 0; nn < 8; ++nn) { const bf16x8 bb = *(const LAS bf16x8*)(VT + (128 * half + 16 * nn + l15) * 72 + kk + quad * 8); acc[nn] = __builtin_amdgcn_mfma_f32_16x16x32_bf16(aa, bb, acc[nn], 0, 0, 0); } }
            const bf16* pv = PREVT + (size_t)unit * 32768 + (size_t)(128 * half + l15) * 128 + quad * 8;
#pragma unroll
            for (int kk = 0; kk < 128; kk += 32) { const bf16x8 aa = *(const LAS bf16x8*)(QD + (16 * ti + l15) * 136 + kk + quad * 8);
#pragma unroll
                for (int nn = 0; nn < 8; ++nn) { const bf16x8 bb = *(const bf16x8*)(pv + (size_t)(16 * nn) * 128 + kk); acc[nn] = __builtin_amdgcn_mfma_f32_16x16x32_bf16(aa, bb, acc[nn], 0, 0, 0); } }
            float ss[4];
#pragma unroll
            for (int j = 0; j < 4; ++j) { float s = 0.f;
#pragma unroll
                for (int nn = 0; nn < 8; ++nn) s += acc[nn][j] * acc[nn][j];
                s += __shfl_xor(s, 1); s += __shfl_xor(s, 2); s += __shfl_xor(s, 4); s += __shfl_xor(s, 8); ss[j] = s; }
            if (l15 == 0) {
#pragma unroll
                for (int j = 0; j < 4; ++j) RED[(16 * ti + quad * 4 + j) * 2 + half] = ss[j]; }
            __syncthreads();
#pragma unroll
            for (int j = 0; j < 4; ++j) { const int i = 16 * ti + quad * 4 + j; const float ms = (RED[i * 2] + RED[i * 2 + 1]) * (1.0f / 256.0f); const float rs = 1.0f / sqrtf(ms + LN_EPS);
                const size_t t = (size_t)(t0 + i);
#pragma unroll
                for (int nn = 0; nn < 8; ++nn) { const int v = 128 * half + 16 * nn + l15; const float gr = bf2f(PROJ[t * NP0 + 2048 + h * 256 + v]);
                    OMIX[t * DM + h * 256 + v] = (bf16)f2bf(acc[nn][j] * rs * normg[v] * fast_silu(gr)); } }
        }
    }
    __syncthreads();
}
__device__ __forceinline__ void ph_indexer(Frame& F, unsigned char* lds_generic) {
    typedef float f32x16 __attribute__((ext_vector_type(16)));
    const bf16* PROJ1 = (const bf16*)(F.ws + WS_PROJ); const bf16* IK = (const bf16*)(F.ws + WS_IK); const float* IW = (const float*)(F.ws + WS_IW); unsigned long long* MASK = (unsigned long long*)(F.ws + WS_MASK);
    LAS float* SCL = (LAS float*)F.lds;
    const int lane = F.lane, w = F.wave, c32 = lane & 31, hi = lane >> 5, rt = w & 3, kpar = w >> 2;
    for (int it = blockIdx.x; it < 512; it += F.G) {
#pragma unroll 1
        for (int pass = 0; pass < 2; ++pass) {
            const int unit = pass ? 1023 - it : it, m0 = unit * 8, b = m0 >> 12, qmax = (m0 & 4095) + 7;
            __syncthreads();
            {
                const int qa = m0 + 2 * rt + ((c32 >> 2) & 1), ha = (c32 & 3) + 4 * (c32 >> 3);
                const bf16* ap = PROJ1 + (size_t)qa * NP1 + 3072 + ha * 64 + 8 * hi;
                bf16x8 af[4];
#pragma unroll
                for (int ks = 0; ks < 4; ++ks) af[ks] = *(const bf16x8*)(ap + 16 * ks);
                const float* wp = IW + (size_t)(m0 + 2 * rt + hi) * 16; float wv[16];
#pragma unroll
                for (int q4 = 0; q4 < 4; ++q4) { const f32x4 t4 = *(const f32x4*)(wp + 4 * q4); wv[4 * q4] = t4[0]; wv[4 * q4 + 1] = t4[1]; wv[4 * q4 + 2] = t4[2]; wv[4 * q4 + 3] = t4[3]; }
                LAS float* srow = SCL + (2 * rt + hi) * 4096 + c32;
                const bf16* kbase = IK + (size_t)b * SEQ * 64 + (size_t)lane * 8;
                bf16x8 bn[4];
#pragma unroll
                for (int ks = 0; ks < 4; ++ks) bn[ks] = *(const bf16x8*)(kbase + (size_t)(kpar * 4 + ks) * 512);
                for (int t = kpar; t * 32 <= qmax; t += 2) {
                    bf16x8 bc[4];
#pragma unroll
                    for (int ks = 0; ks < 4; ++ks) bc[ks] = bn[ks];
                    const int tn = (t + 2) * 32 <= qmax ? t + 2 : t;
#pragma unroll
                    for (int ks = 0; ks < 4; ++ks) bn[ks] = *(const bf16x8*)(kbase + (size_t)(tn * 4 + ks) * 512);
                    f32x16 acc = {};
#pragma unroll
                    for (int ks = 0; ks < 4; ++ks) acc = __builtin_amdgcn_mfma_f32_32x32x16_bf16(af[ks], bc[ks], acc, 0, 0, 0);
                    float s = 0.f;
#pragma unroll
                    for (int r = 0; r < 16; ++r) s += wv[r] * fmaxf(acc[r], 0.f);
                    srow[t * 32] = s; }
            }
            __syncthreads();
            { const int m = m0 + w; topk_mask_row((const LAS float*)(F.lds + w * 16384), m & 4095, MASK + (size_t)m * 64, lane, (LAS unsigned*)(F.lds + LDSCTL_OFF + 4096 + w * 1024)); }
        }
    }
    __syncthreads();
}
#define IN(k) (lo <= (k) && (k) < hi)
#define SEAM(k) do { if (hi > (k) + 1) xcd_barrier(bar); } while (0)
template <int LAYER, int BASE>
__device__ __forceinline__ void common_phases(Frame& F, const Args& args, const int lo, const int hi, const XcdBarrier& bar) {
    unsigned char* ws = args.ws;
    if (IN(BASE + 0)) {
        pg8::Gemm g{(const bf16*)(ws + WS_OMIX), (const bf16*)(ws + (LAYER ? WS_WOC : WS_WOA)), MTOK, DM, DM, DM, DM}; pg8::StaticOrder S; S.init(MTOK, DM, F.G, (int)blockIdx.x);
        pg8::EpiResid E{LAYER ? (const float*)(ws + WS_XR) : args.in[0], (float*)(ws + WS_XR), DN_ALPHA};
        pg8::gemm_phase<pg8::EpiResid, pg8::StaticOrder, true, true>(F.lds, g, S, E);
        SEAM(BASE + 0);
    }
    if (IN(BASE + 1)) { p_ln_route(F, args, LAYER); SEAM(BASE + 1); }
    if (IN(BASE + 3) || IN(BASE + 4) || IN(BASE + 5)) {
        if (F.wave == 0) { int ti; (void)moe_offsets(F.ctl + CW_CNT + LAYER * 64, F.lane, &ti); if (F.lane < 32) { F.MISC[64 + F.lane] = (unsigned)ti; F.MISC[160 + F.lane] = F.ctl[CW_CNT + LAYER * 64 + F.lane]; } if (F.lane == 31) F.MISC[96] = (unsigned)ti; }
        __syncthreads();
    }
    {
        const int Tm = (int)F.MISC[96], T1 = F.G / 4 < Tm ? F.G / 4 : Tm;
        const int n2 = (Tm - T1) * 4;
        const pg8::Gemm gU{(const bf16*)(ws + WS_XB), (const bf16*)(ws + WS_WGU) + (size_t)LAYER * 32 * 1024 * 2048, RPAD, 32 * 1024, DM, DM, DM};
        const pg8::Gemm gD{(const bf16*)(ws + WS_OMIX), (const bf16*)(ws + WS_WD) + (size_t)LAYER * 32 * 2048 * 512, RPAD, 32 * 2048, 512, 512, 512};
        const PG8_LAS int* tend = (const LAS int*)(F.lds + LDSCTL_OFF + 64 * 4); const PG8_LAS int* ecnt = (const LAS int*)(F.lds + LDSCTL_OFF + 160 * 4);
        const int* inv = (const int*)(ws + WS_INV);
        const pg8::EpiGLU EU{(bf16*)(ws + WS_OMIX), (const float*)(ws + WS_WINV)}; const pg8::EpiBf16Plain ED{(bf16*)(ws + WS_CST), DM, 7};
        if (IN(BASE + 3)) {
            pg8::MoeOrder S{F.G, (int)blockIdx.x, 4, 0, T1 * 4, tend, ecnt};
            pg8::gemm_phase_g<pg8::EpiGLU, pg8::MoeOrder>(F.lds, gU, S, EU, inv);
            SEAM(BASE + 3);
        }
        if (IN(BASE + 4)) {
            if ((int)blockIdx.x < n2) { pg8::MoeOrder S{n2, (int)blockIdx.x, 4, T1 * 4, Tm * 4, tend, ecnt}; pg8::gemm_phase_g<pg8::EpiGLU, pg8::MoeOrder>(F.lds, gU, S, EU, inv); }
            else { pg8::MoeOrder S{F.G - n2, (int)blockIdx.x - n2, 8, 0, T1 * 8, tend, ecnt}; pg8::gemm_phase<pg8::EpiBf16Plain, pg8::MoeOrder, true, true>(F.lds, gD, S, ED); }
            SEAM(BASE + 4);
        }
        if (IN(BASE + 5)) {
            pg8::MoeOrder S{F.G, (int)blockIdx.x, 8, T1 * 8, Tm * 8, tend, ecnt};
            pg8::gemm_phase<pg8::EpiBf16Plain, pg8::MoeOrder, true, true>(F.lds, gD, S, ED);
            SEAM(BASE + 5);
        }
    }
    if (IN(BASE + 6)) { p_ln_ffn(F, args, LAYER); SEAM(BASE + 6); }
}
__global__ void __launch_bounds__(NWAVES * 64, 2) mk_fwd(Args args) {
    extern __shared__ __attribute__((aligned(16))) unsigned char lds[];
    Frame F;
    F.lds = (LAS unsigned char*)lds; F.MISC = (volatile LAS unsigned*)(F.lds + LDSCTL_OFF);
    F.tid = threadIdx.x; F.lane = F.tid & 63; F.wave = __builtin_amdgcn_readfirstlane(F.tid >> 6);
    F.G = gridDim.x; F.gw = blockIdx.x * NWAVES + F.wave; F.NGW = F.G * NWAVES;
    F.ws = args.ws; F.ctl = (unsigned*)(args.ws + WS_CTL);
    for (int u = F.tid; u < (LDS_BYTES - LDSCTL_OFF) / 4; u += NWAVES * 64) ((LAS unsigned*)(F.lds + LDSCTL_OFF))[u] = 0u;
    __syncthreads();
    const int lo = args.ph_lo, hi = args.ph_hi;
    XcdBarrier bar; bar.bar = F.ctl + CW_BAR + args.bar_region * XCD_BAR_WORDS; bar.x = 0; bar.st = nullptr;
    if (hi - lo > 1) bar = xcd_barrier_post(F.ctl + CW_BAR + args.bar_region * XCD_BAR_WORDS, F.MISC);
    unsigned char* ws = args.ws;

    if (IN(0)) { p0_prologue(F, args); SEAM(0); }
    if (IN(1)) {
        pg8::Gemm g{(const bf16*)(ws + WS_XB), (const bf16*)(ws + WS_WINA), MTOK, NP0, DM, DM, DM}; pg8::StaticOrder S; S.init(MTOK, NP0, F.G, (int)blockIdx.x);
        pg8::EpiBf16Plain E{(bf16*)(ws + WS_PROJ), NP0, 0x7fffffff};
        pg8::gemm_phase<pg8::EpiBf16Plain, pg8::StaticOrder, true, true>(F.lds, g, S, E);
        p_skinny0(F, args);
        SEAM(1);
    }
    if (IN(2)) { p_fox_bias(F, args); ph_gla_a(F, args); SEAM(2); }
    if (IN(4)) { ph_gla_scan(F); __syncthreads();
        attn::attn_phase<true, false, 8, 1, false, NP0, NP0, DM>((char*)lds, F.lds, (const bf16*)(ws + WS_PROJ) + 3072, (const bf16*)(ws + WS_PROJ) + 4096, (const bf16*)(ws + WS_PROJ) + 5120,
                                                               (bf16*)(ws + WS_OMIX) + 1024, (const float*)(ws + WS_FBIAS), (const unsigned long long*)nullptr, F.G, (int)blockIdx.x);
        late_conv_items(F, args);
        SEAM(4); }
    if (IN(5)) { ph_gla_c(F, args); SEAM(5); }
    common_phases<0, 6>(F, args, lo, hi, bar);
    if (IN(13)) {
        pg8::Gemm g{(const bf16*)(ws + WS_XB), (const bf16*)(ws + WS_WINC), MTOK, NP1, DM, DM, DM}; pg8::StaticOrder S; S.init(MTOK, NP1, F.G, (int)blockIdx.x);
        const float* c128 = (const float*)(ws + WS_ROPE);
        pg8::EpiRope E{(bf16*)(ws + WS_PROJ), c128, c128 + 4096 * 64, c128 + 2 * 4096 * 64, c128 + 2 * 4096 * 64 + 4096 * 32};
        pg8::gemm_phase<pg8::EpiRope, pg8::StaticOrder, true, true>(F.lds, g, S, E);
        SEAM(13);
    }
    if (IN(14)) { ph_indexer(F, lds); SEAM(14); }
    if (IN(16)) {
        attn::attn_phase<false, true, 16, 4, true, NP1, NP1, DM>((char*)lds, F.lds, (const bf16*)(ws + WS_PROJ), (const bf16*)(ws + WS_PROJ) + 2048, (const bf16*)(ws + WS_PROJ) + 2560,
                                                               (bf16*)(ws + WS_OMIX), (const float*)nullptr, (const unsigned long long*)(ws + WS_MASK), F.G, (int)blockIdx.x);
        SEAM(16); }
    common_phases<1, 17>(F, args, lo, hi, bar);
#ifdef PROBE_GEMM_K
    if (IN(30)) {
        pg8::Gemm g{(const bf16*)(ws + WS_XB), (const bf16*)(ws + WS_WINA), MTOK, NP0, PROBE_GEMM_K, PROBE_GEMM_LD, PROBE_GEMM_LD}; pg8::StaticOrder S; S.init(MTOK, NP0, F.G, (int)blockIdx.x);
        pg8::EpiBf16Plain E{(bf16*)(ws + WS_SC), NP0, 0x7fffffff};
        pg8::gemm_phase<pg8::EpiBf16Plain, pg8::StaticOrder, true, true>(F.lds, g, S, E);
    }
#endif
}
#undef IN
#undef SEAM
constexpr int N_PHASE_IDS = 24;
static void launch_mk(const Args& base, int lo, int hi, int grid, hipStream_t stream, int region = 0) {
    Args a = base; a.ph_lo = lo; a.ph_hi = hi; a.bar_region = region; a.pad = 0;
    hipLaunchKernelGGL(mk_fwd, dim3(grid), dim3(NWAVES * 64), LDS_BYTES, stream, a);
}
extern "C" void kernel_launch(void* const* d_in, const int* in_sizes, int n_in, void* d_out, int out_size, void* d_ws, size_t ws_size, hipStream_t stream) {
    static int grid = 0;
    if (grid == 0) {
        if (n_in != 20 || out_size != MTOK * DM || ws_size < WS_END) { fprintf(stderr, "kernel_launch: unexpected shapes (n_in %d, out %d, ws %zu < %zu)\n", n_in, out_size, ws_size, (size_t)WS_END); grid = -1; return; }
        int dev = 0, cus = 0, per_cu = 0;
        if (hipGetDevice(&dev) != hipSuccess || hipDeviceGetAttribute(&cus, hipDeviceAttributeMultiprocessorCount, dev) != hipSuccess) { grid = -1; return; }
        if (hipFuncSetAttribute((const void*)mk_fwd, hipFuncAttributeMaxDynamicSharedMemorySize, LDS_BYTES) != hipSuccess) { fprintf(stderr, "kernel_launch: hipFuncSetAttribute failed\n"); grid = -1; return; }
        if (hipOccupancyMaxActiveBlocksPerMultiprocessor(&per_cu, (const void*)mk_fwd, NWAVES * 64, LDS_BYTES) != hipSuccess || per_cu < 1) { fprintf(stderr, "kernel_launch: occupancy query reports %d workgroups per CU\n", per_cu); }
        (void)hipGetLastError();
        grid = cus;
    }
    if (grid < 0) return;
    (void)in_sizes;
    if (hipMemsetAsync((char*)d_ws + WS_CTL, 0, CTL_ZERO_BYTES, stream) != hipSuccess) return;
    Args a{};
    for (int i = 0; i < 20; ++i) a.in[i] = (const float*)d_in[i];
    a.out = (float*)d_out; a.ws = (unsigned char*)d_ws;
#ifdef PROBE_LO
    launch_mk(a, 0, PROBE_HI + 1, grid, stream, 0); launch_mk(a, PROBE_LO, N_PHASE_IDS, grid, stream, 1);
#else
    launch_mk(a, 0, N_PHASE_IDS, grid, stream);
#endif
#ifdef PROBE_GEMM_K
    launch_mk(a, 30, 31, grid, stream, 2);
#endif
}
```

```cpp
#include <hip/hip_runtime.h>
#include <cstdio>
#include <cstdint>
namespace pg8 {
#define PG8_LAS __attribute__((address_space(3)))
typedef unsigned short bf16_t;
typedef short bf16x8 __attribute__((ext_vector_type(8)));
typedef float f32x4 __attribute__((ext_vector_type(4)));
typedef unsigned u32x4 __attribute__((ext_vector_type(4)));
constexpr int BM = 256, BK = 64, HALF = 128, HTB = HALF * BK * 2  , STAGE_BYTES = 8 * HTB, NXCD = 8, WGM = 8;

__host__ __device__ __forceinline__ int lds_byte(int r, int c) { const int st = (r >> 4) * 2 + (c >> 5), rr = r & 15, cc = c & 31, ob = rr * 64 + cc * 2; return st * 1024 + (ob ^ (((ob >> 9) & 1) << 5)); }
__host__ __device__ __forceinline__ void stage_rc(int b, int& R, int& C) { const int st = b / 1024, sb = b % 1024, swz = sb ^ (((sb >> 9) & 1) << 5); R = (st >> 1) * 16 + swz / 64; C = (st & 1) * 32 + (swz % 64) / 2; }
__host__ __device__ __forceinline__ int perm32(int rho) { const int n = rho >> 4, i = rho & 15; return 8 * (i >> 2) + 4 * n + (i & 3); }

struct Unit { int pm, pn, inv0, nvalid; };
struct Gemm { const bf16_t* A; const bf16_t* Bt; int M, N, K, lda, ldb; };

struct StaticOrder {
    int nM, nN, nwg, G, c;
    __host__ __device__ void init(int M, int N, int G_, int c_) { nM = M / BM; nN = N / BM; nwg = nM * nN; G = G_; c = c_; }
    __host__ __device__ bool next(int i, Unit& u) const {
        const long L = (long)i * G + c; if (L >= nwg) return false;
        int wgid = (int)L; { const int q = nwg / NXCD, r = nwg % NXCD, xcd = wgid % NXCD, off = wgid / NXCD; wgid = (xcd < r ? xcd * (q + 1) : r * (q + 1) + (xcd - r) * q) + off; }
        const int nig = WGM * nN, gid = wgid / nig, fm = gid * WGM, gsz = (nM - fm) < WGM ? (nM - fm) : WGM;
        u.pm = fm + ((wgid % nig) % gsz); u.pn = (wgid % nig) / gsz; return true;
    }
    __device__ __forceinline__ void a_ready(const Unit&) const {}
    __device__ __forceinline__ void done(const Unit&) const {}
};

__device__ __forceinline__ unsigned cvt_pk_bf16(float lo, float hi) { unsigned r; asm volatile("v_cvt_pk_bf16_f32 %0, %1, %2" : "=v"(r) : "v"(lo), "v"(hi)); return r; }
typedef float f32x2 __attribute__((ext_vector_type(2)));
struct EpiBf16Plain {
    static constexpr bool PERM = true, AFTER_DRAIN = false;
    bf16_t* O; int ldc; int pn_mask;
    __device__ __forceinline__ void operator()(const f32x4 (&acc)[2][2][4][2], const Unit& u, int wr, int wc, int fr, int fq) const {
        const int row0 = u.pm * BM + wr * 64 + fr, col0 = (u.pn & pn_mask) * BM + wc * 32 + 8 * fq;
#pragma unroll
        for (int ai = 0; ai < 2; ++ai)
#pragma unroll
            for (int m = 0; m < 4; ++m) { bf16_t* rowp = O + (size_t)(row0 + ai * HALF + m * 16) * ldc + col0;
#pragma unroll
                for (int bj = 0; bj < 2; ++bj) { const f32x4 v0 = acc[ai][bj][m][0], v1 = acc[ai][bj][m][1];
                    u32x4 w; w.x = cvt_pk_bf16(v0[0], v0[1]); w.y = cvt_pk_bf16(v0[2], v0[3]); w.z = cvt_pk_bf16(v1[0], v1[1]); w.w = cvt_pk_bf16(v1[2], v1[3]);
                    *(u32x4*)(rowp + bj * HALF) = w; } }
    }
};
struct EpiResid {
    static constexpr bool PERM = false, AFTER_DRAIN = false;
    const float* base; float* out; float alpha;
    __device__ __forceinline__ void operator()(const f32x4 (&acc)[2][2][4][2], const Unit& u, int wr, int wc, int fr, int fq) const {
        const int row0 = u.pm * BM + wr * 64 + fr, col0 = u.pn * BM + wc * 32 + 4 * fq;
#pragma unroll
        for (int ai = 0; ai < 2; ++ai)
#pragma unroll
            for (int m = 0; m < 4; ++m) { const size_t off = (size_t)(row0 + ai * HALF + m * 16) * 2048 + col0;
#pragma unroll
                for (int bj = 0; bj < 2; ++bj)
#pragma unroll
                    for (int n = 0; n < 2; ++n) { const size_t o = off + bj * HALF + n * 16; const f32x4 b = *(const f32x4*)(base + o); *(f32x4*)(out + o) = b * alpha + acc[ai][bj][m][n]; } }
    }
};
struct EpiGLU {
    static constexpr bool PERM = true, AFTER_DRAIN = false;
    bf16_t* H; const float* winv;
    __device__ __forceinline__ void operator()(const f32x4 (&acc)[2][2][4][2], const Unit& u, int wr, int wc, int fr, int fq) const {
        const int row0 = u.pm * BM + wr * 64 + fr, f0 = (u.pn & 3) * 128 + wc * 32 + 8 * fq;
#pragma unroll
        for (int ai = 0; ai < 2; ++ai)
#pragma unroll
            for (int m = 0; m < 4; ++m) { const int row = row0 + ai * HALF + m * 16; const float w = winv[u.inv0 + ai * HALF + wr * 64 + m * 16 + fr];
                float h[8];
#pragma unroll
                for (int n = 0; n < 2; ++n)
#pragma unroll
                    for (int e = 0; e < 4; ++e) { const float g = acc[ai][0][m][n][e], up = acc[ai][1][m][n][e]; h[n * 4 + e] = g * __builtin_amdgcn_rcpf(1.0f + __expf(-g)) * up * w; }
                u32x4 o; o.x = cvt_pk_bf16(h[0], h[1]); o.y = cvt_pk_bf16(h[2], h[3]); o.z = cvt_pk_bf16(h[4], h[5]); o.w = cvt_pk_bf16(h[6], h[7]);
                *(u32x4*)(H + (size_t)row * 512 + f0) = o; }
    }
};
struct EpiRope {
    static constexpr bool PERM = true, AFTER_DRAIN = false;
    bf16_t* O; const float* c128; const float* s128; const float* c64; const float* s64;
    __device__ __forceinline__ void operator()(const f32x4 (&acc)[2][2][4][2], const Unit& u, int wr, int wc, int fr, int fq) const {
        const int row0 = u.pm * BM + wr * 64 + fr, jj = wc * 32 + 8 * fq;
        const int pn = u.pn;
        if (pn == 10 || pn == 11) {
#pragma unroll
            for (int ai = 0; ai < 2; ++ai)
#pragma unroll
                for (int m = 0; m < 4; ++m) { bf16_t* rowp = O + (size_t)(row0 + ai * HALF + m * 16) * 4096 + pn * 256 + jj;
#pragma unroll
                    for (int bj = 0; bj < 2; ++bj) { const f32x4 v0 = acc[ai][bj][m][0], v1 = acc[ai][bj][m][1];
                        u32x4 w; w.x = cvt_pk_bf16(v0[0], v0[1]); w.y = cvt_pk_bf16(v0[2], v0[3]); w.z = cvt_pk_bf16(v1[0], v1[1]); w.w = cvt_pk_bf16(v1[2], v1[3]);
                        *(u32x4*)(rowp + bj * HALF) = w; } }
            return;
        }
        const bool idx = pn >= 12;
        const int half = idx ? 32 : 64;
        const int hl = idx ? (jj >> 5) : (jj >> 6), i0 = jj & (half - 1);
        const int colbase = idx ? (3072 + ((pn - 12) * 4 + hl) * 64) : (pn * 256 + hl * 128);
        const float* ct = idx ? c64 : c128; const float* st = idx ? s64 : s128;
#pragma unroll
        for (int ai = 0; ai < 2; ++ai)
#pragma unroll
            for (int m = 0; m < 4; ++m) { const int row = row0 + ai * HALF + m * 16; const int pos = row & 4095;
                const float* cp = ct + (size_t)pos * half + i0; const float* sp = st + (size_t)pos * half + i0;
                const f32x4 c0 = *(const f32x4*)cp, c1 = *(const f32x4*)(cp + 4), s0 = *(const f32x4*)sp, s1 = *(const f32x4*)(sp + 4);
                const f32x4 a0 = acc[ai][0][m][0], a1 = acc[ai][0][m][1], b0 = acc[ai][1][m][0], b1 = acc[ai][1][m][1];
                const f32x4 x0 = a0 * c0 - b0 * s0, x1 = a1 * c1 - b1 * s1, y0 = b0 * c0 + a0 * s0, y1 = b1 * c1 + a1 * s1;
                bf16_t* rowp = O + (size_t)row * 4096 + colbase + i0;
                u32x4 w; w.x = cvt_pk_bf16(x0[0], x0[1]); w.y = cvt_pk_bf16(x0[2], x0[3]); w.z = cvt_pk_bf16(x1[0], x1[1]); w.w = cvt_pk_bf16(x1[2], x1[3]);
                *(u32x4*)rowp = w;
                u32x4 z; z.x = cvt_pk_bf16(y0[0], y0[1]); z.y = cvt_pk_bf16(y0[2], y0[3]); z.z = cvt_pk_bf16(y1[0], y1[1]); z.w = cvt_pk_bf16(y1[2], y1[3]);
                *(u32x4*)(rowp + half) = z; }
    }
};
struct MoeOrder {
    int G, c, ntn, L0, Lend; const PG8_LAS int* tend; const PG8_LAS int* cnt;
    __device__ __forceinline__ bool next(int i, Unit& u) const {
        const int L = L0 + i * G + c; if (L >= Lend) return false;
        const int t = L / ntn; int e = 0;
#pragma unroll 1
        for (int k = 0; k < 32; ++k) e += (t >= tend[k]) ? 1 : 0;
        const int p0 = (t - (e ? tend[e - 1] : 0)) * BM, left = cnt[e] - p0;
        u.pm = t; u.pn = e * ntn + (L - t * ntn); u.inv0 = e * 8192 + p0; u.nvalid = left < BM ? left : BM; return true;
    }
    __device__ __forceinline__ void a_ready(const Unit&) const {}
    __device__ __forceinline__ void done(const Unit&) const {}
};
template <class Epi, class Sched, bool ALIGN_EPI = false, bool SP2 = false>
__device__ __forceinline__ void gemm_phase(PG8_LAS unsigned char* lds, const Gemm g, const Sched& S, const Epi& E) {
    const int tid = threadIdx.x, wid = __builtin_amdgcn_readfirstlane(tid >> 6), lane = tid & 63, wr = wid >> 2, wc = wid & 3, fr = lane & 15, fq = lane >> 4;
    const int K = g.K, nt = K / BK;
    unsigned voffA[2], voffB[2];
#pragma unroll
    for (int i = 0; i < 2; ++i) { int R, C; stage_rc(tid * 16 + i * 8192, R, C); const int Rb = Epi::PERM ? ((R & ~31) + perm32(R & 31)) : R;
        voffA[i] = (unsigned)(R * g.lda + C) * 2u; voffB[i] = (unsigned)(Rb * g.ldb + C) * 2u; }
    const size_t kstep = (size_t)(BK * 2);
    const size_t hstepA = (size_t)HALF * g.lda * 2, hstepB = (size_t)HALF * g.ldb * 2;
    const size_t tstepA = 2 * hstepA, tstepB = 2 * hstepB;
    const unsigned ldsw = (unsigned)wid * 1024u;
    const int aoff = lds_byte(wr * 64 + fr, fq * 8), boff = lds_byte(wc * 32 + fr, fq * 8);
#define PG8_SA(b, h) (((b) * 2 + (h)) * HTB)
#define PG8_SB(b, h) ((4 + (b) * 2 + (h)) * HTB)
#define PG8_STAGE(bufoff, gbase, voff) do { _Pragma("unroll") for (int _i = 0; _i < 2; ++_i) \
        __builtin_amdgcn_global_load_lds((const unsigned*)((const char*)(gbase) + (voff)[_i]), (PG8_LAS unsigned*)(lds + (bufoff) + ldsw + _i * 8192), 16, 0, 0); } while (0)
#define PG8_LDA(dst, b, h) do { _Pragma("unroll") for (int m = 0; m < 4; ++m) _Pragma("unroll") for (int k = 0; k < 2; ++k) dst[m][k] = *(const PG8_LAS bf16x8*)(lds + PG8_SA(b, h) + aoff + m * 2048 + k * 1024); } while (0)
#define PG8_LDB(dst, b, h) do { _Pragma("unroll") for (int n = 0; n < 2; ++n) _Pragma("unroll") for (int k = 0; k < 2; ++k) dst[n][k] = *(const PG8_LAS bf16x8*)(lds + PG8_SB(b, h) + boff + n * 2048 + k * 1024); } while (0)
#define PG8_MMA(ai, bj, At, Bt) do { __builtin_amdgcn_s_setprio(1); _Pragma("unroll") for (int m = 0; m < 4; ++m) _Pragma("unroll") for (int n = 0; n < 2; ++n) _Pragma("unroll") for (int k = 0; k < 2; ++k) \
        acc[ai][bj][m][n] = __builtin_amdgcn_mfma_f32_16x16x32_bf16(Bt[n][k], At[m][k], acc[ai][bj][m][n], 0, 0, 0); __builtin_amdgcn_s_setprio(0); } while (0)
#define PG8_WAIT_V(n) asm volatile("s_waitcnt vmcnt(" #n ")" ::: "memory")
#define PG8_WAIT_L(n) asm volatile("s_waitcnt lgkmcnt(" #n ")" ::: "memory")
#define PG8_BAR __builtin_amdgcn_s_barrier()
#define PG8_SCHED __builtin_amdgcn_sched_barrier(0)
    Unit cur, nxt; int ui = 0;
    if (!S.next(0, cur)) return;
    f32x4 acc[2][2][4][2];
#pragma unroll
    for (int a = 0; a < 2; ++a)
#pragma unroll
        for (int b = 0; b < 2; ++b)
#pragma unroll
            for (int m = 0; m < 4; ++m)
#pragma unroll
                for (int n = 0; n < 2; ++n) acc[a][b][m][n] = (f32x4){0.f, 0.f, 0.f, 0.f};
    bf16x8 At[4][2], B0[2][2], B1[2][2];
    const char* cA = (const char*)g.A + (size_t)cur.pm * tstepA; const char* cB = (const char*)g.Bt + (size_t)cur.pn * tstepB;
    S.a_ready(cur);
    if constexpr (SP2) {
        PG8_STAGE(PG8_SB(0, 0), cB, voffB); PG8_STAGE(PG8_SB(0, 1), cB + hstepB, voffB); PG8_STAGE(PG8_SA(0, 0), cA, voffA); PG8_STAGE(PG8_SA(0, 1), cA + hstepA, voffA);
        if (wr == 1) PG8_BAR;
        PG8_WAIT_V(2); PG8_BAR;
        PG8_STAGE(PG8_SB(1, 0), cB + kstep, voffB); PG8_STAGE(PG8_SA(1, 0), cA + kstep, voffA); PG8_STAGE(PG8_SB(1, 1), cB + hstepB + kstep, voffB);
        PG8_WAIT_V(6); PG8_BAR;
    } else {
        PG8_STAGE(PG8_SB(0, 0), cB, voffB); PG8_STAGE(PG8_SA(0, 0), cA, voffA); PG8_STAGE(PG8_SB(0, 1), cB + hstepB, voffB); PG8_STAGE(PG8_SA(0, 1), cA + hstepA, voffA);
        if (wr == 1) PG8_BAR;
        PG8_WAIT_V(4); PG8_BAR;
        PG8_STAGE(PG8_SB(1, 0), cB + kstep, voffB); PG8_STAGE(PG8_SA(1, 0), cA + kstep, voffA); PG8_STAGE(PG8_SB(1, 1), cB + hstepB + kstep, voffB);
        PG8_WAIT_V(6); PG8_BAR;
    }
    for (;;) {
        const bool has_next = S.next(ui + 1, nxt);
        const char* nA = has_next ? (const char*)g.A + (size_t)nxt.pm * tstepA : cA; const char* nB = has_next ? (const char*)g.Bt + (size_t)nxt.pn * tstepB : cB;
        for (int t = 0; t < nt; t += 2) {
            const bool last = (t == nt - 2);
            const char* a1 = cA + (size_t)(t + 1) * kstep;
            const char* a2 = last ? nA : cA + (size_t)(t + 2) * kstep; const char* b2 = last ? nB : cB + (size_t)(t + 2) * kstep;
            const char* a3 = a2 + kstep; const char* b3 = b2 + kstep;
            if (last && has_next) S.a_ready(nxt);
            if constexpr (SP2) {
            PG8_LDB(B0, 0, 0); PG8_LDB(B1, 0, 1); PG8_SCHED; PG8_LDA(At, 0, 0); PG8_STAGE(PG8_SA(1, 1), a1 + hstepA, voffA);
            PG8_WAIT_V(8); PG8_WAIT_L(0); PG8_BAR; PG8_MMA(0, 0, At, B0); PG8_MMA(0, 1, At, B1); PG8_BAR; PG8_SCHED;
            PG8_LDA(At, 0, 1); PG8_STAGE(PG8_SB(0, 0), b2, voffB); PG8_STAGE(PG8_SB(0, 1), b2 + hstepB, voffB); PG8_STAGE(PG8_SA(0, 0), a2, voffA);
            PG8_WAIT_V(8); PG8_WAIT_L(0); PG8_BAR; PG8_MMA(1, 0, At, B0); PG8_MMA(1, 1, At, B1); PG8_BAR; PG8_SCHED;
            PG8_LDB(B0, 1, 0); PG8_LDB(B1, 1, 1); PG8_SCHED; PG8_LDA(At, 1, 0); PG8_STAGE(PG8_SA(0, 1), a2 + hstepA, voffA);
            PG8_WAIT_V(8); PG8_WAIT_L(0); PG8_BAR; PG8_MMA(0, 0, At, B0); PG8_MMA(0, 1, At, B1); PG8_BAR; PG8_SCHED;
            PG8_LDA(At, 1, 1); PG8_STAGE(PG8_SB(1, 0), b3, voffB); PG8_STAGE(PG8_SB(1, 1), b3 + hstepB, voffB); PG8_STAGE(PG8_SA(1, 0), a3, voffA);
            PG8_WAIT_V(8); PG8_WAIT_L(0); PG8_BAR; PG8_MMA(1, 0, At, B0); PG8_MMA(1, 1, At, B1); PG8_BAR; PG8_SCHED;
            } else {
            PG8_LDB(B0, 0, 0); PG8_SCHED; PG8_LDA(At, 0, 0); PG8_STAGE(PG8_SA(1, 1), a1 + hstepA, voffA);
            PG8_WAIT_L(8); PG8_BAR; PG8_WAIT_L(0); PG8_MMA(0, 0, At, B0); PG8_BAR; PG8_SCHED;
            PG8_LDB(B1, 0, 1); PG8_STAGE(PG8_SB(0, 0), b2, voffB);
            PG8_BAR; PG8_WAIT_L(0); PG8_MMA(0, 1, At, B1); PG8_BAR;
            PG8_LDA(At, 0, 1); PG8_STAGE(PG8_SA(0, 0), a2, voffA);
            PG8_BAR; PG8_WAIT_L(0); PG8_MMA(1, 0, At, B0); PG8_BAR; PG8_SCHED;
            PG8_STAGE(PG8_SB(0, 1), b2 + hstepB, voffB);
            PG8_WAIT_V(6); PG8_BAR; PG8_MMA(1, 1, At, B1); PG8_BAR;
            PG8_LDB(B0, 1, 0); PG8_SCHED; PG8_LDA(At, 1, 0); PG8_STAGE(PG8_SA(0, 1), a2 + hstepA, voffA);
            PG8_WAIT_L(8); PG8_BAR; PG8_WAIT_L(0); PG8_MMA(0, 0, At, B0); PG8_BAR; PG8_SCHED;
            PG8_LDB(B1, 1, 1); PG8_STAGE(PG8_SB(1, 0), b3, voffB);
            PG8_BAR; PG8_WAIT_L(0); PG8_MMA(0, 1, At, B1); PG8_BAR;
            PG8_LDA(At, 1, 1); PG8_STAGE(PG8_SA(1, 0), a3, voffA);
            PG8_BAR; PG8_WAIT_L(0); PG8_MMA(1, 0, At, B0); PG8_BAR; PG8_SCHED;
            PG8_STAGE(PG8_SB(1, 1), b3 + hstepB, voffB);
            PG8_WAIT_V(6); PG8_BAR; PG8_MMA(1, 1, At, B1); PG8_BAR;
            }
        }
        if constexpr (ALIGN_EPI) { if (wr == 0) PG8_BAR; }
        if constexpr (!Epi::AFTER_DRAIN) { E(acc, cur, wr, wc, fr, fq); S.done(cur); }
        if (!has_next) break;
#pragma unroll
        for (int a = 0; a < 2; ++a)
#pragma unroll
            for (int b = 0; b < 2; ++b)
#pragma unroll
                for (int m = 0; m < 4; ++m)
#pragma unroll
                    for (int n = 0; n < 2; ++n) acc[a][b][m][n] = (f32x4){0.f, 0.f, 0.f, 0.f};
        cur = nxt; cA = nA; cB = nB; ++ui;
        if constexpr (ALIGN_EPI) { if (wr == 1) PG8_BAR; }
    }
    PG8_WAIT_V(0);
    if constexpr (!ALIGN_EPI) { if (wr == 0) PG8_BAR; }
    PG8_BAR;
    if constexpr (Epi::AFTER_DRAIN) { E.fused(acc, cur, wr, wc, fr, fq, lds, wid, lane); S.done(cur); }
#undef PG8_SA
#undef PG8_SB
#undef PG8_STAGE
#undef PG8_LDA
#undef PG8_LDB
#undef PG8_MMA
#undef PG8_WAIT_V
#undef PG8_WAIT_L
#undef PG8_BAR
#undef PG8_SCHED
}
template <class Epi, class Sched>
__device__ __forceinline__ void gemm_phase_g(PG8_LAS unsigned char* lds, const Gemm g, const Sched& S, const Epi& E, const int* inv) {
    constexpr bool ALIGN_EPI = true;
    const int tid = threadIdx.x, wid = __builtin_amdgcn_readfirstlane(tid >> 6), lane = tid & 63, wr = wid >> 2, wc = wid & 3, fr = lane & 15, fq = lane >> 4;
    const int K = g.K, nt = K / BK;
    unsigned voffA[2], voffB[2];
#pragma unroll
    for (int i = 0; i < 2; ++i) { int R, C; stage_rc(tid * 16 + i * 8192, R, C); const int Rb = Epi::PERM ? ((R & ~31) + perm32(R & 31)) : R;
        voffA[i] = (unsigned)(R * g.lda + C) * 2u; voffB[i] = (unsigned)(Rb * g.ldb + C) * 2u; }
    const size_t kstep = (size_t)(BK * 2);
    const size_t hstepA = (size_t)HALF * g.lda * 2, hstepB = (size_t)HALF * g.ldb * 2;
    const size_t tstepA = 2 * hstepA, tstepB = 2 * hstepB;
    const unsigned ldsw = (unsigned)wid * 1024u;
    const int aoff = lds_byte(wr * 64 + fr, fq * 8), boff = lds_byte(wc * 32 + fr, fq * 8);
#define PG8_SA(b, h) (((b) * 2 + (h)) * HTB)
#define PG8_SB(b, h) ((4 + (b) * 2 + (h)) * HTB)
#define PG8_STAGE(bufoff, gbase, voff) do { _Pragma("unroll") for (int _i = 0; _i < 2; ++_i) \
        __builtin_amdgcn_global_load_lds((const unsigned*)((const char*)(gbase) + (voff)[_i]), (PG8_LAS unsigned*)(lds + (bufoff) + ldsw + _i * 8192), 16, 0, 0); } while (0)
#define PG8_LDA(dst, b, h) do { _Pragma("unroll") for (int m = 0; m < 4; ++m) _Pragma("unroll") for (int k = 0; k < 2; ++k) dst[m][k] = *(const PG8_LAS bf16x8*)(lds + PG8_SA(b, h) + aoff + m * 2048 + k * 1024); } while (0)
#define PG8_LDB(dst, b, h) do { _Pragma("unroll") for (int n = 0; n < 2; ++n) _Pragma("unroll") for (int k = 0; k < 2; ++k) dst[n][k] = *(const PG8_LAS bf16x8*)(lds + PG8_SB(b, h) + boff + n * 2048 + k * 1024); } while (0)
#define PG8_MMA(ai, bj, At, Bt) do { __builtin_amdgcn_s_setprio(1); _Pragma("unroll") for (int m = 0; m < 4; ++m) _Pragma("unroll") for (int n = 0; n < 2; ++n) _Pragma("unroll") for (int k = 0; k < 2; ++k) \
        acc[ai][bj][m][n] = __builtin_amdgcn_mfma_f32_16x16x32_bf16(Bt[n][k], At[m][k], acc[ai][bj][m][n], 0, 0, 0); __builtin_amdgcn_s_setprio(0); } while (0)
#define PG8_WAIT_V(n) asm volatile("s_waitcnt vmcnt(" #n ")" ::: "memory")
#define PG8_WAIT_L(n) asm volatile("s_waitcnt lgkmcnt(" #n ")" ::: "memory")
#define PG8_BAR __builtin_amdgcn_s_barrier()
#define PG8_SCHED __builtin_amdgcn_sched_barrier(0)
    Unit cur, nxt; int ui = 0;
    if (!S.next(0, cur)) return;
    f32x4 acc[2][2][4][2];
#pragma unroll
    for (int a = 0; a < 2; ++a)
#pragma unroll
        for (int b = 0; b < 2; ++b)
#pragma unroll
            for (int m = 0; m < 4; ++m)
#pragma unroll
                for (int n = 0; n < 2; ++n) acc[a][b][m][n] = (f32x4){0.f, 0.f, 0.f, 0.f};
    bf16x8 At[4][2], B0[2][2], B1[2][2];
    const char* cA = (const char*)g.A; const char* cB = (const char*)g.Bt + (size_t)cur.pn * tstepB;
    S.a_ready(cur);
    unsigned vc[2][2], vn[2][2];
#define PG8_ROWS(u_, vo_) do { _Pragma("unroll") for (int h_ = 0; h_ < 2; ++h_) _Pragma("unroll") for (int i_ = 0; i_ < 2; ++i_) { int R_, C_; stage_rc(tid * 16 + i_ * 8192, R_, C_); const int r_ = h_ * HALF + R_; \
        const int tok_ = r_ < (u_).nvalid ? inv[(u_).inv0 + r_] : 0; vo_[h_][i_] = (unsigned)(tok_ * g.lda + C_) * 2u; } } while (0)
    PG8_ROWS(cur, vc);
    {
        PG8_STAGE(PG8_SB(0, 0), cB, voffB); PG8_STAGE(PG8_SB(0, 1), cB + hstepB, voffB); PG8_STAGE(PG8_SA(0, 0), cA, vc[0]); PG8_STAGE(PG8_SA(0, 1), cA, vc[1]);
        if (wr == 1) PG8_BAR;
        PG8_WAIT_V(2); PG8_BAR;
        PG8_STAGE(PG8_SB(1, 0), cB + kstep, voffB); PG8_STAGE(PG8_SA(1, 0), cA + kstep, vc[0]); PG8_STAGE(PG8_SB(1, 1), cB + hstepB + kstep, voffB);
        PG8_WAIT_V(6); PG8_BAR;
    }
    for (;;) {
        const bool has_next = S.next(ui + 1, nxt);
        if (has_next) { PG8_ROWS(nxt, vn); } else {
#pragma unroll
            for (int h_ = 0; h_ < 2; ++h_) { vn[h_][0] = vc[h_][0]; vn[h_][1] = vc[h_][1]; } }
        const char* nA = cA; const char* nB = has_next ? (const char*)g.Bt + (size_t)nxt.pn * tstepB : cB;
        for (int t = 0; t < nt; t += 2) {
            const bool last = (t == nt - 2);
            unsigned v2[2][2];
#pragma unroll
            for (int h_ = 0; h_ < 2; ++h_) { v2[h_][0] = last ? vn[h_][0] : vc[h_][0]; v2[h_][1] = last ? vn[h_][1] : vc[h_][1]; }
            const char* a1 = cA + (size_t)(t + 1) * kstep;
            const char* a2 = last ? nA : cA + (size_t)(t + 2) * kstep; const char* b2 = last ? nB : cB + (size_t)(t + 2) * kstep;
            const char* a3 = a2 + kstep; const char* b3 = b2 + kstep;
            if (last && has_next) S.a_ready(nxt);
            {
            PG8_LDB(B0, 0, 0); PG8_LDB(B1, 0, 1); PG8_SCHED; PG8_LDA(At, 0, 0); PG8_STAGE(PG8_SA(1, 1), a1, vc[1]);
            PG8_WAIT_V(8); PG8_WAIT_L(0); PG8_BAR; PG8_MMA(0, 0, At, B0); PG8_MMA(0, 1, At, B1); PG8_BAR; PG8_SCHED;
            PG8_LDA(At, 0, 1); PG8_STAGE(PG8_SB(0, 0), b2, voffB); PG8_STAGE(PG8_SB(0, 1), b2 + hstepB, voffB); PG8_STAGE(PG8_SA(0, 0), a2, v2[0]);
            PG8_WAIT_V(8); PG8_WAIT_L(0); PG8_BAR; PG8_MMA(1, 0, At, B0); PG8_MMA(1, 1, At, B1); PG8_BAR; PG8_SCHED;
            PG8_LDB(B0, 1, 0); PG8_LDB(B1, 1, 1); PG8_SCHED; PG8_LDA(At, 1, 0); PG8_STAGE(PG8_SA(0, 1), a2, v2[1]);
            PG8_WAIT_V(8); PG8_WAIT_L(0); PG8_BAR; PG8_MMA(0, 0, At, B0); PG8_MMA(0, 1, At, B1); PG8_BAR; PG8_SCHED;
            PG8_LDA(At, 1, 1); PG8_STAGE(PG8_SB(1, 0), b3, voffB); PG8_STAGE(PG8_SB(1, 1), b3 + hstepB, voffB); PG8_STAGE(PG8_SA(1, 0), a3, v2[0]);
            PG8_WAIT_V(8); PG8_WAIT_L(0); PG8_BAR; PG8_MMA(1, 0, At, B0); PG8_MMA(1, 1, At, B1); PG8_BAR; PG8_SCHED;
            }
        }
        if constexpr (ALIGN_EPI) { if (wr == 0) PG8_BAR; }
        if constexpr (!Epi::AFTER_DRAIN) { E(acc, cur, wr, wc, fr, fq); S.done(cur); }
        if (!has_next) break;
#pragma unroll
        for (int a = 0; a < 2; ++a)
#pragma unroll
            for (int b = 0; b < 2; ++b)
#pragma unroll
                for (int m = 0; m < 4; ++m)
#pragma unroll
                    for (int n = 0; n < 2; ++n) acc[a][b][m][n] = (f32x4){0.f, 0.f, 0.f, 0.f};
        cur = nxt; cA = nA; cB = nB; ++ui;
#pragma unroll
        for (int h_ = 0; h_ < 2; ++h_) { vc[h_][0] = vn[h_][0]; vc[h_][1] = vn[h_][1]; }
        if constexpr (ALIGN_EPI) { if (wr == 1) PG8_BAR; }
    }
    PG8_WAIT_V(0);
    if constexpr (!ALIGN_EPI) { if (wr == 0) PG8_BAR; }
    PG8_BAR;
    if constexpr (Epi::AFTER_DRAIN) { E.fused(acc, cur, wr, wc, fr, fq, lds, wid, lane); S.done(cur); }
#undef PG8_ROWS
#undef PG8_SA
#undef PG8_SB
#undef PG8_STAGE
#undef PG8_LDA
#undef PG8_LDB
#undef PG8_MMA
#undef PG8_WAIT_V
#undef PG8_WAIT_L
#undef PG8_BAR
#undef PG8_SCHED
}
}
constexpr int BATCH = 2, SEQ = 4096, DM = 2048, MTOK = BATCH * SEQ;
constexpr int NE0 = 6168, NE1 = 4176;
constexpr int NP0 = 6144, NP1 = 4096;
constexpr float LN_EPS = 1e-5f;
constexpr float DN_ALPHA = 1.41421356237309515f;
constexpr float ATT_SCALE = 0.08838834764831845f;
constexpr int RPAD = 24576;
constexpr size_t MiB = 1u << 20;
constexpr size_t WS_CTL = 0, CTL_ZERO_BYTES = 1 * MiB;
constexpr size_t WS_ROPE = 1 * MiB;
constexpr size_t WS_WSM = 4 * MiB;
constexpr size_t WS_SK0 = 6 * MiB;
constexpr size_t WS_IK = 7 * MiB;
constexpr size_t WS_IW = 8 * MiB + 512 * 1024;
constexpr size_t WS_FBIAS = 10 * MiB;
constexpr size_t WS_ROUTE = 11 * MiB;
constexpr size_t WS_MASK = 12 * MiB;
constexpr size_t WS_WINA = 16 * MiB, WS_WOA = 40 * MiB, WS_WINC = 48 * MiB, WS_WOC = 64 * MiB;
constexpr size_t WS_WGU = 72 * MiB;
constexpr size_t WS_WD = 328 * MiB;
constexpr size_t WS_XB = 456 * MiB;
constexpr size_t WS_XR = 488 * MiB;
constexpr size_t WS_PROJ = 552 * MiB;
constexpr size_t WS_CST = 648 * MiB;
constexpr size_t WS_PREVT = 712 * MiB;
constexpr size_t WS_OMIX = 744 * MiB;
constexpr size_t WS_GB = 776 * MiB;
constexpr size_t WS_DEC = 792 * MiB;
constexpr size_t WS_ROWW = 793 * MiB;
constexpr size_t WS_SC = 800 * MiB;
constexpr size_t WS_INV = 800 * MiB;
constexpr size_t WS_WINV = 801 * MiB;
constexpr size_t WS_END = 928 * MiB;
constexpr int CW_CNT = 1024;
constexpr int CW_FILL = 2048;
constexpr int CW_BAR = 4096;

#define GAS __attribute__((address_space(1)))
#define LAS __attribute__((address_space(3)))
typedef unsigned short bf16;
typedef unsigned v4u __attribute__((ext_vector_type(4)));
typedef unsigned v2u __attribute__((ext_vector_type(2)));
typedef float f32x4 __attribute__((ext_vector_type(4)));
typedef short bf16x8 __attribute__((ext_vector_type(8)));
#define LDS_WAIT() asm volatile("s_waitcnt lgkmcnt(0)" ::: "memory")
#define VM_WAIT() asm volatile("s_waitcnt vmcnt(0)" ::: "memory")
__device__ __forceinline__ unsigned f2bf(float f) { unsigned u = __builtin_bit_cast(unsigned, f); return (u + 0x7fffu + ((u >> 16) & 1u)) >> 16; }
__device__ __forceinline__ unsigned pk2(float lo, float hi) { return f2bf(lo) | (f2bf(hi) << 16); }
__device__ __forceinline__ float bf2f(unsigned short b) { return __builtin_bit_cast(float, ((unsigned)b) << 16); }
__device__ __forceinline__ float wave_sum(float v) {
#pragma unroll
    for (int o = 1; o < 64; o <<= 1) v += __shfl_xor(v, o);
    return v;
}
__device__ __forceinline__ float logsigmoidf(float z) { return fminf(z, 0.f) - log1pf(__expf(-fabsf(z))); }
#define XB_TMO      128
#define XB_XCNT(j)  (256  + 64 * (j))
#define XB_XSUB(j)  (1280 + 64 * (j))
#define XB_XGEN(j)  (2304 + 64 * (j))
#define XB_TOP      3328
#define XB_TOPGEN   3392
#define XCD_BAR_WORDS 3456
#define XB_SPIN_CAP (1u << 21)

__device__ __forceinline__ unsigned xb_ld(unsigned* p)              { return __hip_atomic_load(p, __ATOMIC_RELAXED, __HIP_MEMORY_SCOPE_AGENT); }
__device__ __forceinline__ unsigned xb_add(unsigned* p, unsigned v) { return __hip_atomic_fetch_add(p, v, __ATOMIC_RELAXED, __HIP_MEMORY_SCOPE_AGENT); }
__device__ __forceinline__ unsigned xb_xcc_id() { return (unsigned)__builtin_amdgcn_s_getreg((3 << 11) | 20) & 0xFu; }
#define XB_SPIN(cond, bar) do { unsigned _sp = 0; while (cond) { __builtin_amdgcn_s_sleep(1); \
    if ((++_sp & 255u) == 0u) { if (xb_ld(&(bar)[XB_TMO])) break; if (_sp > XB_SPIN_CAP) { atomicAdd(&(bar)[XB_TMO], 1u); break; } } } } while (0)

struct XcdBarrier {
    unsigned* bar; unsigned x;
    volatile LAS unsigned* st;
};

__device__ __forceinline__ XcdBarrier xcd_barrier_post(unsigned* bar, volatile LAS unsigned* st) {
    XcdBarrier b; b.bar = bar; b.x = xb_xcc_id(); b.st = st;
    if (threadIdx.x == 0) (void)xb_add(&bar[XB_XCNT(b.x)], 1u);
    return b;
}
__device__ __forceinline__ void xcd_barrier_complete(unsigned* bar, unsigned x, unsigned& nloc, unsigned& nx) {
    const unsigned G = gridDim.x * gridDim.y * gridDim.z;
    unsigned sum, cnt, mine, sp = 0u;
    for (;;) {
        sum = 0u; cnt = 0u; mine = 0u;
#pragma unroll
        for (unsigned j = 0; j < 16; ++j) { const unsigned c = xb_ld(&bar[XB_XCNT(j)]); sum += c; cnt += (c > 0u) ? 1u : 0u; mine = (j == x) ? c : mine; }
        if (sum == G) break;
        __builtin_amdgcn_s_sleep(1);
        if ((++sp & 255u) == 0u) { if (xb_ld(&bar[XB_TMO])) break; if (sp > XB_SPIN_CAP) { atomicAdd(&bar[XB_TMO], 1u); break; } }
    }
    nloc = mine > 0u ? mine : 1u; nx = cnt > 0u ? cnt : 1u;
}

__device__ __forceinline__ void xcd_barrier(const XcdBarrier& b) {
    asm volatile("s_waitcnt vmcnt(0)" ::: "memory");
    __syncthreads();
    if (threadIdx.x == 0) {
        unsigned* bar = b.bar;
        __builtin_amdgcn_s_waitcnt(0);
        unsigned nloc = b.st[0], nx = b.st[1];
        if (nloc == 0u) { xcd_barrier_complete(bar, b.x, nloc, nx); b.st[0] = nloc; b.st[1] = nx; }
        const unsigned old = xb_add(&bar[XB_XSUB(b.x)], 1u);
        const unsigned gen = old / nloc;
        if (old + 1u == (gen + 1u) * nloc) {
            __builtin_amdgcn_fence(__ATOMIC_RELEASE, "agent");
            asm volatile("s_waitcnt vmcnt(0)" ::: "memory");
            const unsigned og = xb_add(&bar[XB_TOP], 1u);
            const unsigned tg = og / nx;
            if (og + 1u == (tg + 1u) * nx) xb_add(&bar[XB_TOPGEN], 1u);
            else XB_SPIN(xb_ld(&bar[XB_TOPGEN]) == tg, bar);
            __builtin_amdgcn_fence(__ATOMIC_ACQUIRE, "agent");
            xb_add(&bar[XB_XGEN(b.x)], 1u);
            asm volatile("s_waitcnt vmcnt(0)" ::: "memory");
        } else {
            XB_SPIN(xb_ld(&bar[XB_XGEN(b.x)]) == gen, bar);
            __builtin_amdgcn_fence(__ATOMIC_ACQUIRE, "agent");
            asm volatile("s_waitcnt vmcnt(0)" ::: "memory");
        }
    }
    __syncthreads();
}

constexpr int NWAVES = 8;
constexpr int RING_BYTES = 131072;
constexpr int LDSCTL_OFF = RING_BYTES;
constexpr int LDS_BYTES = 147456;
struct Frame {
    LAS unsigned char* lds; volatile LAS unsigned* MISC; unsigned* ctl;
    int tid, lane, wave, G, gw, NGW;
    unsigned char* ws;
};
struct Args { const float* in[20]; float* out; unsigned char* ws; int ph_lo, ph_hi, bar_region, pad; };

struct TrItem { const float* W; bf16* WT; int ldw, c0, c1, K, n0, k0; };
__device__ __forceinline__ void tr64_load(const TrItem& t, f32x4 (&r)[16], int lane) {
    const int nq = lane & 15, kr = lane >> 4;
    const float* src = t.W + (size_t)(t.k0 + 2 * kr) * t.ldw + (nq < 8 ? t.c0 : t.c1 - 32) + 4 * nq;
#pragma unroll
    for (int i = 0; i < 8; ++i) { r[2 * i] = __builtin_nontemporal_load((const f32x4*)(src + (size_t)(8 * i) * t.ldw)); r[2 * i + 1] = __builtin_nontemporal_load((const f32x4*)(src + (size_t)(8 * i + 1) * t.ldw)); }
}
__device__ __forceinline__ void tr64_store(const TrItem& t, const f32x4 (&r)[16], LAS bf16* T, int lane) {
    const int nq = lane & 15, kr = lane >> 4;
#pragma unroll
    for (int i = 0; i < 8; ++i) { const int kk = 8 * i + 2 * kr;
#pragma unroll
        for (int e = 0; e < 4; ++e) *(LAS unsigned*)(T + (4 * nq + e) * 68 + kk) = pg8::cvt_pk_bf16(r[2 * i][e], r[2 * i + 1][e]); }
    LDS_WAIT(); asm volatile("" ::: "memory");
    const int c = lane & 7;
#pragma unroll
    for (int j = 0; j < 8; ++j) { const int n = (lane >> 3) + 8 * j; const v2u lo = *(const LAS v2u*)(T + n * 68 + 8 * c), hi = *(const LAS v2u*)(T + n * 68 + 8 * c + 4);
        v4u o; o.x = lo.x; o.y = lo.y; o.z = hi.x; o.w = hi.y;
        *(v4u*)(t.WT + (size_t)(t.n0 + n) * t.K + t.k0 + 8 * c) = o; }
    LDS_WAIT(); asm volatile("" ::: "memory");
}
__device__ __forceinline__ void transpose_item64(const float* W, int ldw, int c0, int c1, int K, bf16* WT, int n0, int k0, LAS bf16* T, int lane) {
    const TrItem t{W, WT, ldw, c0, c1, K, n0, k0}; f32x4 r[16]; tr64_load(t, r, lane); tr64_store(t, r, T, lane);
}
__device__ __forceinline__ int l1_src_col(int n) {
    const int pn = n >> 8, j = n & 255, jh = j & 127, second = j >> 7;
    if (pn == 10 || pn == 11) return n;
    if (pn < 10) return pn * 256 + (jh >> 6) * 128 + second * 64 + (jh & 63);
    return 3072 + ((pn - 12) * 4 + (jh >> 5)) * 64 + second * 32 + (jh & 31);
}
constexpr int SK_ROUTE0 = 0, SK_ROUTE1 = 48, SK_SK0 = 96, SK_SK1 = 128, SK_NCOL = 208;
constexpr int SK_PART_OFF = 0, SK_LG_OFF = 65536;
template <int NT> __device__ __forceinline__ void skinny_partials(LAS unsigned char* ldsb, const float* X, const bf16* WH, const bf16* WL, int w, int lane) {
    const int tile = w >> 2, kq = w & 3, l15 = lane & 15, quad = lane >> 4;
    const float* xp = X + (size_t)(16 * tile + l15) * DM + kq * 512 + quad * 8;
    const bf16* hp = WH + (size_t)l15 * 2048 + kq * 512 + quad * 8; const bf16* lp = WL + (size_t)l15 * 2048 + kq * 512 + quad * 8;
    pg8::f32x4 acc[NT];
#pragma unroll
    for (int n = 0; n < NT; ++n) acc[n] = (pg8::f32x4){0.f, 0.f, 0.f, 0.f};
#pragma unroll 2
    for (int ks = 0; ks < 16; ++ks) {
        const f32x4 x0 = *(const f32x4*)(xp + 32 * ks), x1 = *(const f32x4*)(xp + 32 * ks + 4);
        v4u hw, lw;
        hw.x = pg8::cvt_pk_bf16(x0[0], x0[1]); hw.y = pg8::cvt_pk_bf16(x0[2], x0[3]); hw.z = pg8::cvt_pk_bf16(x1[0], x1[1]); hw.w = pg8::cvt_pk_bf16(x1[2], x1[3]);
        lw.x = pg8::cvt_pk_bf16(x0[0] - bf2f(hw.x & 0xffff), x0[1] - bf2f(hw.x >> 16)); lw.y = pg8::cvt_pk_bf16(x0[2] - bf2f(hw.y & 0xffff), x0[3] - bf2f(hw.y >> 16));
        lw.z = pg8::cvt_pk_bf16(x1[0] - bf2f(hw.z & 0xffff), x1[1] - bf2f(hw.z >> 16)); lw.w = pg8::cvt_pk_bf16(x1[2] - bf2f(hw.w & 0xffff), x1[3] - bf2f(hw.w >> 16));
        const bf16x8 ah = __builtin_bit_cast(bf16x8, hw), al = __builtin_bit_cast(bf16x8, lw);
#pragma unroll
        for (int n = 0; n < NT; ++n) { const bf16x8 bh = *(const bf16x8*)(hp + (size_t)n * 16 * 2048 + 32 * ks), bl = *(const bf16x8*)(lp + (size_t)n * 16 * 2048 + 32 * ks);
            acc[n] = __builtin_amdgcn_mfma_f32_16x16x32_bf16(ah, bh, acc[n], 0, 0, 0); acc[n] = __builtin_amdgcn_mfma_f32_16x16x32_bf16(ah, bl, acc[n], 0, 0, 0);
            acc[n] = __builtin_amdgcn_mfma_f32_16x16x32_bf16(al, bh, acc[n], 0, 0, 0); }
    }
    LAS float* PART = (LAS float*)(ldsb + SK_PART_OFF);
#pragma unroll
    for (int n = 0; n < NT; ++n) *(LAS pg8::f32x4*)(PART + ((((tile * 4 + kq) * NT + n) * 64 + lane) * 4)) = acc[n];
}
template <int NT> __device__ __forceinline__ void skinny_reduce(LAS unsigned char* ldsb, int tid) {
    const LAS float* PART = (const LAS float*)(ldsb + SK_PART_OFF); LAS float* LG = (LAS float*)(ldsb + SK_LG_OFF);
    for (int idx = tid; idx < 32 * 16 * NT; idx += NWAVES * 64) { const int row = idx / (16 * NT), col = idx % (16 * NT), tile = row >> 4, rr = row & 15, ln = (rr >> 2) * 16 + (col & 15), n = col >> 4, j = rr & 3;
        float s = 0.f;
#pragma unroll
        for (int kq = 0; kq < 4; ++kq) s += PART[(((tile * 4 + kq) * NT + n) * 64 + ln) * 4 + j];
        LG[row * (16 * NT) + col] = s; }
}
__device__ __forceinline__ void ln_row(f32x4 (&v)[8], const float* g, const float* b, int lane) {
    float s = 0.f;
#pragma unroll
    for (int j = 0; j < 8; ++j) s += (v[j][0] + v[j][1]) + (v[j][2] + v[j][3]);
    const float mean = wave_sum(s) * (1.f / DM); float s2 = 0.f;
#pragma unroll
    for (int j = 0; j < 8; ++j) { v[j] = v[j] - mean; s2 += (v[j][0] * v[j][0] + v[j][1] * v[j][1]) + (v[j][2] * v[j][2] + v[j][3] * v[j][3]); }
    const float rstd = 1.f / sqrtf(wave_sum(s2) * (1.f / DM) + LN_EPS);
#pragma unroll
    for (int j = 0; j < 8; ++j) { const f32x4 gg = *(const f32x4*)(g + 256 * j + 4 * lane), bb = *(const f32x4*)(b + 256 * j + 4 * lane); v[j] = v[j] * rstd * gg + bb; }
}
__device__ __forceinline__ void store_row_bf16(bf16* dst, const f32x4 (&v)[8], int lane) {
#pragma unroll
    for (int j = 0; j < 8; ++j) { uint2 o; o.x = pg8::cvt_pk_bf16(v[j][0], v[j][1]); o.y = pg8::cvt_pk_bf16(v[j][2], v[j][3]); *(uint2*)(dst + 256 * j + 4 * lane) = o; }
}
#define TK_FOR_VALID(...) _Pragma("unroll") for (int g_ = 0; g_ < 8; ++g_) { if (512 * g_ <= qpos) { _Pragma("unroll") for (int i = 8 * g_; i < 8 * g_ + 8; ++i) { __VA_ARGS__ } } }
__device__ __forceinline__ void topk_mask_row(const LAS float* sc, int qpos, unsigned long long* mrow, int lane, LAS unsigned* cbuf) {
    unsigned u[64];
#pragma unroll
    for (int i = 0; i < 64; ++i) { const int s = 64 * i + lane; const bool ok = s <= qpos; const float f = ok ? sc[s] : 0.f; const unsigned b = __builtin_bit_cast(unsigned, f);
        const unsigned key = b ^ ((b >> 31) ? 0xFFFFFFFFu : 0x80000000u); u[i] = ok ? key : 0u; }
    unsigned long long mword = 0ull;
    if (qpos + 1 <= 256) {
#pragma unroll
        for (int i = 0; i < 4; ++i) { const unsigned long long w = __ballot(64 * i + lane <= qpos); mword = (lane == i) ? w : mword; }
        mrow[lane] = mword; return;
    }
    const unsigned long long below = (1ull << lane) - 1ull;
    unsigned T = 0u;
#pragma unroll 1
    for (int bit = 31; bit >= 20; --bit) { const unsigned cand = T | (1u << bit); int cnt = 0;
        TK_FOR_VALID( cnt += __builtin_popcountll(__ballot(u[i] >= cand)); )
        if (cnt >= 256) T = cand; }
    const unsigned pre = T >> 20; int cgt = 0, nc = 0;
    TK_FOR_VALID( { const unsigned p_ = u[i] >> 20; const unsigned long long gm = __ballot(p_ > pre), em = __ballot(p_ == pre); cgt += __builtin_popcountll(gm);
        const int pos_ = nc + __builtin_popcountll(em & below); if (p_ == pre && pos_ < 256) cbuf[pos_] = u[i]; nc += __builtin_popcountll(em); } )
    int kneed = 256 - cgt;
    if (nc <= 256) {
        asm volatile("s_waitcnt lgkmcnt(0)" ::: "memory");
        unsigned c0 = lane < nc ? cbuf[lane] : 0u, c1 = 64 + lane < nc ? cbuf[64 + lane] : 0u, c2 = 128 + lane < nc ? cbuf[128 + lane] : 0u, c3 = 192 + lane < nc ? cbuf[192 + lane] : 0u;
#pragma unroll 1
        for (int bit = 19; bit >= 0; --bit) { const unsigned cand = T | (1u << bit);
            int cnt = __builtin_popcountll(__ballot(c0 >= cand));
            if (nc > 64) cnt += __builtin_popcountll(__ballot(c1 >= cand));
            if (nc > 128) cnt += __builtin_popcountll(__ballot(c2 >= cand)) + __builtin_popcountll(__ballot(c3 >= cand));
            if (cnt >= kneed) T = cand; }
        const int cg2 = __builtin_popcountll(__ballot(c0 > T)) + __builtin_popcountll(__ballot(c1 > T)) + __builtin_popcountll(__ballot(c2 > T)) + __builtin_popcountll(__ballot(c3 > T));
        kneed -= cg2;
    } else {
#pragma unroll 1
        for (int bit = 19; bit >= 0; --bit) { const unsigned cand = T | (1u << bit); int cnt = 0;
            TK_FOR_VALID( cnt += __builtin_popcountll(__ballot(u[i] >= cand)); )
            if (cnt >= 256) T = cand; }
        int cg2 = 0;
        TK_FOR_VALID( cg2 += __builtin_popcountll(__ballot(u[i] > T)); )
        kneed = 256 - cg2;
    }
    int run = 0;
#pragma unroll
    for (int i = 0; i < 64; ++i) { const bool gt = u[i] > T, eq = u[i] == T; const unsigned long long eqm = __ballot(eq);
        const int rank = run + __builtin_popcountll(eqm & below); const bool sel = gt || (eq && rank < kneed); run += __builtin_popcountll(eqm);
        const unsigned long long w = __ballot(sel); mword = (lane == i) ? w : mword; }
    mrow[lane] = mword;
}
#undef TK_FOR_VALID
constexpr int CONV_MOE_ITEMS = 32 * (32 * 16) + 32 * (8 * 32);
constexpr int CONV_LATE_ITEMS = CONV_MOE_ITEMS + 32 * (NP1 / 64) + 32 * 32 + CONV_MOE_ITEMS;
__device__ __forceinline__ TrItem conv_moe_desc(const Args& a, unsigned char* ws, int layer, int it) {
    if (it < 32 * 512) {
        const int ex = layer * 32 + it / 512, r = it % 512, blk = r >> 5, jj = r & 31, kb = (blk >> 2) * 8 + (jj >> 2), nb = (blk & 3) * 4 + (jj & 3), n0 = nb * 64, tile = n0 >> 8, j = n0 & 255;
        const float* W = (j < 128 ? a.in[17] : a.in[18]) + (size_t)ex * 2048 * 512;
        return TrItem{W, (bf16*)(ws + WS_WGU) + (size_t)ex * 1024 * 2048, 512, 128 * tile + (j & 127), 128 * tile + (j & 127) + 32, 2048, n0, kb * 64};
    }
    const int i2 = it - 32 * 512, ex = layer * 32 + i2 / 256, r = i2 % 256, blk = r >> 5, jj = r & 31, kb = jj >> 2, nb = blk * 4 + (jj & 3);
    return TrItem{a.in[19] + (size_t)ex * 512 * 2048, (bf16*)(ws + WS_WD) + (size_t)ex * 2048 * 512, 2048, nb * 64, nb * 64 + 32, 512, nb * 64, kb * 64};
}
__device__ __forceinline__ TrItem conv_late_desc(const Args& a, unsigned char* ws, int it) {
    if (it < CONV_MOE_ITEMS) return conv_moe_desc(a, ws, 0, it);
    it -= CONV_MOE_ITEMS;
    if (it < 32 * (NP1 / 64)) { const int kb = it / (NP1 / 64), nb = it % (NP1 / 64), n0 = nb * 64;
        return TrItem{a.in[7], (bf16*)(ws + WS_WINC), NE1, l1_src_col(n0), l1_src_col(n0 + 32), 2048, n0, kb * 64}; }
    it -= 32 * (NP1 / 64);
    if (it < 32 * 32) { const int kb = it / 32, nb = it % 32; return TrItem{a.in[8], (bf16*)(ws + WS_WOC), 2048, nb * 64, nb * 64 + 32, 2048, nb * 64, kb * 64}; }
    return conv_moe_desc(a, ws, 1, it - 32 * 32);
}
__device__ __forceinline__ void late_conv_items(Frame& F, const Args& a) {
    constexpr int CHUNK = 32;
    LAS bf16* T = (LAS bf16*)(F.lds + F.wave * 16384); volatile LAS int* slot = (volatile LAS int*)(F.lds + 131072 + 512);
    for (;;) {
        __syncthreads();
        if (F.tid == 0) *slot = (int)atomicAdd(F.ctl + CW_FILL, (unsigned)CHUNK);
        __syncthreads();
        const int base = *slot;
        if (base >= CONV_LATE_ITEMS) break;
        f32x4 rA[16], rB[16];
        TrItem t0 = conv_late_desc(a, F.ws, base + F.wave); tr64_load(t0, rA, F.lane);
        TrItem t1 = conv_late_desc(a, F.ws, base + F.wave + 8); tr64_load(t1, rB, F.lane);
        tr64_store(t0, rA, T, F.lane);
        t0 = conv_late_desc(a, F.ws, base + F.wave + 16); tr64_load(t0, rA, F.lane);
        tr64_store(t1, rB, T, F.lane);
        t1 = conv_late_desc(a, F.ws, base + F.wave + 24); tr64_load(t1, rB, F.lane);
        tr64_store(t0, rA, T, F.lane);
        tr64_store(t1, rB, T, F.lane);
    }
    __syncthreads();
}
static_assert(CONV_LATE_ITEMS % 32 == 0, "filler chunks");
__device__ __forceinline__ void p0_prologue(Frame& F, const Args& a) {
    const int gw = F.gw, NGW = F.NGW, lane = F.lane;
    unsigned char* ws = F.ws;
    LAS bf16* T = (LAS bf16*)(F.lds + F.wave * 16384);
    {
        const float* W = a.in[1]; bf16* WT = (bf16*)(ws + WS_WINA);
        for (int it = gw; it < 32 * (NP0 / 64); it += NGW) { const int kb = it / (NP0 / 64), nb = it % (NP0 / 64), n0 = nb * 64; const int c0 = n0 < 3072 ? n0 : n0 + 16; transpose_item64(W, NE0, c0, c0 + 32, 2048, WT, n0, kb * 64, T, lane); }
    }
    {
        for (int it = gw; it < 32 * 32; it += NGW) { const int kb = it / 32, nb = it % 32; transpose_item64(a.in[6], 2048, nb * 64, nb * 64 + 32, 2048, (bf16*)(ws + WS_WOA), nb * 64, kb * 64, T, lane); }
    }
    const int gt = blockIdx.x * (NWAVES * 64) + F.tid, NGT = F.G * NWAVES * 64;
    {   float* c128 = (float*)(ws + WS_ROPE); float* s128 = c128 + 4096 * 64; float* c64 = s128 + 4096 * 64; float* s64 = c64 + 4096 * 32;
        for (int i = gt; i < 4096 * 96; i += NGT) { int pos, idx, half; float* cp; float* sp;
            if (i < 4096 * 64) { pos = i >> 6; idx = i & 63; half = 64; cp = c128 + i; sp = s128 + i; } else { const int r = i - 4096 * 64; pos = r >> 5; idx = r & 31; half = 32; cp = c64 + r; sp = s64 + r; }
            const float inv = exp2f(-(float)idx / (float)half * 13.287712379549449f);
            const float ang = (float)pos * inv;
            double rv = (double)ang * 0.15915494309189535; rv -= rint(rv);
            const float rf = (float)rv;
            *cp = __builtin_amdgcn_cosf(rf); *sp = __builtin_amdgcn_sinf(rf); }
    }
    {   bf16* SKH = (bf16*)(ws + WS_WSM); bf16* SKL = SKH + (size_t)SK_NCOL * 2048;
        for (int i = gt; i < 2048 * SK_NCOL; i += NGT) { const int k = i / SK_NCOL, c = i % SK_NCOL; float v = 0.f;
            if (c < 96) { const int l = c / 48, j = c % 48; if (j < 4) v = a.in[13][((size_t)l * 2048 + k) * 4 + j]; else if (j < 36) { const int g = (j - 4) >> 3, e = (j - 4) & 7; v = a.in[15][(((size_t)l * 4 + g) * 2048 + k) * 8 + e]; } }
            else if (c < 128) { const int j = c - 96; if (j < 16) v = a.in[1][(size_t)k * NE0 + 3072 + j]; else if (j < 24) v = a.in[1][(size_t)k * NE0 + 6160 + j - 16]; }
            else v = a.in[7][(size_t)k * NE1 + 4096 + c - 128];
            const unsigned h = f2bf(v); SKH[(size_t)c * 2048 + k] = (bf16)h; SKL[(size_t)c * 2048 + k] = (bf16)f2bf(v - bf2f((unsigned short)h)); }
    }
    {   const float* x = a.in[0]; bf16* XB = (bf16*)(ws + WS_XB);
        for (int m = gw; m < MTOK; m += NGW) { f32x4 v[8];
#pragma unroll
            for (int j = 0; j < 8; ++j) v[j] = *(const f32x4*)(x + (size_t)m * DM + 256 * j + 4 * lane);
            store_row_bf16(XB + (size_t)m * DM, v, lane); }
    }
}
__device__ __forceinline__ void p_skinny0(Frame& F, const Args& a) {
    const bf16* SKH = (const bf16*)(F.ws + WS_WSM) + (size_t)SK_SK0 * 2048; const bf16* SKL = SKH + (size_t)SK_NCOL * 2048; float* SK0 = (float*)(F.ws + WS_SK0);
    const LAS float* LG = (const LAS float*)(F.lds + SK_LG_OFF);
    for (int blk = blockIdx.x; blk < MTOK / 32; blk += F.G) { const int R0 = blk * 32;
        __syncthreads();
        skinny_partials<2>(F.lds, a.in[0] + (size_t)R0 * DM, SKH, SKL, F.wave, F.lane);
        __syncthreads();
        skinny_reduce<2>(F.lds, F.tid);
        __syncthreads();
        for (int idx = F.tid; idx < 32 * 24; idx += NWAVES * 64) { const int row = idx / 24, c = idx % 24; SK0[(size_t)(R0 + row) * 24 + c] = LG[row * 32 + c]; }
    }
    __syncthreads();
}
__device__ __forceinline__ void p_fox_bias(Frame& F, const Args& a) {
    if (blockIdx.x >= 16) return;
    const int bh = blockIdx.x, b = bh >> 3, h = bh & 7, lane = F.lane, tid = F.tid; const float gb = a.in[5][h];
    const float* SK0 = (const float*)(F.ws + WS_SK0); float* FB = (float*)(F.ws + WS_FBIAS) + (size_t)bh * SEQ; LAS float* wt = (LAS float*)(F.lds + 120000);
    float lf[8], tot = 0.f;
#pragma unroll
    for (int i = 0; i < 8; ++i) lf[i] = SK0[(size_t)(b * SEQ + tid * 8 + i) * 24 + 16 + h];
#pragma unroll
    for (int i = 0; i < 8; ++i) { tot += logsigmoidf(lf[i] + gb); lf[i] = tot; }
    float incl = tot;
#pragma unroll
    for (int o = 1; o < 64; o <<= 1) { const float t = __shfl_up(incl, o); if (lane >= o) incl += t; }
    if (lane == 63) wt[F.wave] = incl;
    __syncthreads();
    float pre = incl - tot;
    for (int w = 0; w < F.wave; ++w) pre += wt[w];
#pragma unroll
    for (int i = 0; i < 8; ++i) FB[tid * 8 + i] = -(pre + lf[i]) * (1.0f / ATT_SCALE);
    __syncthreads();
}
__device__ __forceinline__ void p_ln_route(Frame& F, const Args& a, int layer) {
    float* XR = (float*)(F.ws + WS_XR); bf16* XB = (bf16*)(F.ws + WS_XB); const int lane = F.lane;
    const float* g = a.in[9] + layer * DM; const float* bb = a.in[10] + layer * DM;
    const bf16* SKH = (const bf16*)(F.ws + WS_WSM) + (size_t)(layer ? SK_ROUTE1 : SK_ROUTE0) * 2048; const bf16* SKL = SKH + (size_t)SK_NCOL * 2048;
    const float* bg = a.in[14] + layer * 4; const float* be = a.in[16] + layer * 32;
    int4* ROUTE = (int4*)(F.ws + WS_ROUTE); unsigned* cnt = F.ctl + CW_CNT + layer * 64; int* INV = (int*)(F.ws + WS_INV); float* WINV = (float*)(F.ws + WS_WINV);
    const LAS float* LG = (const LAS float*)(F.lds + SK_LG_OFF);
    for (int blk = blockIdx.x; blk < MTOK / 32; blk += F.G) { const int R0 = blk * 32;
#pragma unroll 2
        for (int i = 0; i < 4; ++i) { const int m = R0 + 4 * F.wave + i; f32x4 v[8];
#pragma unroll
            for (int j = 0; j < 8; ++j) v[j] = *(const f32x4*)(XR + (size_t)m * DM + 256 * j + 4 * lane);
            ln_row(v, g, bb, lane);
#pragma unroll
            for (int j = 0; j < 8; ++j) *(f32x4*)(XR + (size_t)m * DM + 256 * j + 4 * lane) = v[j];
            store_row_bf16(XB + (size_t)m * DM, v, lane); }
        __syncthreads();
        skinny_partials<3>(F.lds, XR + (size_t)R0 * DM, SKH, SKL, F.wave, lane);
        __syncthreads();
        skinny_reduce<3>(F.lds, F.tid);
        __syncthreads();
        if (F.tid < 32) { const int m = R0 + F.tid; const LAS float* l = LG + F.tid * 48;
            float gl[4];
#pragma unroll
            for (int i = 0; i < 4; ++i) gl[i] = l[i] + bg[i];
            int gi = 0; float gm = gl[0];
#pragma unroll
            for (int i = 1; i < 4; ++i) if (gl[i] > gm) { gm = gl[i]; gi = i; }
            float gs = 0.f;
#pragma unroll
            for (int i = 0; i < 4; ++i) gs += __expf(gl[i] - gm);
            const float gp = 1.0f / gs;
            float el[8];
#pragma unroll
            for (int e = 0; e < 8; ++e) el[e] = l[4 + 8 * gi + e] + be[gi * 8 + e];
            int e1 = 0; float v1 = el[0];
#pragma unroll
            for (int e = 1; e < 8; ++e) if (el[e] > v1) { v1 = el[e]; e1 = e; }
            int e2 = -1; float v2 = -3.0e38f;
#pragma unroll
            for (int e = 0; e < 8; ++e) if (e != e1 && el[e] > v2) { v2 = el[e]; e2 = e; }
            const float w1 = gp / (1.0f + __expf(v2 - v1)), w2 = gp - w1;
            const int ge1 = gi * 8 + e1, ge2 = gi * 8 + e2;
            const int p1 = (int)atomicAdd(cnt + ge1, 1u), p2 = (int)atomicAdd(cnt + ge2, 1u);
            ROUTE[(size_t)m * 2 + 0] = make_int4(ge1, p1, 0, 0); ROUTE[(size_t)m * 2 + 1] = make_int4(ge2, p2, 0, 0);
            INV[ge1 * 8192 + p1] = m; INV[ge2 * 8192 + p2] = m; WINV[ge1 * 8192 + p1] = w1; WINV[ge2 * 8192 + p2] = w2; }
    }
    __syncthreads();
}
__device__ __forceinline__ int moe_offsets(const unsigned* cnt, int lane, int* tiles_incl) {
    const int c = lane < 32 ? (int)cnt[lane] : 0; const int t = (c + 255) >> 8; int incl = t;
#pragma unroll
    for (int o = 1; o < 32; o <<= 1) { const int x = __shfl_up(incl, o); if ((lane & 31) >= o) incl += x; }
    *tiles_incl = incl; return (incl - t) * 256;
}
__device__ __forceinline__ void p_ln_ffn(Frame& F, const Args& a, int layer) {
    float* XR = (float*)(F.ws + WS_XR); bf16* XB = (bf16*)(F.ws + WS_XB); const int lane = F.lane; const bf16* YG = (const bf16*)(F.ws + WS_CST);
    const float* g = a.in[11] + layer * DM; const float* bb = a.in[12] + layer * DM; const int4* ROUTE = (const int4*)(F.ws + WS_ROUTE);
    float* dst = layer == 1 ? a.out : XR;
    const bf16* SKH = (const bf16*)(F.ws + WS_WSM) + (size_t)SK_SK1 * 2048; const bf16* SKL = SKH + (size_t)SK_NCOL * 2048;
    const float* c64 = (const float*)(F.ws + WS_ROPE) + 2 * 4096 * 64; const float* s64 = c64 + 4096 * 32;
    bf16* IK = (bf16*)(F.ws + WS_IK); float* IW = (float*)(F.ws + WS_IW);
    const LAS float* LG = (const LAS float*)(F.lds + SK_LG_OFF);
    int ti_; const int eoff = moe_offsets(F.ctl + CW_CNT + layer * 64, lane, &ti_);
    for (int blk = blockIdx.x; blk < MTOK / 32; blk += F.G) { const int R0 = blk * 32;
#pragma unroll 2
        for (int i = 0; i < 4; ++i) { const int m = R0 + 4 * F.wave + i; f32x4 v[8];
            const int4 q0 = ROUTE[(size_t)m * 2], q1 = ROUTE[(size_t)m * 2 + 1]; const int r0 = __shfl(eoff, q0.x) + q0.y, r1 = __shfl(eoff, q1.x) + q1.y;
#pragma unroll
            for (int j = 0; j < 8; ++j) { v[j] = *(const f32x4*)(XR + (size_t)m * DM + 256 * j + 4 * lane) * DN_ALPHA;
                const uint2 y0 = *(const uint2*)(YG + (size_t)r0 * DM + 256 * j + 4 * lane), y1 = *(const uint2*)(YG + (size_t)r1 * DM + 256 * j + 4 * lane);
                v[j][0] += bf2f(y0.x & 0xffff) + bf2f(y1.x & 0xffff); v[j][1] += bf2f(y0.x >> 16) + bf2f(y1.x >> 16);
                v[j][2] += bf2f(y0.y & 0xffff) + bf2f(y1.y & 0xffff); v[j][3] += bf2f(y0.y >> 16) + bf2f(y1.y >> 16); }
            ln_row(v, g, bb, lane);
#pragma unroll
            for (int j = 0; j < 8; ++j) *(f32x4*)(dst + (size_t)m * DM + 256 * j + 4 * lane) = v[j];
            if (layer == 0) store_row_bf16(XB + (size_t)m * DM, v, lane); }
        if (layer == 0) {
            __syncthreads();
            skinny_partials<5>(F.lds, XR + (size_t)R0 * DM, SKH, SKL, F.wave, lane);
            __syncthreads();
            skinny_reduce<5>(F.lds, F.tid);
            __syncthreads();
            for (int idx = F.tid; idx < 32 * 80; idx += NWAVES * 64) { const int row = idx / 80, c = idx % 80, m = R0 + row; const float v = LG[row * 80 + c];
                if (c < 64) { const float part = LG[row * 80 + (c ^ 32)]; const int pos = m & 4095, i = c & 31; const float cs = c64[pos * 32 + i], sn = s64[pos * 32 + i];
                    const int bq = m >> 12, sq = m & 4095; IK[((((size_t)bq * 128 + (sq >> 5)) * 4 + (c >> 4)) * 64 + ((c >> 3) & 1) * 32 + (sq & 31)) * 8 + (c & 7)] = (bf16)f2bf(c < 32 ? (v * cs - part * sn) : (v * cs + part * sn)); }
                else IW[(size_t)m * 16 + c - 64] = v * 0.25f * 0.125f; }
        }
    }
    __syncthreads();
}
__device__ __forceinline__ void ph_gla_b(Frame& F, const Args& a) {
    const float* SK0 = (const float*)(F.ws + WS_SK0); const float* w2 = a.in[2]; const float* gbias = a.in[3]; float* GB = (float*)(F.ws + WS_GB); float* DEC = (float*)(F.ws + WS_DEC);
    for (int u4 = blockIdx.x; u4 < 128; u4 += F.G) {
        const int unit = u4 * 4 + (F.tid >> 7), n = unit & 63, bh = unit >> 6, b = bh >> 2, h = bh & 3, d = F.tid & 127, t0 = b * SEQ + n * 64;
        float w[16];
#pragma unroll
        for (int r = 0; r < 16; ++r) w[r] = w2[r * 512 + h * 128 + d];
        const float gb = gbias[h * 128 + d]; float run = 0.f;
        for (int c = 0; c < 64; ++c) { const int t = t0 + c; float z = gb;
#pragma unroll
            for (int r = 0; r < 16; ++r) z += SK0[(size_t)t * 24 + r] * w[r];
            run += logsigmoidf(z) * (1.0f / 16.0f); GB[(size_t)t * 512 + h * 128 + d] = run; }
        DEC[unit * 128 + d] = __expf(run);
    }
}
__device__ __forceinline__ void ph_gla_state(Frame& F) {
    const bf16* PROJ = (const bf16*)(F.ws + WS_PROJ); const float* GB = (const float*)(F.ws + WS_GB); float* CST = (float*)(F.ws + WS_CST);
    for (int vb = blockIdx.x; vb < 512 * 64; vb += F.G) {
        const int unit = vb >> 6, d = (vb & 63) * 2 + (F.tid >> 8), v = F.tid & 255, n = unit & 63, bh = unit >> 6, b = bh >> 2, h = bh & 3, t0 = b * SEQ + n * 64;
        const float blast = GB[(size_t)(t0 + 63) * 512 + h * 128 + d]; float acc = 0.f;
        for (int c = 0; c < 64; ++c) { const size_t t = t0 + c; const float kk = bf2f(PROJ[t * NP0 + 512 + h * 128 + d]) * __expf(blast - GB[t * 512 + h * 128 + d]);
            acc += kk * bf2f(PROJ[t * NP0 + 1024 + h * 256 + v]); }
        CST[((size_t)unit * 256 + v) * 128 + d] = acc;
    }
}
__device__ __forceinline__ void ph_gla_scan(Frame& F) {
    const float* CST = (const float*)(F.ws + WS_CST); const float* DEC = (const float*)(F.ws + WS_DEC); bf16* PREVT = (bf16*)(F.ws + WS_PREVT);
    for (int idx = blockIdx.x * 512 + F.tid; idx < 8 * 32768; idx += F.G * 512) { const int bh = idx >> 15, vd = idx & 32767, d = vd & 127; float S = 0.f;
        for (int n = 0; n < 64; ++n) { const int unit = bh * 64 + n; PREVT[(size_t)unit * 32768 + vd] = (bf16)f2bf(S); S = DEC[unit * 128 + d] * S + CST[(size_t)unit * 32768 + vd]; } }
}
__device__ __forceinline__ void ph_gla_out(Frame& F, const Args& a) {
    const bf16* PROJ = (const bf16*)(F.ws + WS_PROJ); const float* GB = (const float*)(F.ws + WS_GB); const bf16* PREVT = (const bf16*)(F.ws + WS_PREVT); const float* normg = a.in[4]; bf16* OMIX = (bf16*)(F.ws + WS_OMIX);
    LAS float* qd = (LAS float*)F.lds; LAS float* ki = qd + 64 * 128; LAS float* sc = ki + 64 * 128; LAS float* red = sc + 64 * 64;
    const int tid = F.tid; const bool act = tid < 256;
    for (int unit = blockIdx.x; unit < 512; unit += F.G) {
        const int n = unit & 63, bh = unit >> 6, b = bh >> 2, h = bh & 3, t0 = b * SEQ + n * 64;
        __syncthreads();
        for (int i = tid; i < 64 * 128; i += 512) { const int c = i >> 7, d = i & 127; const size_t t = t0 + c; const float bb = GB[t * 512 + h * 128 + d];
            qd[i] = bf2f(PROJ[t * NP0 + h * 128 + d]) * ATT_SCALE * __expf(bb); ki[i] = bf2f(PROJ[t * NP0 + 512 + h * 128 + d]) * __expf(-bb); }
        __syncthreads();
        for (int p = tid; p < 64 * 64; p += 512) { const int i = p >> 6, j = p & 63; float s = 0.f;
            if (j <= i) for (int d = 0; d < 128; ++d) s += qd[i * 128 + d] * ki[j * 128 + d];
            sc[p] = s; }
        __syncthreads();
        const int v = tid & 255; const bf16* pv = PREVT + ((size_t)unit * 256 + v) * 128; const float gv = normg[v];
        for (int i = 0; i < 64; ++i) { float acc = 0.f;
            if (act) { for (int j = 0; j <= i; ++j) acc += sc[i * 64 + j] * bf2f(PROJ[(size_t)(t0 + j) * NP0 + 1024 + h * 256 + v]);
                for (int d = 0; d < 128; ++d) acc += qd[i * 128 + d] * bf2f(pv[d]);
                const float ss = wave_sum(acc * acc); if ((tid & 63) == 0) red[tid >> 6] = ss; }
            __syncthreads();
            const float ms = (red[0] + red[1] + red[2] + red[3]) * (1.0f / 256.0f); __syncthreads();
            if (act) { const float gr = bf2f(PROJ[(size_t)(t0 + i) * NP0 + 2048 + h * 256 + v]);
                const float o = acc * (1.0f / sqrtf(ms + LN_EPS)) * gv * (gr / (1.0f + __expf(-gr)));
                OMIX[(size_t)(t0 + i) * DM + h * 256 + v] = (bf16)f2bf(o); } }
    }
}
template <int MODE  >
__device__ __forceinline__ void ph_attn_naive(Frame& F, const bf16* Qb, int ldq, int qc0, const bf16* Kb, int ldk, int kc0, const bf16* Vb, int ldv, int vc0, int nheads, int group,
                                              const float* fbias, const unsigned long long* mask, bf16* O, int oc0) {
    const int half = F.tid >> 8, tid = F.tid & 255, qi = tid >> 2, part = tid & 3;
    LAS bf16* Ks = (LAS bf16*)(F.lds + half * 32768); LAS bf16* Vs = Ks + 64 * 128;
    const int nvb = (SEQ / 64) * (nheads / 2) * BATCH;
    for (int vb = blockIdx.x; vb < nvb; vb += F.G) {
        const int cc = vb >> 6, qb = ((vb & 63) + cc * 17) & 63, hp = cc % (nheads / 2), b = cc / (nheads / 2), h = hp * 2 + half, kvh = h / group;
        const int qpos = qb * 64 + qi; const size_t row = (size_t)b * SEQ + qpos;
        float qv[32], o[32];
#pragma unroll
        for (int d = 0; d < 32; ++d) { qv[d] = bf2f(Qb[row * ldq + qc0 + h * 128 + part * 32 + d]); o[d] = 0.f; }
        float mrun = -1e30f, l = 0.f;
        const float* fb = MODE == 0 ? fbias + (size_t)(b * 8 + h) * SEQ : nullptr;
        for (int kt = 0; kt <= qb; ++kt) {
            __syncthreads();
            for (int i = tid; i < 64 * 16; i += 256) { const int r = i >> 4, c8 = (i & 15) * 8; const size_t kr = (size_t)b * SEQ + kt * 64 + r;
                *(LAS v4u*)(Ks + r * 128 + c8) = *(const v4u*)(Kb + kr * ldk + kc0 + kvh * 128 + c8); *(LAS v4u*)(Vs + r * 128 + c8) = *(const v4u*)(Vb + kr * ldv + vc0 + kvh * 128 + c8); }
            __syncthreads();
            unsigned long long mw = ~0ull; if (MODE == 1) mw = mask[row * 64 + kt];
            for (int s = 0; s < 64; ++s) { const int key = kt * 64 + s; float p = 0.f;
#pragma unroll
                for (int d = 0; d < 32; ++d) p += qv[d] * bf2f(Ks[s * 128 + part * 32 + d]);
                p += __shfl_xor(p, 1); p += __shfl_xor(p, 2);
                const bool valid = key <= qpos && ((mw >> s) & 1ull);
                if (valid) { const float logit = (p + (MODE == 0 ? fb[key] : 0.f)) * ATT_SCALE; const float mn = fmaxf(mrun, logit), al = __expf(mrun - mn), pp = __expf(logit - mn);
                    l = l * al + pp; mrun = mn;
#pragma unroll
                    for (int d = 0; d < 32; ++d) o[d] = o[d] * al + pp * bf2f(Vs[s * 128 + part * 32 + d]); } }
        }
        const float il = 1.0f / l;
#pragma unroll
        for (int d = 0; d < 32; ++d) O[row * DM + oc0 + h * 128 + part * 32 + d] = (bf16)f2bf(o[d] * il);
    }
    __syncthreads();
}
__device__ __forceinline__ void ph_idx_scores(Frame& F) {
    const bf16* PROJ1 = (const bf16*)(F.ws + WS_PROJ); const bf16* IK = (const bf16*)(F.ws + WS_IK); const float* IW = (const float*)(F.ws + WS_IW); float* SC = (float*)(F.ws + WS_SC);
    LAS float* q = (LAS float*)F.lds; LAS float* w = q + 1024; const int tid = F.tid;
    for (int m = blockIdx.x; m < MTOK; m += F.G) { const int pos = m & 4095, b = m >> 12;
        __syncthreads();
        for (int i = tid; i < 1024; i += 512) q[i] = bf2f(PROJ1[(size_t)m * NP1 + 3072 + i]);
        if (tid < 16) w[tid] = IW[(size_t)m * 16 + tid];
        __syncthreads();
        for (int s = tid; s <= pos; s += 512) { const bf16* kr = IK + ((size_t)b * SEQ + s) * 64; float kk[64];
#pragma unroll
            for (int d = 0; d < 64; ++d) kk[d] = bf2f(kr[d]);
            float sc = 0.f;
#pragma unroll 1
            for (int hh = 0; hh < 16; ++hh) { float dsum = 0.f;
#pragma unroll
                for (int d = 0; d < 64; ++d) dsum += q[hh * 64 + d] * kk[d];
                sc += w[hh] * fmaxf(dsum, 0.f); }
            SC[(size_t)m * SEQ + s] = sc; }
    }
    __syncthreads();
}
namespace attn {
constexpr int D = 128, NW = 8, QBLK = 32, KVBLK = 64, QB = NW * QBLK;
constexpr int SHM_V = KVBLK * D * 2, SHM_K = KVBLK * D * 2;
constexpr int OFF_WS = 2 * SHM_V + 2 * SHM_K, OFF_BIAS = OFF_WS + NW * 64 * 4, LDS_NEED = OFF_BIAS + 2 * 16384;
constexpr float SCALE = 0.08838834764831845f, THR = 8.f;
typedef short s16x4 __attribute__((ext_vector_type(4)));
typedef float f32x16 __attribute__((ext_vector_type(16)));
typedef unsigned u32x4 __attribute__((ext_vector_type(4)));
#define KSWZ(row, colB) ((row) * 256 + ((colB) ^ (((row) & 7) << 4)))
#define SBAR() __builtin_amdgcn_sched_barrier(0)
__device__ __forceinline__ int v_st(int k, int c) { const int kk = (k & ~0xC) | ((k & 4) << 1) | ((k & 8) >> 1); return ((kk >> 3) * 4 + (c >> 5)) * 512 + ((kk & 7) * 32 + (c & 31)) * 2; }
__device__ __forceinline__ int v_rd_base(int lane) { return ((lane & 3) << 3) | (((lane >> 2) & 3) << 6) | (((lane >> 4) & 1) << 5) | (((lane >> 5) & 1) << 8); }
constexpr int v_rd_off(int d0, int ks, int half) { return d0 * 512 + ks * 4096 + half * 2048; }
__device__ __forceinline__ int crow(int r, int hi) { return (r & 3) + 8 * (r >> 2) + 4 * hi; }
__device__ __forceinline__ unsigned cvtpk(float lo, float hi) { unsigned r; asm volatile("v_cvt_pk_bf16_f32 %0, %1, %2" : "=v"(r) : "v"(lo), "v"(hi)); return r; }
__device__ __forceinline__ bf16x8 load8(const bf16* p) { return *reinterpret_cast<const bf16x8*>(p); }
__device__ __forceinline__ void mask_tile(f32x16& p0, f32x16& p1, int dq) {
    const float NEG = -__builtin_inff();
#pragma unroll
    for (int r = 0; r < 16; ++r) { const int c = (r & 3) + 8 * (r >> 2); if (dq - c < 0) p0[r] = NEG; if (dq - c - 32 < 0) p1[r] = NEG; }
}
__device__ __forceinline__ void mask_bits(f32x16& p0, f32x16& p1, unsigned w0, unsigned w1) {
#pragma unroll
    for (int r = 0; r < 16; ++r) { const unsigned c = (r & 3) + 8 * (r >> 2);
        const unsigned m0 = (unsigned)__builtin_amdgcn_sbfe((int)w0, c, 1), m1 = (unsigned)__builtin_amdgcn_sbfe((int)w1, c, 1);
        p0[r] = __uint_as_float((m0 & __float_as_uint(p0[r])) | (~m0 & 0xFF800000u)); p1[r] = __uint_as_float((m1 & __float_as_uint(p1[r])) | (~m1 & 0xFF800000u)); }
}
__device__ __forceinline__ void partialSM(f32x16& p0, f32x16& p1, float& m_reg, float& mn, float& alpha) {
    float pmax = p0[0]; for (int r = 1; r < 16; ++r) pmax = fmaxf(pmax, p0[r]); for (int r = 0; r < 16; ++r) pmax = fmaxf(pmax, p1[r]);
    { auto rr = __builtin_amdgcn_permlane32_swap(__float_as_uint(pmax), __float_as_uint(pmax), false, false);
      pmax = fmaxf(__uint_as_float(rr[0]), __uint_as_float(rr[1])); }
    constexpr float C2 = 1.4426950408889634f * SCALE;
    if (__builtin_expect(__all((pmax - m_reg) * SCALE <= THR), 1)) { mn = m_reg; alpha = 1.f; }
    else { mn = fmaxf(m_reg, pmax); alpha = __builtin_amdgcn_exp2f((m_reg - mn) * C2); m_reg = mn; }
    const float mnL = -mn * C2;
    for (int r = 0; r < 16; ++r) p0[r] = fmaf(p0[r], C2, mnL); for (int r = 0; r < 16; ++r) p1[r] = fmaf(p1[r], C2, mnL);
    for (int r = 0; r < 16; ++r) p0[r] = __builtin_amdgcn_exp2f(p0[r]);
}
__device__ __forceinline__ void finishSM(f32x16& p0, f32x16& p1, float alpha, float& l_reg, bf16x8& pa0, bf16x8& pa1, bf16x8& pa2, bf16x8& pa3) {
    for (int r = 0; r < 16; ++r) p1[r] = __builtin_amdgcn_exp2f(p1[r]);
    float ps = 0; for (int r = 0; r < 16; ++r) ps += p0[r]; for (int r = 0; r < 16; ++r) ps += p1[r];
    { auto rr = __builtin_amdgcn_permlane32_swap(__float_as_uint(ps), __float_as_uint(ps), false, false);
      ps = __uint_as_float(rr[0]) + __uint_as_float(rr[1]); }
    l_reg = l_reg * alpha + ps;
#define PK4(P, B_, OUT) do { unsigned a0 = cvtpk(P[B_+0], P[B_+1]), a1 = cvtpk(P[B_+2], P[B_+3]);                          \
        unsigned b0 = cvtpk(P[B_+4], P[B_+5]), b1 = cvtpk(P[B_+6], P[B_+7]);                                             \
        auto r0 = __builtin_amdgcn_permlane32_swap(a0, b0, false, false); auto r1 = __builtin_amdgcn_permlane32_swap(a1, b1, false, false); \
        u32x4 w = {r0[0], r1[0], r0[1], r1[1]}; OUT = *reinterpret_cast<bf16x8*>(&w); } while (0)
    PK4(p0, 0, pa0); PK4(p0, 8, pa1); PK4(p1, 0, pa2); PK4(p1, 8, pa3);
#undef PK4
}
template <int KB, bool BIAS>
__device__ __forceinline__ void qkt(f32x16& p0, f32x16& p1, const char* K_lds, int r32, int hi, const bf16x8* qr, const char* bl) {
    p0 = f32x16{}; p1 = f32x16{}; (void)bl;
    const char* kb[4];
#pragma unroll
    for (int dd = 0; dd < 4; ++dd) kb[dd] = K_lds + KB * SHM_K + KSWZ(r32, (dd * 16 + hi * 8) * 2);
#pragma unroll
    for (int d0 = 0; d0 < 8; ++d0) { const char* a = kb[d0 & 3] + (d0 >> 2) * 128;
        bf16x8 b0 = *reinterpret_cast<const bf16x8*>(a);
        bf16x8 b1 = *reinterpret_cast<const bf16x8*>(a + 32 * 256);
        p0 = __builtin_amdgcn_mfma_f32_32x32x16_bf16(b0, qr[d0], p0, 0, 0, 0);
        p1 = __builtin_amdgcn_mfma_f32_32x32x16_bf16(b1, qr[d0], p1, 0, 0, 0); }
}
template <int VB>
__device__ __forceinline__ void pv_tile(f32x16* o, int vb0, bf16x8 pa0, bf16x8 pa1, bf16x8 pa2, bf16x8 pa3) {
#define TRRD(dst, off) asm volatile("ds_read_b64_tr_b16 %0, %1 offset:%2" : "=&v"(dst) : "v"(vb0), "i"(off) : "memory")
#define PV_D0(d0) do { s16x4 l0, l1, l2, l3, h0, h1, h2, h3; constexpr int b_ = VB * SHM_V + v_rd_off(d0, 0, 0); \
        TRRD(l0, b_); TRRD(h0, b_ + 2048); TRRD(l1, b_ + 4096); TRRD(h1, b_ + 6144); TRRD(l2, b_ + 8192); TRRD(h2, b_ + 10240); TRRD(l3, b_ + 12288); TRRD(h3, b_ + 14336); \
        asm volatile("s_waitcnt lgkmcnt(0)" ::: "memory"); SBAR();   \
        o[d0] = __builtin_amdgcn_mfma_f32_32x32x16_bf16(pa0, (bf16x8){l0[0], l0[1], l0[2], l0[3], h0[0], h0[1], h0[2], h0[3]}, o[d0], 0, 0, 0);   \
        o[d0] = __builtin_amdgcn_mfma_f32_32x32x16_bf16(pa1, (bf16x8){l1[0], l1[1], l1[2], l1[3], h1[0], h1[1], h1[2], h1[3]}, o[d0], 0, 0, 0);   \
        o[d0] = __builtin_amdgcn_mfma_f32_32x32x16_bf16(pa2, (bf16x8){l2[0], l2[1], l2[2], l2[3], h2[0], h2[1], h2[2], h2[3]}, o[d0], 0, 0, 0);   \
        o[d0] = __builtin_amdgcn_mfma_f32_32x32x16_bf16(pa3, (bf16x8){l3[0], l3[1], l3[2], l3[3], h3[0], h3[1], h3[2], h3[3]}, o[d0], 0, 0, 0); } while (0)
    PV_D0(0); PV_D0(1); PV_D0(2); PV_D0(3);
#undef PV_D0
#undef TRRD
}
struct BlockRef { const bf16* Q; const bf16* K; const bf16* V; bf16* O; int P0; const float* fb; const unsigned long long* mrow; };
struct Seam { bf16x8 qr[8]; bf16x8 st_v0, st_v1, st_k0, st_k1; };
#define VMW() asm volatile("s_waitcnt vmcnt(0)" ::: "memory")
#define VMWN(n) asm volatile("s_waitcnt vmcnt(%0)" :: "i"(n) : "memory")
#define SLOAD_H(Kp, Vp, k0) do { const bf16* kt_ = (Kp) + (size_t)(k0) * KS; const bf16* vt_ = (Vp) + (size_t)(k0) * KS; S.st_v0 = load8(vt_ + koff); S.st_v1 = load8(vt_ + koff + 32 * KS); S.st_k0 = load8(kt_ + koff); S.st_k1 = load8(kt_ + koff + 32 * KS); } while (0)
#define SWRITE_HK(bf) do { *(bf16x8*)(K_lds + (bf) * SHM_K + kws) = S.st_k0; *(bf16x8*)(K_lds + (bf) * SHM_K + kws + 32 * 256) = S.st_k1; } while (0)
#define SWRITE_HV(bf) do { *(bf16x8*)(V_lds + (bf) * SHM_V + vst0) = S.st_v0; *(bf16x8*)(V_lds + (bf) * SHM_V + vst1) = S.st_v1; } while (0)
#define SWRITE_H(bf) do { SWRITE_HV(bf); SWRITE_HK(bf); } while (0)
template <bool BIAS, bool BITMASK, int QS, int KS, int OS>
__device__ __forceinline__ void attn_block(const BlockRef& cur, char* lds, LAS unsigned char* ldsl) {
    int tid_ = threadIdx.x; asm volatile("" : "+v"(tid_));
    const int tid = tid_, wid = __builtin_amdgcn_readfirstlane(tid >> 6), lane = tid & 63, r32 = lane & 31, hi = lane >> 5;
    const int NT = (cur.P0 + QB - 1) / KVBLK + 1;
    const int qlo = cur.P0 + wid * QBLK, qm = qlo + r32 - 4 * hi;
    char* V_lds = lds; char* K_lds = lds + 2 * SHM_V;
    float* ws = (float*)(lds + OFF_WS) + wid * 64; float* li_l = ws, * al_l = ws + 32;
    const LAS unsigned char* bl0 = ldsl + OFF_BIAS + hi * 16;
    float m_reg = -1e30f, l_reg = 0; f32x16 o[4] = {};
    const int sr = tid >> 4, sc = (tid & 15) * 8, vst0 = v_st(sr, sc), vst1 = v_st(32 + sr, sc), kws = KSWZ(sr, sc * 2);
    const int vb0 = (int)(uintptr_t)V_lds + v_rd_base(lane);
    const bf16* Kh = cur.K; const bf16* Vh = cur.V;
    const int moff = (wid * QBLK + r32) * 64, koff = sr * KS + sc, qoff = (wid * QBLK + r32) * QS + hi * 8;
    Seam S;
#pragma unroll
    for (int d0 = 0; d0 < 8; ++d0) S.qr[d0] = load8(cur.Q + qoff + d0 * 16);
    if constexpr (BIAS) { const f32x4 b0_ = *(const f32x4*)(cur.fb + tid * 8), b1_ = *(const f32x4*)(cur.fb + tid * 8 + 4);
        *(LAS f32x4*)(ldsl + OFF_BIAS + tid * 32) = b0_; *(LAS f32x4*)(ldsl + OFF_BIAS + tid * 32 + 16) = b1_; }
    SLOAD_H(Kh, Vh, 0); VMW(); SWRITE_HK(0); SWRITE_HV(0); SBAR();
#define RESC(a) do { if (__any((a) < 1.f)) { if (hi == 0) al_l[r32] = (a); asm volatile("s_waitcnt lgkmcnt(0)" ::: "memory");              \
                     for (int d_ = 0; d_ < 4; ++d_) for (int r = 0; r < 16; ++r) o[d_][r] *= al_l[crow(r, hi)]; } } while (0)
#define KBASE(t) ((t) * KVBLK)
#define MLOAD(MW, t) do { if constexpr (BITMASK) MW = (cur.mrow + (t))[moff]; } while (0)
#define MASKT(P0_, P1_, MW, t) do { if constexpr (BIAS) { const LAS unsigned char* bl_ = bl0 + KBASE(t) * 4; _Pragma("unroll") for (int g = 0; g < 4; ++g) { const f32x4 a_ = *(const LAS f32x4*)(bl_ + g * 32), b_ = *(const LAS f32x4*)(bl_ + 128 + g * 32); \
            P0_[4 * g] += a_[0]; P0_[4 * g + 1] += a_[1]; P0_[4 * g + 2] += a_[2]; P0_[4 * g + 3] += a_[3]; P1_[4 * g] += b_[0]; P1_[4 * g + 1] += b_[1]; P1_[4 * g + 2] += b_[2]; P1_[4 * g + 3] += b_[3]; } } \
        if constexpr (BITMASK) { mask_bits(P0_, P1_, (unsigned)(MW) >> (4 * hi), (unsigned)((MW) >> 32) >> (4 * hi)); } \
        else { const int kb_ = KBASE(t); if (kb_ + KVBLK - 1 > qlo) mask_tile(P0_, P1_, qm - kb_); } } while (0)
    f32x16 pA0, pA1, pB0, pB1; float mnA, mnB, alA, alB; bf16x8 pa0, pa1, pa2, pa3; unsigned long long mwA = 0, mwB = 0;
    MLOAD(mwA, 0);
    SLOAD_H(Kh, Vh, KBASE(1)); MLOAD(mwB, 1);
    __syncthreads();
    SBAR(); qkt<0, BIAS>(pA0, pA1, K_lds, r32, hi, S.qr, nullptr);
    MASKT(pA0, pA1, mwA, 0); partialSM(pA0, pA1, m_reg, mnA, alA);
    VMW(); SWRITE_H(1);
    __syncthreads();
#define HALF_STEP(PX0, PX1, mnX, alX, MWX, PY0, PY1, alY, MWY, t, KB, VB, SB) do {                                            \
        SBAR(); qkt<KB, BIAS>(PX0, PX1, K_lds, r32, hi, S.qr, nullptr);                                                       \
        finishSM(PY0, PY1, alY, l_reg, pa0, pa1, pa2, pa3); SBAR();                                                           \
        if ((t) + 1 < NT) { SLOAD_H(Kh, Vh, KBASE((t) + 1)); MLOAD(MWY, (t) + 1); SBAR(); }                                   \
        pv_tile<VB>(o, vb0, pa0, pa1, pa2, pa3); MASKT(PX0, PX1, MWX, (t)); partialSM(PX0, PX1, m_reg, mnX, alX);             \
        __syncthreads();                                                                                                      \
        if ((t) + 1 < NT) { VMW(); SWRITE_H(SB); }                                                                            \
        RESC(alX); __syncthreads(); } while (0)
    for (int t = 1; t + 1 < NT; t += 2) {
        HALF_STEP(pB0, pB1, mnB, alB, mwB, pA0, pA1, alA, mwA, t, 1, 0, 0);
        HALF_STEP(pA0, pA1, mnA, alA, mwA, pB0, pB1, alB, mwB, t + 1, 0, 1, 1);
    }
    SBAR(); qkt<1, BIAS>(pB0, pB1, K_lds, r32, hi, S.qr, nullptr); SBAR();
    finishSM(pA0, pA1, alA, l_reg, pa0, pa1, pa2, pa3); SBAR();
    pv_tile<0>(o, vb0, pa0, pa1, pa2, pa3);
    MASKT(pB0, pB1, mwB, NT - 1); partialSM(pB0, pB1, m_reg, mnB, alB); __syncthreads(); RESC(alB);
    finishSM(pB0, pB1, alB, l_reg, pa0, pa1, pa2, pa3); SBAR(); pv_tile<1>(o, vb0, pa0, pa1, pa2, pa3);
    SBAR();
    if (hi == 0) li_l[r32] = l_reg; asm volatile("s_waitcnt lgkmcnt(0)" ::: "memory");
    float rli[16];
#pragma unroll
    for (int r = 0; r < 16; ++r) rli[r] = __builtin_amdgcn_rcpf(li_l[crow(r, hi)]);
    int tid2_ = threadIdx.x; asm volatile("" : "+v"(tid2_));
    const int r32e = tid2_ & 31, hie = (tid2_ >> 5) & 1, ooff = (wid * QBLK + 4 * hie) * OS + r32e;
#pragma unroll
    for (int r = 0; r < 16; ++r) {
#pragma unroll
        for (int d0 = 0; d0 < 4; ++d0) { const float v = o[d0][r] * rli[r]; const float vn = __shfl_xor(v, 1);
            if ((r32e & 1) == 0) *(unsigned*)(cur.O + ((r & 3) + 8 * (r >> 2)) * OS + d0 * 32 + ooff) = cvtpk(v, vn); } }
    __syncthreads();
#undef RESC
#undef KBASE
#undef MLOAD
#undef MASKT
#undef HALF_STEP
}
#undef ROWK
#undef VMW
#undef VMWN
#undef SLOAD_H
#undef SWRITE_HK
#undef SWRITE_HV
#undef SWRITE_H
#undef KSWZ
#undef SBAR
template <bool BIAS, bool BITMASK, int NH, int GROUP, bool PAIR, int QS, int KS, int OS>
__device__ __forceinline__ void attn_phase(char* lds, LAS unsigned char* ldsl, const bf16* Q, const bf16* K, const bf16* V, bf16* O, const float* fbias, const unsigned long long* mask, int G, int bid) {
    constexpr int NBLK = BATCH * NH * 16, NITEM = PAIR ? NBLK / 2 : NBLK, PER = PAIR ? 8 : 16, SETH = BATCH * NH / 8;
    for (int L = bid; L < NITEM; L += G) {
#pragma unroll 1
        for (int pass = 0; pass < (PAIR ? 2 : 1); ++pass) {
            const int g = L & 7, k = L >> 3, hs = k / PER, x = k % PER; const int bh = g * SETH + hs, b = bh / NH, h = bh % NH;
            const int qb = PAIR ? (pass ? 15 - x : x) : 15 - x; BlockRef r; const size_t row0 = (size_t)b * SEQ + (size_t)qb * QB;
            r.Q = Q + row0 * QS + h * D; r.O = O + row0 * OS + h * D; r.K = K + (size_t)b * SEQ * KS + (h / GROUP) * D; r.V = V + (size_t)b * SEQ * KS + (h / GROUP) * D; r.P0 = qb * QB;
            r.fb = BIAS ? fbias + (size_t)bh * SEQ : nullptr; r.mrow = BITMASK ? mask + row0 * 64 : nullptr;
            attn_block<BIAS, BITMASK, QS, KS, OS>(r, lds, ldsl);
        }
    }
}
}
__device__ __forceinline__ float fast_silu(float g) { return g * __builtin_amdgcn_rcpf(1.0f + __expf(-g)); }
__device__ __forceinline__ void ph_gla_a(Frame& F, const Args& a) {
    const float* SK0 = (const float*)(F.ws + WS_SK0); const float* w2 = a.in[2]; const float* gbias = a.in[3]; float* GB = (float*)(F.ws + WS_GB); float* DEC = (float*)(F.ws + WS_DEC);
    const bf16* PROJ = (const bf16*)(F.ws + WS_PROJ); float* CST = (float*)(F.ws + WS_CST);
    LAS float* BSH = (LAS float*)F.lds; LAS float* TOT = BSH + 64 * 128; LAS bf16* VT = (LAS bf16*)(F.lds + 36864); LAS bf16* KET = (LAS bf16*)(F.lds + 73728);
    const int tid = F.tid, lane = F.lane, l15 = lane & 15, quad = lane >> 4, w = F.wave;
    for (int unit = blockIdx.x; unit < 512; unit += F.G) {
        const int n = unit & 63, bh = unit >> 6, b = bh >> 2, h = bh & 3, t0 = b * SEQ + n * 64;
        __syncthreads();
        {
            const int d = tid & 127, cg = tid >> 7; float wv[16];
#pragma unroll
            for (int r = 0; r < 16; ++r) wv[r] = w2[r * 512 + h * 128 + d];
            const float gb = gbias[h * 128 + d]; float run = 0.f;
            for (int cc = 0; cc < 16; ++cc) { const int c = cg * 16 + cc; const float* sk = SK0 + (size_t)(t0 + c) * 24; float z = gb;
#pragma unroll
                for (int r = 0; r < 16; ++r) z += sk[r] * wv[r];
                run += logsigmoidf(z) * (1.0f / 16.0f); BSH[c * 128 + d] = run; }
            TOT[cg * 128 + d] = run;
            __syncthreads();
            float pre = 0.f;
            for (int g = 0; g < cg; ++g) pre += TOT[g * 128 + d];
            for (int cc = 0; cc < 16; ++cc) { const int c = cg * 16 + cc; const float v = BSH[c * 128 + d] + pre; BSH[c * 128 + d] = v; GB[(size_t)(t0 + c) * 512 + h * 128 + d] = v; }
        }
        __syncthreads();
        {
            const int c = tid & 63, g8 = tid >> 6; const size_t t = (size_t)(t0 + c);
            const bf16* kp = PROJ + t * NP0 + 512 + h * 128 + g8 * 16;
            const v4u k0 = *(const v4u*)kp, k1 = *(const v4u*)(kp + 8);
            const unsigned kw[8] = {k0.x, k0.y, k0.z, k0.w, k1.x, k1.y, k1.z, k1.w};
#pragma unroll
            for (int i = 0; i < 8; ++i) { const int d = g8 * 16 + 2 * i; const float e0 = __expf(BSH[63 * 128 + d] - BSH[c * 128 + d]), e1 = __expf(BSH[63 * 128 + d + 1] - BSH[c * 128 + d + 1]);
                KET[d * 72 + c] = (bf16)f2bf(bf2f(kw[i] & 0xffff) * e0); KET[(d + 1) * 72 + c] = (bf16)f2bf(bf2f(kw[i] >> 16) * e1); }
            const bf16* vp = PROJ + t * NP0 + 1024 + h * 256 + g8 * 32;
#pragma unroll
            for (int q = 0; q < 4; ++q) { const v4u vv = *(const v4u*)(vp + 8 * q); const unsigned vw[4] = {vv.x, vv.y, vv.z, vv.w};
#pragma unroll
                for (int i = 0; i < 4; ++i) { const int v = g8 * 32 + q * 8 + 2 * i; VT[v * 72 + c] = (bf16)(vw[i] & 0xffff); VT[(v + 1) * 72 + c] = (bf16)(vw[i] >> 16); } }
            if (tid < 128) DEC[unit * 128 + tid] = __expf(BSH[63 * 128 + tid]);
        }
        __syncthreads();
        {
            pg8::f32x4 acc[2][8];
#pragma unroll
            for (int i = 0; i < 2; ++i)
#pragma unroll
                for (int nn = 0; nn < 8; ++nn) acc[i][nn] = (pg8::f32x4){0.f, 0.f, 0.f, 0.f};
#pragma unroll
            for (int kk = 0; kk < 64; kk += 32) {
                const bf16x8 a0 = *(const LAS bf16x8*)(VT + (32 * w + l15) * 72 + kk + quad * 8), a1 = *(const LAS bf16x8*)(VT + (32 * w + 16 + l15) * 72 + kk + quad * 8);
#pragma unroll
                for (int nn = 0; nn < 8; ++nn) { const bf16x8 bb = *(const LAS bf16x8*)(KET + (16 * nn + l15) * 72 + kk + quad * 8);
                    acc[0][nn] = __builtin_amdgcn_mfma_f32_16x16x32_bf16(a0, bb, acc[0][nn], 0, 0, 0); acc[1][nn] = __builtin_amdgcn_mfma_f32_16x16x32_bf16(a1, bb, acc[1][nn], 0, 0, 0); } }
            float* cp = CST + (size_t)unit * 32768;
#pragma unroll
            for (int i = 0; i < 2; ++i)
#pragma unroll
                for (int nn = 0; nn < 8; ++nn)
#pragma unroll
                    for (int j = 0; j < 4; ++j) cp[(32 * w + 16 * i + quad * 4 + j) * 128 + 16 * nn + l15] = acc[i][nn][j];
        }
    }
    __syncthreads();
}
__device__ __forceinline__ void ph_gla_c(Frame& F, const Args& a) {
    const bf16* PROJ = (const bf16*)(F.ws + WS_PROJ); const float* GB = (const float*)(F.ws + WS_GB); const bf16* PREVT = (const bf16*)(F.ws + WS_PREVT); const float* normg = a.in[4]; bf16* OMIX = (bf16*)(F.ws + WS_OMIX);
    LAS bf16* QD = (LAS bf16*)(F.lds + 32768); LAS bf16* KI = (LAS bf16*)(F.lds + 50176); LAS bf16* P = (LAS bf16*)(F.lds + 67584); LAS bf16* VT = (LAS bf16*)(F.lds + 76800); LAS float* RED = (LAS float*)(F.lds + 113664);
    const int tid = F.tid, lane = F.lane, l15 = lane & 15, quad = lane >> 4, w = F.wave;
    for (int unit = blockIdx.x; unit < 512; unit += F.G) {
        const int n = unit & 63, bh = unit >> 6, b = bh >> 2, h = bh & 3, t0 = b * SEQ + n * 64;
        __syncthreads();
        {
            const int c = tid >> 3, dg = tid & 7; const size_t t = (size_t)(t0 + c);
            const float* bp = GB + t * 512 + h * 128 + dg * 16; const bf16* qp = PROJ + t * NP0 + h * 128 + dg * 16; const bf16* kp = PROJ + t * NP0 + 512 + h * 128 + dg * 16;
#pragma unroll
            for (int q8 = 0; q8 < 2; ++q8) { const v4u qq = *(const v4u*)(qp + 8 * q8), kk = *(const v4u*)(kp + 8 * q8); const f32x4 b0 = *(const f32x4*)(bp + 8 * q8), b1 = *(const f32x4*)(bp + 8 * q8 + 4);
                const unsigned qw[4] = {qq.x, qq.y, qq.z, qq.w}, kw[4] = {kk.x, kk.y, kk.z, kk.w}; const float bv[8] = {b0[0], b0[1], b0[2], b0[3], b1[0], b1[1], b1[2], b1[3]};
                v4u oq, ok; unsigned* oqp = (unsigned*)&oq; unsigned* okp = (unsigned*)&ok;
#pragma unroll
                for (int i = 0; i < 4; ++i) { const float e0 = __expf(bv[2 * i]), e1 = __expf(bv[2 * i + 1]);
                    oqp[i] = pk2(bf2f(qw[i] & 0xffff) * ATT_SCALE * e0, bf2f(qw[i] >> 16) * ATT_SCALE * e1);
                    okp[i] = pk2(bf2f(kw[i] & 0xffff) * __builtin_amdgcn_rcpf(e0), bf2f(kw[i] >> 16) * __builtin_amdgcn_rcpf(e1)); }
                *(LAS v4u*)(QD + c * 136 + dg * 16 + 8 * q8) = oq; *(LAS v4u*)(KI + c * 136 + dg * 16 + 8 * q8) = ok; }
            const int c2 = tid & 63, g8 = tid >> 6; const bf16* vp = PROJ + (size_t)(t0 + c2) * NP0 + 1024 + h * 256 + g8 * 32;
#pragma unroll
            for (int q = 0; q < 4; ++q) { const v4u vv = *(const v4u*)(vp + 8 * q); const unsigned vw[4] = {vv.x, vv.y, vv.z, vv.w};
#pragma unroll
                for (int i = 0; i < 4; ++i) { const int v = g8 * 32 + q * 8 + 2 * i; VT[v * 72 + c2] = (bf16)(vw[i] & 0xffff); VT[(v + 1) * 72 + c2] = (bf16)(vw[i] >> 16); } }
        }
        __syncthreads();
        {
            const int ti = w >> 1;
#pragma unroll
            for (int s = 0; s < 2; ++s) { const int tj = 2 * (w & 1) + s; pg8::f32x4 acc = (pg8::f32x4){0.f, 0.f, 0.f, 0.f};
                if (tj <= ti) {
#pragma unroll
                    for (int kk = 0; kk < 128; kk += 32) { const bf16x8 aa = *(const LAS bf16x8*)(QD + (16 * ti + l15) * 136 + kk + quad * 8), bb = *(const LAS bf16x8*)(KI + (16 * tj + l15) * 136 + kk + quad * 8);
                        acc = __builtin_amdgcn_mfma_f32_16x16x32_bf16(aa, bb, acc, 0, 0, 0); } }
#pragma unroll
                for (int j = 0; j < 4; ++j) { const int i = 16 * ti + quad * 4 + j, jj = 16 * tj + l15; P[i * 72 + jj] = (bf16)f2bf(jj <= i ? acc[j] : 0.f); } }
        }
        __syncthreads();
        {
            const int ti = w >> 1, half = w & 1; pg8::f32x4 acc[8];
#pragma unroll
            for (int nn = 0; nn < 8; ++nn) acc[nn] = (pg8::f32x4){0.f, 0.f, 0.f, 0.f};
#pragma unroll
            for (int kk = 0; kk < 64; kk += 32) { const bf16x8 aa = *(const LAS bf16x8*)(P + (16 * ti + l15) * 72 + kk + quad * 8);
#pragma unroll
                for (int nn = 0; nn < 8; ++nn) { const bf16x8 bb = *(const LAS bf16x8*)(VT + (128 * half + 16 * nn + l15) * 72 + kk + quad * 8); acc[nn] = __builtin_amdgcn_mfma_f32_16x16x32_bf16(aa, bb, acc[nn], 0, 0, 0); } }
            const bf16* pv = PREVT + (size_t)unit * 32768 + (size_t)(128 * half + l15) * 128 + quad * 8;
#pragma unroll
            for (int kk = 0; kk < 128; kk += 32) { const bf16x8 aa = *(const LAS bf16x8*)(QD + (16 * ti + l15) * 136 + kk + quad * 8);
#pragma unroll
                for (int nn = 0; nn < 8; ++nn) { const bf16x8 bb = *(const bf16x8*)(pv + (size_t)(16 * nn) * 128 + kk); acc[nn] = __builtin_amdgcn_mfma_f32_16x16x32_bf16(aa, bb, acc[nn], 0, 0, 0); } }
            float ss[4];
#pragma unroll
            for (int j = 0; j < 4; ++j) { float s = 0.f;
#pragma unroll
                for (int nn = 0; nn < 8; ++nn) s += acc[nn][j] * acc[nn][j];
                s += __shfl_xor(s, 1); s += __shfl_xor(s, 2); s += __shfl_xor(s, 4); s += __shfl_xor(s, 8); ss[j] = s; }
            if (l15 == 0) {
#pragma unroll
                for (int j = 0; j < 4; ++j) RED[(16 * ti + quad * 4 + j) * 2 + half] = ss[j]; }
            __syncthreads();
#pragma unroll
            for (int j = 0; j < 4; ++j) { const int i = 16 * ti + quad * 4 + j; const float ms = (RED[i * 2] + RED[i * 2 + 1]) * (1.0f / 256.0f); const float rs = 1.0f / sqrtf(ms + LN_EPS);
                const size_t t = (size_t)(t0 + i);
#pragma unroll
                for (int nn = 0; nn < 8; ++nn) { const int v = 128 * half + 16 * nn + l15; const float gr = bf2f(PROJ[t * NP0 + 2048 + h * 256 + v]);
                    OMIX[t * DM + h * 256 + v] = (bf16)f2bf(acc[nn][j] * rs * normg[v] * fast_silu(gr)); } }
        }
    }
    __syncthreads();
}
__device__ __forceinline__ void ph_indexer(Frame& F, unsigned char* lds_generic) {
    typedef float f32x16 __attribute__((ext_vector_type(16)));
    const bf16* PROJ1 = (const bf16*)(F.ws + WS_PROJ); const bf16* IK = (const bf16*)(F.ws + WS_IK); const float* IW = (const float*)(F.ws + WS_IW); unsigned long long* MASK = (unsigned long long*)(F.ws + WS_MASK);
    LAS float* SCL = (LAS float*)F.lds;
    const int lane = F.lane, w = F.wave, c32 = lane & 31, hi = lane >> 5, rt = w & 3, kpar = w >> 2;
    for (int it = blockIdx.x; it < 512; it += F.G) {
#pragma unroll 1
        for (int pass = 0; pass < 2; ++pass) {
            const int unit = pass ? 1023 - it : it, m0 = unit * 8, b = m0 >> 12, qmax = (m0 & 4095) + 7;
            __syncthreads();
            {
                const int qa = m0 + 2 * rt + ((c32 >> 2) & 1), ha = (c32 & 3) + 4 * (c32 >> 3);
                const bf16* ap = PROJ1 + (size_t)qa * NP1 + 3072 + ha * 64 + 8 * hi;
                bf16x8 af[4];
#pragma unroll
                for (int ks = 0; ks < 4; ++ks) af[ks] = *(const bf16x8*)(ap + 16 * ks);
                const float* wp = IW + (size_t)(m0 + 2 * rt + hi) * 16; float wv[16];
#pragma unroll
                for (int q4 = 0; q4 < 4; ++q4) { const f32x4 t4 = *(const f32x4*)(wp + 4 * q4); wv[4 * q4] = t4[0]; wv[4 * q4 + 1] = t4[1]; wv[4 * q4 + 2] = t4[2]; wv[4 * q4 + 3] = t4[3]; }
                LAS float* srow = SCL + (2 * rt + hi) * 4096 + c32;
                const bf16* kbase = IK + (size_t)b * SEQ * 64 + (size_t)lane * 8;
                bf16x8 bn[4];
#pragma unroll
                for (int ks = 0; ks < 4; ++ks) bn[ks] = *(const bf16x8*)(kbase + (size_t)(kpar * 4 + ks) * 512);
                for (int t = kpar; t * 32 <= qmax; t += 2) {
                    bf16x8 bc[4];
#pragma unroll
                    for (int ks = 0; ks < 4; ++ks) bc[ks] = bn[ks];
                    const int tn = (t + 2) * 32 <= qmax ? t + 2 : t;
#pragma unroll
                    for (int ks = 0; ks < 4; ++ks) bn[ks] = *(const bf16x8*)(kbase + (size_t)(tn * 4 + ks) * 512);
                    f32x16 acc = {};
#pragma unroll
                    for (int ks = 0; ks < 4; ++ks) acc = __builtin_amdgcn_mfma_f32_32x32x16_bf16(af[ks], bc[ks], acc, 0, 0, 0);
                    float s = 0.f;
#pragma unroll
                    for (int r = 0; r < 16; ++r) s += wv[r] * fmaxf(acc[r], 0.f);
                    srow[t * 32] = s; }
            }
            __syncthreads();
            { const int m = m0 + w; topk_mask_row((const LAS float*)(F.lds + w * 16384), m & 4095, MASK + (size_t)m * 64, lane, (LAS unsigned*)(F.lds + LDSCTL_OFF + 4096 + w * 1024)); }
        }
    }
    __syncthreads();
}
#define IN(k) (lo <= (k) && (k) < hi)
#define SEAM(k) do { if (hi > (k) + 1) xcd_barrier(bar); } while (0)
template <int LAYER, int BASE>
__device__ __forceinline__ void common_phases(Frame& F, const Args& args, const int lo, const int hi, const XcdBarrier& bar) {
    unsigned char* ws = args.ws;
    if (IN(BASE + 0)) {
        pg8::Gemm g{(const bf16*)(ws + WS_OMIX), (const bf16*)(ws + (LAYER ? WS_WOC : WS_WOA)), MTOK, DM, DM, DM, DM}; pg8::StaticOrder S; S.init(MTOK, DM, F.G, (int)blockIdx.x);
        pg8::EpiResid E{LAYER ? (const float*)(ws + WS_XR) : args.in[0], (float*)(ws + WS_XR), DN_ALPHA};
        pg8::gemm_phase<pg8::EpiResid, pg8::StaticOrder, true, true>(F.lds, g, S, E);
        SEAM(BASE + 0);
    }
    if (IN(BASE + 1)) { p_ln_route(F, args, LAYER); SEAM(BASE + 1); }
    if (IN(BASE + 3) || IN(BASE + 4) || IN(BASE + 5)) {
        if (F.wave == 0) { int ti; (void)moe_offsets(F.ctl + CW_CNT + LAYER * 64, F.lane, &ti); if (F.lane < 32) { F.MISC[64 + F.lane] = (unsigned)ti; F.MISC[160 + F.lane] = F.ctl[CW_CNT + LAYER * 64 + F.lane]; } if (F.lane == 31) F.MISC[96] = (unsigned)ti; }
        __syncthreads();
    }
    {
        const int Tm = (int)F.MISC[96], T1 = F.G / 4 < Tm ? F.G / 4 : Tm;
        const int n2 = (Tm - T1) * 4;
        const pg8::Gemm gU{(const bf16*)(ws + WS_XB), (const bf16*)(ws + WS_WGU) + (size_t)LAYER * 32 * 1024 * 2048, RPAD, 32 * 1024, DM, DM, DM};
        const pg8::Gemm gD{(const bf16*)(ws + WS_OMIX), (const bf16*)(ws + WS_WD) + (size_t)LAYER * 32 * 2048 * 512, RPAD, 32 * 2048, 512, 512, 512};
        const PG8_LAS int* tend = (const LAS int*)(F.lds + LDSCTL_OFF + 64 * 4); const PG8_LAS int* ecnt = (const LAS int*)(F.lds + LDSCTL_OFF + 160 * 4);
        const int* inv = (const int*)(ws + WS_INV);
        const pg8::EpiGLU EU{(bf16*)(ws + WS_OMIX), (const float*)(ws + WS_WINV)}; const pg8::EpiBf16Plain ED{(bf16*)(ws + WS_CST), DM, 7};
        if (IN(BASE + 3)) {
            pg8::MoeOrder S{F.G, (int)blockIdx.x, 4, 0, T1 * 4, tend, ecnt};
            pg8::gemm_phase_g<pg8::EpiGLU, pg8::MoeOrder>(F.lds, gU, S, EU, inv);
            SEAM(BASE + 3);
        }
        if (IN(BASE + 4)) {
            if ((int)blockIdx.x < n2) { pg8::MoeOrder S{n2, (int)blockIdx.x, 4, T1 * 4, Tm * 4, tend, ecnt}; pg8::gemm_phase_g<pg8::EpiGLU, pg8::MoeOrder>(F.lds, gU, S, EU, inv); }
            else { pg8::MoeOrder S{F.G - n2, (int)blockIdx.x - n2, 8, 0, T1 * 8, tend, ecnt}; pg8::gemm_phase<pg8::EpiBf16Plain, pg8::MoeOrder, true, true>(F.lds, gD, S, ED); }
            SEAM(BASE + 4);
        }
        if (IN(BASE + 5)) {
            pg8::MoeOrder S{F.G, (int)blockIdx.x, 8, T1 * 8, Tm * 8, tend, ecnt};
            pg8::gemm_phase<pg8::EpiBf16Plain, pg8::MoeOrder, true, true>(F.lds, gD, S, ED);
            SEAM(BASE + 5);
        }
    }
    if (IN(BASE + 6)) { p_ln_ffn(F, args, LAYER); SEAM(BASE + 6); }
}
__global__ void __launch_bounds__(NWAVES * 64, 2) mk_fwd(Args args) {
    extern __shared__ __attribute__((aligned(16))) unsigned char lds[];
    Frame F;
    F.lds = (LAS unsigned char*)lds; F.MISC = (volatile LAS unsigned*)(F.lds + LDSCTL_OFF);
    F.tid = threadIdx.x; F.lane = F.tid & 63; F.wave = __builtin_amdgcn_readfirstlane(F.tid >> 6);
    F.G = gridDim.x; F.gw = blockIdx.x * NWAVES + F.wave; F.NGW = F.G * NWAVES;
    F.ws = args.ws; F.ctl = (unsigned*)(args.ws + WS_CTL);
    for (int u = F.tid; u < (LDS_BYTES - LDSCTL_OFF) / 4; u += NWAVES * 64) ((LAS unsigned*)(F.lds + LDSCTL_OFF))[u] = 0u;
    __syncthreads();
    const int lo = args.ph_lo, hi = args.ph_hi;
    XcdBarrier bar; bar.bar = F.ctl + CW_BAR + args.bar_region * XCD_BAR_WORDS; bar.x = 0; bar.st = nullptr;
    if (hi - lo > 1) bar = xcd_barrier_post(F.ctl + CW_BAR + args.bar_region * XCD_BAR_WORDS, F.MISC);
    unsigned char* ws = args.ws;

    if (IN(0)) { p0_prologue(F, args); SEAM(0); }
    if (IN(1)) {
        pg8::Gemm g{(const bf16*)(ws + WS_XB), (const bf16*)(ws + WS_WINA), MTOK, NP0, DM, DM, DM}; pg8::StaticOrder S; S.init(MTOK, NP0, F.G, (int)blockIdx.x);
        pg8::EpiBf16Plain E{(bf16*)(ws + WS_PROJ), NP0, 0x7fffffff};
        pg8::gemm_phase<pg8::EpiBf16Plain, pg8::StaticOrder, true, true>(F.lds, g, S, E);
        p_skinny0(F, args);
        SEAM(1);
    }
    if (IN(2)) { p_fox_bias(F, args); ph_gla_a(F, args); SEAM(2); }
    if (IN(4)) { ph_gla_scan(F); __syncthreads();
        attn::attn_phase<true, false, 8, 1, false, NP0, NP0, DM>((char*)lds, F.lds, (const bf16*)(ws + WS_PROJ) + 3072, (const bf16*)(ws + WS_PROJ) + 4096, (const bf16*)(ws + WS_PROJ) + 5120,
                                                               (bf16*)(ws + WS_OMIX) + 1024, (const float*)(ws + WS_FBIAS), (const unsigned long long*)nullptr, F.G, (int)blockIdx.x);
        late_conv_items(F, args);
        SEAM(4); }
    if (IN(5)) { ph_gla_c(F, args); SEAM(5); }
    common_phases<0, 6>(F, args, lo, hi, bar);
    if (IN(13)) {
        pg8::Gemm g{(const bf16*)(ws + WS_XB), (const bf16*)(ws + WS_WINC), MTOK, NP1, DM, DM, DM}; pg8::StaticOrder S; S.init(MTOK, NP1, F.G, (int)blockIdx.x);
        const float* c128 = (const float*)(ws + WS_ROPE);
        pg8::EpiRope E{(bf16*)(ws + WS_PROJ), c128, c128 + 4096 * 64, c128 + 2 * 4096 * 64, c128 + 2 * 4096 * 64 + 4096 * 32};
        pg8::gemm_phase<pg8::EpiRope, pg8::StaticOrder, true, true>(F.lds, g, S, E);
        SEAM(13);
    }
    if (IN(14)) { ph_indexer(F, lds); SEAM(14); }
    if (IN(16)) {
        attn::attn_phase<false, true, 16, 4, true, NP1, NP1, DM>((char*)lds, F.lds, (const bf16*)(ws + WS_PROJ), (const bf16*)(ws + WS_PROJ) + 2048, (const bf16*)(ws + WS_PROJ) + 2560,
                                                               (bf16*)(ws + WS_OMIX), (const float*)nullptr, (const unsigned long long*)(ws + WS_MASK), F.G, (int)blockIdx.x);
        SEAM(16); }
    common_phases<1, 17>(F, args, lo, hi, bar);
#ifdef PROBE_GEMM_K
    if (IN(30)) {
        pg8::Gemm g{(const bf16*)(ws + WS_XB), (const bf16*)(ws + WS_WINA), MTOK, NP0, PROBE_GEMM_K, PROBE_GEMM_LD, PROBE_GEMM_LD}; pg8::StaticOrder S; S.init(MTOK, NP0, F.G, (int)blockIdx.x);
        pg8::EpiBf16Plain E{(bf16*)(ws + WS_SC), NP0, 0x7fffffff};
        pg8::gemm_phase<pg8::EpiBf16Plain, pg8::StaticOrder, true, true>(F.lds, g, S, E);
    }
#endif
}
#undef IN
#undef SEAM
constexpr int N_PHASE_IDS = 24;
static void launch_mk(const Args& base, int lo, int hi, int grid, hipStream_t stream, int region = 0) {
    Args a = base; a.ph_lo = lo; a.ph_hi = hi; a.bar_region = region; a.pad = 0;
    hipLaunchKernelGGL(mk_fwd, dim3(grid), dim3(NWAVES * 64), LDS_BYTES, stream, a);
}
extern "C" void kernel_launch(void* const* d_in, const int* in_sizes, int n_in, void* d_out, int out_size, void* d_ws, size_t ws_size, hipStream_t stream) {
    static int grid = 0;
    if (grid == 0) {
        if (n_in != 20 || out_size != MTOK * DM || ws_size < WS_END) { fprintf(stderr, "kernel_launch: unexpected shapes (n_in %d, out %d, ws %zu < %zu)\n", n_in, out_size, ws_size, (size_t)WS_END); grid = -1; return; }
        int dev = 0, cus = 0, per_cu = 0;
        if (hipGetDevice(&dev) != hipSuccess || hipDeviceGetAttribute(&cus, hipDeviceAttributeMultiprocessorCount, dev) != hipSuccess) { grid = -1; return; }
        if (hipFuncSetAttribute((const void*)mk_fwd, hipFuncAttributeMaxDynamicSharedMemorySize, LDS_BYTES) != hipSuccess) { fprintf(stderr, "kernel_launch: hipFuncSetAttribute failed\n"); grid = -1; return; }
        if (hipOccupancyMaxActiveBlocksPerMultiprocessor(&per_cu, (const void*)mk_fwd, NWAVES * 64, LDS_BYTES) != hipSuccess || per_cu < 1) { fprintf(stderr, "kernel_launch: occupancy query reports %d workgroups per CU\n", per_cu); }
        (void)hipGetLastError();
        grid = cus;
    }
    if (grid < 0) return;
    (void)in_sizes;
    if (hipMemsetAsync((char*)d_ws + WS_CTL, 0, CTL_ZERO_BYTES, stream) != hipSuccess) return;
    Args a{};
    for (int i = 0; i < 20; ++i) a.in[i] = (const float*)d_in[i];
    a.out = (float*)d_out; a.ws = (unsigned char*)d_ws;
#ifdef PROBE_LO
    launch_mk(a, 0, PROBE_HI + 1, grid, stream, 0); launch_mk(a, PROBE_LO, N_PHASE_IDS, grid, stream, 1);
#else
    launch_mk(a, 0, N_PHASE_IDS, grid, stream);
#endif
#ifdef PROBE_GEMM_K
    launch_mk(a, 30, 31, grid, stream, 2);
#endif
}
```

```cpp
#include <hip/hip_runtime.h>
#include <cstdio>
#include <cstdint>
namespace pg8 {
#define PG8_LAS __attribute__((address_space(3)))
typedef unsigned short bf16_t;
typedef short bf16x8 __attribute__((ext_vector_type(8)));
typedef float f32x4 __attribute__((ext_vector_type(4)));
typedef unsigned u32x4 __attribute__((ext_vector_type(4)));
constexpr int BM = 256, BK = 64, HALF = 128, HTB = HALF * BK * 2  , STAGE_BYTES = 8 * HTB, NXCD = 8, WGM = 8;

__host__ __device__ __forceinline__ int lds_byte(int r, int c) { const int st = (r >> 4) * 2 + (c >> 5), rr = r & 15, cc = c & 31, ob = rr * 64 + cc * 2; return st * 1024 + (ob ^ (((ob >> 9) & 1) << 5)); }
__host__ __device__ __forceinline__ void stage_rc(int b, int& R, int& C) { const int st = b / 1024, sb = b % 1024, swz = sb ^ (((sb >> 9) & 1) << 5); R = (st >> 1) * 16 + swz / 64; C = (st & 1) * 32 + (swz % 64) / 2; }
__host__ __device__ __forceinline__ int perm32(int rho) { const int n = rho >> 4, i = rho & 15; return 8 * (i >> 2) + 4 * n + (i & 3); }

struct Unit { int pm, pn, inv0, nvalid; };
struct Gemm { const bf16_t* A; const bf16_t* Bt; int M, N, K, lda, ldb; };

struct StaticOrder {
    int nM, nN, nwg, G, c;
    __host__ __device__ void init(int M, int N, int G_, int c_) { nM = M / BM; nN = N / BM; nwg = nM * nN; G = G_; c = c_; }
    __host__ __device__ bool next(int i, Unit& u) const {
        const long L = (long)i * G + c; if (L >= nwg) return false;
        int wgid = (int)L; { const int q = nwg / NXCD, r = nwg % NXCD, xcd = wgid % NXCD, off = wgid / NXCD; wgid = (xcd < r ? xcd * (q + 1) : r * (q + 1) + (xcd - r) * q) + off; }
        const int nig = WGM * nN, gid = wgid / nig, fm = gid * WGM, gsz = (nM - fm) < WGM ? (nM - fm) : WGM;
        u.pm = fm + ((wgid % nig) % gsz); u.pn = (wgid % nig) / gsz; return true;
    }
    __device__ __forceinline__ void a_ready(const Unit&) const {}
    __device__ __forceinline__ void done(const Unit&) const {}
};

__device__ __forceinline__ unsigned cvt_pk_bf16(float lo, float hi) { unsigned r; asm volatile("v_cvt_pk_bf16_f32 %0, %1, %2" : "=v"(r) : "v"(lo), "v"(hi)); return r; }
typedef float f32x2 __attribute__((ext_vector_type(2)));
struct EpiBf16Plain {
    static constexpr bool PERM = true, AFTER_DRAIN = false;
    bf16_t* O; int ldc; int pn_mask;
    __device__ __forceinline__ void operator()(const f32x4 (&acc)[2][2][4][2], const Unit& u, int wr, int wc, int fr, int fq) const {
        const int row0 = u.pm * BM + wr * 64 + fr, col0 = (u.pn & pn_mask) * BM + wc * 32 + 8 * fq;
#pragma unroll
        for (int ai = 0; ai < 2; ++ai)
#pragma unroll
            for (int m = 0; m < 4; ++m) { bf16_t* rowp = O + (size_t)(row0 + ai * HALF + m * 16) * ldc + col0;
#pragma unroll
                for (int bj = 0; bj < 2; ++bj) { const f32x4 v0 = acc[ai][bj][m][0], v1 = acc[ai][bj][m][1];
                    u32x4 w; w.x = cvt_pk_bf16(v0[0], v0[1]); w.y = cvt_pk_bf16(v0[2], v0[3]); w.z = cvt_pk_bf16(v1[0], v1[1]); w.w = cvt_pk_bf16(v1[2], v1[3]);
                    *(u32x4*)(rowp + bj * HALF) = w; } }
    }
};
struct EpiResid {
    static constexpr bool PERM = true, AFTER_DRAIN = false;
    const bf16_t* base; bf16_t* out; float alpha;
    __device__ __forceinline__ void operator()(const f32x4 (&acc)[2][2][4][2], const Unit& u, int wr, int wc, int fr, int fq) const {
        const int row0 = u.pm * BM + wr * 64 + fr, col0 = u.pn * BM + wc * 32 + 8 * fq;
#pragma unroll
        for (int ai = 0; ai < 2; ++ai)
#pragma unroll
            for (int m = 0; m < 4; ++m) { const size_t off = (size_t)(row0 + ai * HALF + m * 16) * 2048 + col0;
#pragma unroll
                for (int bj = 0; bj < 2; ++bj) { const u32x4 b = *(const u32x4*)(base + off + bj * HALF); const f32x4 v0 = acc[ai][bj][m][0], v1 = acc[ai][bj][m][1];
                    const unsigned bw[4] = {b.x, b.y, b.z, b.w}; u32x4 w; unsigned* wp = (unsigned*)&w;
#pragma unroll
                    for (int q = 0; q < 4; ++q) { const float lo = __builtin_bit_cast(float, bw[q] << 16), hi = __builtin_bit_cast(float, bw[q] & 0xffff0000u);
                        const float a0 = q < 2 ? v0[2 * q] : v1[2 * q - 4], a1 = q < 2 ? v0[2 * q + 1] : v1[2 * q - 3];
                        wp[q] = cvt_pk_bf16(lo * alpha + a0, hi * alpha + a1); }
                    *(u32x4*)(out + off + bj * HALF) = w; } }
    }
};
struct EpiGLU {
    static constexpr bool PERM = true, AFTER_DRAIN = false;
    bf16_t* H; const float* winv;
    __device__ __forceinline__ void operator()(const f32x4 (&acc)[2][2][4][2], const Unit& u, int wr, int wc, int fr, int fq) const {
        const int row0 = u.pm * BM + wr * 64 + fr, f0 = (u.pn & 3) * 128 + wc * 32 + 8 * fq;
#pragma unroll
        for (int ai = 0; ai < 2; ++ai)
#pragma unroll
            for (int m = 0; m < 4; ++m) { const int row = row0 + ai * HALF + m * 16; const float w = winv[u.inv0 + ai * HALF + wr * 64 + m * 16 + fr];
                float h[8];
#pragma unroll
                for (int n = 0; n < 2; ++n)
#pragma unroll
                    for (int e = 0; e < 4; ++e) { const float g = acc[ai][0][m][n][e], up = acc[ai][1][m][n][e]; h[n * 4 + e] = g * __builtin_amdgcn_rcpf(1.0f + __expf(-g)) * up * w; }
                u32x4 o; o.x = cvt_pk_bf16(h[0], h[1]); o.y = cvt_pk_bf16(h[2], h[3]); o.z = cvt_pk_bf16(h[4], h[5]); o.w = cvt_pk_bf16(h[6], h[7]);
                *(u32x4*)(H + (size_t)row * 512 + f0) = o; }
    }
};
struct EpiRope {
    static constexpr bool PERM = true, AFTER_DRAIN = false;
    bf16_t* O; const float* c128; const float* s128; const float* c64; const float* s64;
    __device__ __forceinline__ void operator()(const f32x4 (&acc)[2][2][4][2], const Unit& u, int wr, int wc, int fr, int fq) const {
        const int row0 = u.pm * BM + wr * 64 + fr, jj = wc * 32 + 8 * fq;
        const int pn = u.pn;
        if (pn == 10 || pn == 11) {
#pragma unroll
            for (int ai = 0; ai < 2; ++ai)
#pragma unroll
                for (int m = 0; m < 4; ++m) { bf16_t* rowp = O + (size_t)(row0 + ai * HALF + m * 16) * 4096 + pn * 256 + jj;
#pragma unroll
                    for (int bj = 0; bj < 2; ++bj) { const f32x4 v0 = acc[ai][bj][m][0], v1 = acc[ai][bj][m][1];
                        u32x4 w; w.x = cvt_pk_bf16(v0[0], v0[1]); w.y = cvt_pk_bf16(v0[2], v0[3]); w.z = cvt_pk_bf16(v1[0], v1[1]); w.w = cvt_pk_bf16(v1[2], v1[3]);
                        *(u32x4*)(rowp + bj * HALF) = w; } }
            return;
        }
        const bool idx = pn >= 12;
        const int half = idx ? 32 : 64;
        const int hl = idx ? (jj >> 5) : (jj >> 6), i0 = jj & (half - 1);
        const int colbase = idx ? (3072 + ((pn - 12) * 4 + hl) * 64) : (pn * 256 + hl * 128);
        const float* ct = idx ? c64 : c128; const float* st = idx ? s64 : s128;
#pragma unroll
        for (int ai = 0; ai < 2; ++ai)
#pragma unroll
            for (int m = 0; m < 4; ++m) { const int row = row0 + ai * HALF + m * 16; const int pos = row & 4095;
                const float* cp = ct + (size_t)pos * half + i0; const float* sp = st + (size_t)pos * half + i0;
                const f32x4 c0 = *(const f32x4*)cp, c1 = *(const f32x4*)(cp + 4), s0 = *(const f32x4*)sp, s1 = *(const f32x4*)(sp + 4);
                const f32x4 a0 = acc[ai][0][m][0], a1 = acc[ai][0][m][1], b0 = acc[ai][1][m][0], b1 = acc[ai][1][m][1];
                const f32x4 x0 = a0 * c0 - b0 * s0, x1 = a1 * c1 - b1 * s1, y0 = b0 * c0 + a0 * s0, y1 = b1 * c1 + a1 * s1;
                bf16_t* rowp = O + (size_t)row * 4096 + colbase + i0;
                u32x4 w; w.x = cvt_pk_bf16(x0[0], x0[1]); w.y = cvt_pk_bf16(x0[2], x0[3]); w.z = cvt_pk_bf16(x1[0], x1[1]); w.w = cvt_pk_bf16(x1[2], x1[3]);
                *(u32x4*)rowp = w;
                u32x4 z; z.x = cvt_pk_bf16(y0[0], y0[1]); z.y = cvt_pk_bf16(y0[2], y0[3]); z.z = cvt_pk_bf16(y1[0], y1[1]); z.w = cvt_pk_bf16(y1[2], y1[3]);
                *(u32x4*)(rowp + half) = z; }
    }
};
struct MoeOrder {
    int G, c, ntn, L0, Lend; const PG8_LAS int* tend; const PG8_LAS int* cnt;
    __device__ __forceinline__ bool next(int i, Unit& u) const {
        const int L = L0 + i * G + c; if (L >= Lend) return false;
        const int t = L / ntn; int e = 0;
#pragma unroll 1
        for (int k = 0; k < 32; ++k) e += (t >= tend[k]) ? 1 : 0;
        const int p0 = (t - (e ? tend[e - 1] : 0)) * BM, left = cnt[e] - p0;
        u.pm = t; u.pn = e * ntn + (L - t * ntn); u.inv0 = e * 8192 + p0; u.nvalid = left < BM ? left : BM; return true;
    }
    __device__ __forceinline__ void a_ready(const Unit&) const {}
    __device__ __forceinline__ void done(const Unit&) const {}
};
template <class Epi, class Sched, bool ALIGN_EPI = false, bool SP2 = false>
__device__ __forceinline__ void gemm_phase(PG8_LAS unsigned char* lds, const Gemm g, const Sched& S, const Epi& E) {
    const int tid = threadIdx.x, wid = __builtin_amdgcn_readfirstlane(tid >> 6), lane = tid & 63, wr = wid >> 2, wc = wid & 3, fr = lane & 15, fq = lane >> 4;
    const int K = g.K, nt = K / BK;
    unsigned voffA[2], voffB[2];
#pragma unroll
    for (int i = 0; i < 2; ++i) { int R, C; stage_rc(tid * 16 + i * 8192, R, C); const int Rb = Epi::PERM ? ((R & ~31) + perm32(R & 31)) : R;
        voffA[i] = (unsigned)(R * g.lda + C) * 2u; voffB[i] = (unsigned)(Rb * g.ldb + C) * 2u; }
    const size_t kstep = (size_t)(BK * 2);
    const size_t hstepA = (size_t)HALF * g.lda * 2, hstepB = (size_t)HALF * g.ldb * 2;
    const size_t tstepA = 2 * hstepA, tstepB = 2 * hstepB;
    const unsigned ldsw = (unsigned)wid * 1024u;
    const int aoff = lds_byte(wr * 64 + fr, fq * 8), boff = lds_byte(wc * 32 + fr, fq * 8);
#define PG8_SA(b, h) (((b) * 2 + (h)) * HTB)
#define PG8_SB(b, h) ((4 + (b) * 2 + (h)) * HTB)
#define PG8_STAGE(bufoff, gbase, voff) do { _Pragma("unroll") for (int _i = 0; _i < 2; ++_i) \
        __builtin_amdgcn_global_load_lds((const unsigned*)((const char*)(gbase) + (voff)[_i]), (PG8_LAS unsigned*)(lds + (bufoff) + ldsw + _i * 8192), 16, 0, 0); } while (0)
#define PG8_LDA(dst, b, h) do { _Pragma("unroll") for (int m = 0; m < 4; ++m) _Pragma("unroll") for (int k = 0; k < 2; ++k) dst[m][k] = *(const PG8_LAS bf16x8*)(lds + PG8_SA(b, h) + aoff + m * 2048 + k * 1024); } while (0)
#define PG8_LDB(dst, b, h) do { _Pragma("unroll") for (int n = 0; n < 2; ++n) _Pragma("unroll") for (int k = 0; k < 2; ++k) dst[n][k] = *(const PG8_LAS bf16x8*)(lds + PG8_SB(b, h) + boff + n * 2048 + k * 1024); } while (0)
#define PG8_MMA(ai, bj, At, Bt) do { __builtin_amdgcn_s_setprio(1); _Pragma("unroll") for (int m = 0; m < 4; ++m) _Pragma("unroll") for (int n = 0; n < 2; ++n) _Pragma("unroll") for (int k = 0; k < 2; ++k) \
        acc[ai][bj][m][n] = __builtin_amdgcn_mfma_f32_16x16x32_bf16(Bt[n][k], At[m][k], acc[ai][bj][m][n], 0, 0, 0); __builtin_amdgcn_s_setprio(0); } while (0)
#define PG8_WAIT_V(n) asm volatile("s_waitcnt vmcnt(" #n ")" ::: "memory")
#define PG8_WAIT_L(n) asm volatile("s_waitcnt lgkmcnt(" #n ")" ::: "memory")
#define PG8_BAR __builtin_amdgcn_s_barrier()
#define PG8_SCHED __builtin_amdgcn_sched_barrier(0)
    Unit cur, nxt; int ui = 0;
    if (!S.next(0, cur)) return;
    f32x4 acc[2][2][4][2];
#pragma unroll
    for (int a = 0; a < 2; ++a)
#pragma unroll
        for (int b = 0; b < 2; ++b)
#pragma unroll
            for (int m = 0; m < 4; ++m)
#pragma unroll
                for (int n = 0; n < 2; ++n) acc[a][b][m][n] = (f32x4){0.f, 0.f, 0.f, 0.f};
    bf16x8 At[4][2], B0[2][2], B1[2][2];
    const char* cA = (const char*)g.A + (size_t)cur.pm * tstepA; const char* cB = (const char*)g.Bt + (size_t)cur.pn * tstepB;
    S.a_ready(cur);
    if constexpr (SP2) {
        PG8_STAGE(PG8_SB(0, 0), cB, voffB); PG8_STAGE(PG8_SB(0, 1), cB + hstepB, voffB); PG8_STAGE(PG8_SA(0, 0), cA, voffA); PG8_STAGE(PG8_SA(0, 1), cA + hstepA, voffA);
        if (wr == 1) PG8_BAR;
        PG8_WAIT_V(2); PG8_BAR;
        PG8_STAGE(PG8_SB(1, 0), cB + kstep, voffB); PG8_STAGE(PG8_SA(1, 0), cA + kstep, voffA); PG8_STAGE(PG8_SB(1, 1), cB + hstepB + kstep, voffB);
        PG8_WAIT_V(6); PG8_BAR;
    } else {
        PG8_STAGE(PG8_SB(0, 0), cB, voffB); PG8_STAGE(PG8_SA(0, 0), cA, voffA); PG8_STAGE(PG8_SB(0, 1), cB + hstepB, voffB); PG8_STAGE(PG8_SA(0, 1), cA + hstepA, voffA);
        if (wr == 1) PG8_BAR;
        PG8_WAIT_V(4); PG8_BAR;
        PG8_STAGE(PG8_SB(1, 0), cB + kstep, voffB); PG8_STAGE(PG8_SA(1, 0), cA + kstep, voffA); PG8_STAGE(PG8_SB(1, 1), cB + hstepB + kstep, voffB);
        PG8_WAIT_V(6); PG8_BAR;
    }
    for (;;) {
        const bool has_next = S.next(ui + 1, nxt);
        const char* nA = has_next ? (const char*)g.A + (size_t)nxt.pm * tstepA : cA; const char* nB = has_next ? (const char*)g.Bt + (size_t)nxt.pn * tstepB : cB;
        for (int t = 0; t < nt; t += 2) {
            const bool last = (t == nt - 2);
            const char* a1 = cA + (size_t)(t + 1) * kstep;
            const char* a2 = last ? nA : cA + (size_t)(t + 2) * kstep; const char* b2 = last ? nB : cB + (size_t)(t + 2) * kstep;
            const char* a3 = a2 + kstep; const char* b3 = b2 + kstep;
            if (last && has_next) S.a_ready(nxt);
            if constexpr (SP2) {
            PG8_LDB(B0, 0, 0); PG8_LDB(B1, 0, 1); PG8_SCHED; PG8_LDA(At, 0, 0); PG8_STAGE(PG8_SA(1, 1), a1 + hstepA, voffA);
            PG8_WAIT_V(8); PG8_WAIT_L(0); PG8_BAR; PG8_MMA(0, 0, At, B0); PG8_MMA(0, 1, At, B1); PG8_BAR; PG8_SCHED;
            PG8_LDA(At, 0, 1); PG8_STAGE(PG8_SB(0, 0), b2, voffB); PG8_STAGE(PG8_SB(0, 1), b2 + hstepB, voffB); PG8_STAGE(PG8_SA(0, 0), a2, voffA);
            PG8_WAIT_V(8); PG8_WAIT_L(0); PG8_BAR; PG8_MMA(1, 0, At, B0); PG8_MMA(1, 1, At, B1); PG8_BAR; PG8_SCHED;
            PG8_LDB(B0, 1, 0); PG8_LDB(B1, 1, 1); PG8_SCHED; PG8_LDA(At, 1, 0); PG8_STAGE(PG8_SA(0, 1), a2 + hstepA, voffA);
            PG8_WAIT_V(8); PG8_WAIT_L(0); PG8_BAR; PG8_MMA(0, 0, At, B0); PG8_MMA(0, 1, At, B1); PG8_BAR; PG8_SCHED;
            PG8_LDA(At, 1, 1); PG8_STAGE(PG8_SB(1, 0), b3, voffB); PG8_STAGE(PG8_SB(1, 1), b3 + hstepB, voffB); PG8_STAGE(PG8_SA(1, 0), a3, voffA);
            PG8_WAIT_V(8); PG8_WAIT_L(0); PG8_BAR; PG8_MMA(1, 0, At, B0); PG8_MMA(1, 1, At, B1); PG8_BAR; PG8_SCHED;
            } else {
            PG8_LDB(B0, 0, 0); PG8_SCHED; PG8_LDA(At, 0, 0); PG8_STAGE(PG8_SA(1, 1), a1 + hstepA, voffA);
            PG8_WAIT_L(8); PG8_BAR; PG8_WAIT_L(0); PG8_MMA(0, 0, At, B0); PG8_BAR; PG8_SCHED;
            PG8_LDB(B1, 0, 1); PG8_STAGE(PG8_SB(0, 0), b2, voffB);
            PG8_BAR; PG8_WAIT_L(0); PG8_MMA(0, 1, At, B1); PG8_BAR;
            PG8_LDA(At, 0, 1); PG8_STAGE(PG8_SA(0, 0), a2, voffA);
            PG8_BAR; PG8_WAIT_L(0); PG8_MMA(1, 0, At, B0); PG8_BAR; PG8_SCHED;
            PG8_STAGE(PG8_SB(0, 1), b2 + hstepB, voffB);
            PG8_WAIT_V(6); PG8_BAR; PG8_MMA(1, 1, At, B1); PG8_BAR;
            PG8_LDB(B0, 1, 0); PG8_SCHED; PG8_LDA(At, 1, 0); PG8_STAGE(PG8_SA(0, 1), a2 + hstepA, voffA);
            PG8_WAIT_L(8); PG8_BAR; PG8_WAIT_L(0); PG8_MMA(0, 0, At, B0); PG8_BAR; PG8_SCHED;
            PG8_LDB(B1, 1, 1); PG8_STAGE(PG8_SB(1, 0), b3, voffB);
            PG8_BAR; PG8_WAIT_L(0); PG8_MMA(0, 1, At, B1); PG8_BAR;
            PG8_LDA(At, 1, 1); PG8_STAGE(PG8_SA(1, 0), a3, voffA);
            PG8_BAR; PG8_WAIT_L(0); PG8_MMA(1, 0, At, B0); PG8_BAR; PG8_SCHED;
            PG8_STAGE(PG8_SB(1, 1), b3 + hstepB, voffB);
            PG8_WAIT_V(6); PG8_BAR; PG8_MMA(1, 1, At, B1); PG8_BAR;
            }
        }
        if constexpr (ALIGN_EPI) { if (wr == 0) PG8_BAR; }
        if constexpr (!Epi::AFTER_DRAIN) { E(acc, cur, wr, wc, fr, fq); S.done(cur); }
        if (!has_next) break;
#pragma unroll
        for (int a = 0; a < 2; ++a)
#pragma unroll
            for (int b = 0; b < 2; ++b)
#pragma unroll
                for (int m = 0; m < 4; ++m)
#pragma unroll
                    for (int n = 0; n < 2; ++n) acc[a][b][m][n] = (f32x4){0.f, 0.f, 0.f, 0.f};
        cur = nxt; cA = nA; cB = nB; ++ui;
        if constexpr (ALIGN_EPI) { if (wr == 1) PG8_BAR; }
    }
    PG8_WAIT_V(0);
    if constexpr (!ALIGN_EPI) { if (wr == 0) PG8_BAR; }
    PG8_BAR;
    if constexpr (Epi::AFTER_DRAIN) { E.fused(acc, cur, wr, wc, fr, fq, lds, wid, lane); S.done(cur); }
#undef PG8_SA
#undef PG8_SB
#undef PG8_STAGE
#undef PG8_LDA
#undef PG8_LDB
#undef PG8_MMA
#undef PG8_WAIT_V
#undef PG8_WAIT_L
#undef PG8_BAR
#undef PG8_SCHED
}
template <class Epi, class Sched>
__device__ __forceinline__ void gemm_phase_g(PG8_LAS unsigned char* lds, const Gemm g, const Sched& S, const Epi& E, const int* inv) {
    constexpr bool ALIGN_EPI = true;
    const int tid = threadIdx.x, wid = __builtin_amdgcn_readfirstlane(tid >> 6), lane = tid & 63, wr = wid >> 2, wc = wid & 3, fr = lane & 15, fq = lane >> 4;
    const int K = g.K, nt = K / BK;
    unsigned voffA[2], voffB[2];
#pragma unroll
    for (int i = 0; i < 2; ++i) { int R, C; stage_rc(tid * 16 + i * 8192, R, C); const int Rb = Epi::PERM ? ((R & ~31) + perm32(R & 31)) : R;
        voffA[i] = (unsigned)(R * g.lda + C) * 2u; voffB[i] = (unsigned)(Rb * g.ldb + C) * 2u; }
    const size_t kstep = (size_t)(BK * 2);
    const size_t hstepA = (size_t)HALF * g.lda * 2, hstepB = (size_t)HALF * g.ldb * 2;
    const size_t tstepA = 2 * hstepA, tstepB = 2 * hstepB;
    const unsigned ldsw = (unsigned)wid * 1024u;
    const int aoff = lds_byte(wr * 64 + fr, fq * 8), boff = lds_byte(wc * 32 + fr, fq * 8);
#define PG8_SA(b, h) (((b) * 2 + (h)) * HTB)
#define PG8_SB(b, h) ((4 + (b) * 2 + (h)) * HTB)
#define PG8_STAGE(bufoff, gbase, voff) do { _Pragma("unroll") for (int _i = 0; _i < 2; ++_i) \
        __builtin_amdgcn_global_load_lds((const unsigned*)((const char*)(gbase) + (voff)[_i]), (PG8_LAS unsigned*)(lds + (bufoff) + ldsw + _i * 8192), 16, 0, 0); } while (0)
#define PG8_LDA(dst, b, h) do { _Pragma("unroll") for (int m = 0; m < 4; ++m) _Pragma("unroll") for (int k = 0; k < 2; ++k) dst[m][k] = *(const PG8_LAS bf16x8*)(lds + PG8_SA(b, h) + aoff + m * 2048 + k * 1024); } while (0)
#define PG8_LDB(dst, b, h) do { _Pragma("unroll") for (int n = 0; n < 2; ++n) _Pragma("unroll") for (int k = 0; k < 2; ++k) dst[n][k] = *(const PG8_LAS bf16x8*)(lds + PG8_SB(b, h) + boff + n * 2048 + k * 1024); } while (0)
#define PG8_MMA(ai, bj, At, Bt) do { __builtin_amdgcn_s_setprio(1); _Pragma("unroll") for (int m = 0; m < 4; ++m) _Pragma("unroll") for (int n = 0; n < 2; ++n) _Pragma("unroll") for (int k = 0; k < 2; ++k) \
        acc[ai][bj][m][n] = __builtin_amdgcn_mfma_f32_16x16x32_bf16(Bt[n][k], At[m][k], acc[ai][bj][m][n], 0, 0, 0); __builtin_amdgcn_s_setprio(0); } while (0)
#define PG8_WAIT_V(n) asm volatile("s_waitcnt vmcnt(" #n ")" ::: "memory")
#define PG8_WAIT_L(n) asm volatile("s_waitcnt lgkmcnt(" #n ")" ::: "memory")
#define PG8_BAR __builtin_amdgcn_s_barrier()
#define PG8_SCHED __builtin_amdgcn_sched_barrier(0)
    Unit cur, nxt; int ui = 0;
    if (!S.next(0, cur)) return;
    f32x4 acc[2][2][4][2];
#pragma unroll
    for (int a = 0; a < 2; ++a)
#pragma unroll
        for (int b = 0; b < 2; ++b)
#pragma unroll
            for (int m = 0; m < 4; ++m)
#pragma unroll
                for (int n = 0; n < 2; ++n) acc[a][b][m][n] = (f32x4){0.f, 0.f, 0.f, 0.f};
    bf16x8 At[4][2], B0[2][2], B1[2][2];
    const char* cA = (const char*)g.A; const char* cB = (const char*)g.Bt + (size_t)cur.pn * tstepB;
    S.a_ready(cur);
    unsigned vc[2][2], vn[2][2];
#define PG8_ROWS(u_, vo_) do { _Pragma("unroll") for (int h_ = 0; h_ < 2; ++h_) _Pragma("unroll") for (int i_ = 0; i_ < 2; ++i_) { int R_, C_; stage_rc(tid * 16 + i_ * 8192, R_, C_); const int r_ = h_ * HALF + R_; \
        const int tok_ = r_ < (u_).nvalid ? inv[(u_).inv0 + r_] : 0; vo_[h_][i_] = (unsigned)(tok_ * g.lda + C_) * 2u; } } while (0)
    PG8_ROWS(cur, vc);
    {
        PG8_STAGE(PG8_SB(0, 0), cB, voffB); PG8_STAGE(PG8_SB(0, 1), cB + hstepB, voffB); PG8_STAGE(PG8_SA(0, 0), cA, vc[0]); PG8_STAGE(PG8_SA(0, 1), cA, vc[1]);
        if (wr == 1) PG8_BAR;
        PG8_WAIT_V(2); PG8_BAR;
        PG8_STAGE(PG8_SB(1, 0), cB + kstep, voffB); PG8_STAGE(PG8_SA(1, 0), cA + kstep, vc[0]); PG8_STAGE(PG8_SB(1, 1), cB + hstepB + kstep, voffB);
        PG8_WAIT_V(6); PG8_BAR;
    }
    for (;;) {
        const bool has_next = S.next(ui + 1, nxt);
        if (has_next) { PG8_ROWS(nxt, vn); } else {
#pragma unroll
            for (int h_ = 0; h_ < 2; ++h_) { vn[h_][0] = vc[h_][0]; vn[h_][1] = vc[h_][1]; } }
        const char* nA = cA; const char* nB = has_next ? (const char*)g.Bt + (size_t)nxt.pn * tstepB : cB;
        for (int t = 0; t < nt; t += 2) {
            const bool last = (t == nt - 2);
            unsigned v2[2][2];
#pragma unroll
            for (int h_ = 0; h_ < 2; ++h_) { v2[h_][0] = last ? vn[h_][0] : vc[h_][0]; v2[h_][1] = last ? vn[h_][1] : vc[h_][1]; }
            const char* a1 = cA + (size_t)(t + 1) * kstep;
            const char* a2 = last ? nA : cA + (size_t)(t + 2) * kstep; const char* b2 = last ? nB : cB + (size_t)(t + 2) * kstep;
            const char* a3 = a2 + kstep; const char* b3 = b2 + kstep;
            if (last && has_next) S.a_ready(nxt);
            {
            PG8_LDB(B0, 0, 0); PG8_LDB(B1, 0, 1); PG8_SCHED; PG8_LDA(At, 0, 0); PG8_STAGE(PG8_SA(1, 1), a1, vc[1]);
            PG8_WAIT_V(8); PG8_WAIT_L(0); PG8_BAR; PG8_MMA(0, 0, At, B0); PG8_MMA(0, 1, At, B1); PG8_BAR; PG8_SCHED;
            PG8_LDA(At, 0, 1); PG8_STAGE(PG8_SB(0, 0), b2, voffB); PG8_STAGE(PG8_SB(0, 1), b2 + hstepB, voffB); PG8_STAGE(PG8_SA(0, 0), a2, v2[0]);
            PG8_WAIT_V(8); PG8_WAIT_L(0); PG8_BAR; PG8_MMA(1, 0, At, B0); PG8_MMA(1, 1, At, B1); PG8_BAR; PG8_SCHED;
            PG8_LDB(B0, 1, 0); PG8_LDB(B1, 1, 1); PG8_SCHED; PG8_LDA(At, 1, 0); PG8_STAGE(PG8_SA(0, 1), a2, v2[1]);
            PG8_WAIT_V(8); PG8_WAIT_L(0); PG8_BAR; PG8_MMA(0, 0, At, B0); PG8_MMA(0, 1, At, B1); PG8_BAR; PG8_SCHED;
            PG8_LDA(At, 1, 1); PG8_STAGE(PG8_SB(1, 0), b3, voffB); PG8_STAGE(PG8_SB(1, 1), b3 + hstepB, voffB); PG8_STAGE(PG8_SA(1, 0), a3, v2[0]);
            PG8_WAIT_V(8); PG8_WAIT_L(0); PG8_BAR; PG8_MMA(1, 0, At, B0); PG8_MMA(1, 1, At, B1); PG8_BAR; PG8_SCHED;
            }
        }
        if constexpr (ALIGN_EPI) { if (wr == 0) PG8_BAR; }
        if constexpr (!Epi::AFTER_DRAIN) { E(acc, cur, wr, wc, fr, fq); S.done(cur); }
        if (!has_next) break;
#pragma unroll
        for (int a = 0; a < 2; ++a)
#pragma unroll
            for (int b = 0; b < 2; ++b)
#pragma unroll
                for (int m = 0; m < 4; ++m)
#pragma unroll
                    for (int n = 0; n < 2; ++n) acc[a][b][m][n] = (f32x4){0.f, 0.f, 0.f, 0.f};
        cur = nxt; cA = nA; cB = nB; ++ui;
#pragma unroll
        for (int h_ = 0; h_ < 2; ++h_) { vc[h_][0] = vn[h_][0]; vc[h_][1] = vn[h_][1]; }
        if constexpr (ALIGN_EPI) { if (wr == 1) PG8_BAR; }
    }
    PG8_WAIT_V(0);
    if constexpr (!ALIGN_EPI) { if (wr == 0) PG8_BAR; }
    PG8_BAR;
    if constexpr (Epi::AFTER_DRAIN) { E.fused(acc, cur, wr, wc, fr, fq, lds, wid, lane); S.done(cur); }
#undef PG8_ROWS
#undef PG8_SA
#undef PG8_SB
#undef PG8_STAGE
#undef PG8_LDA
#undef PG8_LDB
#undef PG8_MMA
#undef PG8_WAIT_V
#undef PG8_WAIT_L
#undef PG8_BAR
#undef PG8_SCHED
}
}
constexpr int BATCH = 2, SEQ = 4096, DM = 2048, MTOK = BATCH * SEQ;
constexpr int NE0 = 6168, NE1 = 4176;
constexpr int NP0 = 6144, NP1 = 4096;
constexpr float LN_EPS = 1e-5f;
constexpr float DN_ALPHA = 1.41421356237309515f;
constexpr float ATT_SCALE = 0.08838834764831845f;
constexpr int RPAD = 24576;
constexpr size_t MiB = 1u << 20;
constexpr size_t WS_CTL = 0, CTL_ZERO_BYTES = 1 * MiB;
constexpr size_t WS_ROPE = 1 * MiB;
constexpr size_t WS_WSM = 4 * MiB;
constexpr size_t WS_SK0 = 6 * MiB;
constexpr size_t WS_IK = 7 * MiB;
constexpr size_t WS_IW = 8 * MiB + 512 * 1024;
constexpr size_t WS_FBIAS = 10 * MiB;
constexpr size_t WS_ROUTE = 11 * MiB;
constexpr size_t WS_MASK = 12 * MiB;
constexpr size_t WS_WINA = 16 * MiB, WS_WOA = 40 * MiB, WS_WINC = 48 * MiB, WS_WOC = 64 * MiB;
constexpr size_t WS_WGU = 72 * MiB;
constexpr size_t WS_WD = 328 * MiB;
constexpr size_t WS_XB = 456 * MiB;
constexpr size_t WS_YB = 488 * MiB;
constexpr size_t WS_PROJ = 552 * MiB;
constexpr size_t WS_CST = 648 * MiB;
constexpr size_t WS_PREVT = 712 * MiB;
constexpr size_t WS_OMIX = 744 * MiB;
constexpr size_t WS_GB = 776 * MiB;
constexpr size_t WS_DEC = 792 * MiB;
constexpr size_t WS_ROWW = 793 * MiB;
constexpr size_t WS_SC = 800 * MiB;
constexpr size_t WS_INV = 800 * MiB;
constexpr size_t WS_WINV = 801 * MiB;
constexpr size_t WS_END = 928 * MiB;
constexpr int CW_CNT = 1024;
constexpr int CW_FILL = 2048;
constexpr int CW_BAR = 4096;

#define GAS __attribute__((address_space(1)))
#define LAS __attribute__((address_space(3)))
typedef unsigned short bf16;
typedef unsigned v4u __attribute__((ext_vector_type(4)));
typedef unsigned v2u __attribute__((ext_vector_type(2)));
typedef float f32x4 __attribute__((ext_vector_type(4)));
typedef short bf16x8 __attribute__((ext_vector_type(8)));
#define LDS_WAIT() asm volatile("s_waitcnt lgkmcnt(0)" ::: "memory")
#define VM_WAIT() asm volatile("s_waitcnt vmcnt(0)" ::: "memory")
__device__ __forceinline__ unsigned f2bf(float f) { unsigned u = __builtin_bit_cast(unsigned, f); return (u + 0x7fffu + ((u >> 16) & 1u)) >> 16; }
__device__ __forceinline__ unsigned pk2(float lo, float hi) { return f2bf(lo) | (f2bf(hi) << 16); }
__device__ __forceinline__ float bf2f(unsigned short b) { return __builtin_bit_cast(float, ((unsigned)b) << 16); }
__device__ __forceinline__ float wave_sum(float v) {
#pragma unroll
    for (int o = 1; o < 64; o <<= 1) v += __shfl_xor(v, o);
    return v;
}
__device__ __forceinline__ float logsigmoidf(float z) { return fminf(z, 0.f) - log1pf(__expf(-fabsf(z))); }
#define XB_TMO      128
#define XB_XCNT(j)  (256  + 64 * (j))
#define XB_XSUB(j)  (1280 + 64 * (j))
#define XB_XGEN(j)  (2304 + 64 * (j))
#define XB_TOP      3328
#define XB_TOPGEN   3392
#define XCD_BAR_WORDS 3456
#define XB_SPIN_CAP (1u << 21)

__device__ __forceinline__ unsigned xb_ld(unsigned* p)              { return __hip_atomic_load(p, __ATOMIC_RELAXED, __HIP_MEMORY_SCOPE_AGENT); }
__device__ __forceinline__ unsigned xb_add(unsigned* p, unsigned v) { return __hip_atomic_fetch_add(p, v, __ATOMIC_RELAXED, __HIP_MEMORY_SCOPE_AGENT); }
__device__ __forceinline__ unsigned xb_xcc_id() { return (unsigned)__builtin_amdgcn_s_getreg((3 << 11) | 20) & 0xFu; }
#define XB_SPIN(cond, bar) do { unsigned _sp = 0; while (cond) { __builtin_amdgcn_s_sleep(1); \
    if ((++_sp & 255u) == 0u) { if (xb_ld(&(bar)[XB_TMO])) break; if (_sp > XB_SPIN_CAP) { atomicAdd(&(bar)[XB_TMO], 1u); break; } } } } while (0)

struct XcdBarrier {
    unsigned* bar; unsigned x;
    volatile LAS unsigned* st;
};

__device__ __forceinline__ XcdBarrier xcd_barrier_post(unsigned* bar, volatile LAS unsigned* st) {
    XcdBarrier b; b.bar = bar; b.x = xb_xcc_id(); b.st = st;
    if (threadIdx.x == 0) (void)xb_add(&bar[XB_XCNT(b.x)], 1u);
    return b;
}
__device__ __forceinline__ void xcd_barrier_complete(unsigned* bar, unsigned x, unsigned& nloc, unsigned& nx) {
    const unsigned G = gridDim.x * gridDim.y * gridDim.z;
    unsigned sum, cnt, mine, sp = 0u;
    for (;;) {
        sum = 0u; cnt = 0u; mine = 0u;
#pragma unroll
        for (unsigned j = 0; j < 16; ++j) { const unsigned c = xb_ld(&bar[XB_XCNT(j)]); sum += c; cnt += (c > 0u) ? 1u : 0u; mine = (j == x) ? c : mine; }
        if (sum == G) break;
        __builtin_amdgcn_s_sleep(1);
        if ((++sp & 255u) == 0u) { if (xb_ld(&bar[XB_TMO])) break; if (sp > XB_SPIN_CAP) { atomicAdd(&bar[XB_TMO], 1u); break; } }
    }
    nloc = mine > 0u ? mine : 1u; nx = cnt > 0u ? cnt : 1u;
}

__device__ __forceinline__ void xcd_barrier(const XcdBarrier& b) {
    asm volatile("s_waitcnt vmcnt(0)" ::: "memory");
    __syncthreads();
    if (threadIdx.x == 0) {
        unsigned* bar = b.bar;
        __builtin_amdgcn_s_waitcnt(0);
        unsigned nloc = b.st[0], nx = b.st[1];
        if (nloc == 0u) { xcd_barrier_complete(bar, b.x, nloc, nx); b.st[0] = nloc; b.st[1] = nx; }
        const unsigned old = xb_add(&bar[XB_XSUB(b.x)], 1u);
        const unsigned gen = old / nloc;
        if (old + 1u == (gen + 1u) * nloc) {
            __builtin_amdgcn_fence(__ATOMIC_RELEASE, "agent");
            asm volatile("s_waitcnt vmcnt(0)" ::: "memory");
            const unsigned og = xb_add(&bar[XB_TOP], 1u);
            const unsigned tg = og / nx;
            if (og + 1u == (tg + 1u) * nx) xb_add(&bar[XB_TOPGEN], 1u);
            else XB_SPIN(xb_ld(&bar[XB_TOPGEN]) == tg, bar);
            __builtin_amdgcn_fence(__ATOMIC_ACQUIRE, "agent");
            xb_add(&bar[XB_XGEN(b.x)], 1u);
            asm volatile("s_waitcnt vmcnt(0)" ::: "memory");
        } else {
            XB_SPIN(xb_ld(&bar[XB_XGEN(b.x)]) == gen, bar);
            __builtin_amdgcn_fence(__ATOMIC_ACQUIRE, "agent");
            asm volatile("s_waitcnt vmcnt(0)" ::: "memory");
        }
    }
    __syncthreads();
}

constexpr int NWAVES = 8;
constexpr int RING_BYTES = 131072;
constexpr int LDSCTL_OFF = RING_BYTES;
constexpr int LDS_BYTES = 147456;
struct Frame {
    LAS unsigned char* lds; volatile LAS unsigned* MISC; unsigned* ctl;
    int tid, lane, wave, G, gw, NGW;
    unsigned char* ws;
};
struct Args { const float* in[20]; float* out; unsigned char* ws; int ph_lo, ph_hi, bar_region, pad; };

struct TrItem { const float* W; bf16* WT; int ldw, c0, c1, K, n0, k0; };
__device__ __forceinline__ void tr64_load(const TrItem& t, f32x4 (&r)[16], int lane) {
    const int nq = lane & 15, kr = lane >> 4;
    const float* src = t.W + (size_t)(t.k0 + 2 * kr) * t.ldw + (nq < 8 ? t.c0 : t.c1 - 32) + 4 * nq;
#pragma unroll
    for (int i = 0; i < 8; ++i) { r[2 * i] = __builtin_nontemporal_load((const f32x4*)(src + (size_t)(8 * i) * t.ldw)); r[2 * i + 1] = __builtin_nontemporal_load((const f32x4*)(src + (size_t)(8 * i + 1) * t.ldw)); }
}
__device__ __forceinline__ void tr64_store(const TrItem& t, const f32x4 (&r)[16], LAS bf16* T, int lane) {
    const int nq = lane & 15, kr = lane >> 4;
#pragma unroll
    for (int i = 0; i < 8; ++i) { const int kk = 8 * i + 2 * kr;
#pragma unroll
        for (int e = 0; e < 4; ++e) *(LAS unsigned*)(T + (4 * nq + e) * 68 + kk) = pg8::cvt_pk_bf16(r[2 * i][e], r[2 * i + 1][e]); }
    LDS_WAIT(); asm volatile("" ::: "memory");
    const int c = lane & 7;
#pragma unroll
    for (int j = 0; j < 8; ++j) { const int n = (lane >> 3) + 8 * j; const v2u lo = *(const LAS v2u*)(T + n * 68 + 8 * c), hi = *(const LAS v2u*)(T + n * 68 + 8 * c + 4);
        v4u o; o.x = lo.x; o.y = lo.y; o.z = hi.x; o.w = hi.y;
        *(v4u*)(t.WT + (size_t)(t.n0 + n) * t.K + t.k0 + 8 * c) = o; }
    LDS_WAIT(); asm volatile("" ::: "memory");
}
__device__ __forceinline__ void transpose_item64(const float* W, int ldw, int c0, int c1, int K, bf16* WT, int n0, int k0, LAS bf16* T, int lane) {
    const TrItem t{W, WT, ldw, c0, c1, K, n0, k0}; f32x4 r[16]; tr64_load(t, r, lane); tr64_store(t, r, T, lane);
}
__device__ __forceinline__ int l1_src_col(int n) {
    const int pn = n >> 8, j = n & 255, jh = j & 127, second = j >> 7;
    if (pn == 10 || pn == 11) return n;
    if (pn < 10) return pn * 256 + (jh >> 6) * 128 + second * 64 + (jh & 63);
    return 3072 + ((pn - 12) * 4 + (jh >> 5)) * 64 + second * 32 + (jh & 31);
}
constexpr int SK_ROUTE0 = 0, SK_ROUTE1 = 48, SK_SK0 = 96, SK_SK1 = 128, SK_NCOL = 208;
constexpr int SK_PART_OFF = 0, SK_LG_OFF = 65536;
template <int NT> __device__ __forceinline__ void skinny_partials(LAS unsigned char* ldsb, const bf16* X, const bf16* WH, const bf16* WL, int w, int lane) {
    const int tile = w >> 2, kq = w & 3, l15 = lane & 15, quad = lane >> 4;
    const bf16* xp = X + (size_t)(16 * tile + l15) * DM + kq * 512 + quad * 8;
    const bf16* hp = WH + (size_t)l15 * 2048 + kq * 512 + quad * 8; const bf16* lp = WL + (size_t)l15 * 2048 + kq * 512 + quad * 8;
    pg8::f32x4 acc[NT];
#pragma unroll
    for (int n = 0; n < NT; ++n) acc[n] = (pg8::f32x4){0.f, 0.f, 0.f, 0.f};
#pragma unroll 2
    for (int ks = 0; ks < 16; ++ks) {
        const bf16x8 ah = *(const bf16x8*)(xp + 32 * ks);
#pragma unroll
        for (int n = 0; n < NT; ++n) { const bf16x8 bh = *(const bf16x8*)(hp + (size_t)n * 16 * 2048 + 32 * ks), bl = *(const bf16x8*)(lp + (size_t)n * 16 * 2048 + 32 * ks);
            acc[n] = __builtin_amdgcn_mfma_f32_16x16x32_bf16(ah, bh, acc[n], 0, 0, 0); acc[n] = __builtin_amdgcn_mfma_f32_16x16x32_bf16(ah, bl, acc[n], 0, 0, 0); }
    }
    LAS float* PART = (LAS float*)(ldsb + SK_PART_OFF);
#pragma unroll
    for (int n = 0; n < NT; ++n) *(LAS pg8::f32x4*)(PART + ((((tile * 4 + kq) * NT + n) * 64 + lane) * 4)) = acc[n];
}
template <int NT> __device__ __forceinline__ void skinny_reduce(LAS unsigned char* ldsb, int tid) {
    const LAS float* PART = (const LAS float*)(ldsb + SK_PART_OFF); LAS float* LG = (LAS float*)(ldsb + SK_LG_OFF);
    for (int idx = tid; idx < 32 * 16 * NT; idx += NWAVES * 64) { const int row = idx / (16 * NT), col = idx % (16 * NT), tile = row >> 4, rr = row & 15, ln = (rr >> 2) * 16 + (col & 15), n = col >> 4, j = rr & 3;
        float s = 0.f;
#pragma unroll
        for (int kq = 0; kq < 4; ++kq) s += PART[(((tile * 4 + kq) * NT + n) * 64 + ln) * 4 + j];
        LG[row * (16 * NT) + col] = s; }
}
__device__ __forceinline__ void ln_row(f32x4 (&v)[8], const float* g, const float* b, int lane) {
    float s = 0.f;
#pragma unroll
    for (int j = 0; j < 8; ++j) s += (v[j][0] + v[j][1]) + (v[j][2] + v[j][3]);
    const float mean = wave_sum(s) * (1.f / DM); float s2 = 0.f;
#pragma unroll
    for (int j = 0; j < 8; ++j) { v[j] = v[j] - mean; s2 += (v[j][0] * v[j][0] + v[j][1] * v[j][1]) + (v[j][2] * v[j][2] + v[j][3] * v[j][3]); }
    const float rstd = 1.f / sqrtf(wave_sum(s2) * (1.f / DM) + LN_EPS);
#pragma unroll
    for (int j = 0; j < 8; ++j) { const f32x4 gg = *(const f32x4*)(g + 256 * j + 4 * lane), bb = *(const f32x4*)(b + 256 * j + 4 * lane); v[j] = v[j] * rstd * gg + bb; }
}
__device__ __forceinline__ void load_row_bf16(const bf16* src, f32x4 (&v)[8], int lane) {
#pragma unroll
    for (int j = 0; j < 8; ++j) { const uint2 p = *(const uint2*)(src + 256 * j + 4 * lane); v[j][0] = bf2f(p.x & 0xffff); v[j][1] = bf2f(p.x >> 16); v[j][2] = bf2f(p.y & 0xffff); v[j][3] = bf2f(p.y >> 16); }
}
__device__ __forceinline__ void store_row_bf16(bf16* dst, const f32x4 (&v)[8], int lane) {
#pragma unroll
    for (int j = 0; j < 8; ++j) { uint2 o; o.x = pg8::cvt_pk_bf16(v[j][0], v[j][1]); o.y = pg8::cvt_pk_bf16(v[j][2], v[j][3]); *(uint2*)(dst + 256 * j + 4 * lane) = o; }
}
#define TK_FOR_VALID(...) _Pragma("unroll") for (int g_ = 0; g_ < 8; ++g_) { if (512 * g_ <= qpos) { _Pragma("unroll") for (int i = 8 * g_; i < 8 * g_ + 8; ++i) { __VA_ARGS__ } } }
__device__ __forceinline__ void topk_mask_row(const LAS float* sc, int qpos, unsigned long long* mrow, int lane, LAS unsigned* cbuf) {
    unsigned u[64];
#pragma unroll
    for (int i = 0; i < 64; ++i) { const int s = 64 * i + lane; const bool ok = s <= qpos; const float f = ok ? sc[s] : 0.f; const unsigned b = __builtin_bit_cast(unsigned, f);
        const unsigned key = b ^ ((b >> 31) ? 0xFFFFFFFFu : 0x80000000u); u[i] = ok ? key : 0u; }
    unsigned long long mword = 0ull;
    if (qpos + 1 <= 256) {
#pragma unroll
        for (int i = 0; i < 4; ++i) { const unsigned long long w = __ballot(64 * i + lane <= qpos); mword = (lane == i) ? w : mword; }
        mrow[lane] = mword; return;
    }
    const unsigned long long below = (1ull << lane) - 1ull;
    unsigned T = 0u;
#pragma unroll 1
    for (int bit = 31; bit >= 20; --bit) { const unsigned cand = T | (1u << bit); int cnt = 0;
        TK_FOR_VALID( cnt += __builtin_popcountll(__ballot(u[i] >= cand)); )
        if (cnt >= 256) T = cand; }
    const unsigned pre = T >> 20; int cgt = 0, nc = 0;
    TK_FOR_VALID( { const unsigned p_ = u[i] >> 20; const unsigned long long gm = __ballot(p_ > pre), em = __ballot(p_ == pre); cgt += __builtin_popcountll(gm);
        const int pos_ = nc + __builtin_popcountll(em & below); if (p_ == pre && pos_ < 256) cbuf[pos_] = u[i]; nc += __builtin_popcountll(em); } )
    int kneed = 256 - cgt;
    if (nc <= 256) {
        asm volatile("s_waitcnt lgkmcnt(0)" ::: "memory");
        unsigned c0 = lane < nc ? cbuf[lane] : 0u, c1 = 64 + lane < nc ? cbuf[64 + lane] : 0u, c2 = 128 + lane < nc ? cbuf[128 + lane] : 0u, c3 = 192 + lane < nc ? cbuf[192 + lane] : 0u;
#pragma unroll 1
        for (int bit = 19; bit >= 0; --bit) { const unsigned cand = T | (1u << bit);
            int cnt = __builtin_popcountll(__ballot(c0 >= cand));
            if (nc > 64) cnt += __builtin_popcountll(__ballot(c1 >= cand));
            if (nc > 128) cnt += __builtin_popcountll(__ballot(c2 >= cand)) + __builtin_popcountll(__ballot(c3 >= cand));
            if (cnt >= kneed) T = cand; }
        const int cg2 = __builtin_popcountll(__ballot(c0 > T)) + __builtin_popcountll(__ballot(c1 > T)) + __builtin_popcountll(__ballot(c2 > T)) + __builtin_popcountll(__ballot(c3 > T));
        kneed -= cg2;
    } else {
#pragma unroll 1
        for (int bit = 19; bit >= 0; --bit) { const unsigned cand = T | (1u << bit); int cnt = 0;
            TK_FOR_VALID( cnt += __builtin_popcountll(__ballot(u[i] >= cand)); )
            if (cnt >= 256) T = cand; }
        int cg2 = 0;
        TK_FOR_VALID( cg2 += __builtin_popcountll(__ballot(u[i] > T)); )
        kneed = 256 - cg2;
    }
    int run = 0;
#pragma unroll
    for (int i = 0; i < 64; ++i) { const bool gt = u[i] > T, eq = u[i] == T; const unsigned long long eqm = __ballot(eq);
        const int rank = run + __builtin_popcountll(eqm & below); const bool sel = gt || (eq && rank < kneed); run += __builtin_popcountll(eqm);
        const unsigned long long w = __ballot(sel); mword = (lane == i) ? w : mword; }
    mrow[lane] = mword;
}
#undef TK_FOR_VALID
constexpr int CONV_MOE_ITEMS = 32 * (32 * 16) + 32 * (8 * 32);
#ifndef CONV_STATIC_ITEMS
#define CONV_STATIC_ITEMS 0
#endif
constexpr int CONV_STATIC = CONV_STATIC_ITEMS;
constexpr int CONV_LATE_ITEMS = CONV_MOE_ITEMS + 32 * (NP1 / 64) + 32 * 32 + CONV_MOE_ITEMS;
__device__ __forceinline__ TrItem conv_moe_desc(const Args& a, unsigned char* ws, int layer, int it) {
    if (it < 32 * 512) {
        const int ex = layer * 32 + it / 512, r = it % 512, blk = r >> 5, jj = r & 31, kb = (blk >> 2) * 8 + (jj >> 2), nb = (blk & 3) * 4 + (jj & 3), n0 = nb * 64, tile = n0 >> 8, j = n0 & 255;
        const float* W = (j < 128 ? a.in[17] : a.in[18]) + (size_t)ex * 2048 * 512;
        return TrItem{W, (bf16*)(ws + WS_WGU) + (size_t)ex * 1024 * 2048, 512, 128 * tile + (j & 127), 128 * tile + (j & 127) + 32, 2048, n0, kb * 64};
    }
    const int i2 = it - 32 * 512, ex = layer * 32 + i2 / 256, r = i2 % 256, blk = r >> 5, jj = r & 31, kb = jj >> 2, nb = blk * 4 + (jj & 3);
    return TrItem{a.in[19] + (size_t)ex * 512 * 2048, (bf16*)(ws + WS_WD) + (size_t)ex * 2048 * 512, 2048, nb * 64, nb * 64 + 32, 512, nb * 64, kb * 64};
}
__device__ __forceinline__ TrItem conv_late_desc(const Args& a, unsigned char* ws, int it) {
    if (it < CONV_MOE_ITEMS) return conv_moe_desc(a, ws, 0, it);
    it -= CONV_MOE_ITEMS;
    if (it < 32 * (NP1 / 64)) { const int kb = it / (NP1 / 64), nb = it % (NP1 / 64), n0 = nb * 64;
        return TrItem{a.in[7], (bf16*)(ws + WS_WINC), NE1, l1_src_col(n0), l1_src_col(n0 + 32), 2048, n0, kb * 64}; }
    it -= 32 * (NP1 / 64);
    if (it < 32 * 32) { const int kb = it / 32, nb = it % 32; return TrItem{a.in[8], (bf16*)(ws + WS_WOC), 2048, nb * 64, nb * 64 + 32, 2048, nb * 64, kb * 64}; }
    return conv_moe_desc(a, ws, 1, it - 32 * 32);
}
__device__ __forceinline__ void late_conv_items(Frame& F, const Args& a) {
    constexpr int CHUNK = 32;
    LAS bf16* T = (LAS bf16*)(F.lds + F.wave * 16384); volatile LAS int* slot = (volatile LAS int*)(F.lds + 131072 + 512);
    for (;;) {
        __syncthreads();
        if (F.tid == 0) *slot = CONV_STATIC + (int)atomicAdd(F.ctl + CW_FILL, (unsigned)CHUNK);
        __syncthreads();
        const int base = *slot;
        if (base >= CONV_LATE_ITEMS) break;
        f32x4 rA[16], rB[16];
        TrItem t0 = conv_late_desc(a, F.ws, base + F.wave); tr64_load(t0, rA, F.lane);
        TrItem t1 = conv_late_desc(a, F.ws, base + F.wave + 8); tr64_load(t1, rB, F.lane);
        tr64_store(t0, rA, T, F.lane);
        t0 = conv_late_desc(a, F.ws, base + F.wave + 16); tr64_load(t0, rA, F.lane);
        tr64_store(t1, rB, T, F.lane);
        t1 = conv_late_desc(a, F.ws, base + F.wave + 24); tr64_load(t1, rB, F.lane);
        tr64_store(t0, rA, T, F.lane);
        tr64_store(t1, rB, T, F.lane);
    }
    __syncthreads();
}
static_assert(CONV_LATE_ITEMS % 32 == 0 && CONV_STATIC % 32 == 0 && CONV_STATIC <= CONV_LATE_ITEMS, "filler chunks");
__device__ __forceinline__ void p0_prologue(Frame& F, const Args& a) {
    const int gw = F.gw, NGW = F.NGW, lane = F.lane;
    unsigned char* ws = F.ws;
    LAS bf16* T = (LAS bf16*)(F.lds + F.wave * 16384);
    {
        const float* W = a.in[1]; bf16* WT = (bf16*)(ws + WS_WINA);
        for (int it = gw; it < 32 * (NP0 / 64); it += NGW) { const int kb = it / (NP0 / 64), nb = it % (NP0 / 64), n0 = nb * 64; const int c0 = n0 < 3072 ? n0 : n0 + 16; transpose_item64(W, NE0, c0, c0 + 32, 2048, WT, n0, kb * 64, T, lane); }
    }
    {
        for (int it = gw; it < 32 * 32; it += NGW) { const int kb = it / 32, nb = it % 32; transpose_item64(a.in[6], 2048, nb * 64, nb * 64 + 32, 2048, (bf16*)(ws + WS_WOA), nb * 64, kb * 64, T, lane); }
    }
    for (int it = gw; it < CONV_STATIC; it += NGW) { const TrItem t = conv_late_desc(a, ws, it); f32x4 r16[16]; tr64_load(t, r16, lane); tr64_store(t, r16, T, lane); }
    const int gt = blockIdx.x * (NWAVES * 64) + F.tid, NGT = F.G * NWAVES * 64;
    {   float* c128 = (float*)(ws + WS_ROPE); float* s128 = c128 + 4096 * 64; float* c64 = s128 + 4096 * 64; float* s64 = c64 + 4096 * 32;
        for (int i = gt; i < 4096 * 96; i += NGT) { int pos, idx, half; float* cp; float* sp;
            if (i < 4096 * 64) { pos = i >> 6; idx = i & 63; half = 64; cp = c128 + i; sp = s128 + i; } else { const int r = i - 4096 * 64; pos = r >> 5; idx = r & 31; half = 32; cp = c64 + r; sp = s64 + r; }
            const float inv = exp2f(-(float)idx / (float)half * 13.287712379549449f);
            const float ang = (float)pos * inv;
            double rv = (double)ang * 0.15915494309189535; rv -= rint(rv);
            const float rf = (float)rv;
            *cp = __builtin_amdgcn_cosf(rf); *sp = __builtin_amdgcn_sinf(rf); }
    }
    {   bf16* SKH = (bf16*)(ws + WS_WSM); bf16* SKL = SKH + (size_t)SK_NCOL * 2048;
        for (int i = gt; i < 2048 * SK_NCOL; i += NGT) { const int k = i / SK_NCOL, c = i % SK_NCOL; float v = 0.f;
            if (c < 96) { const int l = c / 48, j = c % 48; if (j < 4) v = a.in[13][((size_t)l * 2048 + k) * 4 + j]; else if (j < 36) { const int g = (j - 4) >> 3, e = (j - 4) & 7; v = a.in[15][(((size_t)l * 4 + g) * 2048 + k) * 8 + e]; } }
            else if (c < 128) { const int j = c - 96; if (j < 16) v = a.in[1][(size_t)k * NE0 + 3072 + j]; else if (j < 24) v = a.in[1][(size_t)k * NE0 + 6160 + j - 16]; }
            else v = a.in[7][(size_t)k * NE1 + 4096 + c - 128];
            const unsigned h = f2bf(v); SKH[(size_t)c * 2048 + k] = (bf16)h; SKL[(size_t)c * 2048 + k] = (bf16)f2bf(v - bf2f((unsigned short)h)); }
    }
    {   const float* x = a.in[0]; bf16* XB = (bf16*)(ws + WS_XB);
        for (int m = gw; m < MTOK; m += NGW) { f32x4 v[8];
#pragma unroll
            for (int j = 0; j < 8; ++j) v[j] = *(const f32x4*)(x + (size_t)m * DM + 256 * j + 4 * lane);
            store_row_bf16(XB + (size_t)m * DM, v, lane); }
    }
}
__device__ __forceinline__ void p_skinny0(Frame& F, const Args& a) {
    const bf16* SKH = (const bf16*)(F.ws + WS_WSM) + (size_t)SK_SK0 * 2048; const bf16* SKL = SKH + (size_t)SK_NCOL * 2048; float* SK0 = (float*)(F.ws + WS_SK0);
    const LAS float* LG = (const LAS float*)(F.lds + SK_LG_OFF);
    for (int blk = blockIdx.x; blk < MTOK / 32; blk += F.G) { const int R0 = blk * 32;
        __syncthreads();
        skinny_partials<2>(F.lds, (const bf16*)(F.ws + WS_XB) + (size_t)R0 * DM, SKH, SKL, F.wave, F.lane);
        __syncthreads();
        skinny_reduce<2>(F.lds, F.tid);
        __syncthreads();
        for (int idx = F.tid; idx < 32 * 24; idx += NWAVES * 64) { const int row = idx / 24, c = idx % 24; SK0[(size_t)(R0 + row) * 24 + c] = LG[row * 32 + c]; }
    }
    __syncthreads();
}
__device__ __forceinline__ void p_fox_bias(Frame& F, const Args& a) {
    if (blockIdx.x >= 16) return;
    const int bh = blockIdx.x, b = bh >> 3, h = bh & 7, lane = F.lane, tid = F.tid; const float gb = a.in[5][h];
    const float* SK0 = (const float*)(F.ws + WS_SK0); float* FB = (float*)(F.ws + WS_FBIAS) + (size_t)bh * SEQ; LAS float* wt = (LAS float*)(F.lds + 120000);
    float lf[8], tot = 0.f;
#pragma unroll
    for (int i = 0; i < 8; ++i) lf[i] = SK0[(size_t)(b * SEQ + tid * 8 + i) * 24 + 16 + h];
#pragma unroll
    for (int i = 0; i < 8; ++i) { tot += logsigmoidf(lf[i] + gb); lf[i] = tot; }
    float incl = tot;
#pragma unroll
    for (int o = 1; o < 64; o <<= 1) { const float t = __shfl_up(incl, o); if (lane >= o) incl += t; }
    if (lane == 63) wt[F.wave] = incl;
    __syncthreads();
    float pre = incl - tot;
    for (int w = 0; w < F.wave; ++w) pre += wt[w];
#pragma unroll
    for (int i = 0; i < 8; ++i) FB[tid * 8 + i] = -(pre + lf[i]) * (1.0f / ATT_SCALE);
    __syncthreads();
}
__device__ __forceinline__ void p_ln_route(Frame& F, const Args& a, int layer) {
    const bf16* YB = (const bf16*)(F.ws + WS_YB); bf16* XB = (bf16*)(F.ws + WS_XB); const int lane = F.lane;
    const float* g = a.in[9] + layer * DM; const float* bb = a.in[10] + layer * DM;
    const bf16* SKH = (const bf16*)(F.ws + WS_WSM) + (size_t)(layer ? SK_ROUTE1 : SK_ROUTE0) * 2048; const bf16* SKL = SKH + (size_t)SK_NCOL * 2048;
    const float* bg = a.in[14] + layer * 4; const float* be = a.in[16] + layer * 32;
    int4* ROUTE = (int4*)(F.ws + WS_ROUTE); unsigned* cnt = F.ctl + CW_CNT + layer * 64; int* INV = (int*)(F.ws + WS_INV); float* WINV = (float*)(F.ws + WS_WINV);
    const LAS float* LG = (const LAS float*)(F.lds + SK_LG_OFF);
    for (int blk = blockIdx.x; blk < MTOK / 32; blk += F.G) { const int R0 = blk * 32;
#pragma unroll 2
        for (int i = 0; i < 4; ++i) { const int m = R0 + 4 * F.wave + i; f32x4 v[8];
            load_row_bf16(YB + (size_t)m * DM, v, lane);
            ln_row(v, g, bb, lane);
            store_row_bf16(XB + (size_t)m * DM, v, lane); }
        __syncthreads();
        skinny_partials<3>(F.lds, XB + (size_t)R0 * DM, SKH, SKL, F.wave, lane);
        __syncthreads();
        skinny_reduce<3>(F.lds, F.tid);
        __syncthreads();
        if (F.tid < 32) { const int m = R0 + F.tid; const LAS float* l = LG + F.tid * 48;
            float gl[4];
#pragma unroll
            for (int i = 0; i < 4; ++i) gl[i] = l[i] + bg[i];
            int gi = 0; float gm = gl[0];
#pragma unroll
            for (int i = 1; i < 4; ++i) if (gl[i] > gm) { gm = gl[i]; gi = i; }
            float gs = 0.f;
#pragma unroll
            for (int i = 0; i < 4; ++i) gs += __expf(gl[i] - gm);
            const float gp = 1.0f / gs;
            float el[8];
#pragma unroll
            for (int e = 0; e < 8; ++e) el[e] = l[4 + 8 * gi + e] + be[gi * 8 + e];
            int e1 = 0; float v1 = el[0];
#pragma unroll
            for (int e = 1; e < 8; ++e) if (el[e] > v1) { v1 = el[e]; e1 = e; }
            int e2 = -1; float v2 = -3.0e38f;
#pragma unroll
            for (int e = 0; e < 8; ++e) if (e != e1 && el[e] > v2) { v2 = el[e]; e2 = e; }
            const float w1 = gp / (1.0f + __expf(v2 - v1)), w2 = gp - w1;
            const int ge1 = gi * 8 + e1, ge2 = gi * 8 + e2;
            const int p1 = (int)atomicAdd(cnt + ge1, 1u), p2 = (int)atomicAdd(cnt + ge2, 1u);
            ROUTE[(size_t)m * 2 + 0] = make_int4(ge1, p1, 0, 0); ROUTE[(size_t)m * 2 + 1] = make_int4(ge2, p2, 0, 0);
            INV[ge1 * 8192 + p1] = m; INV[ge2 * 8192 + p2] = m; WINV[ge1 * 8192 + p1] = w1; WINV[ge2 * 8192 + p2] = w2; }
    }
    __syncthreads();
}
__device__ __forceinline__ int moe_offsets(const unsigned* cnt, int lane, int* tiles_incl) {
    const int c = lane < 32 ? (int)cnt[lane] : 0; const int t = (c + 255) >> 8; int incl = t;
#pragma unroll
    for (int o = 1; o < 32; o <<= 1) { const int x = __shfl_up(incl, o); if ((lane & 31) >= o) incl += x; }
    *tiles_incl = incl; return (incl - t) * 256;
}
__device__ __forceinline__ void p_ln_ffn(Frame& F, const Args& a, int layer) {
    bf16* XB = (bf16*)(F.ws + WS_XB); const int lane = F.lane; const bf16* YG = (const bf16*)(F.ws + WS_CST);
    const float* g = a.in[11] + layer * DM; const float* bb = a.in[12] + layer * DM; const int4* ROUTE = (const int4*)(F.ws + WS_ROUTE);
    const bf16* SKH = (const bf16*)(F.ws + WS_WSM) + (size_t)SK_SK1 * 2048; const bf16* SKL = SKH + (size_t)SK_NCOL * 2048;
    const float* c64 = (const float*)(F.ws + WS_ROPE) + 2 * 4096 * 64; const float* s64 = c64 + 4096 * 32;
    bf16* IK = (bf16*)(F.ws + WS_IK); float* IW = (float*)(F.ws + WS_IW);
    const LAS float* LG = (const LAS float*)(F.lds + SK_LG_OFF);
    int ti_; const int eoff = moe_offsets(F.ctl + CW_CNT + layer * 64, lane, &ti_);
    for (int blk = blockIdx.x; blk < MTOK / 32; blk += F.G) { const int R0 = blk * 32;
#pragma unroll 2
        for (int i = 0; i < 4; ++i) { const int m = R0 + 4 * F.wave + i; f32x4 v[8];
            const int4 q0 = ROUTE[(size_t)m * 2], q1 = ROUTE[(size_t)m * 2 + 1]; const int r0 = __shfl(eoff, q0.x) + q0.y, r1 = __shfl(eoff, q1.x) + q1.y;
            load_row_bf16(XB + (size_t)m * DM, v, lane);
#pragma unroll
            for (int j = 0; j < 8; ++j) { v[j] = v[j] * DN_ALPHA;
                const uint2 y0 = *(const uint2*)(YG + (size_t)r0 * DM + 256 * j + 4 * lane), y1 = *(const uint2*)(YG + (size_t)r1 * DM + 256 * j + 4 * lane);
                v[j][0] += bf2f(y0.x & 0xffff) + bf2f(y1.x & 0xffff); v[j][1] += bf2f(y0.x >> 16) + bf2f(y1.x >> 16);
                v[j][2] += bf2f(y0.y & 0xffff) + bf2f(y1.y & 0xffff); v[j][3] += bf2f(y0.y >> 16) + bf2f(y1.y >> 16); }
            ln_row(v, g, bb, lane);
            if (layer == 0) store_row_bf16(XB + (size_t)m * DM, v, lane);
            else {
#pragma unroll
                for (int j = 0; j < 8; ++j) *(f32x4*)(a.out + (size_t)m * DM + 256 * j + 4 * lane) = v[j]; } }
        if (layer == 0) {
            __syncthreads();
            skinny_partials<5>(F.lds, XB + (size_t)R0 * DM, SKH, SKL, F.wave, lane);
            __syncthreads();
            skinny_reduce<5>(F.lds, F.tid);
            __syncthreads();
            for (int idx = F.tid; idx < 32 * 80; idx += NWAVES * 64) { const int row = idx / 80, c = idx % 80, m = R0 + row; const float v = LG[row * 80 + c];
                if (c < 64) { const float part = LG[row * 80 + (c ^ 32)]; const int pos = m & 4095, i = c & 31; const float cs = c64[pos * 32 + i], sn = s64[pos * 32 + i];
                    const int bq = m >> 12, sq = m & 4095; IK[((((size_t)bq * 128 + (sq >> 5)) * 4 + (c >> 4)) * 64 + ((c >> 3) & 1) * 32 + (sq & 31)) * 8 + (c & 7)] = (bf16)f2bf(c < 32 ? (v * cs - part * sn) : (v * cs + part * sn)); }
                else IW[(size_t)m * 16 + c - 64] = v * 0.25f * 0.125f; }
        }
    }
    __syncthreads();
}
__device__ __forceinline__ void ph_gla_b(Frame& F, const Args& a) {
    const float* SK0 = (const float*)(F.ws + WS_SK0); const float* w2 = a.in[2]; const float* gbias = a.in[3]; float* GB = (float*)(F.ws + WS_GB); float* DEC = (float*)(F.ws + WS_DEC);
    for (int u4 = blockIdx.x; u4 < 128; u4 += F.G) {
        const int unit = u4 * 4 + (F.tid >> 7), n = unit & 63, bh = unit >> 6, b = bh >> 2, h = bh & 3, d = F.tid & 127, t0 = b * SEQ + n * 64;
        float w[16];
#pragma unroll
        for (int r = 0; r < 16; ++r) w[r] = w2[r * 512 + h * 128 + d];
        const float gb = gbias[h * 128 + d]; float run = 0.f;
        for (int c = 0; c < 64; ++c) { const int t = t0 + c; float z = gb;
#pragma unroll
            for (int r = 0; r < 16; ++r) z += SK0[(size_t)t * 24 + r] * w[r];
            run += logsigmoidf(z) * (1.0f / 16.0f); GB[(size_t)t * 512 + h * 128 + d] = run; }
        DEC[unit * 128 + d] = __expf(run);
    }
}
__device__ __forceinline__ void ph_gla_state(Frame& F) {
    const bf16* PROJ = (const bf16*)(F.ws + WS_PROJ); const float* GB = (const float*)(F.ws + WS_GB); float* CST = (float*)(F.ws + WS_CST);
    for (int vb = blockIdx.x; vb < 512 * 64; vb += F.G) {
        const int unit = vb >> 6, d = (vb & 63) * 2 + (F.tid >> 8), v = F.tid & 255, n = unit & 63, bh = unit >> 6, b = bh >> 2, h = bh & 3, t0 = b * SEQ + n * 64;
        const float blast = GB[(size_t)(t0 + 63) * 512 + h * 128 + d]; float acc = 0.f;
        for (int c = 0; c < 64; ++c) { const size_t t = t0 + c; const float kk = bf2f(PROJ[t * NP0 + 512 + h * 128 + d]) * __expf(blast - GB[t * 512 + h * 128 + d]);
            acc += kk * bf2f(PROJ[t * NP0 + 1024 + h * 256 + v]); }
        CST[((size_t)unit * 256 + v) * 128 + d] = acc;
    }
}
__device__ __forceinline__ void ph_gla_scan(Frame& F) {
    const float* CST = (const float*)(F.ws + WS_CST); const float* DEC = (const float*)(F.ws + WS_DEC); bf16* PREVT = (bf16*)(F.ws + WS_PREVT);
    for (int idx = blockIdx.x * 512 + F.tid; idx < 8 * 32768; idx += F.G * 512) { const int bh = idx >> 15, vd = idx & 32767, d = vd & 127; float S = 0.f;
        for (int n = 0; n < 64; ++n) { const int unit = bh * 64 + n; PREVT[(size_t)unit * 32768 + vd] = (bf16)f2bf(S); S = DEC[unit * 128 + d] * S + CST[(size_t)unit * 32768 + vd]; } }
}
__device__ __forceinline__ void ph_gla_out(Frame& F, const Args& a) {
    const bf16* PROJ = (const bf16*)(F.ws + WS_PROJ); const float* GB = (const float*)(F.ws + WS_GB); const bf16* PREVT = (const bf16*)(F.ws + WS_PREVT); const float* normg = a.in[4]; bf16* OMIX = (bf16*)(F.ws + WS_OMIX);
    LAS float* qd = (LAS float*)F.lds; LAS float* ki = qd + 64 * 128; LAS float* sc = ki + 64 * 128; LAS float* red = sc + 64 * 64;
    const int tid = F.tid; const bool act = tid < 256;
    for (int unit = blockIdx.x; unit < 512; unit += F.G) {
        const int n = unit & 63, bh = unit >> 6, b = bh >> 2, h = bh & 3, t0 = b * SEQ + n * 64;
        __syncthreads();
        for (int i = tid; i < 64 * 128; i += 512) { const int c = i >> 7, d = i & 127; const size_t t = t0 + c; const float bb = GB[t * 512 + h * 128 + d];
            qd[i] = bf2f(PROJ[t * NP0 + h * 128 + d]) * ATT_SCALE * __expf(bb); ki[i] = bf2f(PROJ[t * NP0 + 512 + h * 128 + d]) * __expf(-bb); }
        __syncthreads();
        for (int p = tid; p < 64 * 64; p += 512) { const int i = p >> 6, j = p & 63; float s = 0.f;
            if (j <= i) for (int d = 0; d < 128; ++d) s += qd[i * 128 + d] * ki[j * 128 + d];
            sc[p] = s; }
        __syncthreads();
        const int v = tid & 255; const bf16* pv = PREVT + ((size_t)unit * 256 + v) * 128; const float gv = normg[v];
        for (int i = 0; i < 64; ++i) { float acc = 0.f;
            if (act) { for (int j = 0; j <= i; ++j) acc += sc[i * 64 + j] * bf2f(PROJ[(size_t)(t0 + j) * NP0 + 1024 + h * 256 + v]);
                for (int d = 0; d < 128; ++d) acc += qd[i * 128 + d] * bf2f(pv[d]);
                const float ss = wave_sum(acc * acc); if ((tid & 63) == 0) red[tid >> 6] = ss; }
            __syncthreads();
            const float ms = (red[0] + red[1] + red[2] + red[3]) * (1.0f / 256.0f); __syncthreads();
            if (act) { const float gr = bf2f(PROJ[(size_t)(t0 + i) * NP0 + 2048 + h * 256 + v]);
                const float o = acc * (1.0f / sqrtf(ms + LN_EPS)) * gv * (gr / (1.0f + __expf(-gr)));
                OMIX[(size_t)(t0 + i) * DM + h * 256 + v] = (bf16)f2bf(o); } }
    }
}
template <int MODE  >
__device__ __forceinline__ void ph_attn_naive(Frame& F, const bf16* Qb, int ldq, int qc0, const bf16* Kb, int ldk, int kc0, const bf16* Vb, int ldv, int vc0, int nheads, int group,
                                              const float* fbias, const unsigned long long* mask, bf16* O, int oc0) {
    const int half = F.tid >> 8, tid = F.tid & 255, qi = tid >> 2, part = tid & 3;
    LAS bf16* Ks = (LAS bf16*)(F.lds + half * 32768); LAS bf16* Vs = Ks + 64 * 128;
    const int nvb = (SEQ / 64) * (nheads / 2) * BATCH;
    for (int vb = blockIdx.x; vb < nvb; vb += F.G) {
        const int cc = vb >> 6, qb = ((vb & 63) + cc * 17) & 63, hp = cc % (nheads / 2), b = cc / (nheads / 2), h = hp * 2 + half, kvh = h / group;
        const int qpos = qb * 64 + qi; const size_t row = (size_t)b * SEQ + qpos;
        float qv[32], o[32];
#pragma unroll
        for (int d = 0; d < 32; ++d) { qv[d] = bf2f(Qb[row * ldq + qc0 + h * 128 + part * 32 + d]); o[d] = 0.f; }
        float mrun = -1e30f, l = 0.f;
        const float* fb = MODE == 0 ? fbias + (size_t)(b * 8 + h) * SEQ : nullptr;
        for (int kt = 0; kt <= qb; ++kt) {
            __syncthreads();
            for (int i = tid; i < 64 * 16; i += 256) { const int r = i >> 4, c8 = (i & 15) * 8; const size_t kr = (size_t)b * SEQ + kt * 64 + r;
                *(LAS v4u*)(Ks + r * 128 + c8) = *(const v4u*)(Kb + kr * ldk + kc0 + kvh * 128 + c8); *(LAS v4u*)(Vs + r * 128 + c8) = *(const v4u*)(Vb + kr * ldv + vc0 + kvh * 128 + c8); }
            __syncthreads();
            unsigned long long mw = ~0ull; if (MODE == 1) mw = mask[row * 64 + kt];
            for (int s = 0; s < 64; ++s) { const int key = kt * 64 + s; float p = 0.f;
#pragma unroll
                for (int d = 0; d < 32; ++d) p += qv[d] * bf2f(Ks[s * 128 + part * 32 + d]);
                p += __shfl_xor(p, 1); p += __shfl_xor(p, 2);
                const bool valid = key <= qpos && ((mw >> s) & 1ull);
                if (valid) { const float logit = (p + (MODE == 0 ? fb[key] : 0.f)) * ATT_SCALE; const float mn = fmaxf(mrun, logit), al = __expf(mrun - mn), pp = __expf(logit - mn);
                    l = l * al + pp; mrun = mn;
#pragma unroll
                    for (int d = 0; d < 32; ++d) o[d] = o[d] * al + pp * bf2f(Vs[s * 128 + part * 32 + d]); } }
        }
        const float il = 1.0f / l;
#pragma unroll
        for (int d = 0; d < 32; ++d) O[row * DM + oc0 + h * 128 + part * 32 + d] = (bf16)f2bf(o[d] * il);
    }
    __syncthreads();
}
__device__ __forceinline__ void ph_idx_scores(Frame& F) {
    const bf16* PROJ1 = (const bf16*)(F.ws + WS_PROJ); const bf16* IK = (const bf16*)(F.ws + WS_IK); const float* IW = (const float*)(F.ws + WS_IW); float* SC = (float*)(F.ws + WS_SC);
    LAS float* q = (LAS float*)F.lds; LAS float* w = q + 1024; const int tid = F.tid;
    for (int m = blockIdx.x; m < MTOK; m += F.G) { const int pos = m & 4095, b = m >> 12;
        __syncthreads();
        for (int i = tid; i < 1024; i += 512) q[i] = bf2f(PROJ1[(size_t)m * NP1 + 3072 + i]);
        if (tid < 16) w[tid] = IW[(size_t)m * 16 + tid];
        __syncthreads();
        for (int s = tid; s <= pos; s += 512) { const bf16* kr = IK + ((size_t)b * SEQ + s) * 64; float kk[64];
#pragma unroll
            for (int d = 0; d < 64; ++d) kk[d] = bf2f(kr[d]);
            float sc = 0.f;
#pragma unroll 1
            for (int hh = 0; hh < 16; ++hh) { float dsum = 0.f;
#pragma unroll
                for (int d = 0; d < 64; ++d) dsum += q[hh * 64 + d] * kk[d];
                sc += w[hh] * fmaxf(dsum, 0.f); }
            SC[(size_t)m * SEQ + s] = sc; }
    }
    __syncthreads();
}
namespace attn {
constexpr int D = 128, NW = 8, QBLK = 32, KVBLK = 64, QB = NW * QBLK;
constexpr int SHM_V = KVBLK * D * 2, SHM_K = KVBLK * D * 2;
constexpr int OFF_WS = 2 * SHM_V + 2 * SHM_K, OFF_BIAS = OFF_WS + NW * 64 * 4, LDS_NEED = OFF_BIAS + 2 * 16384;
constexpr float SCALE = 0.08838834764831845f, THR = 8.f;
typedef short s16x4 __attribute__((ext_vector_type(4)));
typedef float f32x16 __attribute__((ext_vector_type(16)));
typedef unsigned u32x4 __attribute__((ext_vector_type(4)));
#define KSWZ(row, colB) ((row) * 256 + ((colB) ^ (((row) & 7) << 4)))
#define SBAR() __builtin_amdgcn_sched_barrier(0)
__device__ __forceinline__ int v_st(int k, int c) { const int kk = (k & ~0xC) | ((k & 4) << 1) | ((k & 8) >> 1); return ((kk >> 3) * 4 + (c >> 5)) * 512 + ((kk & 7) * 32 + (c & 31)) * 2; }
__device__ __forceinline__ int v_rd_base(int lane) { return ((lane & 3) << 3) | (((lane >> 2) & 3) << 6) | (((lane >> 4) & 1) << 5) | (((lane >> 5) & 1) << 8); }
constexpr int v_rd_off(int d0, int ks, int half) { return d0 * 512 + ks * 4096 + half * 2048; }
__device__ __forceinline__ int crow(int r, int hi) { return (r & 3) + 8 * (r >> 2) + 4 * hi; }
__device__ __forceinline__ unsigned cvtpk(float lo, float hi) { unsigned r; asm volatile("v_cvt_pk_bf16_f32 %0, %1, %2" : "=v"(r) : "v"(lo), "v"(hi)); return r; }
__device__ __forceinline__ bf16x8 load8(const bf16* p) { return *reinterpret_cast<const bf16x8*>(p); }
__device__ __forceinline__ void mask_tile(f32x16& p0, f32x16& p1, int dq) {
    const float NEG = -__builtin_inff();
#pragma unroll
    for (int r = 0; r < 16; ++r) { const int c = (r & 3) + 8 * (r >> 2); if (dq - c < 0) p0[r] = NEG; if (dq - c - 32 < 0) p1[r] = NEG; }
}
__device__ __forceinline__ void mask_bits(f32x16& p0, f32x16& p1, unsigned w0, unsigned w1) {
#pragma unroll
    for (int r = 0; r < 16; ++r) { const unsigned c = (r & 3) + 8 * (r >> 2);
        const unsigned m0 = (unsigned)__builtin_amdgcn_sbfe((int)w0, c, 1), m1 = (unsigned)__builtin_amdgcn_sbfe((int)w1, c, 1);
        p0[r] = __uint_as_float((m0 & __float_as_uint(p0[r])) | (~m0 & 0xFF800000u)); p1[r] = __uint_as_float((m1 & __float_as_uint(p1[r])) | (~m1 & 0xFF800000u)); }
}
__device__ __forceinline__ void partialSM(f32x16& p0, f32x16& p1, float& m_reg, float& mn, float& alpha) {
    float pmax = p0[0]; for (int r = 1; r < 16; ++r) pmax = fmaxf(pmax, p0[r]); for (int r = 0; r < 16; ++r) pmax = fmaxf(pmax, p1[r]);
    { auto rr = __builtin_amdgcn_permlane32_swap(__float_as_uint(pmax), __float_as_uint(pmax), false, false);
      pmax = fmaxf(__uint_as_float(rr[0]), __uint_as_float(rr[1])); }
    constexpr float C2 = 1.4426950408889634f * SCALE;
    if (__builtin_expect(__all((pmax - m_reg) * SCALE <= THR), 1)) { mn = m_reg; alpha = 1.f; }
    else { mn = fmaxf(m_reg, pmax); alpha = __builtin_amdgcn_exp2f((m_reg - mn) * C2); m_reg = mn; }
    const float mnL = -mn * C2;
    for (int r = 0; r < 16; ++r) p0[r] = fmaf(p0[r], C2, mnL); for (int r = 0; r < 16; ++r) p1[r] = fmaf(p1[r], C2, mnL);
    for (int r = 0; r < 16; ++r) p0[r] = __builtin_amdgcn_exp2f(p0[r]);
}
__device__ __forceinline__ void finishSM(f32x16& p0, f32x16& p1, float alpha, float& l_reg, bf16x8& pa0, bf16x8& pa1, bf16x8& pa2, bf16x8& pa3) {
    for (int r = 0; r < 16; ++r) p1[r] = __builtin_amdgcn_exp2f(p1[r]);
    float ps = 0; for (int r = 0; r < 16; ++r) ps += p0[r]; for (int r = 0; r < 16; ++r) ps += p1[r];
    { auto rr = __builtin_amdgcn_permlane32_swap(__float_as_uint(ps), __float_as_uint(ps), false, false);
      ps = __uint_as_float(rr[0]) + __uint_as_float(rr[1]); }
    l_reg = l_reg * alpha + ps;
#define PK4(P, B_, OUT) do { unsigned a0 = cvtpk(P[B_+0], P[B_+1]), a1 = cvtpk(P[B_+2], P[B_+3]);                          \
        unsigned b0 = cvtpk(P[B_+4], P[B_+5]), b1 = cvtpk(P[B_+6], P[B_+7]);                                             \
        auto r0 = __builtin_amdgcn_permlane32_swap(a0, b0, false, false); auto r1 = __builtin_amdgcn_permlane32_swap(a1, b1, false, false); \
        u32x4 w = {r0[0], r1[0], r0[1], r1[1]}; OUT = *reinterpret_cast<bf16x8*>(&w); } while (0)
    PK4(p0, 0, pa0); PK4(p0, 8, pa1); PK4(p1, 0, pa2); PK4(p1, 8, pa3);
#undef PK4
}
template <int KB, bool BIAS>
__device__ __forceinline__ void qkt(f32x16& p0, f32x16& p1, const char* K_lds, int r32, int hi, const bf16x8* qr, const char* bl) {
    p0 = f32x16{}; p1 = f32x16{}; (void)bl;
    const char* kb[4];
#pragma unroll
    for (int dd = 0; dd < 4; ++dd) kb[dd] = K_lds + KB * SHM_K + KSWZ(r32, (dd * 16 + hi * 8) * 2);
#pragma unroll
    for (int d0 = 0; d0 < 8; ++d0) { const char* a = kb[d0 & 3] + (d0 >> 2) * 128;
        bf16x8 b0 = *reinterpret_cast<const bf16x8*>(a);
        bf16x8 b1 = *reinterpret_cast<const bf16x8*>(a + 32 * 256);
        p0 = __builtin_amdgcn_mfma_f32_32x32x16_bf16(b0, qr[d0], p0, 0, 0, 0);
        p1 = __builtin_amdgcn_mfma_f32_32x32x16_bf16(b1, qr[d0], p1, 0, 0, 0); }
}
template <int VB>
__device__ __forceinline__ void pv_tile(f32x16* o, int vb0, bf16x8 pa0, bf16x8 pa1, bf16x8 pa2, bf16x8 pa3) {
#define TRRD(dst, off) asm volatile("ds_read_b64_tr_b16 %0, %1 offset:%2" : "=&v"(dst) : "v"(vb0), "i"(off) : "memory")
#define PV_D0(d0) do { s16x4 l0, l1, l2, l3, h0, h1, h2, h3; constexpr int b_ = VB * SHM_V + v_rd_off(d0, 0, 0); \
        TRRD(l0, b_); TRRD(h0, b_ + 2048); TRRD(l1, b_ + 4096); TRRD(h1, b_ + 6144); TRRD(l2, b_ + 8192); TRRD(h2, b_ + 10240); TRRD(l3, b_ + 12288); TRRD(h3, b_ + 14336); \
        asm volatile("s_waitcnt lgkmcnt(0)" ::: "memory"); SBAR();   \
        o[d0] = __builtin_amdgcn_mfma_f32_32x32x16_bf16(pa0, (bf16x8){l0[0], l0[1], l0[2], l0[3], h0[0], h0[1], h0[2], h0[3]}, o[d0], 0, 0, 0);   \
        o[d0] = __builtin_amdgcn_mfma_f32_32x32x16_bf16(pa1, (bf16x8){l1[0], l1[1], l1[2], l1[3], h1[0], h1[1], h1[2], h1[3]}, o[d0], 0, 0, 0);   \
        o[d0] = __builtin_amdgcn_mfma_f32_32x32x16_bf16(pa2, (bf16x8){l2[0], l2[1], l2[2], l2[3], h2[0], h2[1], h2[2], h2[3]}, o[d0], 0, 0, 0);   \
        o[d0] = __builtin_amdgcn_mfma_f32_32x32x16_bf16(pa3, (bf16x8){l3[0], l3[1], l3[2], l3[3], h3[0], h3[1], h3[2], h3[3]}, o[d0], 0, 0, 0); } while (0)
    PV_D0(0); PV_D0(1); PV_D0(2); PV_D0(3);
#undef PV_D0
#undef TRRD
}
struct BlockRef { const bf16* Q; const bf16* K; const bf16* V; bf16* O; int P0; const float* fb; const unsigned long long* mrow; };
struct Seam { bf16x8 qr[8]; bf16x8 st_v0, st_v1, st_k0, st_k1; };
#define VMW() asm volatile("s_waitcnt vmcnt(0)" ::: "memory")
#define VMWN(n) asm volatile("s_waitcnt vmcnt(%0)" :: "i"(n) : "memory")
#define SLOAD_H(Kp, Vp, k0) do { const bf16* kt_ = (Kp) + (size_t)(k0) * KS; const bf16* vt_ = (Vp) + (size_t)(k0) * KS; S.st_v0 = load8(vt_ + koff); S.st_v1 = load8(vt_ + koff + 32 * KS); S.st_k0 = load8(kt_ + koff); S.st_k1 = load8(kt_ + koff + 32 * KS); } while (0)
#define SWRITE_HK(bf) do { *(bf16x8*)(K_lds + (bf) * SHM_K + kws) = S.st_k0; *(bf16x8*)(K_lds + (bf) * SHM_K + kws + 32 * 256) = S.st_k1; } while (0)
#define SWRITE_HV(bf) do { *(bf16x8*)(V_lds + (bf) * SHM_V + vst0) = S.st_v0; *(bf16x8*)(V_lds + (bf) * SHM_V + vst1) = S.st_v1; } while (0)
#define SWRITE_H(bf) do { SWRITE_HV(bf); SWRITE_HK(bf); } while (0)
template <bool BIAS, bool BITMASK, int QS, int KS, int OS>
__device__ __forceinline__ void attn_block(const BlockRef& cur, char* lds, LAS unsigned char* ldsl) {
    int tid_ = threadIdx.x; asm volatile("" : "+v"(tid_));
    const int tid = tid_, wid = __builtin_amdgcn_readfirstlane(tid >> 6), lane = tid & 63, r32 = lane & 31, hi = lane >> 5;
    const int NT = (cur.P0 + QB - 1) / KVBLK + 1;
    const int qlo = cur.P0 + wid * QBLK, qm = qlo + r32 - 4 * hi;
    char* V_lds = lds; char* K_lds = lds + 2 * SHM_V;
    float* ws = (float*)(lds + OFF_WS) + wid * 64; float* li_l = ws, * al_l = ws + 32;
    const LAS unsigned char* bl0 = ldsl + OFF_BIAS + hi * 16;
    float m_reg = -1e30f, l_reg = 0; f32x16 o[4] = {};
    const int sr = tid >> 4, sc = (tid & 15) * 8, vst0 = v_st(sr, sc), vst1 = v_st(32 + sr, sc), kws = KSWZ(sr, sc * 2);
    const int vb0 = (int)(uintptr_t)V_lds + v_rd_base(lane);
    const bf16* Kh = cur.K; const bf16* Vh = cur.V;
    const int moff = (wid * QBLK + r32) * 64, koff = sr * KS + sc, qoff = (wid * QBLK + r32) * QS + hi * 8;
    Seam S;
#pragma unroll
    for (int d0 = 0; d0 < 8; ++d0) S.qr[d0] = load8(cur.Q + qoff + d0 * 16);
    if constexpr (BIAS) { const f32x4 b0_ = *(const f32x4*)(cur.fb + tid * 8), b1_ = *(const f32x4*)(cur.fb + tid * 8 + 4);
        *(LAS f32x4*)(ldsl + OFF_BIAS + tid * 32) = b0_; *(LAS f32x4*)(ldsl + OFF_BIAS + tid * 32 + 16) = b1_; }
    SLOAD_H(Kh, Vh, 0); VMW(); SWRITE_HK(0); SWRITE_HV(0); SBAR();
#define RESC(a) do { if (__any((a) < 1.f)) { if (hi == 0) al_l[r32] = (a); asm volatile("s_waitcnt lgkmcnt(0)" ::: "memory");              \
                     for (int d_ = 0; d_ < 4; ++d_) for (int r = 0; r < 16; ++r) o[d_][r] *= al_l[crow(r, hi)]; } } while (0)
#define KBASE(t) ((t) * KVBLK)
#define MLOAD(MW, t) do { if constexpr (BITMASK) MW = (cur.mrow + (t))[moff]; } while (0)
#define MASKT(P0_, P1_, MW, t) do { if constexpr (BIAS) { const LAS unsigned char* bl_ = bl0 + KBASE(t) * 4; _Pragma("unroll") for (int g = 0; g < 4; ++g) { const f32x4 a_ = *(const LAS f32x4*)(bl_ + g * 32), b_ = *(const LAS f32x4*)(bl_ + 128 + g * 32); \
            P0_[4 * g] += a_[0]; P0_[4 * g + 1] += a_[1]; P0_[4 * g + 2] += a_[2]; P0_[4 * g + 3] += a_[3]; P1_[4 * g] += b_[0]; P1_[4 * g + 1] += b_[1]; P1_[4 * g + 2] += b_[2]; P1_[4 * g + 3] += b_[3]; } } \
        if constexpr (BITMASK) { mask_bits(P0_, P1_, (unsigned)(MW) >> (4 * hi), (unsigned)((MW) >> 32) >> (4 * hi)); } \
        else { const int kb_ = KBASE(t); if (kb_ + KVBLK - 1 > qlo) mask_tile(P0_, P1_, qm - kb_); } } while (0)
    f32x16 pA0, pA1, pB0, pB1; float mnA, mnB, alA, alB; bf16x8 pa0, pa1, pa2, pa3; unsigned long long mwA = 0, mwB = 0;
    MLOAD(mwA, 0);
    SLOAD_H(Kh, Vh, KBASE(1)); MLOAD(mwB, 1);
    __syncthreads();
    SBAR(); qkt<0, BIAS>(pA0, pA1, K_lds, r32, hi, S.qr, nullptr);
    MASKT(pA0, pA1, mwA, 0); partialSM(pA0, pA1, m_reg, mnA, alA);
    VMW(); SWRITE_H(1);
    __syncthreads();
#define HALF_STEP(PX0, PX1, mnX, alX, MWX, PY0, PY1, alY, MWY, t, KB, VB, SB) do {                                            \
        SBAR(); qkt<KB, BIAS>(PX0, PX1, K_lds, r32, hi, S.qr, nullptr);                                                       \
        finishSM(PY0, PY1, alY, l_reg, pa0, pa1, pa2, pa3); SBAR();                                                           \
        if ((t) + 1 < NT) { SLOAD_H(Kh, Vh, KBASE((t) + 1)); MLOAD(MWY, (t) + 1); SBAR(); }                                   \
        pv_tile<VB>(o, vb0, pa0, pa1, pa2, pa3); MASKT(PX0, PX1, MWX, (t)); partialSM(PX0, PX1, m_reg, mnX, alX);             \
        __syncthreads();                                                                                                      \
        if ((t) + 1 < NT) { VMW(); SWRITE_H(SB); }                                                                            \
        RESC(alX); __syncthreads(); } while (0)
    for (int t = 1; t + 1 < NT; t += 2) {
        HALF_STEP(pB0, pB1, mnB, alB, mwB, pA0, pA1, alA, mwA, t, 1, 0, 0);
        HALF_STEP(pA0, pA1, mnA, alA, mwA, pB0, pB1, alB, mwB, t + 1, 0, 1, 1);
    }
    SBAR(); qkt<1, BIAS>(pB0, pB1, K_lds, r32, hi, S.qr, nullptr); SBAR();
    finishSM(pA0, pA1, alA, l_reg, pa0, pa1, pa2, pa3); SBAR();
    pv_tile<0>(o, vb0, pa0, pa1, pa2, pa3);
    MASKT(pB0, pB1, mwB, NT - 1); partialSM(pB0, pB1, m_reg, mnB, alB); __syncthreads(); RESC(alB);
    finishSM(pB0, pB1, alB, l_reg, pa0, pa1, pa2, pa3); SBAR(); pv_tile<1>(o, vb0, pa0, pa1, pa2, pa3);
    SBAR();
    if (hi == 0) li_l[r32] = l_reg; asm volatile("s_waitcnt lgkmcnt(0)" ::: "memory");
    float rli[16];
#pragma unroll
    for (int r = 0; r < 16; ++r) rli[r] = __builtin_amdgcn_rcpf(li_l[crow(r, hi)]);
    int tid2_ = threadIdx.x; asm volatile("" : "+v"(tid2_));
    const int r32e = tid2_ & 31, hie = (tid2_ >> 5) & 1, ooff = (wid * QBLK + 4 * hie) * OS + r32e;
#pragma unroll
    for (int r = 0; r < 16; ++r) {
#pragma unroll
        for (int d0 = 0; d0 < 4; ++d0) { const float v = o[d0][r] * rli[r]; const float vn = __shfl_xor(v, 1);
            if ((r32e & 1) == 0) *(unsigned*)(cur.O + ((r & 3) + 8 * (r >> 2)) * OS + d0 * 32 + ooff) = cvtpk(v, vn); } }
    __syncthreads();
#undef RESC
#undef KBASE
#undef MLOAD
#undef MASKT
#undef HALF_STEP
}
#undef ROWK
#undef VMW
#undef VMWN
#undef SLOAD_H
#undef SWRITE_HK
#undef SWRITE_HV
#undef SWRITE_H
#undef KSWZ
#undef SBAR
template <bool BIAS, bool BITMASK, int NH, int GROUP, bool PAIR, int QS, int KS, int OS>
__device__ __forceinline__ void attn_phase(char* lds, LAS unsigned char* ldsl, const bf16* Q, const bf16* K, const bf16* V, bf16* O, const float* fbias, const unsigned long long* mask, int G, int bid) {
    constexpr int NBLK = BATCH * NH * 16, NITEM = PAIR ? NBLK / 2 : NBLK, PER = PAIR ? 8 : 16, SETH = BATCH * NH / 8;
    for (int L = bid; L < NITEM; L += G) {
#pragma unroll 1
        for (int pass = 0; pass < (PAIR ? 2 : 1); ++pass) {
            const int g = L & 7, k = L >> 3, hs = k / PER, x = k % PER; const int bh = g * SETH + hs, b = bh / NH, h = bh % NH;
            const int qb = PAIR ? (pass ? 15 - x : x) : 15 - x; BlockRef r; const size_t row0 = (size_t)b * SEQ + (size_t)qb * QB;
            r.Q = Q + row0 * QS + h * D; r.O = O + row0 * OS + h * D; r.K = K + (size_t)b * SEQ * KS + (h / GROUP) * D; r.V = V + (size_t)b * SEQ * KS + (h / GROUP) * D; r.P0 = qb * QB;
            r.fb = BIAS ? fbias + (size_t)bh * SEQ : nullptr; r.mrow = BITMASK ? mask + row0 * 64 : nullptr;
            attn_block<BIAS, BITMASK, QS, KS, OS>(r, lds, ldsl);
        }
    }
}
}
__device__ __forceinline__ float fast_silu(float g) { return g * __builtin_amdgcn_rcpf(1.0f + __expf(-g)); }
__device__ __forceinline__ void ph_gla_a(Frame& F, const Args& a) {
    const float* SK0 = (const float*)(F.ws + WS_SK0); const float* w2 = a.in[2]; const float* gbias = a.in[3]; float* GB = (float*)(F.ws + WS_GB); float* DEC = (float*)(F.ws + WS_DEC);
    const bf16* PROJ = (const bf16*)(F.ws + WS_PROJ); float* CST = (float*)(F.ws + WS_CST);
    LAS float* BSH = (LAS float*)F.lds; LAS float* TOT = BSH + 64 * 128; LAS bf16* VT = (LAS bf16*)(F.lds + 36864); LAS bf16* KET = (LAS bf16*)(F.lds + 73728);
    const int tid = F.tid, lane = F.lane, l15 = lane & 15, quad = lane >> 4, w = F.wave;
    for (int unit = blockIdx.x; unit < 512; unit += F.G) {
        const int n = unit & 63, bh = unit >> 6, b = bh >> 2, h = bh & 3, t0 = b * SEQ + n * 64;
        __syncthreads();
        {
            const int d = tid & 127, cg = tid >> 7; float wv[16];
#pragma unroll
            for (int r = 0; r < 16; ++r) wv[r] = w2[r * 512 + h * 128 + d];
            const float gb = gbias[h * 128 + d]; float run = 0.f;
            for (int cc = 0; cc < 16; ++cc) { const int c = cg * 16 + cc; const float* sk = SK0 + (size_t)(t0 + c) * 24; float z = gb;
#pragma unroll
                for (int r = 0; r < 16; ++r) z += sk[r] * wv[r];
                run += logsigmoidf(z) * (1.0f / 16.0f); BSH[c * 128 + d] = run; }
            TOT[cg * 128 + d] = run;
            __syncthreads();
            float pre = 0.f;
            for (int g = 0; g < cg; ++g) pre += TOT[g * 128 + d];
            for (int cc = 0; cc < 16; ++cc) { const int c = cg * 16 + cc; const float v = BSH[c * 128 + d] + pre; BSH[c * 128 + d] = v; GB[(size_t)(t0 + c) * 512 + h * 128 + d] = v; }
        }
        __syncthreads();
        {
            const int c = tid & 63, g8 = tid >> 6; const size_t t = (size_t)(t0 + c);
            const bf16* kp = PROJ + t * NP0 + 512 + h * 128 + g8 * 16;
            const v4u k0 = *(const v4u*)kp, k1 = *(const v4u*)(kp + 8);
            const unsigned kw[8] = {k0.x, k0.y, k0.z, k0.w, k1.x, k1.y, k1.z, k1.w};
#pragma unroll
            for (int i = 0; i < 8; ++i) { const int d = g8 * 16 + 2 * i; const float e0 = __expf(BSH[63 * 128 + d] - BSH[c * 128 + d]), e1 = __expf(BSH[63 * 128 + d + 1] - BSH[c * 128 + d + 1]);
                KET[d * 72 + c] = (bf16)f2bf(bf2f(kw[i] & 0xffff) * e0); KET[(d + 1) * 72 + c] = (bf16)f2bf(bf2f(kw[i] >> 16) * e1); }
            const bf16* vp = PROJ + t * NP0 + 1024 + h * 256 + g8 * 32;
#pragma unroll
            for (int q = 0; q < 4; ++q) { const v4u vv = *(const v4u*)(vp + 8 * q); const unsigned vw[4] = {vv.x, vv.y, vv.z, vv.w};
#pragma unroll
                for (int i = 0; i < 4; ++i) { const int v = g8 * 32 + q * 8 + 2 * i; VT[v * 72 + c] = (bf16)(vw[i] & 0xffff); VT[(v + 1) * 72 + c] = (bf16)(vw[i] >> 16); } }
            if (tid < 128) DEC[unit * 128 + tid] = __expf(BSH[63 * 128 + tid]);
        }
        __syncthreads();
        {
            pg8::f32x4 acc[2][8];
#pragma unroll
            for (int i = 0; i < 2; ++i)
#pragma unroll
                for (int nn = 0; nn < 8; ++nn) acc[i][nn] = (pg8::f32x4){0.f, 0.f, 0.f, 0.f};
#pragma unroll
            for (int kk = 0; kk < 64; kk += 32) {
                const bf16x8 a0 = *(const LAS bf16x8*)(VT + (32 * w + l15) * 72 + kk + quad * 8), a1 = *(const LAS bf16x8*)(VT + (32 * w + 16 + l15) * 72 + kk + quad * 8);
#pragma unroll
                for (int nn = 0; nn < 8; ++nn) { const bf16x8 bb = *(const LAS bf16x8*)(KET + (16 * nn + l15) * 72 + kk + quad * 8);
                    acc[0][nn] = __builtin_amdgcn_mfma_f32_16x16x32_bf16(a0, bb, acc[0][nn], 0, 0, 0); acc[1][nn] = __builtin_amdgcn_mfma_f32_16x16x32_bf16(a1, bb, acc[1][nn], 0, 0, 0); } }
            float* cp = CST + (size_t)unit * 32768;
#pragma unroll
            for (int i = 0; i < 2; ++i)
#pragma unroll
                for (int nn = 0; nn < 8; ++nn)
#pragma unroll
                    for (int j = 0; j < 4; ++j) cp[(32 * w + 16 * i + quad * 4 + j) * 128 + 16 * nn + l15] = acc[i][nn][j];
        }
    }
    __syncthreads();
}
__device__ __forceinline__ void ph_gla_c(Frame& F, const Args& a) {
    const bf16* PROJ = (const bf16*)(F.ws + WS_PROJ); const float* GB = (const float*)(F.ws + WS_GB); const bf16* PREVT = (const bf16*)(F.ws + WS_PREVT); const float* normg = a.in[4]; bf16* OMIX = (bf16*)(F.ws + WS_OMIX);
    LAS bf16* QD = (LAS bf16*)(F.lds + 32768); LAS bf16* KI = (LAS bf16*)(F.lds + 50176); LAS bf16* P = (LAS bf16*)(F.lds + 67584); LAS bf16* VT = (LAS bf16*)(F.lds + 76800); LAS float* RED = (LAS float*)(F.lds + 113664);
    const int tid = F.tid, lane = F.lane, l15 = lane & 15, quad = lane >> 4, w = F.wave;
    for (int unit = blockIdx.x; unit < 512; unit += F.G) {
        const int n = unit & 63, bh = unit >> 6, b = bh >> 2, h = bh & 3, t0 = b * SEQ + n * 64;
        __syncthreads();
        {
            const int c = tid >> 3, dg = tid & 7; const size_t t = (size_t)(t0 + c);
            const float* bp = GB + t * 512 + h * 128 + dg * 16; const bf16* qp = PROJ + t * NP0 + h * 128 + dg * 16; const bf16* kp = PROJ + t * NP0 + 512 + h * 128 + dg * 16;
#pragma unroll
            for (int q8 = 0; q8 < 2; ++q8) { const v4u qq = *(const v4u*)(qp + 8 * q8), kk = *(const v4u*)(kp + 8 * q8); const f32x4 b0 = *(const f32x4*)(bp + 8 * q8), b1 = *(const f32x4*)(bp + 8 * q8 + 4);
                const unsigned qw[4] = {qq.x, qq.y, qq.z, qq.w}, kw[4] = {kk.x, kk.y, kk.z, kk.w}; const float bv[8] = {b0[0], b0[1], b0[2], b0[3], b1[0], b1[1], b1[2], b1[3]};
                v4u oq, ok; unsigned* oqp = (unsigned*)&oq; unsigned* okp = (unsigned*)&ok;
#pragma unroll
                for (int i = 0; i < 4; ++i) { const float e0 = __expf(bv[2 * i]), e1 = __expf(bv[2 * i + 1]);
                    oqp[i] = pk2(bf2f(qw[i] & 0xffff) * ATT_SCALE * e0, bf2f(qw[i] >> 16) * ATT_SCALE * e1);
                    okp[i] = pk2(bf2f(kw[i] & 0xffff) * __builtin_amdgcn_rcpf(e0), bf2f(kw[i] >> 16) * __builtin_amdgcn_rcpf(e1)); }
                *(LAS v4u*)(QD + c * 136 + dg * 16 + 8 * q8) = oq; *(LAS v4u*)(KI + c * 136 + dg * 16 + 8 * q8) = ok; }
            const int c2 = tid & 63, g8 = tid >> 6; const bf16* vp = PROJ + (size_t)(t0 + c2) * NP0 + 1024 + h * 256 + g8 * 32;
#pragma unroll
            for (int q = 0; q < 4; ++q) { const v4u vv = *(const v4u*)(vp + 8 * q); const unsigned vw[4] = {vv.x, vv.y, vv.z, vv.w};
#pragma unroll
                for (int i = 0; i < 4; ++i) { const int v = g8 * 32 + q * 8 + 2 * i; VT[v * 72 + c2] = (bf16)(vw[i] & 0xffff); VT[(v + 1) * 72 + c2] = (bf16)(vw[i] >> 16); } }
        }
        __syncthreads();
        {
            const int ti = w >> 1;
#pragma unroll
            for (int s = 0; s < 2; ++s) { const int tj = 2 * (w & 1) + s; pg8::f32x4 acc = (pg8::f32x4){0.f, 0.f, 0.f, 0.f};
                if (tj <= ti) {
#pragma unroll
                    for (int kk = 0; kk < 128; kk += 32) { const bf16x8 aa = *(const LAS bf16x8*)(QD + (16 * ti + l15) * 136 + kk + quad * 8), bb = *(const LAS bf16x8*)(KI + (16 * tj + l15) * 136 + kk + quad * 8);
                        acc = __builtin_amdgcn_mfma_f32_16x16x32_bf16(aa, bb, acc, 0, 0, 0); } }
#pragma unroll
                for (int j = 0; j < 4; ++j) { const int i = 16 * ti + quad * 4 + j, jj = 16 * tj + l15; P[i * 72 + jj] = (bf16)f2bf(jj <= i ? acc[j] : 0.f); } }
        }
        __syncthreads();
        {
            const int ti = w >> 1, half = w & 1; pg8::f32x4 acc[8];
#pragma unroll
            for (int nn = 0; nn < 8; ++nn) acc[nn] = (pg8::f32x4){0.f, 0.f, 0.f, 0.f};
#pragma unroll
            for (int kk = 0; kk < 64; kk += 32) { const bf16x8 aa = *(const LAS bf16x8*)(P + (16 * ti + l15) * 72 + kk + quad * 8);
#pragma unroll
                for (int nn = 0; nn < 8; ++nn) { const bf16x8 bb = *(const LAS bf16x8*)(VT + (128 * half + 16 * nn + l15) * 72 + kk + quad * 8); acc[nn] = __builtin_amdgcn_mfma_f32_16x16x32_bf16(aa, bb, acc[nn], 0, 0, 0); } }
            const bf16* pv = PREVT + (size_t)unit * 32768 + (size_t)(128 * half + l15) * 128 + quad * 8;
#pragma unroll
            for (int kk = 0; kk < 128; kk += 32) { const bf16x8 aa = *(const LAS bf16x8*)(QD + (16 * ti + l15) * 136 + kk + quad * 8);
#pragma unroll
                for (int nn = 0; nn < 8; ++nn) { const bf16x8 bb = *(const bf16x8*)(pv + (size_t)(16 * nn) * 128 + kk); acc[nn] = __builtin_amdgcn_mfma_f32_16x16x32_bf16(aa, bb, acc[nn], 0, 0, 0); } }
            float ss[4];
#pragma unroll
            for (int j = 0; j < 4; ++j) { float s = 0.f;
#pragma unroll
                for (int nn = 0; nn < 8; ++nn) s += acc[nn][j] * acc[nn][j];
                s += __shfl_xor(s, 1); s += __shfl_xor(s, 2); s += __shfl_xor(s, 4); s += __shfl_xor(s, 8); ss[j] = s; }
            if (l15 == 0) {
#pragma unroll
                for (int j = 0; j < 4; ++j) RED[(16 * ti + quad * 4 + j) * 2 + half] = ss[j]; }
            __syncthreads();
#pragma unroll
            for (int j = 0; j < 4; ++j) { const int i = 16 * ti + quad * 4 + j; const float ms = (RED[i * 2] + RED[i * 2 + 1]) * (1.0f / 256.0f); const float rs = 1.0f / sqrtf(ms + LN_EPS);
                const size_t t = (size_t)(t0 + i);
#pragma unroll
                for (int nn = 0; nn < 8; ++nn) { const int v = 128 * half + 16 * nn + l15; const float gr = bf2f(PROJ[t * NP0 + 2048 + h * 256 + v]);
                    OMIX[t * DM + h * 256 + v] = (bf16)f2bf(acc[nn][j] * rs * normg[v] * fast_silu(gr)); } }
        }
    }
    __syncthreads();
}
__device__ __forceinline__ void ph_indexer(Frame& F, unsigned char* lds_generic) {
    typedef float f32x16 __attribute__((ext_vector_type(16)));
    const bf16* PROJ1 = (const bf16*)(F.ws + WS_PROJ); const bf16* IK = (const bf16*)(F.ws + WS_IK); const float* IW = (const float*)(F.ws + WS_IW); unsigned long long* MASK = (unsigned long long*)(F.ws + WS_MASK);
    LAS float* SCL = (LAS float*)F.lds;
    const int lane = F.lane, w = F.wave, c32 = lane & 31, hi = lane >> 5, rt = w & 3, kpar = w >> 2;
    for (int it = blockIdx.x; it < 512; it += F.G) {
#pragma unroll 1
        for (int pass = 0; pass < 2; ++pass) {
            const int unit = pass ? 1023 - it : it, m0 = unit * 8, b = m0 >> 12, qmax = (m0 & 4095) + 7;
            __syncthreads();
            {
                const int qa = m0 + 2 * rt + ((c32 >> 2) & 1), ha = (c32 & 3) + 4 * (c32 >> 3);
                const bf16* ap = PROJ1 + (size_t)qa * NP1 + 3072 + ha * 64 + 8 * hi;
                bf16x8 af[4];
#pragma unroll
                for (int ks = 0; ks < 4; ++ks) af[ks] = *(const bf16x8*)(ap + 16 * ks);
                const float* wp = IW + (size_t)(m0 + 2 * rt + hi) * 16; float wv[16];
#pragma unroll
                for (int q4 = 0; q4 < 4; ++q4) { const f32x4 t4 = *(const f32x4*)(wp + 4 * q4); wv[4 * q4] = t4[0]; wv[4 * q4 + 1] = t4[1]; wv[4 * q4 + 2] = t4[2]; wv[4 * q4 + 3] = t4[3]; }
                LAS float* srow = SCL + (2 * rt + hi) * 4096 + c32;
                const bf16* kbase = IK + (size_t)b * SEQ * 64 + (size_t)lane * 8;
                bf16x8 bn[4];
#pragma unroll
                for (int ks = 0; ks < 4; ++ks) bn[ks] = *(const bf16x8*)(kbase + (size_t)(kpar * 4 + ks) * 512);
                for (int t = kpar; t * 32 <= qmax; t += 2) {
                    bf16x8 bc[4];
#pragma unroll
                    for (int ks = 0; ks < 4; ++ks) bc[ks] = bn[ks];
                    const int tn = (t + 2) * 32 <= qmax ? t + 2 : t;
#pragma unroll
                    for (int ks = 0; ks < 4; ++ks) bn[ks] = *(const bf16x8*)(kbase + (size_t)(tn * 4 + ks) * 512);
                    f32x16 acc = {};
#pragma unroll
                    for (int ks = 0; ks < 4; ++ks) acc = __builtin_amdgcn_mfma_f32_32x32x16_bf16(af[ks], bc[ks], acc, 0, 0, 0);
                    float s = 0.f;
#pragma unroll
                    for (int r = 0; r < 16; ++r) s += wv[r] * fmaxf(acc[r], 0.f);
                    srow[t * 32] = s; }
            }
            __syncthreads();
            { const int m = m0 + w; topk_mask_row((const LAS float*)(F.lds + w * 16384), m & 4095, MASK + (size_t)m * 64, lane, (LAS unsigned*)(F.lds + LDSCTL_OFF + 4096 + w * 1024)); }
        }
    }
    __syncthreads();
}
#define IN(k) (lo <= (k) && (k) < hi)
#define SEAM(k) do { if (hi > (k) + 1) xcd_barrier(bar); } while (0)
template <int LAYER, int BASE>
__device__ __forceinline__ void common_phases(Frame& F, const Args& args, const int lo, const int hi, const XcdBarrier& bar) {
    unsigned char* ws = args.ws;
    if (IN(BASE + 0)) {
        pg8::Gemm g{(const bf16*)(ws + WS_OMIX), (const bf16*)(ws + (LAYER ? WS_WOC : WS_WOA)), MTOK, DM, DM, DM, DM}; pg8::StaticOrder S; S.init(MTOK, DM, F.G, (int)blockIdx.x);
        pg8::EpiResid E{(const bf16*)(ws + WS_XB), (bf16*)(ws + WS_YB), DN_ALPHA};
        pg8::gemm_phase<pg8::EpiResid, pg8::StaticOrder, true, true>(F.lds, g, S, E);
        SEAM(BASE + 0);
    }
    if (IN(BASE + 1)) { p_ln_route(F, args, LAYER); SEAM(BASE + 1); }
    if (IN(BASE + 3) || IN(BASE + 4) || IN(BASE + 5)) {
        if (F.wave == 0) { int ti; (void)moe_offsets(F.ctl + CW_CNT + LAYER * 64, F.lane, &ti); if (F.lane < 32) { F.MISC[64 + F.lane] = (unsigned)ti; F.MISC[160 + F.lane] = F.ctl[CW_CNT + LAYER * 64 + F.lane]; } if (F.lane == 31) F.MISC[96] = (unsigned)ti; }
        __syncthreads();
    }
    {
        const int Tm = (int)F.MISC[96], T1 = F.G / 4 < Tm ? F.G / 4 : Tm;
        const int n2 = (Tm - T1) * 4;
        const pg8::Gemm gU{(const bf16*)(ws + WS_XB), (const bf16*)(ws + WS_WGU) + (size_t)LAYER * 32 * 1024 * 2048, RPAD, 32 * 1024, DM, DM, DM};
        const pg8::Gemm gD{(const bf16*)(ws + WS_OMIX), (const bf16*)(ws + WS_WD) + (size_t)LAYER * 32 * 2048 * 512, RPAD, 32 * 2048, 512, 512, 512};
        const PG8_LAS int* tend = (const LAS int*)(F.lds + LDSCTL_OFF + 64 * 4); const PG8_LAS int* ecnt = (const LAS int*)(F.lds + LDSCTL_OFF + 160 * 4);
        const int* inv = (const int*)(ws + WS_INV);
        const pg8::EpiGLU EU{(bf16*)(ws + WS_OMIX), (const float*)(ws + WS_WINV)}; const pg8::EpiBf16Plain ED{(bf16*)(ws + WS_CST), DM, 7};
        if (IN(BASE + 3)) {
            pg8::MoeOrder S{F.G, (int)blockIdx.x, 4, 0, T1 * 4, tend, ecnt};
            pg8::gemm_phase_g<pg8::EpiGLU, pg8::MoeOrder>(F.lds, gU, S, EU, inv);
            SEAM(BASE + 3);
        }
        if (IN(BASE + 4)) {
            if ((int)blockIdx.x < n2) { pg8::MoeOrder S{n2, (int)blockIdx.x, 4, T1 * 4, Tm * 4, tend, ecnt}; pg8::gemm_phase_g<pg8::EpiGLU, pg8::MoeOrder>(F.lds, gU, S, EU, inv); }
            else { pg8::MoeOrder S{F.G - n2, (int)blockIdx.x - n2, 8, 0, T1 * 8, tend, ecnt}; pg8::gemm_phase<pg8::EpiBf16Plain, pg8::MoeOrder, true, true>(F.lds, gD, S, ED); }
            SEAM(BASE + 4);
        }
        if (IN(BASE + 5)) {
            pg8::MoeOrder S{F.G, (int)blockIdx.x, 8, T1 * 8, Tm * 8, tend, ecnt};
            pg8::gemm_phase<pg8::EpiBf16Plain, pg8::MoeOrder, true, true>(F.lds, gD, S, ED);
            SEAM(BASE + 5);
        }
    }
    if (IN(BASE + 6)) { p_ln_ffn(F, args, LAYER); SEAM(BASE + 6); }
}
__global__ void __launch_bounds__(NWAVES * 64, 2) mk_fwd(Args args) {
    extern __shared__ __attribute__((aligned(16))) unsigned char lds[];
    Frame F;
    F.lds = (LAS unsigned char*)lds; F.MISC = (volatile LAS unsigned*)(F.lds + LDSCTL_OFF);
    F.tid = threadIdx.x; F.lane = F.tid & 63; F.wave = __builtin_amdgcn_readfirstlane(F.tid >> 6);
    F.G = gridDim.x; F.gw = blockIdx.x * NWAVES + F.wave; F.NGW = F.G * NWAVES;
    F.ws = args.ws; F.ctl = (unsigned*)(args.ws + WS_CTL);
    for (int u = F.tid; u < (LDS_BYTES - LDSCTL_OFF) / 4; u += NWAVES * 64) ((LAS unsigned*)(F.lds + LDSCTL_OFF))[u] = 0u;
    __syncthreads();
    const int lo = args.ph_lo, hi = args.ph_hi;
    XcdBarrier bar; bar.bar = F.ctl + CW_BAR + args.bar_region * XCD_BAR_WORDS; bar.x = 0; bar.st = nullptr;
    if (hi - lo > 1) bar = xcd_barrier_post(F.ctl + CW_BAR + args.bar_region * XCD_BAR_WORDS, F.MISC);
    unsigned char* ws = args.ws;

    if (IN(0)) { p0_prologue(F, args); SEAM(0); }
    if (IN(1)) {
        pg8::Gemm g{(const bf16*)(ws + WS_XB), (const bf16*)(ws + WS_WINA), MTOK, NP0, DM, DM, DM}; pg8::StaticOrder S; S.init(MTOK, NP0, F.G, (int)blockIdx.x);
        pg8::EpiBf16Plain E{(bf16*)(ws + WS_PROJ), NP0, 0x7fffffff};
        pg8::gemm_phase<pg8::EpiBf16Plain, pg8::StaticOrder, true, true>(F.lds, g, S, E);
        p_skinny0(F, args);
        SEAM(1);
    }
    if (IN(2)) { p_fox_bias(F, args); ph_gla_a(F, args); SEAM(2); }
    if (IN(4)) { ph_gla_scan(F); __syncthreads();
        attn::attn_phase<true, false, 8, 1, false, NP0, NP0, DM>((char*)lds, F.lds, (const bf16*)(ws + WS_PROJ) + 3072, (const bf16*)(ws + WS_PROJ) + 4096, (const bf16*)(ws + WS_PROJ) + 5120,
                                                               (bf16*)(ws + WS_OMIX) + 1024, (const float*)(ws + WS_FBIAS), (const unsigned long long*)nullptr, F.G, (int)blockIdx.x);
        late_conv_items(F, args);
        SEAM(4); }
    if (IN(5)) { ph_gla_c(F, args); SEAM(5); }
    common_phases<0, 6>(F, args, lo, hi, bar);
    if (IN(13)) {
        pg8::Gemm g{(const bf16*)(ws + WS_XB), (const bf16*)(ws + WS_WINC), MTOK, NP1, DM, DM, DM}; pg8::StaticOrder S; S.init(MTOK, NP1, F.G, (int)blockIdx.x);
        const float* c128 = (const float*)(ws + WS_ROPE);
        pg8::EpiRope E{(bf16*)(ws + WS_PROJ), c128, c128 + 4096 * 64, c128 + 2 * 4096 * 64, c128 + 2 * 4096 * 64 + 4096 * 32};
        pg8::gemm_phase<pg8::EpiRope, pg8::StaticOrder, true, true>(F.lds, g, S, E);
        SEAM(13);
    }
    if (IN(14)) { ph_indexer(F, lds); SEAM(14); }
    if (IN(16)) {
        attn::attn_phase<false, true, 16, 4, true, NP1, NP1, DM>((char*)lds, F.lds, (const bf16*)(ws + WS_PROJ), (const bf16*)(ws + WS_PROJ) + 2048, (const bf16*)(ws + WS_PROJ) + 2560,
                                                               (bf16*)(ws + WS_OMIX), (const float*)nullptr, (const unsigned long long*)(ws + WS_MASK), F.G, (int)blockIdx.x);
        SEAM(16); }
    common_phases<1, 17>(F, args, lo, hi, bar);
#ifdef PROBE_CONV
    if (IN(31)) {
        LAS bf16* T = (LAS bf16*)(F.lds + F.wave * 16384); bf16* dstb = (bf16*)(ws + WS_SC); float sink = 0.f;
        for (int it = F.gw; it < 32 * 256; it += F.NGW) {
            const int ex = 32 + it / 256, r = it % 256, kb = r / 8, nb = r % 8;
            TrItem t{args.in[17] + (size_t)ex * 2048 * 512, dstb + (size_t)(it / 256) * 512 * 2048, 512, nb * 64, nb * 64 + 32, 2048, nb * 64, kb * 64};
            f32x4 r16[16]; tr64_load(t, r16, F.lane);
            if (PROBE_CONV == 0) tr64_store(t, r16, T, F.lane);
            else if (PROBE_CONV == 1) {
#pragma unroll
                for (int i = 0; i < 8; ++i) { uint2 o; o.x = pg8::cvt_pk_bf16(r16[2 * i][0], r16[2 * i][1]); o.y = pg8::cvt_pk_bf16(r16[2 * i][2], r16[2 * i][3]); uint2 p; p.x = pg8::cvt_pk_bf16(r16[2 * i + 1][0], r16[2 * i + 1][1]); p.y = pg8::cvt_pk_bf16(r16[2 * i + 1][2], r16[2 * i + 1][3]);
                    bf16* d = dstb + (size_t)(it / 256) * 512 * 2048 + (size_t)(kb * 64 + 8 * i + 2 * (F.lane >> 4)) * 512 + nb * 64 + 4 * (F.lane & 15); *(uint2*)d = o; *(uint2*)(d + 512) = p; } }
            else {
#pragma unroll
                for (int i = 0; i < 16; ++i) sink += r16[i][0] + r16[i][3]; }
        }
        if (PROBE_CONV == 2 && sink == 12345.678f) dstb[F.tid] = 1;
    }
#endif
#ifdef PROBE_GEMM_K
    if (IN(30)) {
        pg8::Gemm g{(const bf16*)(ws + WS_XB), (const bf16*)(ws + WS_WINA), MTOK, NP0, PROBE_GEMM_K, PROBE_GEMM_LD, PROBE_GEMM_LD}; pg8::StaticOrder S; S.init(MTOK, NP0, F.G, (int)blockIdx.x);
        pg8::EpiBf16Plain E{(bf16*)(ws + WS_SC), NP0, 0x7fffffff};
        pg8::gemm_phase<pg8::EpiBf16Plain, pg8::StaticOrder, true, true>(F.lds, g, S, E);
    }
#endif
}
#undef IN
#undef SEAM
constexpr int N_PHASE_IDS = 24;
static void launch_mk(const Args& base, int lo, int hi, int grid, hipStream_t stream, int region = 0) {
    Args a = base; a.ph_lo = lo; a.ph_hi = hi; a.bar_region = region; a.pad = 0;
    hipLaunchKernelGGL(mk_fwd, dim3(grid), dim3(NWAVES * 64), LDS_BYTES, stream, a);
}
extern "C" void kernel_launch(void* const* d_in, const int* in_sizes, int n_in, void* d_out, int out_size, void* d_ws, size_t ws_size, hipStream_t stream) {
    static int grid = 0;
    if (grid == 0) {
        if (n_in != 20 || out_size != MTOK * DM || ws_size < WS_END) { fprintf(stderr, "kernel_launch: unexpected shapes (n_in %d, out %d, ws %zu < %zu)\n", n_in, out_size, ws_size, (size_t)WS_END); grid = -1; return; }
        int dev = 0, cus = 0, per_cu = 0;
        if (hipGetDevice(&dev) != hipSuccess || hipDeviceGetAttribute(&cus, hipDeviceAttributeMultiprocessorCount, dev) != hipSuccess) { grid = -1; return; }
        if (hipFuncSetAttribute((const void*)mk_fwd, hipFuncAttributeMaxDynamicSharedMemorySize, LDS_BYTES) != hipSuccess) { fprintf(stderr, "kernel_launch: hipFuncSetAttribute failed\n"); grid = -1; return; }
        if (hipOccupancyMaxActiveBlocksPerMultiprocessor(&per_cu, (const void*)mk_fwd, NWAVES * 64, LDS_BYTES) != hipSuccess || per_cu < 1) { fprintf(stderr, "kernel_launch: occupancy query reports %d workgroups per CU\n", per_cu); }
        (void)hipGetLastError();
        grid = cus;
    }
    if (grid < 0) return;
    (void)in_sizes;
    if (hipMemsetAsync((char*)d_ws + WS_CTL, 0, CTL_ZERO_BYTES, stream) != hipSuccess) return;
    Args a{};
    for (int i = 0; i < 20; ++i) a.in[i] = (const float*)d_in[i];
    a.out = (float*)d_out; a.ws = (unsigned char*)d_ws;
#ifdef PROBE_LO
    launch_mk(a, 0, PROBE_HI + 1, grid, stream, 0); launch_mk(a, PROBE_LO, N_PHASE_IDS, grid, stream, 1);
#else
    launch_mk(a, 0, N_PHASE_IDS, grid, stream);
#endif
#ifdef PROBE_GEMM_K
    launch_mk(a, 30, 31, grid, stream, 2);
#endif
#ifdef PROBE_CONV
    launch_mk(a, 31, 32, grid, stream, 2);
#endif
}
```

```cpp
#include <hip/hip_runtime.h>
#include <cstdio>
#include <cstdint>
namespace pg8 {
#define PG8_LAS __attribute__((address_space(3)))
typedef unsigned short bf16_t;
typedef short bf16x8 __attribute__((ext_vector_type(8)));
typedef float f32x4 __attribute__((ext_vector_type(4)));
typedef unsigned u32x4 __attribute__((ext_vector_type(4)));
constexpr int BM = 256, BK = 64, HALF = 128, HTB = HALF * BK * 2  , STAGE_BYTES = 8 * HTB, NXCD = 8, WGM = 8;

__host__ __device__ __forceinline__ int lds_byte(int r, int c) { const int st = (r >> 4) * 2 + (c >> 5), rr = r & 15, cc = c & 31, ob = rr * 64 + cc * 2; return st * 1024 + (ob ^ (((ob >> 9) & 1) << 5)); }
__host__ __device__ __forceinline__ void stage_rc(int b, int& R, int& C) { const int st = b / 1024, sb = b % 1024, swz = sb ^ (((sb >> 9) & 1) << 5); R = (st >> 1) * 16 + swz / 64; C = (st & 1) * 32 + (swz % 64) / 2; }
__host__ __device__ __forceinline__ int perm32(int rho) { const int n = rho >> 4, i = rho & 15; return 8 * (i >> 2) + 4 * n + (i & 3); }

struct Unit { int pm, pn, inv0, nvalid, half; };
struct Gemm { const bf16_t* A; const bf16_t* Bt; int M, N, K, lda, ldb; };

struct StaticOrder {
    int nM, nN, nwg, G, c;
    __host__ __device__ void init(int M, int N, int G_, int c_) { nM = M / BM; nN = N / BM; nwg = nM * nN; G = G_; c = c_; }
    __host__ __device__ bool next(int i, Unit& u) const {
        const long L = (long)i * G + c; if (L >= nwg) return false;
        int wgid = (int)L; { const int q = nwg / NXCD, r = nwg % NXCD, xcd = wgid % NXCD, off = wgid / NXCD; wgid = (xcd < r ? xcd * (q + 1) : r * (q + 1) + (xcd - r) * q) + off; }
        const int nig = WGM * nN, gid = wgid / nig, fm = gid * WGM, gsz = (nM - fm) < WGM ? (nM - fm) : WGM;
        u.pm = fm + ((wgid % nig) % gsz); u.pn = (wgid % nig) / gsz; return true;
    }
    __device__ __forceinline__ void a_ready(const Unit&) const {}
    __device__ __forceinline__ void done(const Unit&) const {}
};

__device__ __forceinline__ unsigned cvt_pk_bf16(float lo, float hi) { unsigned r; asm volatile("v_cvt_pk_bf16_f32 %0, %1, %2" : "=v"(r) : "v"(lo), "v"(hi)); return r; }
typedef float f32x2 __attribute__((ext_vector_type(2)));
struct EpiBf16Plain {
    static constexpr bool PERM = true, AFTER_DRAIN = false;
    bf16_t* O; int ldc; int pn_mask;
    __device__ __forceinline__ void operator()(const f32x4 (&acc)[2][2][4][2], const Unit& u, int wr, int wc, int fr, int fq) const {
        const int row0 = u.pm * BM + wr * 64 + fr, col0 = (u.pn & pn_mask) * BM + wc * 32 + 8 * fq;
#pragma unroll
        for (int ai = 0; ai < 2; ++ai)
#pragma unroll
            for (int m = 0; m < 4; ++m) { bf16_t* rowp = O + (size_t)(row0 + ai * HALF + m * 16) * ldc + col0;
#pragma unroll
                for (int bj = 0; bj < 2; ++bj) { const f32x4 v0 = acc[ai][bj][m][0], v1 = acc[ai][bj][m][1];
                    u32x4 w; w.x = cvt_pk_bf16(v0[0], v0[1]); w.y = cvt_pk_bf16(v0[2], v0[3]); w.z = cvt_pk_bf16(v1[0], v1[1]); w.w = cvt_pk_bf16(v1[2], v1[3]);
                    *(u32x4*)(rowp + bj * HALF) = w; } }
    }
};
struct EpiResid {
    static constexpr bool PERM = true, AFTER_DRAIN = false;
    const bf16_t* base; bf16_t* out; float alpha;
    __device__ __forceinline__ void operator()(const f32x4 (&acc)[2][2][4][2], const Unit& u, int wr, int wc, int fr, int fq) const {
        const int row0 = u.pm * BM + wr * 64 + fr, col0 = u.pn * BM + wc * 32 + 8 * fq;
#pragma unroll
        for (int ai = 0; ai < 2; ++ai)
#pragma unroll
            for (int m = 0; m < 4; ++m) { const size_t off = (size_t)(row0 + ai * HALF + m * 16) * 2048 + col0;
#pragma unroll
                for (int bj = 0; bj < 2; ++bj) { const u32x4 b = *(const u32x4*)(base + off + bj * HALF); const f32x4 v0 = acc[ai][bj][m][0], v1 = acc[ai][bj][m][1];
                    const unsigned bw[4] = {b.x, b.y, b.z, b.w}; u32x4 w; unsigned* wp = (unsigned*)&w;
#pragma unroll
                    for (int q = 0; q < 4; ++q) { const float lo = __builtin_bit_cast(float, bw[q] << 16), hi = __builtin_bit_cast(float, bw[q] & 0xffff0000u);
                        const float a0 = q < 2 ? v0[2 * q] : v1[2 * q - 4], a1 = q < 2 ? v0[2 * q + 1] : v1[2 * q - 3];
                        wp[q] = cvt_pk_bf16(lo * alpha + a0, hi * alpha + a1); }
                    *(u32x4*)(out + off + bj * HALF) = w; } }
    }
};
struct EpiGLU {
    static constexpr bool PERM = true, AFTER_DRAIN = false;
    bf16_t* H; const float* winv;
    __device__ __forceinline__ void operator()(const f32x4 (&acc)[2][2][4][2], const Unit& u, int wr, int wc, int fr, int fq) const {
        const int row0 = u.pm * BM + wr * 64 + fr, f0 = (u.pn & 3) * 128 + wc * 32 + 8 * fq;
#pragma unroll
        for (int ai = 0; ai < 2; ++ai) { if (u.half >= 0 && u.half != ai) continue;
#pragma unroll
            for (int m = 0; m < 4; ++m) { const int row = row0 + ai * HALF + m * 16; const float w = winv[u.inv0 + ai * HALF + wr * 64 + m * 16 + fr];
                float h[8];
#pragma unroll
                for (int n = 0; n < 2; ++n)
#pragma unroll
                    for (int e = 0; e < 4; ++e) { const float g = acc[ai][0][m][n][e], up = acc[ai][1][m][n][e]; h[n * 4 + e] = g * __builtin_amdgcn_rcpf(1.0f + __expf(-g)) * up * w; }
                u32x4 o; o.x = cvt_pk_bf16(h[0], h[1]); o.y = cvt_pk_bf16(h[2], h[3]); o.z = cvt_pk_bf16(h[4], h[5]); o.w = cvt_pk_bf16(h[6], h[7]);
                *(u32x4*)(H + (size_t)row * 512 + f0) = o; } }
    }
};
struct EpiRope {
    static constexpr bool PERM = true, AFTER_DRAIN = false;
    bf16_t* O; const float* c128; const float* s128; const float* c64; const float* s64;
    __device__ __forceinline__ void operator()(const f32x4 (&acc)[2][2][4][2], const Unit& u, int wr, int wc, int fr, int fq) const {
        const int row0 = u.pm * BM + wr * 64 + fr, jj = wc * 32 + 8 * fq;
        const int pn = u.pn;
        if (pn == 10 || pn == 11) {
#pragma unroll
            for (int ai = 0; ai < 2; ++ai)
#pragma unroll
                for (int m = 0; m < 4; ++m) { bf16_t* rowp = O + (size_t)(row0 + ai * HALF + m * 16) * 4096 + pn * 256 + jj;
#pragma unroll
                    for (int bj = 0; bj < 2; ++bj) { const f32x4 v0 = acc[ai][bj][m][0], v1 = acc[ai][bj][m][1];
                        u32x4 w; w.x = cvt_pk_bf16(v0[0], v0[1]); w.y = cvt_pk_bf16(v0[2], v0[3]); w.z = cvt_pk_bf16(v1[0], v1[1]); w.w = cvt_pk_bf16(v1[2], v1[3]);
                        *(u32x4*)(rowp + bj * HALF) = w; } }
            return;
        }
        const bool idx = pn >= 12;
        const int half = idx ? 32 : 64;
        const int hl = idx ? (jj >> 5) : (jj >> 6), i0 = jj & (half - 1);
        const int colbase = idx ? (3072 + ((pn - 12) * 4 + hl) * 64) : (pn * 256 + hl * 128);
        const float* ct = idx ? c64 : c128; const float* st = idx ? s64 : s128;
#pragma unroll
        for (int ai = 0; ai < 2; ++ai)
#pragma unroll
            for (int m = 0; m < 4; ++m) { const int row = row0 + ai * HALF + m * 16; const int pos = row & 4095;
                const float* cp = ct + (size_t)pos * half + i0; const float* sp = st + (size_t)pos * half + i0;
                const f32x4 c0 = *(const f32x4*)cp, c1 = *(const f32x4*)(cp + 4), s0 = *(const f32x4*)sp, s1 = *(const f32x4*)(sp + 4);
                const f32x4 a0 = acc[ai][0][m][0], a1 = acc[ai][0][m][1], b0 = acc[ai][1][m][0], b1 = acc[ai][1][m][1];
                const f32x4 x0 = a0 * c0 - b0 * s0, x1 = a1 * c1 - b1 * s1, y0 = b0 * c0 + a0 * s0, y1 = b1 * c1 + a1 * s1;
                bf16_t* rowp = O + (size_t)row * 4096 + colbase + i0;
                u32x4 w; w.x = cvt_pk_bf16(x0[0], x0[1]); w.y = cvt_pk_bf16(x0[2], x0[3]); w.z = cvt_pk_bf16(x1[0], x1[1]); w.w = cvt_pk_bf16(x1[2], x1[3]);
                *(u32x4*)rowp = w;
                u32x4 z; z.x = cvt_pk_bf16(y0[0], y0[1]); z.y = cvt_pk_bf16(y0[2], y0[3]); z.z = cvt_pk_bf16(y1[0], y1[1]); z.w = cvt_pk_bf16(y1[2], y1[3]);
                *(u32x4*)(rowp + half) = z; }
    }
};
struct MoeOrder {
    int G, c, ntn, L0, Lend, hsplit; const PG8_LAS int* tend; const PG8_LAS int* cnt;
    __device__ __forceinline__ bool next(int i, Unit& u) const {
        const int Lx = L0 + i * G + c; if (Lx >= Lend) return false;
        const int L = hsplit ? Lx >> 1 : Lx;
        const int t = L / ntn; int e = 0;
#pragma unroll 1
        for (int k = 0; k < 32; ++k) e += (t >= tend[k]) ? 1 : 0;
        const int p0 = (t - (e ? tend[e - 1] : 0)) * BM, left = cnt[e] - p0;
        u.pm = t; u.pn = e * ntn + (L - t * ntn); u.inv0 = e * 8192 + p0; u.nvalid = left < BM ? left : BM; u.half = hsplit ? (Lx & 1) : -1; return true;
    }
    __device__ __forceinline__ void a_ready(const Unit&) const {}
    __device__ __forceinline__ void done(const Unit&) const {}
};
template <class Epi, class Sched, bool ALIGN_EPI = false, bool SP2 = false>
__device__ __forceinline__ void gemm_phase(PG8_LAS unsigned char* lds, const Gemm g, const Sched& S, const Epi& E) {
    const int tid = threadIdx.x, wid = __builtin_amdgcn_readfirstlane(tid >> 6), lane = tid & 63, wr = wid >> 2, wc = wid & 3, fr = lane & 15, fq = lane >> 4;
    const int K = g.K, nt = K / BK;
    unsigned voffA[2], voffB[2];
#pragma unroll
    for (int i = 0; i < 2; ++i) { int R, C; stage_rc(tid * 16 + i * 8192, R, C); const int Rb = Epi::PERM ? ((R & ~31) + perm32(R & 31)) : R;
        voffA[i] = (unsigned)(R * g.lda + C) * 2u; voffB[i] = (unsigned)(Rb * g.ldb + C) * 2u; }
    const size_t kstep = (size_t)(BK * 2);
    const size_t hstepA = (size_t)HALF * g.lda * 2, hstepB = (size_t)HALF * g.ldb * 2;
    const size_t tstepA = 2 * hstepA, tstepB = 2 * hstepB;
    const unsigned ldsw = (unsigned)wid * 1024u;
    const int aoff = lds_byte(wr * 64 + fr, fq * 8), boff = lds_byte(wc * 32 + fr, fq * 8);
#define PG8_SA(b, h) (((b) * 2 + (h)) * HTB)
#define PG8_SB(b, h) ((4 + (b) * 2 + (h)) * HTB)
#define PG8_STAGE(bufoff, gbase, voff) do { _Pragma("unroll") for (int _i = 0; _i < 2; ++_i) \
        __builtin_amdgcn_global_load_lds((const unsigned*)((const char*)(gbase) + (voff)[_i]), (PG8_LAS unsigned*)(lds + (bufoff) + ldsw + _i * 8192), 16, 0, 0); } while (0)
#define PG8_LDA(dst, b, h) do { _Pragma("unroll") for (int m = 0; m < 4; ++m) _Pragma("unroll") for (int k = 0; k < 2; ++k) dst[m][k] = *(const PG8_LAS bf16x8*)(lds + PG8_SA(b, h) + aoff + m * 2048 + k * 1024); } while (0)
#define PG8_LDB(dst, b, h) do { _Pragma("unroll") for (int n = 0; n < 2; ++n) _Pragma("unroll") for (int k = 0; k < 2; ++k) dst[n][k] = *(const PG8_LAS bf16x8*)(lds + PG8_SB(b, h) + boff + n * 2048 + k * 1024); } while (0)
#define PG8_MMA(ai, bj, At, Bt) do { __builtin_amdgcn_s_setprio(1); _Pragma("unroll") for (int m = 0; m < 4; ++m) _Pragma("unroll") for (int n = 0; n < 2; ++n) _Pragma("unroll") for (int k = 0; k < 2; ++k) \
        acc[ai][bj][m][n] = __builtin_amdgcn_mfma_f32_16x16x32_bf16(Bt[n][k], At[m][k], acc[ai][bj][m][n], 0, 0, 0); __builtin_amdgcn_s_setprio(0); } while (0)
#define PG8_WAIT_V(n) asm volatile("s_waitcnt vmcnt(" #n ")" ::: "memory")
#define PG8_WAIT_L(n) asm volatile("s_waitcnt lgkmcnt(" #n ")" ::: "memory")
#define PG8_BAR __builtin_amdgcn_s_barrier()
#define PG8_SCHED __builtin_amdgcn_sched_barrier(0)
    Unit cur, nxt; int ui = 0;
    if (!S.next(0, cur)) return;
    f32x4 acc[2][2][4][2];
#pragma unroll
    for (int a = 0; a < 2; ++a)
#pragma unroll
        for (int b = 0; b < 2; ++b)
#pragma unroll
            for (int m = 0; m < 4; ++m)
#pragma unroll
                for (int n = 0; n < 2; ++n) acc[a][b][m][n] = (f32x4){0.f, 0.f, 0.f, 0.f};
    bf16x8 At[4][2], B0[2][2], B1[2][2];
    const char* cA = (const char*)g.A + (size_t)cur.pm * tstepA; const char* cB = (const char*)g.Bt + (size_t)cur.pn * tstepB;
    S.a_ready(cur);
    if constexpr (SP2) {
        PG8_STAGE(PG8_SB(0, 0), cB, voffB); PG8_STAGE(PG8_SB(0, 1), cB + hstepB, voffB); PG8_STAGE(PG8_SA(0, 0), cA, voffA); PG8_STAGE(PG8_SA(0, 1), cA + hstepA, voffA);
        if (wr == 1) PG8_BAR;
        PG8_WAIT_V(2); PG8_BAR;
        PG8_STAGE(PG8_SB(1, 0), cB + kstep, voffB); PG8_STAGE(PG8_SA(1, 0), cA + kstep, voffA); PG8_STAGE(PG8_SB(1, 1), cB + hstepB + kstep, voffB);
        PG8_WAIT_V(6); PG8_BAR;
    } else {
        PG8_STAGE(PG8_SB(0, 0), cB, voffB); PG8_STAGE(PG8_SA(0, 0), cA, voffA); PG8_STAGE(PG8_SB(0, 1), cB + hstepB, voffB); PG8_STAGE(PG8_SA(0, 1), cA + hstepA, voffA);
        if (wr == 1) PG8_BAR;
        PG8_WAIT_V(4); PG8_BAR;
        PG8_STAGE(PG8_SB(1, 0), cB + kstep, voffB); PG8_STAGE(PG8_SA(1, 0), cA + kstep, voffA); PG8_STAGE(PG8_SB(1, 1), cB + hstepB + kstep, voffB);
        PG8_WAIT_V(6); PG8_BAR;
    }
    for (;;) {
        const bool has_next = S.next(ui + 1, nxt);
        const char* nA = has_next ? (const char*)g.A + (size_t)nxt.pm * tstepA : cA; const char* nB = has_next ? (const char*)g.Bt + (size_t)nxt.pn * tstepB : cB;
        for (int t = 0; t < nt; t += 2) {
            const bool last = (t == nt - 2);
            const char* a1 = cA + (size_t)(t + 1) * kstep;
            const char* a2 = last ? nA : cA + (size_t)(t + 2) * kstep; const char* b2 = last ? nB : cB + (size_t)(t + 2) * kstep;
            const char* a3 = a2 + kstep; const char* b3 = b2 + kstep;
            if (last && has_next) S.a_ready(nxt);
            if constexpr (SP2) {
            PG8_LDB(B0, 0, 0); PG8_LDB(B1, 0, 1); PG8_SCHED; PG8_LDA(At, 0, 0); PG8_STAGE(PG8_SA(1, 1), a1 + hstepA, voffA);
            PG8_WAIT_V(8); PG8_WAIT_L(0); PG8_BAR; PG8_MMA(0, 0, At, B0); PG8_MMA(0, 1, At, B1); PG8_BAR; PG8_SCHED;
            PG8_LDA(At, 0, 1); PG8_STAGE(PG8_SB(0, 0), b2, voffB); PG8_STAGE(PG8_SB(0, 1), b2 + hstepB, voffB); PG8_STAGE(PG8_SA(0, 0), a2, voffA);
            PG8_WAIT_V(8); PG8_WAIT_L(0); PG8_BAR; PG8_MMA(1, 0, At, B0); PG8_MMA(1, 1, At, B1); PG8_BAR; PG8_SCHED;
            PG8_LDB(B0, 1, 0); PG8_LDB(B1, 1, 1); PG8_SCHED; PG8_LDA(At, 1, 0); PG8_STAGE(PG8_SA(0, 1), a2 + hstepA, voffA);
            PG8_WAIT_V(8); PG8_WAIT_L(0); PG8_BAR; PG8_MMA(0, 0, At, B0); PG8_MMA(0, 1, At, B1); PG8_BAR; PG8_SCHED;
            PG8_LDA(At, 1, 1); PG8_STAGE(PG8_SB(1, 0), b3, voffB); PG8_STAGE(PG8_SB(1, 1), b3 + hstepB, voffB); PG8_STAGE(PG8_SA(1, 0), a3, voffA);
            PG8_WAIT_V(8); PG8_WAIT_L(0); PG8_BAR; PG8_MMA(1, 0, At, B0); PG8_MMA(1, 1, At, B1); PG8_BAR; PG8_SCHED;
            } else {
            PG8_LDB(B0, 0, 0); PG8_SCHED; PG8_LDA(At, 0, 0); PG8_STAGE(PG8_SA(1, 1), a1 + hstepA, voffA);
            PG8_WAIT_L(8); PG8_BAR; PG8_WAIT_L(0); PG8_MMA(0, 0, At, B0); PG8_BAR; PG8_SCHED;
            PG8_LDB(B1, 0, 1); PG8_STAGE(PG8_SB(0, 0), b2, voffB);
            PG8_BAR; PG8_WAIT_L(0); PG8_MMA(0, 1, At, B1); PG8_BAR;
            PG8_LDA(At, 0, 1); PG8_STAGE(PG8_SA(0, 0), a2, voffA);
            PG8_BAR; PG8_WAIT_L(0); PG8_MMA(1, 0, At, B0); PG8_BAR; PG8_SCHED;
            PG8_STAGE(PG8_SB(0, 1), b2 + hstepB, voffB);
            PG8_WAIT_V(6); PG8_BAR; PG8_MMA(1, 1, At, B1); PG8_BAR;
            PG8_LDB(B0, 1, 0); PG8_SCHED; PG8_LDA(At, 1, 0); PG8_STAGE(PG8_SA(0, 1), a2 + hstepA, voffA);
            PG8_WAIT_L(8); PG8_BAR; PG8_WAIT_L(0); PG8_MMA(0, 0, At, B0); PG8_BAR; PG8_SCHED;
            PG8_LDB(B1, 1, 1); PG8_STAGE(PG8_SB(1, 0), b3, voffB);
            PG8_BAR; PG8_WAIT_L(0); PG8_MMA(0, 1, At, B1); PG8_BAR;
            PG8_LDA(At, 1, 1); PG8_STAGE(PG8_SA(1, 0), a3, voffA);
            PG8_BAR; PG8_WAIT_L(0); PG8_MMA(1, 0, At, B0); PG8_BAR; PG8_SCHED;
            PG8_STAGE(PG8_SB(1, 1), b3 + hstepB, voffB);
            PG8_WAIT_V(6); PG8_BAR; PG8_MMA(1, 1, At, B1); PG8_BAR;
            }
        }
        if constexpr (ALIGN_EPI) { if (wr == 0) PG8_BAR; }
        if constexpr (!Epi::AFTER_DRAIN) { E(acc, cur, wr, wc, fr, fq); S.done(cur); }
        if (!has_next) break;
#pragma unroll
        for (int a = 0; a < 2; ++a)
#pragma unroll
            for (int b = 0; b < 2; ++b)
#pragma unroll
                for (int m = 0; m < 4; ++m)
#pragma unroll
                    for (int n = 0; n < 2; ++n) acc[a][b][m][n] = (f32x4){0.f, 0.f, 0.f, 0.f};
        cur = nxt; cA = nA; cB = nB; ++ui;
        if constexpr (ALIGN_EPI) { if (wr == 1) PG8_BAR; }
    }
    PG8_WAIT_V(0);
    if constexpr (!ALIGN_EPI) { if (wr == 0) PG8_BAR; }
    PG8_BAR;
    if constexpr (Epi::AFTER_DRAIN) { E.fused(acc, cur, wr, wc, fr, fq, lds, wid, lane); S.done(cur); }
#undef PG8_SA
#undef PG8_SB
#undef PG8_STAGE
#undef PG8_LDA
#undef PG8_LDB
#undef PG8_MMA
#undef PG8_WAIT_V
#undef PG8_WAIT_L
#undef PG8_BAR
#undef PG8_SCHED
}
template <class Epi, class Sched>
__device__ __forceinline__ void gemm_phase_g(PG8_LAS unsigned char* lds, const Gemm g, const Sched& S, const Epi& E, const int* inv) {
    constexpr bool ALIGN_EPI = true;
    const int tid = threadIdx.x, wid = __builtin_amdgcn_readfirstlane(tid >> 6), lane = tid & 63, wr = wid >> 2, wc = wid & 3, fr = lane & 15, fq = lane >> 4;
    const int K = g.K, nt = K / BK;
    unsigned voffA[2], voffB[2];
#pragma unroll
    for (int i = 0; i < 2; ++i) { int R, C; stage_rc(tid * 16 + i * 8192, R, C); const int Rb = Epi::PERM ? ((R & ~31) + perm32(R & 31)) : R;
        voffA[i] = (unsigned)(R * g.lda + C) * 2u; voffB[i] = (unsigned)(Rb * g.ldb + C) * 2u; }
    const size_t kstep = (size_t)(BK * 2);
    const size_t hstepA = (size_t)HALF * g.lda * 2, hstepB = (size_t)HALF * g.ldb * 2;
    const size_t tstepA = 2 * hstepA, tstepB = 2 * hstepB;
    const unsigned ldsw = (unsigned)wid * 1024u;
    const int aoff = lds_byte(wr * 64 + fr, fq * 8), boff = lds_byte(wc * 32 + fr, fq * 8);
#define PG8_SA(b, h) (((b) * 2 + (h)) * HTB)
#define PG8_SB(b, h) ((4 + (b) * 2 + (h)) * HTB)
#define PG8_STAGE(bufoff, gbase, voff) do { _Pragma("unroll") for (int _i = 0; _i < 2; ++_i) \
        __builtin_amdgcn_global_load_lds((const unsigned*)((const char*)(gbase) + (voff)[_i]), (PG8_LAS unsigned*)(lds + (bufoff) + ldsw + _i * 8192), 16, 0, 0); } while (0)
#define PG8_LDA(dst, b, h) do { _Pragma("unroll") for (int m = 0; m < 4; ++m) _Pragma("unroll") for (int k = 0; k < 2; ++k) dst[m][k] = *(const PG8_LAS bf16x8*)(lds + PG8_SA(b, h) + aoff + m * 2048 + k * 1024); } while (0)
#define PG8_LDB(dst, b, h) do { _Pragma("unroll") for (int n = 0; n < 2; ++n) _Pragma("unroll") for (int k = 0; k < 2; ++k) dst[n][k] = *(const PG8_LAS bf16x8*)(lds + PG8_SB(b, h) + boff + n * 2048 + k * 1024); } while (0)
#define PG8_MMA(ai, bj, At, Bt) do { __builtin_amdgcn_s_setprio(1); _Pragma("unroll") for (int m = 0; m < 4; ++m) _Pragma("unroll") for (int n = 0; n < 2; ++n) _Pragma("unroll") for (int k = 0; k < 2; ++k) \
        acc[ai][bj][m][n] = __builtin_amdgcn_mfma_f32_16x16x32_bf16(Bt[n][k], At[m][k], acc[ai][bj][m][n], 0, 0, 0); __builtin_amdgcn_s_setprio(0); } while (0)
#define PG8_WAIT_V(n) asm volatile("s_waitcnt vmcnt(" #n ")" ::: "memory")
#define PG8_WAIT_L(n) asm volatile("s_waitcnt lgkmcnt(" #n ")" ::: "memory")
#define PG8_BAR __builtin_amdgcn_s_barrier()
#define PG8_SCHED __builtin_amdgcn_sched_barrier(0)
    Unit cur, nxt; int ui = 0;
    if (!S.next(0, cur)) return;
    f32x4 acc[2][2][4][2];
#pragma unroll
    for (int a = 0; a < 2; ++a)
#pragma unroll
        for (int b = 0; b < 2; ++b)
#pragma unroll
            for (int m = 0; m < 4; ++m)
#pragma unroll
                for (int n = 0; n < 2; ++n) acc[a][b][m][n] = (f32x4){0.f, 0.f, 0.f, 0.f};
    bf16x8 At[4][2], B0[2][2], B1[2][2];
    const char* cA = (const char*)g.A; const char* cB = (const char*)g.Bt + (size_t)cur.pn * tstepB;
    S.a_ready(cur);
    unsigned vc[2][2], vn[2][2];
#define PG8_ROWS(u_, vo_) do { _Pragma("unroll") for (int h_ = 0; h_ < 2; ++h_) _Pragma("unroll") for (int i_ = 0; i_ < 2; ++i_) { int R_, C_; stage_rc(tid * 16 + i_ * 8192, R_, C_); const int r_ = h_ * HALF + R_; \
        const int tok_ = r_ < (u_).nvalid ? inv[(u_).inv0 + r_] : 0; vo_[h_][i_] = (unsigned)(tok_ * g.lda + C_) * 2u; } } while (0)
    PG8_ROWS(cur, vc);
    {
        PG8_STAGE(PG8_SB(0, 0), cB, voffB); PG8_STAGE(PG8_SB(0, 1), cB + hstepB, voffB); PG8_STAGE(PG8_SA(0, 0), cA, vc[0]); PG8_STAGE(PG8_SA(0, 1), cA, vc[1]);
        if (wr == 1) PG8_BAR;
        PG8_WAIT_V(2); PG8_BAR;
        PG8_STAGE(PG8_SB(1, 0), cB + kstep, voffB); PG8_STAGE(PG8_SA(1, 0), cA + kstep, vc[0]); PG8_STAGE(PG8_SB(1, 1), cB + hstepB + kstep, voffB);
        PG8_WAIT_V(6); PG8_BAR;
    }
    for (;;) {
        const bool has_next = S.next(ui + 1, nxt);
        if (has_next) { PG8_ROWS(nxt, vn); } else {
#pragma unroll
            for (int h_ = 0; h_ < 2; ++h_) { vn[h_][0] = vc[h_][0]; vn[h_][1] = vc[h_][1]; } }
        const char* nA = cA; const char* nB = has_next ? (const char*)g.Bt + (size_t)nxt.pn * tstepB : cB;
        const bool do0 = cur.half != 1, do1 = cur.half != 0;
        for (int t = 0; t < nt; t += 2) {
            const bool last = (t == nt - 2);
            unsigned v2[2][2];
#pragma unroll
            for (int h_ = 0; h_ < 2; ++h_) { v2[h_][0] = last ? vn[h_][0] : vc[h_][0]; v2[h_][1] = last ? vn[h_][1] : vc[h_][1]; }
            const char* a1 = cA + (size_t)(t + 1) * kstep;
            const char* a2 = last ? nA : cA + (size_t)(t + 2) * kstep; const char* b2 = last ? nB : cB + (size_t)(t + 2) * kstep;
            const char* a3 = a2 + kstep; const char* b3 = b2 + kstep;
            if (last && has_next) S.a_ready(nxt);
            {
            PG8_LDB(B0, 0, 0); PG8_LDB(B1, 0, 1); PG8_SCHED; if (do0) { PG8_LDA(At, 0, 0); } PG8_STAGE(PG8_SA(1, 1), a1, vc[1]);
            PG8_WAIT_V(8); PG8_WAIT_L(0); PG8_BAR; if (do0) { PG8_MMA(0, 0, At, B0); PG8_MMA(0, 1, At, B1); } PG8_BAR; PG8_SCHED;
            if (do1) { PG8_LDA(At, 0, 1); } PG8_STAGE(PG8_SB(0, 0), b2, voffB); PG8_STAGE(PG8_SB(0, 1), b2 + hstepB, voffB); PG8_STAGE(PG8_SA(0, 0), a2, v2[0]);
            PG8_WAIT_V(8); PG8_WAIT_L(0); PG8_BAR; if (do1) { PG8_MMA(1, 0, At, B0); PG8_MMA(1, 1, At, B1); } PG8_BAR; PG8_SCHED;
            PG8_LDB(B0, 1, 0); PG8_LDB(B1, 1, 1); PG8_SCHED; if (do0) { PG8_LDA(At, 1, 0); } PG8_STAGE(PG8_SA(0, 1), a2, v2[1]);
            PG8_WAIT_V(8); PG8_WAIT_L(0); PG8_BAR; if (do0) { PG8_MMA(0, 0, At, B0); PG8_MMA(0, 1, At, B1); } PG8_BAR; PG8_SCHED;
            if (do1) { PG8_LDA(At, 1, 1); } PG8_STAGE(PG8_SB(1, 0), b3, voffB); PG8_STAGE(PG8_SB(1, 1), b3 + hstepB, voffB); PG8_STAGE(PG8_SA(1, 0), a3, v2[0]);
            PG8_WAIT_V(8); PG8_WAIT_L(0); PG8_BAR; if (do1) { PG8_MMA(1, 0, At, B0); PG8_MMA(1, 1, At, B1); } PG8_BAR; PG8_SCHED;
            }
        }
        if constexpr (ALIGN_EPI) { if (wr == 0) PG8_BAR; }
        if constexpr (!Epi::AFTER_DRAIN) { E(acc, cur, wr, wc, fr, fq); S.done(cur); }
        if (!has_next) break;
#pragma unroll
        for (int a = 0; a < 2; ++a)
#pragma unroll
            for (int b = 0; b < 2; ++b)
#pragma unroll
                for (int m = 0; m < 4; ++m)
#pragma unroll
                    for (int n = 0; n < 2; ++n) acc[a][b][m][n] = (f32x4){0.f, 0.f, 0.f, 0.f};
        cur = nxt; cA = nA; cB = nB; ++ui;
#pragma unroll
        for (int h_ = 0; h_ < 2; ++h_) { vc[h_][0] = vn[h_][0]; vc[h_][1] = vn[h_][1]; }
        if constexpr (ALIGN_EPI) { if (wr == 1) PG8_BAR; }
    }
    PG8_WAIT_V(0);
    if constexpr (!ALIGN_EPI) { if (wr == 0) PG8_BAR; }
    PG8_BAR;
    if constexpr (Epi::AFTER_DRAIN) { E.fused(acc, cur, wr, wc, fr, fq, lds, wid, lane); S.done(cur); }
#undef PG8_ROWS
#undef PG8_SA
#undef PG8_SB
#undef PG8_STAGE
#undef PG8_LDA
#undef PG8_LDB
#undef PG8_MMA
#undef PG8_WAIT_V
#undef PG8_WAIT_L
#undef PG8_BAR
#undef PG8_SCHED
}
}
constexpr int BATCH = 2, SEQ = 4096, DM = 2048, MTOK = BATCH * SEQ;
constexpr int NE0 = 6168, NE1 = 4176;
constexpr int NP0 = 6144, NP1 = 4096;
constexpr float LN_EPS = 1e-5f;
constexpr float DN_ALPHA = 1.41421356237309515f;
constexpr float ATT_SCALE = 0.08838834764831845f;
constexpr int RPAD = 24576;
constexpr size_t MiB = 1u << 20;
constexpr size_t WS_CTL = 0, CTL_ZERO_BYTES = 1 * MiB;
constexpr size_t WS_ROPE = 1 * MiB;
constexpr size_t WS_WSM = 4 * MiB;
constexpr size_t WS_SK0 = 6 * MiB;
constexpr size_t WS_IK = 7 * MiB;
constexpr size_t WS_IW = 8 * MiB + 512 * 1024;
constexpr size_t WS_FBIAS = 10 * MiB;
constexpr size_t WS_ROUTE = 11 * MiB;
constexpr size_t WS_MASK = 12 * MiB;
constexpr size_t WS_WINA = 16 * MiB, WS_WOA = 40 * MiB, WS_WINC = 48 * MiB, WS_WOC = 64 * MiB;
constexpr size_t WS_WGU = 72 * MiB;
constexpr size_t WS_WD = 328 * MiB;
constexpr size_t WS_XB = 456 * MiB;
constexpr size_t WS_YB = 488 * MiB;
constexpr size_t WS_PROJ = 552 * MiB;
constexpr size_t WS_CST = 648 * MiB;
constexpr size_t WS_PREVT = 712 * MiB;
constexpr size_t WS_OMIX = 744 * MiB;
constexpr size_t WS_GB = 776 * MiB;
constexpr size_t WS_DEC = 792 * MiB;
constexpr size_t WS_ROWW = 793 * MiB;
constexpr size_t WS_SC = 800 * MiB;
constexpr size_t WS_INV = 800 * MiB;
constexpr size_t WS_WINV = 801 * MiB;
constexpr size_t WS_END = 928 * MiB;
constexpr int CW_CNT = 1024;
constexpr int CW_FILL = 2048;
constexpr int CW_BAR = 4096;

#define GAS __attribute__((address_space(1)))
#define LAS __attribute__((address_space(3)))
typedef unsigned short bf16;
typedef unsigned v4u __attribute__((ext_vector_type(4)));
typedef unsigned v2u __attribute__((ext_vector_type(2)));
typedef float f32x4 __attribute__((ext_vector_type(4)));
typedef short bf16x8 __attribute__((ext_vector_type(8)));
#define LDS_WAIT() asm volatile("s_waitcnt lgkmcnt(0)" ::: "memory")
#define VM_WAIT() asm volatile("s_waitcnt vmcnt(0)" ::: "memory")
__device__ __forceinline__ unsigned f2bf(float f) { unsigned u = __builtin_bit_cast(unsigned, f); return (u + 0x7fffu + ((u >> 16) & 1u)) >> 16; }
__device__ __forceinline__ unsigned pk2(float lo, float hi) { return f2bf(lo) | (f2bf(hi) << 16); }
__device__ __forceinline__ float bf2f(unsigned short b) { return __builtin_bit_cast(float, ((unsigned)b) << 16); }
__device__ __forceinline__ float wave_sum(float v) {
#pragma unroll
    for (int o = 1; o < 64; o <<= 1) v += __shfl_xor(v, o);
    return v;
}
__device__ __forceinline__ float logsigmoidf(float z) { return fminf(z, 0.f) - log1pf(__expf(-fabsf(z))); }
#define XB_TMO      128
#define XB_XCNT(j)  (256  + 64 * (j))
#define XB_XSUB(j)  (1280 + 64 * (j))
#define XB_XGEN(j)  (2304 + 64 * (j))
#define XB_TOP      3328
#define XB_TOPGEN   3392
#define XCD_BAR_WORDS 3456
#define XB_SPIN_CAP (1u << 21)

__device__ __forceinline__ unsigned xb_ld(unsigned* p)              { return __hip_atomic_load(p, __ATOMIC_RELAXED, __HIP_MEMORY_SCOPE_AGENT); }
__device__ __forceinline__ unsigned xb_add(unsigned* p, unsigned v) { return __hip_atomic_fetch_add(p, v, __ATOMIC_RELAXED, __HIP_MEMORY_SCOPE_AGENT); }
__device__ __forceinline__ unsigned xb_xcc_id() { return (unsigned)__builtin_amdgcn_s_getreg((3 << 11) | 20) & 0xFu; }
#define XB_SPIN(cond, bar) do { unsigned _sp = 0; while (cond) { __builtin_amdgcn_s_sleep(1); \
    if ((++_sp & 255u) == 0u) { if (xb_ld(&(bar)[XB_TMO])) break; if (_sp > XB_SPIN_CAP) { atomicAdd(&(bar)[XB_TMO], 1u); break; } } } } while (0)

struct XcdBarrier {
    unsigned* bar; unsigned x;
    volatile LAS unsigned* st;
};

__device__ __forceinline__ XcdBarrier xcd_barrier_post(unsigned* bar, volatile LAS unsigned* st) {
    XcdBarrier b; b.bar = bar; b.x = xb_xcc_id(); b.st = st;
    if (threadIdx.x == 0) (void)xb_add(&bar[XB_XCNT(b.x)], 1u);
    return b;
}
__device__ __forceinline__ void xcd_barrier_complete(unsigned* bar, unsigned x, unsigned& nloc, unsigned& nx) {
    const unsigned G = gridDim.x * gridDim.y * gridDim.z;
    unsigned sum, cnt, mine, sp = 0u;
    for (;;) {
        sum = 0u; cnt = 0u; mine = 0u;
#pragma unroll
        for (unsigned j = 0; j < 16; ++j) { const unsigned c = xb_ld(&bar[XB_XCNT(j)]); sum += c; cnt += (c > 0u) ? 1u : 0u; mine = (j == x) ? c : mine; }
        if (sum == G) break;
        __builtin_amdgcn_s_sleep(1);
        if ((++sp & 255u) == 0u) { if (xb_ld(&bar[XB_TMO])) break; if (sp > XB_SPIN_CAP) { atomicAdd(&bar[XB_TMO], 1u); break; } }
    }
    nloc = mine > 0u ? mine : 1u; nx = cnt > 0u ? cnt : 1u;
}

__device__ __forceinline__ void xcd_barrier(const XcdBarrier& b) {
    asm volatile("s_waitcnt vmcnt(0)" ::: "memory");
    __syncthreads();
    if (threadIdx.x == 0) {
        unsigned* bar = b.bar;
        __builtin_amdgcn_s_waitcnt(0);
        unsigned nloc = b.st[0], nx = b.st[1];
        if (nloc == 0u) { xcd_barrier_complete(bar, b.x, nloc, nx); b.st[0] = nloc; b.st[1] = nx; }
        const unsigned old = xb_add(&bar[XB_XSUB(b.x)], 1u);
        const unsigned gen = old / nloc;
        if (old + 1u == (gen + 1u) * nloc) {
            __builtin_amdgcn_fence(__ATOMIC_RELEASE, "agent");
            asm volatile("s_waitcnt vmcnt(0)" ::: "memory");
            const unsigned og = xb_add(&bar[XB_TOP], 1u);
            const unsigned tg = og / nx;
            if (og + 1u == (tg + 1u) * nx) xb_add(&bar[XB_TOPGEN], 1u);
            else XB_SPIN(xb_ld(&bar[XB_TOPGEN]) == tg, bar);
            __builtin_amdgcn_fence(__ATOMIC_ACQUIRE, "agent");
            xb_add(&bar[XB_XGEN(b.x)], 1u);
            asm volatile("s_waitcnt vmcnt(0)" ::: "memory");
        } else {
            XB_SPIN(xb_ld(&bar[XB_XGEN(b.x)]) == gen, bar);
            __builtin_amdgcn_fence(__ATOMIC_ACQUIRE, "agent");
            asm volatile("s_waitcnt vmcnt(0)" ::: "memory");
        }
    }
    __syncthreads();
}

constexpr int NWAVES = 8;
constexpr int RING_BYTES = 131072;
constexpr int LDSCTL_OFF = RING_BYTES;
constexpr int LDS_BYTES = 147456;
struct Frame {
    LAS unsigned char* lds; volatile LAS unsigned* MISC; unsigned* ctl;
    int tid, lane, wave, G, gw, NGW;
    unsigned char* ws;
};
struct Args { const float* in[20]; float* out; unsigned char* ws; int ph_lo, ph_hi, bar_region, pad; };

struct TrItem { const float* W; bf16* WT; int ldw, c0, c1, K, n0, k0; };
__device__ __forceinline__ void tr64_load(const TrItem& t, f32x4 (&r)[16], int lane) {
    const int nq = lane & 15, kr = lane >> 4;
    const float* src = t.W + (size_t)(t.k0 + 2 * kr) * t.ldw + (nq < 8 ? t.c0 : t.c1 - 32) + 4 * nq;
#pragma unroll
    for (int i = 0; i < 8; ++i) { r[2 * i] = __builtin_nontemporal_load((const f32x4*)(src + (size_t)(8 * i) * t.ldw)); r[2 * i + 1] = __builtin_nontemporal_load((const f32x4*)(src + (size_t)(8 * i + 1) * t.ldw)); }
}
__device__ __forceinline__ void tr64_store(const TrItem& t, const f32x4 (&r)[16], LAS bf16* T, int lane) {
    const int nq = lane & 15, kr = lane >> 4;
#pragma unroll
    for (int i = 0; i < 8; ++i) { const int kk = 8 * i + 2 * kr;
#pragma unroll
        for (int e = 0; e < 4; ++e) *(LAS unsigned*)(T + (4 * nq + e) * 68 + kk) = pg8::cvt_pk_bf16(r[2 * i][e], r[2 * i + 1][e]); }
    LDS_WAIT(); asm volatile("" ::: "memory");
    const int c = lane & 7;
#pragma unroll
    for (int j = 0; j < 8; ++j) { const int n = (lane >> 3) + 8 * j; const v2u lo = *(const LAS v2u*)(T + n * 68 + 8 * c), hi = *(const LAS v2u*)(T + n * 68 + 8 * c + 4);
        v4u o; o.x = lo.x; o.y = lo.y; o.z = hi.x; o.w = hi.y;
        *(v4u*)(t.WT + (size_t)(t.n0 + n) * t.K + t.k0 + 8 * c) = o; }
    LDS_WAIT(); asm volatile("" ::: "memory");
}
__device__ __forceinline__ void transpose_item64(const float* W, int ldw, int c0, int c1, int K, bf16* WT, int n0, int k0, LAS bf16* T, int lane) {
    const TrItem t{W, WT, ldw, c0, c1, K, n0, k0}; f32x4 r[16]; tr64_load(t, r, lane); tr64_store(t, r, T, lane);
}
__device__ __forceinline__ int l1_src_col(int n) {
    const int pn = n >> 8, j = n & 255, jh = j & 127, second = j >> 7;
    if (pn == 10 || pn == 11) return n;
    if (pn < 10) return pn * 256 + (jh >> 6) * 128 + second * 64 + (jh & 63);
    return 3072 + ((pn - 12) * 4 + (jh >> 5)) * 64 + second * 32 + (jh & 31);
}
constexpr int SK_ROUTE0 = 0, SK_ROUTE1 = 48, SK_SK0 = 96, SK_SK1 = 128, SK_NCOL = 208;
constexpr int SK_PART_OFF = 0, SK_LG_OFF = 65536;
template <int NT> __device__ __forceinline__ void skinny_partials(LAS unsigned char* ldsb, const bf16* X, const bf16* WH, const bf16* WL, int w, int lane) {
    const int tile = w >> 2, kq = w & 3, l15 = lane & 15, quad = lane >> 4;
    const bf16* xp = X + (size_t)(16 * tile + l15) * DM + kq * 512 + quad * 8;
    const bf16* hp = WH + (size_t)l15 * 2048 + kq * 512 + quad * 8; const bf16* lp = WL + (size_t)l15 * 2048 + kq * 512 + quad * 8;
    pg8::f32x4 acc[NT];
#pragma unroll
    for (int n = 0; n < NT; ++n) acc[n] = (pg8::f32x4){0.f, 0.f, 0.f, 0.f};
#pragma unroll 2
    for (int ks = 0; ks < 16; ++ks) {
        const bf16x8 ah = *(const bf16x8*)(xp + 32 * ks);
#pragma unroll
        for (int n = 0; n < NT; ++n) { const bf16x8 bh = *(const bf16x8*)(hp + (size_t)n * 16 * 2048 + 32 * ks), bl = *(const bf16x8*)(lp + (size_t)n * 16 * 2048 + 32 * ks);
            acc[n] = __builtin_amdgcn_mfma_f32_16x16x32_bf16(ah, bh, acc[n], 0, 0, 0); acc[n] = __builtin_amdgcn_mfma_f32_16x16x32_bf16(ah, bl, acc[n], 0, 0, 0); }
    }
    LAS float* PART = (LAS float*)(ldsb + SK_PART_OFF);
#pragma unroll
    for (int n = 0; n < NT; ++n) *(LAS pg8::f32x4*)(PART + ((((tile * 4 + kq) * NT + n) * 64 + lane) * 4)) = acc[n];
}
template <int NT> __device__ __forceinline__ void skinny_reduce(LAS unsigned char* ldsb, int tid) {
    const LAS float* PART = (const LAS float*)(ldsb + SK_PART_OFF); LAS float* LG = (LAS float*)(ldsb + SK_LG_OFF);
    for (int idx = tid; idx < 32 * 16 * NT; idx += NWAVES * 64) { const int row = idx / (16 * NT), col = idx % (16 * NT), tile = row >> 4, rr = row & 15, ln = (rr >> 2) * 16 + (col & 15), n = col >> 4, j = rr & 3;
        float s = 0.f;
#pragma unroll
        for (int kq = 0; kq < 4; ++kq) s += PART[(((tile * 4 + kq) * NT + n) * 64 + ln) * 4 + j];
        LG[row * (16 * NT) + col] = s; }
}
__device__ __forceinline__ void ln_row(f32x4 (&v)[8], const float* g, const float* b, int lane) {
    float s = 0.f;
#pragma unroll
    for (int j = 0; j < 8; ++j) s += (v[j][0] + v[j][1]) + (v[j][2] + v[j][3]);
    const float mean = wave_sum(s) * (1.f / DM); float s2 = 0.f;
#pragma unroll
    for (int j = 0; j < 8; ++j) { v[j] = v[j] - mean; s2 += (v[j][0] * v[j][0] + v[j][1] * v[j][1]) + (v[j][2] * v[j][2] + v[j][3] * v[j][3]); }
    const float rstd = 1.f / sqrtf(wave_sum(s2) * (1.f / DM) + LN_EPS);
#pragma unroll
    for (int j = 0; j < 8; ++j) { const f32x4 gg = *(const f32x4*)(g + 256 * j + 4 * lane), bb = *(const f32x4*)(b + 256 * j + 4 * lane); v[j] = v[j] * rstd * gg + bb; }
}
__device__ __forceinline__ void load_row_bf16(const bf16* src, f32x4 (&v)[8], int lane) {
#pragma unroll
    for (int j = 0; j < 8; ++j) { const uint2 p = *(const uint2*)(src + 256 * j + 4 * lane); v[j][0] = bf2f(p.x & 0xffff); v[j][1] = bf2f(p.x >> 16); v[j][2] = bf2f(p.y & 0xffff); v[j][3] = bf2f(p.y >> 16); }
}
__device__ __forceinline__ void store_row_bf16(bf16* dst, const f32x4 (&v)[8], int lane) {
#pragma unroll
    for (int j = 0; j < 8; ++j) { uint2 o; o.x = pg8::cvt_pk_bf16(v[j][0], v[j][1]); o.y = pg8::cvt_pk_bf16(v[j][2], v[j][3]); *(uint2*)(dst + 256 * j + 4 * lane) = o; }
}
#define TK_FOR_VALID(...) _Pragma("unroll") for (int g_ = 0; g_ < 8; ++g_) { if (512 * g_ <= qpos) { _Pragma("unroll") for (int i = 8 * g_; i < 8 * g_ + 8; ++i) { __VA_ARGS__ } } }
__device__ __forceinline__ void topk_mask_row(const LAS float* sc, int qpos, unsigned long long* mrow, int lane, LAS unsigned* cbuf) {
    unsigned u[64];
#pragma unroll
    for (int i = 0; i < 64; ++i) { const int s = 64 * i + lane; const bool ok = s <= qpos; const float f = ok ? sc[s] : 0.f; const unsigned b = __builtin_bit_cast(unsigned, f);
        const unsigned key = b ^ ((b >> 31) ? 0xFFFFFFFFu : 0x80000000u); u[i] = ok ? key : 0u; }
    unsigned long long mword = 0ull;
    if (qpos + 1 <= 256) {
#pragma unroll
        for (int i = 0; i < 4; ++i) { const unsigned long long w = __ballot(64 * i + lane <= qpos); mword = (lane == i) ? w : mword; }
        mrow[lane] = mword; return;
    }
    const unsigned long long below = (1ull << lane) - 1ull;
    unsigned T = 0u;
#pragma unroll 1
    for (int bit = 31; bit >= 20; --bit) { const unsigned cand = T | (1u << bit); int cnt = 0;
        TK_FOR_VALID( cnt += __builtin_popcountll(__ballot(u[i] >= cand)); )
        if (cnt >= 256) T = cand; }
    const unsigned pre = T >> 20; int cgt = 0, nc = 0;
    TK_FOR_VALID( { const unsigned p_ = u[i] >> 20; const unsigned long long gm = __ballot(p_ > pre), em = __ballot(p_ == pre); cgt += __builtin_popcountll(gm);
        const int pos_ = nc + __builtin_popcountll(em & below); if (p_ == pre && pos_ < 256) cbuf[pos_] = u[i]; nc += __builtin_popcountll(em); } )
    int kneed = 256 - cgt;
    if (nc <= 256) {
        asm volatile("s_waitcnt lgkmcnt(0)" ::: "memory");
        unsigned c0 = lane < nc ? cbuf[lane] : 0u, c1 = 64 + lane < nc ? cbuf[64 + lane] : 0u, c2 = 128 + lane < nc ? cbuf[128 + lane] : 0u, c3 = 192 + lane < nc ? cbuf[192 + lane] : 0u;
#pragma unroll 1
        for (int bit = 19; bit >= 0; --bit) { const unsigned cand = T | (1u << bit);
            int cnt = __builtin_popcountll(__ballot(c0 >= cand));
            if (nc > 64) cnt += __builtin_popcountll(__ballot(c1 >= cand));
            if (nc > 128) cnt += __builtin_popcountll(__ballot(c2 >= cand)) + __builtin_popcountll(__ballot(c3 >= cand));
            if (cnt >= kneed) T = cand; }
        const int cg2 = __builtin_popcountll(__ballot(c0 > T)) + __builtin_popcountll(__ballot(c1 > T)) + __builtin_popcountll(__ballot(c2 > T)) + __builtin_popcountll(__ballot(c3 > T));
        kneed -= cg2;
    } else {
#pragma unroll 1
        for (int bit = 19; bit >= 0; --bit) { const unsigned cand = T | (1u << bit); int cnt = 0;
            TK_FOR_VALID( cnt += __builtin_popcountll(__ballot(u[i] >= cand)); )
            if (cnt >= 256) T = cand; }
        int cg2 = 0;
        TK_FOR_VALID( cg2 += __builtin_popcountll(__ballot(u[i] > T)); )
        kneed = 256 - cg2;
    }
    int run = 0;
#pragma unroll
    for (int i = 0; i < 64; ++i) { const bool gt = u[i] > T, eq = u[i] == T; const unsigned long long eqm = __ballot(eq);
        const int rank = run + __builtin_popcountll(eqm & below); const bool sel = gt || (eq && rank < kneed); run += __builtin_popcountll(eqm);
        const unsigned long long w = __ballot(sel); mword = (lane == i) ? w : mword; }
    mrow[lane] = mword;
}
#undef TK_FOR_VALID
constexpr int CONV_MOE_ITEMS = 32 * (32 * 16) + 32 * (8 * 32);
#ifndef CONV_STATIC_ITEMS
#define CONV_STATIC_ITEMS 0
#endif
constexpr int CONV_STATIC = CONV_STATIC_ITEMS;
constexpr int CONV_LATE_ITEMS = CONV_MOE_ITEMS + 32 * (NP1 / 64) + 32 * 32 + CONV_MOE_ITEMS;
#ifndef CONV_TAIL_ITEMS
#define CONV_TAIL_ITEMS 12288
#endif
constexpr int CONV_SPLIT = CONV_LATE_ITEMS - CONV_TAIL_ITEMS;
__device__ __forceinline__ TrItem conv_moe_desc(const Args& a, unsigned char* ws, int layer, int it) {
    if (it < 32 * 512) {
        const int ex = layer * 32 + it / 512, r = it % 512, blk = r >> 5, jj = r & 31, kb = (blk >> 2) * 8 + (jj >> 2), nb = (blk & 3) * 4 + (jj & 3), n0 = nb * 64, tile = n0 >> 8, j = n0 & 255;
        const float* W = (j < 128 ? a.in[17] : a.in[18]) + (size_t)ex * 2048 * 512;
        return TrItem{W, (bf16*)(ws + WS_WGU) + (size_t)ex * 1024 * 2048, 512, 128 * tile + (j & 127), 128 * tile + (j & 127) + 32, 2048, n0, kb * 64};
    }
    const int i2 = it - 32 * 512, ex = layer * 32 + i2 / 256, r = i2 % 256, blk = r >> 5, jj = r & 31, kb = jj >> 2, nb = blk * 4 + (jj & 3);
    return TrItem{a.in[19] + (size_t)ex * 512 * 2048, (bf16*)(ws + WS_WD) + (size_t)ex * 2048 * 512, 2048, nb * 64, nb * 64 + 32, 512, nb * 64, kb * 64};
}
__device__ __forceinline__ TrItem conv_late_desc(const Args& a, unsigned char* ws, int it) {
    if (it < CONV_MOE_ITEMS) return conv_moe_desc(a, ws, 0, it);
    it -= CONV_MOE_ITEMS;
    if (it < 32 * (NP1 / 64)) { const int kb = it / (NP1 / 64), nb = it % (NP1 / 64), n0 = nb * 64;
        return TrItem{a.in[7], (bf16*)(ws + WS_WINC), NE1, l1_src_col(n0), l1_src_col(n0 + 32), 2048, n0, kb * 64}; }
    it -= 32 * (NP1 / 64);
    if (it < 32 * 32) { const int kb = it / 32, nb = it % 32; return TrItem{a.in[8], (bf16*)(ws + WS_WOC), 2048, nb * 64, nb * 64 + 32, 2048, nb * 64, kb * 64}; }
    return conv_moe_desc(a, ws, 1, it - 32 * 32);
}
__device__ __forceinline__ void late_conv_items(Frame& F, const Args& a, const int lo, const int hi, const int ctr) {
    constexpr int CHUNK = 32;
    LAS bf16* T = (LAS bf16*)(F.lds + F.wave * 16384); volatile LAS int* slot = (volatile LAS int*)(F.lds + 131072 + 512);
    for (;;) {
        __syncthreads();
        if (F.tid == 0) *slot = lo + (int)atomicAdd(F.ctl + CW_FILL + 64 * ctr, (unsigned)CHUNK);
        __syncthreads();
        const int base = *slot;
        if (base >= hi) break;
        f32x4 rA[16], rB[16];
        TrItem t0 = conv_late_desc(a, F.ws, base + F.wave); tr64_load(t0, rA, F.lane);
        TrItem t1 = conv_late_desc(a, F.ws, base + F.wave + 8); tr64_load(t1, rB, F.lane);
        tr64_store(t0, rA, T, F.lane);
        t0 = conv_late_desc(a, F.ws, base + F.wave + 16); tr64_load(t0, rA, F.lane);
        tr64_store(t1, rB, T, F.lane);
        t1 = conv_late_desc(a, F.ws, base + F.wave + 24); tr64_load(t1, rB, F.lane);
        tr64_store(t0, rA, T, F.lane);
        tr64_store(t1, rB, T, F.lane);
    }
    __syncthreads();
}
static_assert(CONV_LATE_ITEMS % 32 == 0 && CONV_STATIC % 32 == 0 && CONV_STATIC <= CONV_LATE_ITEMS, "filler chunks");
__device__ __forceinline__ void p0_prologue(Frame& F, const Args& a) {
    const int gw = F.gw, NGW = F.NGW, lane = F.lane;
    unsigned char* ws = F.ws;
    LAS bf16* T = (LAS bf16*)(F.lds + F.wave * 16384);
    {
        const float* W = a.in[1]; bf16* WT = (bf16*)(ws + WS_WINA);
        for (int it = gw; it < 32 * (NP0 / 64); it += NGW) { const int kb = it / (NP0 / 64), nb = it % (NP0 / 64), n0 = nb * 64; const int c0 = n0 < 3072 ? n0 : n0 + 16; transpose_item64(W, NE0, c0, c0 + 32, 2048, WT, n0, kb * 64, T, lane); }
    }
    {
        for (int it = gw; it < 32 * 32; it += NGW) { const int kb = it / 32, nb = it % 32; transpose_item64(a.in[6], 2048, nb * 64, nb * 64 + 32, 2048, (bf16*)(ws + WS_WOA), nb * 64, kb * 64, T, lane); }
    }
    for (int it = gw; it < CONV_STATIC; it += NGW) { const TrItem t = conv_late_desc(a, ws, it); f32x4 r16[16]; tr64_load(t, r16, lane); tr64_store(t, r16, T, lane); }
    const int gt = blockIdx.x * (NWAVES * 64) + F.tid, NGT = F.G * NWAVES * 64;
    {   float* c128 = (float*)(ws + WS_ROPE); float* s128 = c128 + 4096 * 64; float* c64 = s128 + 4096 * 64; float* s64 = c64 + 4096 * 32;
        for (int i = gt; i < 4096 * 96; i += NGT) { int pos, idx, half; float* cp; float* sp;
            if (i < 4096 * 64) { pos = i >> 6; idx = i & 63; half = 64; cp = c128 + i; sp = s128 + i; } else { const int r = i - 4096 * 64; pos = r >> 5; idx = r & 31; half = 32; cp = c64 + r; sp = s64 + r; }
            const float inv = exp2f(-(float)idx / (float)half * 13.287712379549449f);
            const float ang = (float)pos * inv;
            double rv = (double)ang * 0.15915494309189535; rv -= rint(rv);
            const float rf = (float)rv;
            *cp = __builtin_amdgcn_cosf(rf); *sp = __builtin_amdgcn_sinf(rf); }
    }
    {   bf16* SKH = (bf16*)(ws + WS_WSM); bf16* SKL = SKH + (size_t)SK_NCOL * 2048;
        for (int i = gt; i < 2048 * SK_NCOL; i += NGT) { const int k = i / SK_NCOL, c = i % SK_NCOL; float v = 0.f;
            if (c < 96) { const int l = c / 48, j = c % 48; if (j < 4) v = a.in[13][((size_t)l * 2048 + k) * 4 + j]; else if (j < 36) { const int g = (j - 4) >> 3, e = (j - 4) & 7; v = a.in[15][(((size_t)l * 4 + g) * 2048 + k) * 8 + e]; } }
            else if (c < 128) { const int j = c - 96; if (j < 16) v = a.in[1][(size_t)k * NE0 + 3072 + j]; else if (j < 24) v = a.in[1][(size_t)k * NE0 + 6160 + j - 16]; }
            else v = a.in[7][(size_t)k * NE1 + 4096 + c - 128];
            const unsigned h = f2bf(v); SKH[(size_t)c * 2048 + k] = (bf16)h; SKL[(size_t)c * 2048 + k] = (bf16)f2bf(v - bf2f((unsigned short)h)); }
    }
    {   const float* x = a.in[0]; bf16* XB = (bf16*)(ws + WS_XB);
        for (int m = gw; m < MTOK; m += NGW) { f32x4 v[8];
#pragma unroll
            for (int j = 0; j < 8; ++j) v[j] = *(const f32x4*)(x + (size_t)m * DM + 256 * j + 4 * lane);
            store_row_bf16(XB + (size_t)m * DM, v, lane); }
    }
}
__device__ __forceinline__ void p_skinny0(Frame& F, const Args& a) {
    const bf16* SKH = (const bf16*)(F.ws + WS_WSM) + (size_t)SK_SK0 * 2048; const bf16* SKL = SKH + (size_t)SK_NCOL * 2048; float* SK0 = (float*)(F.ws + WS_SK0);
    const LAS float* LG = (const LAS float*)(F.lds + SK_LG_OFF);
    for (int blk = blockIdx.x; blk < MTOK / 32; blk += F.G) { const int R0 = blk * 32;
        __syncthreads();
        skinny_partials<2>(F.lds, (const bf16*)(F.ws + WS_XB) + (size_t)R0 * DM, SKH, SKL, F.wave, F.lane);
        __syncthreads();
        skinny_reduce<2>(F.lds, F.tid);
        __syncthreads();
        for (int idx = F.tid; idx < 32 * 24; idx += NWAVES * 64) { const int row = idx / 24, c = idx % 24; SK0[(size_t)(R0 + row) * 24 + c] = LG[row * 32 + c]; }
    }
    __syncthreads();
}
__device__ __forceinline__ void p_fox_bias(Frame& F, const Args& a) {
    if (blockIdx.x >= 16) return;
    const int bh = blockIdx.x, b = bh >> 3, h = bh & 7, lane = F.lane, tid = F.tid; const float gb = a.in[5][h];
    const float* SK0 = (const float*)(F.ws + WS_SK0); float* FB = (float*)(F.ws + WS_FBIAS) + (size_t)bh * SEQ; LAS float* wt = (LAS float*)(F.lds + 120000);
    float lf[8], tot = 0.f;
#pragma unroll
    for (int i = 0; i < 8; ++i) lf[i] = SK0[(size_t)(b * SEQ + tid * 8 + i) * 24 + 16 + h];
#pragma unroll
    for (int i = 0; i < 8; ++i) { tot += logsigmoidf(lf[i] + gb); lf[i] = tot; }
    float incl = tot;
#pragma unroll
    for (int o = 1; o < 64; o <<= 1) { const float t = __shfl_up(incl, o); if (lane >= o) incl += t; }
    if (lane == 63) wt[F.wave] = incl;
    __syncthreads();
    float pre = incl - tot;
    for (int w = 0; w < F.wave; ++w) pre += wt[w];
#pragma unroll
    for (int i = 0; i < 8; ++i) FB[tid * 8 + i] = -(pre + lf[i]) * (1.0f / ATT_SCALE);
    __syncthreads();
}
__device__ __forceinline__ void p_ln_route(Frame& F, const Args& a, int layer) {
    const bf16* YB = (const bf16*)(F.ws + WS_YB); bf16* XB = (bf16*)(F.ws + WS_XB); const int lane = F.lane;
    const float* g = a.in[9] + layer * DM; const float* bb = a.in[10] + layer * DM;
    const bf16* SKH = (const bf16*)(F.ws + WS_WSM) + (size_t)(layer ? SK_ROUTE1 : SK_ROUTE0) * 2048; const bf16* SKL = SKH + (size_t)SK_NCOL * 2048;
    const float* bg = a.in[14] + layer * 4; const float* be = a.in[16] + layer * 32;
    int4* ROUTE = (int4*)(F.ws + WS_ROUTE); unsigned* cnt = F.ctl + CW_CNT + layer * 64; int* INV = (int*)(F.ws + WS_INV); float* WINV = (float*)(F.ws + WS_WINV);
    const LAS float* LG = (const LAS float*)(F.lds + SK_LG_OFF);
    for (int blk = blockIdx.x; blk < MTOK / 32; blk += F.G) { const int R0 = blk * 32;
#pragma unroll 2
        for (int i = 0; i < 4; ++i) { const int m = R0 + 4 * F.wave + i; f32x4 v[8];
            load_row_bf16(YB + (size_t)m * DM, v, lane);
            ln_row(v, g, bb, lane);
            store_row_bf16(XB + (size_t)m * DM, v, lane); }
        __syncthreads();
        skinny_partials<3>(F.lds, XB + (size_t)R0 * DM, SKH, SKL, F.wave, lane);
        __syncthreads();
        skinny_reduce<3>(F.lds, F.tid);
        __syncthreads();
        if (F.tid < 32) { const int m = R0 + F.tid; const LAS float* l = LG + F.tid * 48;
            float gl[4];
#pragma unroll
            for (int i = 0; i < 4; ++i) gl[i] = l[i] + bg[i];
            int gi = 0; float gm = gl[0];
#pragma unroll
            for (int i = 1; i < 4; ++i) if (gl[i] > gm) { gm = gl[i]; gi = i; }
            float gs = 0.f;
#pragma unroll
            for (int i = 0; i < 4; ++i) gs += __expf(gl[i] - gm);
            const float gp = 1.0f / gs;
            float el[8];
#pragma unroll
            for (int e = 0; e < 8; ++e) el[e] = l[4 + 8 * gi + e] + be[gi * 8 + e];
            int e1 = 0; float v1 = el[0];
#pragma unroll
            for (int e = 1; e < 8; ++e) if (el[e] > v1) { v1 = el[e]; e1 = e; }
            int e2 = -1; float v2 = -3.0e38f;
#pragma unroll
            for (int e = 0; e < 8; ++e) if (e != e1 && el[e] > v2) { v2 = el[e]; e2 = e; }
            const float w1 = gp / (1.0f + __expf(v2 - v1)), w2 = gp - w1;
            const int ge1 = gi * 8 + e1, ge2 = gi * 8 + e2;
            const int p1 = (int)atomicAdd(cnt + ge1, 1u), p2 = (int)atomicAdd(cnt + ge2, 1u);
            ROUTE[(size_t)m * 2 + 0] = make_int4(ge1, p1, 0, 0); ROUTE[(size_t)m * 2 + 1] = make_int4(ge2, p2, 0, 0);
            INV[ge1 * 8192 + p1] = m; INV[ge2 * 8192 + p2] = m; WINV[ge1 * 8192 + p1] = w1; WINV[ge2 * 8192 + p2] = w2; }
    }
    __syncthreads();
}
__device__ __forceinline__ int moe_offsets(const unsigned* cnt, int lane, int* tiles_incl) {
    const int c = lane < 32 ? (int)cnt[lane] : 0; const int t = (c + 255) >> 8; int incl = t;
#pragma unroll
    for (int o = 1; o < 32; o <<= 1) { const int x = __shfl_up(incl, o); if ((lane & 31) >= o) incl += x; }
    *tiles_incl = incl; return (incl - t) * 256;
}
__device__ __forceinline__ void p_ln_ffn(Frame& F, const Args& a, int layer) {
    bf16* XB = (bf16*)(F.ws + WS_XB); const int lane = F.lane; const bf16* YG = (const bf16*)(F.ws + WS_CST);
    const float* g = a.in[11] + layer * DM; const float* bb = a.in[12] + layer * DM; const int4* ROUTE = (const int4*)(F.ws + WS_ROUTE);
    const bf16* SKH = (const bf16*)(F.ws + WS_WSM) + (size_t)SK_SK1 * 2048; const bf16* SKL = SKH + (size_t)SK_NCOL * 2048;
    const float* c64 = (const float*)(F.ws + WS_ROPE) + 2 * 4096 * 64; const float* s64 = c64 + 4096 * 32;
    bf16* IK = (bf16*)(F.ws + WS_IK); float* IW = (float*)(F.ws + WS_IW);
    const LAS float* LG = (const LAS float*)(F.lds + SK_LG_OFF);
    int ti_; const int eoff = moe_offsets(F.ctl + CW_CNT + layer * 64, lane, &ti_);
    for (int blk = blockIdx.x; blk < MTOK / 32; blk += F.G) { const int R0 = blk * 32;
#pragma unroll 2
        for (int i = 0; i < 4; ++i) { const int m = R0 + 4 * F.wave + i; f32x4 v[8];
            const int4 q0 = ROUTE[(size_t)m * 2], q1 = ROUTE[(size_t)m * 2 + 1]; const int r0 = __shfl(eoff, q0.x) + q0.y, r1 = __shfl(eoff, q1.x) + q1.y;
            load_row_bf16(XB + (size_t)m * DM, v, lane);
#pragma unroll
            for (int j = 0; j < 8; ++j) { v[j] = v[j] * DN_ALPHA;
                const uint2 y0 = *(const uint2*)(YG + (size_t)r0 * DM + 256 * j + 4 * lane), y1 = *(const uint2*)(YG + (size_t)r1 * DM + 256 * j + 4 * lane);
                v[j][0] += bf2f(y0.x & 0xffff) + bf2f(y1.x & 0xffff); v[j][1] += bf2f(y0.x >> 16) + bf2f(y1.x >> 16);
                v[j][2] += bf2f(y0.y & 0xffff) + bf2f(y1.y & 0xffff); v[j][3] += bf2f(y0.y >> 16) + bf2f(y1.y >> 16); }
            ln_row(v, g, bb, lane);
            if (layer == 0) store_row_bf16(XB + (size_t)m * DM, v, lane);
            else {
#pragma unroll
                for (int j = 0; j < 8; ++j) *(f32x4*)(a.out + (size_t)m * DM + 256 * j + 4 * lane) = v[j]; } }
        if (layer == 0) {
            __syncthreads();
            skinny_partials<5>(F.lds, XB + (size_t)R0 * DM, SKH, SKL, F.wave, lane);
            __syncthreads();
            skinny_reduce<5>(F.lds, F.tid);
            __syncthreads();
            for (int idx = F.tid; idx < 32 * 80; idx += NWAVES * 64) { const int row = idx / 80, c = idx % 80, m = R0 + row; const float v = LG[row * 80 + c];
                if (c < 64) { const float part = LG[row * 80 + (c ^ 32)]; const int pos = m & 4095, i = c & 31; const float cs = c64[pos * 32 + i], sn = s64[pos * 32 + i];
                    const int bq = m >> 12, sq = m & 4095; IK[((((size_t)bq * 128 + (sq >> 5)) * 4 + (c >> 4)) * 64 + ((c >> 3) & 1) * 32 + (sq & 31)) * 8 + (c & 7)] = (bf16)f2bf(c < 32 ? (v * cs - part * sn) : (v * cs + part * sn)); }
                else IW[(size_t)m * 16 + c - 64] = v * 0.25f * 0.125f; }
        }
    }
    __syncthreads();
}
__device__ __forceinline__ void ph_gla_b(Frame& F, const Args& a) {
    const float* SK0 = (const float*)(F.ws + WS_SK0); const float* w2 = a.in[2]; const float* gbias = a.in[3]; float* GB = (float*)(F.ws + WS_GB); float* DEC = (float*)(F.ws + WS_DEC);
    for (int u4 = blockIdx.x; u4 < 128; u4 += F.G) {
        const int unit = u4 * 4 + (F.tid >> 7), n = unit & 63, bh = unit >> 6, b = bh >> 2, h = bh & 3, d = F.tid & 127, t0 = b * SEQ + n * 64;
        float w[16];
#pragma unroll
        for (int r = 0; r < 16; ++r) w[r] = w2[r * 512 + h * 128 + d];
        const float gb = gbias[h * 128 + d]; float run = 0.f;
        for (int c = 0; c < 64; ++c) { const int t = t0 + c; float z = gb;
#pragma unroll
            for (int r = 0; r < 16; ++r) z += SK0[(size_t)t * 24 + r] * w[r];
            run += logsigmoidf(z) * (1.0f / 16.0f); GB[(size_t)t * 512 + h * 128 + d] = run; }
        DEC[unit * 128 + d] = __expf(run);
    }
}
__device__ __forceinline__ void ph_gla_state(Frame& F) {
    const bf16* PROJ = (const bf16*)(F.ws + WS_PROJ); const float* GB = (const float*)(F.ws + WS_GB); float* CST = (float*)(F.ws + WS_CST);
    for (int vb = blockIdx.x; vb < 512 * 64; vb += F.G) {
        const int unit = vb >> 6, d = (vb & 63) * 2 + (F.tid >> 8), v = F.tid & 255, n = unit & 63, bh = unit >> 6, b = bh >> 2, h = bh & 3, t0 = b * SEQ + n * 64;
        const float blast = GB[(size_t)(t0 + 63) * 512 + h * 128 + d]; float acc = 0.f;
        for (int c = 0; c < 64; ++c) { const size_t t = t0 + c; const float kk = bf2f(PROJ[t * NP0 + 512 + h * 128 + d]) * __expf(blast - GB[t * 512 + h * 128 + d]);
            acc += kk * bf2f(PROJ[t * NP0 + 1024 + h * 256 + v]); }
        CST[((size_t)unit * 256 + v) * 128 + d] = acc;
    }
}
__device__ __forceinline__ void ph_gla_scan(Frame& F) {
    const bf16* CST = (const bf16*)(F.ws + WS_CST); const float* DEC = (const float*)(F.ws + WS_DEC); bf16* PREVT = (bf16*)(F.ws + WS_PREVT);
    for (int idx = blockIdx.x * 512 + F.tid; idx < 8 * 32768; idx += F.G * 512) { const int bh = idx >> 15, vd = idx & 32767, d = vd & 127; float S = 0.f;
        for (int n = 0; n < 64; ++n) { const int unit = bh * 64 + n; PREVT[(size_t)unit * 32768 + vd] = (bf16)f2bf(S); S = DEC[unit * 128 + d] * S + bf2f(CST[(size_t)unit * 32768 + vd]); } }
}
__device__ __forceinline__ void ph_gla_out(Frame& F, const Args& a) {
    const bf16* PROJ = (const bf16*)(F.ws + WS_PROJ); const float* GB = (const float*)(F.ws + WS_GB); const bf16* PREVT = (const bf16*)(F.ws + WS_PREVT); const float* normg = a.in[4]; bf16* OMIX = (bf16*)(F.ws + WS_OMIX);
    LAS float* qd = (LAS float*)F.lds; LAS float* ki = qd + 64 * 128; LAS float* sc = ki + 64 * 128; LAS float* red = sc + 64 * 64;
    const int tid = F.tid; const bool act = tid < 256;
    for (int unit = blockIdx.x; unit < 512; unit += F.G) {
        const int n = unit & 63, bh = unit >> 6, b = bh >> 2, h = bh & 3, t0 = b * SEQ + n * 64;
        __syncthreads();
        for (int i = tid; i < 64 * 128; i += 512) { const int c = i >> 7, d = i & 127; const size_t t = t0 + c; const float bb = GB[t * 512 + h * 128 + d];
            qd[i] = bf2f(PROJ[t * NP0 + h * 128 + d]) * ATT_SCALE * __expf(bb); ki[i] = bf2f(PROJ[t * NP0 + 512 + h * 128 + d]) * __expf(-bb); }
        __syncthreads();
        for (int p = tid; p < 64 * 64; p += 512) { const int i = p >> 6, j = p & 63; float s = 0.f;
            if (j <= i) for (int d = 0; d < 128; ++d) s += qd[i * 128 + d] * ki[j * 128 + d];
            sc[p] = s; }
        __syncthreads();
        const int v = tid & 255; const bf16* pv = PREVT + ((size_t)unit * 256 + v) * 128; const float gv = normg[v];
        for (int i = 0; i < 64; ++i) { float acc = 0.f;
            if (act) { for (int j = 0; j <= i; ++j) acc += sc[i * 64 + j] * bf2f(PROJ[(size_t)(t0 + j) * NP0 + 1024 + h * 256 + v]);
                for (int d = 0; d < 128; ++d) acc += qd[i * 128 + d] * bf2f(pv[d]);
                const float ss = wave_sum(acc * acc); if ((tid & 63) == 0) red[tid >> 6] = ss; }
            __syncthreads();
            const float ms = (red[0] + red[1] + red[2] + red[3]) * (1.0f / 256.0f); __syncthreads();
            if (act) { const float gr = bf2f(PROJ[(size_t)(t0 + i) * NP0 + 2048 + h * 256 + v]);
                const float o = acc * (1.0f / sqrtf(ms + LN_EPS)) * gv * (gr / (1.0f + __expf(-gr)));
                OMIX[(size_t)(t0 + i) * DM + h * 256 + v] = (bf16)f2bf(o); } }
    }
}
template <int MODE  >
__device__ __forceinline__ void ph_attn_naive(Frame& F, const bf16* Qb, int ldq, int qc0, const bf16* Kb, int ldk, int kc0, const bf16* Vb, int ldv, int vc0, int nheads, int group,
                                              const float* fbias, const unsigned long long* mask, bf16* O, int oc0) {
    const int half = F.tid >> 8, tid = F.tid & 255, qi = tid >> 2, part = tid & 3;
    LAS bf16* Ks = (LAS bf16*)(F.lds + half * 32768); LAS bf16* Vs = Ks + 64 * 128;
    const int nvb = (SEQ / 64) * (nheads / 2) * BATCH;
    for (int vb = blockIdx.x; vb < nvb; vb += F.G) {
        const int cc = vb >> 6, qb = ((vb & 63) + cc * 17) & 63, hp = cc % (nheads / 2), b = cc / (nheads / 2), h = hp * 2 + half, kvh = h / group;
        const int qpos = qb * 64 + qi; const size_t row = (size_t)b * SEQ + qpos;
        float qv[32], o[32];
#pragma unroll
        for (int d = 0; d < 32; ++d) { qv[d] = bf2f(Qb[row * ldq + qc0 + h * 128 + part * 32 + d]); o[d] = 0.f; }
        float mrun = -1e30f, l = 0.f;
        const float* fb = MODE == 0 ? fbias + (size_t)(b * 8 + h) * SEQ : nullptr;
        for (int kt = 0; kt <= qb; ++kt) {
            __syncthreads();
            for (int i = tid; i < 64 * 16; i += 256) { const int r = i >> 4, c8 = (i & 15) * 8; const size_t kr = (size_t)b * SEQ + kt * 64 + r;
                *(LAS v4u*)(Ks + r * 128 + c8) = *(const v4u*)(Kb + kr * ldk + kc0 + kvh * 128 + c8); *(LAS v4u*)(Vs + r * 128 + c8) = *(const v4u*)(Vb + kr * ldv + vc0 + kvh * 128 + c8); }
            __syncthreads();
            unsigned long long mw = ~0ull; if (MODE == 1) mw = mask[row * 64 + kt];
            for (int s = 0; s < 64; ++s) { const int key = kt * 64 + s; float p = 0.f;
#pragma unroll
                for (int d = 0; d < 32; ++d) p += qv[d] * bf2f(Ks[s * 128 + part * 32 + d]);
                p += __shfl_xor(p, 1); p += __shfl_xor(p, 2);
                const bool valid = key <= qpos && ((mw >> s) & 1ull);
                if (valid) { const float logit = (p + (MODE == 0 ? fb[key] : 0.f)) * ATT_SCALE; const float mn = fmaxf(mrun, logit), al = __expf(mrun - mn), pp = __expf(logit - mn);
                    l = l * al + pp; mrun = mn;
#pragma unroll
                    for (int d = 0; d < 32; ++d) o[d] = o[d] * al + pp * bf2f(Vs[s * 128 + part * 32 + d]); } }
        }
        const float il = 1.0f / l;
#pragma unroll
        for (int d = 0; d < 32; ++d) O[row * DM + oc0 + h * 128 + part * 32 + d] = (bf16)f2bf(o[d] * il);
    }
    __syncthreads();
}
__device__ __forceinline__ void ph_idx_scores(Frame& F) {
    const bf16* PROJ1 = (const bf16*)(F.ws + WS_PROJ); const bf16* IK = (const bf16*)(F.ws + WS_IK); const float* IW = (const float*)(F.ws + WS_IW); float* SC = (float*)(F.ws + WS_SC);
    LAS float* q = (LAS float*)F.lds; LAS float* w = q + 1024; const int tid = F.tid;
    for (int m = blockIdx.x; m < MTOK; m += F.G) { const int pos = m & 4095, b = m >> 12;
        __syncthreads();
        for (int i = tid; i < 1024; i += 512) q[i] = bf2f(PROJ1[(size_t)m * NP1 + 3072 + i]);
        if (tid < 16) w[tid] = IW[(size_t)m * 16 + tid];
        __syncthreads();
        for (int s = tid; s <= pos; s += 512) { const bf16* kr = IK + ((size_t)b * SEQ + s) * 64; float kk[64];
#pragma unroll
            for (int d = 0; d < 64; ++d) kk[d] = bf2f(kr[d]);
            float sc = 0.f;
#pragma unroll 1
            for (int hh = 0; hh < 16; ++hh) { float dsum = 0.f;
#pragma unroll
                for (int d = 0; d < 64; ++d) dsum += q[hh * 64 + d] * kk[d];
                sc += w[hh] * fmaxf(dsum, 0.f); }
            SC[(size_t)m * SEQ + s] = sc; }
    }
    __syncthreads();
}
namespace attn {
constexpr int D = 128, NW = 8, QBLK = 32, KVBLK = 64, QB = NW * QBLK;
constexpr int SHM_V = KVBLK * D * 2, SHM_K = KVBLK * D * 2;
constexpr int OFF_WS = 2 * SHM_V + 2 * SHM_K, OFF_BIAS = OFF_WS + NW * 64 * 4, LDS_NEED = OFF_BIAS + 2 * 16384;
constexpr float SCALE = 0.08838834764831845f, THR = 8.f;
typedef short s16x4 __attribute__((ext_vector_type(4)));
typedef float f32x16 __attribute__((ext_vector_type(16)));
typedef unsigned u32x4 __attribute__((ext_vector_type(4)));
#define KSWZ(row, colB) ((row) * 256 + ((colB) ^ (((row) & 7) << 4)))
#define SBAR() __builtin_amdgcn_sched_barrier(0)
__device__ __forceinline__ int v_st(int k, int c) { const int kk = (k & ~0xC) | ((k & 4) << 1) | ((k & 8) >> 1); return ((kk >> 3) * 4 + (c >> 5)) * 512 + ((kk & 7) * 32 + (c & 31)) * 2; }
__device__ __forceinline__ int v_rd_base(int lane) { return ((lane & 3) << 3) | (((lane >> 2) & 3) << 6) | (((lane >> 4) & 1) << 5) | (((lane >> 5) & 1) << 8); }
constexpr int v_rd_off(int d0, int ks, int half) { return d0 * 512 + ks * 4096 + half * 2048; }
__device__ __forceinline__ int crow(int r, int hi) { return (r & 3) + 8 * (r >> 2) + 4 * hi; }
__device__ __forceinline__ unsigned cvtpk(float lo, float hi) { unsigned r; asm volatile("v_cvt_pk_bf16_f32 %0, %1, %2" : "=v"(r) : "v"(lo), "v"(hi)); return r; }
__device__ __forceinline__ bf16x8 load8(const bf16* p) { return *reinterpret_cast<const bf16x8*>(p); }
__device__ __forceinline__ void mask_tile(f32x16& p0, f32x16& p1, int dq) {
    const float NEG = -__builtin_inff();
#pragma unroll
    for (int r = 0; r < 16; ++r) { const int c = (r & 3) + 8 * (r >> 2); if (dq - c < 0) p0[r] = NEG; if (dq - c - 32 < 0) p1[r] = NEG; }
}
__device__ __forceinline__ void mask_bits(f32x16& p0, f32x16& p1, unsigned w0, unsigned w1) {
#pragma unroll
    for (int r = 0; r < 16; ++r) { const unsigned c = (r & 3) + 8 * (r >> 2);
        const unsigned m0 = (unsigned)__builtin_amdgcn_sbfe((int)w0, c, 1), m1 = (unsigned)__builtin_amdgcn_sbfe((int)w1, c, 1);
        p0[r] = __uint_as_float((m0 & __float_as_uint(p0[r])) | (~m0 & 0xFF800000u)); p1[r] = __uint_as_float((m1 & __float_as_uint(p1[r])) | (~m1 & 0xFF800000u)); }
}
__device__ __forceinline__ void partialSM(f32x16& p0, f32x16& p1, float& m_reg, float& mn, float& alpha) {
    float pmax = p0[0]; for (int r = 1; r < 16; ++r) pmax = fmaxf(pmax, p0[r]); for (int r = 0; r < 16; ++r) pmax = fmaxf(pmax, p1[r]);
    { auto rr = __builtin_amdgcn_permlane32_swap(__float_as_uint(pmax), __float_as_uint(pmax), false, false);
      pmax = fmaxf(__uint_as_float(rr[0]), __uint_as_float(rr[1])); }
    constexpr float C2 = 1.4426950408889634f * SCALE;
    if (__builtin_expect(__all((pmax - m_reg) * SCALE <= THR), 1)) { mn = m_reg; alpha = 1.f; }
    else { mn = fmaxf(m_reg, pmax); alpha = __builtin_amdgcn_exp2f((m_reg - mn) * C2); m_reg = mn; }
    const float mnL = -mn * C2;
    for (int r = 0; r < 16; ++r) p0[r] = fmaf(p0[r], C2, mnL); for (int r = 0; r < 16; ++r) p1[r] = fmaf(p1[r], C2, mnL);
    for (int r = 0; r < 16; ++r) p0[r] = __builtin_amdgcn_exp2f(p0[r]);
}
__device__ __forceinline__ void finishSM(f32x16& p0, f32x16& p1, float alpha, float& l_reg, bf16x8& pa0, bf16x8& pa1, bf16x8& pa2, bf16x8& pa3) {
    for (int r = 0; r < 16; ++r) p1[r] = __builtin_amdgcn_exp2f(p1[r]);
    float ps = 0; for (int r = 0; r < 16; ++r) ps += p0[r]; for (int r = 0; r < 16; ++r) ps += p1[r];
    { auto rr = __builtin_amdgcn_permlane32_swap(__float_as_uint(ps), __float_as_uint(ps), false, false);
      ps = __uint_as_float(rr[0]) + __uint_as_float(rr[1]); }
    l_reg = l_reg * alpha + ps;
#define PK4(P, B_, OUT) do { unsigned a0 = cvtpk(P[B_+0], P[B_+1]), a1 = cvtpk(P[B_+2], P[B_+3]);                          \
        unsigned b0 = cvtpk(P[B_+4], P[B_+5]), b1 = cvtpk(P[B_+6], P[B_+7]);                                             \
        auto r0 = __builtin_amdgcn_permlane32_swap(a0, b0, false, false); auto r1 = __builtin_amdgcn_permlane32_swap(a1, b1, false, false); \
        u32x4 w = {r0[0], r1[0], r0[1], r1[1]}; OUT = *reinterpret_cast<bf16x8*>(&w); } while (0)
    PK4(p0, 0, pa0); PK4(p0, 8, pa1); PK4(p1, 0, pa2); PK4(p1, 8, pa3);
#undef PK4
}
template <int KB, bool BIAS>
__device__ __forceinline__ void qkt(f32x16& p0, f32x16& p1, const char* K_lds, int r32, int hi, const bf16x8* qr, const char* bl) {
    p0 = f32x16{}; p1 = f32x16{}; (void)bl;
    const char* kb[4];
#pragma unroll
    for (int dd = 0; dd < 4; ++dd) kb[dd] = K_lds + KB * SHM_K + KSWZ(r32, (dd * 16 + hi * 8) * 2);
#pragma unroll
    for (int d0 = 0; d0 < 8; ++d0) { const char* a = kb[d0 & 3] + (d0 >> 2) * 128;
        bf16x8 b0 = *reinterpret_cast<const bf16x8*>(a);
        bf16x8 b1 = *reinterpret_cast<const bf16x8*>(a + 32 * 256);
        p0 = __builtin_amdgcn_mfma_f32_32x32x16_bf16(b0, qr[d0], p0, 0, 0, 0);
        p1 = __builtin_amdgcn_mfma_f32_32x32x16_bf16(b1, qr[d0], p1, 0, 0, 0); }
}
template <int VB>
__device__ __forceinline__ void pv_tile(f32x16* o, int vb0, bf16x8 pa0, bf16x8 pa1, bf16x8 pa2, bf16x8 pa3) {
#define TRRD(dst, off) asm volatile("ds_read_b64_tr_b16 %0, %1 offset:%2" : "=&v"(dst) : "v"(vb0), "i"(off) : "memory")
#define PV_D0(d0) do { s16x4 l0, l1, l2, l3, h0, h1, h2, h3; constexpr int b_ = VB * SHM_V + v_rd_off(d0, 0, 0); \
        TRRD(l0, b_); TRRD(h0, b_ + 2048); TRRD(l1, b_ + 4096); TRRD(h1, b_ + 6144); TRRD(l2, b_ + 8192); TRRD(h2, b_ + 10240); TRRD(l3, b_ + 12288); TRRD(h3, b_ + 14336); \
        asm volatile("s_waitcnt lgkmcnt(0)" ::: "memory"); SBAR();   \
        o[d0] = __builtin_amdgcn_mfma_f32_32x32x16_bf16(pa0, (bf16x8){l0[0], l0[1], l0[2], l0[3], h0[0], h0[1], h0[2], h0[3]}, o[d0], 0, 0, 0);   \
        o[d0] = __builtin_amdgcn_mfma_f32_32x32x16_bf16(pa1, (bf16x8){l1[0], l1[1], l1[2], l1[3], h1[0], h1[1], h1[2], h1[3]}, o[d0], 0, 0, 0);   \
        o[d0] = __builtin_amdgcn_mfma_f32_32x32x16_bf16(pa2, (bf16x8){l2[0], l2[1], l2[2], l2[3], h2[0], h2[1], h2[2], h2[3]}, o[d0], 0, 0, 0);   \
        o[d0] = __builtin_amdgcn_mfma_f32_32x32x16_bf16(pa3, (bf16x8){l3[0], l3[1], l3[2], l3[3], h3[0], h3[1], h3[2], h3[3]}, o[d0], 0, 0, 0); } while (0)
    PV_D0(0); PV_D0(1); PV_D0(2); PV_D0(3);
#undef PV_D0
#undef TRRD
}
struct BlockRef { const bf16* Q; const bf16* K; const bf16* V; bf16* O; int P0; const float* fb; const unsigned long long* mrow; };
struct Seam { bf16x8 qr[8]; bf16x8 st_v0, st_v1, st_k0, st_k1; };
#define VMW() asm volatile("s_waitcnt vmcnt(0)" ::: "memory")
#define VMWN(n) asm volatile("s_waitcnt vmcnt(%0)" :: "i"(n) : "memory")
#define SLOAD_H(Kp, Vp, k0) do { const bf16* kt_ = (Kp) + (size_t)(k0) * KS; const bf16* vt_ = (Vp) + (size_t)(k0) * KS; S.st_v0 = load8(vt_ + koff); S.st_v1 = load8(vt_ + koff + 32 * KS); S.st_k0 = load8(kt_ + koff); S.st_k1 = load8(kt_ + koff + 32 * KS); } while (0)
#define SWRITE_HK(bf) do { *(bf16x8*)(K_lds + (bf) * SHM_K + kws) = S.st_k0; *(bf16x8*)(K_lds + (bf) * SHM_K + kws + 32 * 256) = S.st_k1; } while (0)
#define SWRITE_HV(bf) do { *(bf16x8*)(V_lds + (bf) * SHM_V + vst0) = S.st_v0; *(bf16x8*)(V_lds + (bf) * SHM_V + vst1) = S.st_v1; } while (0)
#define SWRITE_H(bf) do { SWRITE_HV(bf); SWRITE_HK(bf); } while (0)
template <bool BIAS, bool BITMASK, int QS, int KS, int OS>
__device__ __forceinline__ void attn_block(const BlockRef& cur, char* lds, LAS unsigned char* ldsl) {
    int tid_ = threadIdx.x; asm volatile("" : "+v"(tid_));
    const int tid = tid_, wid = __builtin_amdgcn_readfirstlane(tid >> 6), lane = tid & 63, r32 = lane & 31, hi = lane >> 5;
    const int NT = (cur.P0 + QB - 1) / KVBLK + 1;
    const int qlo = cur.P0 + wid * QBLK, qm = qlo + r32 - 4 * hi;
    char* V_lds = lds; char* K_lds = lds + 2 * SHM_V;
    float* ws = (float*)(lds + OFF_WS) + wid * 64; float* li_l = ws, * al_l = ws + 32;
    const LAS unsigned char* bl0 = ldsl + OFF_BIAS + hi * 16;
    float m_reg = -1e30f, l_reg = 0; f32x16 o[4] = {};
    const int sr = tid >> 4, sc = (tid & 15) * 8, vst0 = v_st(sr, sc), vst1 = v_st(32 + sr, sc), kws = KSWZ(sr, sc * 2);
    const int vb0 = (int)(uintptr_t)V_lds + v_rd_base(lane);
    const bf16* Kh = cur.K; const bf16* Vh = cur.V;
    const int moff = (wid * QBLK + r32) * 64, koff = sr * KS + sc, qoff = (wid * QBLK + r32) * QS + hi * 8;
    Seam S;
#pragma unroll
    for (int d0 = 0; d0 < 8; ++d0) S.qr[d0] = load8(cur.Q + qoff + d0 * 16);
    if constexpr (BIAS) { const f32x4 b0_ = *(const f32x4*)(cur.fb + tid * 8), b1_ = *(const f32x4*)(cur.fb + tid * 8 + 4);
        *(LAS f32x4*)(ldsl + OFF_BIAS + tid * 32) = b0_; *(LAS f32x4*)(ldsl + OFF_BIAS + tid * 32 + 16) = b1_; }
    SLOAD_H(Kh, Vh, 0); VMW(); SWRITE_HK(0); SWRITE_HV(0); SBAR();
#define RESC(a) do { if (__any((a) < 1.f)) { if (hi == 0) al_l[r32] = (a); asm volatile("s_waitcnt lgkmcnt(0)" ::: "memory");              \
                     for (int d_ = 0; d_ < 4; ++d_) for (int r = 0; r < 16; ++r) o[d_][r] *= al_l[crow(r, hi)]; } } while (0)
#define KBASE(t) ((t) * KVBLK)
#define MLOAD(MW, t) do { if constexpr (BITMASK) MW = (cur.mrow + (t))[moff]; } while (0)
#define MASKT(P0_, P1_, MW, t) do { if constexpr (BIAS) { const LAS unsigned char* bl_ = bl0 + KBASE(t) * 4; _Pragma("unroll") for (int g = 0; g < 4; ++g) { const f32x4 a_ = *(const LAS f32x4*)(bl_ + g * 32), b_ = *(const LAS f32x4*)(bl_ + 128 + g * 32); \
            P0_[4 * g] += a_[0]; P0_[4 * g + 1] += a_[1]; P0_[4 * g + 2] += a_[2]; P0_[4 * g + 3] += a_[3]; P1_[4 * g] += b_[0]; P1_[4 * g + 1] += b_[1]; P1_[4 * g + 2] += b_[2]; P1_[4 * g + 3] += b_[3]; } } \
        if constexpr (BITMASK) { mask_bits(P0_, P1_, (unsigned)(MW) >> (4 * hi), (unsigned)((MW) >> 32) >> (4 * hi)); } \
        else { const int kb_ = KBASE(t); if (kb_ + KVBLK - 1 > qlo) mask_tile(P0_, P1_, qm - kb_); } } while (0)
    f32x16 pA0, pA1, pB0, pB1; float mnA, mnB, alA, alB; bf16x8 pa0, pa1, pa2, pa3; unsigned long long mwA = 0, mwB = 0;
    MLOAD(mwA, 0);
    SLOAD_H(Kh, Vh, KBASE(1)); MLOAD(mwB, 1);
    __syncthreads();
    SBAR(); qkt<0, BIAS>(pA0, pA1, K_lds, r32, hi, S.qr, nullptr);
    MASKT(pA0, pA1, mwA, 0); partialSM(pA0, pA1, m_reg, mnA, alA);
    VMW(); SWRITE_H(1);
    __syncthreads();
#define HALF_STEP(PX0, PX1, mnX, alX, MWX, PY0, PY1, alY, MWY, t, KB, VB, SB) do {                                            \
        SBAR(); qkt<KB, BIAS>(PX0, PX1, K_lds, r32, hi, S.qr, nullptr);                                                       \
        finishSM(PY0, PY1, alY, l_reg, pa0, pa1, pa2, pa3); SBAR();                                                           \
        if ((t) + 1 < NT) { SLOAD_H(Kh, Vh, KBASE((t) + 1)); MLOAD(MWY, (t) + 1); SBAR(); }                                   \
        pv_tile<VB>(o, vb0, pa0, pa1, pa2, pa3); MASKT(PX0, PX1, MWX, (t)); partialSM(PX0, PX1, m_reg, mnX, alX);             \
        __syncthreads();                                                                                                      \
        if ((t) + 1 < NT) { VMW(); SWRITE_H(SB); }                                                                            \
        RESC(alX); __syncthreads(); } while (0)
    for (int t = 1; t + 1 < NT; t += 2) {
        HALF_STEP(pB0, pB1, mnB, alB, mwB, pA0, pA1, alA, mwA, t, 1, 0, 0);
        HALF_STEP(pA0, pA1, mnA, alA, mwA, pB0, pB1, alB, mwB, t + 1, 0, 1, 1);
    }
    SBAR(); qkt<1, BIAS>(pB0, pB1, K_lds, r32, hi, S.qr, nullptr); SBAR();
    finishSM(pA0, pA1, alA, l_reg, pa0, pa1, pa2, pa3); SBAR();
    pv_tile<0>(o, vb0, pa0, pa1, pa2, pa3);
    MASKT(pB0, pB1, mwB, NT - 1); partialSM(pB0, pB1, m_reg, mnB, alB); __syncthreads(); RESC(alB);
    finishSM(pB0, pB1, alB, l_reg, pa0, pa1, pa2, pa3); SBAR(); pv_tile<1>(o, vb0, pa0, pa1, pa2, pa3);
    SBAR();
    if (hi == 0) li_l[r32] = l_reg; asm volatile("s_waitcnt lgkmcnt(0)" ::: "memory");
    float rli[16];
#pragma unroll
    for (int r = 0; r < 16; ++r) rli[r] = __builtin_amdgcn_rcpf(li_l[crow(r, hi)]);
    int tid2_ = threadIdx.x; asm volatile("" : "+v"(tid2_));
    const int r32e = tid2_ & 31, hie = (tid2_ >> 5) & 1, ooff = (wid * QBLK + 4 * hie) * OS + r32e;
#pragma unroll
    for (int r = 0; r < 16; ++r) {
#pragma unroll
        for (int d0 = 0; d0 < 4; ++d0) { const float v = o[d0][r] * rli[r]; const float vn = __shfl_xor(v, 1);
            if ((r32e & 1) == 0) *(unsigned*)(cur.O + ((r & 3) + 8 * (r >> 2)) * OS + d0 * 32 + ooff) = cvtpk(v, vn); } }
    __syncthreads();
#undef RESC
#undef KBASE
#undef MLOAD
#undef MASKT
#undef HALF_STEP
}
#undef ROWK
#undef VMW
#undef VMWN
#undef SLOAD_H
#undef SWRITE_HK
#undef SWRITE_HV
#undef SWRITE_H
#undef KSWZ
#undef SBAR
template <bool BIAS, bool BITMASK, int NH, int GROUP, bool PAIR, int QS, int KS, int OS>
__device__ __forceinline__ void attn_phase(char* lds, LAS unsigned char* ldsl, const bf16* Q, const bf16* K, const bf16* V, bf16* O, const float* fbias, const unsigned long long* mask, int G, int bid) {
    constexpr int NBLK = BATCH * NH * 16, NITEM = PAIR ? NBLK / 2 : NBLK, PER = PAIR ? 8 : 16, SETH = BATCH * NH / 8;
    for (int L = bid; L < NITEM; L += G) {
#pragma unroll 1
        for (int pass = 0; pass < (PAIR ? 2 : 1); ++pass) {
            const int g = L & 7, k = L >> 3, hs = k / PER, x = k % PER; const int bh = g * SETH + hs, b = bh / NH, h = bh % NH;
            const int qb = PAIR ? (pass ? 15 - x : x) : 15 - x; BlockRef r; const size_t row0 = (size_t)b * SEQ + (size_t)qb * QB;
            r.Q = Q + row0 * QS + h * D; r.O = O + row0 * OS + h * D; r.K = K + (size_t)b * SEQ * KS + (h / GROUP) * D; r.V = V + (size_t)b * SEQ * KS + (h / GROUP) * D; r.P0 = qb * QB;
            r.fb = BIAS ? fbias + (size_t)bh * SEQ : nullptr; r.mrow = BITMASK ? mask + row0 * 64 : nullptr;
            attn_block<BIAS, BITMASK, QS, KS, OS>(r, lds, ldsl);
        }
    }
}
}
__device__ __forceinline__ float fast_silu(float g) { return g * __builtin_amdgcn_rcpf(1.0f + __expf(-g)); }
__device__ __forceinline__ void ph_gla_a(Frame& F, const Args& a) {
    const float* SK0 = (const float*)(F.ws + WS_SK0); const float* w2 = a.in[2]; const float* gbias = a.in[3]; float* GB = (float*)(F.ws + WS_GB); float* DEC = (float*)(F.ws + WS_DEC);
    const bf16* PROJ = (const bf16*)(F.ws + WS_PROJ); bf16* CST = (bf16*)(F.ws + WS_CST);
    LAS float* BSH = (LAS float*)F.lds; LAS float* TOT = BSH + 64 * 128; LAS bf16* VT = (LAS bf16*)(F.lds + 36864); LAS bf16* KET = (LAS bf16*)(F.lds + 73728);
    const int tid = F.tid, lane = F.lane, l15 = lane & 15, quad = lane >> 4, w = F.wave;
    for (int unit = blockIdx.x; unit < 512; unit += F.G) {
        const int n = unit & 63, bh = unit >> 6, b = bh >> 2, h = bh & 3, t0 = b * SEQ + n * 64;
        __syncthreads();
        {
            const int d = tid & 127, cg = tid >> 7; float wv[16];
#pragma unroll
            for (int r = 0; r < 16; ++r) wv[r] = w2[r * 512 + h * 128 + d];
            const float gb = gbias[h * 128 + d]; float run = 0.f;
            for (int cc = 0; cc < 16; ++cc) { const int c = cg * 16 + cc; const float* sk = SK0 + (size_t)(t0 + c) * 24; float z = gb;
#pragma unroll
                for (int r = 0; r < 16; ++r) z += sk[r] * wv[r];
                run += logsigmoidf(z) * (1.0f / 16.0f); BSH[c * 128 + d] = run; }
            TOT[cg * 128 + d] = run;
            __syncthreads();
            float pre = 0.f;
            for (int g = 0; g < cg; ++g) pre += TOT[g * 128 + d];
            for (int cc = 0; cc < 16; ++cc) { const int c = cg * 16 + cc; const float v = BSH[c * 128 + d] + pre; BSH[c * 128 + d] = v; GB[(size_t)(t0 + c) * 512 + h * 128 + d] = v; }
        }
        __syncthreads();
        {
            const int c = tid & 63, g8 = tid >> 6; const size_t t = (size_t)(t0 + c);
            const bf16* kp = PROJ + t * NP0 + 512 + h * 128 + g8 * 16;
            const v4u k0 = *(const v4u*)kp, k1 = *(const v4u*)(kp + 8);
            const unsigned kw[8] = {k0.x, k0.y, k0.z, k0.w, k1.x, k1.y, k1.z, k1.w};
#pragma unroll
            for (int i = 0; i < 8; ++i) { const int d = g8 * 16 + 2 * i; const float e0 = __expf(BSH[63 * 128 + d] - BSH[c * 128 + d]), e1 = __expf(BSH[63 * 128 + d + 1] - BSH[c * 128 + d + 1]);
                KET[d * 72 + c] = (bf16)f2bf(bf2f(kw[i] & 0xffff) * e0); KET[(d + 1) * 72 + c] = (bf16)f2bf(bf2f(kw[i] >> 16) * e1); }
            const bf16* vp = PROJ + t * NP0 + 1024 + h * 256 + g8 * 32;
#pragma unroll
            for (int q = 0; q < 4; ++q) { const v4u vv = *(const v4u*)(vp + 8 * q); const unsigned vw[4] = {vv.x, vv.y, vv.z, vv.w};
#pragma unroll
                for (int i = 0; i < 4; ++i) { const int v = g8 * 32 + q * 8 + 2 * i; VT[v * 72 + c] = (bf16)(vw[i] & 0xffff); VT[(v + 1) * 72 + c] = (bf16)(vw[i] >> 16); } }
            if (tid < 128) DEC[unit * 128 + tid] = __expf(BSH[63 * 128 + tid]);
        }
        __syncthreads();
        {
            pg8::f32x4 acc[2][8];
#pragma unroll
            for (int i = 0; i < 2; ++i)
#pragma unroll
                for (int nn = 0; nn < 8; ++nn) acc[i][nn] = (pg8::f32x4){0.f, 0.f, 0.f, 0.f};
#pragma unroll
            for (int kk = 0; kk < 64; kk += 32) {
                const bf16x8 a0 = *(const LAS bf16x8*)(VT + (32 * w + l15) * 72 + kk + quad * 8), a1 = *(const LAS bf16x8*)(VT + (32 * w + 16 + l15) * 72 + kk + quad * 8);
#pragma unroll
                for (int nn = 0; nn < 8; ++nn) { const bf16x8 bb = *(const LAS bf16x8*)(KET + (16 * nn + l15) * 72 + kk + quad * 8);
                    acc[0][nn] = __builtin_amdgcn_mfma_f32_16x16x32_bf16(a0, bb, acc[0][nn], 0, 0, 0); acc[1][nn] = __builtin_amdgcn_mfma_f32_16x16x32_bf16(a1, bb, acc[1][nn], 0, 0, 0); } }
            bf16* cp = CST + (size_t)unit * 32768;
#pragma unroll
            for (int i = 0; i < 2; ++i)
#pragma unroll
                for (int nn = 0; nn < 8; ++nn)
#pragma unroll
                    for (int j = 0; j < 4; ++j) cp[(32 * w + 16 * i + quad * 4 + j) * 128 + 16 * nn + l15] = (bf16)f2bf(acc[i][nn][j]);
        }
    }
    __syncthreads();
}
__device__ __forceinline__ void ph_gla_c(Frame& F, const Args& a) {
    const bf16* PROJ = (const bf16*)(F.ws + WS_PROJ); const float* GB = (const float*)(F.ws + WS_GB); const bf16* PREVT = (const bf16*)(F.ws + WS_PREVT); const float* normg = a.in[4]; bf16* OMIX = (bf16*)(F.ws + WS_OMIX);
    LAS bf16* QD = (LAS bf16*)(F.lds + 32768); LAS bf16* KI = (LAS bf16*)(F.lds + 50176); LAS bf16* P = (LAS bf16*)(F.lds + 67584); LAS bf16* VT = (LAS bf16*)(F.lds + 76800); LAS float* RED = (LAS float*)(F.lds + 113664);
    const int tid = F.tid, lane = F.lane, l15 = lane & 15, quad = lane >> 4, w = F.wave;
    for (int unit = blockIdx.x; unit < 512; unit += F.G) {
        const int n = unit & 63, bh = unit >> 6, b = bh >> 2, h = bh & 3, t0 = b * SEQ + n * 64;
        __syncthreads();
        {
            const int c = tid >> 3, dg = tid & 7; const size_t t = (size_t)(t0 + c);
            const float* bp = GB + t * 512 + h * 128 + dg * 16; const bf16* qp = PROJ + t * NP0 + h * 128 + dg * 16; const bf16* kp = PROJ + t * NP0 + 512 + h * 128 + dg * 16;
#pragma unroll
            for (int q8 = 0; q8 < 2; ++q8) { const v4u qq = *(const v4u*)(qp + 8 * q8), kk = *(const v4u*)(kp + 8 * q8); const f32x4 b0 = *(const f32x4*)(bp + 8 * q8), b1 = *(const f32x4*)(bp + 8 * q8 + 4);
                const unsigned qw[4] = {qq.x, qq.y, qq.z, qq.w}, kw[4] = {kk.x, kk.y, kk.z, kk.w}; const float bv[8] = {b0[0], b0[1], b0[2], b0[3], b1[0], b1[1], b1[2], b1[3]};
                v4u oq, ok; unsigned* oqp = (unsigned*)&oq; unsigned* okp = (unsigned*)&ok;
#pragma unroll
                for (int i = 0; i < 4; ++i) { const float e0 = __expf(bv[2 * i]), e1 = __expf(bv[2 * i + 1]);
                    oqp[i] = pk2(bf2f(qw[i] & 0xffff) * ATT_SCALE * e0, bf2f(qw[i] >> 16) * ATT_SCALE * e1);
                    okp[i] = pk2(bf2f(kw[i] & 0xffff) * __builtin_amdgcn_rcpf(e0), bf2f(kw[i] >> 16) * __builtin_amdgcn_rcpf(e1)); }
                *(LAS v4u*)(QD + c * 136 + dg * 16 + 8 * q8) = oq; *(LAS v4u*)(KI + c * 136 + dg * 16 + 8 * q8) = ok; }
            const int c2 = tid & 63, g8 = tid >> 6; const bf16* vp = PROJ + (size_t)(t0 + c2) * NP0 + 1024 + h * 256 + g8 * 32;
#pragma unroll
            for (int q = 0; q < 4; ++q) { const v4u vv = *(const v4u*)(vp + 8 * q); const unsigned vw[4] = {vv.x, vv.y, vv.z, vv.w};
#pragma unroll
                for (int i = 0; i < 4; ++i) { const int v = g8 * 32 + q * 8 + 2 * i; VT[v * 72 + c2] = (bf16)(vw[i] & 0xffff); VT[(v + 1) * 72 + c2] = (bf16)(vw[i] >> 16); } }
        }
        __syncthreads();
        {
            const int ti = w >> 1;
#pragma unroll
            for (int s = 0; s < 2; ++s) { const int tj = 2 * (w & 1) + s; pg8::f32x4 acc = (pg8::f32x4){0.f, 0.f, 0.f, 0.f};
                if (tj <= ti) {
#pragma unroll
                    for (int kk = 0; kk < 128; kk += 32) { const bf16x8 aa = *(const LAS bf16x8*)(QD + (16 * ti + l15) * 136 + kk + quad * 8), bb = *(const LAS bf16x8*)(KI + (16 * tj + l15) * 136 + kk + quad * 8);
                        acc = __builtin_amdgcn_mfma_f32_16x16x32_bf16(aa, bb, acc, 0, 0, 0); } }
#pragma unroll
                for (int j = 0; j < 4; ++j) { const int i = 16 * ti + quad * 4 + j, jj = 16 * tj + l15; P[i * 72 + jj] = (bf16)f2bf(jj <= i ? acc[j] : 0.f); } }
        }
        __syncthreads();
        {
            const int ti = w >> 1, half = w & 1; pg8::f32x4 acc[8];
#pragma unroll
            for (int nn = 0; nn < 8; ++nn) acc[nn] = (pg8::f32x4){0.f, 0.f, 0.f, 0.f};
#pragma unroll
            for (int kk = 0; kk < 64; kk += 32) { const bf16x8 aa = *(const LAS bf16x8*)(P + (16 * ti + l15) * 72 + kk + quad * 8);
#pragma unroll
                for (int nn = 0; nn < 8; ++nn) { const bf16x8 bb = *(const LAS bf16x8*)(VT + (128 * half + 16 * nn + l15) * 72 + kk + quad * 8); acc[nn] = __builtin_amdgcn_mfma_f32_16x16x32_bf16(aa, bb, acc[nn], 0, 0, 0); } }
            const bf16* pv = PREVT + (size_t)unit * 32768 + (size_t)(128 * half + l15) * 128 + quad * 8;
#pragma unroll
            for (int kk = 0; kk < 128; kk += 32) { const bf16x8 aa = *(const LAS bf16x8*)(QD + (16 * ti + l15) * 136 + kk + quad * 8);
#pragma unroll
                for (int nn = 0; nn < 8; ++nn) { const bf16x8 bb = *(const bf16x8*)(pv + (size_t)(16 * nn) * 128 + kk); acc[nn] = __builtin_amdgcn_mfma_f32_16x16x32_bf16(aa, bb, acc[nn], 0, 0, 0); } }
            float ss[4];
#pragma unroll
            for (int j = 0; j < 4; ++j) { float s = 0.f;
#pragma unroll
                for (int nn = 0; nn < 8; ++nn) s += acc[nn][j] * acc[nn][j];
                s += __shfl_xor(s, 1); s += __shfl_xor(s, 2); s += __shfl_xor(s, 4); s += __shfl_xor(s, 8); ss[j] = s; }
            if (l15 == 0) {
#pragma unroll
                for (int j = 0; j < 4; ++j) RED[(16 * ti + quad * 4 + j) * 2 + half] = ss[j]; }
            __syncthreads();
#pragma unroll
            for (int j = 0; j < 4; ++j) { const int i = 16 * ti + quad * 4 + j; const float ms = (RED[i * 2] + RED[i * 2 + 1]) * (1.0f / 256.0f); const float rs = 1.0f / sqrtf(ms + LN_EPS);
                const size_t t = (size_t)(t0 + i);
#pragma unroll
                for (int nn = 0; nn < 8; ++nn) { const int v = 128 * half + 16 * nn + l15; const float gr = bf2f(PROJ[t * NP0 + 2048 + h * 256 + v]);
                    OMIX[t * DM + h * 256 + v] = (bf16)f2bf(acc[nn][j] * rs * normg[v] * fast_silu(gr)); } }
        }
    }
    __syncthreads();
}
__device__ __forceinline__ void ph_indexer(Frame& F, unsigned char* lds_generic) {
    typedef float f32x16 __attribute__((ext_vector_type(16)));
    const bf16* PROJ1 = (const bf16*)(F.ws + WS_PROJ); const bf16* IK = (const bf16*)(F.ws + WS_IK); const float* IW = (const float*)(F.ws + WS_IW); unsigned long long* MASK = (unsigned long long*)(F.ws + WS_MASK);
    LAS float* SCL = (LAS float*)F.lds;
    const int lane = F.lane, w = F.wave, c32 = lane & 31, hi = lane >> 5, rt = w & 3, kpar = w >> 2;
    for (int it = blockIdx.x; it < 512; it += F.G) {
#pragma unroll 1
        for (int pass = 0; pass < 2; ++pass) {
            const int unit = pass ? 1023 - it : it, m0 = unit * 8, b = m0 >> 12, qmax = (m0 & 4095) + 7;
            __syncthreads();
            {
                const int qa = m0 + 2 * rt + ((c32 >> 2) & 1), ha = (c32 & 3) + 4 * (c32 >> 3);
                const bf16* ap = PROJ1 + (size_t)qa * NP1 + 3072 + ha * 64 + 8 * hi;
                bf16x8 af[4];
#pragma unroll
                for (int ks = 0; ks < 4; ++ks) af[ks] = *(const bf16x8*)(ap + 16 * ks);
                const float* wp = IW + (size_t)(m0 + 2 * rt + hi) * 16; float wv[16];
#pragma unroll
                for (int q4 = 0; q4 < 4; ++q4) { const f32x4 t4 = *(const f32x4*)(wp + 4 * q4); wv[4 * q4] = t4[0]; wv[4 * q4 + 1] = t4[1]; wv[4 * q4 + 2] = t4[2]; wv[4 * q4 + 3] = t4[3]; }
                LAS float* srow = SCL + (2 * rt + hi) * 4096 + c32;
                const bf16* kbase = IK + (size_t)b * SEQ * 64 + (size_t)lane * 8;
                bf16x8 bn[4];
#pragma unroll
                for (int ks = 0; ks < 4; ++ks) bn[ks] = *(const bf16x8*)(kbase + (size_t)(kpar * 4 + ks) * 512);
                for (int t = kpar; t * 32 <= qmax; t += 2) {
                    bf16x8 bc[4];
#pragma unroll
                    for (int ks = 0; ks < 4; ++ks) bc[ks] = bn[ks];
                    const int tn = (t + 2) * 32 <= qmax ? t + 2 : t;
#pragma unroll
                    for (int ks = 0; ks < 4; ++ks) bn[ks] = *(const bf16x8*)(kbase + (size_t)(tn * 4 + ks) * 512);
                    f32x16 acc = {};
#pragma unroll
                    for (int ks = 0; ks < 4; ++ks) acc = __builtin_amdgcn_mfma_f32_32x32x16_bf16(af[ks], bc[ks], acc, 0, 0, 0);
                    float s = 0.f;
#pragma unroll
                    for (int r = 0; r < 16; ++r) s += wv[r] * fmaxf(acc[r], 0.f);
                    srow[t * 32] = s; }
            }
            __syncthreads();
            { const int m = m0 + w; topk_mask_row((const LAS float*)(F.lds + w * 16384), m & 4095, MASK + (size_t)m * 64, lane, (LAS unsigned*)(F.lds + LDSCTL_OFF + 4096 + w * 1024)); }
        }
    }
    __syncthreads();
}
#define IN(k) (lo <= (k) && (k) < hi)
#define SEAM(k) do { if (hi > (k) + 1) xcd_barrier(bar); } while (0)
template <int LAYER, int BASE>
__device__ __forceinline__ void common_phases(Frame& F, const Args& args, const int lo, const int hi, const XcdBarrier& bar) {
    unsigned char* ws = args.ws;
    if (IN(BASE + 0)) {
        pg8::Gemm g{(const bf16*)(ws + WS_OMIX), (const bf16*)(ws + (LAYER ? WS_WOC : WS_WOA)), MTOK, DM, DM, DM, DM}; pg8::StaticOrder S; S.init(MTOK, DM, F.G, (int)blockIdx.x);
        pg8::EpiResid E{(const bf16*)(ws + WS_XB), (bf16*)(ws + WS_YB), DN_ALPHA};
        pg8::gemm_phase<pg8::EpiResid, pg8::StaticOrder, true, true>(F.lds, g, S, E);
        SEAM(BASE + 0);
    }
    if (IN(BASE + 1)) { p_ln_route(F, args, LAYER); SEAM(BASE + 1); }
    if (IN(BASE + 3) || IN(BASE + 4) || IN(BASE + 5)) {
        if (F.wave == 0) { int ti; (void)moe_offsets(F.ctl + CW_CNT + LAYER * 64, F.lane, &ti); if (F.lane < 32) { F.MISC[64 + F.lane] = (unsigned)ti; F.MISC[160 + F.lane] = F.ctl[CW_CNT + LAYER * 64 + F.lane]; } if (F.lane == 31) F.MISC[96] = (unsigned)ti; }
        __syncthreads();
    }
    {
        const int Tm = (int)F.MISC[96], T1 = F.G / 4 < Tm ? F.G / 4 : Tm;
        const int n2 = (Tm - T1) * 4;
        const pg8::Gemm gU{(const bf16*)(ws + WS_XB), (const bf16*)(ws + WS_WGU) + (size_t)LAYER * 32 * 1024 * 2048, RPAD, 32 * 1024, DM, DM, DM};
        const pg8::Gemm gD{(const bf16*)(ws + WS_OMIX), (const bf16*)(ws + WS_WD) + (size_t)LAYER * 32 * 2048 * 512, RPAD, 32 * 2048, 512, 512, 512};
        const PG8_LAS int* tend = (const LAS int*)(F.lds + LDSCTL_OFF + 64 * 4); const PG8_LAS int* ecnt = (const LAS int*)(F.lds + LDSCTL_OFF + 160 * 4);
        const int* inv = (const int*)(ws + WS_INV);
        const pg8::EpiGLU EU{(bf16*)(ws + WS_OMIX), (const float*)(ws + WS_WINV)}; const pg8::EpiBf16Plain ED{(bf16*)(ws + WS_CST), DM, 7};
        if (IN(BASE + 3)) {
            pg8::MoeOrder S{F.G, (int)blockIdx.x, 4, 0, T1 * 4, 0, tend, ecnt};
            pg8::gemm_phase_g<pg8::EpiGLU, pg8::MoeOrder>(F.lds, gU, S, EU, inv);
            SEAM(BASE + 3);
        }
        if (IN(BASE + 4)) {
            if ((int)blockIdx.x < n2) { pg8::MoeOrder S{n2, (int)blockIdx.x, 4, T1 * 4, Tm * 4, 0, tend, ecnt}; pg8::gemm_phase_g<pg8::EpiGLU, pg8::MoeOrder>(F.lds, gU, S, EU, inv); }
            else { pg8::MoeOrder S{F.G - n2, (int)blockIdx.x - n2, 8, 0, T1 * 8, 0, tend, ecnt}; pg8::gemm_phase<pg8::EpiBf16Plain, pg8::MoeOrder, true, true>(F.lds, gD, S, ED); }
            if (LAYER == 0) late_conv_items(F, args, CONV_SPLIT, CONV_LATE_ITEMS, 1);
            SEAM(BASE + 4);
        }
        if (IN(BASE + 5)) {
            pg8::MoeOrder S{F.G, (int)blockIdx.x, 8, T1 * 8, Tm * 8, 0, tend, ecnt};
            pg8::gemm_phase<pg8::EpiBf16Plain, pg8::MoeOrder, true, true>(F.lds, gD, S, ED);
            if (LAYER == 0) late_conv_items(F, args, CONV_SPLIT, CONV_LATE_ITEMS, 1);
            SEAM(BASE + 5);
        }
    }
    if (IN(BASE + 6)) { p_ln_ffn(F, args, LAYER); SEAM(BASE + 6); }
}
__global__ void __launch_bounds__(NWAVES * 64, 2) mk_fwd(Args args) {
    extern __shared__ __attribute__((aligned(16))) unsigned char lds[];
    Frame F;
    F.lds = (LAS unsigned char*)lds; F.MISC = (volatile LAS unsigned*)(F.lds + LDSCTL_OFF);
    F.tid = threadIdx.x; F.lane = F.tid & 63; F.wave = __builtin_amdgcn_readfirstlane(F.tid >> 6);
    F.G = gridDim.x; F.gw = blockIdx.x * NWAVES + F.wave; F.NGW = F.G * NWAVES;
    F.ws = args.ws; F.ctl = (unsigned*)(args.ws + WS_CTL);
    for (int u = F.tid; u < (LDS_BYTES - LDSCTL_OFF) / 4; u += NWAVES * 64) ((LAS unsigned*)(F.lds + LDSCTL_OFF))[u] = 0u;
    __syncthreads();
    const int lo = args.ph_lo, hi = args.ph_hi;
    XcdBarrier bar; bar.bar = F.ctl + CW_BAR + args.bar_region * XCD_BAR_WORDS; bar.x = 0; bar.st = nullptr;
    if (hi - lo > 1) bar = xcd_barrier_post(F.ctl + CW_BAR + args.bar_region * XCD_BAR_WORDS, F.MISC);
    unsigned char* ws = args.ws;

    if (IN(0)) { p0_prologue(F, args); SEAM(0); }
    if (IN(1)) {
        pg8::Gemm g{(const bf16*)(ws + WS_XB), (const bf16*)(ws + WS_WINA), MTOK, NP0, DM, DM, DM}; pg8::StaticOrder S; S.init(MTOK, NP0, F.G, (int)blockIdx.x);
        pg8::EpiBf16Plain E{(bf16*)(ws + WS_PROJ), NP0, 0x7fffffff};
        pg8::gemm_phase<pg8::EpiBf16Plain, pg8::StaticOrder, true, true>(F.lds, g, S, E);
        p_skinny0(F, args);
        SEAM(1);
    }
    if (IN(2)) { p_fox_bias(F, args); ph_gla_a(F, args); SEAM(2); }
    if (IN(4)) { ph_gla_scan(F); __syncthreads();
        attn::attn_phase<true, false, 8, 1, false, NP0, NP0, DM>((char*)lds, F.lds, (const bf16*)(ws + WS_PROJ) + 3072, (const bf16*)(ws + WS_PROJ) + 4096, (const bf16*)(ws + WS_PROJ) + 5120,
                                                               (bf16*)(ws + WS_OMIX) + 1024, (const float*)(ws + WS_FBIAS), (const unsigned long long*)nullptr, F.G, (int)blockIdx.x);
        late_conv_items(F, args, CONV_STATIC, CONV_SPLIT, 0);
        SEAM(4); }
    if (IN(5)) { ph_gla_c(F, args); SEAM(5); }
    common_phases<0, 6>(F, args, lo, hi, bar);
    if (IN(13)) {
        pg8::Gemm g{(const bf16*)(ws + WS_XB), (const bf16*)(ws + WS_WINC), MTOK, NP1, DM, DM, DM}; pg8::StaticOrder S; S.init(MTOK, NP1, F.G, (int)blockIdx.x);
        const float* c128 = (const float*)(ws + WS_ROPE);
        pg8::EpiRope E{(bf16*)(ws + WS_PROJ), c128, c128 + 4096 * 64, c128 + 2 * 4096 * 64, c128 + 2 * 4096 * 64 + 4096 * 32};
        pg8::gemm_phase<pg8::EpiRope, pg8::StaticOrder, true, true>(F.lds, g, S, E);
        SEAM(13);
    }
    if (IN(14)) { ph_indexer(F, lds); SEAM(14); }
    if (IN(16)) {
        attn::attn_phase<false, true, 16, 4, true, NP1, NP1, DM>((char*)lds, F.lds, (const bf16*)(ws + WS_PROJ), (const bf16*)(ws + WS_PROJ) + 2048, (const bf16*)(ws + WS_PROJ) + 2560,
                                                               (bf16*)(ws + WS_OMIX), (const float*)nullptr, (const unsigned long long*)(ws + WS_MASK), F.G, (int)blockIdx.x);
        SEAM(16); }
    common_phases<1, 17>(F, args, lo, hi, bar);
#ifdef PROBE_CONV
    if (IN(31)) {
        LAS bf16* T = (LAS bf16*)(F.lds + F.wave * 16384); bf16* dstb = (bf16*)(ws + WS_SC); float sink = 0.f;
        for (int it = F.gw; it < 32 * 256; it += F.NGW) {
            const int ex = 32 + it / 256, r = it % 256, kb = r / 8, nb = r % 8;
            TrItem t{args.in[17] + (size_t)ex * 2048 * 512, dstb + (size_t)(it / 256) * 512 * 2048, 512, nb * 64, nb * 64 + 32, 2048, nb * 64, kb * 64};
            f32x4 r16[16]; tr64_load(t, r16, F.lane);
            if (PROBE_CONV == 0) tr64_store(t, r16, T, F.lane);
            else if (PROBE_CONV == 1) {
#pragma unroll
                for (int i = 0; i < 8; ++i) { uint2 o; o.x = pg8::cvt_pk_bf16(r16[2 * i][0], r16[2 * i][1]); o.y = pg8::cvt_pk_bf16(r16[2 * i][2], r16[2 * i][3]); uint2 p; p.x = pg8::cvt_pk_bf16(r16[2 * i + 1][0], r16[2 * i + 1][1]); p.y = pg8::cvt_pk_bf16(r16[2 * i + 1][2], r16[2 * i + 1][3]);
                    bf16* d = dstb + (size_t)(it / 256) * 512 * 2048 + (size_t)(kb * 64 + 8 * i + 2 * (F.lane >> 4)) * 512 + nb * 64 + 4 * (F.lane & 15); *(uint2*)d = o; *(uint2*)(d + 512) = p; } }
            else {
#pragma unroll
                for (int i = 0; i < 16; ++i) sink += r16[i][0] + r16[i][3]; }
        }
        if (PROBE_CONV == 2 && sink == 12345.678f) dstb[F.tid] = 1;
    }
#endif
#ifdef PROBE_GEMM_K
    if (IN(30)) {
        pg8::Gemm g{(const bf16*)(ws + WS_XB), (const bf16*)(ws + WS_WINA), MTOK, NP0, PROBE_GEMM_K, PROBE_GEMM_LD, PROBE_GEMM_LD}; pg8::StaticOrder S; S.init(MTOK, NP0, F.G, (int)blockIdx.x);
        pg8::EpiBf16Plain E{(bf16*)(ws + WS_SC), NP0, 0x7fffffff};
        pg8::gemm_phase<pg8::EpiBf16Plain, pg8::StaticOrder, true, true>(F.lds, g, S, E);
    }
#endif
}
#undef IN
#undef SEAM
constexpr int N_PHASE_IDS = 24;
static void launch_mk(const Args& base, int lo, int hi, int grid, hipStream_t stream, int region = 0) {
    Args a = base; a.ph_lo = lo; a.ph_hi = hi; a.bar_region = region; a.pad = 0;
    hipLaunchKernelGGL(mk_fwd, dim3(grid), dim3(NWAVES * 64), LDS_BYTES, stream, a);
}
extern "C" void kernel_launch(void* const* d_in, const int* in_sizes, int n_in, void* d_out, int out_size, void* d_ws, size_t ws_size, hipStream_t stream) {
    static int grid = 0;
    if (grid == 0) {
        if (n_in != 20 || out_size != MTOK * DM || ws_size < WS_END) { fprintf(stderr, "kernel_launch: unexpected shapes (n_in %d, out %d, ws %zu < %zu)\n", n_in, out_size, ws_size, (size_t)WS_END); grid = -1; return; }
        int dev = 0, cus = 0, per_cu = 0;
        if (hipGetDevice(&dev) != hipSuccess || hipDeviceGetAttribute(&cus, hipDeviceAttributeMultiprocessorCount, dev) != hipSuccess) { grid = -1; return; }
        if (hipFuncSetAttribute((const void*)mk_fwd, hipFuncAttributeMaxDynamicSharedMemorySize, LDS_BYTES) != hipSuccess) { fprintf(stderr, "kernel_launch: hipFuncSetAttribute failed\n"); grid = -1; return; }
        if (hipOccupancyMaxActiveBlocksPerMultiprocessor(&per_cu, (const void*)mk_fwd, NWAVES * 64, LDS_BYTES) != hipSuccess || per_cu < 1) { fprintf(stderr, "kernel_launch: occupancy query reports %d workgroups per CU\n", per_cu); }
        (void)hipGetLastError();
        grid = cus;
    }
    if (grid < 0) return;
    (void)in_sizes;
    if (hipMemsetAsync((char*)d_ws + WS_CTL, 0, CTL_ZERO_BYTES, stream) != hipSuccess) return;
    Args a{};
    for (int i = 0; i < 20; ++i) a.in[i] = (const float*)d_in[i];
    a.out = (float*)d_out; a.ws = (unsigned char*)d_ws;
#ifdef PROBE_LO
    launch_mk(a, 0, PROBE_HI + 1, grid, stream, 0); launch_mk(a, PROBE_LO, N_PHASE_IDS, grid, stream, 1);
#else
    launch_mk(a, 0, N_PHASE_IDS, grid, stream);
#endif
#ifdef PROBE_GEMM_K
    launch_mk(a, 30, 31, grid, stream, 2);
#endif
#ifdef PROBE_CONV
    launch_mk(a, 31, 32, grid, stream, 2);
#endif
}
```

```cpp
#include <hip/hip_runtime.h>
#include <cstdio>
#include <cstdint>
namespace pg8 {
#define PG8_LAS __attribute__((address_space(3)))
typedef unsigned short bf16_t;
typedef short bf16x8 __attribute__((ext_vector_type(8)));
typedef float f32x4 __attribute__((ext_vector_type(4)));
typedef unsigned u32x4 __attribute__((ext_vector_type(4)));
constexpr int BM = 256, BK = 64, HALF = 128, HTB = HALF * BK * 2  , STAGE_BYTES = 8 * HTB, NXCD = 8, WGM = 8;

__host__ __device__ __forceinline__ int lds_byte(int r, int c) { const int st = (r >> 4) * 2 + (c >> 5), rr = r & 15, cc = c & 31, ob = rr * 64 + cc * 2; return st * 1024 + (ob ^ (((ob >> 9) & 1) << 5)); }
__host__ __device__ __forceinline__ void stage_rc(int b, int& R, int& C) { const int st = b / 1024, sb = b % 1024, swz = sb ^ (((sb >> 9) & 1) << 5); R = (st >> 1) * 16 + swz / 64; C = (st & 1) * 32 + (swz % 64) / 2; }
__host__ __device__ __forceinline__ int perm32(int rho) { const int n = rho >> 4, i = rho & 15; return 8 * (i >> 2) + 4 * n + (i & 3); }

struct Unit { int pm, pn, inv0, nvalid, half; };
struct Gemm { const bf16_t* A; const bf16_t* Bt; int M, N, K, lda, ldb; };

struct StaticOrder {
    int nM, nN, nwg, G, c;
    __host__ __device__ void init(int M, int N, int G_, int c_) { nM = M / BM; nN = N / BM; nwg = nM * nN; G = G_; c = c_; }
    __host__ __device__ bool next(int i, Unit& u) const {
        const long L = (long)i * G + c; if (L >= nwg) return false;
        int wgid = (int)L; { const int q = nwg / NXCD, r = nwg % NXCD, xcd = wgid % NXCD, off = wgid / NXCD; wgid = (xcd < r ? xcd * (q + 1) : r * (q + 1) + (xcd - r) * q) + off; }
        const int nig = WGM * nN, gid = wgid / nig, fm = gid * WGM, gsz = (nM - fm) < WGM ? (nM - fm) : WGM;
        u.pm = fm + ((wgid % nig) % gsz); u.pn = (wgid % nig) / gsz; return true;
    }
    __device__ __forceinline__ void a_ready(const Unit&) const {}
    __device__ __forceinline__ void done(const Unit&) const {}
};

__device__ __forceinline__ unsigned cvt_pk_bf16(float lo, float hi) { unsigned r; asm volatile("v_cvt_pk_bf16_f32 %0, %1, %2" : "=v"(r) : "v"(lo), "v"(hi)); return r; }
typedef float f32x2 __attribute__((ext_vector_type(2)));
struct EpiBf16Plain {
    static constexpr bool PERM = true, AFTER_DRAIN = false;
    bf16_t* O; int ldc; int pn_mask;
    __device__ __forceinline__ void operator()(const f32x4 (&acc)[2][2][4][2], const Unit& u, int wr, int wc, int fr, int fq) const {
        const int row0 = u.pm * BM + wr * 64 + fr, col0 = (u.pn & pn_mask) * BM + wc * 32 + 8 * fq;
#pragma unroll
        for (int ai = 0; ai < 2; ++ai)
#pragma unroll
            for (int m = 0; m < 4; ++m) { bf16_t* rowp = O + (size_t)(row0 + ai * HALF + m * 16) * ldc + col0;
#pragma unroll
                for (int bj = 0; bj < 2; ++bj) { const f32x4 v0 = acc[ai][bj][m][0], v1 = acc[ai][bj][m][1];
                    u32x4 w; w.x = cvt_pk_bf16(v0[0], v0[1]); w.y = cvt_pk_bf16(v0[2], v0[3]); w.z = cvt_pk_bf16(v1[0], v1[1]); w.w = cvt_pk_bf16(v1[2], v1[3]);
                    *(u32x4*)(rowp + bj * HALF) = w; } }
    }
};
struct EpiResid {
    static constexpr bool PERM = true, AFTER_DRAIN = false;
    const bf16_t* base; bf16_t* out; float alpha;
    __device__ __forceinline__ void operator()(const f32x4 (&acc)[2][2][4][2], const Unit& u, int wr, int wc, int fr, int fq) const {
        const int row0 = u.pm * BM + wr * 64 + fr, col0 = u.pn * BM + wc * 32 + 8 * fq;
#pragma unroll
        for (int ai = 0; ai < 2; ++ai)
#pragma unroll
            for (int m = 0; m < 4; ++m) { const size_t off = (size_t)(row0 + ai * HALF + m * 16) * 2048 + col0;
#pragma unroll
                for (int bj = 0; bj < 2; ++bj) { const u32x4 b = *(const u32x4*)(base + off + bj * HALF); const f32x4 v0 = acc[ai][bj][m][0], v1 = acc[ai][bj][m][1];
                    const unsigned bw[4] = {b.x, b.y, b.z, b.w}; u32x4 w; unsigned* wp = (unsigned*)&w;
#pragma unroll
                    for (int q = 0; q < 4; ++q) { const float lo = __builtin_bit_cast(float, bw[q] << 16), hi = __builtin_bit_cast(float, bw[q] & 0xffff0000u);
                        const float a0 = q < 2 ? v0[2 * q] : v1[2 * q - 4], a1 = q < 2 ? v0[2 * q + 1] : v1[2 * q - 3];
                        wp[q] = cvt_pk_bf16(lo * alpha + a0, hi * alpha + a1); }
                    *(u32x4*)(out + off + bj * HALF) = w; } }
    }
};
struct EpiGLU {
    static constexpr bool PERM = true, AFTER_DRAIN = false;
    bf16_t* H; const float* winv;
    __device__ __forceinline__ void operator()(const f32x4 (&acc)[2][2][4][2], const Unit& u, int wr, int wc, int fr, int fq) const {
        const int row0 = u.pm * BM + wr * 64 + fr, f0 = (u.pn & 3) * 128 + wc * 32 + 8 * fq;
#pragma unroll
        for (int ai = 0; ai < 2; ++ai) { if (u.half >= 0 && u.half != ai) continue;
#pragma unroll
            for (int m = 0; m < 4; ++m) { const int row = row0 + ai * HALF + m * 16; const float w = winv[u.inv0 + ai * HALF + wr * 64 + m * 16 + fr];
                float h[8];
#pragma unroll
                for (int n = 0; n < 2; ++n)
#pragma unroll
                    for (int e = 0; e < 4; ++e) { const float g = acc[ai][0][m][n][e], up = acc[ai][1][m][n][e]; h[n * 4 + e] = g * __builtin_amdgcn_rcpf(1.0f + __expf(-g)) * up * w; }
                u32x4 o; o.x = cvt_pk_bf16(h[0], h[1]); o.y = cvt_pk_bf16(h[2], h[3]); o.z = cvt_pk_bf16(h[4], h[5]); o.w = cvt_pk_bf16(h[6], h[7]);
                *(u32x4*)(H + (size_t)row * 512 + f0) = o; } }
    }
};
struct EpiRope {
    static constexpr bool PERM = true, AFTER_DRAIN = false;
    bf16_t* O; const float* c128; const float* s128; const float* c64; const float* s64;
    __device__ __forceinline__ void operator()(const f32x4 (&acc)[2][2][4][2], const Unit& u, int wr, int wc, int fr, int fq) const {
        const int row0 = u.pm * BM + wr * 64 + fr, jj = wc * 32 + 8 * fq;
        const int pn = u.pn;
        if (pn == 10 || pn == 11) {
#pragma unroll
            for (int ai = 0; ai < 2; ++ai)
#pragma unroll
                for (int m = 0; m < 4; ++m) { bf16_t* rowp = O + (size_t)(row0 + ai * HALF + m * 16) * 4096 + pn * 256 + jj;
#pragma unroll
                    for (int bj = 0; bj < 2; ++bj) { const f32x4 v0 = acc[ai][bj][m][0], v1 = acc[ai][bj][m][1];
                        u32x4 w; w.x = cvt_pk_bf16(v0[0], v0[1]); w.y = cvt_pk_bf16(v0[2], v0[3]); w.z = cvt_pk_bf16(v1[0], v1[1]); w.w = cvt_pk_bf16(v1[2], v1[3]);
                        *(u32x4*)(rowp + bj * HALF) = w; } }
            return;
        }
        const bool idx = pn >= 12;
        const int half = idx ? 32 : 64;
        const int hl = idx ? (jj >> 5) : (jj >> 6), i0 = jj & (half - 1);
        const int colbase = idx ? (3072 + ((pn - 12) * 4 + hl) * 64) : (pn * 256 + hl * 128);
        const float* ct = idx ? c64 : c128; const float* st = idx ? s64 : s128;
#pragma unroll
        for (int ai = 0; ai < 2; ++ai)
#pragma unroll
            for (int m = 0; m < 4; ++m) { const int row = row0 + ai * HALF + m * 16; const int pos = row & 4095;
                const float* cp = ct + (size_t)pos * half + i0; const float* sp = st + (size_t)pos * half + i0;
                const f32x4 c0 = *(const f32x4*)cp, c1 = *(const f32x4*)(cp + 4), s0 = *(const f32x4*)sp, s1 = *(const f32x4*)(sp + 4);
                const f32x4 a0 = acc[ai][0][m][0], a1 = acc[ai][0][m][1], b0 = acc[ai][1][m][0], b1 = acc[ai][1][m][1];
                const f32x4 x0 = a0 * c0 - b0 * s0, x1 = a1 * c1 - b1 * s1, y0 = b0 * c0 + a0 * s0, y1 = b1 * c1 + a1 * s1;
                bf16_t* rowp = O + (size_t)row * 4096 + colbase + i0;
                u32x4 w; w.x = cvt_pk_bf16(x0[0], x0[1]); w.y = cvt_pk_bf16(x0[2], x0[3]); w.z = cvt_pk_bf16(x1[0], x1[1]); w.w = cvt_pk_bf16(x1[2], x1[3]);
                *(u32x4*)rowp = w;
                u32x4 z; z.x = cvt_pk_bf16(y0[0], y0[1]); z.y = cvt_pk_bf16(y0[2], y0[3]); z.z = cvt_pk_bf16(y1[0], y1[1]); z.w = cvt_pk_bf16(y1[2], y1[3]);
                *(u32x4*)(rowp + half) = z; }
    }
};
struct MoeOrder {
    int G, c, ntn, L0, Lend, hsplit; const PG8_LAS int* tend; const PG8_LAS int* cnt;
    __device__ __forceinline__ bool next(int i, Unit& u) const {
        int Lx = L0 + i * G + c; if (Lx >= Lend) return false;
        if (hsplit == 2) { const int x = c & 7, s = c >> 3; Lx = ((x >> 2) * (G >> 3) + s) * ntn + (x & 3); }
        const int L = hsplit == 1 ? Lx >> 1 : Lx;
        const int t = L / ntn; int e = 0;
#pragma unroll 1
        for (int k = 0; k < 32; ++k) e += (t >= tend[k]) ? 1 : 0;
        const int p0 = (t - (e ? tend[e - 1] : 0)) * BM, left = cnt[e] - p0;
        u.pm = t; u.pn = e * ntn + (L - t * ntn); u.inv0 = e * 8192 + p0; u.nvalid = left < BM ? left : BM; u.half = hsplit == 1 ? (Lx & 1) : -1; return true;
    }
    __device__ __forceinline__ void a_ready(const Unit&) const {}
    __device__ __forceinline__ void done(const Unit&) const {}
};
template <class Epi, class Sched, bool ALIGN_EPI = false, bool SP2 = false>
__device__ __forceinline__ void gemm_phase(PG8_LAS unsigned char* lds, const Gemm g, const Sched& S, const Epi& E) {
    const int tid = threadIdx.x, wid = __builtin_amdgcn_readfirstlane(tid >> 6), lane = tid & 63, wr = wid >> 2, wc = wid & 3, fr = lane & 15, fq = lane >> 4;
    const int K = g.K, nt = K / BK;
    unsigned voffA[2], voffB[2];
#pragma unroll
    for (int i = 0; i < 2; ++i) { int R, C; stage_rc(tid * 16 + i * 8192, R, C); const int Rb = Epi::PERM ? ((R & ~31) + perm32(R & 31)) : R;
        voffA[i] = (unsigned)(R * g.lda + C) * 2u; voffB[i] = (unsigned)(Rb * g.ldb + C) * 2u; }
    const size_t kstep = (size_t)(BK * 2);
    const size_t hstepA = (size_t)HALF * g.lda * 2, hstepB = (size_t)HALF * g.ldb * 2;
    const size_t tstepA = 2 * hstepA, tstepB = 2 * hstepB;
    const unsigned ldsw = (unsigned)wid * 1024u;
    const int aoff = lds_byte(wr * 64 + fr, fq * 8), boff = lds_byte(wc * 32 + fr, fq * 8);
#define PG8_SA(b, h) (((b) * 2 + (h)) * HTB)
#define PG8_SB(b, h) ((4 + (b) * 2 + (h)) * HTB)
#define PG8_STAGE(bufoff, gbase, voff) do { _Pragma("unroll") for (int _i = 0; _i < 2; ++_i) \
        __builtin_amdgcn_global_load_lds((const unsigned*)((const char*)(gbase) + (voff)[_i]), (PG8_LAS unsigned*)(lds + (bufoff) + ldsw + _i * 8192), 16, 0, 0); } while (0)
#define PG8_LDA(dst, b, h) do { _Pragma("unroll") for (int m = 0; m < 4; ++m) _Pragma("unroll") for (int k = 0; k < 2; ++k) dst[m][k] = *(const PG8_LAS bf16x8*)(lds + PG8_SA(b, h) + aoff + m * 2048 + k * 1024); } while (0)
#define PG8_LDB(dst, b, h) do { _Pragma("unroll") for (int n = 0; n < 2; ++n) _Pragma("unroll") for (int k = 0; k < 2; ++k) dst[n][k] = *(const PG8_LAS bf16x8*)(lds + PG8_SB(b, h) + boff + n * 2048 + k * 1024); } while (0)
#define PG8_MMA(ai, bj, At, Bt) do { __builtin_amdgcn_s_setprio(1); _Pragma("unroll") for (int m = 0; m < 4; ++m) _Pragma("unroll") for (int n = 0; n < 2; ++n) _Pragma("unroll") for (int k = 0; k < 2; ++k) \
        acc[ai][bj][m][n] = __builtin_amdgcn_mfma_f32_16x16x32_bf16(Bt[n][k], At[m][k], acc[ai][bj][m][n], 0, 0, 0); __builtin_amdgcn_s_setprio(0); } while (0)
#define PG8_WAIT_V(n) asm volatile("s_waitcnt vmcnt(" #n ")" ::: "memory")
#define PG8_WAIT_L(n) asm volatile("s_waitcnt lgkmcnt(" #n ")" ::: "memory")
#define PG8_BAR __builtin_amdgcn_s_barrier()
#define PG8_SCHED __builtin_amdgcn_sched_barrier(0)
    Unit cur, nxt; int ui = 0;
    if (!S.next(0, cur)) return;
    f32x4 acc[2][2][4][2];
#pragma unroll
    for (int a = 0; a < 2; ++a)
#pragma unroll
        for (int b = 0; b < 2; ++b)
#pragma unroll
            for (int m = 0; m < 4; ++m)
#pragma unroll
                for (int n = 0; n < 2; ++n) acc[a][b][m][n] = (f32x4){0.f, 0.f, 0.f, 0.f};
    bf16x8 At[4][2], B0[2][2], B1[2][2];
    const char* cA = (const char*)g.A + (size_t)cur.pm * tstepA; const char* cB = (const char*)g.Bt + (size_t)cur.pn * tstepB;
    S.a_ready(cur);
    if constexpr (SP2) {
        PG8_STAGE(PG8_SB(0, 0), cB, voffB); PG8_STAGE(PG8_SB(0, 1), cB + hstepB, voffB); PG8_STAGE(PG8_SA(0, 0), cA, voffA); PG8_STAGE(PG8_SA(0, 1), cA + hstepA, voffA);
        if (wr == 1) PG8_BAR;
        PG8_WAIT_V(2); PG8_BAR;
        PG8_STAGE(PG8_SB(1, 0), cB + kstep, voffB); PG8_STAGE(PG8_SA(1, 0), cA + kstep, voffA); PG8_STAGE(PG8_SB(1, 1), cB + hstepB + kstep, voffB);
        PG8_WAIT_V(6); PG8_BAR;
    } else {
        PG8_STAGE(PG8_SB(0, 0), cB, voffB); PG8_STAGE(PG8_SA(0, 0), cA, voffA); PG8_STAGE(PG8_SB(0, 1), cB + hstepB, voffB); PG8_STAGE(PG8_SA(0, 1), cA + hstepA, voffA);
        if (wr == 1) PG8_BAR;
        PG8_WAIT_V(4); PG8_BAR;
        PG8_STAGE(PG8_SB(1, 0), cB + kstep, voffB); PG8_STAGE(PG8_SA(1, 0), cA + kstep, voffA); PG8_STAGE(PG8_SB(1, 1), cB + hstepB + kstep, voffB);
        PG8_WAIT_V(6); PG8_BAR;
    }
    for (;;) {
        const bool has_next = S.next(ui + 1, nxt);
        const char* nA = has_next ? (const char*)g.A + (size_t)nxt.pm * tstepA : cA; const char* nB = has_next ? (const char*)g.Bt + (size_t)nxt.pn * tstepB : cB;
        for (int t = 0; t < nt; t += 2) {
            const bool last = (t == nt - 2);
            const char* a1 = cA + (size_t)(t + 1) * kstep;
            const char* a2 = last ? nA : cA + (size_t)(t + 2) * kstep; const char* b2 = last ? nB : cB + (size_t)(t + 2) * kstep;
            const char* a3 = a2 + kstep; const char* b3 = b2 + kstep;
            if (last && has_next) S.a_ready(nxt);
            if constexpr (SP2) {
            PG8_LDB(B0, 0, 0); PG8_LDB(B1, 0, 1); PG8_SCHED; PG8_LDA(At, 0, 0); PG8_STAGE(PG8_SA(1, 1), a1 + hstepA, voffA);
            PG8_WAIT_V(8); PG8_WAIT_L(0); PG8_BAR; PG8_MMA(0, 0, At, B0); PG8_MMA(0, 1, At, B1); PG8_BAR; PG8_SCHED;
            PG8_LDA(At, 0, 1); PG8_STAGE(PG8_SB(0, 0), b2, voffB); PG8_STAGE(PG8_SB(0, 1), b2 + hstepB, voffB); PG8_STAGE(PG8_SA(0, 0), a2, voffA);
            PG8_WAIT_V(8); PG8_WAIT_L(0); PG8_BAR; PG8_MMA(1, 0, At, B0); PG8_MMA(1, 1, At, B1); PG8_BAR; PG8_SCHED;
            PG8_LDB(B0, 1, 0); PG8_LDB(B1, 1, 1); PG8_SCHED; PG8_LDA(At, 1, 0); PG8_STAGE(PG8_SA(0, 1), a2 + hstepA, voffA);
            PG8_WAIT_V(8); PG8_WAIT_L(0); PG8_BAR; PG8_MMA(0, 0, At, B0); PG8_MMA(0, 1, At, B1); PG8_BAR; PG8_SCHED;
            PG8_LDA(At, 1, 1); PG8_STAGE(PG8_SB(1, 0), b3, voffB); PG8_STAGE(PG8_SB(1, 1), b3 + hstepB, voffB); PG8_STAGE(PG8_SA(1, 0), a3, voffA);
            PG8_WAIT_V(8); PG8_WAIT_L(0); PG8_BAR; PG8_MMA(1, 0, At, B0); PG8_MMA(1, 1, At, B1); PG8_BAR; PG8_SCHED;
            } else {
            PG8_LDB(B0, 0, 0); PG8_SCHED; PG8_LDA(At, 0, 0); PG8_STAGE(PG8_SA(1, 1), a1 + hstepA, voffA);
            PG8_WAIT_L(8); PG8_BAR; PG8_WAIT_L(0); PG8_MMA(0, 0, At, B0); PG8_BAR; PG8_SCHED;
            PG8_LDB(B1, 0, 1); PG8_STAGE(PG8_SB(0, 0), b2, voffB);
            PG8_BAR; PG8_WAIT_L(0); PG8_MMA(0, 1, At, B1); PG8_BAR;
            PG8_LDA(At, 0, 1); PG8_STAGE(PG8_SA(0, 0), a2, voffA);
            PG8_BAR; PG8_WAIT_L(0); PG8_MMA(1, 0, At, B0); PG8_BAR; PG8_SCHED;
            PG8_STAGE(PG8_SB(0, 1), b2 + hstepB, voffB);
            PG8_WAIT_V(6); PG8_BAR; PG8_MMA(1, 1, At, B1); PG8_BAR;
            PG8_LDB(B0, 1, 0); PG8_SCHED; PG8_LDA(At, 1, 0); PG8_STAGE(PG8_SA(0, 1), a2 + hstepA, voffA);
            PG8_WAIT_L(8); PG8_BAR; PG8_WAIT_L(0); PG8_MMA(0, 0, At, B0); PG8_BAR; PG8_SCHED;
            PG8_LDB(B1, 1, 1); PG8_STAGE(PG8_SB(1, 0), b3, voffB);
            PG8_BAR; PG8_WAIT_L(0); PG8_MMA(0, 1, At, B1); PG8_BAR;
            PG8_LDA(At, 1, 1); PG8_STAGE(PG8_SA(1, 0), a3, voffA);
            PG8_BAR; PG8_WAIT_L(0); PG8_MMA(1, 0, At, B0); PG8_BAR; PG8_SCHED;
            PG8_STAGE(PG8_SB(1, 1), b3 + hstepB, voffB);
            PG8_WAIT_V(6); PG8_BAR; PG8_MMA(1, 1, At, B1); PG8_BAR;
            }
        }
        if constexpr (ALIGN_EPI) { if (wr == 0) PG8_BAR; }
        if constexpr (!Epi::AFTER_DRAIN) { E(acc, cur, wr, wc, fr, fq); S.done(cur); }
        if (!has_next) break;
#pragma unroll
        for (int a = 0; a < 2; ++a)
#pragma unroll
            for (int b = 0; b < 2; ++b)
#pragma unroll
                for (int m = 0; m < 4; ++m)
#pragma unroll
                    for (int n = 0; n < 2; ++n) acc[a][b][m][n] = (f32x4){0.f, 0.f, 0.f, 0.f};
        cur = nxt; cA = nA; cB = nB; ++ui;
        if constexpr (ALIGN_EPI) { if (wr == 1) PG8_BAR; }
    }
    PG8_WAIT_V(0);
    if constexpr (!ALIGN_EPI) { if (wr == 0) PG8_BAR; }
    PG8_BAR;
    if constexpr (Epi::AFTER_DRAIN) { E.fused(acc, cur, wr, wc, fr, fq, lds, wid, lane); S.done(cur); }
#undef PG8_SA
#undef PG8_SB
#undef PG8_STAGE
#undef PG8_LDA
#undef PG8_LDB
#undef PG8_MMA
#undef PG8_WAIT_V
#undef PG8_WAIT_L
#undef PG8_BAR
#undef PG8_SCHED
}
template <class Epi, class Sched>
__device__ __forceinline__ void gemm_phase_g(PG8_LAS unsigned char* lds, const Gemm g, const Sched& S, const Epi& E, const int* inv) {
    constexpr bool ALIGN_EPI = true;
    const int tid = threadIdx.x, wid = __builtin_amdgcn_readfirstlane(tid >> 6), lane = tid & 63, wr = wid >> 2, wc = wid & 3, fr = lane & 15, fq = lane >> 4;
    const int K = g.K, nt = K / BK;
    unsigned voffA[2], voffB[2];
#pragma unroll
    for (int i = 0; i < 2; ++i) { int R, C; stage_rc(tid * 16 + i * 8192, R, C); const int Rb = Epi::PERM ? ((R & ~31) + perm32(R & 31)) : R;
        voffA[i] = (unsigned)(R * g.lda + C) * 2u; voffB[i] = (unsigned)(Rb * g.ldb + C) * 2u; }
    const size_t kstep = (size_t)(BK * 2);
    const size_t hstepA = (size_t)HALF * g.lda * 2, hstepB = (size_t)HALF * g.ldb * 2;
    const size_t tstepA = 2 * hstepA, tstepB = 2 * hstepB;
    const unsigned ldsw = (unsigned)wid * 1024u;
    const int aoff = lds_byte(wr * 64 + fr, fq * 8), boff = lds_byte(wc * 32 + fr, fq * 8);
#define PG8_SA(b, h) (((b) * 2 + (h)) * HTB)
#define PG8_SB(b, h) ((4 + (b) * 2 + (h)) * HTB)
#define PG8_STAGE(bufoff, gbase, voff) do { _Pragma("unroll") for (int _i = 0; _i < 2; ++_i) \
        __builtin_amdgcn_global_load_lds((const unsigned*)((const char*)(gbase) + (voff)[_i]), (PG8_LAS unsigned*)(lds + (bufoff) + ldsw + _i * 8192), 16, 0, 0); } while (0)
#define PG8_LDA(dst, b, h) do { _Pragma("unroll") for (int m = 0; m < 4; ++m) _Pragma("unroll") for (int k = 0; k < 2; ++k) dst[m][k] = *(const PG8_LAS bf16x8*)(lds + PG8_SA(b, h) + aoff + m * 2048 + k * 1024); } while (0)
#define PG8_LDB(dst, b, h) do { _Pragma("unroll") for (int n = 0; n < 2; ++n) _Pragma("unroll") for (int k = 0; k < 2; ++k) dst[n][k] = *(const PG8_LAS bf16x8*)(lds + PG8_SB(b, h) + boff + n * 2048 + k * 1024); } while (0)
#define PG8_MMA(ai, bj, At, Bt) do { __builtin_amdgcn_s_setprio(1); _Pragma("unroll") for (int m = 0; m < 4; ++m) _Pragma("unroll") for (int n = 0; n < 2; ++n) _Pragma("unroll") for (int k = 0; k < 2; ++k) \
        acc[ai][bj][m][n] = __builtin_amdgcn_mfma_f32_16x16x32_bf16(Bt[n][k], At[m][k], acc[ai][bj][m][n], 0, 0, 0); __builtin_amdgcn_s_setprio(0); } while (0)
#define PG8_WAIT_V(n) asm volatile("s_waitcnt vmcnt(" #n ")" ::: "memory")
#define PG8_WAIT_L(n) asm volatile("s_waitcnt lgkmcnt(" #n ")" ::: "memory")
#define PG8_BAR __builtin_amdgcn_s_barrier()
#define PG8_SCHED __builtin_amdgcn_sched_barrier(0)
    Unit cur, nxt; int ui = 0;
    if (!S.next(0, cur)) return;
    f32x4 acc[2][2][4][2];
#pragma unroll
    for (int a = 0; a < 2; ++a)
#pragma unroll
        for (int b = 0; b < 2; ++b)
#pragma unroll
            for (int m = 0; m < 4; ++m)
#pragma unroll
                for (int n = 0; n < 2; ++n) acc[a][b][m][n] = (f32x4){0.f, 0.f, 0.f, 0.f};
    bf16x8 At[4][2], B0[2][2], B1[2][2];
    const char* cA = (const char*)g.A; const char* cB = (const char*)g.Bt + (size_t)cur.pn * tstepB;
    S.a_ready(cur);
    unsigned vc[2][2], vn[2][2];
#define PG8_ROWS(u_, vo_) do { _Pragma("unroll") for (int h_ = 0; h_ < 2; ++h_) _Pragma("unroll") for (int i_ = 0; i_ < 2; ++i_) { int R_, C_; stage_rc(tid * 16 + i_ * 8192, R_, C_); const int r_ = h_ * HALF + R_; \
        const int tok_ = r_ < (u_).nvalid ? inv[(u_).inv0 + r_] : 0; vo_[h_][i_] = (unsigned)(tok_ * g.lda + C_) * 2u; } } while (0)
    PG8_ROWS(cur, vc);
    {
        PG8_STAGE(PG8_SB(0, 0), cB, voffB); PG8_STAGE(PG8_SB(0, 1), cB + hstepB, voffB); PG8_STAGE(PG8_SA(0, 0), cA, vc[0]); PG8_STAGE(PG8_SA(0, 1), cA, vc[1]);
        if (wr == 1) PG8_BAR;
        PG8_WAIT_V(2); PG8_BAR;
        PG8_STAGE(PG8_SB(1, 0), cB + kstep, voffB); PG8_STAGE(PG8_SA(1, 0), cA + kstep, vc[0]); PG8_STAGE(PG8_SB(1, 1), cB + hstepB + kstep, voffB);
        PG8_WAIT_V(6); PG8_BAR;
    }
    for (;;) {
        const bool has_next = S.next(ui + 1, nxt);
        if (has_next) { PG8_ROWS(nxt, vn); } else {
#pragma unroll
            for (int h_ = 0; h_ < 2; ++h_) { vn[h_][0] = vc[h_][0]; vn[h_][1] = vc[h_][1]; } }
        const char* nA = cA; const char* nB = has_next ? (const char*)g.Bt + (size_t)nxt.pn * tstepB : cB;
        const bool do0 = cur.half != 1, do1 = cur.half != 0;
        for (int t = 0; t < nt; t += 2) {
            const bool last = (t == nt - 2);
            unsigned v2[2][2];
#pragma unroll
            for (int h_ = 0; h_ < 2; ++h_) { v2[h_][0] = last ? vn[h_][0] : vc[h_][0]; v2[h_][1] = last ? vn[h_][1] : vc[h_][1]; }
            const char* a1 = cA + (size_t)(t + 1) * kstep;
            const char* a2 = last ? nA : cA + (size_t)(t + 2) * kstep; const char* b2 = last ? nB : cB + (size_t)(t + 2) * kstep;
            const char* a3 = a2 + kstep; const char* b3 = b2 + kstep;
            if (last && has_next) S.a_ready(nxt);
            {
            PG8_LDB(B0, 0, 0); PG8_LDB(B1, 0, 1); PG8_SCHED; if (do0) { PG8_LDA(At, 0, 0); } PG8_STAGE(PG8_SA(1, 1), a1, vc[1]);
            PG8_WAIT_V(8); PG8_WAIT_L(0); PG8_BAR; if (do0) { PG8_MMA(0, 0, At, B0); PG8_MMA(0, 1, At, B1); } PG8_BAR; PG8_SCHED;
            if (do1) { PG8_LDA(At, 0, 1); } PG8_STAGE(PG8_SB(0, 0), b2, voffB); PG8_STAGE(PG8_SB(0, 1), b2 + hstepB, voffB); PG8_STAGE(PG8_SA(0, 0), a2, v2[0]);
            PG8_WAIT_V(8); PG8_WAIT_L(0); PG8_BAR; if (do1) { PG8_MMA(1, 0, At, B0); PG8_MMA(1, 1, At, B1); } PG8_BAR; PG8_SCHED;
            PG8_LDB(B0, 1, 0); PG8_LDB(B1, 1, 1); PG8_SCHED; if (do0) { PG8_LDA(At, 1, 0); } PG8_STAGE(PG8_SA(0, 1), a2, v2[1]);
            PG8_WAIT_V(8); PG8_WAIT_L(0); PG8_BAR; if (do0) { PG8_MMA(0, 0, At, B0); PG8_MMA(0, 1, At, B1); } PG8_BAR; PG8_SCHED;
            if (do1) { PG8_LDA(At, 1, 1); } PG8_STAGE(PG8_SB(1, 0), b3, voffB); PG8_STAGE(PG8_SB(1, 1), b3 + hstepB, voffB); PG8_STAGE(PG8_SA(1, 0), a3, v2[0]);
            PG8_WAIT_V(8); PG8_WAIT_L(0); PG8_BAR; if (do1) { PG8_MMA(1, 0, At, B0); PG8_MMA(1, 1, At, B1); } PG8_BAR; PG8_SCHED;
            }
        }
        if constexpr (ALIGN_EPI) { if (wr == 0) PG8_BAR; }
        if constexpr (!Epi::AFTER_DRAIN) { E(acc, cur, wr, wc, fr, fq); S.done(cur); }
        if (!has_next) break;
#pragma unroll
        for (int a = 0; a < 2; ++a)
#pragma unroll
            for (int b = 0; b < 2; ++b)
#pragma unroll
                for (int m = 0; m < 4; ++m)
#pragma unroll
                    for (int n = 0; n < 2; ++n) acc[a][b][m][n] = (f32x4){0.f, 0.f, 0.f, 0.f};
        cur = nxt; cA = nA; cB = nB; ++ui;
#pragma unroll
        for (int h_ = 0; h_ < 2; ++h_) { vc[h_][0] = vn[h_][0]; vc[h_][1] = vn[h_][1]; }
        if constexpr (ALIGN_EPI) { if (wr == 1) PG8_BAR; }
    }
    PG8_WAIT_V(0);
    if constexpr (!ALIGN_EPI) { if (wr == 0) PG8_BAR; }
    PG8_BAR;
    if constexpr (Epi::AFTER_DRAIN) { E.fused(acc, cur, wr, wc, fr, fq, lds, wid, lane); S.done(cur); }
#undef PG8_ROWS
#undef PG8_SA
#undef PG8_SB
#undef PG8_STAGE
#undef PG8_LDA
#undef PG8_LDB
#undef PG8_MMA
#undef PG8_WAIT_V
#undef PG8_WAIT_L
#undef PG8_BAR
#undef PG8_SCHED
}
}
constexpr int BATCH = 2, SEQ = 4096, DM = 2048, MTOK = BATCH * SEQ;
constexpr int NE0 = 6168, NE1 = 4176;
constexpr int NP0 = 6144, NP1 = 4096;
constexpr float LN_EPS = 1e-5f;
constexpr float DN_ALPHA = 1.41421356237309515f;
constexpr float ATT_SCALE = 0.08838834764831845f;
constexpr int RPAD = 24576;
constexpr size_t MiB = 1u << 20;
constexpr size_t WS_CTL = 0, CTL_ZERO_BYTES = 1 * MiB;
constexpr size_t WS_ROPE = 1 * MiB;
constexpr size_t WS_WSM = 4 * MiB;
constexpr size_t WS_SK0 = 6 * MiB;
constexpr size_t WS_IK = 7 * MiB;
constexpr size_t WS_IW = 8 * MiB + 512 * 1024;
constexpr size_t WS_FBIAS = 10 * MiB;
constexpr size_t WS_ROUTE = 11 * MiB;
constexpr size_t WS_MASK = 12 * MiB;
constexpr size_t WS_WINA = 16 * MiB, WS_WOA = 40 * MiB, WS_WINC = 48 * MiB, WS_WOC = 64 * MiB;
constexpr size_t WS_WGU = 72 * MiB;
constexpr size_t WS_WD = 328 * MiB;
constexpr size_t WS_XB = 456 * MiB;
constexpr size_t WS_YB = 488 * MiB;
constexpr size_t WS_PROJ = 552 * MiB;
constexpr size_t WS_CST = 648 * MiB;
constexpr size_t WS_PREVT = 712 * MiB;
constexpr size_t WS_OMIX = 744 * MiB;
constexpr size_t WS_GB = 776 * MiB;
constexpr size_t WS_DEC = 792 * MiB;
constexpr size_t WS_ROWW = 793 * MiB;
constexpr size_t WS_SC = 800 * MiB;
constexpr size_t WS_INV = 800 * MiB;
constexpr size_t WS_WINV = 801 * MiB;
constexpr size_t WS_END = 928 * MiB;
constexpr int CW_CNT = 1024;
constexpr int CW_FILL = 2048;
constexpr int CW_BAR = 4096;

#define GAS __attribute__((address_space(1)))
#define LAS __attribute__((address_space(3)))
typedef unsigned short bf16;
typedef unsigned v4u __attribute__((ext_vector_type(4)));
typedef unsigned v2u __attribute__((ext_vector_type(2)));
typedef float f32x4 __attribute__((ext_vector_type(4)));
typedef short bf16x8 __attribute__((ext_vector_type(8)));
#define LDS_WAIT() asm volatile("s_waitcnt lgkmcnt(0)" ::: "memory")
#define VM_WAIT() asm volatile("s_waitcnt vmcnt(0)" ::: "memory")
__device__ __forceinline__ unsigned f2bf(float f) { unsigned u = __builtin_bit_cast(unsigned, f); return (u + 0x7fffu + ((u >> 16) & 1u)) >> 16; }
__device__ __forceinline__ unsigned pk2(float lo, float hi) { return f2bf(lo) | (f2bf(hi) << 16); }
__device__ __forceinline__ float bf2f(unsigned short b) { return __builtin_bit_cast(float, ((unsigned)b) << 16); }
__device__ __forceinline__ float wave_sum(float v) {
#pragma unroll
    for (int o = 1; o < 64; o <<= 1) v += __shfl_xor(v, o);
    return v;
}
__device__ __forceinline__ float logsigmoidf(float z) { return fminf(z, 0.f) - log1pf(__expf(-fabsf(z))); }
#define XB_TMO      128
#define XB_XCNT(j)  (256  + 64 * (j))
#define XB_XSUB(j)  (1280 + 64 * (j))
#define XB_XGEN(j)  (2304 + 64 * (j))
#define XB_TOP      3328
#define XB_TOPGEN   3392
#define XCD_BAR_WORDS 3456
#define XB_SPIN_CAP (1u << 21)

__device__ __forceinline__ unsigned xb_ld(unsigned* p)              { return __hip_atomic_load(p, __ATOMIC_RELAXED, __HIP_MEMORY_SCOPE_AGENT); }
__device__ __forceinline__ unsigned xb_add(unsigned* p, unsigned v) { return __hip_atomic_fetch_add(p, v, __ATOMIC_RELAXED, __HIP_MEMORY_SCOPE_AGENT); }
__device__ __forceinline__ unsigned xb_xcc_id() { return (unsigned)__builtin_amdgcn_s_getreg((3 << 11) | 20) & 0xFu; }
#define XB_SPIN(cond, bar) do { unsigned _sp = 0; while (cond) { __builtin_amdgcn_s_sleep(1); \
    if ((++_sp & 255u) == 0u) { if (xb_ld(&(bar)[XB_TMO])) break; if (_sp > XB_SPIN_CAP) { atomicAdd(&(bar)[XB_TMO], 1u); break; } } } } while (0)

struct XcdBarrier {
    unsigned* bar; unsigned x;
    volatile LAS unsigned* st;
};

__device__ __forceinline__ XcdBarrier xcd_barrier_post(unsigned* bar, volatile LAS unsigned* st) {
    XcdBarrier b; b.bar = bar; b.x = xb_xcc_id(); b.st = st;
    if (threadIdx.x == 0) (void)xb_add(&bar[XB_XCNT(b.x)], 1u);
    return b;
}
__device__ __forceinline__ void xcd_barrier_complete(unsigned* bar, unsigned x, unsigned& nloc, unsigned& nx) {
    const unsigned G = gridDim.x * gridDim.y * gridDim.z;
    unsigned sum, cnt, mine, sp = 0u;
    for (;;) {
        sum = 0u; cnt = 0u; mine = 0u;
#pragma unroll
        for (unsigned j = 0; j < 16; ++j) { const unsigned c = xb_ld(&bar[XB_XCNT(j)]); sum += c; cnt += (c > 0u) ? 1u : 0u; mine = (j == x) ? c : mine; }
        if (sum == G) break;
        __builtin_amdgcn_s_sleep(1);
        if ((++sp & 255u) == 0u) { if (xb_ld(&bar[XB_TMO])) break; if (sp > XB_SPIN_CAP) { atomicAdd(&bar[XB_TMO], 1u); break; } }
    }
    nloc = mine > 0u ? mine : 1u; nx = cnt > 0u ? cnt : 1u;
}

__device__ __forceinline__ void xcd_barrier(const XcdBarrier& b) {
    asm volatile("s_waitcnt vmcnt(0)" ::: "memory");
    __syncthreads();
    if (threadIdx.x == 0) {
        unsigned* bar = b.bar;
        __builtin_amdgcn_s_waitcnt(0);
        unsigned nloc = b.st[0], nx = b.st[1];
        if (nloc == 0u) { xcd_barrier_complete(bar, b.x, nloc, nx); b.st[0] = nloc; b.st[1] = nx; }
        const unsigned old = xb_add(&bar[XB_XSUB(b.x)], 1u);
        const unsigned gen = old / nloc;
        if (old + 1u == (gen + 1u) * nloc) {
            __builtin_amdgcn_fence(__ATOMIC_RELEASE, "agent");
            asm volatile("s_waitcnt vmcnt(0)" ::: "memory");
            const unsigned og = xb_add(&bar[XB_TOP], 1u);
            const unsigned tg = og / nx;
            if (og + 1u == (tg + 1u) * nx) xb_add(&bar[XB_TOPGEN], 1u);
            else XB_SPIN(xb_ld(&bar[XB_TOPGEN]) == tg, bar);
            __builtin_amdgcn_fence(__ATOMIC_ACQUIRE, "agent");
            xb_add(&bar[XB_XGEN(b.x)], 1u);
            asm volatile("s_waitcnt vmcnt(0)" ::: "memory");
        } else {
            XB_SPIN(xb_ld(&bar[XB_XGEN(b.x)]) == gen, bar);
            __builtin_amdgcn_fence(__ATOMIC_ACQUIRE, "agent");
            asm volatile("s_waitcnt vmcnt(0)" ::: "memory");
        }
    }
    __syncthreads();
}

constexpr int NWAVES = 8;
constexpr int RING_BYTES = 131072;
constexpr int LDSCTL_OFF = RING_BYTES;
constexpr int LDS_BYTES = 147456;
struct Frame {
    LAS unsigned char* lds; volatile LAS unsigned* MISC; unsigned* ctl;
    int tid, lane, wave, G, gw, NGW;
    unsigned char* ws;
};
struct Args { const float* in[20]; float* out; unsigned char* ws; int ph_lo, ph_hi, bar_region, pad; };

struct TrItem { const float* W; bf16* WT; int ldw, c0, c1, K, n0, k0; };
__device__ __forceinline__ void tr64_load(const TrItem& t, f32x4 (&r)[16], int lane) {
    const int nq = lane & 15, kr = lane >> 4;
    const float* src = t.W + (size_t)(t.k0 + 2 * kr) * t.ldw + (nq < 8 ? t.c0 : t.c1 - 32) + 4 * nq;
#pragma unroll
    for (int i = 0; i < 8; ++i) { r[2 * i] = __builtin_nontemporal_load((const f32x4*)(src + (size_t)(8 * i) * t.ldw)); r[2 * i + 1] = __builtin_nontemporal_load((const f32x4*)(src + (size_t)(8 * i + 1) * t.ldw)); }
}
__device__ __forceinline__ void tr64_store(const TrItem& t, const f32x4 (&r)[16], LAS bf16* T, int lane) {
    const int nq = lane & 15, kr = lane >> 4;
#pragma unroll
    for (int i = 0; i < 8; ++i) { const int kk = 8 * i + 2 * kr;
#pragma unroll
        for (int e = 0; e < 4; ++e) *(LAS unsigned*)(T + (4 * nq + e) * 68 + kk) = pg8::cvt_pk_bf16(r[2 * i][e], r[2 * i + 1][e]); }
    LDS_WAIT(); asm volatile("" ::: "memory");
    const int c = lane & 7;
#pragma unroll
    for (int j = 0; j < 8; ++j) { const int n = (lane >> 3) + 8 * j; const v2u lo = *(const LAS v2u*)(T + n * 68 + 8 * c), hi = *(const LAS v2u*)(T + n * 68 + 8 * c + 4);
        v4u o; o.x = lo.x; o.y = lo.y; o.z = hi.x; o.w = hi.y;
        *(v4u*)(t.WT + (size_t)(t.n0 + n) * t.K + t.k0 + 8 * c) = o; }
    LDS_WAIT(); asm volatile("" ::: "memory");
}
__device__ __forceinline__ void transpose_item64(const float* W, int ldw, int c0, int c1, int K, bf16* WT, int n0, int k0, LAS bf16* T, int lane) {
    const TrItem t{W, WT, ldw, c0, c1, K, n0, k0}; f32x4 r[16]; tr64_load(t, r, lane); tr64_store(t, r, T, lane);
}
__device__ __forceinline__ int l1_src_col(int n) {
    const int pn = n >> 8, j = n & 255, jh = j & 127, second = j >> 7;
    if (pn == 10 || pn == 11) return n;
    if (pn < 10) return pn * 256 + (jh >> 6) * 128 + second * 64 + (jh & 63);
    return 3072 + ((pn - 12) * 4 + (jh >> 5)) * 64 + second * 32 + (jh & 31);
}
constexpr int SK_ROUTE0 = 0, SK_ROUTE1 = 48, SK_SK0 = 96, SK_SK1 = 128, SK_NCOL = 208;
constexpr int SK_PART_OFF = 0, SK_LG_OFF = 65536;
template <int NT> __device__ __forceinline__ void skinny_partials(LAS unsigned char* ldsb, const bf16* X, const bf16* WH, const bf16* WL, int w, int lane) {
    const int tile = w >> 2, kq = w & 3, l15 = lane & 15, quad = lane >> 4;
    const bf16* xp = X + (size_t)(16 * tile + l15) * DM + kq * 512 + quad * 8;
    const bf16* hp = WH + (size_t)l15 * 2048 + kq * 512 + quad * 8; const bf16* lp = WL + (size_t)l15 * 2048 + kq * 512 + quad * 8;
    pg8::f32x4 acc[NT];
#pragma unroll
    for (int n = 0; n < NT; ++n) acc[n] = (pg8::f32x4){0.f, 0.f, 0.f, 0.f};
#pragma unroll 2
    for (int ks = 0; ks < 16; ++ks) {
        const bf16x8 ah = *(const bf16x8*)(xp + 32 * ks);
#pragma unroll
        for (int n = 0; n < NT; ++n) { const bf16x8 bh = *(const bf16x8*)(hp + (size_t)n * 16 * 2048 + 32 * ks), bl = *(const bf16x8*)(lp + (size_t)n * 16 * 2048 + 32 * ks);
            acc[n] = __builtin_amdgcn_mfma_f32_16x16x32_bf16(ah, bh, acc[n], 0, 0, 0); acc[n] = __builtin_amdgcn_mfma_f32_16x16x32_bf16(ah, bl, acc[n], 0, 0, 0); }
    }
    LAS float* PART = (LAS float*)(ldsb + SK_PART_OFF);
#pragma unroll
    for (int n = 0; n < NT; ++n) *(LAS pg8::f32x4*)(PART + ((((tile * 4 + kq) * NT + n) * 64 + lane) * 4)) = acc[n];
}
template <int NT> __device__ __forceinline__ void skinny_reduce(LAS unsigned char* ldsb, int tid) {
    const LAS float* PART = (const LAS float*)(ldsb + SK_PART_OFF); LAS float* LG = (LAS float*)(ldsb + SK_LG_OFF);
    for (int idx = tid; idx < 32 * 16 * NT; idx += NWAVES * 64) { const int row = idx / (16 * NT), col = idx % (16 * NT), tile = row >> 4, rr = row & 15, ln = (rr >> 2) * 16 + (col & 15), n = col >> 4, j = rr & 3;
        float s = 0.f;
#pragma unroll
        for (int kq = 0; kq < 4; ++kq) s += PART[(((tile * 4 + kq) * NT + n) * 64 + ln) * 4 + j];
        LG[row * (16 * NT) + col] = s; }
}
__device__ __forceinline__ void ln_row(f32x4 (&v)[8], const float* g, const float* b, int lane) {
    float s = 0.f;
#pragma unroll
    for (int j = 0; j < 8; ++j) s += (v[j][0] + v[j][1]) + (v[j][2] + v[j][3]);
    const float mean = wave_sum(s) * (1.f / DM); float s2 = 0.f;
#pragma unroll
    for (int j = 0; j < 8; ++j) { v[j] = v[j] - mean; s2 += (v[j][0] * v[j][0] + v[j][1] * v[j][1]) + (v[j][2] * v[j][2] + v[j][3] * v[j][3]); }
    const float rstd = 1.f / sqrtf(wave_sum(s2) * (1.f / DM) + LN_EPS);
#pragma unroll
    for (int j = 0; j < 8; ++j) { const f32x4 gg = *(const f32x4*)(g + 256 * j + 4 * lane), bb = *(const f32x4*)(b + 256 * j + 4 * lane); v[j] = v[j] * rstd * gg + bb; }
}
__device__ __forceinline__ void load_row_bf16(const bf16* src, f32x4 (&v)[8], int lane) {
#pragma unroll
    for (int j = 0; j < 8; ++j) { const uint2 p = *(const uint2*)(src + 256 * j + 4 * lane); v[j][0] = bf2f(p.x & 0xffff); v[j][1] = bf2f(p.x >> 16); v[j][2] = bf2f(p.y & 0xffff); v[j][3] = bf2f(p.y >> 16); }
}
__device__ __forceinline__ void store_row_bf16(bf16* dst, const f32x4 (&v)[8], int lane) {
#pragma unroll
    for (int j = 0; j < 8; ++j) { uint2 o; o.x = pg8::cvt_pk_bf16(v[j][0], v[j][1]); o.y = pg8::cvt_pk_bf16(v[j][2], v[j][3]); *(uint2*)(dst + 256 * j + 4 * lane) = o; }
}
#define TK_FOR_VALID(...) _Pragma("unroll") for (int g_ = 0; g_ < 8; ++g_) { if (512 * g_ <= qpos) { _Pragma("unroll") for (int i = 8 * g_; i < 8 * g_ + 8; ++i) { __VA_ARGS__ } } }
__device__ __forceinline__ void topk_mask_row(const LAS float* sc, int qpos, unsigned long long* mrow, int lane, LAS unsigned* cbuf) {
    unsigned u[64];
#pragma unroll
    for (int i = 0; i < 64; ++i) { const int s = 64 * i + lane; const bool ok = s <= qpos; const float f = ok ? sc[s] : 0.f; const unsigned b = __builtin_bit_cast(unsigned, f);
        const unsigned key = b ^ ((b >> 31) ? 0xFFFFFFFFu : 0x80000000u); u[i] = ok ? key : 0u; }
    unsigned long long mword = 0ull;
    if (qpos + 1 <= 256) {
#pragma unroll
        for (int i = 0; i < 4; ++i) { const unsigned long long w = __ballot(64 * i + lane <= qpos); mword = (lane == i) ? w : mword; }
        mrow[lane] = mword; return;
    }
    const unsigned long long below = (1ull << lane) - 1ull;
    unsigned T = 0u;
#pragma unroll 1
    for (int bit = 31; bit >= 20; --bit) { const unsigned cand = T | (1u << bit); int cnt = 0;
        TK_FOR_VALID( cnt += __builtin_popcountll(__ballot(u[i] >= cand)); )
        if (cnt >= 256) T = cand; }
    const unsigned pre = T >> 20; int cgt = 0, nc = 0;
    TK_FOR_VALID( { const unsigned p_ = u[i] >> 20; const unsigned long long gm = __ballot(p_ > pre), em = __ballot(p_ == pre); cgt += __builtin_popcountll(gm);
        const int pos_ = nc + __builtin_popcountll(em & below); if (p_ == pre && pos_ < 256) cbuf[pos_] = u[i]; nc += __builtin_popcountll(em); } )
    int kneed = 256 - cgt;
    if (nc <= 256) {
        asm volatile("s_waitcnt lgkmcnt(0)" ::: "memory");
        unsigned c0 = lane < nc ? cbuf[lane] : 0u, c1 = 64 + lane < nc ? cbuf[64 + lane] : 0u, c2 = 128 + lane < nc ? cbuf[128 + lane] : 0u, c3 = 192 + lane < nc ? cbuf[192 + lane] : 0u;
#pragma unroll 1
        for (int bit = 19; bit >= 0; --bit) { const unsigned cand = T | (1u << bit);
            int cnt = __builtin_popcountll(__ballot(c0 >= cand));
            if (nc > 64) cnt += __builtin_popcountll(__ballot(c1 >= cand));
            if (nc > 128) cnt += __builtin_popcountll(__ballot(c2 >= cand)) + __builtin_popcountll(__ballot(c3 >= cand));
            if (cnt >= kneed) T = cand; }
        const int cg2 = __builtin_popcountll(__ballot(c0 > T)) + __builtin_popcountll(__ballot(c1 > T)) + __builtin_popcountll(__ballot(c2 > T)) + __builtin_popcountll(__ballot(c3 > T));
        kneed -= cg2;
    } else {
#pragma unroll 1
        for (int bit = 19; bit >= 0; --bit) { const unsigned cand = T | (1u << bit); int cnt = 0;
            TK_FOR_VALID( cnt += __builtin_popcountll(__ballot(u[i] >= cand)); )
            if (cnt >= 256) T = cand; }
        int cg2 = 0;
        TK_FOR_VALID( cg2 += __builtin_popcountll(__ballot(u[i] > T)); )
        kneed = 256 - cg2;
    }
    int run = 0;
#pragma unroll
    for (int i = 0; i < 64; ++i) { const bool gt = u[i] > T, eq = u[i] == T; const unsigned long long eqm = __ballot(eq);
        const int rank = run + __builtin_popcountll(eqm & below); const bool sel = gt || (eq && rank < kneed); run += __builtin_popcountll(eqm);
        const unsigned long long w = __ballot(sel); mword = (lane == i) ? w : mword; }
    mrow[lane] = mword;
}
#undef TK_FOR_VALID
constexpr int CONV_MOE_ITEMS = 32 * (32 * 16) + 32 * (8 * 32);
#ifndef CONV_STATIC_ITEMS
#define CONV_STATIC_ITEMS 0
#endif
constexpr int CONV_STATIC = CONV_STATIC_ITEMS;
constexpr int CONV_LATE_ITEMS = CONV_MOE_ITEMS + 32 * (NP1 / 64) + 32 * 32 + CONV_MOE_ITEMS;
#ifndef CONV_TAIL_ITEMS
#define CONV_TAIL_ITEMS 12288
#endif
constexpr int CONV_SPLIT = CONV_LATE_ITEMS - CONV_TAIL_ITEMS;
__device__ __forceinline__ TrItem conv_moe_desc(const Args& a, unsigned char* ws, int layer, int it) {
    if (it < 32 * 512) {
        const int ex = layer * 32 + it / 512, r = it % 512, blk = r >> 5, jj = r & 31, kb = (blk >> 2) * 8 + (jj >> 2), nb = (blk & 3) * 4 + (jj & 3), n0 = nb * 64, tile = n0 >> 8, j = n0 & 255;
        const float* W = (j < 128 ? a.in[17] : a.in[18]) + (size_t)ex * 2048 * 512;
        return TrItem{W, (bf16*)(ws + WS_WGU) + (size_t)ex * 1024 * 2048, 512, 128 * tile + (j & 127), 128 * tile + (j & 127) + 32, 2048, n0, kb * 64};
    }
    const int i2 = it - 32 * 512, ex = layer * 32 + i2 / 256, r = i2 % 256, blk = r >> 5, jj = r & 31, kb = jj >> 2, nb = blk * 4 + (jj & 3);
    return TrItem{a.in[19] + (size_t)ex * 512 * 2048, (bf16*)(ws + WS_WD) + (size_t)ex * 2048 * 512, 2048, nb * 64, nb * 64 + 32, 512, nb * 64, kb * 64};
}
__device__ __forceinline__ TrItem conv_late_desc(const Args& a, unsigned char* ws, int it) {
    if (it < CONV_MOE_ITEMS) return conv_moe_desc(a, ws, 0, it);
    it -= CONV_MOE_ITEMS;
    if (it < 32 * (NP1 / 64)) { const int kb = it / (NP1 / 64), nb = it % (NP1 / 64), n0 = nb * 64;
        return TrItem{a.in[7], (bf16*)(ws + WS_WINC), NE1, l1_src_col(n0), l1_src_col(n0 + 32), 2048, n0, kb * 64}; }
    it -= 32 * (NP1 / 64);
    if (it < 32 * 32) { const int kb = it / 32, nb = it % 32; return TrItem{a.in[8], (bf16*)(ws + WS_WOC), 2048, nb * 64, nb * 64 + 32, 2048, nb * 64, kb * 64}; }
    return conv_moe_desc(a, ws, 1, it - 32 * 32);
}
__device__ __forceinline__ void late_conv_items(Frame& F, const Args& a, const int lo, const int hi, const int ctr) {
    constexpr int CHUNK = 32;
    LAS bf16* T = (LAS bf16*)(F.lds + F.wave * 16384); volatile LAS int* slot = (volatile LAS int*)(F.lds + 131072 + 512);
    for (;;) {
        __syncthreads();
        if (F.tid == 0) *slot = lo + (int)atomicAdd(F.ctl + CW_FILL + 64 * ctr, (unsigned)CHUNK);
        __syncthreads();
        const int base = *slot;
        if (base >= hi) break;
        f32x4 rA[16], rB[16];
        TrItem t0 = conv_late_desc(a, F.ws, base + F.wave); tr64_load(t0, rA, F.lane);
        TrItem t1 = conv_late_desc(a, F.ws, base + F.wave + 8); tr64_load(t1, rB, F.lane);
        tr64_store(t0, rA, T, F.lane);
        t0 = conv_late_desc(a, F.ws, base + F.wave + 16); tr64_load(t0, rA, F.lane);
        tr64_store(t1, rB, T, F.lane);
        t1 = conv_late_desc(a, F.ws, base + F.wave + 24); tr64_load(t1, rB, F.lane);
        tr64_store(t0, rA, T, F.lane);
        tr64_store(t1, rB, T, F.lane);
    }
    __syncthreads();
}
static_assert(CONV_LATE_ITEMS % 32 == 0 && CONV_STATIC % 32 == 0 && CONV_STATIC <= CONV_LATE_ITEMS, "filler chunks");
__device__ __forceinline__ void p0_prologue(Frame& F, const Args& a) {
    const int gw = F.gw, NGW = F.NGW, lane = F.lane;
    unsigned char* ws = F.ws;
    LAS bf16* T = (LAS bf16*)(F.lds + F.wave * 16384);
    {
        const float* W = a.in[1]; bf16* WT = (bf16*)(ws + WS_WINA);
        for (int it = gw; it < 32 * (NP0 / 64); it += NGW) { const int kb = it / (NP0 / 64), nb = it % (NP0 / 64), n0 = nb * 64; const int c0 = n0 < 3072 ? n0 : n0 + 16; transpose_item64(W, NE0, c0, c0 + 32, 2048, WT, n0, kb * 64, T, lane); }
    }
    {
        for (int it = gw; it < 32 * 32; it += NGW) { const int kb = it / 32, nb = it % 32; transpose_item64(a.in[6], 2048, nb * 64, nb * 64 + 32, 2048, (bf16*)(ws + WS_WOA), nb * 64, kb * 64, T, lane); }
    }
    for (int it = gw; it < CONV_STATIC; it += NGW) { const TrItem t = conv_late_desc(a, ws, it); f32x4 r16[16]; tr64_load(t, r16, lane); tr64_store(t, r16, T, lane); }
    const int gt = blockIdx.x * (NWAVES * 64) + F.tid, NGT = F.G * NWAVES * 64;
    {   float* c128 = (float*)(ws + WS_ROPE); float* s128 = c128 + 4096 * 64; float* c64 = s128 + 4096 * 64; float* s64 = c64 + 4096 * 32;
        for (int i = gt; i < 4096 * 96; i += NGT) { int pos, idx, half; float* cp; float* sp;
            if (i < 4096 * 64) { pos = i >> 6; idx = i & 63; half = 64; cp = c128 + i; sp = s128 + i; } else { const int r = i - 4096 * 64; pos = r >> 5; idx = r & 31; half = 32; cp = c64 + r; sp = s64 + r; }
            const float inv = exp2f(-(float)idx / (float)half * 13.287712379549449f);
            const float ang = (float)pos * inv;
            double rv = (double)ang * 0.15915494309189535; rv -= rint(rv);
            const float rf = (float)rv;
            *cp = __builtin_amdgcn_cosf(rf); *sp = __builtin_amdgcn_sinf(rf); }
    }
    {   bf16* SKH = (bf16*)(ws + WS_WSM); bf16* SKL = SKH + (size_t)SK_NCOL * 2048;
        for (int i = gt; i < 2048 * SK_NCOL; i += NGT) { const int k = i / SK_NCOL, c = i % SK_NCOL; float v = 0.f;
            if (c < 96) { const int l = c / 48, j = c % 48; if (j < 4) v = a.in[13][((size_t)l * 2048 + k) * 4 + j]; else if (j < 36) { const int g = (j - 4) >> 3, e = (j - 4) & 7; v = a.in[15][(((size_t)l * 4 + g) * 2048 + k) * 8 + e]; } }
            else if (c < 128) { const int j = c - 96; if (j < 16) v = a.in[1][(size_t)k * NE0 + 3072 + j]; else if (j < 24) v = a.in[1][(size_t)k * NE0 + 6160 + j - 16]; }
            else v = a.in[7][(size_t)k * NE1 + 4096 + c - 128];
            const unsigned h = f2bf(v); SKH[(size_t)c * 2048 + k] = (bf16)h; SKL[(size_t)c * 2048 + k] = (bf16)f2bf(v - bf2f((unsigned short)h)); }
    }
    {   const float* x = a.in[0]; bf16* XB = (bf16*)(ws + WS_XB);
        for (int m = gw; m < MTOK; m += NGW) { f32x4 v[8];
#pragma unroll
            for (int j = 0; j < 8; ++j) v[j] = *(const f32x4*)(x + (size_t)m * DM + 256 * j + 4 * lane);
            store_row_bf16(XB + (size_t)m * DM, v, lane); }
    }
}
__device__ __forceinline__ void p_skinny0(Frame& F, const Args& a) {
    const bf16* SKH = (const bf16*)(F.ws + WS_WSM) + (size_t)SK_SK0 * 2048; const bf16* SKL = SKH + (size_t)SK_NCOL * 2048; float* SK0 = (float*)(F.ws + WS_SK0);
    const LAS float* LG = (const LAS float*)(F.lds + SK_LG_OFF);
    for (int blk = blockIdx.x; blk < MTOK / 32; blk += F.G) { const int R0 = blk * 32;
        __syncthreads();
        skinny_partials<2>(F.lds, (const bf16*)(F.ws + WS_XB) + (size_t)R0 * DM, SKH, SKL, F.wave, F.lane);
        __syncthreads();
        skinny_reduce<2>(F.lds, F.tid);
        __syncthreads();
        for (int idx = F.tid; idx < 32 * 24; idx += NWAVES * 64) { const int row = idx / 24, c = idx % 24; SK0[(size_t)(R0 + row) * 24 + c] = LG[row * 32 + c]; }
    }
    __syncthreads();
}
__device__ __forceinline__ void p_fox_bias(Frame& F, const Args& a) {
    if (blockIdx.x >= 16) return;
    const int bh = blockIdx.x, b = bh >> 3, h = bh & 7, lane = F.lane, tid = F.tid; const float gb = a.in[5][h];
    const float* SK0 = (const float*)(F.ws + WS_SK0); float* FB = (float*)(F.ws + WS_FBIAS) + (size_t)bh * SEQ; LAS float* wt = (LAS float*)(F.lds + 120000);
    float lf[8], tot = 0.f;
#pragma unroll
    for (int i = 0; i < 8; ++i) lf[i] = SK0[(size_t)(b * SEQ + tid * 8 + i) * 24 + 16 + h];
#pragma unroll
    for (int i = 0; i < 8; ++i) { tot += logsigmoidf(lf[i] + gb); lf[i] = tot; }
    float incl = tot;
#pragma unroll
    for (int o = 1; o < 64; o <<= 1) { const float t = __shfl_up(incl, o); if (lane >= o) incl += t; }
    if (lane == 63) wt[F.wave] = incl;
    __syncthreads();
    float pre = incl - tot;
    for (int w = 0; w < F.wave; ++w) pre += wt[w];
#pragma unroll
    for (int i = 0; i < 8; ++i) FB[tid * 8 + i] = -(pre + lf[i]) * (1.0f / ATT_SCALE);
    __syncthreads();
}
__device__ __forceinline__ void p_ln_route(Frame& F, const Args& a, int layer) {
    const bf16* YB = (const bf16*)(F.ws + WS_YB); bf16* XB = (bf16*)(F.ws + WS_XB); const int lane = F.lane;
    const float* g = a.in[9] + layer * DM; const float* bb = a.in[10] + layer * DM;
    const bf16* SKH = (const bf16*)(F.ws + WS_WSM) + (size_t)(layer ? SK_ROUTE1 : SK_ROUTE0) * 2048; const bf16* SKL = SKH + (size_t)SK_NCOL * 2048;
    const float* bg = a.in[14] + layer * 4; const float* be = a.in[16] + layer * 32;
    int4* ROUTE = (int4*)(F.ws + WS_ROUTE); unsigned* cnt = F.ctl + CW_CNT + layer * 64; int* INV = (int*)(F.ws + WS_INV); float* WINV = (float*)(F.ws + WS_WINV);
    const LAS float* LG = (const LAS float*)(F.lds + SK_LG_OFF);
    for (int blk = blockIdx.x; blk < MTOK / 32; blk += F.G) { const int R0 = blk * 32;
#pragma unroll 2
        for (int i = 0; i < 4; ++i) { const int m = R0 + 4 * F.wave + i; f32x4 v[8];
            load_row_bf16(YB + (size_t)m * DM, v, lane);
            ln_row(v, g, bb, lane);
            store_row_bf16(XB + (size_t)m * DM, v, lane); }
        __syncthreads();
        skinny_partials<3>(F.lds, XB + (size_t)R0 * DM, SKH, SKL, F.wave, lane);
        __syncthreads();
        skinny_reduce<3>(F.lds, F.tid);
        __syncthreads();
        if (F.tid < 32) { const int m = R0 + F.tid; const LAS float* l = LG + F.tid * 48;
            float gl[4];
#pragma unroll
            for (int i = 0; i < 4; ++i) gl[i] = l[i] + bg[i];
            int gi = 0; float gm = gl[0];
#pragma unroll
            for (int i = 1; i < 4; ++i) if (gl[i] > gm) { gm = gl[i]; gi = i; }
            float gs = 0.f;
#pragma unroll
            for (int i = 0; i < 4; ++i) gs += __expf(gl[i] - gm);
            const float gp = 1.0f / gs;
            float el[8];
#pragma unroll
            for (int e = 0; e < 8; ++e) el[e] = l[4 + 8 * gi + e] + be[gi * 8 + e];
            int e1 = 0; float v1 = el[0];
#pragma unroll
            for (int e = 1; e < 8; ++e) if (el[e] > v1) { v1 = el[e]; e1 = e; }
            int e2 = -1; float v2 = -3.0e38f;
#pragma unroll
            for (int e = 0; e < 8; ++e) if (e != e1 && el[e] > v2) { v2 = el[e]; e2 = e; }
            const float w1 = gp / (1.0f + __expf(v2 - v1)), w2 = gp - w1;
            const int ge1 = gi * 8 + e1, ge2 = gi * 8 + e2;
            const int p1 = (int)atomicAdd(cnt + ge1, 1u), p2 = (int)atomicAdd(cnt + ge2, 1u);
            ROUTE[(size_t)m * 2 + 0] = make_int4(ge1, p1, 0, 0); ROUTE[(size_t)m * 2 + 1] = make_int4(ge2, p2, 0, 0);
            INV[ge1 * 8192 + p1] = m; INV[ge2 * 8192 + p2] = m; WINV[ge1 * 8192 + p1] = w1; WINV[ge2 * 8192 + p2] = w2; }
    }
    __syncthreads();
}
__device__ __forceinline__ int moe_offsets(const unsigned* cnt, int lane, int* tiles_incl) {
    const int c = lane < 32 ? (int)cnt[lane] : 0; const int t = (c + 255) >> 8; int incl = t;
#pragma unroll
    for (int o = 1; o < 32; o <<= 1) { const int x = __shfl_up(incl, o); if ((lane & 31) >= o) incl += x; }
    *tiles_incl = incl; return (incl - t) * 256;
}
__device__ __forceinline__ void p_ln_ffn(Frame& F, const Args& a, int layer) {
    bf16* XB = (bf16*)(F.ws + WS_XB); const int lane = F.lane; const bf16* YG = (const bf16*)(F.ws + WS_CST);
    const float* g = a.in[11] + layer * DM; const float* bb = a.in[12] + layer * DM; const int4* ROUTE = (const int4*)(F.ws + WS_ROUTE);
    const bf16* SKH = (const bf16*)(F.ws + WS_WSM) + (size_t)SK_SK1 * 2048; const bf16* SKL = SKH + (size_t)SK_NCOL * 2048;
    const float* c64 = (const float*)(F.ws + WS_ROPE) + 2 * 4096 * 64; const float* s64 = c64 + 4096 * 32;
    bf16* IK = (bf16*)(F.ws + WS_IK); float* IW = (float*)(F.ws + WS_IW);
    const LAS float* LG = (const LAS float*)(F.lds + SK_LG_OFF);
    int ti_; const int eoff = moe_offsets(F.ctl + CW_CNT + layer * 64, lane, &ti_);
    for (int blk = blockIdx.x; blk < MTOK / 32; blk += F.G) { const int R0 = blk * 32;
#pragma unroll 2
        for (int i = 0; i < 4; ++i) { const int m = R0 + 4 * F.wave + i; f32x4 v[8];
            const int4 q0 = ROUTE[(size_t)m * 2], q1 = ROUTE[(size_t)m * 2 + 1]; const int r0 = __shfl(eoff, q0.x) + q0.y, r1 = __shfl(eoff, q1.x) + q1.y;
            load_row_bf16(XB + (size_t)m * DM, v, lane);
#pragma unroll
            for (int j = 0; j < 8; ++j) { v[j] = v[j] * DN_ALPHA;
                const uint2 y0 = *(const uint2*)(YG + (size_t)r0 * DM + 256 * j + 4 * lane), y1 = *(const uint2*)(YG + (size_t)r1 * DM + 256 * j + 4 * lane);
                v[j][0] += bf2f(y0.x & 0xffff) + bf2f(y1.x & 0xffff); v[j][1] += bf2f(y0.x >> 16) + bf2f(y1.x >> 16);
                v[j][2] += bf2f(y0.y & 0xffff) + bf2f(y1.y & 0xffff); v[j][3] += bf2f(y0.y >> 16) + bf2f(y1.y >> 16); }
            ln_row(v, g, bb, lane);
            if (layer == 0) store_row_bf16(XB + (size_t)m * DM, v, lane);
            else {
#pragma unroll
                for (int j = 0; j < 8; ++j) *(f32x4*)(a.out + (size_t)m * DM + 256 * j + 4 * lane) = v[j]; } }
        if (layer == 0) {
            __syncthreads();
            skinny_partials<5>(F.lds, XB + (size_t)R0 * DM, SKH, SKL, F.wave, lane);
            __syncthreads();
            skinny_reduce<5>(F.lds, F.tid);
            __syncthreads();
            for (int idx = F.tid; idx < 32 * 80; idx += NWAVES * 64) { const int row = idx / 80, c = idx % 80, m = R0 + row; const float v = LG[row * 80 + c];
                if (c < 64) { const float part = LG[row * 80 + (c ^ 32)]; const int pos = m & 4095, i = c & 31; const float cs = c64[pos * 32 + i], sn = s64[pos * 32 + i];
                    const int bq = m >> 12, sq = m & 4095; IK[((((size_t)bq * 128 + (sq >> 5)) * 4 + (c >> 4)) * 64 + ((c >> 3) & 1) * 32 + (sq & 31)) * 8 + (c & 7)] = (bf16)f2bf(c < 32 ? (v * cs - part * sn) : (v * cs + part * sn)); }
                else IW[(size_t)m * 16 + c - 64] = v * 0.25f * 0.125f; }
        }
    }
    __syncthreads();
}
__device__ __forceinline__ void ph_gla_b(Frame& F, const Args& a) {
    const float* SK0 = (const float*)(F.ws + WS_SK0); const float* w2 = a.in[2]; const float* gbias = a.in[3]; float* GB = (float*)(F.ws + WS_GB); float* DEC = (float*)(F.ws + WS_DEC);
    for (int u4 = blockIdx.x; u4 < 128; u4 += F.G) {
        const int unit = u4 * 4 + (F.tid >> 7), n = unit & 63, bh = unit >> 6, b = bh >> 2, h = bh & 3, d = F.tid & 127, t0 = b * SEQ + n * 64;
        float w[16];
#pragma unroll
        for (int r = 0; r < 16; ++r) w[r] = w2[r * 512 + h * 128 + d];
        const float gb = gbias[h * 128 + d]; float run = 0.f;
        for (int c = 0; c < 64; ++c) { const int t = t0 + c; float z = gb;
#pragma unroll
            for (int r = 0; r < 16; ++r) z += SK0[(size_t)t * 24 + r] * w[r];
            run += logsigmoidf(z) * (1.0f / 16.0f); GB[(size_t)t * 512 + h * 128 + d] = run; }
        DEC[unit * 128 + d] = __expf(run);
    }
}
__device__ __forceinline__ void ph_gla_state(Frame& F) {
    const bf16* PROJ = (const bf16*)(F.ws + WS_PROJ); const float* GB = (const float*)(F.ws + WS_GB); float* CST = (float*)(F.ws + WS_CST);
    for (int vb = blockIdx.x; vb < 512 * 64; vb += F.G) {
        const int unit = vb >> 6, d = (vb & 63) * 2 + (F.tid >> 8), v = F.tid & 255, n = unit & 63, bh = unit >> 6, b = bh >> 2, h = bh & 3, t0 = b * SEQ + n * 64;
        const float blast = GB[(size_t)(t0 + 63) * 512 + h * 128 + d]; float acc = 0.f;
        for (int c = 0; c < 64; ++c) { const size_t t = t0 + c; const float kk = bf2f(PROJ[t * NP0 + 512 + h * 128 + d]) * __expf(blast - GB[t * 512 + h * 128 + d]);
            acc += kk * bf2f(PROJ[t * NP0 + 1024 + h * 256 + v]); }
        CST[((size_t)unit * 256 + v) * 128 + d] = acc;
    }
}
__device__ __forceinline__ void ph_gla_scan(Frame& F) {
    const bf16* CST = (const bf16*)(F.ws + WS_CST); const float* DEC = (const float*)(F.ws + WS_DEC); bf16* PREVT = (bf16*)(F.ws + WS_PREVT);
    for (int idx = blockIdx.x * 512 + F.tid; idx < 8 * 32768; idx += F.G * 512) { const int bh = idx >> 15, vd = idx & 32767, d = vd & 127; float S = 0.f;
        for (int n = 0; n < 64; ++n) { const int unit = bh * 64 + n; PREVT[(size_t)unit * 32768 + vd] = (bf16)f2bf(S); S = DEC[unit * 128 + d] * S + bf2f(CST[(size_t)unit * 32768 + vd]); } }
}
__device__ __forceinline__ void ph_gla_out(Frame& F, const Args& a) {
    const bf16* PROJ = (const bf16*)(F.ws + WS_PROJ); const float* GB = (const float*)(F.ws + WS_GB); const bf16* PREVT = (const bf16*)(F.ws + WS_PREVT); const float* normg = a.in[4]; bf16* OMIX = (bf16*)(F.ws + WS_OMIX);
    LAS float* qd = (LAS float*)F.lds; LAS float* ki = qd + 64 * 128; LAS float* sc = ki + 64 * 128; LAS float* red = sc + 64 * 64;
    const int tid = F.tid; const bool act = tid < 256;
    for (int unit = blockIdx.x; unit < 512; unit += F.G) {
        const int n = unit & 63, bh = unit >> 6, b = bh >> 2, h = bh & 3, t0 = b * SEQ + n * 64;
        __syncthreads();
        for (int i = tid; i < 64 * 128; i += 512) { const int c = i >> 7, d = i & 127; const size_t t = t0 + c; const float bb = GB[t * 512 + h * 128 + d];
            qd[i] = bf2f(PROJ[t * NP0 + h * 128 + d]) * ATT_SCALE * __expf(bb); ki[i] = bf2f(PROJ[t * NP0 + 512 + h * 128 + d]) * __expf(-bb); }
        __syncthreads();
        for (int p = tid; p < 64 * 64; p += 512) { const int i = p >> 6, j = p & 63; float s = 0.f;
            if (j <= i) for (int d = 0; d < 128; ++d) s += qd[i * 128 + d] * ki[j * 128 + d];
            sc[p] = s; }
        __syncthreads();
        const int v = tid & 255; const bf16* pv = PREVT + ((size_t)unit * 256 + v) * 128; const float gv = normg[v];
        for (int i = 0; i < 64; ++i) { float acc = 0.f;
            if (act) { for (int j = 0; j <= i; ++j) acc += sc[i * 64 + j] * bf2f(PROJ[(size_t)(t0 + j) * NP0 + 1024 + h * 256 + v]);
                for (int d = 0; d < 128; ++d) acc += qd[i * 128 + d] * bf2f(pv[d]);
                const float ss = wave_sum(acc * acc); if ((tid & 63) == 0) red[tid >> 6] = ss; }
            __syncthreads();
            const float ms = (red[0] + red[1] + red[2] + red[3]) * (1.0f / 256.0f); __syncthreads();
            if (act) { const float gr = bf2f(PROJ[(size_t)(t0 + i) * NP0 + 2048 + h * 256 + v]);
                const float o = acc * (1.0f / sqrtf(ms + LN_EPS)) * gv * (gr / (1.0f + __expf(-gr)));
                OMIX[(size_t)(t0 + i) * DM + h * 256 + v] = (bf16)f2bf(o); } }
    }
}
template <int MODE  >
__device__ __forceinline__ void ph_attn_naive(Frame& F, const bf16* Qb, int ldq, int qc0, const bf16* Kb, int ldk, int kc0, const bf16* Vb, int ldv, int vc0, int nheads, int group,
                                              const float* fbias, const unsigned long long* mask, bf16* O, int oc0) {
    const int half = F.tid >> 8, tid = F.tid & 255, qi = tid >> 2, part = tid & 3;
    LAS bf16* Ks = (LAS bf16*)(F.lds + half * 32768); LAS bf16* Vs = Ks + 64 * 128;
    const int nvb = (SEQ / 64) * (nheads / 2) * BATCH;
    for (int vb = blockIdx.x; vb < nvb; vb += F.G) {
        const int cc = vb >> 6, qb = ((vb & 63) + cc * 17) & 63, hp = cc % (nheads / 2), b = cc / (nheads / 2), h = hp * 2 + half, kvh = h / group;
        const int qpos = qb * 64 + qi; const size_t row = (size_t)b * SEQ + qpos;
        float qv[32], o[32];
#pragma unroll
        for (int d = 0; d < 32; ++d) { qv[d] = bf2f(Qb[row * ldq + qc0 + h * 128 + part * 32 + d]); o[d] = 0.f; }
        float mrun = -1e30f, l = 0.f;
        const float* fb = MODE == 0 ? fbias + (size_t)(b * 8 + h) * SEQ : nullptr;
        for (int kt = 0; kt <= qb; ++kt) {
            __syncthreads();
            for (int i = tid; i < 64 * 16; i += 256) { const int r = i >> 4, c8 = (i & 15) * 8; const size_t kr = (size_t)b * SEQ + kt * 64 + r;
                *(LAS v4u*)(Ks + r * 128 + c8) = *(const v4u*)(Kb + kr * ldk + kc0 + kvh * 128 + c8); *(LAS v4u*)(Vs + r * 128 + c8) = *(const v4u*)(Vb + kr * ldv + vc0 + kvh * 128 + c8); }
            __syncthreads();
            unsigned long long mw = ~0ull; if (MODE == 1) mw = mask[row * 64 + kt];
            for (int s = 0; s < 64; ++s) { const int key = kt * 64 + s; float p = 0.f;
#pragma unroll
                for (int d = 0; d < 32; ++d) p += qv[d] * bf2f(Ks[s * 128 + part * 32 + d]);
                p += __shfl_xor(p, 1); p += __shfl_xor(p, 2);
                const bool valid = key <= qpos && ((mw >> s) & 1ull);
                if (valid) { const float logit = (p + (MODE == 0 ? fb[key] : 0.f)) * ATT_SCALE; const float mn = fmaxf(mrun, logit), al = __expf(mrun - mn), pp = __expf(logit - mn);
                    l = l * al + pp; mrun = mn;
#pragma unroll
                    for (int d = 0; d < 32; ++d) o[d] = o[d] * al + pp * bf2f(Vs[s * 128 + part * 32 + d]); } }
        }
        const float il = 1.0f / l;
#pragma unroll
        for (int d = 0; d < 32; ++d) O[row * DM + oc0 + h * 128 + part * 32 + d] = (bf16)f2bf(o[d] * il);
    }
    __syncthreads();
}
__device__ __forceinline__ void ph_idx_scores(Frame& F) {
    const bf16* PROJ1 = (const bf16*)(F.ws + WS_PROJ); const bf16* IK = (const bf16*)(F.ws + WS_IK); const float* IW = (const float*)(F.ws + WS_IW); float* SC = (float*)(F.ws + WS_SC);
    LAS float* q = (LAS float*)F.lds; LAS float* w = q + 1024; const int tid = F.tid;
    for (int m = blockIdx.x; m < MTOK; m += F.G) { const int pos = m & 4095, b = m >> 12;
        __syncthreads();
        for (int i = tid; i < 1024; i += 512) q[i] = bf2f(PROJ1[(size_t)m * NP1 + 3072 + i]);
        if (tid < 16) w[tid] = IW[(size_t)m * 16 + tid];
        __syncthreads();
        for (int s = tid; s <= pos; s += 512) { const bf16* kr = IK + ((size_t)b * SEQ + s) * 64; float kk[64];
#pragma unroll
            for (int d = 0; d < 64; ++d) kk[d] = bf2f(kr[d]);
            float sc = 0.f;
#pragma unroll 1
            for (int hh = 0; hh < 16; ++hh) { float dsum = 0.f;
#pragma unroll
                for (int d = 0; d < 64; ++d) dsum += q[hh * 64 + d] * kk[d];
                sc += w[hh] * fmaxf(dsum, 0.f); }
            SC[(size_t)m * SEQ + s] = sc; }
    }
    __syncthreads();
}
namespace attn {
constexpr int D = 128, NW = 8, QBLK = 32, KVBLK = 64, QB = NW * QBLK;
constexpr int SHM_V = KVBLK * D * 2, SHM_K = KVBLK * D * 2;
constexpr int OFF_WS = 2 * SHM_V + 2 * SHM_K, OFF_BIAS = OFF_WS + NW * 64 * 4, LDS_NEED = OFF_BIAS + 2 * 16384;
constexpr float SCALE = 0.08838834764831845f, THR = 8.f;
typedef short s16x4 __attribute__((ext_vector_type(4)));
typedef float f32x16 __attribute__((ext_vector_type(16)));
typedef unsigned u32x4 __attribute__((ext_vector_type(4)));
#define KSWZ(row, colB) ((row) * 256 + ((colB) ^ (((row) & 7) << 4)))
#define SBAR() __builtin_amdgcn_sched_barrier(0)
__device__ __forceinline__ int v_st(int k, int c) { const int kk = (k & ~0xC) | ((k & 4) << 1) | ((k & 8) >> 1); return ((kk >> 3) * 4 + (c >> 5)) * 512 + ((kk & 7) * 32 + (c & 31)) * 2; }
__device__ __forceinline__ int v_rd_base(int lane) { return ((lane & 3) << 3) | (((lane >> 2) & 3) << 6) | (((lane >> 4) & 1) << 5) | (((lane >> 5) & 1) << 8); }
constexpr int v_rd_off(int d0, int ks, int half) { return d0 * 512 + ks * 4096 + half * 2048; }
__device__ __forceinline__ int crow(int r, int hi) { return (r & 3) + 8 * (r >> 2) + 4 * hi; }
__device__ __forceinline__ unsigned cvtpk(float lo, float hi) { unsigned r; asm volatile("v_cvt_pk_bf16_f32 %0, %1, %2" : "=v"(r) : "v"(lo), "v"(hi)); return r; }
__device__ __forceinline__ bf16x8 load8(const bf16* p) { return *reinterpret_cast<const bf16x8*>(p); }
__device__ __forceinline__ void mask_tile(f32x16& p0, f32x16& p1, int dq) {
    const float NEG = -__builtin_inff();
#pragma unroll
    for (int r = 0; r < 16; ++r) { const int c = (r & 3) + 8 * (r >> 2); if (dq - c < 0) p0[r] = NEG; if (dq - c - 32 < 0) p1[r] = NEG; }
}
__device__ __forceinline__ void mask_bits(f32x16& p0, f32x16& p1, unsigned w0, unsigned w1) {
#pragma unroll
    for (int r = 0; r < 16; ++r) { const unsigned c = (r & 3) + 8 * (r >> 2);
        const unsigned m0 = (unsigned)__builtin_amdgcn_sbfe((int)w0, c, 1), m1 = (unsigned)__builtin_amdgcn_sbfe((int)w1, c, 1);
        p0[r] = __uint_as_float((m0 & __float_as_uint(p0[r])) | (~m0 & 0xFF800000u)); p1[r] = __uint_as_float((m1 & __float_as_uint(p1[r])) | (~m1 & 0xFF800000u)); }
}
__device__ __forceinline__ void partialSM(f32x16& p0, f32x16& p1, float& m_reg, float& mn, float& alpha) {
    float pmax = p0[0]; for (int r = 1; r < 16; ++r) pmax = fmaxf(pmax, p0[r]); for (int r = 0; r < 16; ++r) pmax = fmaxf(pmax, p1[r]);
    { auto rr = __builtin_amdgcn_permlane32_swap(__float_as_uint(pmax), __float_as_uint(pmax), false, false);
      pmax = fmaxf(__uint_as_float(rr[0]), __uint_as_float(rr[1])); }
    constexpr float C2 = 1.4426950408889634f * SCALE;
    if (__builtin_expect(__all((pmax - m_reg) * SCALE <= THR), 1)) { mn = m_reg; alpha = 1.f; }
    else { mn = fmaxf(m_reg, pmax); alpha = __builtin_amdgcn_exp2f((m_reg - mn) * C2); m_reg = mn; }
    const float mnL = -mn * C2;
    for (int r = 0; r < 16; ++r) p0[r] = fmaf(p0[r], C2, mnL); for (int r = 0; r < 16; ++r) p1[r] = fmaf(p1[r], C2, mnL);
    for (int r = 0; r < 16; ++r) p0[r] = __builtin_amdgcn_exp2f(p0[r]);
}
__device__ __forceinline__ void finishSM(f32x16& p0, f32x16& p1, float alpha, float& l_reg, bf16x8& pa0, bf16x8& pa1, bf16x8& pa2, bf16x8& pa3) {
    for (int r = 0; r < 16; ++r) p1[r] = __builtin_amdgcn_exp2f(p1[r]);
    float ps = 0; for (int r = 0; r < 16; ++r) ps += p0[r]; for (int r = 0; r < 16; ++r) ps += p1[r];
    { auto rr = __builtin_amdgcn_permlane32_swap(__float_as_uint(ps), __float_as_uint(ps), false, false);
      ps = __uint_as_float(rr[0]) + __uint_as_float(rr[1]); }
    l_reg = l_reg * alpha + ps;
#define PK4(P, B_, OUT) do { unsigned a0 = cvtpk(P[B_+0], P[B_+1]), a1 = cvtpk(P[B_+2], P[B_+3]);                          \
        unsigned b0 = cvtpk(P[B_+4], P[B_+5]), b1 = cvtpk(P[B_+6], P[B_+7]);                                             \
        auto r0 = __builtin_amdgcn_permlane32_swap(a0, b0, false, false); auto r1 = __builtin_amdgcn_permlane32_swap(a1, b1, false, false); \
        u32x4 w = {r0[0], r1[0], r0[1], r1[1]}; OUT = *reinterpret_cast<bf16x8*>(&w); } while (0)
    PK4(p0, 0, pa0); PK4(p0, 8, pa1); PK4(p1, 0, pa2); PK4(p1, 8, pa3);
#undef PK4
}
template <int KB, bool BIAS>
__device__ __forceinline__ void qkt(f32x16& p0, f32x16& p1, const char* K_lds, int r32, int hi, const bf16x8* qr, const char* bl) {
    p0 = f32x16{}; p1 = f32x16{}; (void)bl;
    const char* kb[4];
#pragma unroll
    for (int dd = 0; dd < 4; ++dd) kb[dd] = K_lds + KB * SHM_K + KSWZ(r32, (dd * 16 + hi * 8) * 2);
#pragma unroll
    for (int d0 = 0; d0 < 8; ++d0) { const char* a = kb[d0 & 3] + (d0 >> 2) * 128;
        bf16x8 b0 = *reinterpret_cast<const bf16x8*>(a);
        bf16x8 b1 = *reinterpret_cast<const bf16x8*>(a + 32 * 256);
        p0 = __builtin_amdgcn_mfma_f32_32x32x16_bf16(b0, qr[d0], p0, 0, 0, 0);
        p1 = __builtin_amdgcn_mfma_f32_32x32x16_bf16(b1, qr[d0], p1, 0, 0, 0); }
}
template <int VB>
__device__ __forceinline__ void pv_tile(f32x16* o, int vb0, bf16x8 pa0, bf16x8 pa1, bf16x8 pa2, bf16x8 pa3) {
#define TRRD(dst, off) asm volatile("ds_read_b64_tr_b16 %0, %1 offset:%2" : "=&v"(dst) : "v"(vb0), "i"(off) : "memory")
#define PV_D0(d0) do { s16x4 l0, l1, l2, l3, h0, h1, h2, h3; constexpr int b_ = VB * SHM_V + v_rd_off(d0, 0, 0); \
        TRRD(l0, b_); TRRD(h0, b_ + 2048); TRRD(l1, b_ + 4096); TRRD(h1, b_ + 6144); TRRD(l2, b_ + 8192); TRRD(h2, b_ + 10240); TRRD(l3, b_ + 12288); TRRD(h3, b_ + 14336); \
        asm volatile("s_waitcnt lgkmcnt(0)" ::: "memory"); SBAR();   \
        o[d0] = __builtin_amdgcn_mfma_f32_32x32x16_bf16(pa0, (bf16x8){l0[0], l0[1], l0[2], l0[3], h0[0], h0[1], h0[2], h0[3]}, o[d0], 0, 0, 0);   \
        o[d0] = __builtin_amdgcn_mfma_f32_32x32x16_bf16(pa1, (bf16x8){l1[0], l1[1], l1[2], l1[3], h1[0], h1[1], h1[2], h1[3]}, o[d0], 0, 0, 0);   \
        o[d0] = __builtin_amdgcn_mfma_f32_32x32x16_bf16(pa2, (bf16x8){l2[0], l2[1], l2[2], l2[3], h2[0], h2[1], h2[2], h2[3]}, o[d0], 0, 0, 0);   \
        o[d0] = __builtin_amdgcn_mfma_f32_32x32x16_bf16(pa3, (bf16x8){l3[0], l3[1], l3[2], l3[3], h3[0], h3[1], h3[2], h3[3]}, o[d0], 0, 0, 0); } while (0)
    PV_D0(0); PV_D0(1); PV_D0(2); PV_D0(3);
#undef PV_D0
#undef TRRD
}
struct BlockRef { const bf16* Q; const bf16* K; const bf16* V; bf16* O; int P0; const float* fb; const unsigned long long* mrow; };
struct Seam { bf16x8 qr[8]; bf16x8 st_v0, st_v1, st_k0, st_k1; };
#define VMW() asm volatile("s_waitcnt vmcnt(0)" ::: "memory")
#define VMWN(n) asm volatile("s_waitcnt vmcnt(%0)" :: "i"(n) : "memory")
#define SLOAD_H(Kp, Vp, k0) do { const bf16* kt_ = (Kp) + (size_t)(k0) * KS; const bf16* vt_ = (Vp) + (size_t)(k0) * KS; S.st_v0 = load8(vt_ + koff); S.st_v1 = load8(vt_ + koff + 32 * KS); S.st_k0 = load8(kt_ + koff); S.st_k1 = load8(kt_ + koff + 32 * KS); } while (0)
#define SWRITE_HK(bf) do { *(bf16x8*)(K_lds + (bf) * SHM_K + kws) = S.st_k0; *(bf16x8*)(K_lds + (bf) * SHM_K + kws + 32 * 256) = S.st_k1; } while (0)
#define SWRITE_HV(bf) do { *(bf16x8*)(V_lds + (bf) * SHM_V + vst0) = S.st_v0; *(bf16x8*)(V_lds + (bf) * SHM_V + vst1) = S.st_v1; } while (0)
#define SWRITE_H(bf) do { SWRITE_HV(bf); SWRITE_HK(bf); } while (0)
template <bool BIAS, bool BITMASK, int QS, int KS, int OS>
__device__ __forceinline__ void attn_block(const BlockRef& cur, char* lds, LAS unsigned char* ldsl) {
    int tid_ = threadIdx.x; asm volatile("" : "+v"(tid_));
    const int tid = tid_, wid = __builtin_amdgcn_readfirstlane(tid >> 6), lane = tid & 63, r32 = lane & 31, hi = lane >> 5;
    const int NT = (cur.P0 + QB - 1) / KVBLK + 1;
    const int qlo = cur.P0 + wid * QBLK, qm = qlo + r32 - 4 * hi;
    char* V_lds = lds; char* K_lds = lds + 2 * SHM_V;
    float* ws = (float*)(lds + OFF_WS) + wid * 64; float* li_l = ws, * al_l = ws + 32;
    const LAS unsigned char* bl0 = ldsl + OFF_BIAS + hi * 16;
    float m_reg = -1e30f, l_reg = 0; f32x16 o[4] = {};
    const int sr = tid >> 4, sc = (tid & 15) * 8, vst0 = v_st(sr, sc), vst1 = v_st(32 + sr, sc), kws = KSWZ(sr, sc * 2);
    const int vb0 = (int)(uintptr_t)V_lds + v_rd_base(lane);
    const bf16* Kh = cur.K; const bf16* Vh = cur.V;
    const int moff = (wid * QBLK + r32) * 64, koff = sr * KS + sc, qoff = (wid * QBLK + r32) * QS + hi * 8;
    Seam S;
#pragma unroll
    for (int d0 = 0; d0 < 8; ++d0) S.qr[d0] = load8(cur.Q + qoff + d0 * 16);
    if constexpr (BIAS) { const f32x4 b0_ = *(const f32x4*)(cur.fb + tid * 8), b1_ = *(const f32x4*)(cur.fb + tid * 8 + 4);
        *(LAS f32x4*)(ldsl + OFF_BIAS + tid * 32) = b0_; *(LAS f32x4*)(ldsl + OFF_BIAS + tid * 32 + 16) = b1_; }
    SLOAD_H(Kh, Vh, 0); VMW(); SWRITE_HK(0); SWRITE_HV(0); SBAR();
#define RESC(a) do { if (__any((a) < 1.f)) { if (hi == 0) al_l[r32] = (a); asm volatile("s_waitcnt lgkmcnt(0)" ::: "memory");              \
                     for (int d_ = 0; d_ < 4; ++d_) for (int r = 0; r < 16; ++r) o[d_][r] *= al_l[crow(r, hi)]; } } while (0)
#define KBASE(t) ((t) * KVBLK)
#define MLOAD(MW, t) do { if constexpr (BITMASK) MW = (cur.mrow + (t))[moff]; } while (0)
#define MASKT(P0_, P1_, MW, t) do { if constexpr (BIAS) { const LAS unsigned char* bl_ = bl0 + KBASE(t) * 4; _Pragma("unroll") for (int g = 0; g < 4; ++g) { const f32x4 a_ = *(const LAS f32x4*)(bl_ + g * 32), b_ = *(const LAS f32x4*)(bl_ + 128 + g * 32); \
            P0_[4 * g] += a_[0]; P0_[4 * g + 1] += a_[1]; P0_[4 * g + 2] += a_[2]; P0_[4 * g + 3] += a_[3]; P1_[4 * g] += b_[0]; P1_[4 * g + 1] += b_[1]; P1_[4 * g + 2] += b_[2]; P1_[4 * g + 3] += b_[3]; } } \
        if constexpr (BITMASK) { mask_bits(P0_, P1_, (unsigned)(MW) >> (4 * hi), (unsigned)((MW) >> 32) >> (4 * hi)); } \
        else { const int kb_ = KBASE(t); if (kb_ + KVBLK - 1 > qlo) mask_tile(P0_, P1_, qm - kb_); } } while (0)
    f32x16 pA0, pA1, pB0, pB1; float mnA, mnB, alA, alB; bf16x8 pa0, pa1, pa2, pa3; unsigned long long mwA = 0, mwB = 0;
    MLOAD(mwA, 0);
    SLOAD_H(Kh, Vh, KBASE(1)); MLOAD(mwB, 1);
    __syncthreads();
    SBAR(); qkt<0, BIAS>(pA0, pA1, K_lds, r32, hi, S.qr, nullptr);
    MASKT(pA0, pA1, mwA, 0); partialSM(pA0, pA1, m_reg, mnA, alA);
    VMW(); SWRITE_H(1);
    __syncthreads();
#define HALF_STEP(PX0, PX1, mnX, alX, MWX, PY0, PY1, alY, MWY, t, KB, VB, SB) do {                                            \
        SBAR(); qkt<KB, BIAS>(PX0, PX1, K_lds, r32, hi, S.qr, nullptr);                                                       \
        finishSM(PY0, PY1, alY, l_reg, pa0, pa1, pa2, pa3); SBAR();                                                           \
        if ((t) + 1 < NT) { SLOAD_H(Kh, Vh, KBASE((t) + 1)); MLOAD(MWY, (t) + 1); SBAR(); }                                   \
        pv_tile<VB>(o, vb0, pa0, pa1, pa2, pa3); MASKT(PX0, PX1, MWX, (t)); partialSM(PX0, PX1, m_reg, mnX, alX);             \
        __syncthreads();                                                                                                      \
        if ((t) + 1 < NT) { VMW(); SWRITE_H(SB); }                                                                            \
        RESC(alX); __syncthreads(); } while (0)
    for (int t = 1; t + 1 < NT; t += 2) {
        HALF_STEP(pB0, pB1, mnB, alB, mwB, pA0, pA1, alA, mwA, t, 1, 0, 0);
        HALF_STEP(pA0, pA1, mnA, alA, mwA, pB0, pB1, alB, mwB, t + 1, 0, 1, 1);
    }
    SBAR(); qkt<1, BIAS>(pB0, pB1, K_lds, r32, hi, S.qr, nullptr); SBAR();
    finishSM(pA0, pA1, alA, l_reg, pa0, pa1, pa2, pa3); SBAR();
    pv_tile<0>(o, vb0, pa0, pa1, pa2, pa3);
    MASKT(pB0, pB1, mwB, NT - 1); partialSM(pB0, pB1, m_reg, mnB, alB); __syncthreads(); RESC(alB);
    finishSM(pB0, pB1, alB, l_reg, pa0, pa1, pa2, pa3); SBAR(); pv_tile<1>(o, vb0, pa0, pa1, pa2, pa3);
    SBAR();
    if (hi == 0) li_l[r32] = l_reg; asm volatile("s_waitcnt lgkmcnt(0)" ::: "memory");
    float rli[16];
#pragma unroll
    for (int r = 0; r < 16; ++r) rli[r] = __builtin_amdgcn_rcpf(li_l[crow(r, hi)]);
    int tid2_ = threadIdx.x; asm volatile("" : "+v"(tid2_));
    const int r32e = tid2_ & 31, hie = (tid2_ >> 5) & 1, ooff = (wid * QBLK + 4 * hie) * OS + r32e;
#pragma unroll
    for (int r = 0; r < 16; ++r) {
#pragma unroll
        for (int d0 = 0; d0 < 4; ++d0) { const float v = o[d0][r] * rli[r]; const float vn = __shfl_xor(v, 1);
            if ((r32e & 1) == 0) *(unsigned*)(cur.O + ((r & 3) + 8 * (r >> 2)) * OS + d0 * 32 + ooff) = cvtpk(v, vn); } }
    __syncthreads();
#undef RESC
#undef KBASE
#undef MLOAD
#undef MASKT
#undef HALF_STEP
}
#undef ROWK
#undef VMW
#undef VMWN
#undef SLOAD_H
#undef SWRITE_HK
#undef SWRITE_HV
#undef SWRITE_H
#undef KSWZ
#undef SBAR
template <bool BIAS, bool BITMASK, int NH, int GROUP, bool PAIR, int QS, int KS, int OS>
__device__ __forceinline__ void attn_phase(char* lds, LAS unsigned char* ldsl, const bf16* Q, const bf16* K, const bf16* V, bf16* O, const float* fbias, const unsigned long long* mask, int G, int bid) {
    constexpr int NBLK = BATCH * NH * 16, NITEM = PAIR ? NBLK / 2 : NBLK, PER = PAIR ? 8 : 16, SETH = BATCH * NH / 8;
    for (int L = bid; L < NITEM; L += G) {
#pragma unroll 1
        for (int pass = 0; pass < (PAIR ? 2 : 1); ++pass) {
            const int g = L & 7, k = L >> 3, hs = k / PER, x = k % PER; const int bh = g * SETH + hs, b = bh / NH, h = bh % NH;
            const int qb = PAIR ? (pass ? 15 - x : x) : 15 - x; BlockRef r; const size_t row0 = (size_t)b * SEQ + (size_t)qb * QB;
            r.Q = Q + row0 * QS + h * D; r.O = O + row0 * OS + h * D; r.K = K + (size_t)b * SEQ * KS + (h / GROUP) * D; r.V = V + (size_t)b * SEQ * KS + (h / GROUP) * D; r.P0 = qb * QB;
            r.fb = BIAS ? fbias + (size_t)bh * SEQ : nullptr; r.mrow = BITMASK ? mask + row0 * 64 : nullptr;
            attn_block<BIAS, BITMASK, QS, KS, OS>(r, lds, ldsl);
        }
    }
}
}
__device__ __forceinline__ float fast_silu(float g) { return g * __builtin_amdgcn_rcpf(1.0f + __expf(-g)); }
__device__ __forceinline__ void ph_gla_a(Frame& F, const Args& a) {
    const float* SK0 = (const float*)(F.ws + WS_SK0); const float* w2 = a.in[2]; const float* gbias = a.in[3]; float* GB = (float*)(F.ws + WS_GB); float* DEC = (float*)(F.ws + WS_DEC);
    const bf16* PROJ = (const bf16*)(F.ws + WS_PROJ); bf16* CST = (bf16*)(F.ws + WS_CST);
    LAS float* BSH = (LAS float*)F.lds; LAS float* TOT = BSH + 64 * 128; LAS bf16* VT = (LAS bf16*)(F.lds + 36864); LAS bf16* KET = (LAS bf16*)(F.lds + 73728);
    const int tid = F.tid, lane = F.lane, l15 = lane & 15, quad = lane >> 4, w = F.wave;
    for (int unit = blockIdx.x; unit < 512; unit += F.G) {
        const int n = unit & 63, bh = unit >> 6, b = bh >> 2, h = bh & 3, t0 = b * SEQ + n * 64;
        __syncthreads();
        {
            const int d = tid & 127, cg = tid >> 7; float wv[16];
#pragma unroll
            for (int r = 0; r < 16; ++r) wv[r] = w2[r * 512 + h * 128 + d];
            const float gb = gbias[h * 128 + d]; float run = 0.f;
            for (int cc = 0; cc < 16; ++cc) { const int c = cg * 16 + cc; const float* sk = SK0 + (size_t)(t0 + c) * 24; float z = gb;
#pragma unroll
                for (int r = 0; r < 16; ++r) z += sk[r] * wv[r];
                run += logsigmoidf(z) * (1.0f / 16.0f); BSH[c * 128 + d] = run; }
            TOT[cg * 128 + d] = run;
            __syncthreads();
            float pre = 0.f;
            for (int g = 0; g < cg; ++g) pre += TOT[g * 128 + d];
            for (int cc = 0; cc < 16; ++cc) { const int c = cg * 16 + cc; const float v = BSH[c * 128 + d] + pre; BSH[c * 128 + d] = v; GB[(size_t)(t0 + c) * 512 + h * 128 + d] = v; }
        }
        __syncthreads();
        {
            const int c = tid & 63, g8 = tid >> 6; const size_t t = (size_t)(t0 + c);
            const bf16* kp = PROJ + t * NP0 + 512 + h * 128 + g8 * 16;
            const v4u k0 = *(const v4u*)kp, k1 = *(const v4u*)(kp + 8);
            const unsigned kw[8] = {k0.x, k0.y, k0.z, k0.w, k1.x, k1.y, k1.z, k1.w};
#pragma unroll
            for (int i = 0; i < 8; ++i) { const int d = g8 * 16 + 2 * i; const float e0 = __expf(BSH[63 * 128 + d] - BSH[c * 128 + d]), e1 = __expf(BSH[63 * 128 + d + 1] - BSH[c * 128 + d + 1]);
                KET[d * 72 + c] = (bf16)f2bf(bf2f(kw[i] & 0xffff) * e0); KET[(d + 1) * 72 + c] = (bf16)f2bf(bf2f(kw[i] >> 16) * e1); }
            const bf16* vp = PROJ + t * NP0 + 1024 + h * 256 + g8 * 32;
#pragma unroll
            for (int q = 0; q < 4; ++q) { const v4u vv = *(const v4u*)(vp + 8 * q); const unsigned vw[4] = {vv.x, vv.y, vv.z, vv.w};
#pragma unroll
                for (int i = 0; i < 4; ++i) { const int v = g8 * 32 + q * 8 + 2 * i; VT[v * 72 + c] = (bf16)(vw[i] & 0xffff); VT[(v + 1) * 72 + c] = (bf16)(vw[i] >> 16); } }
            if (tid < 128) DEC[unit * 128 + tid] = __expf(BSH[63 * 128 + tid]);
        }
        __syncthreads();
        {
            pg8::f32x4 acc[2][8];
#pragma unroll
            for (int i = 0; i < 2; ++i)
#pragma unroll
                for (int nn = 0; nn < 8; ++nn) acc[i][nn] = (pg8::f32x4){0.f, 0.f, 0.f, 0.f};
#pragma unroll
            for (int kk = 0; kk < 64; kk += 32) {
                const bf16x8 a0 = *(const LAS bf16x8*)(VT + (32 * w + l15) * 72 + kk + quad * 8), a1 = *(const LAS bf16x8*)(VT + (32 * w + 16 + l15) * 72 + kk + quad * 8);
#pragma unroll
                for (int nn = 0; nn < 8; ++nn) { const bf16x8 bb = *(const LAS bf16x8*)(KET + (16 * nn + l15) * 72 + kk + quad * 8);
                    acc[0][nn] = __builtin_amdgcn_mfma_f32_16x16x32_bf16(bb, a0, acc[0][nn], 0, 0, 0); acc[1][nn] = __builtin_amdgcn_mfma_f32_16x16x32_bf16(bb, a1, acc[1][nn], 0, 0, 0); } }
            bf16* cp = CST + (size_t)unit * 32768;
#pragma unroll
            for (int i = 0; i < 2; ++i)
#pragma unroll
                for (int nn = 0; nn < 8; ++nn) { uint2 o; o.x = pk2(acc[i][nn][0], acc[i][nn][1]); o.y = pk2(acc[i][nn][2], acc[i][nn][3]);
                    *(uint2*)(cp + (32 * w + 16 * i + l15) * 128 + 16 * nn + quad * 4) = o; }
        }
    }
    __syncthreads();
}
__device__ __forceinline__ void ph_gla_c(Frame& F, const Args& a) {
    const bf16* PROJ = (const bf16*)(F.ws + WS_PROJ); const float* GB = (const float*)(F.ws + WS_GB); const bf16* PREVT = (const bf16*)(F.ws + WS_PREVT); const float* normg = a.in[4]; bf16* OMIX = (bf16*)(F.ws + WS_OMIX);
    LAS bf16* QD = (LAS bf16*)(F.lds + 32768); LAS bf16* KI = (LAS bf16*)(F.lds + 50176); LAS bf16* P = (LAS bf16*)(F.lds + 67584); LAS bf16* VT = (LAS bf16*)(F.lds + 76800); LAS float* RED = (LAS float*)(F.lds + 113664);
    const int tid = F.tid, lane = F.lane, l15 = lane & 15, quad = lane >> 4, w = F.wave;
    for (int unit = blockIdx.x; unit < 512; unit += F.G) {
        const int n = unit & 63, bh = unit >> 6, b = bh >> 2, h = bh & 3, t0 = b * SEQ + n * 64;
        __syncthreads();
        {
            const int c = tid >> 3, dg = tid & 7; const size_t t = (size_t)(t0 + c);
            const float* bp = GB + t * 512 + h * 128 + dg * 16; const bf16* qp = PROJ + t * NP0 + h * 128 + dg * 16; const bf16* kp = PROJ + t * NP0 + 512 + h * 128 + dg * 16;
#pragma unroll
            for (int q8 = 0; q8 < 2; ++q8) { const v4u qq = *(const v4u*)(qp + 8 * q8), kk = *(const v4u*)(kp + 8 * q8); const f32x4 b0 = *(const f32x4*)(bp + 8 * q8), b1 = *(const f32x4*)(bp + 8 * q8 + 4);
                const unsigned qw[4] = {qq.x, qq.y, qq.z, qq.w}, kw[4] = {kk.x, kk.y, kk.z, kk.w}; const float bv[8] = {b0[0], b0[1], b0[2], b0[3], b1[0], b1[1], b1[2], b1[3]};
                v4u oq, ok; unsigned* oqp = (unsigned*)&oq; unsigned* okp = (unsigned*)&ok;
#pragma unroll
                for (int i = 0; i < 4; ++i) { const float e0 = __expf(bv[2 * i]), e1 = __expf(bv[2 * i + 1]);
                    oqp[i] = pk2(bf2f(qw[i] & 0xffff) * ATT_SCALE * e0, bf2f(qw[i] >> 16) * ATT_SCALE * e1);
                    okp[i] = pk2(bf2f(kw[i] & 0xffff) * __builtin_amdgcn_rcpf(e0), bf2f(kw[i] >> 16) * __builtin_amdgcn_rcpf(e1)); }
                *(LAS v4u*)(QD + c * 136 + dg * 16 + 8 * q8) = oq; *(LAS v4u*)(KI + c * 136 + dg * 16 + 8 * q8) = ok; }
            const int c2 = tid & 63, g8 = tid >> 6; const bf16* vp = PROJ + (size_t)(t0 + c2) * NP0 + 1024 + h * 256 + g8 * 32;
#pragma unroll
            for (int q = 0; q < 4; ++q) { const v4u vv = *(const v4u*)(vp + 8 * q); const unsigned vw[4] = {vv.x, vv.y, vv.z, vv.w};
#pragma unroll
                for (int i = 0; i < 4; ++i) { const int v = g8 * 32 + q * 8 + 2 * i; VT[v * 72 + c2] = (bf16)(vw[i] & 0xffff); VT[(v + 1) * 72 + c2] = (bf16)(vw[i] >> 16); } }
        }
        __syncthreads();
        {
            const int ti = w >> 1;
#pragma unroll
            for (int s = 0; s < 2; ++s) { const int tj = 2 * (w & 1) + s; pg8::f32x4 acc = (pg8::f32x4){0.f, 0.f, 0.f, 0.f};
                if (tj <= ti) {
#pragma unroll
                    for (int kk = 0; kk < 128; kk += 32) { const bf16x8 aa = *(const LAS bf16x8*)(QD + (16 * ti + l15) * 136 + kk + quad * 8), bb = *(const LAS bf16x8*)(KI + (16 * tj + l15) * 136 + kk + quad * 8);
                        acc = __builtin_amdgcn_mfma_f32_16x16x32_bf16(aa, bb, acc, 0, 0, 0); } }
#pragma unroll
                for (int j = 0; j < 4; ++j) { const int i = 16 * ti + quad * 4 + j, jj = 16 * tj + l15; P[i * 72 + jj] = (bf16)f2bf(jj <= i ? acc[j] : 0.f); } }
        }
        __syncthreads();
        {
            const int ti = w >> 1, half = w & 1; pg8::f32x4 acc[8];
#pragma unroll
            for (int nn = 0; nn < 8; ++nn) acc[nn] = (pg8::f32x4){0.f, 0.f, 0.f, 0.f};
#pragma unroll
            for (int kk = 0; kk < 64; kk += 32) { const bf16x8 aa = *(const LAS bf16x8*)(P + (16 * ti + l15) * 72 + kk + quad * 8);
#pragma unroll
                for (int nn = 0; nn < 8; ++nn) { const bf16x8 bb = *(const LAS bf16x8*)(VT + (128 * half + 16 * nn + l15) * 72 + kk + quad * 8); acc[nn] = __builtin_amdgcn_mfma_f32_16x16x32_bf16(bb, aa, acc[nn], 0, 0, 0); } }
            const bf16* pv = PREVT + (size_t)unit * 32768 + (size_t)(128 * half + l15) * 128 + quad * 8;
#pragma unroll
            for (int kk = 0; kk < 128; kk += 32) { const bf16x8 aa = *(const LAS bf16x8*)(QD + (16 * ti + l15) * 136 + kk + quad * 8);
#pragma unroll
                for (int nn = 0; nn < 8; ++nn) { const bf16x8 bb = *(const bf16x8*)(pv + (size_t)(16 * nn) * 128 + kk); acc[nn] = __builtin_amdgcn_mfma_f32_16x16x32_bf16(bb, aa, acc[nn], 0, 0, 0); } }
            float s = 0.f;
#pragma unroll
            for (int nn = 0; nn < 8; ++nn) s += (acc[nn][0] * acc[nn][0] + acc[nn][1] * acc[nn][1]) + (acc[nn][2] * acc[nn][2] + acc[nn][3] * acc[nn][3]);
            s += __shfl_xor(s, 16); s += __shfl_xor(s, 32);
            if (quad == 0) RED[(16 * ti + l15) * 2 + half] = s;
            __syncthreads();
            const int i = 16 * ti + l15; const float ms = (RED[i * 2] + RED[i * 2 + 1]) * (1.0f / 256.0f); const float rs = 1.0f / sqrtf(ms + LN_EPS);
            const size_t t = (size_t)(t0 + i);
#pragma unroll
            for (int nn = 0; nn < 8; ++nn) { const int v = 128 * half + 16 * nn + quad * 4; const uint2 gr = *(const uint2*)(PROJ + t * NP0 + 2048 + h * 256 + v); const f32x4 ng = *(const f32x4*)(normg + v);
                uint2 o; o.x = pg8::cvt_pk_bf16(acc[nn][0] * rs * ng[0] * fast_silu(bf2f(gr.x & 0xffff)), acc[nn][1] * rs * ng[1] * fast_silu(bf2f(gr.x >> 16)));
                o.y = pg8::cvt_pk_bf16(acc[nn][2] * rs * ng[2] * fast_silu(bf2f(gr.y & 0xffff)), acc[nn][3] * rs * ng[3] * fast_silu(bf2f(gr.y >> 16)));
                *(uint2*)(OMIX + t * DM + h * 256 + v) = o; }
        }
    }
    __syncthreads();
}
__device__ __forceinline__ void ph_indexer(Frame& F, unsigned char* lds_generic) {
    typedef float f32x16 __attribute__((ext_vector_type(16)));
    const bf16* PROJ1 = (const bf16*)(F.ws + WS_PROJ); const bf16* IK = (const bf16*)(F.ws + WS_IK); const float* IW = (const float*)(F.ws + WS_IW); unsigned long long* MASK = (unsigned long long*)(F.ws + WS_MASK);
    LAS float* SCL = (LAS float*)F.lds;
    const int lane = F.lane, w = F.wave, c32 = lane & 31, hi = lane >> 5, rt = w & 3, kpar = w >> 2;
    for (int it = blockIdx.x; it < 512; it += F.G) {
#pragma unroll 1
        for (int pass = 0; pass < 2; ++pass) {
            const int unit = pass ? 1023 - it : it, m0 = unit * 8, b = m0 >> 12, qmax = (m0 & 4095) + 7;
            __syncthreads();
            {
                const int qa = m0 + 2 * rt + ((c32 >> 2) & 1), ha = (c32 & 3) + 4 * (c32 >> 3);
                const bf16* ap = PROJ1 + (size_t)qa * NP1 + 3072 + ha * 64 + 8 * hi;
                bf16x8 af[4];
#pragma unroll
                for (int ks = 0; ks < 4; ++ks) af[ks] = *(const bf16x8*)(ap + 16 * ks);
                const float* wp = IW + (size_t)(m0 + 2 * rt + hi) * 16; float wv[16];
#pragma unroll
                for (int q4 = 0; q4 < 4; ++q4) { const f32x4 t4 = *(const f32x4*)(wp + 4 * q4); wv[4 * q4] = t4[0]; wv[4 * q4 + 1] = t4[1]; wv[4 * q4 + 2] = t4[2]; wv[4 * q4 + 3] = t4[3]; }
                LAS float* srow = SCL + (2 * rt + hi) * 4096 + c32;
                const bf16* kbase = IK + (size_t)b * SEQ * 64 + (size_t)lane * 8;
                bf16x8 bn[4];
#pragma unroll
                for (int ks = 0; ks < 4; ++ks) bn[ks] = *(const bf16x8*)(kbase + (size_t)(kpar * 4 + ks) * 512);
                for (int t = kpar; t * 32 <= qmax; t += 2) {
                    bf16x8 bc[4];
#pragma unroll
                    for (int ks = 0; ks < 4; ++ks) bc[ks] = bn[ks];
                    const int tn = (t + 2) * 32 <= qmax ? t + 2 : t;
#pragma unroll
                    for (int ks = 0; ks < 4; ++ks) bn[ks] = *(const bf16x8*)(kbase + (size_t)(tn * 4 + ks) * 512);
                    f32x16 acc = {};
#pragma unroll
                    for (int ks = 0; ks < 4; ++ks) acc = __builtin_amdgcn_mfma_f32_32x32x16_bf16(af[ks], bc[ks], acc, 0, 0, 0);
                    float s = 0.f;
#pragma unroll
                    for (int r = 0; r < 16; ++r) s += wv[r] * fmaxf(acc[r], 0.f);
                    srow[t * 32] = s; }
            }
            __syncthreads();
            { const int m = m0 + w; topk_mask_row((const LAS float*)(F.lds + w * 16384), m & 4095, MASK + (size_t)m * 64, lane, (LAS unsigned*)(F.lds + LDSCTL_OFF + 4096 + w * 1024)); }
        }
    }
    __syncthreads();
}
#define IN(k) (lo <= (k) && (k) < hi)
#define SEAM(k) do { if (hi > (k) + 1) xcd_barrier(bar); } while (0)
template <int LAYER, int BASE>
__device__ __forceinline__ void common_phases(Frame& F, const Args& args, const int lo, const int hi, const XcdBarrier& bar) {
    unsigned char* ws = args.ws;
    if (IN(BASE + 0)) {
        pg8::Gemm g{(const bf16*)(ws + WS_OMIX), (const bf16*)(ws + (LAYER ? WS_WOC : WS_WOA)), MTOK, DM, DM, DM, DM}; pg8::StaticOrder S; S.init(MTOK, DM, F.G, (int)blockIdx.x);
        pg8::EpiResid E{(const bf16*)(ws + WS_XB), (bf16*)(ws + WS_YB), DN_ALPHA};
        pg8::gemm_phase<pg8::EpiResid, pg8::StaticOrder, true, true>(F.lds, g, S, E);
        SEAM(BASE + 0);
    }
    if (IN(BASE + 1)) { p_ln_route(F, args, LAYER); SEAM(BASE + 1); }
    if (IN(BASE + 3) || IN(BASE + 4) || IN(BASE + 5)) {
        if (F.wave == 0) { int ti; (void)moe_offsets(F.ctl + CW_CNT + LAYER * 64, F.lane, &ti); if (F.lane < 32) { F.MISC[64 + F.lane] = (unsigned)ti; F.MISC[160 + F.lane] = F.ctl[CW_CNT + LAYER * 64 + F.lane]; } if (F.lane == 31) F.MISC[96] = (unsigned)ti; }
        __syncthreads();
    }
    {
        const int Tm = (int)F.MISC[96], T1 = F.G / 4 < Tm ? F.G / 4 : Tm;
        const int n2 = (Tm - T1) * 4;
        const pg8::Gemm gU{(const bf16*)(ws + WS_XB), (const bf16*)(ws + WS_WGU) + (size_t)LAYER * 32 * 1024 * 2048, RPAD, 32 * 1024, DM, DM, DM};
        const pg8::Gemm gD{(const bf16*)(ws + WS_OMIX), (const bf16*)(ws + WS_WD) + (size_t)LAYER * 32 * 2048 * 512, RPAD, 32 * 2048, 512, 512, 512};
        const PG8_LAS int* tend = (const LAS int*)(F.lds + LDSCTL_OFF + 64 * 4); const PG8_LAS int* ecnt = (const LAS int*)(F.lds + LDSCTL_OFF + 160 * 4);
        const int* inv = (const int*)(ws + WS_INV);
        const pg8::EpiGLU EU{(bf16*)(ws + WS_OMIX), (const float*)(ws + WS_WINV)}; const pg8::EpiBf16Plain ED{(bf16*)(ws + WS_CST), DM, 7};
        if (IN(BASE + 3)) {
            pg8::MoeOrder S{F.G, (int)blockIdx.x, 4, 0, T1 * 4, (T1 * 4 == F.G && (F.G & 7) == 0) ? 2 : 0, tend, ecnt};
            pg8::gemm_phase_g<pg8::EpiGLU, pg8::MoeOrder>(F.lds, gU, S, EU, inv);
            SEAM(BASE + 3);
        }
        if (IN(BASE + 4)) {
            if ((int)blockIdx.x < n2) { pg8::MoeOrder S{n2, (int)blockIdx.x, 4, T1 * 4, Tm * 4, 0, tend, ecnt}; pg8::gemm_phase_g<pg8::EpiGLU, pg8::MoeOrder>(F.lds, gU, S, EU, inv); }
            else { pg8::MoeOrder S{F.G - n2, (int)blockIdx.x - n2, 8, 0, T1 * 8, 0, tend, ecnt}; pg8::gemm_phase<pg8::EpiBf16Plain, pg8::MoeOrder, true, true>(F.lds, gD, S, ED); }
            if (LAYER == 0) late_conv_items(F, args, CONV_SPLIT, CONV_LATE_ITEMS, 1);
            SEAM(BASE + 4);
        }
        if (IN(BASE + 5)) {
            pg8::MoeOrder S{F.G, (int)blockIdx.x, 8, T1 * 8, Tm * 8, 0, tend, ecnt};
            pg8::gemm_phase<pg8::EpiBf16Plain, pg8::MoeOrder, true, true>(F.lds, gD, S, ED);
            if (LAYER == 0) late_conv_items(F, args, CONV_SPLIT, CONV_LATE_ITEMS, 1);
            SEAM(BASE + 5);
        }
    }
    if (IN(BASE + 6)) { p_ln_ffn(F, args, LAYER); SEAM(BASE + 6); }
}
__global__ void __launch_bounds__(NWAVES * 64, 2) mk_fwd(Args args) {
    extern __shared__ __attribute__((aligned(16))) unsigned char lds[];
    Frame F;
    F.lds = (LAS unsigned char*)lds; F.MISC = (volatile LAS unsigned*)(F.lds + LDSCTL_OFF);
    F.tid = threadIdx.x; F.lane = F.tid & 63; F.wave = __builtin_amdgcn_readfirstlane(F.tid >> 6);
    F.G = gridDim.x; F.gw = blockIdx.x * NWAVES + F.wave; F.NGW = F.G * NWAVES;
    F.ws = args.ws; F.ctl = (unsigned*)(args.ws + WS_CTL);
    for (int u = F.tid; u < (LDS_BYTES - LDSCTL_OFF) / 4; u += NWAVES * 64) ((LAS unsigned*)(F.lds + LDSCTL_OFF))[u] = 0u;
    __syncthreads();
    const int lo = args.ph_lo, hi = args.ph_hi;
    XcdBarrier bar; bar.bar = F.ctl + CW_BAR + args.bar_region * XCD_BAR_WORDS; bar.x = 0; bar.st = nullptr;
    if (hi - lo > 1) bar = xcd_barrier_post(F.ctl + CW_BAR + args.bar_region * XCD_BAR_WORDS, F.MISC);
    unsigned char* ws = args.ws;

    if (IN(0)) { p0_prologue(F, args); SEAM(0); }
    if (IN(1)) {
        pg8::Gemm g{(const bf16*)(ws + WS_XB), (const bf16*)(ws + WS_WINA), MTOK, NP0, DM, DM, DM}; pg8::StaticOrder S; S.init(MTOK, NP0, F.G, (int)blockIdx.x);
        pg8::EpiBf16Plain E{(bf16*)(ws + WS_PROJ), NP0, 0x7fffffff};
        pg8::gemm_phase<pg8::EpiBf16Plain, pg8::StaticOrder, true, true>(F.lds, g, S, E);
        p_skinny0(F, args);
        SEAM(1);
    }
    if (IN(2)) { p_fox_bias(F, args); ph_gla_a(F, args); SEAM(2); }
    if (IN(4)) { ph_gla_scan(F); __syncthreads();
        attn::attn_phase<true, false, 8, 1, false, NP0, NP0, DM>((char*)lds, F.lds, (const bf16*)(ws + WS_PROJ) + 3072, (const bf16*)(ws + WS_PROJ) + 4096, (const bf16*)(ws + WS_PROJ) + 5120,
                                                               (bf16*)(ws + WS_OMIX) + 1024, (const float*)(ws + WS_FBIAS), (const unsigned long long*)nullptr, F.G, (int)blockIdx.x);
        late_conv_items(F, args, CONV_STATIC, CONV_SPLIT, 0);
        SEAM(4); }
    if (IN(5)) { ph_gla_c(F, args); SEAM(5); }
    common_phases<0, 6>(F, args, lo, hi, bar);
    if (IN(13)) {
        pg8::Gemm g{(const bf16*)(ws + WS_XB), (const bf16*)(ws + WS_WINC), MTOK, NP1, DM, DM, DM}; pg8::StaticOrder S; S.init(MTOK, NP1, F.G, (int)blockIdx.x);
        const float* c128 = (const float*)(ws + WS_ROPE);
        pg8::EpiRope E{(bf16*)(ws + WS_PROJ), c128, c128 + 4096 * 64, c128 + 2 * 4096 * 64, c128 + 2 * 4096 * 64 + 4096 * 32};
        pg8::gemm_phase<pg8::EpiRope, pg8::StaticOrder, true, true>(F.lds, g, S, E);
        SEAM(13);
    }
    if (IN(14)) { ph_indexer(F, lds); SEAM(14); }
    if (IN(16)) {
        attn::attn_phase<false, true, 16, 4, true, NP1, NP1, DM>((char*)lds, F.lds, (const bf16*)(ws + WS_PROJ), (const bf16*)(ws + WS_PROJ) + 2048, (const bf16*)(ws + WS_PROJ) + 2560,
                                                               (bf16*)(ws + WS_OMIX), (const float*)nullptr, (const unsigned long long*)(ws + WS_MASK), F.G, (int)blockIdx.x);
        SEAM(16); }
    common_phases<1, 17>(F, args, lo, hi, bar);
#ifdef PROBE_CONV
    if (IN(31)) {
        LAS bf16* T = (LAS bf16*)(F.lds + F.wave * 16384); bf16* dstb = (bf16*)(ws + WS_SC); float sink = 0.f;
        for (int it = F.gw; it < 32 * 256; it += F.NGW) {
            const int ex = 32 + it / 256, r = it % 256, kb = r / 8, nb = r % 8;
            TrItem t{args.in[17] + (size_t)ex * 2048 * 512, dstb + (size_t)(it / 256) * 512 * 2048, 512, nb * 64, nb * 64 + 32, 2048, nb * 64, kb * 64};
            f32x4 r16[16]; tr64_load(t, r16, F.lane);
            if (PROBE_CONV == 0) tr64_store(t, r16, T, F.lane);
            else if (PROBE_CONV == 1) {
#pragma unroll
                for (int i = 0; i < 8; ++i) { uint2 o; o.x = pg8::cvt_pk_bf16(r16[2 * i][0], r16[2 * i][1]); o.y = pg8::cvt_pk_bf16(r16[2 * i][2], r16[2 * i][3]); uint2 p; p.x = pg8::cvt_pk_bf16(r16[2 * i + 1][0], r16[2 * i + 1][1]); p.y = pg8::cvt_pk_bf16(r16[2 * i + 1][2], r16[2 * i + 1][3]);
                    bf16* d = dstb + (size_t)(it / 256) * 512 * 2048 + (size_t)(kb * 64 + 8 * i + 2 * (F.lane >> 4)) * 512 + nb * 64 + 4 * (F.lane & 15); *(uint2*)d = o; *(uint2*)(d + 512) = p; } }
            else {
#pragma unroll
                for (int i = 0; i < 16; ++i) sink += r16[i][0] + r16[i][3]; }
        }
        if (PROBE_CONV == 2 && sink == 12345.678f) dstb[F.tid] = 1;
    }
#endif
#ifdef PROBE_GEMM_K
    if (IN(30)) {
        pg8::Gemm g{(const bf16*)(ws + WS_XB), (const bf16*)(ws + WS_WINA), MTOK, NP0, PROBE_GEMM_K, PROBE_GEMM_LD, PROBE_GEMM_LD}; pg8::StaticOrder S; S.init(MTOK, NP0, F.G, (int)blockIdx.x);
        pg8::EpiBf16Plain E{(bf16*)(ws + WS_SC), NP0, 0x7fffffff};
        pg8::gemm_phase<pg8::EpiBf16Plain, pg8::StaticOrder, true, true>(F.lds, g, S, E);
    }
#endif
}
#undef IN
#undef SEAM
constexpr int N_PHASE_IDS = 24;
static void launch_mk(const Args& base, int lo, int hi, int grid, hipStream_t stream, int region = 0) {
    Args a = base; a.ph_lo = lo; a.ph_hi = hi; a.bar_region = region; a.pad = 0;
    hipLaunchKernelGGL(mk_fwd, dim3(grid), dim3(NWAVES * 64), LDS_BYTES, stream, a);
}
extern "C" void kernel_launch(void* const* d_in, const int* in_sizes, int n_in, void* d_out, int out_size, void* d_ws, size_t ws_size, hipStream_t stream) {
    static int grid = 0;
    if (grid == 0) {
        if (n_in != 20 || out_size != MTOK * DM || ws_size < WS_END) { fprintf(stderr, "kernel_launch: unexpected shapes (n_in %d, out %d, ws %zu < %zu)\n", n_in, out_size, ws_size, (size_t)WS_END); grid = -1; return; }
        int dev = 0, cus = 0, per_cu = 0;
        if (hipGetDevice(&dev) != hipSuccess || hipDeviceGetAttribute(&cus, hipDeviceAttributeMultiprocessorCount, dev) != hipSuccess) { grid = -1; return; }
        if (hipFuncSetAttribute((const void*)mk_fwd, hipFuncAttributeMaxDynamicSharedMemorySize, LDS_BYTES) != hipSuccess) { fprintf(stderr, "kernel_launch: hipFuncSetAttribute failed\n"); grid = -1; return; }
        if (hipOccupancyMaxActiveBlocksPerMultiprocessor(&per_cu, (const void*)mk_fwd, NWAVES * 64, LDS_BYTES) != hipSuccess || per_cu < 1) { fprintf(stderr, "kernel_launch: occupancy query reports %d workgroups per CU\n", per_cu); }
        (void)hipGetLastError();
        grid = cus;
    }
    if (grid < 0) return;
    (void)in_sizes;
    if (hipMemsetAsync((char*)d_ws + WS_CTL, 0, CTL_ZERO_BYTES, stream) != hipSuccess) return;
    Args a{};
    for (int i = 0; i < 20; ++i) a.in[i] = (const float*)d_in[i];
    a.out = (float*)d_out; a.ws = (unsigned char*)d_ws;
#ifdef PROBE_LO
    launch_mk(a, 0, PROBE_HI + 1, grid, stream, 0); launch_mk(a, PROBE_LO, N_PHASE_IDS, grid, stream, 1);
#else
    launch_mk(a, 0, N_PHASE_IDS, grid, stream);
#endif
#ifdef PROBE_GEMM_K
    launch_mk(a, 30, 31, grid, stream, 2);
#endif
#ifdef PROBE_CONV
    launch_mk(a, 31, 32, grid, stream, 2);
#endif
}
```

```cpp
#include <hip/hip_runtime.h>
#include <cstdio>
#include <cstdint>
namespace pg8 {
#define PG8_LAS __attribute__((address_space(3)))
typedef unsigned short bf16_t;
typedef short bf16x8 __attribute__((ext_vector_type(8)));
typedef float f32x4 __attribute__((ext_vector_type(4)));
typedef unsigned u32x4 __attribute__((ext_vector_type(4)));
constexpr int BM = 256, BK = 64, HALF = 128, HTB = HALF * BK * 2  , STAGE_BYTES = 8 * HTB, NXCD = 8, WGM = 8;

__host__ __device__ __forceinline__ int lds_byte(int r, int c) { const int st = (r >> 4) * 2 + (c >> 5), rr = r & 15, cc = c & 31, ob = rr * 64 + cc * 2; return st * 1024 + (ob ^ (((ob >> 9) & 1) << 5)); }
__host__ __device__ __forceinline__ void stage_rc(int b, int& R, int& C) { const int st = b / 1024, sb = b % 1024, swz = sb ^ (((sb >> 9) & 1) << 5); R = (st >> 1) * 16 + swz / 64; C = (st & 1) * 32 + (swz % 64) / 2; }
__host__ __device__ __forceinline__ int perm32(int rho) { const int n = rho >> 4, i = rho & 15; return 8 * (i >> 2) + 4 * n + (i & 3); }

struct Unit { int pm, pn, inv0, nvalid, half; };
struct Gemm { const bf16_t* A; const bf16_t* Bt; int M, N, K, lda, ldb; };

struct StaticOrder {
    int nM, nN, nwg, G, c;
    __host__ __device__ void init(int M, int N, int G_, int c_) { nM = M / BM; nN = N / BM; nwg = nM * nN; G = G_; c = c_; }
    __host__ __device__ bool next(int i, Unit& u) const {
        const long L = (long)i * G + c; if (L >= nwg) return false;
        int wgid = (int)L; { const int q = nwg / NXCD, r = nwg % NXCD, xcd = wgid % NXCD, off = wgid / NXCD; wgid = (xcd < r ? xcd * (q + 1) : r * (q + 1) + (xcd - r) * q) + off; }
        const int nig = WGM * nN, gid = wgid / nig, fm = gid * WGM, gsz = (nM - fm) < WGM ? (nM - fm) : WGM;
        u.pm = fm + ((wgid % nig) % gsz); u.pn = (wgid % nig) / gsz; return true;
    }
    __device__ __forceinline__ void a_ready(const Unit&) const {}
    __device__ __forceinline__ void done(const Unit&) const {}
};

__device__ __forceinline__ unsigned cvt_pk_bf16(float lo, float hi) { unsigned r; asm volatile("v_cvt_pk_bf16_f32 %0, %1, %2" : "=v"(r) : "v"(lo), "v"(hi)); return r; }
typedef float f32x2 __attribute__((ext_vector_type(2)));
struct EpiBf16Plain {
    static constexpr bool PERM = true, AFTER_DRAIN = false;
    bf16_t* O; int ldc; int pn_mask;
    __device__ __forceinline__ void operator()(const f32x4 (&acc)[2][2][4][2], const Unit& u, int wr, int wc, int fr, int fq) const {
        const int row0 = u.pm * BM + wr * 64 + fr, col0 = (u.pn & pn_mask) * BM + wc * 32 + 8 * fq;
#pragma unroll
        for (int ai = 0; ai < 2; ++ai)
#pragma unroll
            for (int m = 0; m < 4; ++m) { bf16_t* rowp = O + (size_t)(row0 + ai * HALF + m * 16) * ldc + col0;
#pragma unroll
                for (int bj = 0; bj < 2; ++bj) { const f32x4 v0 = acc[ai][bj][m][0], v1 = acc[ai][bj][m][1];
                    u32x4 w; w.x = cvt_pk_bf16(v0[0], v0[1]); w.y = cvt_pk_bf16(v0[2], v0[3]); w.z = cvt_pk_bf16(v1[0], v1[1]); w.w = cvt_pk_bf16(v1[2], v1[3]);
                    *(u32x4*)(rowp + bj * HALF) = w; } }
    }
};
struct EpiResid {
    static constexpr bool PERM = true, AFTER_DRAIN = false;
    const bf16_t* base; bf16_t* out; float alpha;
    __device__ __forceinline__ void operator()(const f32x4 (&acc)[2][2][4][2], const Unit& u, int wr, int wc, int fr, int fq) const {
        const int row0 = u.pm * BM + wr * 64 + fr, col0 = u.pn * BM + wc * 32 + 8 * fq;
#pragma unroll
        for (int ai = 0; ai < 2; ++ai)
#pragma unroll
            for (int m = 0; m < 4; ++m) { const size_t off = (size_t)(row0 + ai * HALF + m * 16) * 2048 + col0;
#pragma unroll
                for (int bj = 0; bj < 2; ++bj) { const u32x4 b = *(const u32x4*)(base + off + bj * HALF); const f32x4 v0 = acc[ai][bj][m][0], v1 = acc[ai][bj][m][1];
                    const unsigned bw[4] = {b.x, b.y, b.z, b.w}; u32x4 w; unsigned* wp = (unsigned*)&w;
#pragma unroll
                    for (int q = 0; q < 4; ++q) { const float lo = __builtin_bit_cast(float, bw[q] << 16), hi = __builtin_bit_cast(float, bw[q] & 0xffff0000u);
                        const float a0 = q < 2 ? v0[2 * q] : v1[2 * q - 4], a1 = q < 2 ? v0[2 * q + 1] : v1[2 * q - 3];
                        wp[q] = cvt_pk_bf16(lo * alpha + a0, hi * alpha + a1); }
                    *(u32x4*)(out + off + bj * HALF) = w; } }
    }
};
struct EpiGLU {
    static constexpr bool PERM = true, AFTER_DRAIN = false;
    bf16_t* H; const float* winv;
    __device__ __forceinline__ void operator()(const f32x4 (&acc)[2][2][4][2], const Unit& u, int wr, int wc, int fr, int fq) const {
        const int row0 = u.pm * BM + wr * 64 + fr, f0 = (u.pn & 3) * 128 + wc * 32 + 8 * fq;
#pragma unroll
        for (int ai = 0; ai < 2; ++ai) { if (u.half >= 0 && u.half != ai) continue;
#pragma unroll
            for (int m = 0; m < 4; ++m) { const int row = row0 + ai * HALF + m * 16; const float w = winv[u.inv0 + ai * HALF + wr * 64 + m * 16 + fr];
                float h[8];
#pragma unroll
                for (int n = 0; n < 2; ++n)
#pragma unroll
                    for (int e = 0; e < 4; ++e) { const float g = acc[ai][0][m][n][e], up = acc[ai][1][m][n][e]; h[n * 4 + e] = g * __builtin_amdgcn_rcpf(1.0f + __expf(-g)) * up * w; }
                u32x4 o; o.x = cvt_pk_bf16(h[0], h[1]); o.y = cvt_pk_bf16(h[2], h[3]); o.z = cvt_pk_bf16(h[4], h[5]); o.w = cvt_pk_bf16(h[6], h[7]);
                *(u32x4*)(H + (size_t)row * 512 + f0) = o; } }
    }
};
struct EpiRope {
    static constexpr bool PERM = true, AFTER_DRAIN = false;
    bf16_t* O; const float* c128; const float* s128; const float* c64; const float* s64;
    __device__ __forceinline__ void operator()(const f32x4 (&acc)[2][2][4][2], const Unit& u, int wr, int wc, int fr, int fq) const {
        const int row0 = u.pm * BM + wr * 64 + fr, jj = wc * 32 + 8 * fq;
        const int pn = u.pn;
        if (pn == 10 || pn == 11) {
#pragma unroll
            for (int ai = 0; ai < 2; ++ai)
#pragma unroll
                for (int m = 0; m < 4; ++m) { bf16_t* rowp = O + (size_t)(row0 + ai * HALF + m * 16) * 4096 + pn * 256 + jj;
#pragma unroll
                    for (int bj = 0; bj < 2; ++bj) { const f32x4 v0 = acc[ai][bj][m][0], v1 = acc[ai][bj][m][1];
                        u32x4 w; w.x = cvt_pk_bf16(v0[0], v0[1]); w.y = cvt_pk_bf16(v0[2], v0[3]); w.z = cvt_pk_bf16(v1[0], v1[1]); w.w = cvt_pk_bf16(v1[2], v1[3]);
                        *(u32x4*)(rowp + bj * HALF) = w; } }
            return;
        }
        const bool idx = pn >= 12;
        const int half = idx ? 32 : 64;
        const int hl = idx ? (jj >> 5) : (jj >> 6), i0 = jj & (half - 1);
        const int colbase = idx ? (3072 + ((pn - 12) * 4 + hl) * 64) : (pn * 256 + hl * 128);
        const float* ct = idx ? c64 : c128; const float* st = idx ? s64 : s128;
#pragma unroll
        for (int ai = 0; ai < 2; ++ai)
#pragma unroll
            for (int m = 0; m < 4; ++m) { const int row = row0 + ai * HALF + m * 16; const int pos = row & 4095;
                const float* cp = ct + (size_t)pos * half + i0; const float* sp = st + (size_t)pos * half + i0;
                const f32x4 c0 = *(const f32x4*)cp, c1 = *(const f32x4*)(cp + 4), s0 = *(const f32x4*)sp, s1 = *(const f32x4*)(sp + 4);
                const f32x4 a0 = acc[ai][0][m][0], a1 = acc[ai][0][m][1], b0 = acc[ai][1][m][0], b1 = acc[ai][1][m][1];
                const f32x4 x0 = a0 * c0 - b0 * s0, x1 = a1 * c1 - b1 * s1, y0 = b0 * c0 + a0 * s0, y1 = b1 * c1 + a1 * s1;
                bf16_t* rowp = O + (size_t)row * 4096 + colbase + i0;
                u32x4 w; w.x = cvt_pk_bf16(x0[0], x0[1]); w.y = cvt_pk_bf16(x0[2], x0[3]); w.z = cvt_pk_bf16(x1[0], x1[1]); w.w = cvt_pk_bf16(x1[2], x1[3]);
                *(u32x4*)rowp = w;
                u32x4 z; z.x = cvt_pk_bf16(y0[0], y0[1]); z.y = cvt_pk_bf16(y0[2], y0[3]); z.z = cvt_pk_bf16(y1[0], y1[1]); z.w = cvt_pk_bf16(y1[2], y1[3]);
                *(u32x4*)(rowp + half) = z; }
    }
};
struct MoeOrder {
    int G, c, ntn, L0, Lend, hsplit; const PG8_LAS int* tend; const PG8_LAS int* cnt;
    __device__ __forceinline__ bool next(int i, Unit& u) const {
        int Lx = L0 + i * G + c; if (Lx >= Lend) return false;
        if (hsplit == 2) { const int x = c & 7, s = c >> 3; Lx = L0 + ((x >> 2) * (G >> 3) + s) * ntn + (x & 3); }
        const int L = hsplit == 1 ? Lx >> 1 : Lx;
        const int t = L / ntn; int e = 0;
#pragma unroll 1
        for (int k = 0; k < 32; ++k) e += (t >= tend[k]) ? 1 : 0;
        const int p0 = (t - (e ? tend[e - 1] : 0)) * BM, left = cnt[e] - p0;
        u.pm = t; u.pn = e * ntn + (L - t * ntn); u.inv0 = e * 8192 + p0; u.nvalid = left < BM ? left : BM; u.half = hsplit == 1 ? (Lx & 1) : -1; return true;
    }
    __device__ __forceinline__ void a_ready(const Unit&) const {}
    __device__ __forceinline__ void done(const Unit&) const {}
};
template <class Epi, class Sched, bool ALIGN_EPI = false, bool SP2 = false>
__device__ __forceinline__ void gemm_phase(PG8_LAS unsigned char* lds, const Gemm g, const Sched& S, const Epi& E) {
    const int tid = threadIdx.x, wid = __builtin_amdgcn_readfirstlane(tid >> 6), lane = tid & 63, wr = wid >> 2, wc = wid & 3, fr = lane & 15, fq = lane >> 4;
    const int K = g.K, nt = K / BK;
    unsigned voffA[2], voffB[2];
#pragma unroll
    for (int i = 0; i < 2; ++i) { int R, C; stage_rc(tid * 16 + i * 8192, R, C); const int Rb = Epi::PERM ? ((R & ~31) + perm32(R & 31)) : R;
        voffA[i] = (unsigned)(R * g.lda + C) * 2u; voffB[i] = (unsigned)(Rb * g.ldb + C) * 2u; }
    const size_t kstep = (size_t)(BK * 2);
    const size_t hstepA = (size_t)HALF * g.lda * 2, hstepB = (size_t)HALF * g.ldb * 2;
    const size_t tstepA = 2 * hstepA, tstepB = 2 * hstepB;
    const unsigned ldsw = (unsigned)wid * 1024u;
    const int aoff = lds_byte(wr * 64 + fr, fq * 8), boff = lds_byte(wc * 32 + fr, fq * 8);
#define PG8_SA(b, h) (((b) * 2 + (h)) * HTB)
#define PG8_SB(b, h) ((4 + (b) * 2 + (h)) * HTB)
#define PG8_STAGE(bufoff, gbase, voff) do { _Pragma("unroll") for (int _i = 0; _i < 2; ++_i) \
        __builtin_amdgcn_global_load_lds((const unsigned*)((const char*)(gbase) + (voff)[_i]), (PG8_LAS unsigned*)(lds + (bufoff) + ldsw + _i * 8192), 16, 0, 0); } while (0)
#define PG8_LDA(dst, b, h) do { _Pragma("unroll") for (int m = 0; m < 4; ++m) _Pragma("unroll") for (int k = 0; k < 2; ++k) dst[m][k] = *(const PG8_LAS bf16x8*)(lds + PG8_SA(b, h) + aoff + m * 2048 + k * 1024); } while (0)
#define PG8_LDB(dst, b, h) do { _Pragma("unroll") for (int n = 0; n < 2; ++n) _Pragma("unroll") for (int k = 0; k < 2; ++k) dst[n][k] = *(const PG8_LAS bf16x8*)(lds + PG8_SB(b, h) + boff + n * 2048 + k * 1024); } while (0)
#define PG8_MMA(ai, bj, At, Bt) do { __builtin_amdgcn_s_setprio(1); _Pragma("unroll") for (int m = 0; m < 4; ++m) _Pragma("unroll") for (int n = 0; n < 2; ++n) _Pragma("unroll") for (int k = 0; k < 2; ++k) \
        acc[ai][bj][m][n] = __builtin_amdgcn_mfma_f32_16x16x32_bf16(Bt[n][k], At[m][k], acc[ai][bj][m][n], 0, 0, 0); __builtin_amdgcn_s_setprio(0); } while (0)
#define PG8_WAIT_V(n) asm volatile("s_waitcnt vmcnt(" #n ")" ::: "memory")
#define PG8_WAIT_L(n) asm volatile("s_waitcnt lgkmcnt(" #n ")" ::: "memory")
#define PG8_BAR __builtin_amdgcn_s_barrier()
#define PG8_SCHED __builtin_amdgcn_sched_barrier(0)
    Unit cur, nxt; int ui = 0;
    if (!S.next(0, cur)) return;
    f32x4 acc[2][2][4][2];
#pragma unroll
    for (int a = 0; a < 2; ++a)
#pragma unroll
        for (int b = 0; b < 2; ++b)
#pragma unroll
            for (int m = 0; m < 4; ++m)
#pragma unroll
                for (int n = 0; n < 2; ++n) acc[a][b][m][n] = (f32x4){0.f, 0.f, 0.f, 0.f};
    bf16x8 At[4][2], B0[2][2], B1[2][2];
    const char* cA = (const char*)g.A + (size_t)cur.pm * tstepA; const char* cB = (const char*)g.Bt + (size_t)cur.pn * tstepB;
    S.a_ready(cur);
    if constexpr (SP2) {
        PG8_STAGE(PG8_SB(0, 0), cB, voffB); PG8_STAGE(PG8_SB(0, 1), cB + hstepB, voffB); PG8_STAGE(PG8_SA(0, 0), cA, voffA); PG8_STAGE(PG8_SA(0, 1), cA + hstepA, voffA);
        if (wr == 1) PG8_BAR;
        PG8_WAIT_V(2); PG8_BAR;
        PG8_STAGE(PG8_SB(1, 0), cB + kstep, voffB); PG8_STAGE(PG8_SA(1, 0), cA + kstep, voffA); PG8_STAGE(PG8_SB(1, 1), cB + hstepB + kstep, voffB);
        PG8_WAIT_V(6); PG8_BAR;
    } else {
        PG8_STAGE(PG8_SB(0, 0), cB, voffB); PG8_STAGE(PG8_SA(0, 0), cA, voffA); PG8_STAGE(PG8_SB(0, 1), cB + hstepB, voffB); PG8_STAGE(PG8_SA(0, 1), cA + hstepA, voffA);
        if (wr == 1) PG8_BAR;
        PG8_WAIT_V(4); PG8_BAR;
        PG8_STAGE(PG8_SB(1, 0), cB + kstep, voffB); PG8_STAGE(PG8_SA(1, 0), cA + kstep, voffA); PG8_STAGE(PG8_SB(1, 1), cB + hstepB + kstep, voffB);
        PG8_WAIT_V(6); PG8_BAR;
    }
    for (;;) {
        const bool has_next = S.next(ui + 1, nxt);
        const char* nA = has_next ? (const char*)g.A + (size_t)nxt.pm * tstepA : cA; const char* nB = has_next ? (const char*)g.Bt + (size_t)nxt.pn * tstepB : cB;
        for (int t = 0; t < nt; t += 2) {
            const bool last = (t == nt - 2);
            const char* a1 = cA + (size_t)(t + 1) * kstep;
            const char* a2 = last ? nA : cA + (size_t)(t + 2) * kstep; const char* b2 = last ? nB : cB + (size_t)(t + 2) * kstep;
            const char* a3 = a2 + kstep; const char* b3 = b2 + kstep;
            if (last && has_next) S.a_ready(nxt);
            if constexpr (SP2) {
            PG8_LDB(B0, 0, 0); PG8_LDB(B1, 0, 1); PG8_SCHED; PG8_LDA(At, 0, 0); PG8_STAGE(PG8_SA(1, 1), a1 + hstepA, voffA);
            PG8_WAIT_V(8); PG8_WAIT_L(0); PG8_BAR; PG8_MMA(0, 0, At, B0); PG8_MMA(0, 1, At, B1); PG8_BAR; PG8_SCHED;
            PG8_LDA(At, 0, 1); PG8_STAGE(PG8_SB(0, 0), b2, voffB); PG8_STAGE(PG8_SB(0, 1), b2 + hstepB, voffB); PG8_STAGE(PG8_SA(0, 0), a2, voffA);
            PG8_WAIT_V(8); PG8_WAIT_L(0); PG8_BAR; PG8_MMA(1, 0, At, B0); PG8_MMA(1, 1, At, B1); PG8_BAR; PG8_SCHED;
            PG8_LDB(B0, 1, 0); PG8_LDB(B1, 1, 1); PG8_SCHED; PG8_LDA(At, 1, 0); PG8_STAGE(PG8_SA(0, 1), a2 + hstepA, voffA);
            PG8_WAIT_V(8); PG8_WAIT_L(0); PG8_BAR; PG8_MMA(0, 0, At, B0); PG8_MMA(0, 1, At, B1); PG8_BAR; PG8_SCHED;
            PG8_LDA(At, 1, 1); PG8_STAGE(PG8_SB(1, 0), b3, voffB); PG8_STAGE(PG8_SB(1, 1), b3 + hstepB, voffB); PG8_STAGE(PG8_SA(1, 0), a3, voffA);
            PG8_WAIT_V(8); PG8_WAIT_L(0); PG8_BAR; PG8_MMA(1, 0, At, B0); PG8_MMA(1, 1, At, B1); PG8_BAR; PG8_SCHED;
            } else {
            PG8_LDB(B0, 0, 0); PG8_SCHED; PG8_LDA(At, 0, 0); PG8_STAGE(PG8_SA(1, 1), a1 + hstepA, voffA);
            PG8_WAIT_L(8); PG8_BAR; PG8_WAIT_L(0); PG8_MMA(0, 0, At, B0); PG8_BAR; PG8_SCHED;
            PG8_LDB(B1, 0, 1); PG8_STAGE(PG8_SB(0, 0), b2, voffB);
            PG8_BAR; PG8_WAIT_L(0); PG8_MMA(0, 1, At, B1); PG8_BAR;
            PG8_LDA(At, 0, 1); PG8_STAGE(PG8_SA(0, 0), a2, voffA);
            PG8_BAR; PG8_WAIT_L(0); PG8_MMA(1, 0, At, B0); PG8_BAR; PG8_SCHED;
            PG8_STAGE(PG8_SB(0, 1), b2 + hstepB, voffB);
            PG8_WAIT_V(6); PG8_BAR; PG8_MMA(1, 1, At, B1); PG8_BAR;
            PG8_LDB(B0, 1, 0); PG8_SCHED; PG8_LDA(At, 1, 0); PG8_STAGE(PG8_SA(0, 1), a2 + hstepA, voffA);
            PG8_WAIT_L(8); PG8_BAR; PG8_WAIT_L(0); PG8_MMA(0, 0, At, B0); PG8_BAR; PG8_SCHED;
            PG8_LDB(B1, 1, 1); PG8_STAGE(PG8_SB(1, 0), b3, voffB);
            PG8_BAR; PG8_WAIT_L(0); PG8_MMA(0, 1, At, B1); PG8_BAR;
            PG8_LDA(At, 1, 1); PG8_STAGE(PG8_SA(1, 0), a3, voffA);
            PG8_BAR; PG8_WAIT_L(0); PG8_MMA(1, 0, At, B0); PG8_BAR; PG8_SCHED;
            PG8_STAGE(PG8_SB(1, 1), b3 + hstepB, voffB);
            PG8_WAIT_V(6); PG8_BAR; PG8_MMA(1, 1, At, B1); PG8_BAR;
            }
        }
        if constexpr (ALIGN_EPI) { if (wr == 0) PG8_BAR; }
        if constexpr (!Epi::AFTER_DRAIN) { E(acc, cur, wr, wc, fr, fq); S.done(cur); }
        if (!has_next) break;
#pragma unroll
        for (int a = 0; a < 2; ++a)
#pragma unroll
            for (int b = 0; b < 2; ++b)
#pragma unroll
                for (int m = 0; m < 4; ++m)
#pragma unroll
                    for (int n = 0; n < 2; ++n) acc[a][b][m][n] = (f32x4){0.f, 0.f, 0.f, 0.f};
        cur = nxt; cA = nA; cB = nB; ++ui;
        if constexpr (ALIGN_EPI) { if (wr == 1) PG8_BAR; }
    }
    PG8_WAIT_V(0);
    if constexpr (!ALIGN_EPI) { if (wr == 0) PG8_BAR; }
    PG8_BAR;
    if constexpr (Epi::AFTER_DRAIN) { E.fused(acc, cur, wr, wc, fr, fq, lds, wid, lane); S.done(cur); }
#undef PG8_SA
#undef PG8_SB
#undef PG8_STAGE
#undef PG8_LDA
#undef PG8_LDB
#undef PG8_MMA
#undef PG8_WAIT_V
#undef PG8_WAIT_L
#undef PG8_BAR
#undef PG8_SCHED
}
template <class Epi, class Sched>
__device__ __forceinline__ void gemm_phase_g(PG8_LAS unsigned char* lds, const Gemm g, const Sched& S, const Epi& E, const int* inv) {
    constexpr bool ALIGN_EPI = true;
    const int tid = threadIdx.x, wid = __builtin_amdgcn_readfirstlane(tid >> 6), lane = tid & 63, wr = wid >> 2, wc = wid & 3, fr = lane & 15, fq = lane >> 4;
    const int K = g.K, nt = K / BK;
    unsigned voffA[2], voffB[2];
#pragma unroll
    for (int i = 0; i < 2; ++i) { int R, C; stage_rc(tid * 16 + i * 8192, R, C); const int Rb = Epi::PERM ? ((R & ~31) + perm32(R & 31)) : R;
        voffA[i] = (unsigned)(R * g.lda + C) * 2u; voffB[i] = (unsigned)(Rb * g.ldb + C) * 2u; }
    const size_t kstep = (size_t)(BK * 2);
    const size_t hstepA = (size_t)HALF * g.lda * 2, hstepB = (size_t)HALF * g.ldb * 2;
    const size_t tstepA = 2 * hstepA, tstepB = 2 * hstepB;
    const unsigned ldsw = (unsigned)wid * 1024u;
    const int aoff = lds_byte(wr * 64 + fr, fq * 8), boff = lds_byte(wc * 32 + fr, fq * 8);
#define PG8_SA(b, h) (((b) * 2 + (h)) * HTB)
#define PG8_SB(b, h) ((4 + (b) * 2 + (h)) * HTB)
#define PG8_STAGE(bufoff, gbase, voff) do { _Pragma("unroll") for (int _i = 0; _i < 2; ++_i) \
        __builtin_amdgcn_global_load_lds((const unsigned*)((const char*)(gbase) + (voff)[_i]), (PG8_LAS unsigned*)(lds + (bufoff) + ldsw + _i * 8192), 16, 0, 0); } while (0)
#define PG8_LDA(dst, b, h) do { _Pragma("unroll") for (int m = 0; m < 4; ++m) _Pragma("unroll") for (int k = 0; k < 2; ++k) dst[m][k] = *(const PG8_LAS bf16x8*)(lds + PG8_SA(b, h) + aoff + m * 2048 + k * 1024); } while (0)
#define PG8_LDB(dst, b, h) do { _Pragma("unroll") for (int n = 0; n < 2; ++n) _Pragma("unroll") for (int k = 0; k < 2; ++k) dst[n][k] = *(const PG8_LAS bf16x8*)(lds + PG8_SB(b, h) + boff + n * 2048 + k * 1024); } while (0)
#define PG8_MMA(ai, bj, At, Bt) do { __builtin_amdgcn_s_setprio(1); _Pragma("unroll") for (int m = 0; m < 4; ++m) _Pragma("unroll") for (int n = 0; n < 2; ++n) _Pragma("unroll") for (int k = 0; k < 2; ++k) \
        acc[ai][bj][m][n] = __builtin_amdgcn_mfma_f32_16x16x32_bf16(Bt[n][k], At[m][k], acc[ai][bj][m][n], 0, 0, 0); __builtin_amdgcn_s_setprio(0); } while (0)
#define PG8_WAIT_V(n) asm volatile("s_waitcnt vmcnt(" #n ")" ::: "memory")
#define PG8_WAIT_L(n) asm volatile("s_waitcnt lgkmcnt(" #n ")" ::: "memory")
#define PG8_BAR __builtin_amdgcn_s_barrier()
#define PG8_SCHED __builtin_amdgcn_sched_barrier(0)
    Unit cur, nxt; int ui = 0;
    if (!S.next(0, cur)) return;
    f32x4 acc[2][2][4][2];
#pragma unroll
    for (int a = 0; a < 2; ++a)
#pragma unroll
        for (int b = 0; b < 2; ++b)
#pragma unroll
            for (int m = 0; m < 4; ++m)
#pragma unroll
                for (int n = 0; n < 2; ++n) acc[a][b][m][n] = (f32x4){0.f, 0.f, 0.f, 0.f};
    bf16x8 At[4][2], B0[2][2], B1[2][2];
    const char* cA = (const char*)g.A; const char* cB = (const char*)g.Bt + (size_t)cur.pn * tstepB;
    S.a_ready(cur);
    unsigned vc[2][2], vn[2][2];
#define PG8_ROWS(u_, vo_) do { _Pragma("unroll") for (int h_ = 0; h_ < 2; ++h_) _Pragma("unroll") for (int i_ = 0; i_ < 2; ++i_) { int R_, C_; stage_rc(tid * 16 + i_ * 8192, R_, C_); const int r_ = h_ * HALF + R_; \
        const int tok_ = r_ < (u_).nvalid ? inv[(u_).inv0 + r_] : 0; vo_[h_][i_] = (unsigned)(tok_ * g.lda + C_) * 2u; } } while (0)
    PG8_ROWS(cur, vc);
    {
        PG8_STAGE(PG8_SB(0, 0), cB, voffB); PG8_STAGE(PG8_SB(0, 1), cB + hstepB, voffB); PG8_STAGE(PG8_SA(0, 0), cA, vc[0]); PG8_STAGE(PG8_SA(0, 1), cA, vc[1]);
        if (wr == 1) PG8_BAR;
        PG8_WAIT_V(2); PG8_BAR;
        PG8_STAGE(PG8_SB(1, 0), cB + kstep, voffB); PG8_STAGE(PG8_SA(1, 0), cA + kstep, vc[0]); PG8_STAGE(PG8_SB(1, 1), cB + hstepB + kstep, voffB);
        PG8_WAIT_V(6); PG8_BAR;
    }
    for (;;) {
        const bool has_next = S.next(ui + 1, nxt);
        if (has_next) { PG8_ROWS(nxt, vn); } else {
#pragma unroll
            for (int h_ = 0; h_ < 2; ++h_) { vn[h_][0] = vc[h_][0]; vn[h_][1] = vc[h_][1]; } }
        const char* nA = cA; const char* nB = has_next ? (const char*)g.Bt + (size_t)nxt.pn * tstepB : cB;
        const bool do0 = cur.half != 1, do1 = cur.half != 0;
        for (int t = 0; t < nt; t += 2) {
            const bool last = (t == nt - 2);
            unsigned v2[2][2];
#pragma unroll
            for (int h_ = 0; h_ < 2; ++h_) { v2[h_][0] = last ? vn[h_][0] : vc[h_][0]; v2[h_][1] = last ? vn[h_][1] : vc[h_][1]; }
            const char* a1 = cA + (size_t)(t + 1) * kstep;
            const char* a2 = last ? nA : cA + (size_t)(t + 2) * kstep; const char* b2 = last ? nB : cB + (size_t)(t + 2) * kstep;
            const char* a3 = a2 + kstep; const char* b3 = b2 + kstep;
            if (last && has_next) S.a_ready(nxt);
            {
            PG8_LDB(B0, 0, 0); PG8_LDB(B1, 0, 1); PG8_SCHED; if (do0) { PG8_LDA(At, 0, 0); } PG8_STAGE(PG8_SA(1, 1), a1, vc[1]);
            PG8_WAIT_V(8); PG8_WAIT_L(0); PG8_BAR; if (do0) { PG8_MMA(0, 0, At, B0); PG8_MMA(0, 1, At, B1); } PG8_BAR; PG8_SCHED;
            if (do1) { PG8_LDA(At, 0, 1); } PG8_STAGE(PG8_SB(0, 0), b2, voffB); PG8_STAGE(PG8_SB(0, 1), b2 + hstepB, voffB); PG8_STAGE(PG8_SA(0, 0), a2, v2[0]);
            PG8_WAIT_V(8); PG8_WAIT_L(0); PG8_BAR; if (do1) { PG8_MMA(1, 0, At, B0); PG8_MMA(1, 1, At, B1); } PG8_BAR; PG8_SCHED;
            PG8_LDB(B0, 1, 0); PG8_LDB(B1, 1, 1); PG8_SCHED; if (do0) { PG8_LDA(At, 1, 0); } PG8_STAGE(PG8_SA(0, 1), a2, v2[1]);
            PG8_WAIT_V(8); PG8_WAIT_L(0); PG8_BAR; if (do0) { PG8_MMA(0, 0, At, B0); PG8_MMA(0, 1, At, B1); } PG8_BAR; PG8_SCHED;
            if (do1) { PG8_LDA(At, 1, 1); } PG8_STAGE(PG8_SB(1, 0), b3, voffB); PG8_STAGE(PG8_SB(1, 1), b3 + hstepB, voffB); PG8_STAGE(PG8_SA(1, 0), a3, v2[0]);
            PG8_WAIT_V(8); PG8_WAIT_L(0); PG8_BAR; if (do1) { PG8_MMA(1, 0, At, B0); PG8_MMA(1, 1, At, B1); } PG8_BAR; PG8_SCHED;
            }
        }
        if constexpr (ALIGN_EPI) { if (wr == 0) PG8_BAR; }
        if constexpr (!Epi::AFTER_DRAIN) { E(acc, cur, wr, wc, fr, fq); S.done(cur); }
        if (!has_next) break;
#pragma unroll
        for (int a = 0; a < 2; ++a)
#pragma unroll
            for (int b = 0; b < 2; ++b)
#pragma unroll
                for (int m = 0; m < 4; ++m)
#pragma unroll
                    for (int n = 0; n < 2; ++n) acc[a][b][m][n] = (f32x4){0.f, 0.f, 0.f, 0.f};
        cur = nxt; cA = nA; cB = nB; ++ui;
#pragma unroll
        for (int h_ = 0; h_ < 2; ++h_) { vc[h_][0] = vn[h_][0]; vc[h_][1] = vn[h_][1]; }
        if constexpr (ALIGN_EPI) { if (wr == 1) PG8_BAR; }
    }
    PG8_WAIT_V(0);
    if constexpr (!ALIGN_EPI) { if (wr == 0) PG8_BAR; }
    PG8_BAR;
    if constexpr (Epi::AFTER_DRAIN) { E.fused(acc, cur, wr, wc, fr, fq, lds, wid, lane); S.done(cur); }
#undef PG8_ROWS
#undef PG8_SA
#undef PG8_SB
#undef PG8_STAGE
#undef PG8_LDA
#undef PG8_LDB
#undef PG8_MMA
#undef PG8_WAIT_V
#undef PG8_WAIT_L
#undef PG8_BAR
#undef PG8_SCHED
}
}
constexpr int BATCH = 2, SEQ = 4096, DM = 2048, MTOK = BATCH * SEQ;
constexpr int NE0 = 6168, NE1 = 4176;
constexpr int NP0 = 6144, NP1 = 4096;
constexpr float LN_EPS = 1e-5f;
constexpr float DN_ALPHA = 1.41421356237309515f;
constexpr float ATT_SCALE = 0.08838834764831845f;
constexpr int RPAD = 24576;
constexpr size_t MiB = 1u << 20;
constexpr size_t WS_CTL = 0, CTL_ZERO_BYTES = 1 * MiB;
constexpr size_t WS_ROPE = 1 * MiB;
constexpr size_t WS_WSM = 4 * MiB;
constexpr size_t WS_SK0 = 6 * MiB;
constexpr size_t WS_IK = 7 * MiB;
constexpr size_t WS_IW = 8 * MiB + 512 * 1024;
constexpr size_t WS_FBIAS = 10 * MiB;
constexpr size_t WS_ROUTE = 11 * MiB;
constexpr size_t WS_MASK = 12 * MiB;
constexpr size_t WS_WINA = 16 * MiB, WS_WOA = 40 * MiB, WS_WINC = 48 * MiB, WS_WOC = 64 * MiB;
constexpr size_t WS_WGU = 72 * MiB;
constexpr size_t WS_WD = 328 * MiB;
constexpr size_t WS_XB = 456 * MiB;
constexpr size_t WS_YB = 488 * MiB;
constexpr size_t WS_PROJ = 552 * MiB;
constexpr size_t WS_CST = 648 * MiB;
constexpr size_t WS_PREVT = 712 * MiB;
constexpr size_t WS_OMIX = 744 * MiB;
constexpr size_t WS_GB = 776 * MiB;
constexpr size_t WS_DEC = 792 * MiB;
constexpr size_t WS_ROWW = 793 * MiB;
constexpr size_t WS_SC = 800 * MiB;
constexpr size_t WS_INV = 800 * MiB;
constexpr size_t WS_WINV = 801 * MiB;
constexpr size_t WS_END = 928 * MiB;
constexpr int CW_CNT = 1024;
constexpr int CW_FILL = 2048;
constexpr int CW_BAR = 4096;

#define GAS __attribute__((address_space(1)))
#define LAS __attribute__((address_space(3)))
typedef unsigned short bf16;
typedef unsigned v4u __attribute__((ext_vector_type(4)));
typedef unsigned v2u __attribute__((ext_vector_type(2)));
typedef float f32x4 __attribute__((ext_vector_type(4)));
typedef short bf16x8 __attribute__((ext_vector_type(8)));
#define LDS_WAIT() asm volatile("s_waitcnt lgkmcnt(0)" ::: "memory")
#define VM_WAIT() asm volatile("s_waitcnt vmcnt(0)" ::: "memory")
__device__ __forceinline__ unsigned f2bf(float f) { unsigned u = __builtin_bit_cast(unsigned, f); return (u + 0x7fffu + ((u >> 16) & 1u)) >> 16; }
__device__ __forceinline__ unsigned pk2(float lo, float hi) { return f2bf(lo) | (f2bf(hi) << 16); }
__device__ __forceinline__ float bf2f(unsigned short b) { return __builtin_bit_cast(float, ((unsigned)b) << 16); }
__device__ __forceinline__ float wave_sum(float v) {
#pragma unroll
    for (int o = 1; o < 64; o <<= 1) v += __shfl_xor(v, o);
    return v;
}
__device__ __forceinline__ float logsigmoidf(float z) { return fminf(z, 0.f) - log1pf(__expf(-fabsf(z))); }
#define XB_TMO      128
#define XB_XCNT(j)  (256  + 64 * (j))
#define XB_XSUB(j)  (1280 + 64 * (j))
#define XB_XGEN(j)  (2304 + 64 * (j))
#define XB_TOP      3328
#define XB_TOPGEN   3392
#define XCD_BAR_WORDS 3456
#define XB_SPIN_CAP (1u << 21)

__device__ __forceinline__ unsigned xb_ld(unsigned* p)              { return __hip_atomic_load(p, __ATOMIC_RELAXED, __HIP_MEMORY_SCOPE_AGENT); }
__device__ __forceinline__ unsigned xb_add(unsigned* p, unsigned v) { return __hip_atomic_fetch_add(p, v, __ATOMIC_RELAXED, __HIP_MEMORY_SCOPE_AGENT); }
__device__ __forceinline__ unsigned xb_xcc_id() { return (unsigned)__builtin_amdgcn_s_getreg((3 << 11) | 20) & 0xFu; }
#define XB_SPIN(cond, bar) do { unsigned _sp = 0; while (cond) { __builtin_amdgcn_s_sleep(1); \
    if ((++_sp & 255u) == 0u) { if (xb_ld(&(bar)[XB_TMO])) break; if (_sp > XB_SPIN_CAP) { atomicAdd(&(bar)[XB_TMO], 1u); break; } } } } while (0)

struct XcdBarrier {
    unsigned* bar; unsigned x;
    volatile LAS unsigned* st;
};

__device__ __forceinline__ XcdBarrier xcd_barrier_post(unsigned* bar, volatile LAS unsigned* st) {
    XcdBarrier b; b.bar = bar; b.x = xb_xcc_id(); b.st = st;
    if (threadIdx.x == 0) (void)xb_add(&bar[XB_XCNT(b.x)], 1u);
    return b;
}
__device__ __forceinline__ void xcd_barrier_complete(unsigned* bar, unsigned x, unsigned& nloc, unsigned& nx) {
    const unsigned G = gridDim.x * gridDim.y * gridDim.z;
    unsigned sum, cnt, mine, sp = 0u;
    for (;;) {
        sum = 0u; cnt = 0u; mine = 0u;
#pragma unroll
        for (unsigned j = 0; j < 16; ++j) { const unsigned c = xb_ld(&bar[XB_XCNT(j)]); sum += c; cnt += (c > 0u) ? 1u : 0u; mine = (j == x) ? c : mine; }
        if (sum == G) break;
        __builtin_amdgcn_s_sleep(1);
        if ((++sp & 255u) == 0u) { if (xb_ld(&bar[XB_TMO])) break; if (sp > XB_SPIN_CAP) { atomicAdd(&bar[XB_TMO], 1u); break; } }
    }
    nloc = mine > 0u ? mine : 1u; nx = cnt > 0u ? cnt : 1u;
}

__device__ __forceinline__ void xcd_barrier(const XcdBarrier& b) {
    asm volatile("s_waitcnt vmcnt(0)" ::: "memory");
    __syncthreads();
    if (threadIdx.x == 0) {
        unsigned* bar = b.bar;
        __builtin_amdgcn_s_waitcnt(0);
        unsigned nloc = b.st[0], nx = b.st[1];
        if (nloc == 0u) { xcd_barrier_complete(bar, b.x, nloc, nx); b.st[0] = nloc; b.st[1] = nx; }
        const unsigned old = xb_add(&bar[XB_XSUB(b.x)], 1u);
        const unsigned gen = old / nloc;
        if (old + 1u == (gen + 1u) * nloc) {
            __builtin_amdgcn_fence(__ATOMIC_RELEASE, "agent");
            asm volatile("s_waitcnt vmcnt(0)" ::: "memory");
            const unsigned og = xb_add(&bar[XB_TOP], 1u);
            const unsigned tg = og / nx;
            if (og + 1u == (tg + 1u) * nx) xb_add(&bar[XB_TOPGEN], 1u);
            else XB_SPIN(xb_ld(&bar[XB_TOPGEN]) == tg, bar);
            __builtin_amdgcn_fence(__ATOMIC_ACQUIRE, "agent");
            xb_add(&bar[XB_XGEN(b.x)], 1u);
            asm volatile("s_waitcnt vmcnt(0)" ::: "memory");
        } else {
            XB_SPIN(xb_ld(&bar[XB_XGEN(b.x)]) == gen, bar);
            __builtin_amdgcn_fence(__ATOMIC_ACQUIRE, "agent");
            asm volatile("s_waitcnt vmcnt(0)" ::: "memory");
        }
    }
    __syncthreads();
}

constexpr int NWAVES = 8;
constexpr int RING_BYTES = 131072;
constexpr int LDSCTL_OFF = RING_BYTES;
constexpr int LDS_BYTES = 147456;
struct Frame {
    LAS unsigned char* lds; volatile LAS unsigned* MISC; unsigned* ctl;
    int tid, lane, wave, G, gw, NGW;
    unsigned char* ws;
};
struct Args { const float* in[20]; float* out; unsigned char* ws; int ph_lo, ph_hi, bar_region, pad; };

struct TrItem { const float* W; bf16* WT; int ldw, c0, c1, K, n0, k0; };
__device__ __forceinline__ void tr64_load(const TrItem& t, f32x4 (&r)[16], int lane) {
    const int nq = lane & 15, kr = lane >> 4;
    const float* src = t.W + (size_t)(t.k0 + 2 * kr) * t.ldw + (nq < 8 ? t.c0 : t.c1 - 32) + 4 * nq;
#pragma unroll
    for (int i = 0; i < 8; ++i) { r[2 * i] = __builtin_nontemporal_load((const f32x4*)(src + (size_t)(8 * i) * t.ldw)); r[2 * i + 1] = __builtin_nontemporal_load((const f32x4*)(src + (size_t)(8 * i + 1) * t.ldw)); }
}
__device__ __forceinline__ void tr64_store(const TrItem& t, const f32x4 (&r)[16], LAS bf16* T, int lane) {
    const int nq = lane & 15, kr = lane >> 4;
#pragma unroll
    for (int i = 0; i < 8; ++i) { const int kk = 8 * i + 2 * kr;
#pragma unroll
        for (int e = 0; e < 4; ++e) *(LAS unsigned*)(T + (4 * nq + e) * 68 + kk) = pg8::cvt_pk_bf16(r[2 * i][e], r[2 * i + 1][e]); }
    LDS_WAIT(); asm volatile("" ::: "memory");
    const int c = lane & 7;
#pragma unroll
    for (int j = 0; j < 8; ++j) { const int n = (lane >> 3) + 8 * j; const v2u lo = *(const LAS v2u*)(T + n * 68 + 8 * c), hi = *(const LAS v2u*)(T + n * 68 + 8 * c + 4);
        v4u o; o.x = lo.x; o.y = lo.y; o.z = hi.x; o.w = hi.y;
        *(v4u*)(t.WT + (size_t)(t.n0 + n) * t.K + t.k0 + 8 * c) = o; }
    LDS_WAIT(); asm volatile("" ::: "memory");
}
__device__ __forceinline__ void transpose_item64(const float* W, int ldw, int c0, int c1, int K, bf16* WT, int n0, int k0, LAS bf16* T, int lane) {
    const TrItem t{W, WT, ldw, c0, c1, K, n0, k0}; f32x4 r[16]; tr64_load(t, r, lane); tr64_store(t, r, T, lane);
}
__device__ __forceinline__ int l1_src_col(int n) {
    const int pn = n >> 8, j = n & 255, jh = j & 127, second = j >> 7;
    if (pn == 10 || pn == 11) return n;
    if (pn < 10) return pn * 256 + (jh >> 6) * 128 + second * 64 + (jh & 63);
    return 3072 + ((pn - 12) * 4 + (jh >> 5)) * 64 + second * 32 + (jh & 31);
}
constexpr int SK_ROUTE0 = 0, SK_ROUTE1 = 48, SK_SK0 = 96, SK_SK1 = 128, SK_NCOL = 208;
constexpr int SK_PART_OFF = 0, SK_LG_OFF = 65536;
template <int NT> __device__ __forceinline__ void skinny_partials(LAS unsigned char* ldsb, const bf16* X, const bf16* WH, const bf16* WL, int w, int lane) {
    const int tile = w >> 2, kq = w & 3, l15 = lane & 15, quad = lane >> 4;
    const bf16* xp = X + (size_t)(16 * tile + l15) * DM + kq * 512 + quad * 8;
    const bf16* hp = WH + (size_t)l15 * 2048 + kq * 512 + quad * 8; const bf16* lp = WL + (size_t)l15 * 2048 + kq * 512 + quad * 8;
    pg8::f32x4 acc[NT];
#pragma unroll
    for (int n = 0; n < NT; ++n) acc[n] = (pg8::f32x4){0.f, 0.f, 0.f, 0.f};
#pragma unroll 2
    for (int ks = 0; ks < 16; ++ks) {
        const bf16x8 ah = *(const bf16x8*)(xp + 32 * ks);
#pragma unroll
        for (int n = 0; n < NT; ++n) { const bf16x8 bh = *(const bf16x8*)(hp + (size_t)n * 16 * 2048 + 32 * ks), bl = *(const bf16x8*)(lp + (size_t)n * 16 * 2048 + 32 * ks);
            acc[n] = __builtin_amdgcn_mfma_f32_16x16x32_bf16(ah, bh, acc[n], 0, 0, 0); acc[n] = __builtin_amdgcn_mfma_f32_16x16x32_bf16(ah, bl, acc[n], 0, 0, 0); }
    }
    LAS float* PART = (LAS float*)(ldsb + SK_PART_OFF);
#pragma unroll
    for (int n = 0; n < NT; ++n) *(LAS pg8::f32x4*)(PART + ((((tile * 4 + kq) * NT + n) * 64 + lane) * 4)) = acc[n];
}
template <int NT> __device__ __forceinline__ void skinny_reduce(LAS unsigned char* ldsb, int tid) {
    const LAS float* PART = (const LAS float*)(ldsb + SK_PART_OFF); LAS float* LG = (LAS float*)(ldsb + SK_LG_OFF);
    for (int idx = tid; idx < 32 * 16 * NT; idx += NWAVES * 64) { const int row = idx / (16 * NT), col = idx % (16 * NT), tile = row >> 4, rr = row & 15, ln = (rr >> 2) * 16 + (col & 15), n = col >> 4, j = rr & 3;
        float s = 0.f;
#pragma unroll
        for (int kq = 0; kq < 4; ++kq) s += PART[(((tile * 4 + kq) * NT + n) * 64 + ln) * 4 + j];
        LG[row * (16 * NT) + col] = s; }
}
__device__ __forceinline__ void ln_row(f32x4 (&v)[8], const float* g, const float* b, int lane) {
    float s = 0.f;
#pragma unroll
    for (int j = 0; j < 8; ++j) s += (v[j][0] + v[j][1]) + (v[j][2] + v[j][3]);
    const float mean = wave_sum(s) * (1.f / DM); float s2 = 0.f;
#pragma unroll
    for (int j = 0; j < 8; ++j) { v[j] = v[j] - mean; s2 += (v[j][0] * v[j][0] + v[j][1] * v[j][1]) + (v[j][2] * v[j][2] + v[j][3] * v[j][3]); }
    const float rstd = 1.f / sqrtf(wave_sum(s2) * (1.f / DM) + LN_EPS);
#pragma unroll
    for (int j = 0; j < 8; ++j) { const f32x4 gg = *(const f32x4*)(g + 256 * j + 4 * lane), bb = *(const f32x4*)(b + 256 * j + 4 * lane); v[j] = v[j] * rstd * gg + bb; }
}
__device__ __forceinline__ void load_row_bf16(const bf16* src, f32x4 (&v)[8], int lane) {
#pragma unroll
    for (int j = 0; j < 8; ++j) { const uint2 p = *(const uint2*)(src + 256 * j + 4 * lane); v[j][0] = bf2f(p.x & 0xffff); v[j][1] = bf2f(p.x >> 16); v[j][2] = bf2f(p.y & 0xffff); v[j][3] = bf2f(p.y >> 16); }
}
__device__ __forceinline__ void store_row_bf16(bf16* dst, const f32x4 (&v)[8], int lane) {
#pragma unroll
    for (int j = 0; j < 8; ++j) { uint2 o; o.x = pg8::cvt_pk_bf16(v[j][0], v[j][1]); o.y = pg8::cvt_pk_bf16(v[j][2], v[j][3]); *(uint2*)(dst + 256 * j + 4 * lane) = o; }
}
#define TK_FOR_VALID(...) _Pragma("unroll") for (int g_ = 0; g_ < 8; ++g_) { if (512 * g_ <= qpos) { _Pragma("unroll") for (int i = 8 * g_; i < 8 * g_ + 8; ++i) { __VA_ARGS__ } } }
__device__ __forceinline__ void topk_mask_row(const LAS float* sc, int qpos, unsigned long long* mrow, int lane, LAS unsigned* cbuf) {
    unsigned u[64];
#pragma unroll
    for (int i = 0; i < 64; ++i) { const int s = 64 * i + lane; const bool ok = s <= qpos; const float f = ok ? sc[s] : 0.f; const unsigned b = __builtin_bit_cast(unsigned, f);
        const unsigned key = b ^ ((b >> 31) ? 0xFFFFFFFFu : 0x80000000u); u[i] = ok ? key : 0u; }
    unsigned long long mword = 0ull;
    if (qpos + 1 <= 256) {
#pragma unroll
        for (int i = 0; i < 4; ++i) { const unsigned long long w = __ballot(64 * i + lane <= qpos); mword = (lane == i) ? w : mword; }
        mrow[lane] = mword; return;
    }
    const unsigned long long below = (1ull << lane) - 1ull;
    unsigned T = 0u;
#pragma unroll 1
    for (int bit = 31; bit >= 20; --bit) { const unsigned cand = T | (1u << bit); int cnt = 0;
        TK_FOR_VALID( cnt += __builtin_popcountll(__ballot(u[i] >= cand)); )
        if (cnt >= 256) T = cand; }
    const unsigned pre = T >> 20; int cgt = 0, nc = 0;
    TK_FOR_VALID( { const unsigned p_ = u[i] >> 20; const unsigned long long gm = __ballot(p_ > pre), em = __ballot(p_ == pre); cgt += __builtin_popcountll(gm);
        const int pos_ = nc + __builtin_popcountll(em & below); if (p_ == pre && pos_ < 256) cbuf[pos_] = u[i]; nc += __builtin_popcountll(em); } )
    int kneed = 256 - cgt;
    if (nc <= 256) {
        asm volatile("s_waitcnt lgkmcnt(0)" ::: "memory");
        unsigned c0 = lane < nc ? cbuf[lane] : 0u, c1 = 64 + lane < nc ? cbuf[64 + lane] : 0u, c2 = 128 + lane < nc ? cbuf[128 + lane] : 0u, c3 = 192 + lane < nc ? cbuf[192 + lane] : 0u;
#pragma unroll 1
        for (int bit = 19; bit >= 0; --bit) { const unsigned cand = T | (1u << bit);
            int cnt = __builtin_popcountll(__ballot(c0 >= cand));
            if (nc > 64) cnt += __builtin_popcountll(__ballot(c1 >= cand));
            if (nc > 128) cnt += __builtin_popcountll(__ballot(c2 >= cand)) + __builtin_popcountll(__ballot(c3 >= cand));
            if (cnt >= kneed) T = cand; }
        const int cg2 = __builtin_popcountll(__ballot(c0 > T)) + __builtin_popcountll(__ballot(c1 > T)) + __builtin_popcountll(__ballot(c2 > T)) + __builtin_popcountll(__ballot(c3 > T));
        kneed -= cg2;
    } else {
#pragma unroll 1
        for (int bit = 19; bit >= 0; --bit) { const unsigned cand = T | (1u << bit); int cnt = 0;
            TK_FOR_VALID( cnt += __builtin_popcountll(__ballot(u[i] >= cand)); )
            if (cnt >= 256) T = cand; }
        int cg2 = 0;
        TK_FOR_VALID( cg2 += __builtin_popcountll(__ballot(u[i] > T)); )
        kneed = 256 - cg2;
    }
    int run = 0;
#pragma unroll
    for (int i = 0; i < 64; ++i) { const bool gt = u[i] > T, eq = u[i] == T; const unsigned long long eqm = __ballot(eq);
        const int rank = run + __builtin_popcountll(eqm & below); const bool sel = gt || (eq && rank < kneed); run += __builtin_popcountll(eqm);
        const unsigned long long w = __ballot(sel); mword = (lane == i) ? w : mword; }
    mrow[lane] = mword;
}
#undef TK_FOR_VALID
constexpr int CONV_MOE_ITEMS = 32 * (32 * 16) + 32 * (8 * 32);
#ifndef CONV_STATIC_ITEMS
#define CONV_STATIC_ITEMS 0
#endif
constexpr int CONV_STATIC = CONV_STATIC_ITEMS;
constexpr int CONV_LATE_ITEMS = CONV_MOE_ITEMS + 32 * (NP1 / 64) + 32 * 32 + CONV_MOE_ITEMS;
#ifndef CONV_CHUNK
#define CONV_CHUNK 16
#endif
#ifndef CONV_TAIL_ITEMS
#define CONV_TAIL_ITEMS 12288
#endif
constexpr int CONV_SPLIT = CONV_LATE_ITEMS - CONV_TAIL_ITEMS;
__device__ __forceinline__ TrItem conv_moe_desc(const Args& a, unsigned char* ws, int layer, int it) {
    if (it < 32 * 512) {
        const int ex = layer * 32 + it / 512, r = it % 512, blk = r >> 5, jj = r & 31, kb = (blk >> 2) * 8 + (jj >> 2), nb = (blk & 3) * 4 + (jj & 3), n0 = nb * 64, tile = n0 >> 8, j = n0 & 255;
        const float* W = (j < 128 ? a.in[17] : a.in[18]) + (size_t)ex * 2048 * 512;
        return TrItem{W, (bf16*)(ws + WS_WGU) + (size_t)ex * 1024 * 2048, 512, 128 * tile + (j & 127), 128 * tile + (j & 127) + 32, 2048, n0, kb * 64};
    }
    const int i2 = it - 32 * 512, ex = layer * 32 + i2 / 256, r = i2 % 256, blk = r >> 5, jj = r & 31, kb = jj >> 2, nb = blk * 4 + (jj & 3);
    return TrItem{a.in[19] + (size_t)ex * 512 * 2048, (bf16*)(ws + WS_WD) + (size_t)ex * 2048 * 512, 2048, nb * 64, nb * 64 + 32, 512, nb * 64, kb * 64};
}
__device__ __forceinline__ TrItem conv_late_desc(const Args& a, unsigned char* ws, int it) {
    if (it < CONV_MOE_ITEMS) return conv_moe_desc(a, ws, 0, it);
    it -= CONV_MOE_ITEMS;
    if (it < 32 * (NP1 / 64)) { const int kb = it / (NP1 / 64), nb = it % (NP1 / 64), n0 = nb * 64;
        return TrItem{a.in[7], (bf16*)(ws + WS_WINC), NE1, l1_src_col(n0), l1_src_col(n0 + 32), 2048, n0, kb * 64}; }
    it -= 32 * (NP1 / 64);
    if (it < 32 * 32) { const int kb = it / 32, nb = it % 32; return TrItem{a.in[8], (bf16*)(ws + WS_WOC), 2048, nb * 64, nb * 64 + 32, 2048, nb * 64, kb * 64}; }
    return conv_moe_desc(a, ws, 1, it - 32 * 32);
}
__device__ __forceinline__ void late_conv_items(Frame& F, const Args& a, const int lo, const int hi, const int ctr) {
    constexpr int CHUNK = CONV_CHUNK;
    LAS bf16* T = (LAS bf16*)(F.lds + F.wave * 16384); volatile LAS int* slot = (volatile LAS int*)(F.lds + 131072 + 512);
    for (;;) {
        __syncthreads();
        if (F.tid == 0) *slot = lo + (int)atomicAdd(F.ctl + CW_FILL + 64 * ctr, (unsigned)CHUNK);
        __syncthreads();
        const int base = *slot;
        if (base >= hi) break;
        f32x4 rA[16], rB[16];
        TrItem t0 = conv_late_desc(a, F.ws, base + F.wave); tr64_load(t0, rA, F.lane);
        TrItem t1 = conv_late_desc(a, F.ws, base + F.wave + 8); tr64_load(t1, rB, F.lane);
        tr64_store(t0, rA, T, F.lane);
        if (CHUNK == 32) { t0 = conv_late_desc(a, F.ws, base + F.wave + 16); tr64_load(t0, rA, F.lane); }
        tr64_store(t1, rB, T, F.lane);
        if (CHUNK == 32) { t1 = conv_late_desc(a, F.ws, base + F.wave + 24); tr64_load(t1, rB, F.lane);
            tr64_store(t0, rA, T, F.lane);
            tr64_store(t1, rB, T, F.lane); }
    }
    __syncthreads();
}
static_assert(CONV_LATE_ITEMS % 32 == 0 && CONV_STATIC % 32 == 0 && CONV_STATIC <= CONV_LATE_ITEMS, "filler chunks");
__device__ __forceinline__ void p0_prologue(Frame& F, const Args& a) {
    const int gw = F.gw, NGW = F.NGW, lane = F.lane;
    unsigned char* ws = F.ws;
    LAS bf16* T = (LAS bf16*)(F.lds + F.wave * 16384);
    {
        const float* W = a.in[1]; bf16* WT = (bf16*)(ws + WS_WINA);
        for (int it = gw; it < 32 * (NP0 / 64); it += NGW) { const int kb = it / (NP0 / 64), nb = it % (NP0 / 64), n0 = nb * 64; const int c0 = n0 < 3072 ? n0 : n0 + 16; transpose_item64(W, NE0, c0, c0 + 32, 2048, WT, n0, kb * 64, T, lane); }
    }
    {
        for (int it = gw; it < 32 * 32; it += NGW) { const int kb = it / 32, nb = it % 32; transpose_item64(a.in[6], 2048, nb * 64, nb * 64 + 32, 2048, (bf16*)(ws + WS_WOA), nb * 64, kb * 64, T, lane); }
    }
    for (int it = gw; it < CONV_STATIC; it += NGW) { const TrItem t = conv_late_desc(a, ws, it); f32x4 r16[16]; tr64_load(t, r16, lane); tr64_store(t, r16, T, lane); }
    const int gt = blockIdx.x * (NWAVES * 64) + F.tid, NGT = F.G * NWAVES * 64;
    {   float* c128 = (float*)(ws + WS_ROPE); float* s128 = c128 + 4096 * 64; float* c64 = s128 + 4096 * 64; float* s64 = c64 + 4096 * 32;
        for (int i = gt; i < 4096 * 96; i += NGT) { int pos, idx, half; float* cp; float* sp;
            if (i < 4096 * 64) { pos = i >> 6; idx = i & 63; half = 64; cp = c128 + i; sp = s128 + i; } else { const int r = i - 4096 * 64; pos = r >> 5; idx = r & 31; half = 32; cp = c64 + r; sp = s64 + r; }
            const float inv = exp2f(-(float)idx / (float)half * 13.287712379549449f);
            const float ang = (float)pos * inv;
            double rv = (double)ang * 0.15915494309189535; rv -= rint(rv);
            const float rf = (float)rv;
            *cp = __builtin_amdgcn_cosf(rf); *sp = __builtin_amdgcn_sinf(rf); }
    }
    {   bf16* SKH = (bf16*)(ws + WS_WSM); bf16* SKL = SKH + (size_t)SK_NCOL * 2048;
        for (int i = gt; i < 2048 * SK_NCOL; i += NGT) { const int k = i / SK_NCOL, c = i % SK_NCOL; float v = 0.f;
            if (c < 96) { const int l = c / 48, j = c % 48; if (j < 4) v = a.in[13][((size_t)l * 2048 + k) * 4 + j]; else if (j < 36) { const int g = (j - 4) >> 3, e = (j - 4) & 7; v = a.in[15][(((size_t)l * 4 + g) * 2048 + k) * 8 + e]; } }
            else if (c < 128) { const int j = c - 96; if (j < 16) v = a.in[1][(size_t)k * NE0 + 3072 + j]; else if (j < 24) v = a.in[1][(size_t)k * NE0 + 6160 + j - 16]; }
            else v = a.in[7][(size_t)k * NE1 + 4096 + c - 128];
            const unsigned h = f2bf(v); SKH[(size_t)c * 2048 + k] = (bf16)h; SKL[(size_t)c * 2048 + k] = (bf16)f2bf(v - bf2f((unsigned short)h)); }
    }
    {   const float* x = a.in[0]; bf16* XB = (bf16*)(ws + WS_XB);
        for (int m = gw; m < MTOK; m += NGW) { f32x4 v[8];
#pragma unroll
            for (int j = 0; j < 8; ++j) v[j] = *(const f32x4*)(x + (size_t)m * DM + 256 * j + 4 * lane);
            store_row_bf16(XB + (size_t)m * DM, v, lane); }
    }
}
__device__ __forceinline__ void p_skinny0(Frame& F, const Args& a) {
    const bf16* SKH = (const bf16*)(F.ws + WS_WSM) + (size_t)SK_SK0 * 2048; const bf16* SKL = SKH + (size_t)SK_NCOL * 2048; float* SK0 = (float*)(F.ws + WS_SK0);
    const LAS float* LG = (const LAS float*)(F.lds + SK_LG_OFF);
    for (int blk = blockIdx.x; blk < MTOK / 32; blk += F.G) { const int R0 = blk * 32;
        __syncthreads();
        skinny_partials<2>(F.lds, (const bf16*)(F.ws + WS_XB) + (size_t)R0 * DM, SKH, SKL, F.wave, F.lane);
        __syncthreads();
        skinny_reduce<2>(F.lds, F.tid);
        __syncthreads();
        for (int idx = F.tid; idx < 32 * 24; idx += NWAVES * 64) { const int row = idx / 24, c = idx % 24; SK0[(size_t)(R0 + row) * 24 + c] = LG[row * 32 + c]; }
    }
    __syncthreads();
}
__device__ __forceinline__ void p_fox_bias(Frame& F, const Args& a) {
    if (blockIdx.x >= 16) return;
    const int bh = blockIdx.x, b = bh >> 3, h = bh & 7, lane = F.lane, tid = F.tid; const float gb = a.in[5][h];
    const float* SK0 = (const float*)(F.ws + WS_SK0); float* FB = (float*)(F.ws + WS_FBIAS) + (size_t)bh * SEQ; LAS float* wt = (LAS float*)(F.lds + 120000);
    float lf[8], tot = 0.f;
#pragma unroll
    for (int i = 0; i < 8; ++i) lf[i] = SK0[(size_t)(b * SEQ + tid * 8 + i) * 24 + 16 + h];
#pragma unroll
    for (int i = 0; i < 8; ++i) { tot += logsigmoidf(lf[i] + gb); lf[i] = tot; }
    float incl = tot;
#pragma unroll
    for (int o = 1; o < 64; o <<= 1) { const float t = __shfl_up(incl, o); if (lane >= o) incl += t; }
    if (lane == 63) wt[F.wave] = incl;
    __syncthreads();
    float pre = incl - tot;
    for (int w = 0; w < F.wave; ++w) pre += wt[w];
#pragma unroll
    for (int i = 0; i < 8; ++i) FB[tid * 8 + i] = -(pre + lf[i]) * (1.0f / ATT_SCALE);
    __syncthreads();
}
__device__ __forceinline__ void p_ln_route(Frame& F, const Args& a, int layer) {
    const bf16* YB = (const bf16*)(F.ws + WS_YB); bf16* XB = (bf16*)(F.ws + WS_XB); const int lane = F.lane;
    const float* g = a.in[9] + layer * DM; const float* bb = a.in[10] + layer * DM;
    const bf16* SKH = (const bf16*)(F.ws + WS_WSM) + (size_t)(layer ? SK_ROUTE1 : SK_ROUTE0) * 2048; const bf16* SKL = SKH + (size_t)SK_NCOL * 2048;
    const float* bg = a.in[14] + layer * 4; const float* be = a.in[16] + layer * 32;
    int4* ROUTE = (int4*)(F.ws + WS_ROUTE); unsigned* cnt = F.ctl + CW_CNT + layer * 64; int* INV = (int*)(F.ws + WS_INV); float* WINV = (float*)(F.ws + WS_WINV);
    const LAS float* LG = (const LAS float*)(F.lds + SK_LG_OFF);
    for (int blk = blockIdx.x; blk < MTOK / 32; blk += F.G) { const int R0 = blk * 32;
#pragma unroll 2
        for (int i = 0; i < 4; ++i) { const int m = R0 + 4 * F.wave + i; f32x4 v[8];
            load_row_bf16(YB + (size_t)m * DM, v, lane);
            ln_row(v, g, bb, lane);
            store_row_bf16(XB + (size_t)m * DM, v, lane); }
        __syncthreads();
        skinny_partials<3>(F.lds, XB + (size_t)R0 * DM, SKH, SKL, F.wave, lane);
        __syncthreads();
        skinny_reduce<3>(F.lds, F.tid);
        __syncthreads();
        if (F.tid < 32) { const int m = R0 + F.tid; const LAS float* l = LG + F.tid * 48;
            float gl[4];
#pragma unroll
            for (int i = 0; i < 4; ++i) gl[i] = l[i] + bg[i];
            int gi = 0; float gm = gl[0];
#pragma unroll
            for (int i = 1; i < 4; ++i) if (gl[i] > gm) { gm = gl[i]; gi = i; }
            float gs = 0.f;
#pragma unroll
            for (int i = 0; i < 4; ++i) gs += __expf(gl[i] - gm);
            const float gp = 1.0f / gs;
            float el[8];
#pragma unroll
            for (int e = 0; e < 8; ++e) el[e] = l[4 + 8 * gi + e] + be[gi * 8 + e];
            int e1 = 0; float v1 = el[0];
#pragma unroll
            for (int e = 1; e < 8; ++e) if (el[e] > v1) { v1 = el[e]; e1 = e; }
            int e2 = -1; float v2 = -3.0e38f;
#pragma unroll
            for (int e = 0; e < 8; ++e) if (e != e1 && el[e] > v2) { v2 = el[e]; e2 = e; }
            const float w1 = gp / (1.0f + __expf(v2 - v1)), w2 = gp - w1;
            const int ge1 = gi * 8 + e1, ge2 = gi * 8 + e2;
            const int p1 = (int)atomicAdd(cnt + ge1, 1u), p2 = (int)atomicAdd(cnt + ge2, 1u);
            ROUTE[(size_t)m * 2 + 0] = make_int4(ge1, p1, 0, 0); ROUTE[(size_t)m * 2 + 1] = make_int4(ge2, p2, 0, 0);
            INV[ge1 * 8192 + p1] = m; INV[ge2 * 8192 + p2] = m; WINV[ge1 * 8192 + p1] = w1; WINV[ge2 * 8192 + p2] = w2; }
    }
    __syncthreads();
}
__device__ __forceinline__ int moe_offsets(const unsigned* cnt, int lane, int* tiles_incl) {
    const int c = lane < 32 ? (int)cnt[lane] : 0; const int t = (c + 255) >> 8; int incl = t;
#pragma unroll
    for (int o = 1; o < 32; o <<= 1) { const int x = __shfl_up(incl, o); if ((lane & 31) >= o) incl += x; }
    *tiles_incl = incl; return (incl - t) * 256;
}
__device__ __forceinline__ void p_ln_ffn(Frame& F, const Args& a, int layer) {
    bf16* XB = (bf16*)(F.ws + WS_XB); const int lane = F.lane; const bf16* YG = (const bf16*)(F.ws + WS_CST);
    const float* g = a.in[11] + layer * DM; const float* bb = a.in[12] + layer * DM; const int4* ROUTE = (const int4*)(F.ws + WS_ROUTE);
    const bf16* SKH = (const bf16*)(F.ws + WS_WSM) + (size_t)SK_SK1 * 2048; const bf16* SKL = SKH + (size_t)SK_NCOL * 2048;
    const float* c64 = (const float*)(F.ws + WS_ROPE) + 2 * 4096 * 64; const float* s64 = c64 + 4096 * 32;
    bf16* IK = (bf16*)(F.ws + WS_IK); float* IW = (float*)(F.ws + WS_IW);
    const LAS float* LG = (const LAS float*)(F.lds + SK_LG_OFF);
    int ti_; const int eoff = moe_offsets(F.ctl + CW_CNT + layer * 64, lane, &ti_);
    for (int blk = blockIdx.x; blk < MTOK / 32; blk += F.G) { const int R0 = blk * 32;
#pragma unroll 2
        for (int i = 0; i < 4; ++i) { const int m = R0 + 4 * F.wave + i; f32x4 v[8];
            const int4 q0 = ROUTE[(size_t)m * 2], q1 = ROUTE[(size_t)m * 2 + 1]; const int r0 = __shfl(eoff, q0.x) + q0.y, r1 = __shfl(eoff, q1.x) + q1.y;
            load_row_bf16(XB + (size_t)m * DM, v, lane);
#pragma unroll
            for (int j = 0; j < 8; ++j) { v[j] = v[j] * DN_ALPHA;
                const uint2 y0 = *(const uint2*)(YG + (size_t)r0 * DM + 256 * j + 4 * lane), y1 = *(const uint2*)(YG + (size_t)r1 * DM + 256 * j + 4 * lane);
                v[j][0] += bf2f(y0.x & 0xffff) + bf2f(y1.x & 0xffff); v[j][1] += bf2f(y0.x >> 16) + bf2f(y1.x >> 16);
                v[j][2] += bf2f(y0.y & 0xffff) + bf2f(y1.y & 0xffff); v[j][3] += bf2f(y0.y >> 16) + bf2f(y1.y >> 16); }
            ln_row(v, g, bb, lane);
            if (layer == 0) store_row_bf16(XB + (size_t)m * DM, v, lane);
            else {
#pragma unroll
                for (int j = 0; j < 8; ++j) *(f32x4*)(a.out + (size_t)m * DM + 256 * j + 4 * lane) = v[j]; } }
        if (layer == 0) {
            __syncthreads();
            skinny_partials<5>(F.lds, XB + (size_t)R0 * DM, SKH, SKL, F.wave, lane);
            __syncthreads();
            skinny_reduce<5>(F.lds, F.tid);
            __syncthreads();
            for (int idx = F.tid; idx < 32 * 80; idx += NWAVES * 64) { const int row = idx / 80, c = idx % 80, m = R0 + row; const float v = LG[row * 80 + c];
                if (c < 64) { const float part = LG[row * 80 + (c ^ 32)]; const int pos = m & 4095, i = c & 31; const float cs = c64[pos * 32 + i], sn = s64[pos * 32 + i];
                    const int bq = m >> 12, sq = m & 4095; IK[((((size_t)bq * 128 + (sq >> 5)) * 4 + (c >> 4)) * 64 + ((c >> 3) & 1) * 32 + (sq & 31)) * 8 + (c & 7)] = (bf16)f2bf(c < 32 ? (v * cs - part * sn) : (v * cs + part * sn)); }
                else IW[(size_t)m * 16 + c - 64] = v * 0.25f * 0.125f; }
        }
    }
    __syncthreads();
}
__device__ __forceinline__ void ph_gla_b(Frame& F, const Args& a) {
    const float* SK0 = (const float*)(F.ws + WS_SK0); const float* w2 = a.in[2]; const float* gbias = a.in[3]; float* GB = (float*)(F.ws + WS_GB); float* DEC = (float*)(F.ws + WS_DEC);
    for (int u4 = blockIdx.x; u4 < 128; u4 += F.G) {
        const int unit = u4 * 4 + (F.tid >> 7), n = unit & 63, bh = unit >> 6, b = bh >> 2, h = bh & 3, d = F.tid & 127, t0 = b * SEQ + n * 64;
        float w[16];
#pragma unroll
        for (int r = 0; r < 16; ++r) w[r] = w2[r * 512 + h * 128 + d];
        const float gb = gbias[h * 128 + d]; float run = 0.f;
        for (int c = 0; c < 64; ++c) { const int t = t0 + c; float z = gb;
#pragma unroll
            for (int r = 0; r < 16; ++r) z += SK0[(size_t)t * 24 + r] * w[r];
            run += logsigmoidf(z) * (1.0f / 16.0f); GB[(size_t)t * 512 + h * 128 + d] = run; }
        DEC[unit * 128 + d] = __expf(run);
    }
}
__device__ __forceinline__ void ph_gla_state(Frame& F) {
    const bf16* PROJ = (const bf16*)(F.ws + WS_PROJ); const float* GB = (const float*)(F.ws + WS_GB); float* CST = (float*)(F.ws + WS_CST);
    for (int vb = blockIdx.x; vb < 512 * 64; vb += F.G) {
        const int unit = vb >> 6, d = (vb & 63) * 2 + (F.tid >> 8), v = F.tid & 255, n = unit & 63, bh = unit >> 6, b = bh >> 2, h = bh & 3, t0 = b * SEQ + n * 64;
        const float blast = GB[(size_t)(t0 + 63) * 512 + h * 128 + d]; float acc = 0.f;
        for (int c = 0; c < 64; ++c) { const size_t t = t0 + c; const float kk = bf2f(PROJ[t * NP0 + 512 + h * 128 + d]) * __expf(blast - GB[t * 512 + h * 128 + d]);
            acc += kk * bf2f(PROJ[t * NP0 + 1024 + h * 256 + v]); }
        CST[((size_t)unit * 256 + v) * 128 + d] = acc;
    }
}
__device__ __forceinline__ void ph_gla_scan(Frame& F) {
    const bf16* CST = (const bf16*)(F.ws + WS_CST); const float* DEC = (const float*)(F.ws + WS_DEC); bf16* PREVT = (bf16*)(F.ws + WS_PREVT);
    for (int idx = blockIdx.x * 512 + F.tid; idx < 8 * 32768; idx += F.G * 512) { const int bh = idx >> 15, vd = idx & 32767, d = vd & 127; float S = 0.f;
        for (int n = 0; n < 64; ++n) { const int unit = bh * 64 + n; PREVT[(size_t)unit * 32768 + vd] = (bf16)f2bf(S); S = DEC[unit * 128 + d] * S + bf2f(CST[(size_t)unit * 32768 + vd]); } }
}
__device__ __forceinline__ void ph_gla_out(Frame& F, const Args& a) {
    const bf16* PROJ = (const bf16*)(F.ws + WS_PROJ); const float* GB = (const float*)(F.ws + WS_GB); const bf16* PREVT = (const bf16*)(F.ws + WS_PREVT); const float* normg = a.in[4]; bf16* OMIX = (bf16*)(F.ws + WS_OMIX);
    LAS float* qd = (LAS float*)F.lds; LAS float* ki = qd + 64 * 128; LAS float* sc = ki + 64 * 128; LAS float* red = sc + 64 * 64;
    const int tid = F.tid; const bool act = tid < 256;
    for (int unit = blockIdx.x; unit < 512; unit += F.G) {
        const int n = unit & 63, bh = unit >> 6, b = bh >> 2, h = bh & 3, t0 = b * SEQ + n * 64;
        __syncthreads();
        for (int i = tid; i < 64 * 128; i += 512) { const int c = i >> 7, d = i & 127; const size_t t = t0 + c; const float bb = GB[t * 512 + h * 128 + d];
            qd[i] = bf2f(PROJ[t * NP0 + h * 128 + d]) * ATT_SCALE * __expf(bb); ki[i] = bf2f(PROJ[t * NP0 + 512 + h * 128 + d]) * __expf(-bb); }
        __syncthreads();
        for (int p = tid; p < 64 * 64; p += 512) { const int i = p >> 6, j = p & 63; float s = 0.f;
            if (j <= i) for (int d = 0; d < 128; ++d) s += qd[i * 128 + d] * ki[j * 128 + d];
            sc[p] = s; }
        __syncthreads();
        const int v = tid & 255; const bf16* pv = PREVT + ((size_t)unit * 256 + v) * 128; const float gv = normg[v];
        for (int i = 0; i < 64; ++i) { float acc = 0.f;
            if (act) { for (int j = 0; j <= i; ++j) acc += sc[i * 64 + j] * bf2f(PROJ[(size_t)(t0 + j) * NP0 + 1024 + h * 256 + v]);
                for (int d = 0; d < 128; ++d) acc += qd[i * 128 + d] * bf2f(pv[d]);
                const float ss = wave_sum(acc * acc); if ((tid & 63) == 0) red[tid >> 6] = ss; }
            __syncthreads();
            const float ms = (red[0] + red[1] + red[2] + red[3]) * (1.0f / 256.0f); __syncthreads();
            if (act) { const float gr = bf2f(PROJ[(size_t)(t0 + i) * NP0 + 2048 + h * 256 + v]);
                const float o = acc * (1.0f / sqrtf(ms + LN_EPS)) * gv * (gr / (1.0f + __expf(-gr)));
                OMIX[(size_t)(t0 + i) * DM + h * 256 + v] = (bf16)f2bf(o); } }
    }
}
template <int MODE  >
__device__ __forceinline__ void ph_attn_naive(Frame& F, const bf16* Qb, int ldq, int qc0, const bf16* Kb, int ldk, int kc0, const bf16* Vb, int ldv, int vc0, int nheads, int group,
                                              const float* fbias, const unsigned long long* mask, bf16* O, int oc0) {
    const int half = F.tid >> 8, tid = F.tid & 255, qi = tid >> 2, part = tid & 3;
    LAS bf16* Ks = (LAS bf16*)(F.lds + half * 32768); LAS bf16* Vs = Ks + 64 * 128;
    const int nvb = (SEQ / 64) * (nheads / 2) * BATCH;
    for (int vb = blockIdx.x; vb < nvb; vb += F.G) {
        const int cc = vb >> 6, qb = ((vb & 63) + cc * 17) & 63, hp = cc % (nheads / 2), b = cc / (nheads / 2), h = hp * 2 + half, kvh = h / group;
        const int qpos = qb * 64 + qi; const size_t row = (size_t)b * SEQ + qpos;
        float qv[32], o[32];
#pragma unroll
        for (int d = 0; d < 32; ++d) { qv[d] = bf2f(Qb[row * ldq + qc0 + h * 128 + part * 32 + d]); o[d] = 0.f; }
        float mrun = -1e30f, l = 0.f;
        const float* fb = MODE == 0 ? fbias + (size_t)(b * 8 + h) * SEQ : nullptr;
        for (int kt = 0; kt <= qb; ++kt) {
            __syncthreads();
            for (int i = tid; i < 64 * 16; i += 256) { const int r = i >> 4, c8 = (i & 15) * 8; const size_t kr = (size_t)b * SEQ + kt * 64 + r;
                *(LAS v4u*)(Ks + r * 128 + c8) = *(const v4u*)(Kb + kr * ldk + kc0 + kvh * 128 + c8); *(LAS v4u*)(Vs + r * 128 + c8) = *(const v4u*)(Vb + kr * ldv + vc0 + kvh * 128 + c8); }
            __syncthreads();
            unsigned long long mw = ~0ull; if (MODE == 1) mw = mask[row * 64 + kt];
            for (int s = 0; s < 64; ++s) { const int key = kt * 64 + s; float p = 0.f;
#pragma unroll
                for (int d = 0; d < 32; ++d) p += qv[d] * bf2f(Ks[s * 128 + part * 32 + d]);
                p += __shfl_xor(p, 1); p += __shfl_xor(p, 2);
                const bool valid = key <= qpos && ((mw >> s) & 1ull);
                if (valid) { const float logit = (p + (MODE == 0 ? fb[key] : 0.f)) * ATT_SCALE; const float mn = fmaxf(mrun, logit), al = __expf(mrun - mn), pp = __expf(logit - mn);
                    l = l * al + pp; mrun = mn;
#pragma unroll
                    for (int d = 0; d < 32; ++d) o[d] = o[d] * al + pp * bf2f(Vs[s * 128 + part * 32 + d]); } }
        }
        const float il = 1.0f / l;
#pragma unroll
        for (int d = 0; d < 32; ++d) O[row * DM + oc0 + h * 128 + part * 32 + d] = (bf16)f2bf(o[d] * il);
    }
    __syncthreads();
}
__device__ __forceinline__ void ph_idx_scores(Frame& F) {
    const bf16* PROJ1 = (const bf16*)(F.ws + WS_PROJ); const bf16* IK = (const bf16*)(F.ws + WS_IK); const float* IW = (const float*)(F.ws + WS_IW); float* SC = (float*)(F.ws + WS_SC);
    LAS float* q = (LAS float*)F.lds; LAS float* w = q + 1024; const int tid = F.tid;
    for (int m = blockIdx.x; m < MTOK; m += F.G) { const int pos = m & 4095, b = m >> 12;
        __syncthreads();
        for (int i = tid; i < 1024; i += 512) q[i] = bf2f(PROJ1[(size_t)m * NP1 + 3072 + i]);
        if (tid < 16) w[tid] = IW[(size_t)m * 16 + tid];
        __syncthreads();
        for (int s = tid; s <= pos; s += 512) { const bf16* kr = IK + ((size_t)b * SEQ + s) * 64; float kk[64];
#pragma unroll
            for (int d = 0; d < 64; ++d) kk[d] = bf2f(kr[d]);
            float sc = 0.f;
#pragma unroll 1
            for (int hh = 0; hh < 16; ++hh) { float dsum = 0.f;
#pragma unroll
                for (int d = 0; d < 64; ++d) dsum += q[hh * 64 + d] * kk[d];
                sc += w[hh] * fmaxf(dsum, 0.f); }
            SC[(size_t)m * SEQ + s] = sc; }
    }
    __syncthreads();
}
namespace attn {
constexpr int D = 128, NW = 8, QBLK = 32, KVBLK = 64, QB = NW * QBLK;
constexpr int SHM_V = KVBLK * D * 2, SHM_K = KVBLK * D * 2;
constexpr int OFF_WS = 2 * SHM_V + 2 * SHM_K, OFF_BIAS = OFF_WS + NW * 64 * 4, LDS_NEED = OFF_BIAS + 2 * 16384;
constexpr float SCALE = 0.08838834764831845f, THR = 8.f;
typedef short s16x4 __attribute__((ext_vector_type(4)));
typedef float f32x16 __attribute__((ext_vector_type(16)));
typedef unsigned u32x4 __attribute__((ext_vector_type(4)));
#define KSWZ(row, colB) ((row) * 256 + ((colB) ^ (((row) & 7) << 4)))
#define SBAR() __builtin_amdgcn_sched_barrier(0)
__device__ __forceinline__ int v_st(int k, int c) { const int kk = (k & ~0xC) | ((k & 4) << 1) | ((k & 8) >> 1); return ((kk >> 3) * 4 + (c >> 5)) * 512 + ((kk & 7) * 32 + (c & 31)) * 2; }
__device__ __forceinline__ int v_rd_base(int lane) { return ((lane & 3) << 3) | (((lane >> 2) & 3) << 6) | (((lane >> 4) & 1) << 5) | (((lane >> 5) & 1) << 8); }
constexpr int v_rd_off(int d0, int ks, int half) { return d0 * 512 + ks * 4096 + half * 2048; }
__device__ __forceinline__ int crow(int r, int hi) { return (r & 3) + 8 * (r >> 2) + 4 * hi; }
__device__ __forceinline__ unsigned cvtpk(float lo, float hi) { unsigned r; asm volatile("v_cvt_pk_bf16_f32 %0, %1, %2" : "=v"(r) : "v"(lo), "v"(hi)); return r; }
__device__ __forceinline__ bf16x8 load8(const bf16* p) { return *reinterpret_cast<const bf16x8*>(p); }
__device__ __forceinline__ void mask_tile(f32x16& p0, f32x16& p1, int dq) {
    const float NEG = -__builtin_inff();
#pragma unroll
    for (int r = 0; r < 16; ++r) { const int c = (r & 3) + 8 * (r >> 2); if (dq - c < 0) p0[r] = NEG; if (dq - c - 32 < 0) p1[r] = NEG; }
}
__device__ __forceinline__ void mask_bits(f32x16& p0, f32x16& p1, unsigned w0, unsigned w1) {
#pragma unroll
    for (int r = 0; r < 16; ++r) { const unsigned c = (r & 3) + 8 * (r >> 2);
        const unsigned m0 = (unsigned)__builtin_amdgcn_sbfe((int)w0, c, 1), m1 = (unsigned)__builtin_amdgcn_sbfe((int)w1, c, 1);
        p0[r] = __uint_as_float((m0 & __float_as_uint(p0[r])) | (~m0 & 0xFF800000u)); p1[r] = __uint_as_float((m1 & __float_as_uint(p1[r])) | (~m1 & 0xFF800000u)); }
}
__device__ __forceinline__ void partialSM(f32x16& p0, f32x16& p1, float& m_reg, float& mn, float& alpha) {
    float pmax = p0[0]; for (int r = 1; r < 16; ++r) pmax = fmaxf(pmax, p0[r]); for (int r = 0; r < 16; ++r) pmax = fmaxf(pmax, p1[r]);
    { auto rr = __builtin_amdgcn_permlane32_swap(__float_as_uint(pmax), __float_as_uint(pmax), false, false);
      pmax = fmaxf(__uint_as_float(rr[0]), __uint_as_float(rr[1])); }
    constexpr float C2 = 1.4426950408889634f * SCALE;
    if (__builtin_expect(__all((pmax - m_reg) * SCALE <= THR), 1)) { mn = m_reg; alpha = 1.f; }
    else { mn = fmaxf(m_reg, pmax); alpha = __builtin_amdgcn_exp2f((m_reg - mn) * C2); m_reg = mn; }
    const float mnL = -mn * C2;
    for (int r = 0; r < 16; ++r) p0[r] = fmaf(p0[r], C2, mnL); for (int r = 0; r < 16; ++r) p1[r] = fmaf(p1[r], C2, mnL);
    for (int r = 0; r < 16; ++r) p0[r] = __builtin_amdgcn_exp2f(p0[r]);
}
__device__ __forceinline__ void finishSM(f32x16& p0, f32x16& p1, float alpha, float& l_reg, bf16x8& pa0, bf16x8& pa1, bf16x8& pa2, bf16x8& pa3) {
    for (int r = 0; r < 16; ++r) p1[r] = __builtin_amdgcn_exp2f(p1[r]);
    float ps = 0; for (int r = 0; r < 16; ++r) ps += p0[r]; for (int r = 0; r < 16; ++r) ps += p1[r];
    { auto rr = __builtin_amdgcn_permlane32_swap(__float_as_uint(ps), __float_as_uint(ps), false, false);
      ps = __uint_as_float(rr[0]) + __uint_as_float(rr[1]); }
    l_reg = l_reg * alpha + ps;
#define PK4(P, B_, OUT) do { unsigned a0 = cvtpk(P[B_+0], P[B_+1]), a1 = cvtpk(P[B_+2], P[B_+3]);                          \
        unsigned b0 = cvtpk(P[B_+4], P[B_+5]), b1 = cvtpk(P[B_+6], P[B_+7]);                                             \
        auto r0 = __builtin_amdgcn_permlane32_swap(a0, b0, false, false); auto r1 = __builtin_amdgcn_permlane32_swap(a1, b1, false, false); \
        u32x4 w = {r0[0], r1[0], r0[1], r1[1]}; OUT = *reinterpret_cast<bf16x8*>(&w); } while (0)
    PK4(p0, 0, pa0); PK4(p0, 8, pa1); PK4(p1, 0, pa2); PK4(p1, 8, pa3);
#undef PK4
}
template <int KB, bool BIAS>
__device__ __forceinline__ void qkt(f32x16& p0, f32x16& p1, const char* K_lds, int r32, int hi, const bf16x8* qr, const char* bl) {
    p0 = f32x16{}; p1 = f32x16{}; (void)bl;
    const char* kb[4];
#pragma unroll
    for (int dd = 0; dd < 4; ++dd) kb[dd] = K_lds + KB * SHM_K + KSWZ(r32, (dd * 16 + hi * 8) * 2);
#pragma unroll
    for (int d0 = 0; d0 < 8; ++d0) { const char* a = kb[d0 & 3] + (d0 >> 2) * 128;
        bf16x8 b0 = *reinterpret_cast<const bf16x8*>(a);
        bf16x8 b1 = *reinterpret_cast<const bf16x8*>(a + 32 * 256);
        p0 = __builtin_amdgcn_mfma_f32_32x32x16_bf16(b0, qr[d0], p0, 0, 0, 0);
        p1 = __builtin_amdgcn_mfma_f32_32x32x16_bf16(b1, qr[d0], p1, 0, 0, 0); }
}
template <int VB>
__device__ __forceinline__ void pv_tile(f32x16* o, int vb0, bf16x8 pa0, bf16x8 pa1, bf16x8 pa2, bf16x8 pa3) {
#define TRRD(dst, off) asm volatile("ds_read_b64_tr_b16 %0, %1 offset:%2" : "=&v"(dst) : "v"(vb0), "i"(off) : "memory")
#define PV_D0(d0) do { s16x4 l0, l1, l2, l3, h0, h1, h2, h3; constexpr int b_ = VB * SHM_V + v_rd_off(d0, 0, 0); \
        TRRD(l0, b_); TRRD(h0, b_ + 2048); TRRD(l1, b_ + 4096); TRRD(h1, b_ + 6144); TRRD(l2, b_ + 8192); TRRD(h2, b_ + 10240); TRRD(l3, b_ + 12288); TRRD(h3, b_ + 14336); \
        asm volatile("s_waitcnt lgkmcnt(0)" ::: "memory"); SBAR();   \
        o[d0] = __builtin_amdgcn_mfma_f32_32x32x16_bf16(pa0, (bf16x8){l0[0], l0[1], l0[2], l0[3], h0[0], h0[1], h0[2], h0[3]}, o[d0], 0, 0, 0);   \
        o[d0] = __builtin_amdgcn_mfma_f32_32x32x16_bf16(pa1, (bf16x8){l1[0], l1[1], l1[2], l1[3], h1[0], h1[1], h1[2], h1[3]}, o[d0], 0, 0, 0);   \
        o[d0] = __builtin_amdgcn_mfma_f32_32x32x16_bf16(pa2, (bf16x8){l2[0], l2[1], l2[2], l2[3], h2[0], h2[1], h2[2], h2[3]}, o[d0], 0, 0, 0);   \
        o[d0] = __builtin_amdgcn_mfma_f32_32x32x16_bf16(pa3, (bf16x8){l3[0], l3[1], l3[2], l3[3], h3[0], h3[1], h3[2], h3[3]}, o[d0], 0, 0, 0); } while (0)
    PV_D0(0); PV_D0(1); PV_D0(2); PV_D0(3);
#undef PV_D0
#undef TRRD
}
struct BlockRef { const bf16* Q; const bf16* K; const bf16* V; bf16* O; int P0; const float* fb; const unsigned long long* mrow; };
struct Seam { bf16x8 qr[8]; bf16x8 st_v0, st_v1, st_k0, st_k1; };
#define VMW() asm volatile("s_waitcnt vmcnt(0)" ::: "memory")
#define VMWN(n) asm volatile("s_waitcnt vmcnt(%0)" :: "i"(n) : "memory")
#define SLOAD_H(Kp, Vp, k0) do { const bf16* kt_ = (Kp) + (size_t)(k0) * KS; const bf16* vt_ = (Vp) + (size_t)(k0) * KS; S.st_v0 = load8(vt_ + koff); S.st_v1 = load8(vt_ + koff + 32 * KS); S.st_k0 = load8(kt_ + koff); S.st_k1 = load8(kt_ + koff + 32 * KS); } while (0)
#define SWRITE_HK(bf) do { *(bf16x8*)(K_lds + (bf) * SHM_K + kws) = S.st_k0; *(bf16x8*)(K_lds + (bf) * SHM_K + kws + 32 * 256) = S.st_k1; } while (0)
#define SWRITE_HV(bf) do { *(bf16x8*)(V_lds + (bf) * SHM_V + vst0) = S.st_v0; *(bf16x8*)(V_lds + (bf) * SHM_V + vst1) = S.st_v1; } while (0)
#define SWRITE_H(bf) do { SWRITE_HV(bf); SWRITE_HK(bf); } while (0)
template <bool BIAS, bool BITMASK, int QS, int KS, int OS>
__device__ __forceinline__ void attn_block(const BlockRef& cur, char* lds, LAS unsigned char* ldsl) {
    int tid_ = threadIdx.x; asm volatile("" : "+v"(tid_));
    const int tid = tid_, wid = __builtin_amdgcn_readfirstlane(tid >> 6), lane = tid & 63, r32 = lane & 31, hi = lane >> 5;
    const int NT = (cur.P0 + QB - 1) / KVBLK + 1;
    const int qlo = cur.P0 + wid * QBLK, qm = qlo + r32 - 4 * hi;
    char* V_lds = lds; char* K_lds = lds + 2 * SHM_V;
    float* ws = (float*)(lds + OFF_WS) + wid * 64; float* li_l = ws, * al_l = ws + 32;
    const LAS unsigned char* bl0 = ldsl + OFF_BIAS + hi * 16;
    float m_reg = -1e30f, l_reg = 0; f32x16 o[4] = {};
    const int sr = tid >> 4, sc = (tid & 15) * 8, vst0 = v_st(sr, sc), vst1 = v_st(32 + sr, sc), kws = KSWZ(sr, sc * 2);
    const int vb0 = (int)(uintptr_t)V_lds + v_rd_base(lane);
    const bf16* Kh = cur.K; const bf16* Vh = cur.V;
    const int moff = (wid * QBLK + r32) * 64, koff = sr * KS + sc, qoff = (wid * QBLK + r32) * QS + hi * 8;
    Seam S;
#pragma unroll
    for (int d0 = 0; d0 < 8; ++d0) S.qr[d0] = load8(cur.Q + qoff + d0 * 16);
    if constexpr (BIAS) { const f32x4 b0_ = *(const f32x4*)(cur.fb + tid * 8), b1_ = *(const f32x4*)(cur.fb + tid * 8 + 4);
        *(LAS f32x4*)(ldsl + OFF_BIAS + tid * 32) = b0_; *(LAS f32x4*)(ldsl + OFF_BIAS + tid * 32 + 16) = b1_; }
    SLOAD_H(Kh, Vh, 0); VMW(); SWRITE_HK(0); SWRITE_HV(0); SBAR();
#define RESC(a) do { if (__any((a) < 1.f)) { if (hi == 0) al_l[r32] = (a); asm volatile("s_waitcnt lgkmcnt(0)" ::: "memory");              \
                     for (int d_ = 0; d_ < 4; ++d_) for (int r = 0; r < 16; ++r) o[d_][r] *= al_l[crow(r, hi)]; } } while (0)
#define KBASE(t) ((t) * KVBLK)
#define MLOAD(MW, t) do { if constexpr (BITMASK) MW = (cur.mrow + (t))[moff]; } while (0)
#define MASKT(P0_, P1_, MW, t) do { if constexpr (BIAS) { const LAS unsigned char* bl_ = bl0 + KBASE(t) * 4; _Pragma("unroll") for (int g = 0; g < 4; ++g) { const f32x4 a_ = *(const LAS f32x4*)(bl_ + g * 32), b_ = *(const LAS f32x4*)(bl_ + 128 + g * 32); \
            P0_[4 * g] += a_[0]; P0_[4 * g + 1] += a_[1]; P0_[4 * g + 2] += a_[2]; P0_[4 * g + 3] += a_[3]; P1_[4 * g] += b_[0]; P1_[4 * g + 1] += b_[1]; P1_[4 * g + 2] += b_[2]; P1_[4 * g + 3] += b_[3]; } } \
        if constexpr (BITMASK) { mask_bits(P0_, P1_, (unsigned)(MW) >> (4 * hi), (unsigned)((MW) >> 32) >> (4 * hi)); } \
        else { const int kb_ = KBASE(t); if (kb_ + KVBLK - 1 > qlo) mask_tile(P0_, P1_, qm - kb_); } } while (0)
    f32x16 pA0, pA1, pB0, pB1; float mnA, mnB, alA, alB; bf16x8 pa0, pa1, pa2, pa3; unsigned long long mwA = 0, mwB = 0;
    MLOAD(mwA, 0);
    SLOAD_H(Kh, Vh, KBASE(1)); MLOAD(mwB, 1);
    __syncthreads();
    SBAR(); qkt<0, BIAS>(pA0, pA1, K_lds, r32, hi, S.qr, nullptr);
    MASKT(pA0, pA1, mwA, 0); partialSM(pA0, pA1, m_reg, mnA, alA);
    VMW(); SWRITE_H(1);
    __syncthreads();
#define HALF_STEP(PX0, PX1, mnX, alX, MWX, PY0, PY1, alY, MWY, t, KB, VB, SB) do {                                            \
        SBAR(); qkt<KB, BIAS>(PX0, PX1, K_lds, r32, hi, S.qr, nullptr);                                                       \
        finishSM(PY0, PY1, alY, l_reg, pa0, pa1, pa2, pa3); SBAR();                                                           \
        if ((t) + 1 < NT) { SLOAD_H(Kh, Vh, KBASE((t) + 1)); MLOAD(MWY, (t) + 1); SBAR(); }                                   \
        pv_tile<VB>(o, vb0, pa0, pa1, pa2, pa3); MASKT(PX0, PX1, MWX, (t)); partialSM(PX0, PX1, m_reg, mnX, alX);             \
        __syncthreads();                                                                                                      \
        if ((t) + 1 < NT) { VMW(); SWRITE_H(SB); }                                                                            \
        RESC(alX); __syncthreads(); } while (0)
    for (int t = 1; t + 1 < NT; t += 2) {
        HALF_STEP(pB0, pB1, mnB, alB, mwB, pA0, pA1, alA, mwA, t, 1, 0, 0);
        HALF_STEP(pA0, pA1, mnA, alA, mwA, pB0, pB1, alB, mwB, t + 1, 0, 1, 1);
    }
    SBAR(); qkt<1, BIAS>(pB0, pB1, K_lds, r32, hi, S.qr, nullptr); SBAR();
    finishSM(pA0, pA1, alA, l_reg, pa0, pa1, pa2, pa3); SBAR();
    pv_tile<0>(o, vb0, pa0, pa1, pa2, pa3);
    MASKT(pB0, pB1, mwB, NT - 1); partialSM(pB0, pB1, m_reg, mnB, alB); __syncthreads(); RESC(alB);
    finishSM(pB0, pB1, alB, l_reg, pa0, pa1, pa2, pa3); SBAR(); pv_tile<1>(o, vb0, pa0, pa1, pa2, pa3);
    SBAR();
    if (hi == 0) li_l[r32] = l_reg; asm volatile("s_waitcnt lgkmcnt(0)" ::: "memory");
    float rli[16];
#pragma unroll
    for (int r = 0; r < 16; ++r) rli[r] = __builtin_amdgcn_rcpf(li_l[crow(r, hi)]);
    int tid2_ = threadIdx.x; asm volatile("" : "+v"(tid2_));
    const int r32e = tid2_ & 31, hie = (tid2_ >> 5) & 1, ooff = (wid * QBLK + 4 * hie) * OS + r32e;
#pragma unroll
    for (int r = 0; r < 16; ++r) {
#pragma unroll
        for (int d0 = 0; d0 < 4; ++d0) { const float v = o[d0][r] * rli[r]; const float vn = __shfl_xor(v, 1);
            if ((r32e & 1) == 0) *(unsigned*)(cur.O + ((r & 3) + 8 * (r >> 2)) * OS + d0 * 32 + ooff) = cvtpk(v, vn); } }
    __syncthreads();
#undef RESC
#undef KBASE
#undef MLOAD
#undef MASKT
#undef HALF_STEP
}
#undef ROWK
#undef VMW
#undef VMWN
#undef SLOAD_H
#undef SWRITE_HK
#undef SWRITE_HV
#undef SWRITE_H
#undef KSWZ
#undef SBAR
template <bool BIAS, bool BITMASK, int NH, int GROUP, bool PAIR, int QS, int KS, int OS>
__device__ __forceinline__ void attn_phase(char* lds, LAS unsigned char* ldsl, const bf16* Q, const bf16* K, const bf16* V, bf16* O, const float* fbias, const unsigned long long* mask, int G, int bid) {
    constexpr int NBLK = BATCH * NH * 16, NITEM = PAIR ? NBLK / 2 : NBLK, PER = PAIR ? 8 : 16, SETH = BATCH * NH / 8;
    for (int L = bid; L < NITEM; L += G) {
#pragma unroll 1
        for (int pass = 0; pass < (PAIR ? 2 : 1); ++pass) {
            const int g = L & 7, k = L >> 3, hs = k / PER, x = k % PER; const int bh = g * SETH + hs, b = bh / NH, h = bh % NH;
            const int qb = PAIR ? (pass ? 15 - x : x) : 15 - x; BlockRef r; const size_t row0 = (size_t)b * SEQ + (size_t)qb * QB;
            r.Q = Q + row0 * QS + h * D; r.O = O + row0 * OS + h * D; r.K = K + (size_t)b * SEQ * KS + (h / GROUP) * D; r.V = V + (size_t)b * SEQ * KS + (h / GROUP) * D; r.P0 = qb * QB;
            r.fb = BIAS ? fbias + (size_t)bh * SEQ : nullptr; r.mrow = BITMASK ? mask + row0 * 64 : nullptr;
            attn_block<BIAS, BITMASK, QS, KS, OS>(r, lds, ldsl);
        }
    }
}
}
__device__ __forceinline__ float fast_silu(float g) { return g * __builtin_amdgcn_rcpf(1.0f + __expf(-g)); }
__device__ __forceinline__ void ph_gla_a(Frame& F, const Args& a) {
    const float* SK0 = (const float*)(F.ws + WS_SK0); const float* w2 = a.in[2]; const float* gbias = a.in[3]; float* GB = (float*)(F.ws + WS_GB); float* DEC = (float*)(F.ws + WS_DEC);
    const bf16* PROJ = (const bf16*)(F.ws + WS_PROJ); bf16* CST = (bf16*)(F.ws + WS_CST);
    LAS float* BSH = (LAS float*)F.lds; LAS float* TOT = BSH + 64 * 128; LAS bf16* VT = (LAS bf16*)(F.lds + 36864); LAS bf16* KET = (LAS bf16*)(F.lds + 73728);
    const int tid = F.tid, lane = F.lane, l15 = lane & 15, quad = lane >> 4, w = F.wave;
    for (int unit = blockIdx.x; unit < 512; unit += F.G) {
        const int n = unit & 63, bh = unit >> 6, b = bh >> 2, h = bh & 3, t0 = b * SEQ + n * 64;
        __syncthreads();
        {
            const int d = tid & 127, cg = tid >> 7; float wv[16];
#pragma unroll
            for (int r = 0; r < 16; ++r) wv[r] = w2[r * 512 + h * 128 + d];
            const float gb = gbias[h * 128 + d]; float run = 0.f;
            for (int cc = 0; cc < 16; ++cc) { const int c = cg * 16 + cc; const float* sk = SK0 + (size_t)(t0 + c) * 24; float z = gb;
#pragma unroll
                for (int r = 0; r < 16; ++r) z += sk[r] * wv[r];
                run += logsigmoidf(z) * (1.0f / 16.0f); BSH[c * 128 + d] = run; }
            TOT[cg * 128 + d] = run;
            __syncthreads();
            float pre = 0.f;
            for (int g = 0; g < cg; ++g) pre += TOT[g * 128 + d];
            for (int cc = 0; cc < 16; ++cc) { const int c = cg * 16 + cc; const float v = BSH[c * 128 + d] + pre; BSH[c * 128 + d] = v; GB[(size_t)(t0 + c) * 512 + h * 128 + d] = v; }
        }
        __syncthreads();
        {
            const int c = tid & 63, g8 = tid >> 6; const size_t t = (size_t)(t0 + c);
            const bf16* kp = PROJ + t * NP0 + 512 + h * 128 + g8 * 16;
            const v4u k0 = *(const v4u*)kp, k1 = *(const v4u*)(kp + 8);
            const unsigned kw[8] = {k0.x, k0.y, k0.z, k0.w, k1.x, k1.y, k1.z, k1.w};
#pragma unroll
            for (int i = 0; i < 8; ++i) { const int d = g8 * 16 + 2 * i; const float e0 = __expf(BSH[63 * 128 + d] - BSH[c * 128 + d]), e1 = __expf(BSH[63 * 128 + d + 1] - BSH[c * 128 + d + 1]);
                KET[d * 72 + c] = (bf16)f2bf(bf2f(kw[i] & 0xffff) * e0); KET[(d + 1) * 72 + c] = (bf16)f2bf(bf2f(kw[i] >> 16) * e1); }
            const bf16* vp = PROJ + t * NP0 + 1024 + h * 256 + g8 * 32;
#pragma unroll
            for (int q = 0; q < 4; ++q) { const v4u vv = *(const v4u*)(vp + 8 * q); const unsigned vw[4] = {vv.x, vv.y, vv.z, vv.w};
#pragma unroll
                for (int i = 0; i < 4; ++i) { const int v = g8 * 32 + q * 8 + 2 * i; VT[v * 72 + c] = (bf16)(vw[i] & 0xffff); VT[(v + 1) * 72 + c] = (bf16)(vw[i] >> 16); } }
            if (tid < 128) DEC[unit * 128 + tid] = __expf(BSH[63 * 128 + tid]);
        }
        __syncthreads();
        {
            pg8::f32x4 acc[2][8];
#pragma unroll
            for (int i = 0; i < 2; ++i)
#pragma unroll
                for (int nn = 0; nn < 8; ++nn) acc[i][nn] = (pg8::f32x4){0.f, 0.f, 0.f, 0.f};
#pragma unroll
            for (int kk = 0; kk < 64; kk += 32) {
                const bf16x8 a0 = *(const LAS bf16x8*)(VT + (32 * w + l15) * 72 + kk + quad * 8), a1 = *(const LAS bf16x8*)(VT + (32 * w + 16 + l15) * 72 + kk + quad * 8);
#pragma unroll
                for (int nn = 0; nn < 8; ++nn) { const bf16x8 bb = *(const LAS bf16x8*)(KET + (16 * nn + l15) * 72 + kk + quad * 8);
                    acc[0][nn] = __builtin_amdgcn_mfma_f32_16x16x32_bf16(bb, a0, acc[0][nn], 0, 0, 0); acc[1][nn] = __builtin_amdgcn_mfma_f32_16x16x32_bf16(bb, a1, acc[1][nn], 0, 0, 0); } }
            bf16* cp = CST + (size_t)unit * 32768;
#pragma unroll
            for (int i = 0; i < 2; ++i)
#pragma unroll
                for (int nn = 0; nn < 8; ++nn) { uint2 o; o.x = pk2(acc[i][nn][0], acc[i][nn][1]); o.y = pk2(acc[i][nn][2], acc[i][nn][3]);
                    *(uint2*)(cp + (32 * w + 16 * i + l15) * 128 + 16 * nn + quad * 4) = o; }
        }
    }
    __syncthreads();
}
__device__ __forceinline__ void ph_gla_c(Frame& F, const Args& a) {
    const bf16* PROJ = (const bf16*)(F.ws + WS_PROJ); const float* GB = (const float*)(F.ws + WS_GB); const bf16* PREVT = (const bf16*)(F.ws + WS_PREVT); const float* normg = a.in[4]; bf16* OMIX = (bf16*)(F.ws + WS_OMIX);
    LAS bf16* QD = (LAS bf16*)(F.lds + 32768); LAS bf16* KI = (LAS bf16*)(F.lds + 50176); LAS bf16* P = (LAS bf16*)(F.lds + 67584); LAS bf16* VT = (LAS bf16*)(F.lds + 76800); LAS float* RED = (LAS float*)(F.lds + 113664);
    const int tid = F.tid, lane = F.lane, l15 = lane & 15, quad = lane >> 4, w = F.wave;
    for (int unit = blockIdx.x; unit < 512; unit += F.G) {
        const int n = unit & 63, bh = unit >> 6, b = bh >> 2, h = bh & 3, t0 = b * SEQ + n * 64;
        __syncthreads();
        {
            const int c = tid >> 3, dg = tid & 7; const size_t t = (size_t)(t0 + c);
            const float* bp = GB + t * 512 + h * 128 + dg * 16; const bf16* qp = PROJ + t * NP0 + h * 128 + dg * 16; const bf16* kp = PROJ + t * NP0 + 512 + h * 128 + dg * 16;
#pragma unroll
            for (int q8 = 0; q8 < 2; ++q8) { const v4u qq = *(const v4u*)(qp + 8 * q8), kk = *(const v4u*)(kp + 8 * q8); const f32x4 b0 = *(const f32x4*)(bp + 8 * q8), b1 = *(const f32x4*)(bp + 8 * q8 + 4);
                const unsigned qw[4] = {qq.x, qq.y, qq.z, qq.w}, kw[4] = {kk.x, kk.y, kk.z, kk.w}; const float bv[8] = {b0[0], b0[1], b0[2], b0[3], b1[0], b1[1], b1[2], b1[3]};
                v4u oq, ok; unsigned* oqp = (unsigned*)&oq; unsigned* okp = (unsigned*)&ok;
#pragma unroll
                for (int i = 0; i < 4; ++i) { const float e0 = __expf(bv[2 * i]), e1 = __expf(bv[2 * i + 1]);
                    oqp[i] = pk2(bf2f(qw[i] & 0xffff) * ATT_SCALE * e0, bf2f(qw[i] >> 16) * ATT_SCALE * e1);
                    okp[i] = pk2(bf2f(kw[i] & 0xffff) * __builtin_amdgcn_rcpf(e0), bf2f(kw[i] >> 16) * __builtin_amdgcn_rcpf(e1)); }
                *(LAS v4u*)(QD + c * 136 + dg * 16 + 8 * q8) = oq; *(LAS v4u*)(KI + c * 136 + dg * 16 + 8 * q8) = ok; }
            const int c2 = tid & 63, g8 = tid >> 6; const bf16* vp = PROJ + (size_t)(t0 + c2) * NP0 + 1024 + h * 256 + g8 * 32;
#pragma unroll
            for (int q = 0; q < 4; ++q) { const v4u vv = *(const v4u*)(vp + 8 * q); const unsigned vw[4] = {vv.x, vv.y, vv.z, vv.w};
#pragma unroll
                for (int i = 0; i < 4; ++i) { const int v = g8 * 32 + q * 8 + 2 * i; VT[v * 72 + c2] = (bf16)(vw[i] & 0xffff); VT[(v + 1) * 72 + c2] = (bf16)(vw[i] >> 16); } }
        }
        __syncthreads();
        {
            const int ti = w >> 1;
#pragma unroll
            for (int s = 0; s < 2; ++s) { const int tj = 2 * (w & 1) + s; pg8::f32x4 acc = (pg8::f32x4){0.f, 0.f, 0.f, 0.f};
                if (tj <= ti) {
#pragma unroll
                    for (int kk = 0; kk < 128; kk += 32) { const bf16x8 aa = *(const LAS bf16x8*)(QD + (16 * ti + l15) * 136 + kk + quad * 8), bb = *(const LAS bf16x8*)(KI + (16 * tj + l15) * 136 + kk + quad * 8);
                        acc = __builtin_amdgcn_mfma_f32_16x16x32_bf16(aa, bb, acc, 0, 0, 0); } }
#pragma unroll
                for (int j = 0; j < 4; ++j) { const int i = 16 * ti + quad * 4 + j, jj = 16 * tj + l15; P[i * 72 + jj] = (bf16)f2bf(jj <= i ? acc[j] : 0.f); } }
        }
        __syncthreads();
        {
            const int ti = w >> 1, half = w & 1; pg8::f32x4 acc[8];
#pragma unroll
            for (int nn = 0; nn < 8; ++nn) acc[nn] = (pg8::f32x4){0.f, 0.f, 0.f, 0.f};
#pragma unroll
            for (int kk = 0; kk < 64; kk += 32) { const bf16x8 aa = *(const LAS bf16x8*)(P + (16 * ti + l15) * 72 + kk + quad * 8);
#pragma unroll
                for (int nn = 0; nn < 8; ++nn) { const bf16x8 bb = *(const LAS bf16x8*)(VT + (128 * half + 16 * nn + l15) * 72 + kk + quad * 8); acc[nn] = __builtin_amdgcn_mfma_f32_16x16x32_bf16(bb, aa, acc[nn], 0, 0, 0); } }
            const bf16* pv = PREVT + (size_t)unit * 32768 + (size_t)(128 * half + l15) * 128 + quad * 8;
#pragma unroll
            for (int kk = 0; kk < 128; kk += 32) { const bf16x8 aa = *(const LAS bf16x8*)(QD + (16 * ti + l15) * 136 + kk + quad * 8);
#pragma unroll
                for (int nn = 0; nn < 8; ++nn) { const bf16x8 bb = *(const bf16x8*)(pv + (size_t)(16 * nn) * 128 + kk); acc[nn] = __builtin_amdgcn_mfma_f32_16x16x32_bf16(bb, aa, acc[nn], 0, 0, 0); } }
            float s = 0.f;
#pragma unroll
            for (int nn = 0; nn < 8; ++nn) s += (acc[nn][0] * acc[nn][0] + acc[nn][1] * acc[nn][1]) + (acc[nn][2] * acc[nn][2] + acc[nn][3] * acc[nn][3]);
            s += __shfl_xor(s, 16); s += __shfl_xor(s, 32);
            if (quad == 0) RED[(16 * ti + l15) * 2 + half] = s;
            __syncthreads();
            const int i = 16 * ti + l15; const float ms = (RED[i * 2] + RED[i * 2 + 1]) * (1.0f / 256.0f); const float rs = 1.0f / sqrtf(ms + LN_EPS);
            const size_t t = (size_t)(t0 + i);
#pragma unroll
            for (int nn = 0; nn < 8; ++nn) { const int v = 128 * half + 16 * nn + quad * 4; const uint2 gr = *(const uint2*)(PROJ + t * NP0 + 2048 + h * 256 + v); const f32x4 ng = *(const f32x4*)(normg + v);
                uint2 o; o.x = pg8::cvt_pk_bf16(acc[nn][0] * rs * ng[0] * fast_silu(bf2f(gr.x & 0xffff)), acc[nn][1] * rs * ng[1] * fast_silu(bf2f(gr.x >> 16)));
                o.y = pg8::cvt_pk_bf16(acc[nn][2] * rs * ng[2] * fast_silu(bf2f(gr.y & 0xffff)), acc[nn][3] * rs * ng[3] * fast_silu(bf2f(gr.y >> 16)));
                *(uint2*)(OMIX + t * DM + h * 256 + v) = o; }
        }
    }
    __syncthreads();
}
__device__ __forceinline__ void ph_indexer(Frame& F, unsigned char* lds_generic) {
    typedef float f32x16 __attribute__((ext_vector_type(16)));
    const bf16* PROJ1 = (const bf16*)(F.ws + WS_PROJ); const bf16* IK = (const bf16*)(F.ws + WS_IK); const float* IW = (const float*)(F.ws + WS_IW); unsigned long long* MASK = (unsigned long long*)(F.ws + WS_MASK);
    LAS float* SCL = (LAS float*)F.lds;
    const int lane = F.lane, w = F.wave, c32 = lane & 31, hi = lane >> 5, rt = w & 3, kpar = w >> 2;
    for (int it = blockIdx.x; it < 512; it += F.G) {
#pragma unroll 1
        for (int pass = 0; pass < 2; ++pass) {
            const int unit = pass ? 1023 - it : it, m0 = unit * 8, b = m0 >> 12, qmax = (m0 & 4095) + 7;
            __syncthreads();
            {
                const int qa = m0 + 2 * rt + ((c32 >> 2) & 1), ha = (c32 & 3) + 4 * (c32 >> 3);
                const bf16* ap = PROJ1 + (size_t)qa * NP1 + 3072 + ha * 64 + 8 * hi;
                bf16x8 af[4];
#pragma unroll
                for (int ks = 0; ks < 4; ++ks) af[ks] = *(const bf16x8*)(ap + 16 * ks);
                const float* wp = IW + (size_t)(m0 + 2 * rt + hi) * 16; float wv[16];
#pragma unroll
                for (int q4 = 0; q4 < 4; ++q4) { const f32x4 t4 = *(const f32x4*)(wp + 4 * q4); wv[4 * q4] = t4[0]; wv[4 * q4 + 1] = t4[1]; wv[4 * q4 + 2] = t4[2]; wv[4 * q4 + 3] = t4[3]; }
                LAS float* srow = SCL + (2 * rt + hi) * 4096 + c32;
                const bf16* kbase = IK + (size_t)b * SEQ * 64 + (size_t)lane * 8;
                bf16x8 bn[4];
#pragma unroll
                for (int ks = 0; ks < 4; ++ks) bn[ks] = *(const bf16x8*)(kbase + (size_t)(kpar * 4 + ks) * 512);
                for (int t = kpar; t * 32 <= qmax; t += 2) {
                    bf16x8 bc[4];
#pragma unroll
                    for (int ks = 0; ks < 4; ++ks) bc[ks] = bn[ks];
                    const int tn = (t + 2) * 32 <= qmax ? t + 2 : t;
#pragma unroll
                    for (int ks = 0; ks < 4; ++ks) bn[ks] = *(const bf16x8*)(kbase + (size_t)(tn * 4 + ks) * 512);
                    f32x16 acc = {};
#pragma unroll
                    for (int ks = 0; ks < 4; ++ks) acc = __builtin_amdgcn_mfma_f32_32x32x16_bf16(af[ks], bc[ks], acc, 0, 0, 0);
                    float s = 0.f;
#pragma unroll
                    for (int r = 0; r < 16; ++r) s += wv[r] * fmaxf(acc[r], 0.f);
                    srow[t * 32] = s; }
            }
            __syncthreads();
            { const int m = m0 + w; topk_mask_row((const LAS float*)(F.lds + w * 16384), m & 4095, MASK + (size_t)m * 64, lane, (LAS unsigned*)(F.lds + LDSCTL_OFF + 4096 + w * 1024)); }
        }
    }
    __syncthreads();
}
#define IN(k) (lo <= (k) && (k) < hi)
#define SEAM(k) do { if (hi > (k) + 1) xcd_barrier(bar); } while (0)
template <int LAYER, int BASE>
__device__ __forceinline__ void common_phases(Frame& F, const Args& args, const int lo, const int hi, const XcdBarrier& bar) {
    unsigned char* ws = args.ws;
    if (IN(BASE + 0)) {
        pg8::Gemm g{(const bf16*)(ws + WS_OMIX), (const bf16*)(ws + (LAYER ? WS_WOC : WS_WOA)), MTOK, DM, DM, DM, DM}; pg8::StaticOrder S; S.init(MTOK, DM, F.G, (int)blockIdx.x);
        pg8::EpiResid E{(const bf16*)(ws + WS_XB), (bf16*)(ws + WS_YB), DN_ALPHA};
        pg8::gemm_phase<pg8::EpiResid, pg8::StaticOrder, true, true>(F.lds, g, S, E);
        SEAM(BASE + 0);
    }
    if (IN(BASE + 1)) { p_ln_route(F, args, LAYER); SEAM(BASE + 1); }
    if (IN(BASE + 3) || IN(BASE + 4) || IN(BASE + 5)) {
        if (F.wave == 0) { int ti; (void)moe_offsets(F.ctl + CW_CNT + LAYER * 64, F.lane, &ti); if (F.lane < 32) { F.MISC[64 + F.lane] = (unsigned)ti; F.MISC[160 + F.lane] = F.ctl[CW_CNT + LAYER * 64 + F.lane]; } if (F.lane == 31) F.MISC[96] = (unsigned)ti; }
        __syncthreads();
    }
    {
        const int Tm = (int)F.MISC[96], T1 = F.G / 4 < Tm ? F.G / 4 : Tm;
        const int n2 = (Tm - T1) * 4;
        const pg8::Gemm gU{(const bf16*)(ws + WS_XB), (const bf16*)(ws + WS_WGU) + (size_t)LAYER * 32 * 1024 * 2048, RPAD, 32 * 1024, DM, DM, DM};
        const pg8::Gemm gD{(const bf16*)(ws + WS_OMIX), (const bf16*)(ws + WS_WD) + (size_t)LAYER * 32 * 2048 * 512, RPAD, 32 * 2048, 512, 512, 512};
        const PG8_LAS int* tend = (const LAS int*)(F.lds + LDSCTL_OFF + 64 * 4); const PG8_LAS int* ecnt = (const LAS int*)(F.lds + LDSCTL_OFF + 160 * 4);
        const int* inv = (const int*)(ws + WS_INV);
        const pg8::EpiGLU EU{(bf16*)(ws + WS_OMIX), (const float*)(ws + WS_WINV)}; const pg8::EpiBf16Plain ED{(bf16*)(ws + WS_CST), DM, 7};
        if (IN(BASE + 3)) {
            pg8::MoeOrder S{F.G, (int)blockIdx.x, 4, 0, T1 * 4, (T1 * 4 == F.G && (F.G & 7) == 0) ? 2 : 0, tend, ecnt};
            pg8::gemm_phase_g<pg8::EpiGLU, pg8::MoeOrder>(F.lds, gU, S, EU, inv);
            SEAM(BASE + 3);
        }
        if (IN(BASE + 4)) {
            if ((int)blockIdx.x < n2) { pg8::MoeOrder S{n2, (int)blockIdx.x, 4, T1 * 4, Tm * 4, ((n2 & 7) == 0 && (F.G & 7) == 0) ? 2 : 0, tend, ecnt}; pg8::gemm_phase_g<pg8::EpiGLU, pg8::MoeOrder>(F.lds, gU, S, EU, inv); }
            else { pg8::MoeOrder S{F.G - n2, (int)blockIdx.x - n2, 8, 0, T1 * 8, 0, tend, ecnt}; pg8::gemm_phase<pg8::EpiBf16Plain, pg8::MoeOrder, true, true>(F.lds, gD, S, ED); }
            if (LAYER == 0) late_conv_items(F, args, CONV_SPLIT, CONV_LATE_ITEMS, 1);
            SEAM(BASE + 4);
        }
        if (IN(BASE + 5)) {
            pg8::MoeOrder S{F.G, (int)blockIdx.x, 8, T1 * 8, Tm * 8, 0, tend, ecnt};
            pg8::gemm_phase<pg8::EpiBf16Plain, pg8::MoeOrder, true, true>(F.lds, gD, S, ED);
            if (LAYER == 0) late_conv_items(F, args, CONV_SPLIT, CONV_LATE_ITEMS, 1);
            SEAM(BASE + 5);
        }
    }
    if (IN(BASE + 6)) { p_ln_ffn(F, args, LAYER); SEAM(BASE + 6); }
}
__global__ void __launch_bounds__(NWAVES * 64, 2) mk_fwd(Args args) {
    extern __shared__ __attribute__((aligned(16))) unsigned char lds[];
    Frame F;
    F.lds = (LAS unsigned char*)lds; F.MISC = (volatile LAS unsigned*)(F.lds + LDSCTL_OFF);
    F.tid = threadIdx.x; F.lane = F.tid & 63; F.wave = __builtin_amdgcn_readfirstlane(F.tid >> 6);
    F.G = gridDim.x; F.gw = blockIdx.x * NWAVES + F.wave; F.NGW = F.G * NWAVES;
    F.ws = args.ws; F.ctl = (unsigned*)(args.ws + WS_CTL);
    for (int u = F.tid; u < (LDS_BYTES - LDSCTL_OFF) / 4; u += NWAVES * 64) ((LAS unsigned*)(F.lds + LDSCTL_OFF))[u] = 0u;
    __syncthreads();
    const int lo = args.ph_lo, hi = args.ph_hi;
    XcdBarrier bar; bar.bar = F.ctl + CW_BAR + args.bar_region * XCD_BAR_WORDS; bar.x = 0; bar.st = nullptr;
    if (hi - lo > 1) bar = xcd_barrier_post(F.ctl + CW_BAR + args.bar_region * XCD_BAR_WORDS, F.MISC);
    unsigned char* ws = args.ws;

    if (IN(0)) { p0_prologue(F, args); SEAM(0); }
    if (IN(1)) {
        pg8::Gemm g{(const bf16*)(ws + WS_XB), (const bf16*)(ws + WS_WINA), MTOK, NP0, DM, DM, DM}; pg8::StaticOrder S; S.init(MTOK, NP0, F.G, (int)blockIdx.x);
        pg8::EpiBf16Plain E{(bf16*)(ws + WS_PROJ), NP0, 0x7fffffff};
        pg8::gemm_phase<pg8::EpiBf16Plain, pg8::StaticOrder, true, true>(F.lds, g, S, E);
        p_skinny0(F, args);
        SEAM(1);
    }
    if (IN(2)) { p_fox_bias(F, args); ph_gla_a(F, args); SEAM(2); }
    if (IN(4)) { ph_gla_scan(F); __syncthreads();
        attn::attn_phase<true, false, 8, 1, false, NP0, NP0, DM>((char*)lds, F.lds, (const bf16*)(ws + WS_PROJ) + 3072, (const bf16*)(ws + WS_PROJ) + 4096, (const bf16*)(ws + WS_PROJ) + 5120,
                                                               (bf16*)(ws + WS_OMIX) + 1024, (const float*)(ws + WS_FBIAS), (const unsigned long long*)nullptr, F.G, (int)blockIdx.x);
        late_conv_items(F, args, CONV_STATIC, CONV_SPLIT, 0);
        SEAM(4); }
    if (IN(5)) { ph_gla_c(F, args); SEAM(5); }
    common_phases<0, 6>(F, args, lo, hi, bar);
    if (IN(13)) {
        pg8::Gemm g{(const bf16*)(ws + WS_XB), (const bf16*)(ws + WS_WINC), MTOK, NP1, DM, DM, DM}; pg8::StaticOrder S; S.init(MTOK, NP1, F.G, (int)blockIdx.x);
        const float* c128 = (const float*)(ws + WS_ROPE);
        pg8::EpiRope E{(bf16*)(ws + WS_PROJ), c128, c128 + 4096 * 64, c128 + 2 * 4096 * 64, c128 + 2 * 4096 * 64 + 4096 * 32};
        pg8::gemm_phase<pg8::EpiRope, pg8::StaticOrder, true, true>(F.lds, g, S, E);
        SEAM(13);
    }
    if (IN(14)) { ph_indexer(F, lds); SEAM(14); }
    if (IN(16)) {
        attn::attn_phase<false, true, 16, 4, true, NP1, NP1, DM>((char*)lds, F.lds, (const bf16*)(ws + WS_PROJ), (const bf16*)(ws + WS_PROJ) + 2048, (const bf16*)(ws + WS_PROJ) + 2560,
                                                               (bf16*)(ws + WS_OMIX), (const float*)nullptr, (const unsigned long long*)(ws + WS_MASK), F.G, (int)blockIdx.x);
        SEAM(16); }
    common_phases<1, 17>(F, args, lo, hi, bar);
#ifdef PROBE_CONV
    if (IN(31)) {
        LAS bf16* T = (LAS bf16*)(F.lds + F.wave * 16384); bf16* dstb = (bf16*)(ws + WS_SC); float sink = 0.f;
        for (int it = F.gw; it < 32 * 256; it += F.NGW) {
            const int ex = 32 + it / 256, r = it % 256, kb = r / 8, nb = r % 8;
            TrItem t{args.in[17] + (size_t)ex * 2048 * 512, dstb + (size_t)(it / 256) * 512 * 2048, 512, nb * 64, nb * 64 + 32, 2048, nb * 64, kb * 64};
            f32x4 r16[16]; tr64_load(t, r16, F.lane);
            if (PROBE_CONV == 0) tr64_store(t, r16, T, F.lane);
            else if (PROBE_CONV == 1) {
#pragma unroll
                for (int i = 0; i < 8; ++i) { uint2 o; o.x = pg8::cvt_pk_bf16(r16[2 * i][0], r16[2 * i][1]); o.y = pg8::cvt_pk_bf16(r16[2 * i][2], r16[2 * i][3]); uint2 p; p.x = pg8::cvt_pk_bf16(r16[2 * i + 1][0], r16[2 * i + 1][1]); p.y = pg8::cvt_pk_bf16(r16[2 * i + 1][2], r16[2 * i + 1][3]);
                    bf16* d = dstb + (size_t)(it / 256) * 512 * 2048 + (size_t)(kb * 64 + 8 * i + 2 * (F.lane >> 4)) * 512 + nb * 64 + 4 * (F.lane & 15); *(uint2*)d = o; *(uint2*)(d + 512) = p; } }
            else {
#pragma unroll
                for (int i = 0; i < 16; ++i) sink += r16[i][0] + r16[i][3]; }
        }
        if (PROBE_CONV == 2 && sink == 12345.678f) dstb[F.tid] = 1;
    }
#endif
#ifdef PROBE_GEMM_K
    if (IN(30)) {
        pg8::Gemm g{(const bf16*)(ws + WS_XB), (const bf16*)(ws + WS_WINA), MTOK, NP0, PROBE_GEMM_K, PROBE_GEMM_LD, PROBE_GEMM_LD}; pg8::StaticOrder S; S.init(MTOK, NP0, F.G, (int)blockIdx.x);
        pg8::EpiBf16Plain E{(bf16*)(ws + WS_SC), NP0, 0x7fffffff};
        pg8::gemm_phase<pg8::EpiBf16Plain, pg8::StaticOrder, true, true>(F.lds, g, S, E);
    }
#endif
}
#undef IN
#undef SEAM
constexpr int N_PHASE_IDS = 24;
static void launch_mk(const Args& base, int lo, int hi, int grid, hipStream_t stream, int region = 0) {
    Args a = base; a.ph_lo = lo; a.ph_hi = hi; a.bar_region = region; a.pad = 0;
    hipLaunchKernelGGL(mk_fwd, dim3(grid), dim3(NWAVES * 64), LDS_BYTES, stream, a);
}
extern "C" void kernel_launch(void* const* d_in, const int* in_sizes, int n_in, void* d_out, int out_size, void* d_ws, size_t ws_size, hipStream_t stream) {
    static int grid = 0;
    if (grid == 0) {
        if (n_in != 20 || out_size != MTOK * DM || ws_size < WS_END) { fprintf(stderr, "kernel_launch: unexpected shapes (n_in %d, out %d, ws %zu < %zu)\n", n_in, out_size, ws_size, (size_t)WS_END); grid = -1; return; }
        int dev = 0, cus = 0, per_cu = 0;
        if (hipGetDevice(&dev) != hipSuccess || hipDeviceGetAttribute(&cus, hipDeviceAttributeMultiprocessorCount, dev) != hipSuccess) { grid = -1; return; }
        if (hipFuncSetAttribute((const void*)mk_fwd, hipFuncAttributeMaxDynamicSharedMemorySize, LDS_BYTES) != hipSuccess) { fprintf(stderr, "kernel_launch: hipFuncSetAttribute failed\n"); grid = -1; return; }
        if (hipOccupancyMaxActiveBlocksPerMultiprocessor(&per_cu, (const void*)mk_fwd, NWAVES * 64, LDS_BYTES) != hipSuccess || per_cu < 1) { fprintf(stderr, "kernel_launch: occupancy query reports %d workgroups per CU\n", per_cu); }
        (void)hipGetLastError();
        grid = cus;
    }
    if (grid < 0) return;
    (void)in_sizes;
    if (hipMemsetAsync((char*)d_ws + WS_CTL, 0, CTL_ZERO_BYTES, stream) != hipSuccess) return;
    Args a{};
    for (int i = 0; i < 20; ++i) a.in[i] = (const float*)d_in[i];
    a.out = (float*)d_out; a.ws = (unsigned char*)d_ws;
#ifdef PROBE_LO
    launch_mk(a, 0, PROBE_HI + 1, grid, stream, 0); launch_mk(a, PROBE_LO, N_PHASE_IDS, grid, stream, 1);
#else
    launch_mk(a, 0, N_PHASE_IDS, grid, stream);
#endif
#ifdef PROBE_GEMM_K
    launch_mk(a, 30, 31, grid, stream, 2);
#endif
#ifdef PROBE_CONV
    launch_mk(a, 31, 32, grid, stream, 2);
#endif
}
```

```cpp
#include <hip/hip_runtime.h>
#include <cstdio>
#include <cstdint>
namespace pg8 {
#define PG8_LAS __attribute__((address_space(3)))
typedef unsigned short bf16_t;
typedef short bf16x8 __attribute__((ext_vector_type(8)));
typedef float f32x4 __attribute__((ext_vector_type(4)));
typedef unsigned u32x4 __attribute__((ext_vector_type(4)));
constexpr int BM = 256, BK = 64, HALF = 128, HTB = HALF * BK * 2  , STAGE_BYTES = 8 * HTB, NXCD = 8, WGM = 8;

__host__ __device__ __forceinline__ int lds_byte(int r, int c) { const int st = (r >> 4) * 2 + (c >> 5), rr = r & 15, cc = c & 31, ob = rr * 64 + cc * 2; return st * 1024 + (ob ^ (((ob >> 9) & 1) << 5)); }
__host__ __device__ __forceinline__ void stage_rc(int b, int& R, int& C) { const int st = b / 1024, sb = b % 1024, swz = sb ^ (((sb >> 9) & 1) << 5); R = (st >> 1) * 16 + swz / 64; C = (st & 1) * 32 + (swz % 64) / 2; }
__host__ __device__ __forceinline__ int perm32(int rho) { const int n = rho >> 4, i = rho & 15; return 8 * (i >> 2) + 4 * n + (i & 3); }

struct Unit { int pm, pn, inv0, nvalid, half; };
struct Gemm { const bf16_t* A; const bf16_t* Bt; int M, N, K, lda, ldb; };

struct StaticOrder {
    int nM, nN, nwg, G, c;
    __host__ __device__ void init(int M, int N, int G_, int c_) { nM = M / BM; nN = N / BM; nwg = nM * nN; G = G_; c = c_; }
    __host__ __device__ bool next(int i, Unit& u) const {
        const long L = (long)i * G + c; if (L >= nwg) return false;
        int wgid = (int)L; { const int q = nwg / NXCD, r = nwg % NXCD, xcd = wgid % NXCD, off = wgid / NXCD; wgid = (xcd < r ? xcd * (q + 1) : r * (q + 1) + (xcd - r) * q) + off; }
        const int nig = WGM * nN, gid = wgid / nig, fm = gid * WGM, gsz = (nM - fm) < WGM ? (nM - fm) : WGM;
        u.pm = fm + ((wgid % nig) % gsz); u.pn = (wgid % nig) / gsz; return true;
    }
    __device__ __forceinline__ void a_ready(const Unit&) const {}
    __device__ __forceinline__ void done(const Unit&) const {}
};

__device__ __forceinline__ unsigned cvt_pk_bf16(float lo, float hi) { unsigned r; asm volatile("v_cvt_pk_bf16_f32 %0, %1, %2" : "=v"(r) : "v"(lo), "v"(hi)); return r; }
typedef float f32x2 __attribute__((ext_vector_type(2)));
struct EpiBf16Plain {
    static constexpr bool PERM = true, AFTER_DRAIN = false;
    bf16_t* O; int ldc; int pn_mask;
    __device__ __forceinline__ void operator()(const f32x4 (&acc)[2][2][4][2], const Unit& u, int wr, int wc, int fr, int fq) const {
        const int row0 = u.pm * BM + wr * 64 + fr, col0 = (u.pn & pn_mask) * BM + wc * 32 + 8 * fq;
#pragma unroll
        for (int ai = 0; ai < 2; ++ai)
#pragma unroll
            for (int m = 0; m < 4; ++m) { bf16_t* rowp = O + (size_t)(row0 + ai * HALF + m * 16) * ldc + col0;
#pragma unroll
                for (int bj = 0; bj < 2; ++bj) { const f32x4 v0 = acc[ai][bj][m][0], v1 = acc[ai][bj][m][1];
                    u32x4 w; w.x = cvt_pk_bf16(v0[0], v0[1]); w.y = cvt_pk_bf16(v0[2], v0[3]); w.z = cvt_pk_bf16(v1[0], v1[1]); w.w = cvt_pk_bf16(v1[2], v1[3]);
                    *(u32x4*)(rowp + bj * HALF) = w; } }
    }
};
struct EpiResid {
    static constexpr bool PERM = true, AFTER_DRAIN = false;
    const bf16_t* base; bf16_t* out; float alpha;
    __device__ __forceinline__ void operator()(const f32x4 (&acc)[2][2][4][2], const Unit& u, int wr, int wc, int fr, int fq) const {
        const int row0 = u.pm * BM + wr * 64 + fr, col0 = u.pn * BM + wc * 32 + 8 * fq;
#pragma unroll
        for (int ai = 0; ai < 2; ++ai)
#pragma unroll
            for (int m = 0; m < 4; ++m) { const size_t off = (size_t)(row0 + ai * HALF + m * 16) * 2048 + col0;
#pragma unroll
                for (int bj = 0; bj < 2; ++bj) { const u32x4 b = *(const u32x4*)(base + off + bj * HALF); const f32x4 v0 = acc[ai][bj][m][0], v1 = acc[ai][bj][m][1];
                    const unsigned bw[4] = {b.x, b.y, b.z, b.w}; u32x4 w; unsigned* wp = (unsigned*)&w;
#pragma unroll
                    for (int q = 0; q < 4; ++q) { const float lo = __builtin_bit_cast(float, bw[q] << 16), hi = __builtin_bit_cast(float, bw[q] & 0xffff0000u);
                        const float a0 = q < 2 ? v0[2 * q] : v1[2 * q - 4], a1 = q < 2 ? v0[2 * q + 1] : v1[2 * q - 3];
                        wp[q] = cvt_pk_bf16(lo * alpha + a0, hi * alpha + a1); }
                    *(u32x4*)(out + off + bj * HALF) = w; } }
    }
};
struct EpiGLU {
    static constexpr bool PERM = true, AFTER_DRAIN = false;
    bf16_t* H; const float* winv;
    __device__ __forceinline__ void operator()(const f32x4 (&acc)[2][2][4][2], const Unit& u, int wr, int wc, int fr, int fq) const {
        const int row0 = u.pm * BM + wr * 64 + fr, f0 = (u.pn & 3) * 128 + wc * 32 + 8 * fq;
#pragma unroll
        for (int ai = 0; ai < 2; ++ai) { if (u.half >= 0 && u.half != ai) continue;
#pragma unroll
            for (int m = 0; m < 4; ++m) { const int row = row0 + ai * HALF + m * 16; const float w = winv[u.inv0 + ai * HALF + wr * 64 + m * 16 + fr];
                float h[8];
#pragma unroll
                for (int n = 0; n < 2; ++n)
#pragma unroll
                    for (int e = 0; e < 4; ++e) { const float g = acc[ai][0][m][n][e], up = acc[ai][1][m][n][e]; h[n * 4 + e] = g * __builtin_amdgcn_rcpf(1.0f + __expf(-g)) * up * w; }
                u32x4 o; o.x = cvt_pk_bf16(h[0], h[1]); o.y = cvt_pk_bf16(h[2], h[3]); o.z = cvt_pk_bf16(h[4], h[5]); o.w = cvt_pk_bf16(h[6], h[7]);
                *(u32x4*)(H + (size_t)row * 512 + f0) = o; } }
    }
};
struct EpiRope {
    static constexpr bool PERM = true, AFTER_DRAIN = false;
    bf16_t* O; const float* c128; const float* s128; const float* c64; const float* s64;
    __device__ __forceinline__ void operator()(const f32x4 (&acc)[2][2][4][2], const Unit& u, int wr, int wc, int fr, int fq) const {
        const int row0 = u.pm * BM + wr * 64 + fr, jj = wc * 32 + 8 * fq;
        const int pn = u.pn;
        if (pn == 10 || pn == 11) {
#pragma unroll
            for (int ai = 0; ai < 2; ++ai)
#pragma unroll
                for (int m = 0; m < 4; ++m) { bf16_t* rowp = O + (size_t)(row0 + ai * HALF + m * 16) * 4096 + pn * 256 + jj;
#pragma unroll
                    for (int bj = 0; bj < 2; ++bj) { const f32x4 v0 = acc[ai][bj][m][0], v1 = acc[ai][bj][m][1];
                        u32x4 w; w.x = cvt_pk_bf16(v0[0], v0[1]); w.y = cvt_pk_bf16(v0[2], v0[3]); w.z = cvt_pk_bf16(v1[0], v1[1]); w.w = cvt_pk_bf16(v1[2], v1[3]);
                        *(u32x4*)(rowp + bj * HALF) = w; } }
            return;
        }
        const bool idx = pn >= 12;
        const int half = idx ? 32 : 64;
        const int hl = idx ? (jj >> 5) : (jj >> 6), i0 = jj & (half - 1);
        const int colbase = idx ? (3072 + ((pn - 12) * 4 + hl) * 64) : (pn * 256 + hl * 128);
        const float* ct = idx ? c64 : c128; const float* st = idx ? s64 : s128;
#pragma unroll
        for (int ai = 0; ai < 2; ++ai)
#pragma unroll
            for (int m = 0; m < 4; ++m) { const int row = row0 + ai * HALF + m * 16; const int pos = row & 4095;
                const float* cp = ct + (size_t)pos * half + i0; const float* sp = st + (size_t)pos * half + i0;
                const f32x4 c0 = *(const f32x4*)cp, c1 = *(const f32x4*)(cp + 4), s0 = *(const f32x4*)sp, s1 = *(const f32x4*)(sp + 4);
                const f32x4 a0 = acc[ai][0][m][0], a1 = acc[ai][0][m][1], b0 = acc[ai][1][m][0], b1 = acc[ai][1][m][1];
                const f32x4 x0 = a0 * c0 - b0 * s0, x1 = a1 * c1 - b1 * s1, y0 = b0 * c0 + a0 * s0, y1 = b1 * c1 + a1 * s1;
                bf16_t* rowp = O + (size_t)row * 4096 + colbase + i0;
                u32x4 w; w.x = cvt_pk_bf16(x0[0], x0[1]); w.y = cvt_pk_bf16(x0[2], x0[3]); w.z = cvt_pk_bf16(x1[0], x1[1]); w.w = cvt_pk_bf16(x1[2], x1[3]);
                *(u32x4*)rowp = w;
                u32x4 z; z.x = cvt_pk_bf16(y0[0], y0[1]); z.y = cvt_pk_bf16(y0[2], y0[3]); z.z = cvt_pk_bf16(y1[0], y1[1]); z.w = cvt_pk_bf16(y1[2], y1[3]);
                *(u32x4*)(rowp + half) = z; }
    }
};
struct MoeOrder {
    int G, c, ntn, L0, Lend, hsplit; const PG8_LAS int* tend; const PG8_LAS int* cnt;
    __device__ __forceinline__ bool next(int i, Unit& u) const {
        int Lx = L0 + i * G + c; if (Lx >= Lend) return false;
        if (hsplit == 2) { const int x = c & 7, s = c >> 3; Lx = L0 + ((x >> 2) * (G >> 3) + s) * ntn + (x & 3); }
        const int L = hsplit == 1 ? Lx >> 1 : Lx;
        const int t = L / ntn; int e = 0;
#pragma unroll 1
        for (int k = 0; k < 32; ++k) e += (t >= tend[k]) ? 1 : 0;
        const int p0 = (t - (e ? tend[e - 1] : 0)) * BM, left = cnt[e] - p0;
        u.pm = t; u.pn = e * ntn + (L - t * ntn); u.inv0 = e * 8192 + p0; u.nvalid = left < BM ? left : BM; u.half = hsplit == 1 ? (Lx & 1) : -1; return true;
    }
    __device__ __forceinline__ void a_ready(const Unit&) const {}
    __device__ __forceinline__ void done(const Unit&) const {}
};
template <class Epi, class Sched, bool ALIGN_EPI = false, bool SP2 = false>
__device__ __forceinline__ void gemm_phase(PG8_LAS unsigned char* lds, const Gemm g, const Sched& S, const Epi& E) {
    const int tid = threadIdx.x, wid = __builtin_amdgcn_readfirstlane(tid >> 6), lane = tid & 63, wr = wid >> 2, wc = wid & 3, fr = lane & 15, fq = lane >> 4;
    const int K = g.K, nt = K / BK;
    unsigned voffA[2], voffB[2];
#pragma unroll
    for (int i = 0; i < 2; ++i) { int R, C; stage_rc(tid * 16 + i * 8192, R, C); const int Rb = Epi::PERM ? ((R & ~31) + perm32(R & 31)) : R;
        voffA[i] = (unsigned)(R * g.lda + C) * 2u; voffB[i] = (unsigned)(Rb * g.ldb + C) * 2u; }
    const size_t kstep = (size_t)(BK * 2);
    const size_t hstepA = (size_t)HALF * g.lda * 2, hstepB = (size_t)HALF * g.ldb * 2;
    const size_t tstepA = 2 * hstepA, tstepB = 2 * hstepB;
    const unsigned ldsw = (unsigned)wid * 1024u;
    const int aoff = lds_byte(wr * 64 + fr, fq * 8), boff = lds_byte(wc * 32 + fr, fq * 8);
#define PG8_SA(b, h) (((b) * 2 + (h)) * HTB)
#define PG8_SB(b, h) ((4 + (b) * 2 + (h)) * HTB)
#define PG8_STAGE(bufoff, gbase, voff) do { _Pragma("unroll") for (int _i = 0; _i < 2; ++_i) \
        __builtin_amdgcn_global_load_lds((const unsigned*)((const char*)(gbase) + (voff)[_i]), (PG8_LAS unsigned*)(lds + (bufoff) + ldsw + _i * 8192), 16, 0, 0); } while (0)
#define PG8_LDA(dst, b, h) do { _Pragma("unroll") for (int m = 0; m < 4; ++m) _Pragma("unroll") for (int k = 0; k < 2; ++k) dst[m][k] = *(const PG8_LAS bf16x8*)(lds + PG8_SA(b, h) + aoff + m * 2048 + k * 1024); } while (0)
#define PG8_LDB(dst, b, h) do { _Pragma("unroll") for (int n = 0; n < 2; ++n) _Pragma("unroll") for (int k = 0; k < 2; ++k) dst[n][k] = *(const PG8_LAS bf16x8*)(lds + PG8_SB(b, h) + boff + n * 2048 + k * 1024); } while (0)
#define PG8_MMA(ai, bj, At, Bt) do { __builtin_amdgcn_s_setprio(1); _Pragma("unroll") for (int m = 0; m < 4; ++m) _Pragma("unroll") for (int n = 0; n < 2; ++n) _Pragma("unroll") for (int k = 0; k < 2; ++k) \
        acc[ai][bj][m][n] = __builtin_amdgcn_mfma_f32_16x16x32_bf16(Bt[n][k], At[m][k], acc[ai][bj][m][n], 0, 0, 0); __builtin_amdgcn_s_setprio(0); } while (0)
#define PG8_WAIT_V(n) asm volatile("s_waitcnt vmcnt(" #n ")" ::: "memory")
#define PG8_WAIT_L(n) asm volatile("s_waitcnt lgkmcnt(" #n ")" ::: "memory")
#define PG8_BAR __builtin_amdgcn_s_barrier()
#define PG8_SCHED __builtin_amdgcn_sched_barrier(0)
    Unit cur, nxt; int ui = 0;
    if (!S.next(0, cur)) return;
    f32x4 acc[2][2][4][2];
#pragma unroll
    for (int a = 0; a < 2; ++a)
#pragma unroll
        for (int b = 0; b < 2; ++b)
#pragma unroll
            for (int m = 0; m < 4; ++m)
#pragma unroll
                for (int n = 0; n < 2; ++n) acc[a][b][m][n] = (f32x4){0.f, 0.f, 0.f, 0.f};
    bf16x8 At[4][2], B0[2][2], B1[2][2];
    const char* cA = (const char*)g.A + (size_t)cur.pm * tstepA; const char* cB = (const char*)g.Bt + (size_t)cur.pn * tstepB;
    S.a_ready(cur);
    if constexpr (SP2) {
        PG8_STAGE(PG8_SB(0, 0), cB, voffB); PG8_STAGE(PG8_SB(0, 1), cB + hstepB, voffB); PG8_STAGE(PG8_SA(0, 0), cA, voffA); PG8_STAGE(PG8_SA(0, 1), cA + hstepA, voffA);
        if (wr == 1) PG8_BAR;
        PG8_WAIT_V(2); PG8_BAR;
        PG8_STAGE(PG8_SB(1, 0), cB + kstep, voffB); PG8_STAGE(PG8_SA(1, 0), cA + kstep, voffA); PG8_STAGE(PG8_SB(1, 1), cB + hstepB + kstep, voffB);
        PG8_WAIT_V(6); PG8_BAR;
    } else {
        PG8_STAGE(PG8_SB(0, 0), cB, voffB); PG8_STAGE(PG8_SA(0, 0), cA, voffA); PG8_STAGE(PG8_SB(0, 1), cB + hstepB, voffB); PG8_STAGE(PG8_SA(0, 1), cA + hstepA, voffA);
        if (wr == 1) PG8_BAR;
        PG8_WAIT_V(4); PG8_BAR;
        PG8_STAGE(PG8_SB(1, 0), cB + kstep, voffB); PG8_STAGE(PG8_SA(1, 0), cA + kstep, voffA); PG8_STAGE(PG8_SB(1, 1), cB + hstepB + kstep, voffB);
        PG8_WAIT_V(6); PG8_BAR;
    }
    for (;;) {
        const bool has_next = S.next(ui + 1, nxt);
        const char* nA = has_next ? (const char*)g.A + (size_t)nxt.pm * tstepA : cA; const char* nB = has_next ? (const char*)g.Bt + (size_t)nxt.pn * tstepB : cB;
        for (int t = 0; t < nt; t += 2) {
            const bool last = (t == nt - 2);
            const char* a1 = cA + (size_t)(t + 1) * kstep;
            const char* a2 = last ? nA : cA + (size_t)(t + 2) * kstep; const char* b2 = last ? nB : cB + (size_t)(t + 2) * kstep;
            const char* a3 = a2 + kstep; const char* b3 = b2 + kstep;
            if (last && has_next) S.a_ready(nxt);
            if constexpr (SP2) {
            PG8_LDB(B0, 0, 0); PG8_LDB(B1, 0, 1); PG8_SCHED; PG8_LDA(At, 0, 0); PG8_STAGE(PG8_SA(1, 1), a1 + hstepA, voffA);
            PG8_WAIT_V(8); PG8_WAIT_L(0); PG8_BAR; PG8_MMA(0, 0, At, B0); PG8_MMA(0, 1, At, B1); PG8_BAR; PG8_SCHED;
            PG8_LDA(At, 0, 1); PG8_STAGE(PG8_SB(0, 0), b2, voffB); PG8_STAGE(PG8_SB(0, 1), b2 + hstepB, voffB); PG8_STAGE(PG8_SA(0, 0), a2, voffA);
            PG8_WAIT_V(8); PG8_WAIT_L(0); PG8_BAR; PG8_MMA(1, 0, At, B0); PG8_MMA(1, 1, At, B1); PG8_BAR; PG8_SCHED;
            PG8_LDB(B0, 1, 0); PG8_LDB(B1, 1, 1); PG8_SCHED; PG8_LDA(At, 1, 0); PG8_STAGE(PG8_SA(0, 1), a2 + hstepA, voffA);
            PG8_WAIT_V(8); PG8_WAIT_L(0); PG8_BAR; PG8_MMA(0, 0, At, B0); PG8_MMA(0, 1, At, B1); PG8_BAR; PG8_SCHED;
            PG8_LDA(At, 1, 1); PG8_STAGE(PG8_SB(1, 0), b3, voffB); PG8_STAGE(PG8_SB(1, 1), b3 + hstepB, voffB); PG8_STAGE(PG8_SA(1, 0), a3, voffA);
            PG8_WAIT_V(8); PG8_WAIT_L(0); PG8_BAR; PG8_MMA(1, 0, At, B0); PG8_MMA(1, 1, At, B1); PG8_BAR; PG8_SCHED;
            } else {
            PG8_LDB(B0, 0, 0); PG8_SCHED; PG8_LDA(At, 0, 0); PG8_STAGE(PG8_SA(1, 1), a1 + hstepA, voffA);
            PG8_WAIT_L(8); PG8_BAR; PG8_WAIT_L(0); PG8_MMA(0, 0, At, B0); PG8_BAR; PG8_SCHED;
            PG8_LDB(B1, 0, 1); PG8_STAGE(PG8_SB(0, 0), b2, voffB);
            PG8_BAR; PG8_WAIT_L(0); PG8_MMA(0, 1, At, B1); PG8_BAR;
            PG8_LDA(At, 0, 1); PG8_STAGE(PG8_SA(0, 0), a2, voffA);
            PG8_BAR; PG8_WAIT_L(0); PG8_MMA(1, 0, At, B0); PG8_BAR; PG8_SCHED;
            PG8_STAGE(PG8_SB(0, 1), b2 + hstepB, voffB);
            PG8_WAIT_V(6); PG8_BAR; PG8_MMA(1, 1, At, B1); PG8_BAR;
            PG8_LDB(B0, 1, 0); PG8_SCHED; PG8_LDA(At, 1, 0); PG8_STAGE(PG8_SA(0, 1), a2 + hstepA, voffA);
            PG8_WAIT_L(8); PG8_BAR; PG8_WAIT_L(0); PG8_MMA(0, 0, At, B0); PG8_BAR; PG8_SCHED;
            PG8_LDB(B1, 1, 1); PG8_STAGE(PG8_SB(1, 0), b3, voffB);
            PG8_BAR; PG8_WAIT_L(0); PG8_MMA(0, 1, At, B1); PG8_BAR;
            PG8_LDA(At, 1, 1); PG8_STAGE(PG8_SA(1, 0), a3, voffA);
            PG8_BAR; PG8_WAIT_L(0); PG8_MMA(1, 0, At, B0); PG8_BAR; PG8_SCHED;
            PG8_STAGE(PG8_SB(1, 1), b3 + hstepB, voffB);
            PG8_WAIT_V(6); PG8_BAR; PG8_MMA(1, 1, At, B1); PG8_BAR;
            }
        }
        if constexpr (ALIGN_EPI) { if (wr == 0) PG8_BAR; }
        if constexpr (!Epi::AFTER_DRAIN) { E(acc, cur, wr, wc, fr, fq); S.done(cur); }
        if (!has_next) break;
#pragma unroll
        for (int a = 0; a < 2; ++a)
#pragma unroll
            for (int b = 0; b < 2; ++b)
#pragma unroll
                for (int m = 0; m < 4; ++m)
#pragma unroll
                    for (int n = 0; n < 2; ++n) acc[a][b][m][n] = (f32x4){0.f, 0.f, 0.f, 0.f};
        cur = nxt; cA = nA; cB = nB; ++ui;
        if constexpr (ALIGN_EPI) { if (wr == 1) PG8_BAR; }
    }
    PG8_WAIT_V(0);
    if constexpr (!ALIGN_EPI) { if (wr == 0) PG8_BAR; }
    PG8_BAR;
    if constexpr (Epi::AFTER_DRAIN) { E.fused(acc, cur, wr, wc, fr, fq, lds, wid, lane); S.done(cur); }
#undef PG8_SA
#undef PG8_SB
#undef PG8_STAGE
#undef PG8_LDA
#undef PG8_LDB
#undef PG8_MMA
#undef PG8_WAIT_V
#undef PG8_WAIT_L
#undef PG8_BAR
#undef PG8_SCHED
}
template <class Epi, class Sched>
__device__ __forceinline__ void gemm_phase_g(PG8_LAS unsigned char* lds, const Gemm g, const Sched& S, const Epi& E, const int* inv) {
    constexpr bool ALIGN_EPI = true;
    const int tid = threadIdx.x, wid = __builtin_amdgcn_readfirstlane(tid >> 6), lane = tid & 63, wr = wid >> 2, wc = wid & 3, fr = lane & 15, fq = lane >> 4;
    const int K = g.K, nt = K / BK;
    unsigned voffA[2], voffB[2];
#pragma unroll
    for (int i = 0; i < 2; ++i) { int R, C; stage_rc(tid * 16 + i * 8192, R, C); const int Rb = Epi::PERM ? ((R & ~31) + perm32(R & 31)) : R;
        voffA[i] = (unsigned)(R * g.lda + C) * 2u; voffB[i] = (unsigned)(Rb * g.ldb + C) * 2u; }
    const size_t kstep = (size_t)(BK * 2);
    const size_t hstepA = (size_t)HALF * g.lda * 2, hstepB = (size_t)HALF * g.ldb * 2;
    const size_t tstepA = 2 * hstepA, tstepB = 2 * hstepB;
    const unsigned ldsw = (unsigned)wid * 1024u;
    const int aoff = lds_byte(wr * 64 + fr, fq * 8), boff = lds_byte(wc * 32 + fr, fq * 8);
#define PG8_SA(b, h) (((b) * 2 + (h)) * HTB)
#define PG8_SB(b, h) ((4 + (b) * 2 + (h)) * HTB)
#define PG8_STAGE(bufoff, gbase, voff) do { _Pragma("unroll") for (int _i = 0; _i < 2; ++_i) \
        __builtin_amdgcn_global_load_lds((const unsigned*)((const char*)(gbase) + (voff)[_i]), (PG8_LAS unsigned*)(lds + (bufoff) + ldsw + _i * 8192), 16, 0, 0); } while (0)
#define PG8_LDA(dst, b, h) do { _Pragma("unroll") for (int m = 0; m < 4; ++m) _Pragma("unroll") for (int k = 0; k < 2; ++k) dst[m][k] = *(const PG8_LAS bf16x8*)(lds + PG8_SA(b, h) + aoff + m * 2048 + k * 1024); } while (0)
#define PG8_LDB(dst, b, h) do { _Pragma("unroll") for (int n = 0; n < 2; ++n) _Pragma("unroll") for (int k = 0; k < 2; ++k) dst[n][k] = *(const PG8_LAS bf16x8*)(lds + PG8_SB(b, h) + boff + n * 2048 + k * 1024); } while (0)
#define PG8_MMA(ai, bj, At, Bt) do { __builtin_amdgcn_s_setprio(1); _Pragma("unroll") for (int m = 0; m < 4; ++m) _Pragma("unroll") for (int n = 0; n < 2; ++n) _Pragma("unroll") for (int k = 0; k < 2; ++k) \
        acc[ai][bj][m][n] = __builtin_amdgcn_mfma_f32_16x16x32_bf16(Bt[n][k], At[m][k], acc[ai][bj][m][n], 0, 0, 0); __builtin_amdgcn_s_setprio(0); } while (0)
#define PG8_WAIT_V(n) asm volatile("s_waitcnt vmcnt(" #n ")" ::: "memory")
#define PG8_WAIT_L(n) asm volatile("s_waitcnt lgkmcnt(" #n ")" ::: "memory")
#define PG8_BAR __builtin_amdgcn_s_barrier()
#define PG8_SCHED __builtin_amdgcn_sched_barrier(0)
    Unit cur, nxt; int ui = 0;
    if (!S.next(0, cur)) return;
    f32x4 acc[2][2][4][2];
#pragma unroll
    for (int a = 0; a < 2; ++a)
#pragma unroll
        for (int b = 0; b < 2; ++b)
#pragma unroll
            for (int m = 0; m < 4; ++m)
#pragma unroll
                for (int n = 0; n < 2; ++n) acc[a][b][m][n] = (f32x4){0.f, 0.f, 0.f, 0.f};
    bf16x8 At[4][2], B0[2][2], B1[2][2];
    const char* cA = (const char*)g.A; const char* cB = (const char*)g.Bt + (size_t)cur.pn * tstepB;
    S.a_ready(cur);
    unsigned vc[2][2], vn[2][2];
#define PG8_ROWS(u_, vo_) do { _Pragma("unroll") for (int h_ = 0; h_ < 2; ++h_) _Pragma("unroll") for (int i_ = 0; i_ < 2; ++i_) { int R_, C_; stage_rc(tid * 16 + i_ * 8192, R_, C_); const int r_ = h_ * HALF + R_; \
        const int tok_ = r_ < (u_).nvalid ? inv[(u_).inv0 + r_] : 0; vo_[h_][i_] = (unsigned)(tok_ * g.lda + C_) * 2u; } } while (0)
    PG8_ROWS(cur, vc);
    {
        PG8_STAGE(PG8_SB(0, 0), cB, voffB); PG8_STAGE(PG8_SB(0, 1), cB + hstepB, voffB); PG8_STAGE(PG8_SA(0, 0), cA, vc[0]); PG8_STAGE(PG8_SA(0, 1), cA, vc[1]);
        if (wr == 1) PG8_BAR;
        PG8_WAIT_V(2); PG8_BAR;
        PG8_STAGE(PG8_SB(1, 0), cB + kstep, voffB); PG8_STAGE(PG8_SA(1, 0), cA + kstep, vc[0]); PG8_STAGE(PG8_SB(1, 1), cB + hstepB + kstep, voffB);
        PG8_WAIT_V(6); PG8_BAR;
    }
    for (;;) {
        const bool has_next = S.next(ui + 1, nxt);
        if (has_next) { PG8_ROWS(nxt, vn); } else {
#pragma unroll
            for (int h_ = 0; h_ < 2; ++h_) { vn[h_][0] = vc[h_][0]; vn[h_][1] = vc[h_][1]; } }
        const char* nA = cA; const char* nB = has_next ? (const char*)g.Bt + (size_t)nxt.pn * tstepB : cB;
        const bool do0 = cur.half != 1, do1 = cur.half != 0;
        for (int t = 0; t < nt; t += 2) {
            const bool last = (t == nt - 2);
            unsigned v2[2][2];
#pragma unroll
            for (int h_ = 0; h_ < 2; ++h_) { v2[h_][0] = last ? vn[h_][0] : vc[h_][0]; v2[h_][1] = last ? vn[h_][1] : vc[h_][1]; }
            const char* a1 = cA + (size_t)(t + 1) * kstep;
            const char* a2 = last ? nA : cA + (size_t)(t + 2) * kstep; const char* b2 = last ? nB : cB + (size_t)(t + 2) * kstep;
            const char* a3 = a2 + kstep; const char* b3 = b2 + kstep;
            if (last && has_next) S.a_ready(nxt);
            {
            PG8_LDB(B0, 0, 0); PG8_LDB(B1, 0, 1); PG8_SCHED; if (do0) { PG8_LDA(At, 0, 0); } PG8_STAGE(PG8_SA(1, 1), a1, vc[1]);
            PG8_WAIT_V(8); PG8_WAIT_L(0); PG8_BAR; if (do0) { PG8_MMA(0, 0, At, B0); PG8_MMA(0, 1, At, B1); } PG8_BAR; PG8_SCHED;
            if (do1) { PG8_LDA(At, 0, 1); } PG8_STAGE(PG8_SB(0, 0), b2, voffB); PG8_STAGE(PG8_SB(0, 1), b2 + hstepB, voffB); PG8_STAGE(PG8_SA(0, 0), a2, v2[0]);
            PG8_WAIT_V(8); PG8_WAIT_L(0); PG8_BAR; if (do1) { PG8_MMA(1, 0, At, B0); PG8_MMA(1, 1, At, B1); } PG8_BAR; PG8_SCHED;
            PG8_LDB(B0, 1, 0); PG8_LDB(B1, 1, 1); PG8_SCHED; if (do0) { PG8_LDA(At, 1, 0); } PG8_STAGE(PG8_SA(0, 1), a2, v2[1]);
            PG8_WAIT_V(8); PG8_WAIT_L(0); PG8_BAR; if (do0) { PG8_MMA(0, 0, At, B0); PG8_MMA(0, 1, At, B1); } PG8_BAR; PG8_SCHED;
            if (do1) { PG8_LDA(At, 1, 1); } PG8_STAGE(PG8_SB(1, 0), b3, voffB); PG8_STAGE(PG8_SB(1, 1), b3 + hstepB, voffB); PG8_STAGE(PG8_SA(1, 0), a3, v2[0]);
            PG8_WAIT_V(8); PG8_WAIT_L(0); PG8_BAR; if (do1) { PG8_MMA(1, 0, At, B0); PG8_MMA(1, 1, At, B1); } PG8_BAR; PG8_SCHED;
            }
        }
        if constexpr (ALIGN_EPI) { if (wr == 0) PG8_BAR; }
        if constexpr (!Epi::AFTER_DRAIN) { E(acc, cur, wr, wc, fr, fq); S.done(cur); }
        if (!has_next) break;
#pragma unroll
        for (int a = 0; a < 2; ++a)
#pragma unroll
            for (int b = 0; b < 2; ++b)
#pragma unroll
                for (int m = 0; m < 4; ++m)
#pragma unroll
                    for (int n = 0; n < 2; ++n) acc[a][b][m][n] = (f32x4){0.f, 0.f, 0.f, 0.f};
        cur = nxt; cA = nA; cB = nB; ++ui;
#pragma unroll
        for (int h_ = 0; h_ < 2; ++h_) { vc[h_][0] = vn[h_][0]; vc[h_][1] = vn[h_][1]; }
        if constexpr (ALIGN_EPI) { if (wr == 1) PG8_BAR; }
    }
    PG8_WAIT_V(0);
    if constexpr (!ALIGN_EPI) { if (wr == 0) PG8_BAR; }
    PG8_BAR;
    if constexpr (Epi::AFTER_DRAIN) { E.fused(acc, cur, wr, wc, fr, fq, lds, wid, lane); S.done(cur); }
#undef PG8_ROWS
#undef PG8_SA
#undef PG8_SB
#undef PG8_STAGE
#undef PG8_LDA
#undef PG8_LDB
#undef PG8_MMA
#undef PG8_WAIT_V
#undef PG8_WAIT_L
#undef PG8_BAR
#undef PG8_SCHED
}
}
constexpr int BATCH = 2, SEQ = 4096, DM = 2048, MTOK = BATCH * SEQ;
constexpr int NE0 = 6168, NE1 = 4176;
constexpr int NP0 = 6144, NP1 = 4096;
constexpr float LN_EPS = 1e-5f;
constexpr float DN_ALPHA = 1.41421356237309515f;
constexpr float ATT_SCALE = 0.08838834764831845f;
constexpr int RPAD = 24576;
constexpr size_t MiB = 1u << 20;
constexpr size_t WS_CTL = 0, CTL_ZERO_BYTES = 1 * MiB;
constexpr size_t WS_ROPE = 1 * MiB;
constexpr size_t WS_WSM = 4 * MiB;
constexpr size_t WS_SK0 = 6 * MiB;
constexpr size_t WS_IK = 7 * MiB;
constexpr size_t WS_IW = 8 * MiB + 512 * 1024;
constexpr size_t WS_FBIAS = 10 * MiB;
constexpr size_t WS_ROUTE = 11 * MiB;
constexpr size_t WS_MASK = 12 * MiB;
constexpr size_t WS_WINA = 16 * MiB, WS_WOA = 40 * MiB, WS_WINC = 48 * MiB, WS_WOC = 64 * MiB;
constexpr size_t WS_WGU = 72 * MiB;
constexpr size_t WS_WD = 328 * MiB;
constexpr size_t WS_XB = 456 * MiB;
constexpr size_t WS_YB = 488 * MiB;
constexpr size_t WS_PROJ = 552 * MiB;
constexpr size_t WS_CST = 648 * MiB;
constexpr size_t WS_PREVT = 712 * MiB;
constexpr size_t WS_OMIX = 744 * MiB;
constexpr size_t WS_GB = 776 * MiB;
constexpr size_t WS_DEC = 792 * MiB;
constexpr size_t WS_ROWW = 793 * MiB;
constexpr size_t WS_SC = 800 * MiB;
constexpr size_t WS_INV = 800 * MiB;
constexpr size_t WS_WINV = 801 * MiB;
constexpr size_t WS_END = 928 * MiB;
constexpr int CW_CNT = 1024;
constexpr int CW_FILL = 2048;
constexpr int CW_BAR = 4096;

#define GAS __attribute__((address_space(1)))
#define LAS __attribute__((address_space(3)))
typedef unsigned short bf16;
typedef unsigned v4u __attribute__((ext_vector_type(4)));
typedef unsigned v2u __attribute__((ext_vector_type(2)));
typedef float f32x4 __attribute__((ext_vector_type(4)));
typedef short bf16x8 __attribute__((ext_vector_type(8)));
#define LDS_WAIT() asm volatile("s_waitcnt lgkmcnt(0)" ::: "memory")
#define VM_WAIT() asm volatile("s_waitcnt vmcnt(0)" ::: "memory")
__device__ __forceinline__ unsigned f2bf(float f) { unsigned u = __builtin_bit_cast(unsigned, f); return (u + 0x7fffu + ((u >> 16) & 1u)) >> 16; }
__device__ __forceinline__ unsigned pk2(float lo, float hi) { return f2bf(lo) | (f2bf(hi) << 16); }
__device__ __forceinline__ float bf2f(unsigned short b) { return __builtin_bit_cast(float, ((unsigned)b) << 16); }
__device__ __forceinline__ float wave_sum(float v) {
#pragma unroll
    for (int o = 1; o < 64; o <<= 1) v += __shfl_xor(v, o);
    return v;
}
__device__ __forceinline__ float logsigmoidf(float z) { return fminf(z, 0.f) - log1pf(__expf(-fabsf(z))); }
#define XB_TMO      128
#define XB_XCNT(j)  (256  + 64 * (j))
#define XB_XSUB(j)  (1280 + 64 * (j))
#define XB_XGEN(j)  (2304 + 64 * (j))
#define XB_TOP      3328
#define XB_TOPGEN   3392
#define XCD_BAR_WORDS 3456
#define XB_SPIN_CAP (1u << 21)

__device__ __forceinline__ unsigned xb_ld(unsigned* p)              { return __hip_atomic_load(p, __ATOMIC_RELAXED, __HIP_MEMORY_SCOPE_AGENT); }
__device__ __forceinline__ unsigned xb_add(unsigned* p, unsigned v) { return __hip_atomic_fetch_add(p, v, __ATOMIC_RELAXED, __HIP_MEMORY_SCOPE_AGENT); }
__device__ __forceinline__ unsigned xb_xcc_id() { return (unsigned)__builtin_amdgcn_s_getreg((3 << 11) | 20) & 0xFu; }
#define XB_SPIN(cond, bar) do { unsigned _sp = 0; while (cond) { __builtin_amdgcn_s_sleep(1); \
    if ((++_sp & 255u) == 0u) { if (xb_ld(&(bar)[XB_TMO])) break; if (_sp > XB_SPIN_CAP) { atomicAdd(&(bar)[XB_TMO], 1u); break; } } } } while (0)

struct XcdBarrier {
    unsigned* bar; unsigned x;
    volatile LAS unsigned* st;
};

__device__ __forceinline__ XcdBarrier xcd_barrier_post(unsigned* bar, volatile LAS unsigned* st) {
    XcdBarrier b; b.bar = bar; b.x = xb_xcc_id(); b.st = st;
    if (threadIdx.x == 0) (void)xb_add(&bar[XB_XCNT(b.x)], 1u);
    return b;
}
__device__ __forceinline__ void xcd_barrier_complete(unsigned* bar, unsigned x, unsigned& nloc, unsigned& nx) {
    const unsigned G = gridDim.x * gridDim.y * gridDim.z;
    unsigned sum, cnt, mine, sp = 0u;
    for (;;) {
        sum = 0u; cnt = 0u; mine = 0u;
#pragma unroll
        for (unsigned j = 0; j < 16; ++j) { const unsigned c = xb_ld(&bar[XB_XCNT(j)]); sum += c; cnt += (c > 0u) ? 1u : 0u; mine = (j == x) ? c : mine; }
        if (sum == G) break;
        __builtin_amdgcn_s_sleep(1);
        if ((++sp & 255u) == 0u) { if (xb_ld(&bar[XB_TMO])) break; if (sp > XB_SPIN_CAP) { atomicAdd(&bar[XB_TMO], 1u); break; } }
    }
    nloc = mine > 0u ? mine : 1u; nx = cnt > 0u ? cnt : 1u;
}

__device__ __forceinline__ void xcd_barrier(const XcdBarrier& b) {
    asm volatile("s_waitcnt vmcnt(0)" ::: "memory");
    __syncthreads();
    if (threadIdx.x == 0) {
        unsigned* bar = b.bar;
        __builtin_amdgcn_s_waitcnt(0);
        unsigned nloc = b.st[0], nx = b.st[1];
        if (nloc == 0u) { xcd_barrier_complete(bar, b.x, nloc, nx); b.st[0] = nloc; b.st[1] = nx; }
        const unsigned old = xb_add(&bar[XB_XSUB(b.x)], 1u);
        const unsigned gen = old / nloc;
        if (old + 1u == (gen + 1u) * nloc) {
            __builtin_amdgcn_fence(__ATOMIC_RELEASE, "agent");
            asm volatile("s_waitcnt vmcnt(0)" ::: "memory");
            const unsigned og = xb_add(&bar[XB_TOP], 1u);
            const unsigned tg = og / nx;
            if (og + 1u == (tg + 1u) * nx) xb_add(&bar[XB_TOPGEN], 1u);
            else XB_SPIN(xb_ld(&bar[XB_TOPGEN]) == tg, bar);
            __builtin_amdgcn_fence(__ATOMIC_ACQUIRE, "agent");
            xb_add(&bar[XB_XGEN(b.x)], 1u);
            asm volatile("s_waitcnt vmcnt(0)" ::: "memory");
        } else {
            XB_SPIN(xb_ld(&bar[XB_XGEN(b.x)]) == gen, bar);
            __builtin_amdgcn_fence(__ATOMIC_ACQUIRE, "agent");
            asm volatile("s_waitcnt vmcnt(0)" ::: "memory");
        }
    }
    __syncthreads();
}

constexpr int NWAVES = 8;
constexpr int RING_BYTES = 131072;
constexpr int LDSCTL_OFF = RING_BYTES;
constexpr int LDS_BYTES = 147456;
struct Frame {
    LAS unsigned char* lds; volatile LAS unsigned* MISC; unsigned* ctl;
    int tid, lane, wave, G, gw, NGW;
    unsigned char* ws;
};
struct Args { const float* in[20]; float* out; unsigned char* ws; int ph_lo, ph_hi, bar_region, pad; };

struct TrItem { const float* W; bf16* WT; int ldw, c0, c1, K, n0, k0; };
__device__ __forceinline__ void tr64_load(const TrItem& t, f32x4 (&r)[16], int lane) {
    const int nq = lane & 15, kr = lane >> 4;
    const float* src = t.W + (size_t)(t.k0 + 2 * kr) * t.ldw + (nq < 8 ? t.c0 : t.c1 - 32) + 4 * nq;
#pragma unroll
    for (int i = 0; i < 8; ++i) { r[2 * i] = __builtin_nontemporal_load((const f32x4*)(src + (size_t)(8 * i) * t.ldw)); r[2 * i + 1] = __builtin_nontemporal_load((const f32x4*)(src + (size_t)(8 * i + 1) * t.ldw)); }
}
__device__ __forceinline__ void tr64_store(const TrItem& t, const f32x4 (&r)[16], LAS bf16* T, int lane) {
    const int nq = lane & 15, kr = lane >> 4;
#pragma unroll
    for (int i = 0; i < 8; ++i) { const int kk = 8 * i + 2 * kr;
#pragma unroll
        for (int e = 0; e < 4; ++e) *(LAS unsigned*)(T + (4 * nq + e) * 68 + kk) = pg8::cvt_pk_bf16(r[2 * i][e], r[2 * i + 1][e]); }
    LDS_WAIT(); asm volatile("" ::: "memory");
    const int c = lane & 7;
#pragma unroll
    for (int j = 0; j < 8; ++j) { const int n = (lane >> 3) + 8 * j; const v2u lo = *(const LAS v2u*)(T + n * 68 + 8 * c), hi = *(const LAS v2u*)(T + n * 68 + 8 * c + 4);
        v4u o; o.x = lo.x; o.y = lo.y; o.z = hi.x; o.w = hi.y;
        *(v4u*)(t.WT + (size_t)(t.n0 + n) * t.K + t.k0 + 8 * c) = o; }
    LDS_WAIT(); asm volatile("" ::: "memory");
}
__device__ __forceinline__ void transpose_item64(const float* W, int ldw, int c0, int c1, int K, bf16* WT, int n0, int k0, LAS bf16* T, int lane) {
    const TrItem t{W, WT, ldw, c0, c1, K, n0, k0}; f32x4 r[16]; tr64_load(t, r, lane); tr64_store(t, r, T, lane);
}
__device__ __forceinline__ int l1_src_col(int n) {
    const int pn = n >> 8, j = n & 255, jh = j & 127, second = j >> 7;
    if (pn == 10 || pn == 11) return n;
    if (pn < 10) return pn * 256 + (jh >> 6) * 128 + second * 64 + (jh & 63);
    return 3072 + ((pn - 12) * 4 + (jh >> 5)) * 64 + second * 32 + (jh & 31);
}
constexpr int SK_ROUTE0 = 0, SK_ROUTE1 = 48, SK_SK0 = 96, SK_SK1 = 128, SK_NCOL = 208;
constexpr int SK_PART_OFF = 0, SK_LG_OFF = 65536;
template <int NT> __device__ __forceinline__ void skinny_partials(LAS unsigned char* ldsb, const bf16* X, const bf16* WH, const bf16* WL, int w, int lane) {
    const int tile = w >> 2, kq = w & 3, l15 = lane & 15, quad = lane >> 4;
    const bf16* xp = X + (size_t)(16 * tile + l15) * DM + kq * 512 + quad * 8;
    const bf16* hp = WH + (size_t)l15 * 2048 + kq * 512 + quad * 8; const bf16* lp = WL + (size_t)l15 * 2048 + kq * 512 + quad * 8;
    pg8::f32x4 acc[NT];
#pragma unroll
    for (int n = 0; n < NT; ++n) acc[n] = (pg8::f32x4){0.f, 0.f, 0.f, 0.f};
#pragma unroll 4
    for (int ks = 0; ks < 16; ++ks) {
        const bf16x8 ah = *(const bf16x8*)(xp + 32 * ks);
#pragma unroll
        for (int n = 0; n < NT; ++n) { const bf16x8 bh = *(const bf16x8*)(hp + (size_t)n * 16 * 2048 + 32 * ks), bl = *(const bf16x8*)(lp + (size_t)n * 16 * 2048 + 32 * ks);
            acc[n] = __builtin_amdgcn_mfma_f32_16x16x32_bf16(ah, bh, acc[n], 0, 0, 0); acc[n] = __builtin_amdgcn_mfma_f32_16x16x32_bf16(ah, bl, acc[n], 0, 0, 0); }
    }
    LAS float* PART = (LAS float*)(ldsb + SK_PART_OFF);
#pragma unroll
    for (int n = 0; n < NT; ++n) *(LAS pg8::f32x4*)(PART + ((((tile * 4 + kq) * NT + n) * 64 + lane) * 4)) = acc[n];
}
template <int NT> __device__ __forceinline__ void skinny_reduce(LAS unsigned char* ldsb, int tid) {
    const LAS float* PART = (const LAS float*)(ldsb + SK_PART_OFF); LAS float* LG = (LAS float*)(ldsb + SK_LG_OFF);
    for (int idx = tid; idx < 32 * 16 * NT; idx += NWAVES * 64) { const int row = idx / (16 * NT), col = idx % (16 * NT), tile = row >> 4, rr = row & 15, ln = (rr >> 2) * 16 + (col & 15), n = col >> 4, j = rr & 3;
        float s = 0.f;
#pragma unroll
        for (int kq = 0; kq < 4; ++kq) s += PART[(((tile * 4 + kq) * NT + n) * 64 + ln) * 4 + j];
        LG[row * (16 * NT) + col] = s; }
}
__device__ __forceinline__ void ln_row(f32x4 (&v)[8], const float* g, const float* b, int lane) {
    float s = 0.f;
#pragma unroll
    for (int j = 0; j < 8; ++j) s += (v[j][0] + v[j][1]) + (v[j][2] + v[j][3]);
    const float mean = wave_sum(s) * (1.f / DM); float s2 = 0.f;
#pragma unroll
    for (int j = 0; j < 8; ++j) { v[j] = v[j] - mean; s2 += (v[j][0] * v[j][0] + v[j][1] * v[j][1]) + (v[j][2] * v[j][2] + v[j][3] * v[j][3]); }
    const float rstd = 1.f / sqrtf(wave_sum(s2) * (1.f / DM) + LN_EPS);
#pragma unroll
    for (int j = 0; j < 8; ++j) { const f32x4 gg = *(const f32x4*)(g + 256 * j + 4 * lane), bb = *(const f32x4*)(b + 256 * j + 4 * lane); v[j] = v[j] * rstd * gg + bb; }
}
__device__ __forceinline__ void load_row_bf16(const bf16* src, f32x4 (&v)[8], int lane) {
#pragma unroll
    for (int j = 0; j < 8; ++j) { const uint2 p = *(const uint2*)(src + 256 * j + 4 * lane); v[j][0] = bf2f(p.x & 0xffff); v[j][1] = bf2f(p.x >> 16); v[j][2] = bf2f(p.y & 0xffff); v[j][3] = bf2f(p.y >> 16); }
}
__device__ __forceinline__ void store_row_bf16(bf16* dst, const f32x4 (&v)[8], int lane) {
#pragma unroll
    for (int j = 0; j < 8; ++j) { uint2 o; o.x = pg8::cvt_pk_bf16(v[j][0], v[j][1]); o.y = pg8::cvt_pk_bf16(v[j][2], v[j][3]); *(uint2*)(dst + 256 * j + 4 * lane) = o; }
}
#define TK_FOR_VALID(...) _Pragma("unroll") for (int g_ = 0; g_ < 8; ++g_) { if (512 * g_ <= qpos) { _Pragma("unroll") for (int i = 8 * g_; i < 8 * g_ + 8; ++i) { __VA_ARGS__ } } }
__device__ __forceinline__ void topk_mask_row(const LAS float* sc, int qpos, unsigned long long* mrow, int lane, LAS unsigned* cbuf) {
    unsigned u[64];
#pragma unroll
    for (int i = 0; i < 64; ++i) { const int s = 64 * i + lane; const bool ok = s <= qpos; const float f = ok ? sc[s] : 0.f; const unsigned b = __builtin_bit_cast(unsigned, f);
        const unsigned key = b ^ ((b >> 31) ? 0xFFFFFFFFu : 0x80000000u); u[i] = ok ? key : 0u; }
    unsigned long long mword = 0ull;
    if (qpos + 1 <= 256) {
#pragma unroll
        for (int i = 0; i < 4; ++i) { const unsigned long long w = __ballot(64 * i + lane <= qpos); mword = (lane == i) ? w : mword; }
        mrow[lane] = mword; return;
    }
    const unsigned long long below = (1ull << lane) - 1ull;
    unsigned T = 0u;
#pragma unroll 1
    for (int bit = 31; bit >= 20; --bit) { const unsigned cand = T | (1u << bit); int cnt = 0;
        TK_FOR_VALID( cnt += __builtin_popcountll(__ballot(u[i] >= cand)); )
        if (cnt >= 256) T = cand; }
    const unsigned pre = T >> 20; int cgt = 0, nc = 0;
    TK_FOR_VALID( { const unsigned p_ = u[i] >> 20; const unsigned long long gm = __ballot(p_ > pre), em = __ballot(p_ == pre); cgt += __builtin_popcountll(gm);
        const int pos_ = nc + __builtin_popcountll(em & below); if (p_ == pre && pos_ < 256) cbuf[pos_] = u[i]; nc += __builtin_popcountll(em); } )
    int kneed = 256 - cgt;
    if (nc <= 256) {
        asm volatile("s_waitcnt lgkmcnt(0)" ::: "memory");
        unsigned c0 = lane < nc ? cbuf[lane] : 0u, c1 = 64 + lane < nc ? cbuf[64 + lane] : 0u, c2 = 128 + lane < nc ? cbuf[128 + lane] : 0u, c3 = 192 + lane < nc ? cbuf[192 + lane] : 0u;
#pragma unroll 1
        for (int bit = 19; bit >= 0; --bit) { const unsigned cand = T | (1u << bit);
            int cnt = __builtin_popcountll(__ballot(c0 >= cand));
            if (nc > 64) cnt += __builtin_popcountll(__ballot(c1 >= cand));
            if (nc > 128) cnt += __builtin_popcountll(__ballot(c2 >= cand)) + __builtin_popcountll(__ballot(c3 >= cand));
            if (cnt >= kneed) T = cand; }
        const int cg2 = __builtin_popcountll(__ballot(c0 > T)) + __builtin_popcountll(__ballot(c1 > T)) + __builtin_popcountll(__ballot(c2 > T)) + __builtin_popcountll(__ballot(c3 > T));
        kneed -= cg2;
    } else {
#pragma unroll 1
        for (int bit = 19; bit >= 0; --bit) { const unsigned cand = T | (1u << bit); int cnt = 0;
            TK_FOR_VALID( cnt += __builtin_popcountll(__ballot(u[i] >= cand)); )
            if (cnt >= 256) T = cand; }
        int cg2 = 0;
        TK_FOR_VALID( cg2 += __builtin_popcountll(__ballot(u[i] > T)); )
        kneed = 256 - cg2;
    }
    int run = 0;
#pragma unroll
    for (int i = 0; i < 64; ++i) { const bool gt = u[i] > T, eq = u[i] == T; const unsigned long long eqm = __ballot(eq);
        const int rank = run + __builtin_popcountll(eqm & below); const bool sel = gt || (eq && rank < kneed); run += __builtin_popcountll(eqm);
        const unsigned long long w = __ballot(sel); mword = (lane == i) ? w : mword; }
    mrow[lane] = mword;
}
#undef TK_FOR_VALID
constexpr int CONV_MOE_ITEMS = 32 * (32 * 16) + 32 * (8 * 32);
#ifndef CONV_STATIC_ITEMS
#define CONV_STATIC_ITEMS 0
#endif
constexpr int CONV_STATIC = CONV_STATIC_ITEMS;
constexpr int CONV_LATE_ITEMS = CONV_MOE_ITEMS + 32 * (NP1 / 64) + 32 * 32 + CONV_MOE_ITEMS;
#ifndef CONV_TAIL_ITEMS
#define CONV_TAIL_ITEMS 12288
#endif
#ifndef CONV_BIG_ITEMS
#define CONV_BIG_ITEMS 32768
#endif
constexpr int CONV_BIG = CONV_BIG_ITEMS;
constexpr int CONV_SPLIT = CONV_LATE_ITEMS - CONV_TAIL_ITEMS;
__device__ __forceinline__ TrItem conv_moe_desc(const Args& a, unsigned char* ws, int layer, int it) {
    if (it < 32 * 512) {
        const int ex = layer * 32 + it / 512, r = it % 512, blk = r >> 5, jj = r & 31, kb = (blk >> 2) * 8 + (jj >> 2), nb = (blk & 3) * 4 + (jj & 3), n0 = nb * 64, tile = n0 >> 8, j = n0 & 255;
        const float* W = (j < 128 ? a.in[17] : a.in[18]) + (size_t)ex * 2048 * 512;
        return TrItem{W, (bf16*)(ws + WS_WGU) + (size_t)ex * 1024 * 2048, 512, 128 * tile + (j & 127), 128 * tile + (j & 127) + 32, 2048, n0, kb * 64};
    }
    const int i2 = it - 32 * 512, ex = layer * 32 + i2 / 256, r = i2 % 256, blk = r >> 5, jj = r & 31, kb = jj >> 2, nb = blk * 4 + (jj & 3);
    return TrItem{a.in[19] + (size_t)ex * 512 * 2048, (bf16*)(ws + WS_WD) + (size_t)ex * 2048 * 512, 2048, nb * 64, nb * 64 + 32, 512, nb * 64, kb * 64};
}
__device__ __forceinline__ TrItem conv_late_desc(const Args& a, unsigned char* ws, int it) {
    if (it < CONV_MOE_ITEMS) return conv_moe_desc(a, ws, 0, it);
    it -= CONV_MOE_ITEMS;
    if (it < 32 * (NP1 / 64)) { const int kb = it / (NP1 / 64), nb = it % (NP1 / 64), n0 = nb * 64;
        return TrItem{a.in[7], (bf16*)(ws + WS_WINC), NE1, l1_src_col(n0), l1_src_col(n0 + 32), 2048, n0, kb * 64}; }
    it -= 32 * (NP1 / 64);
    if (it < 32 * 32) { const int kb = it / 32, nb = it % 32; return TrItem{a.in[8], (bf16*)(ws + WS_WOC), 2048, nb * 64, nb * 64 + 32, 2048, nb * 64, kb * 64}; }
    return conv_moe_desc(a, ws, 1, it - 32 * 32);
}
template <int CHUNK>
__device__ __forceinline__ void late_conv_items(Frame& F, const Args& a, const int lo, const int hi, const int ctr) {
    LAS bf16* T = (LAS bf16*)(F.lds + F.wave * 16384); volatile LAS int* slot = (volatile LAS int*)(F.lds + 131072 + 512);
    for (;;) {
        __syncthreads();
        if (F.tid == 0) *slot = lo + (int)atomicAdd(F.ctl + CW_FILL + 64 * ctr, (unsigned)CHUNK);
        __syncthreads();
        const int base = *slot;
        if (base >= hi) break;
        f32x4 rA[16], rB[16];
        TrItem tA = conv_late_desc(a, F.ws, base + F.wave), tB = tA; tr64_load(tA, rA, F.lane);
#pragma unroll 1
        for (int j = 0; j < CHUNK / 8; j += 2) {
            tB = conv_late_desc(a, F.ws, base + F.wave + 8 * (j + 1)); tr64_load(tB, rB, F.lane);
            tr64_store(tA, rA, T, F.lane);
            if (j + 2 < CHUNK / 8) { tA = conv_late_desc(a, F.ws, base + F.wave + 8 * (j + 2)); tr64_load(tA, rA, F.lane); }
            tr64_store(tB, rB, T, F.lane);
        }
    }
    __syncthreads();
}
static_assert(CONV_LATE_ITEMS % 64 == 0 && CONV_STATIC == 0 && CONV_BIG % 64 == 0 && CONV_SPLIT % 16 == 0 && CONV_BIG <= CONV_SPLIT, "filler chunks");
__device__ __forceinline__ void p0_prologue(Frame& F, const Args& a) {
    const int gw = F.gw, NGW = F.NGW, lane = F.lane;
    unsigned char* ws = F.ws;
    LAS bf16* T = (LAS bf16*)(F.lds + F.wave * 16384);
    {
        const float* W = a.in[1]; bf16* WT = (bf16*)(ws + WS_WINA);
        for (int it = gw; it < 32 * (NP0 / 64); it += NGW) { const int kb = it / (NP0 / 64), nb = it % (NP0 / 64), n0 = nb * 64; const int c0 = n0 < 3072 ? n0 : n0 + 16; transpose_item64(W, NE0, c0, c0 + 32, 2048, WT, n0, kb * 64, T, lane); }
    }
    {
        for (int it = gw; it < 32 * 32; it += NGW) { const int kb = it / 32, nb = it % 32; transpose_item64(a.in[6], 2048, nb * 64, nb * 64 + 32, 2048, (bf16*)(ws + WS_WOA), nb * 64, kb * 64, T, lane); }
    }
    for (int it = gw; it < CONV_STATIC; it += NGW) { const TrItem t = conv_late_desc(a, ws, it); f32x4 r16[16]; tr64_load(t, r16, lane); tr64_store(t, r16, T, lane); }
    const int gt = blockIdx.x * (NWAVES * 64) + F.tid, NGT = F.G * NWAVES * 64;
    {   float* c128 = (float*)(ws + WS_ROPE); float* s128 = c128 + 4096 * 64; float* c64 = s128 + 4096 * 64; float* s64 = c64 + 4096 * 32;
        for (int i = gt; i < 4096 * 96; i += NGT) { int pos, idx, half; float* cp; float* sp;
            if (i < 4096 * 64) { pos = i >> 6; idx = i & 63; half = 64; cp = c128 + i; sp = s128 + i; } else { const int r = i - 4096 * 64; pos = r >> 5; idx = r & 31; half = 32; cp = c64 + r; sp = s64 + r; }
            const float inv = exp2f(-(float)idx / (float)half * 13.287712379549449f);
            const float ang = (float)pos * inv;
            double rv = (double)ang * 0.15915494309189535; rv -= rint(rv);
            const float rf = (float)rv;
            *cp = __builtin_amdgcn_cosf(rf); *sp = __builtin_amdgcn_sinf(rf); }
    }
    {   bf16* SKH = (bf16*)(ws + WS_WSM); bf16* SKL = SKH + (size_t)SK_NCOL * 2048;
        for (int i = gt; i < 2048 * SK_NCOL; i += NGT) { const int k = i / SK_NCOL, c = i % SK_NCOL; float v = 0.f;
            if (c < 96) { const int l = c / 48, j = c % 48; if (j < 4) v = a.in[13][((size_t)l * 2048 + k) * 4 + j]; else if (j < 36) { const int g = (j - 4) >> 3, e = (j - 4) & 7; v = a.in[15][(((size_t)l * 4 + g) * 2048 + k) * 8 + e]; } }
            else if (c < 128) { const int j = c - 96; if (j < 16) v = a.in[1][(size_t)k * NE0 + 3072 + j]; else if (j < 24) v = a.in[1][(size_t)k * NE0 + 6160 + j - 16]; }
            else v = a.in[7][(size_t)k * NE1 + 4096 + c - 128];
            const unsigned h = f2bf(v); SKH[(size_t)c * 2048 + k] = (bf16)h; SKL[(size_t)c * 2048 + k] = (bf16)f2bf(v - bf2f((unsigned short)h)); }
    }
    {   const float* x = a.in[0]; bf16* XB = (bf16*)(ws + WS_XB);
        for (int m = gw; m < MTOK; m += NGW) { f32x4 v[8];
#pragma unroll
            for (int j = 0; j < 8; ++j) v[j] = *(const f32x4*)(x + (size_t)m * DM + 256 * j + 4 * lane);
            store_row_bf16(XB + (size_t)m * DM, v, lane); }
    }
}
__device__ __forceinline__ void p_skinny0(Frame& F, const Args& a) {
    const bf16* SKH = (const bf16*)(F.ws + WS_WSM) + (size_t)SK_SK0 * 2048; const bf16* SKL = SKH + (size_t)SK_NCOL * 2048; float* SK0 = (float*)(F.ws + WS_SK0);
    const LAS float* LG = (const LAS float*)(F.lds + SK_LG_OFF);
    for (int blk = blockIdx.x; blk < MTOK / 32; blk += F.G) { const int R0 = blk * 32;
        __syncthreads();
        skinny_partials<2>(F.lds, (const bf16*)(F.ws + WS_XB) + (size_t)R0 * DM, SKH, SKL, F.wave, F.lane);
        __syncthreads();
        skinny_reduce<2>(F.lds, F.tid);
        __syncthreads();
        for (int idx = F.tid; idx < 32 * 24; idx += NWAVES * 64) { const int row = idx / 24, c = idx % 24; SK0[(size_t)(R0 + row) * 24 + c] = LG[row * 32 + c]; }
    }
    __syncthreads();
}
__device__ __forceinline__ void p_fox_bias(Frame& F, const Args& a) {
    if (blockIdx.x >= 16) return;
    const int bh = blockIdx.x, b = bh >> 3, h = bh & 7, lane = F.lane, tid = F.tid; const float gb = a.in[5][h];
    const float* SK0 = (const float*)(F.ws + WS_SK0); float* FB = (float*)(F.ws + WS_FBIAS) + (size_t)bh * SEQ; LAS float* wt = (LAS float*)(F.lds + 120000);
    float lf[8], tot = 0.f;
#pragma unroll
    for (int i = 0; i < 8; ++i) lf[i] = SK0[(size_t)(b * SEQ + tid * 8 + i) * 24 + 16 + h];
#pragma unroll
    for (int i = 0; i < 8; ++i) { tot += logsigmoidf(lf[i] + gb); lf[i] = tot; }
    float incl = tot;
#pragma unroll
    for (int o = 1; o < 64; o <<= 1) { const float t = __shfl_up(incl, o); if (lane >= o) incl += t; }
    if (lane == 63) wt[F.wave] = incl;
    __syncthreads();
    float pre = incl - tot;
    for (int w = 0; w < F.wave; ++w) pre += wt[w];
#pragma unroll
    for (int i = 0; i < 8; ++i) FB[tid * 8 + i] = -(pre + lf[i]) * (1.0f / ATT_SCALE);
    __syncthreads();
}
__device__ __forceinline__ void p_ln_route(Frame& F, const Args& a, int layer) {
    const bf16* YB = (const bf16*)(F.ws + WS_YB); bf16* XB = (bf16*)(F.ws + WS_XB); const int lane = F.lane;
    const float* g = a.in[9] + layer * DM; const float* bb = a.in[10] + layer * DM;
    const bf16* SKH = (const bf16*)(F.ws + WS_WSM) + (size_t)(layer ? SK_ROUTE1 : SK_ROUTE0) * 2048; const bf16* SKL = SKH + (size_t)SK_NCOL * 2048;
    const float* bg = a.in[14] + layer * 4; const float* be = a.in[16] + layer * 32;
    int4* ROUTE = (int4*)(F.ws + WS_ROUTE); unsigned* cnt = F.ctl + CW_CNT + layer * 64; int* INV = (int*)(F.ws + WS_INV); float* WINV = (float*)(F.ws + WS_WINV);
    const LAS float* LG = (const LAS float*)(F.lds + SK_LG_OFF);
    for (int blk = blockIdx.x; blk < MTOK / 32; blk += F.G) { const int R0 = blk * 32;
#pragma unroll 1
        for (int i2 = 0; i2 < 4; i2 += 2) {
            f32x4 v[2][8];
#pragma unroll
            for (int i = 0; i < 2; ++i) load_row_bf16(YB + (size_t)(R0 + 4 * F.wave + i2 + i) * DM, v[i], lane);
#pragma unroll
            for (int i = 0; i < 2; ++i) ln_row(v[i], g, bb, lane);
#pragma unroll
            for (int i = 0; i < 2; ++i) store_row_bf16(XB + (size_t)(R0 + 4 * F.wave + i2 + i) * DM, v[i], lane);
        }
        __syncthreads();
        skinny_partials<3>(F.lds, XB + (size_t)R0 * DM, SKH, SKL, F.wave, lane);
        __syncthreads();
        skinny_reduce<3>(F.lds, F.tid);
        __syncthreads();
        if (F.tid < 32) { const int m = R0 + F.tid; const LAS float* l = LG + F.tid * 48;
            float gl[4];
#pragma unroll
            for (int i = 0; i < 4; ++i) gl[i] = l[i] + bg[i];
            int gi = 0; float gm = gl[0];
#pragma unroll
            for (int i = 1; i < 4; ++i) if (gl[i] > gm) { gm = gl[i]; gi = i; }
            float gs = 0.f;
#pragma unroll
            for (int i = 0; i < 4; ++i) gs += __expf(gl[i] - gm);
            const float gp = 1.0f / gs;
            float el[8];
#pragma unroll
            for (int e = 0; e < 8; ++e) el[e] = l[4 + 8 * gi + e] + be[gi * 8 + e];
            int e1 = 0; float v1 = el[0];
#pragma unroll
            for (int e = 1; e < 8; ++e) if (el[e] > v1) { v1 = el[e]; e1 = e; }
            int e2 = -1; float v2 = -3.0e38f;
#pragma unroll
            for (int e = 0; e < 8; ++e) if (e != e1 && el[e] > v2) { v2 = el[e]; e2 = e; }
            const float w1 = gp / (1.0f + __expf(v2 - v1)), w2 = gp - w1;
            const int ge1 = gi * 8 + e1, ge2 = gi * 8 + e2;
            LAS unsigned* hist = (LAS unsigned*)(F.lds + SK_LG_OFF + 32 * 48 * 4); LAS unsigned* ebase = hist + 32;
            hist[F.tid] = 0u;
            const unsigned r1 = __hip_atomic_fetch_add(hist + ge1, 1u, __ATOMIC_RELAXED, __HIP_MEMORY_SCOPE_WORKGROUP), r2 = __hip_atomic_fetch_add(hist + ge2, 1u, __ATOMIC_RELAXED, __HIP_MEMORY_SCOPE_WORKGROUP);
            const unsigned hc = hist[F.tid];
            ebase[F.tid] = hc ? atomicAdd(cnt + F.tid, hc) : 0u;
            const int p1 = (int)(ebase[ge1] + r1), p2 = (int)(ebase[ge2] + r2);
            ROUTE[(size_t)m * 2 + 0] = make_int4(ge1, p1, 0, 0); ROUTE[(size_t)m * 2 + 1] = make_int4(ge2, p2, 0, 0);
            INV[ge1 * 8192 + p1] = m; INV[ge2 * 8192 + p2] = m; WINV[ge1 * 8192 + p1] = w1; WINV[ge2 * 8192 + p2] = w2; }
    }
    __syncthreads();
}
__device__ __forceinline__ int moe_offsets(const unsigned* cnt, int lane, int* tiles_incl) {
    const int c = lane < 32 ? (int)cnt[lane] : 0; const int t = (c + 255) >> 8; int incl = t;
#pragma unroll
    for (int o = 1; o < 32; o <<= 1) { const int x = __shfl_up(incl, o); if ((lane & 31) >= o) incl += x; }
    *tiles_incl = incl; return (incl - t) * 256;
}
__device__ __forceinline__ void p_ln_ffn(Frame& F, const Args& a, int layer) {
    bf16* XB = (bf16*)(F.ws + WS_XB); const int lane = F.lane; const bf16* YG = (const bf16*)(F.ws + WS_CST);
    const float* g = a.in[11] + layer * DM; const float* bb = a.in[12] + layer * DM; const int4* ROUTE = (const int4*)(F.ws + WS_ROUTE);
    const bf16* SKH = (const bf16*)(F.ws + WS_WSM) + (size_t)SK_SK1 * 2048; const bf16* SKL = SKH + (size_t)SK_NCOL * 2048;
    const float* c64 = (const float*)(F.ws + WS_ROPE) + 2 * 4096 * 64; const float* s64 = c64 + 4096 * 32;
    bf16* IK = (bf16*)(F.ws + WS_IK); float* IW = (float*)(F.ws + WS_IW);
    const LAS float* LG = (const LAS float*)(F.lds + SK_LG_OFF);
    int ti_; const int eoff = moe_offsets(F.ctl + CW_CNT + layer * 64, lane, &ti_);
    for (int blk = blockIdx.x; blk < MTOK / 32; blk += F.G) { const int R0 = blk * 32;
#pragma unroll 2
        for (int i = 0; i < 4; ++i) { const int m = R0 + 4 * F.wave + i; f32x4 v[8];
            const int4 q0 = ROUTE[(size_t)m * 2], q1 = ROUTE[(size_t)m * 2 + 1]; const int r0 = __shfl(eoff, q0.x) + q0.y, r1 = __shfl(eoff, q1.x) + q1.y;
            load_row_bf16(XB + (size_t)m * DM, v, lane);
#pragma unroll
            for (int j = 0; j < 8; ++j) { v[j] = v[j] * DN_ALPHA;
                const uint2 y0 = *(const uint2*)(YG + (size_t)r0 * DM + 256 * j + 4 * lane), y1 = *(const uint2*)(YG + (size_t)r1 * DM + 256 * j + 4 * lane);
                v[j][0] += bf2f(y0.x & 0xffff) + bf2f(y1.x & 0xffff); v[j][1] += bf2f(y0.x >> 16) + bf2f(y1.x >> 16);
                v[j][2] += bf2f(y0.y & 0xffff) + bf2f(y1.y & 0xffff); v[j][3] += bf2f(y0.y >> 16) + bf2f(y1.y >> 16); }
            ln_row(v, g, bb, lane);
            if (layer == 0) store_row_bf16(XB + (size_t)m * DM, v, lane);
            else {
#pragma unroll
                for (int j = 0; j < 8; ++j) *(f32x4*)(a.out + (size_t)m * DM + 256 * j + 4 * lane) = v[j]; } }
        if (layer == 0) {
            __syncthreads();
            skinny_partials<5>(F.lds, XB + (size_t)R0 * DM, SKH, SKL, F.wave, lane);
            __syncthreads();
            skinny_reduce<5>(F.lds, F.tid);
            __syncthreads();
            for (int idx = F.tid; idx < 32 * 80; idx += NWAVES * 64) { const int row = idx / 80, c = idx % 80, m = R0 + row; const float v = LG[row * 80 + c];
                if (c < 64) { const float part = LG[row * 80 + (c ^ 32)]; const int pos = m & 4095, i = c & 31; const float cs = c64[pos * 32 + i], sn = s64[pos * 32 + i];
                    const int bq = m >> 12, sq = m & 4095; IK[((((size_t)bq * 128 + (sq >> 5)) * 4 + (c >> 4)) * 64 + ((c >> 3) & 1) * 32 + (sq & 31)) * 8 + (c & 7)] = (bf16)f2bf(c < 32 ? (v * cs - part * sn) : (v * cs + part * sn)); }
                else IW[(size_t)m * 16 + c - 64] = v * 0.25f * 0.125f; }
        }
    }
    __syncthreads();
}
__device__ __forceinline__ void ph_gla_b(Frame& F, const Args& a) {
    const float* SK0 = (const float*)(F.ws + WS_SK0); const float* w2 = a.in[2]; const float* gbias = a.in[3]; float* GB = (float*)(F.ws + WS_GB); float* DEC = (float*)(F.ws + WS_DEC);
    for (int u4 = blockIdx.x; u4 < 128; u4 += F.G) {
        const int unit = u4 * 4 + (F.tid >> 7), n = unit & 63, bh = unit >> 6, b = bh >> 2, h = bh & 3, d = F.tid & 127, t0 = b * SEQ + n * 64;
        float w[16];
#pragma unroll
        for (int r = 0; r < 16; ++r) w[r] = w2[r * 512 + h * 128 + d];
        const float gb = gbias[h * 128 + d]; float run = 0.f;
        for (int c = 0; c < 64; ++c) { const int t = t0 + c; float z = gb;
#pragma unroll
            for (int r = 0; r < 16; ++r) z += SK0[(size_t)t * 24 + r] * w[r];
            run += logsigmoidf(z) * (1.0f / 16.0f); GB[(size_t)t * 512 + h * 128 + d] = run; }
        DEC[unit * 128 + d] = __expf(run);
    }
}
__device__ __forceinline__ void ph_gla_state(Frame& F) {
    const bf16* PROJ = (const bf16*)(F.ws + WS_PROJ); const float* GB = (const float*)(F.ws + WS_GB); float* CST = (float*)(F.ws + WS_CST);
    for (int vb = blockIdx.x; vb < 512 * 64; vb += F.G) {
        const int unit = vb >> 6, d = (vb & 63) * 2 + (F.tid >> 8), v = F.tid & 255, n = unit & 63, bh = unit >> 6, b = bh >> 2, h = bh & 3, t0 = b * SEQ + n * 64;
        const float blast = GB[(size_t)(t0 + 63) * 512 + h * 128 + d]; float acc = 0.f;
        for (int c = 0; c < 64; ++c) { const size_t t = t0 + c; const float kk = bf2f(PROJ[t * NP0 + 512 + h * 128 + d]) * __expf(blast - GB[t * 512 + h * 128 + d]);
            acc += kk * bf2f(PROJ[t * NP0 + 1024 + h * 256 + v]); }
        CST[((size_t)unit * 256 + v) * 128 + d] = acc;
    }
}
__device__ __forceinline__ void ph_gla_scan(Frame& F) {
    const bf16* __restrict__ CST = (const bf16*)(F.ws + WS_CST); const float* __restrict__ DEC = (const float*)(F.ws + WS_DEC); bf16* __restrict__ PREVT = (bf16*)(F.ws + WS_PREVT);
    for (int idx = blockIdx.x * 512 + F.tid; idx < 8 * 16384; idx += F.G * 512) { const int bh = idx >> 14, vd = (idx & 16383) * 2, d = vd & 127; float S0 = 0.f, S1 = 0.f;
#pragma unroll 1
        for (int n0 = 0; n0 < 64; n0 += 8) { unsigned c[8]; float2 dc[8];
#pragma unroll
            for (int j = 0; j < 8; ++j) { const int unit = bh * 64 + n0 + j; c[j] = *(const unsigned*)(CST + (size_t)unit * 32768 + vd); dc[j] = *(const float2*)(DEC + unit * 128 + d); }
#pragma unroll
            for (int j = 0; j < 8; ++j) { const int unit = bh * 64 + n0 + j; *(unsigned*)(PREVT + (size_t)unit * 32768 + vd) = pk2(S0, S1);
                S0 = dc[j].x * S0 + bf2f(c[j] & 0xffff); S1 = dc[j].y * S1 + bf2f(c[j] >> 16); } } }
}
__device__ __forceinline__ void ph_gla_out(Frame& F, const Args& a) {
    const bf16* PROJ = (const bf16*)(F.ws + WS_PROJ); const float* GB = (const float*)(F.ws + WS_GB); const bf16* PREVT = (const bf16*)(F.ws + WS_PREVT); const float* normg = a.in[4]; bf16* OMIX = (bf16*)(F.ws + WS_OMIX);
    LAS float* qd = (LAS float*)F.lds; LAS float* ki = qd + 64 * 128; LAS float* sc = ki + 64 * 128; LAS float* red = sc + 64 * 64;
    const int tid = F.tid; const bool act = tid < 256;
    for (int unit = blockIdx.x; unit < 512; unit += F.G) {
        const int n = unit & 63, bh = unit >> 6, b = bh >> 2, h = bh & 3, t0 = b * SEQ + n * 64;
        __syncthreads();
        for (int i = tid; i < 64 * 128; i += 512) { const int c = i >> 7, d = i & 127; const size_t t = t0 + c; const float bb = GB[t * 512 + h * 128 + d];
            qd[i] = bf2f(PROJ[t * NP0 + h * 128 + d]) * ATT_SCALE * __expf(bb); ki[i] = bf2f(PROJ[t * NP0 + 512 + h * 128 + d]) * __expf(-bb); }
        __syncthreads();
        for (int p = tid; p < 64 * 64; p += 512) { const int i = p >> 6, j = p & 63; float s = 0.f;
            if (j <= i) for (int d = 0; d < 128; ++d) s += qd[i * 128 + d] * ki[j * 128 + d];
            sc[p] = s; }
        __syncthreads();
        const int v = tid & 255; const bf16* pv = PREVT + ((size_t)unit * 256 + v) * 128; const float gv = normg[v];
        for (int i = 0; i < 64; ++i) { float acc = 0.f;
            if (act) { for (int j = 0; j <= i; ++j) acc += sc[i * 64 + j] * bf2f(PROJ[(size_t)(t0 + j) * NP0 + 1024 + h * 256 + v]);
                for (int d = 0; d < 128; ++d) acc += qd[i * 128 + d] * bf2f(pv[d]);
                const float ss = wave_sum(acc * acc); if ((tid & 63) == 0) red[tid >> 6] = ss; }
            __syncthreads();
            const float ms = (red[0] + red[1] + red[2] + red[3]) * (1.0f / 256.0f); __syncthreads();
            if (act) { const float gr = bf2f(PROJ[(size_t)(t0 + i) * NP0 + 2048 + h * 256 + v]);
                const float o = acc * (1.0f / sqrtf(ms + LN_EPS)) * gv * (gr / (1.0f + __expf(-gr)));
                OMIX[(size_t)(t0 + i) * DM + h * 256 + v] = (bf16)f2bf(o); } }
    }
}
template <int MODE  >
__device__ __forceinline__ void ph_attn_naive(Frame& F, const bf16* Qb, int ldq, int qc0, const bf16* Kb, int ldk, int kc0, const bf16* Vb, int ldv, int vc0, int nheads, int group,
                                              const float* fbias, const unsigned long long* mask, bf16* O, int oc0) {
    const int half = F.tid >> 8, tid = F.tid & 255, qi = tid >> 2, part = tid & 3;
    LAS bf16* Ks = (LAS bf16*)(F.lds + half * 32768); LAS bf16* Vs = Ks + 64 * 128;
    const int nvb = (SEQ / 64) * (nheads / 2) * BATCH;
    for (int vb = blockIdx.x; vb < nvb; vb += F.G) {
        const int cc = vb >> 6, qb = ((vb & 63) + cc * 17) & 63, hp = cc % (nheads / 2), b = cc / (nheads / 2), h = hp * 2 + half, kvh = h / group;
        const int qpos = qb * 64 + qi; const size_t row = (size_t)b * SEQ + qpos;
        float qv[32], o[32];
#pragma unroll
        for (int d = 0; d < 32; ++d) { qv[d] = bf2f(Qb[row * ldq + qc0 + h * 128 + part * 32 + d]); o[d] = 0.f; }
        float mrun = -1e30f, l = 0.f;
        const float* fb = MODE == 0 ? fbias + (size_t)(b * 8 + h) * SEQ : nullptr;
        for (int kt = 0; kt <= qb; ++kt) {
            __syncthreads();
            for (int i = tid; i < 64 * 16; i += 256) { const int r = i >> 4, c8 = (i & 15) * 8; const size_t kr = (size_t)b * SEQ + kt * 64 + r;
                *(LAS v4u*)(Ks + r * 128 + c8) = *(const v4u*)(Kb + kr * ldk + kc0 + kvh * 128 + c8); *(LAS v4u*)(Vs + r * 128 + c8) = *(const v4u*)(Vb + kr * ldv + vc0 + kvh * 128 + c8); }
            __syncthreads();
            unsigned long long mw = ~0ull; if (MODE == 1) mw = mask[row * 64 + kt];
            for (int s = 0; s < 64; ++s) { const int key = kt * 64 + s; float p = 0.f;
#pragma unroll
                for (int d = 0; d < 32; ++d) p += qv[d] * bf2f(Ks[s * 128 + part * 32 + d]);
                p += __shfl_xor(p, 1); p += __shfl_xor(p, 2);
                const bool valid = key <= qpos && ((mw >> s) & 1ull);
                if (valid) { const float logit = (p + (MODE == 0 ? fb[key] : 0.f)) * ATT_SCALE; const float mn = fmaxf(mrun, logit), al = __expf(mrun - mn), pp = __expf(logit - mn);
                    l = l * al + pp; mrun = mn;
#pragma unroll
                    for (int d = 0; d < 32; ++d) o[d] = o[d] * al + pp * bf2f(Vs[s * 128 + part * 32 + d]); } }
        }
        const float il = 1.0f / l;
#pragma unroll
        for (int d = 0; d < 32; ++d) O[row * DM + oc0 + h * 128 + part * 32 + d] = (bf16)f2bf(o[d] * il);
    }
    __syncthreads();
}
__device__ __forceinline__ void ph_idx_scores(Frame& F) {
    const bf16* PROJ1 = (const bf16*)(F.ws + WS_PROJ); const bf16* IK = (const bf16*)(F.ws + WS_IK); const float* IW = (const float*)(F.ws + WS_IW); float* SC = (float*)(F.ws + WS_SC);
    LAS float* q = (LAS float*)F.lds; LAS float* w = q + 1024; const int tid = F.tid;
    for (int m = blockIdx.x; m < MTOK; m += F.G) { const int pos = m & 4095, b = m >> 12;
        __syncthreads();
        for (int i = tid; i < 1024; i += 512) q[i] = bf2f(PROJ1[(size_t)m * NP1 + 3072 + i]);
        if (tid < 16) w[tid] = IW[(size_t)m * 16 + tid];
        __syncthreads();
        for (int s = tid; s <= pos; s += 512) { const bf16* kr = IK + ((size_t)b * SEQ + s) * 64; float kk[64];
#pragma unroll
            for (int d = 0; d < 64; ++d) kk[d] = bf2f(kr[d]);
            float sc = 0.f;
#pragma unroll 1
            for (int hh = 0; hh < 16; ++hh) { float dsum = 0.f;
#pragma unroll
                for (int d = 0; d < 64; ++d) dsum += q[hh * 64 + d] * kk[d];
                sc += w[hh] * fmaxf(dsum, 0.f); }
            SC[(size_t)m * SEQ + s] = sc; }
    }
    __syncthreads();
}
namespace attn {
constexpr int D = 128, NW = 8, QBLK = 32, KVBLK = 64, QB = NW * QBLK;
constexpr int SHM_V = KVBLK * D * 2, SHM_K = KVBLK * D * 2;
constexpr int OFF_WS = 2 * SHM_V + 2 * SHM_K, OFF_BIAS = OFF_WS + NW * 64 * 4, LDS_NEED = OFF_BIAS + 2 * 16384;
constexpr float SCALE = 0.08838834764831845f, THR = 8.f;
typedef short s16x4 __attribute__((ext_vector_type(4)));
typedef float f32x16 __attribute__((ext_vector_type(16)));
typedef unsigned u32x4 __attribute__((ext_vector_type(4)));
#define KSWZ(row, colB) ((row) * 256 + ((colB) ^ (((row) & 7) << 4)))
#define SBAR() __builtin_amdgcn_sched_barrier(0)
__device__ __forceinline__ int v_st(int k, int c) { const int kk = (k & ~0xC) | ((k & 4) << 1) | ((k & 8) >> 1); return ((kk >> 3) * 4 + (c >> 5)) * 512 + ((kk & 7) * 32 + (c & 31)) * 2; }
__device__ __forceinline__ int v_rd_base(int lane) { return ((lane & 3) << 3) | (((lane >> 2) & 3) << 6) | (((lane >> 4) & 1) << 5) | (((lane >> 5) & 1) << 8); }
constexpr int v_rd_off(int d0, int ks, int half) { return d0 * 512 + ks * 4096 + half * 2048; }
__device__ __forceinline__ int crow(int r, int hi) { return (r & 3) + 8 * (r >> 2) + 4 * hi; }
__device__ __forceinline__ unsigned cvtpk(float lo, float hi) { unsigned r; asm volatile("v_cvt_pk_bf16_f32 %0, %1, %2" : "=v"(r) : "v"(lo), "v"(hi)); return r; }
__device__ __forceinline__ bf16x8 load8(const bf16* p) { return *reinterpret_cast<const bf16x8*>(p); }
__device__ __forceinline__ void mask_tile(f32x16& p0, f32x16& p1, int dq) {
    const float NEG = -__builtin_inff();
#pragma unroll
    for (int r = 0; r < 16; ++r) { const int c = (r & 3) + 8 * (r >> 2); if (dq - c < 0) p0[r] = NEG; if (dq - c - 32 < 0) p1[r] = NEG; }
}
__device__ __forceinline__ void mask_bits(f32x16& p0, f32x16& p1, unsigned w0, unsigned w1) {
#pragma unroll
    for (int r = 0; r < 16; ++r) { const unsigned c = (r & 3) + 8 * (r >> 2);
        const unsigned m0 = (unsigned)__builtin_amdgcn_sbfe((int)w0, c, 1), m1 = (unsigned)__builtin_amdgcn_sbfe((int)w1, c, 1);
        p0[r] = __uint_as_float((m0 & __float_as_uint(p0[r])) | (~m0 & 0xFF800000u)); p1[r] = __uint_as_float((m1 & __float_as_uint(p1[r])) | (~m1 & 0xFF800000u)); }
}
__device__ __forceinline__ void partialSM(f32x16& p0, f32x16& p1, float& m_reg, float& mn, float& alpha) {
    float pmax = p0[0]; for (int r = 1; r < 16; ++r) pmax = fmaxf(pmax, p0[r]); for (int r = 0; r < 16; ++r) pmax = fmaxf(pmax, p1[r]);
    { auto rr = __builtin_amdgcn_permlane32_swap(__float_as_uint(pmax), __float_as_uint(pmax), false, false);
      pmax = fmaxf(__uint_as_float(rr[0]), __uint_as_float(rr[1])); }
    constexpr float C2 = 1.4426950408889634f * SCALE;
    if (__builtin_expect(__all((pmax - m_reg) * SCALE <= THR), 1)) { mn = m_reg; alpha = 1.f; }
    else { mn = fmaxf(m_reg, pmax); alpha = __builtin_amdgcn_exp2f((m_reg - mn) * C2); m_reg = mn; }
    const float mnL = -mn * C2;
    for (int r = 0; r < 16; ++r) p0[r] = fmaf(p0[r], C2, mnL); for (int r = 0; r < 16; ++r) p1[r] = fmaf(p1[r], C2, mnL);
    for (int r = 0; r < 16; ++r) p0[r] = __builtin_amdgcn_exp2f(p0[r]);
}
__device__ __forceinline__ void finishSM(f32x16& p0, f32x16& p1, float alpha, float& l_reg, bf16x8& pa0, bf16x8& pa1, bf16x8& pa2, bf16x8& pa3) {
    for (int r = 0; r < 16; ++r) p1[r] = __builtin_amdgcn_exp2f(p1[r]);
    float ps = 0; for (int r = 0; r < 16; ++r) ps += p0[r]; for (int r = 0; r < 16; ++r) ps += p1[r];
    { auto rr = __builtin_amdgcn_permlane32_swap(__float_as_uint(ps), __float_as_uint(ps), false, false);
      ps = __uint_as_float(rr[0]) + __uint_as_float(rr[1]); }
    l_reg = l_reg * alpha + ps;
#define PK4(P, B_, OUT) do { unsigned a0 = cvtpk(P[B_+0], P[B_+1]), a1 = cvtpk(P[B_+2], P[B_+3]);                          \
        unsigned b0 = cvtpk(P[B_+4], P[B_+5]), b1 = cvtpk(P[B_+6], P[B_+7]);                                             \
        auto r0 = __builtin_amdgcn_permlane32_swap(a0, b0, false, false); auto r1 = __builtin_amdgcn_permlane32_swap(a1, b1, false, false); \
        u32x4 w = {r0[0], r1[0], r0[1], r1[1]}; OUT = *reinterpret_cast<bf16x8*>(&w); } while (0)
    PK4(p0, 0, pa0); PK4(p0, 8, pa1); PK4(p1, 0, pa2); PK4(p1, 8, pa3);
#undef PK4
}
template <int KB, bool BIAS>
__device__ __forceinline__ void qkt(f32x16& p0, f32x16& p1, const char* K_lds, int r32, int hi, const bf16x8* qr, const char* bl) {
    p0 = f32x16{}; p1 = f32x16{}; (void)bl;
    const char* kb[4];
#pragma unroll
    for (int dd = 0; dd < 4; ++dd) kb[dd] = K_lds + KB * SHM_K + KSWZ(r32, (dd * 16 + hi * 8) * 2);
#pragma unroll
    for (int d0 = 0; d0 < 8; ++d0) { const char* a = kb[d0 & 3] + (d0 >> 2) * 128;
        bf16x8 b0 = *reinterpret_cast<const bf16x8*>(a);
        bf16x8 b1 = *reinterpret_cast<const bf16x8*>(a + 32 * 256);
        p0 = __builtin_amdgcn_mfma_f32_32x32x16_bf16(b0, qr[d0], p0, 0, 0, 0);
        p1 = __builtin_amdgcn_mfma_f32_32x32x16_bf16(b1, qr[d0], p1, 0, 0, 0); }
}
template <int VB>
__device__ __forceinline__ void pv_tile(f32x16* o, int vb0, bf16x8 pa0, bf16x8 pa1, bf16x8 pa2, bf16x8 pa3) {
#define TRRD(dst, off) asm volatile("ds_read_b64_tr_b16 %0, %1 offset:%2" : "=&v"(dst) : "v"(vb0), "i"(off) : "memory")
#define PV_D0(d0) do { s16x4 l0, l1, l2, l3, h0, h1, h2, h3; constexpr int b_ = VB * SHM_V + v_rd_off(d0, 0, 0); \
        TRRD(l0, b_); TRRD(h0, b_ + 2048); TRRD(l1, b_ + 4096); TRRD(h1, b_ + 6144); TRRD(l2, b_ + 8192); TRRD(h2, b_ + 10240); TRRD(l3, b_ + 12288); TRRD(h3, b_ + 14336); \
        asm volatile("s_waitcnt lgkmcnt(0)" ::: "memory"); SBAR();   \
        o[d0] = __builtin_amdgcn_mfma_f32_32x32x16_bf16(pa0, (bf16x8){l0[0], l0[1], l0[2], l0[3], h0[0], h0[1], h0[2], h0[3]}, o[d0], 0, 0, 0);   \
        o[d0] = __builtin_amdgcn_mfma_f32_32x32x16_bf16(pa1, (bf16x8){l1[0], l1[1], l1[2], l1[3], h1[0], h1[1], h1[2], h1[3]}, o[d0], 0, 0, 0);   \
        o[d0] = __builtin_amdgcn_mfma_f32_32x32x16_bf16(pa2, (bf16x8){l2[0], l2[1], l2[2], l2[3], h2[0], h2[1], h2[2], h2[3]}, o[d0], 0, 0, 0);   \
        o[d0] = __builtin_amdgcn_mfma_f32_32x32x16_bf16(pa3, (bf16x8){l3[0], l3[1], l3[2], l3[3], h3[0], h3[1], h3[2], h3[3]}, o[d0], 0, 0, 0); } while (0)
    PV_D0(0); PV_D0(1); PV_D0(2); PV_D0(3);
#undef PV_D0
#undef TRRD
}
struct BlockRef { const bf16* Q; const bf16* K; const bf16* V; bf16* O; int P0; const float* fb; const unsigned long long* mrow; };
struct Seam { bf16x8 qr[8]; bf16x8 st_v0, st_v1, st_k0, st_k1; };
#define VMW() asm volatile("s_waitcnt vmcnt(0)" ::: "memory")
#define VMWN(n) asm volatile("s_waitcnt vmcnt(%0)" :: "i"(n) : "memory")
#define SLOAD_H(Kp, Vp, k0) do { const bf16* kt_ = (Kp) + (size_t)(k0) * KS; const bf16* vt_ = (Vp) + (size_t)(k0) * KS; S.st_v0 = load8(vt_ + koff); S.st_v1 = load8(vt_ + koff + 32 * KS); S.st_k0 = load8(kt_ + koff); S.st_k1 = load8(kt_ + koff + 32 * KS); } while (0)
#define SWRITE_HK(bf) do { *(bf16x8*)(K_lds + (bf) * SHM_K + kws) = S.st_k0; *(bf16x8*)(K_lds + (bf) * SHM_K + kws + 32 * 256) = S.st_k1; } while (0)
#define SWRITE_HV(bf) do { *(bf16x8*)(V_lds + (bf) * SHM_V + vst0) = S.st_v0; *(bf16x8*)(V_lds + (bf) * SHM_V + vst1) = S.st_v1; } while (0)
#define SWRITE_H(bf) do { SWRITE_HV(bf); SWRITE_HK(bf); } while (0)
template <bool BIAS, bool BITMASK, int QS, int KS, int OS>
__device__ __forceinline__ void attn_block(const BlockRef& cur, char* lds, LAS unsigned char* ldsl) {
    int tid_ = threadIdx.x; asm volatile("" : "+v"(tid_));
    const int tid = tid_, wid = __builtin_amdgcn_readfirstlane(tid >> 6), lane = tid & 63, r32 = lane & 31, hi = lane >> 5;
    const int NT = (cur.P0 + QB - 1) / KVBLK + 1;
    const int qlo = cur.P0 + wid * QBLK, qm = qlo + r32 - 4 * hi;
    char* V_lds = lds; char* K_lds = lds + 2 * SHM_V;
    float* ws = (float*)(lds + OFF_WS) + wid * 64; float* li_l = ws, * al_l = ws + 32;
    const LAS unsigned char* bl0 = ldsl + OFF_BIAS + hi * 16;
    float m_reg = -1e30f, l_reg = 0; f32x16 o[4] = {};
    const int sr = tid >> 4, sc = (tid & 15) * 8, vst0 = v_st(sr, sc), vst1 = v_st(32 + sr, sc), kws = KSWZ(sr, sc * 2);
    const int vb0 = (int)(uintptr_t)V_lds + v_rd_base(lane);
    const bf16* Kh = cur.K; const bf16* Vh = cur.V;
    const int moff = (wid * QBLK + r32) * 64, koff = sr * KS + sc, qoff = (wid * QBLK + r32) * QS + hi * 8;
    Seam S;
#pragma unroll
    for (int d0 = 0; d0 < 8; ++d0) S.qr[d0] = load8(cur.Q + qoff + d0 * 16);
    if constexpr (BIAS) { const f32x4 b0_ = *(const f32x4*)(cur.fb + tid * 8), b1_ = *(const f32x4*)(cur.fb + tid * 8 + 4);
        *(LAS f32x4*)(ldsl + OFF_BIAS + tid * 32) = b0_; *(LAS f32x4*)(ldsl + OFF_BIAS + tid * 32 + 16) = b1_; }
    SLOAD_H(Kh, Vh, 0); VMW(); SWRITE_HK(0); SWRITE_HV(0); SBAR();
#define RESC(a) do { if (__any((a) < 1.f)) { if (hi == 0) al_l[r32] = (a); asm volatile("s_waitcnt lgkmcnt(0)" ::: "memory");              \
                     for (int d_ = 0; d_ < 4; ++d_) for (int r = 0; r < 16; ++r) o[d_][r] *= al_l[crow(r, hi)]; } } while (0)
#define KBASE(t) ((t) * KVBLK)
#define MLOAD(MW, t) do { if constexpr (BITMASK) MW = (cur.mrow + (t))[moff]; } while (0)
#define MASKT(P0_, P1_, MW, t) do { if constexpr (BIAS) { const LAS unsigned char* bl_ = bl0 + KBASE(t) * 4; _Pragma("unroll") for (int g = 0; g < 4; ++g) { const f32x4 a_ = *(const LAS f32x4*)(bl_ + g * 32), b_ = *(const LAS f32x4*)(bl_ + 128 + g * 32); \
            P0_[4 * g] += a_[0]; P0_[4 * g + 1] += a_[1]; P0_[4 * g + 2] += a_[2]; P0_[4 * g + 3] += a_[3]; P1_[4 * g] += b_[0]; P1_[4 * g + 1] += b_[1]; P1_[4 * g + 2] += b_[2]; P1_[4 * g + 3] += b_[3]; } } \
        if constexpr (BITMASK) { mask_bits(P0_, P1_, (unsigned)(MW) >> (4 * hi), (unsigned)((MW) >> 32) >> (4 * hi)); } \
        else { const int kb_ = KBASE(t); if (kb_ + KVBLK - 1 > qlo) mask_tile(P0_, P1_, qm - kb_); } } while (0)
    f32x16 pA0, pA1, pB0, pB1; float mnA, mnB, alA, alB; bf16x8 pa0, pa1, pa2, pa3; unsigned long long mwA = 0, mwB = 0;
    MLOAD(mwA, 0);
    SLOAD_H(Kh, Vh, KBASE(1)); MLOAD(mwB, 1);
    __syncthreads();
    SBAR(); qkt<0, BIAS>(pA0, pA1, K_lds, r32, hi, S.qr, nullptr);
    MASKT(pA0, pA1, mwA, 0); partialSM(pA0, pA1, m_reg, mnA, alA);
    VMW(); SWRITE_H(1);
    __syncthreads();
#define HALF_STEP(PX0, PX1, mnX, alX, MWX, PY0, PY1, alY, MWY, t, KB, VB, SB) do {                                            \
        SBAR(); qkt<KB, BIAS>(PX0, PX1, K_lds, r32, hi, S.qr, nullptr);                                                       \
        finishSM(PY0, PY1, alY, l_reg, pa0, pa1, pa2, pa3); SBAR();                                                           \
        if ((t) + 1 < NT) { SLOAD_H(Kh, Vh, KBASE((t) + 1)); MLOAD(MWY, (t) + 1); SBAR(); }                                   \
        pv_tile<VB>(o, vb0, pa0, pa1, pa2, pa3); MASKT(PX0, PX1, MWX, (t)); partialSM(PX0, PX1, m_reg, mnX, alX);             \
        __syncthreads();                                                                                                      \
        if ((t) + 1 < NT) { VMW(); SWRITE_H(SB); }                                                                            \
        RESC(alX); __syncthreads(); } while (0)
    for (int t = 1; t + 1 < NT; t += 2) {
        HALF_STEP(pB0, pB1, mnB, alB, mwB, pA0, pA1, alA, mwA, t, 1, 0, 0);
        HALF_STEP(pA0, pA1, mnA, alA, mwA, pB0, pB1, alB, mwB, t + 1, 0, 1, 1);
    }
    SBAR(); qkt<1, BIAS>(pB0, pB1, K_lds, r32, hi, S.qr, nullptr); SBAR();
    finishSM(pA0, pA1, alA, l_reg, pa0, pa1, pa2, pa3); SBAR();
    pv_tile<0>(o, vb0, pa0, pa1, pa2, pa3);
    MASKT(pB0, pB1, mwB, NT - 1); partialSM(pB0, pB1, m_reg, mnB, alB); __syncthreads(); RESC(alB);
    finishSM(pB0, pB1, alB, l_reg, pa0, pa1, pa2, pa3); SBAR(); pv_tile<1>(o, vb0, pa0, pa1, pa2, pa3);
    SBAR();
    if (hi == 0) li_l[r32] = l_reg; asm volatile("s_waitcnt lgkmcnt(0)" ::: "memory");
    float rli[16];
#pragma unroll
    for (int r = 0; r < 16; ++r) rli[r] = __builtin_amdgcn_rcpf(li_l[crow(r, hi)]);
    int tid2_ = threadIdx.x; asm volatile("" : "+v"(tid2_));
    const int r32e = tid2_ & 31, hie = (tid2_ >> 5) & 1, ooff = (wid * QBLK + 4 * hie) * OS + r32e;
#pragma unroll
    for (int r = 0; r < 16; ++r) {
#pragma unroll
        for (int d0 = 0; d0 < 4; ++d0) { const float v = o[d0][r] * rli[r]; const float vn = __shfl_xor(v, 1);
            if ((r32e & 1) == 0) *(unsigned*)(cur.O + ((r & 3) + 8 * (r >> 2)) * OS + d0 * 32 + ooff) = cvtpk(v, vn); } }
    __syncthreads();
#undef RESC
#undef KBASE
#undef MLOAD
#undef MASKT
#undef HALF_STEP
}
#undef ROWK
#undef VMW
#undef VMWN
#undef SLOAD_H
#undef SWRITE_HK
#undef SWRITE_HV
#undef SWRITE_H
#undef KSWZ
#undef SBAR
template <bool BIAS, bool BITMASK, int NH, int GROUP, bool PAIR, int QS, int KS, int OS>
__device__ __forceinline__ void attn_phase(char* lds, LAS unsigned char* ldsl, const bf16* Q, const bf16* K, const bf16* V, bf16* O, const float* fbias, const unsigned long long* mask, int G, int bid) {
    constexpr int NBLK = BATCH * NH * 16, NITEM = PAIR ? NBLK / 2 : NBLK, PER = PAIR ? 8 : 16, SETH = BATCH * NH / 8;
    for (int L = bid; L < NITEM; L += G) {
#pragma unroll 1
        for (int pass = 0; pass < (PAIR ? 2 : 1); ++pass) {
            const int g = L & 7, k = L >> 3, hs = k / PER, x = k % PER; const int bh = g * SETH + hs, b = bh / NH, h = bh % NH;
            const int qb = PAIR ? (pass ? 15 - x : x) : 15 - x; BlockRef r; const size_t row0 = (size_t)b * SEQ + (size_t)qb * QB;
            r.Q = Q + row0 * QS + h * D; r.O = O + row0 * OS + h * D; r.K = K + (size_t)b * SEQ * KS + (h / GROUP) * D; r.V = V + (size_t)b * SEQ * KS + (h / GROUP) * D; r.P0 = qb * QB;
            r.fb = BIAS ? fbias + (size_t)bh * SEQ : nullptr; r.mrow = BITMASK ? mask + row0 * 64 : nullptr;
            attn_block<BIAS, BITMASK, QS, KS, OS>(r, lds, ldsl);
        }
    }
}
}
__device__ __forceinline__ float fast_silu(float g) { return g * __builtin_amdgcn_rcpf(1.0f + __expf(-g)); }
__device__ __forceinline__ void ph_gla_a(Frame& F, const Args& a) {
    const float* SK0 = (const float*)(F.ws + WS_SK0); const float* w2 = a.in[2]; const float* gbias = a.in[3]; float* GB = (float*)(F.ws + WS_GB); float* DEC = (float*)(F.ws + WS_DEC);
    const bf16* PROJ = (const bf16*)(F.ws + WS_PROJ); bf16* CST = (bf16*)(F.ws + WS_CST);
    LAS float* BSH = (LAS float*)F.lds; LAS float* TOT = BSH + 64 * 128; LAS bf16* VT = (LAS bf16*)(F.lds + 36864); LAS bf16* KET = (LAS bf16*)(F.lds + 73728);
    const int tid = F.tid, lane = F.lane, l15 = lane & 15, quad = lane >> 4, w = F.wave;
    for (int unit = blockIdx.x; unit < 512; unit += F.G) {
        const int n = unit & 63, bh = unit >> 6, b = bh >> 2, h = bh & 3, t0 = b * SEQ + n * 64;
        __syncthreads();
        {
            const int d = tid & 127, cg = tid >> 7; float wv[16];
#pragma unroll
            for (int r = 0; r < 16; ++r) wv[r] = w2[r * 512 + h * 128 + d];
            const float gb = gbias[h * 128 + d]; float run = 0.f;
            for (int cc = 0; cc < 16; ++cc) { const int c = cg * 16 + cc; const float* sk = SK0 + (size_t)(t0 + c) * 24; float z = gb;
#pragma unroll
                for (int r = 0; r < 16; ++r) z += sk[r] * wv[r];
                run += logsigmoidf(z) * (1.0f / 16.0f); BSH[c * 128 + d] = run; }
            TOT[cg * 128 + d] = run;
            __syncthreads();
            float pre = 0.f;
            for (int g = 0; g < cg; ++g) pre += TOT[g * 128 + d];
            for (int cc = 0; cc < 16; ++cc) { const int c = cg * 16 + cc; const float v = BSH[c * 128 + d] + pre; BSH[c * 128 + d] = v; GB[(size_t)(t0 + c) * 512 + h * 128 + d] = v; }
        }
        __syncthreads();
        {
            const int c = tid & 63, g8 = tid >> 6; const size_t t = (size_t)(t0 + c);
            const bf16* kp = PROJ + t * NP0 + 512 + h * 128 + g8 * 16;
            const v4u k0 = *(const v4u*)kp, k1 = *(const v4u*)(kp + 8);
            const unsigned kw[8] = {k0.x, k0.y, k0.z, k0.w, k1.x, k1.y, k1.z, k1.w};
#pragma unroll
            for (int i = 0; i < 8; ++i) { const int d = g8 * 16 + 2 * i; const float e0 = __expf(BSH[63 * 128 + d] - BSH[c * 128 + d]), e1 = __expf(BSH[63 * 128 + d + 1] - BSH[c * 128 + d + 1]);
                KET[d * 72 + c] = (bf16)f2bf(bf2f(kw[i] & 0xffff) * e0); KET[(d + 1) * 72 + c] = (bf16)f2bf(bf2f(kw[i] >> 16) * e1); }
            const bf16* vp = PROJ + t * NP0 + 1024 + h * 256 + g8 * 32;
#pragma unroll
            for (int q = 0; q < 4; ++q) { const v4u vv = *(const v4u*)(vp + 8 * q); const unsigned vw[4] = {vv.x, vv.y, vv.z, vv.w};
#pragma unroll
                for (int i = 0; i < 4; ++i) { const int v = g8 * 32 + q * 8 + 2 * i; VT[v * 72 + c] = (bf16)(vw[i] & 0xffff); VT[(v + 1) * 72 + c] = (bf16)(vw[i] >> 16); } }
            if (tid < 128) DEC[unit * 128 + tid] = __expf(BSH[63 * 128 + tid]);
        }
        __syncthreads();
        {
            pg8::f32x4 acc[2][8];
#pragma unroll
            for (int i = 0; i < 2; ++i)
#pragma unroll
                for (int nn = 0; nn < 8; ++nn) acc[i][nn] = (pg8::f32x4){0.f, 0.f, 0.f, 0.f};
#pragma unroll
            for (int kk = 0; kk < 64; kk += 32) {
                const bf16x8 a0 = *(const LAS bf16x8*)(VT + (32 * w + l15) * 72 + kk + quad * 8), a1 = *(const LAS bf16x8*)(VT + (32 * w + 16 + l15) * 72 + kk + quad * 8);
#pragma unroll
                for (int nn = 0; nn < 8; ++nn) { const bf16x8 bb = *(const LAS bf16x8*)(KET + (16 * nn + l15) * 72 + kk + quad * 8);
                    acc[0][nn] = __builtin_amdgcn_mfma_f32_16x16x32_bf16(bb, a0, acc[0][nn], 0, 0, 0); acc[1][nn] = __builtin_amdgcn_mfma_f32_16x16x32_bf16(bb, a1, acc[1][nn], 0, 0, 0); } }
            bf16* cp = CST + (size_t)unit * 32768;
#pragma unroll
            for (int i = 0; i < 2; ++i)
#pragma unroll
                for (int nn = 0; nn < 8; ++nn) { uint2 o; o.x = pk2(acc[i][nn][0], acc[i][nn][1]); o.y = pk2(acc[i][nn][2], acc[i][nn][3]);
                    *(uint2*)(cp + (32 * w + 16 * i + l15) * 128 + 16 * nn + quad * 4) = o; }
        }
    }
    __syncthreads();
}
__device__ __forceinline__ void ph_gla_c(Frame& F, const Args& a) {
    const bf16* PROJ = (const bf16*)(F.ws + WS_PROJ); const float* GB = (const float*)(F.ws + WS_GB); const bf16* PREVT = (const bf16*)(F.ws + WS_PREVT); const float* normg = a.in[4]; bf16* OMIX = (bf16*)(F.ws + WS_OMIX);
    LAS bf16* QD = (LAS bf16*)(F.lds + 32768); LAS bf16* KI = (LAS bf16*)(F.lds + 50176); LAS bf16* P = (LAS bf16*)(F.lds + 67584); LAS bf16* VT = (LAS bf16*)(F.lds + 76800); LAS float* RED = (LAS float*)(F.lds + 113664);
    const int tid = F.tid, lane = F.lane, l15 = lane & 15, quad = lane >> 4, w = F.wave;
    for (int unit = blockIdx.x; unit < 512; unit += F.G) {
        const int n = unit & 63, bh = unit >> 6, b = bh >> 2, h = bh & 3, t0 = b * SEQ + n * 64;
        __syncthreads();
        {
            const int c = tid >> 3, dg = tid & 7; const size_t t = (size_t)(t0 + c);
            const float* bp = GB + t * 512 + h * 128 + dg * 16; const bf16* qp = PROJ + t * NP0 + h * 128 + dg * 16; const bf16* kp = PROJ + t * NP0 + 512 + h * 128 + dg * 16;
#pragma unroll
            for (int q8 = 0; q8 < 2; ++q8) { const v4u qq = *(const v4u*)(qp + 8 * q8), kk = *(const v4u*)(kp + 8 * q8); const f32x4 b0 = *(const f32x4*)(bp + 8 * q8), b1 = *(const f32x4*)(bp + 8 * q8 + 4);
                const unsigned qw[4] = {qq.x, qq.y, qq.z, qq.w}, kw[4] = {kk.x, kk.y, kk.z, kk.w}; const float bv[8] = {b0[0], b0[1], b0[2], b0[3], b1[0], b1[1], b1[2], b1[3]};
                v4u oq, ok; unsigned* oqp = (unsigned*)&oq; unsigned* okp = (unsigned*)&ok;
#pragma unroll
                for (int i = 0; i < 4; ++i) { const float e0 = __expf(bv[2 * i]), e1 = __expf(bv[2 * i + 1]);
                    oqp[i] = pk2(bf2f(qw[i] & 0xffff) * ATT_SCALE * e0, bf2f(qw[i] >> 16) * ATT_SCALE * e1);
                    okp[i] = pk2(bf2f(kw[i] & 0xffff) * __builtin_amdgcn_rcpf(e0), bf2f(kw[i] >> 16) * __builtin_amdgcn_rcpf(e1)); }
                *(LAS v4u*)(QD + c * 136 + dg * 16 + 8 * q8) = oq; *(LAS v4u*)(KI + c * 136 + dg * 16 + 8 * q8) = ok; }
            const int c2 = tid & 63, g8 = tid >> 6; const bf16* vp = PROJ + (size_t)(t0 + c2) * NP0 + 1024 + h * 256 + g8 * 32;
#pragma unroll
            for (int q = 0; q < 4; ++q) { const v4u vv = *(const v4u*)(vp + 8 * q); const unsigned vw[4] = {vv.x, vv.y, vv.z, vv.w};
#pragma unroll
                for (int i = 0; i < 4; ++i) { const int v = g8 * 32 + q * 8 + 2 * i; VT[v * 72 + c2] = (bf16)(vw[i] & 0xffff); VT[(v + 1) * 72 + c2] = (bf16)(vw[i] >> 16); } }
        }
        __syncthreads();
        {
            const int ti = w >> 1;
#pragma unroll
            for (int s = 0; s < 2; ++s) { const int tj = 2 * (w & 1) + s; pg8::f32x4 acc = (pg8::f32x4){0.f, 0.f, 0.f, 0.f};
                if (tj <= ti) {
#pragma unroll
                    for (int kk = 0; kk < 128; kk += 32) { const bf16x8 aa = *(const LAS bf16x8*)(QD + (16 * ti + l15) * 136 + kk + quad * 8), bb = *(const LAS bf16x8*)(KI + (16 * tj + l15) * 136 + kk + quad * 8);
                        acc = __builtin_amdgcn_mfma_f32_16x16x32_bf16(aa, bb, acc, 0, 0, 0); } }
#pragma unroll
                for (int j = 0; j < 4; ++j) { const int i = 16 * ti + quad * 4 + j, jj = 16 * tj + l15; P[i * 72 + jj] = (bf16)f2bf(jj <= i ? acc[j] : 0.f); } }
        }
        __syncthreads();
        {
            const int ti = w >> 1, half = w & 1; pg8::f32x4 acc[8];
#pragma unroll
            for (int nn = 0; nn < 8; ++nn) acc[nn] = (pg8::f32x4){0.f, 0.f, 0.f, 0.f};
#pragma unroll
            for (int kk = 0; kk < 64; kk += 32) { const bf16x8 aa = *(const LAS bf16x8*)(P + (16 * ti + l15) * 72 + kk + quad * 8);
#pragma unroll
                for (int nn = 0; nn < 8; ++nn) { const bf16x8 bb = *(const LAS bf16x8*)(VT + (128 * half + 16 * nn + l15) * 72 + kk + quad * 8); acc[nn] = __builtin_amdgcn_mfma_f32_16x16x32_bf16(bb, aa, acc[nn], 0, 0, 0); } }
            const bf16* pv = PREVT + (size_t)unit * 32768 + (size_t)(128 * half + l15) * 128 + quad * 8;
#pragma unroll
            for (int kk = 0; kk < 128; kk += 32) { const bf16x8 aa = *(const LAS bf16x8*)(QD + (16 * ti + l15) * 136 + kk + quad * 8);
#pragma unroll
                for (int nn = 0; nn < 8; ++nn) { const bf16x8 bb = *(const bf16x8*)(pv + (size_t)(16 * nn) * 128 + kk); acc[nn] = __builtin_amdgcn_mfma_f32_16x16x32_bf16(bb, aa, acc[nn], 0, 0, 0); } }
            float s = 0.f;
#pragma unroll
            for (int nn = 0; nn < 8; ++nn) s += (acc[nn][0] * acc[nn][0] + acc[nn][1] * acc[nn][1]) + (acc[nn][2] * acc[nn][2] + acc[nn][3] * acc[nn][3]);
            s += __shfl_xor(s, 16); s += __shfl_xor(s, 32);
            if (quad == 0) RED[(16 * ti + l15) * 2 + half] = s;
            __syncthreads();
            const int i = 16 * ti + l15; const float ms = (RED[i * 2] + RED[i * 2 + 1]) * (1.0f / 256.0f); const float rs = 1.0f / sqrtf(ms + LN_EPS);
            const size_t t = (size_t)(t0 + i);
#pragma unroll
            for (int nn = 0; nn < 8; ++nn) { const int v = 128 * half + 16 * nn + quad * 4; const uint2 gr = *(const uint2*)(PROJ + t * NP0 + 2048 + h * 256 + v); const f32x4 ng = *(const f32x4*)(normg + v);
                uint2 o; o.x = pg8::cvt_pk_bf16(acc[nn][0] * rs * ng[0] * fast_silu(bf2f(gr.x & 0xffff)), acc[nn][1] * rs * ng[1] * fast_silu(bf2f(gr.x >> 16)));
                o.y = pg8::cvt_pk_bf16(acc[nn][2] * rs * ng[2] * fast_silu(bf2f(gr.y & 0xffff)), acc[nn][3] * rs * ng[3] * fast_silu(bf2f(gr.y >> 16)));
                *(uint2*)(OMIX + t * DM + h * 256 + v) = o; }
        }
    }
    __syncthreads();
}
__device__ __forceinline__ void ph_indexer(Frame& F, unsigned char* lds_generic) {
    typedef float f32x16 __attribute__((ext_vector_type(16)));
    const bf16* PROJ1 = (const bf16*)(F.ws + WS_PROJ); const bf16* IK = (const bf16*)(F.ws + WS_IK); const float* IW = (const float*)(F.ws + WS_IW); unsigned long long* MASK = (unsigned long long*)(F.ws + WS_MASK);
    LAS float* SCL = (LAS float*)F.lds;
    const int lane = F.lane, w = F.wave, c32 = lane & 31, hi = lane >> 5, rt = w & 3, kpar = w >> 2;
    for (int it = blockIdx.x; it < 512; it += F.G) {
#pragma unroll 1
        for (int pass = 0; pass < 2; ++pass) {
            const int unit = pass ? 1023 - it : it, m0 = unit * 8, b = m0 >> 12, qmax = (m0 & 4095) + 7;
            __syncthreads();
            {
                const int qa = m0 + 2 * rt + ((c32 >> 2) & 1), ha = (c32 & 3) + 4 * (c32 >> 3);
                const bf16* ap = PROJ1 + (size_t)qa * NP1 + 3072 + ha * 64 + 8 * hi;
                bf16x8 af[4];
#pragma unroll
                for (int ks = 0; ks < 4; ++ks) af[ks] = *(const bf16x8*)(ap + 16 * ks);
                const float* wp = IW + (size_t)(m0 + 2 * rt + hi) * 16; float wv[16];
#pragma unroll
                for (int q4 = 0; q4 < 4; ++q4) { const f32x4 t4 = *(const f32x4*)(wp + 4 * q4); wv[4 * q4] = t4[0]; wv[4 * q4 + 1] = t4[1]; wv[4 * q4 + 2] = t4[2]; wv[4 * q4 + 3] = t4[3]; }
                LAS float* srow = SCL + (2 * rt + hi) * 4096 + c32;
                const bf16* kbase = IK + (size_t)b * SEQ * 64 + (size_t)lane * 8;
                bf16x8 bn[4];
#pragma unroll
                for (int ks = 0; ks < 4; ++ks) bn[ks] = *(const bf16x8*)(kbase + (size_t)(kpar * 4 + ks) * 512);
                for (int t = kpar; t * 32 <= qmax; t += 2) {
                    bf16x8 bc[4];
#pragma unroll
                    for (int ks = 0; ks < 4; ++ks) bc[ks] = bn[ks];
                    const int tn = (t + 2) * 32 <= qmax ? t + 2 : t;
#pragma unroll
                    for (int ks = 0; ks < 4; ++ks) bn[ks] = *(const bf16x8*)(kbase + (size_t)(tn * 4 + ks) * 512);
                    f32x16 acc = {};
#pragma unroll
                    for (int ks = 0; ks < 4; ++ks) acc = __builtin_amdgcn_mfma_f32_32x32x16_bf16(af[ks], bc[ks], acc, 0, 0, 0);
                    float s = 0.f;
#pragma unroll
                    for (int r = 0; r < 16; ++r) s += wv[r] * fmaxf(acc[r], 0.f);
                    srow[t * 32] = s; }
            }
            __syncthreads();
            { const int m = m0 + w; topk_mask_row((const LAS float*)(F.lds + w * 16384), m & 4095, MASK + (size_t)m * 64, lane, (LAS unsigned*)(F.lds + LDSCTL_OFF + 4096 + w * 1024)); }
        }
    }
    __syncthreads();
}
#define IN(k) (lo <= (k) && (k) < hi)
#define SEAM(k) do { if (hi > (k) + 1) xcd_barrier(bar); } while (0)
template <int LAYER, int BASE>
__device__ __forceinline__ void common_phases(Frame& F, const Args& args, const int lo, const int hi, const XcdBarrier& bar) {
    unsigned char* ws = args.ws;
    if (IN(BASE + 0)) {
        pg8::Gemm g{(const bf16*)(ws + WS_OMIX), (const bf16*)(ws + (LAYER ? WS_WOC : WS_WOA)), MTOK, DM, DM, DM, DM}; pg8::StaticOrder S; S.init(MTOK, DM, F.G, (int)blockIdx.x);
        pg8::EpiResid E{(const bf16*)(ws + WS_XB), (bf16*)(ws + WS_YB), DN_ALPHA};
        pg8::gemm_phase<pg8::EpiResid, pg8::StaticOrder, true, true>(F.lds, g, S, E);
        SEAM(BASE + 0);
    }
    if (IN(BASE + 1)) { p_ln_route(F, args, LAYER); SEAM(BASE + 1); }
    if (IN(BASE + 3) || IN(BASE + 4) || IN(BASE + 5)) {
        if (F.wave == 0) { int ti; (void)moe_offsets(F.ctl + CW_CNT + LAYER * 64, F.lane, &ti); if (F.lane < 32) { F.MISC[64 + F.lane] = (unsigned)ti; F.MISC[160 + F.lane] = F.ctl[CW_CNT + LAYER * 64 + F.lane]; } if (F.lane == 31) F.MISC[96] = (unsigned)ti; }
        __syncthreads();
    }
    {
        const int Tm = (int)F.MISC[96], T1 = F.G / 4 < Tm ? F.G / 4 : Tm;
        const int n2 = (Tm - T1) * 4;
        const pg8::Gemm gU{(const bf16*)(ws + WS_XB), (const bf16*)(ws + WS_WGU) + (size_t)LAYER * 32 * 1024 * 2048, RPAD, 32 * 1024, DM, DM, DM};
        const pg8::Gemm gD{(const bf16*)(ws + WS_OMIX), (const bf16*)(ws + WS_WD) + (size_t)LAYER * 32 * 2048 * 512, RPAD, 32 * 2048, 512, 512, 512};
        const PG8_LAS int* tend = (const LAS int*)(F.lds + LDSCTL_OFF + 64 * 4); const PG8_LAS int* ecnt = (const LAS int*)(F.lds + LDSCTL_OFF + 160 * 4);
        const int* inv = (const int*)(ws + WS_INV);
        const pg8::EpiGLU EU{(bf16*)(ws + WS_OMIX), (const float*)(ws + WS_WINV)}; const pg8::EpiBf16Plain ED{(bf16*)(ws + WS_CST), DM, 7};
        if (IN(BASE + 3)) {
            pg8::MoeOrder S{F.G, (int)blockIdx.x, 4, 0, T1 * 4, (T1 * 4 == F.G && (F.G & 7) == 0) ? 2 : 0, tend, ecnt};
            pg8::gemm_phase_g<pg8::EpiGLU, pg8::MoeOrder>(F.lds, gU, S, EU, inv);
            SEAM(BASE + 3);
        }
        if (IN(BASE + 4)) {
            const int nt2 = Tm - T1, h0 = (nt2 + 1) >> 1, h1 = nt2 - h0, bx = (int)blockIdx.x, xc = bx & 7, sx = bx >> 3, hf = xc >> 2;
            const bool xok = (F.G & 7) == 0 && 8 * h0 <= F.G;
            const bool isU = xok ? sx < (hf ? h1 : h0) : bx < n2;
            const int cd = xok ? (bx >= 8 * h0 ? bx - 8 * h0 : (F.G - 8 * h0) + (xc - 4)) : bx - n2;
            if (isU) { const int L = xok ? T1 * 4 + ((hf ? h0 : 0) + sx) * 4 + (xc & 3) : T1 * 4 + bx;
                pg8::MoeOrder S{1 << 28, 0, 4, L, Tm * 4, 0, tend, ecnt}; pg8::gemm_phase_g<pg8::EpiGLU, pg8::MoeOrder>(F.lds, gU, S, EU, inv); }
            else { pg8::MoeOrder S{F.G - n2, cd, 8, 0, T1 * 8, 0, tend, ecnt}; pg8::gemm_phase<pg8::EpiBf16Plain, pg8::MoeOrder, true, true>(F.lds, gD, S, ED); }
            if (LAYER == 0) late_conv_items<16>(F, args, CONV_SPLIT, CONV_LATE_ITEMS, 1);
            SEAM(BASE + 4);
        }
        if (IN(BASE + 5)) {
            pg8::MoeOrder S{F.G, (int)blockIdx.x, 8, T1 * 8, Tm * 8, 0, tend, ecnt};
            pg8::gemm_phase<pg8::EpiBf16Plain, pg8::MoeOrder, true, true>(F.lds, gD, S, ED);
            if (LAYER == 0) late_conv_items<16>(F, args, CONV_SPLIT, CONV_LATE_ITEMS, 1);
            SEAM(BASE + 5);
        }
    }
    if (IN(BASE + 6)) { p_ln_ffn(F, args, LAYER); SEAM(BASE + 6); }
}
__global__ void __launch_bounds__(NWAVES * 64, 2) mk_fwd(Args args) {
    extern __shared__ __attribute__((aligned(16))) unsigned char lds[];
    Frame F;
    F.lds = (LAS unsigned char*)lds; F.MISC = (volatile LAS unsigned*)(F.lds + LDSCTL_OFF);
    F.tid = threadIdx.x; F.lane = F.tid & 63; F.wave = __builtin_amdgcn_readfirstlane(F.tid >> 6);
    F.G = gridDim.x; F.gw = blockIdx.x * NWAVES + F.wave; F.NGW = F.G * NWAVES;
    F.ws = args.ws; F.ctl = (unsigned*)(args.ws + WS_CTL);
    for (int u = F.tid; u < (LDS_BYTES - LDSCTL_OFF) / 4; u += NWAVES * 64) ((LAS unsigned*)(F.lds + LDSCTL_OFF))[u] = 0u;
    __syncthreads();
    const int lo = args.ph_lo, hi = args.ph_hi;
    XcdBarrier bar; bar.bar = F.ctl + CW_BAR + args.bar_region * XCD_BAR_WORDS; bar.x = 0; bar.st = nullptr;
    if (hi - lo > 1) bar = xcd_barrier_post(F.ctl + CW_BAR + args.bar_region * XCD_BAR_WORDS, F.MISC);
    unsigned char* ws = args.ws;

    if (IN(0)) { p0_prologue(F, args); SEAM(0); }
    if (IN(1)) {
        pg8::Gemm g{(const bf16*)(ws + WS_XB), (const bf16*)(ws + WS_WINA), MTOK, NP0, DM, DM, DM}; pg8::StaticOrder S; S.init(MTOK, NP0, F.G, (int)blockIdx.x);
        pg8::EpiBf16Plain E{(bf16*)(ws + WS_PROJ), NP0, 0x7fffffff};
        pg8::gemm_phase<pg8::EpiBf16Plain, pg8::StaticOrder, true, true>(F.lds, g, S, E);
        p_skinny0(F, args);
        SEAM(1);
    }
    if (IN(2)) { p_fox_bias(F, args); ph_gla_a(F, args); SEAM(2); }
    if (IN(4)) { ph_gla_scan(F); __syncthreads();
        attn::attn_phase<true, false, 8, 1, false, NP0, NP0, DM>((char*)lds, F.lds, (const bf16*)(ws + WS_PROJ) + 3072, (const bf16*)(ws + WS_PROJ) + 4096, (const bf16*)(ws + WS_PROJ) + 5120,
                                                               (bf16*)(ws + WS_OMIX) + 1024, (const float*)(ws + WS_FBIAS), (const unsigned long long*)nullptr, F.G, (int)blockIdx.x);
        late_conv_items<64>(F, args, 0, CONV_BIG, 0); late_conv_items<16>(F, args, CONV_BIG, CONV_SPLIT, 2);
        SEAM(4); }
    if (IN(5)) { ph_gla_c(F, args); SEAM(5); }
    common_phases<0, 6>(F, args, lo, hi, bar);
    if (IN(13)) {
        pg8::Gemm g{(const bf16*)(ws + WS_XB), (const bf16*)(ws + WS_WINC), MTOK, NP1, DM, DM, DM}; pg8::StaticOrder S; S.init(MTOK, NP1, F.G, (int)blockIdx.x);
        const float* c128 = (const float*)(ws + WS_ROPE);
        pg8::EpiRope E{(bf16*)(ws + WS_PROJ), c128, c128 + 4096 * 64, c128 + 2 * 4096 * 64, c128 + 2 * 4096 * 64 + 4096 * 32};
        pg8::gemm_phase<pg8::EpiRope, pg8::StaticOrder, true, true>(F.lds, g, S, E);
        SEAM(13);
    }
    if (IN(14)) { ph_indexer(F, lds); SEAM(14); }
    if (IN(16)) {
        attn::attn_phase<false, true, 16, 4, true, NP1, NP1, DM>((char*)lds, F.lds, (const bf16*)(ws + WS_PROJ), (const bf16*)(ws + WS_PROJ) + 2048, (const bf16*)(ws + WS_PROJ) + 2560,
                                                               (bf16*)(ws + WS_OMIX), (const float*)nullptr, (const unsigned long long*)(ws + WS_MASK), F.G, (int)blockIdx.x);
        SEAM(16); }
    common_phases<1, 17>(F, args, lo, hi, bar);
#ifdef PROBE_CONV
    if (IN(31)) {
        LAS bf16* T = (LAS bf16*)(F.lds + F.wave * 16384); bf16* dstb = (bf16*)(ws + WS_SC); float sink = 0.f;
        for (int it = F.gw; it < 32 * 256; it += F.NGW) {
            const int ex = 32 + it / 256, r = it % 256, kb = r / 8, nb = r % 8;
            TrItem t{args.in[17] + (size_t)ex * 2048 * 512, dstb + (size_t)(it / 256) * 512 * 2048, 512, nb * 64, nb * 64 + 32, 2048, nb * 64, kb * 64};
            f32x4 r16[16]; tr64_load(t, r16, F.lane);
            if (PROBE_CONV == 0) tr64_store(t, r16, T, F.lane);
            else if (PROBE_CONV == 1) {
#pragma unroll
                for (int i = 0; i < 8; ++i) { uint2 o; o.x = pg8::cvt_pk_bf16(r16[2 * i][0], r16[2 * i][1]); o.y = pg8::cvt_pk_bf16(r16[2 * i][2], r16[2 * i][3]); uint2 p; p.x = pg8::cvt_pk_bf16(r16[2 * i + 1][0], r16[2 * i + 1][1]); p.y = pg8::cvt_pk_bf16(r16[2 * i + 1][2], r16[2 * i + 1][3]);
                    bf16* d = dstb + (size_t)(it / 256) * 512 * 2048 + (size_t)(kb * 64 + 8 * i + 2 * (F.lane >> 4)) * 512 + nb * 64 + 4 * (F.lane & 15); *(uint2*)d = o; *(uint2*)(d + 512) = p; } }
            else {
#pragma unroll
                for (int i = 0; i < 16; ++i) sink += r16[i][0] + r16[i][3]; }
        }
        if (PROBE_CONV == 2 && sink == 12345.678f) dstb[F.tid] = 1;
    }
#endif
#ifdef PROBE_GEMM_K
    if (IN(30)) {
        pg8::Gemm g{(const bf16*)(ws + WS_XB), (const bf16*)(ws + WS_WINA), MTOK, NP0, PROBE_GEMM_K, PROBE_GEMM_LD, PROBE_GEMM_LD}; pg8::StaticOrder S; S.init(MTOK, NP0, F.G, (int)blockIdx.x);
        pg8::EpiBf16Plain E{(bf16*)(ws + WS_SC), NP0, 0x7fffffff};
        pg8::gemm_phase<pg8::EpiBf16Plain, pg8::StaticOrder, true, true>(F.lds, g, S, E);
    }
#endif
}
#undef IN
#undef SEAM
constexpr int N_PHASE_IDS = 24;
static void launch_mk(const Args& base, int lo, int hi, int grid, hipStream_t stream, int region = 0) {
    Args a = base; a.ph_lo = lo; a.ph_hi = hi; a.bar_region = region; a.pad = 0;
    hipLaunchKernelGGL(mk_fwd, dim3(grid), dim3(NWAVES * 64), LDS_BYTES, stream, a);
}
extern "C" void kernel_launch(void* const* d_in, const int* in_sizes, int n_in, void* d_out, int out_size, void* d_ws, size_t ws_size, hipStream_t stream) {
    static int grid = 0;
    if (grid == 0) {
        if (n_in != 20 || out_size != MTOK * DM || ws_size < WS_END) { fprintf(stderr, "kernel_launch: unexpected shapes (n_in %d, out %d, ws %zu < %zu)\n", n_in, out_size, ws_size, (size_t)WS_END); grid = -1; return; }
        int dev = 0, cus = 0, per_cu = 0;
        if (hipGetDevice(&dev) != hipSuccess || hipDeviceGetAttribute(&cus, hipDeviceAttributeMultiprocessorCount, dev) != hipSuccess) { grid = -1; return; }
        if (hipFuncSetAttribute((const void*)mk_fwd, hipFuncAttributeMaxDynamicSharedMemorySize, LDS_BYTES) != hipSuccess) { fprintf(stderr, "kernel_launch: hipFuncSetAttribute failed\n"); grid = -1; return; }
        if (hipOccupancyMaxActiveBlocksPerMultiprocessor(&per_cu, (const void*)mk_fwd, NWAVES * 64, LDS_BYTES) != hipSuccess || per_cu < 1) { fprintf(stderr, "kernel_launch: occupancy query reports %d workgroups per CU\n", per_cu); }
        (void)hipGetLastError();
        grid = cus;
    }
    if (grid < 0) return;
    (void)in_sizes;
    if (hipMemsetAsync((char*)d_ws + WS_CTL, 0, CTL_ZERO_BYTES, stream) != hipSuccess) return;
    Args a{};
    for (int i = 0; i < 20; ++i) a.in[i] = (const float*)d_in[i];
    a.out = (float*)d_out; a.ws = (unsigned char*)d_ws;
#ifdef PROBE_LO
    launch_mk(a, 0, PROBE_HI + 1, grid, stream, 0); launch_mk(a, PROBE_LO, N_PHASE_IDS, grid, stream, 1);
#else
    launch_mk(a, 0, N_PHASE_IDS, grid, stream);
#endif
#ifdef PROBE_GEMM_K
    launch_mk(a, 30, 31, grid, stream, 2);
#endif
#ifdef PROBE_CONV
    launch_mk(a, 31, 32, grid, stream, 2);
#endif
}
```

```cpp
#include <hip/hip_runtime.h>
#include <cstdio>
#include <cstdint>
namespace pg8 {
#define PG8_LAS __attribute__((address_space(3)))
typedef unsigned short bf16_t;
typedef short bf16x8 __attribute__((ext_vector_type(8)));
typedef float f32x4 __attribute__((ext_vector_type(4)));
typedef unsigned u32x4 __attribute__((ext_vector_type(4)));
constexpr int BM = 256, BK = 64, HALF = 128, HTB = HALF * BK * 2  , STAGE_BYTES = 8 * HTB, NXCD = 8, WGM = 8;

__host__ __device__ __forceinline__ int lds_byte(int r, int c) { const int st = (r >> 4) * 2 + (c >> 5), rr = r & 15, cc = c & 31, ob = rr * 64 + cc * 2; return st * 1024 + (ob ^ (((ob >> 9) & 1) << 5)); }
__host__ __device__ __forceinline__ void stage_rc(int b, int& R, int& C) { const int st = b / 1024, sb = b % 1024, swz = sb ^ (((sb >> 9) & 1) << 5); R = (st >> 1) * 16 + swz / 64; C = (st & 1) * 32 + (swz % 64) / 2; }
__host__ __device__ __forceinline__ int perm32(int rho) { const int n = rho >> 4, i = rho & 15; return 8 * (i >> 2) + 4 * n + (i & 3); }

struct Unit { int pm, pn, inv0, nvalid, half; };
struct Gemm { const bf16_t* A; const bf16_t* Bt; int M, N, K, lda, ldb; };

struct StaticOrder {
    int nM, nN, nwg, G, c;
    __host__ __device__ void init(int M, int N, int G_, int c_) { nM = M / BM; nN = N / BM; nwg = nM * nN; G = G_; c = c_; }
    __host__ __device__ bool next(int i, Unit& u) const {
        const long L = (long)i * G + c; if (L >= nwg) return false;
        int wgid = (int)L; { const int q = nwg / NXCD, r = nwg % NXCD, xcd = wgid % NXCD, off = wgid / NXCD; wgid = (xcd < r ? xcd * (q + 1) : r * (q + 1) + (xcd - r) * q) + off; }
        const int nig = WGM * nN, gid = wgid / nig, fm = gid * WGM, gsz = (nM - fm) < WGM ? (nM - fm) : WGM;
        u.pm = fm + ((wgid % nig) % gsz); u.pn = (wgid % nig) / gsz; return true;
    }
    __device__ __forceinline__ void a_ready(const Unit&) const {}
    __device__ __forceinline__ void done(const Unit&) const {}
};

__device__ __forceinline__ unsigned cvt_pk_bf16(float lo, float hi) { unsigned r; asm volatile("v_cvt_pk_bf16_f32 %0, %1, %2" : "=v"(r) : "v"(lo), "v"(hi)); return r; }
typedef float f32x2 __attribute__((ext_vector_type(2)));
struct EpiBf16Plain {
    static constexpr bool PERM = true, AFTER_DRAIN = false;
    bf16_t* O; int ldc; int pn_mask;
    __device__ __forceinline__ void operator()(const f32x4 (&acc)[2][2][4][2], const Unit& u, int wr, int wc, int fr, int fq) const {
        const int row0 = u.pm * BM + wr * 64 + fr, col0 = (u.pn & pn_mask) * BM + wc * 32 + 8 * fq;
#pragma unroll
        for (int ai = 0; ai < 2; ++ai)
#pragma unroll
            for (int m = 0; m < 4; ++m) { bf16_t* rowp = O + (size_t)(row0 + ai * HALF + m * 16) * ldc + col0;
#pragma unroll
                for (int bj = 0; bj < 2; ++bj) { const f32x4 v0 = acc[ai][bj][m][0], v1 = acc[ai][bj][m][1];
                    u32x4 w; w.x = cvt_pk_bf16(v0[0], v0[1]); w.y = cvt_pk_bf16(v0[2], v0[3]); w.z = cvt_pk_bf16(v1[0], v1[1]); w.w = cvt_pk_bf16(v1[2], v1[3]);
                    *(u32x4*)(rowp + bj * HALF) = w; } }
    }
};
struct EpiResid {
    static constexpr bool PERM = true, AFTER_DRAIN = false;
    const bf16_t* base; bf16_t* out; float alpha;
    __device__ __forceinline__ void operator()(const f32x4 (&acc)[2][2][4][2], const Unit& u, int wr, int wc, int fr, int fq) const {
        const int row0 = u.pm * BM + wr * 64 + fr, col0 = u.pn * BM + wc * 32 + 8 * fq;
#pragma unroll
        for (int ai = 0; ai < 2; ++ai)
#pragma unroll
            for (int m = 0; m < 4; ++m) { const size_t off = (size_t)(row0 + ai * HALF + m * 16) * 2048 + col0;
#pragma unroll
                for (int bj = 0; bj < 2; ++bj) { const u32x4 b = *(const u32x4*)(base + off + bj * HALF); const f32x4 v0 = acc[ai][bj][m][0], v1 = acc[ai][bj][m][1];
                    const unsigned bw[4] = {b.x, b.y, b.z, b.w}; u32x4 w; unsigned* wp = (unsigned*)&w;
#pragma unroll
                    for (int q = 0; q < 4; ++q) { const float lo = __builtin_bit_cast(float, bw[q] << 16), hi = __builtin_bit_cast(float, bw[q] & 0xffff0000u);
                        const float a0 = q < 2 ? v0[2 * q] : v1[2 * q - 4], a1 = q < 2 ? v0[2 * q + 1] : v1[2 * q - 3];
                        wp[q] = cvt_pk_bf16(lo * alpha + a0, hi * alpha + a1); }
                    *(u32x4*)(out + off + bj * HALF) = w; } }
    }
};
struct EpiGLU {
    static constexpr bool PERM = true, AFTER_DRAIN = false;
    bf16_t* H; const float* winv;
    __device__ __forceinline__ void operator()(const f32x4 (&acc)[2][2][4][2], const Unit& u, int wr, int wc, int fr, int fq) const {
        const int row0 = u.pm * BM + wr * 64 + fr, f0 = (u.pn & 3) * 128 + wc * 32 + 8 * fq;
#pragma unroll
        for (int ai = 0; ai < 2; ++ai) { if (u.half >= 0 && u.half != ai) continue;
#pragma unroll
            for (int m = 0; m < 4; ++m) { const int row = row0 + ai * HALF + m * 16; const float w = winv[u.inv0 + ai * HALF + wr * 64 + m * 16 + fr];
                float h[8];
#pragma unroll
                for (int n = 0; n < 2; ++n)
#pragma unroll
                    for (int e = 0; e < 4; ++e) { const float g = acc[ai][0][m][n][e], up = acc[ai][1][m][n][e]; h[n * 4 + e] = g * __builtin_amdgcn_rcpf(1.0f + __expf(-g)) * up * w; }
                u32x4 o; o.x = cvt_pk_bf16(h[0], h[1]); o.y = cvt_pk_bf16(h[2], h[3]); o.z = cvt_pk_bf16(h[4], h[5]); o.w = cvt_pk_bf16(h[6], h[7]);
                *(u32x4*)(H + (size_t)row * 512 + f0) = o; } }
    }
};
struct EpiRope {
    static constexpr bool PERM = true, AFTER_DRAIN = false;
    bf16_t* O; const float* c128; const float* s128; const float* c64; const float* s64;
    __device__ __forceinline__ void operator()(const f32x4 (&acc)[2][2][4][2], const Unit& u, int wr, int wc, int fr, int fq) const {
        const int row0 = u.pm * BM + wr * 64 + fr, jj = wc * 32 + 8 * fq;
        const int pn = u.pn;
        if (pn == 10 || pn == 11) {
#pragma unroll
            for (int ai = 0; ai < 2; ++ai)
#pragma unroll
                for (int m = 0; m < 4; ++m) { bf16_t* rowp = O + (size_t)(row0 + ai * HALF + m * 16) * 4096 + pn * 256 + jj;
#pragma unroll
                    for (int bj = 0; bj < 2; ++bj) { const f32x4 v0 = acc[ai][bj][m][0], v1 = acc[ai][bj][m][1];
                        u32x4 w; w.x = cvt_pk_bf16(v0[0], v0[1]); w.y = cvt_pk_bf16(v0[2], v0[3]); w.z = cvt_pk_bf16(v1[0], v1[1]); w.w = cvt_pk_bf16(v1[2], v1[3]);
                        *(u32x4*)(rowp + bj * HALF) = w; } }
            return;
        }
        const bool idx = pn >= 12;
        const int half = idx ? 32 : 64;
        const int hl = idx ? (jj >> 5) : (jj >> 6), i0 = jj & (half - 1);
        const int colbase = idx ? (3072 + ((pn - 12) * 4 + hl) * 64) : (pn * 256 + hl * 128);
        const float* ct = idx ? c64 : c128; const float* st = idx ? s64 : s128;
#pragma unroll
        for (int ai = 0; ai < 2; ++ai)
#pragma unroll
            for (int m = 0; m < 4; ++m) { const int row = row0 + ai * HALF + m * 16; const int pos = row & 4095;
                const float* cp = ct + (size_t)pos * half + i0; const float* sp = st + (size_t)pos * half + i0;
                const f32x4 c0 = *(const f32x4*)cp, c1 = *(const f32x4*)(cp + 4), s0 = *(const f32x4*)sp, s1 = *(const f32x4*)(sp + 4);
                const f32x4 a0 = acc[ai][0][m][0], a1 = acc[ai][0][m][1], b0 = acc[ai][1][m][0], b1 = acc[ai][1][m][1];
                const f32x4 x0 = a0 * c0 - b0 * s0, x1 = a1 * c1 - b1 * s1, y0 = b0 * c0 + a0 * s0, y1 = b1 * c1 + a1 * s1;
                bf16_t* rowp = O + (size_t)row * 4096 + colbase + i0;
                u32x4 w; w.x = cvt_pk_bf16(x0[0], x0[1]); w.y = cvt_pk_bf16(x0[2], x0[3]); w.z = cvt_pk_bf16(x1[0], x1[1]); w.w = cvt_pk_bf16(x1[2], x1[3]);
                *(u32x4*)rowp = w;
                u32x4 z; z.x = cvt_pk_bf16(y0[0], y0[1]); z.y = cvt_pk_bf16(y0[2], y0[3]); z.z = cvt_pk_bf16(y1[0], y1[1]); z.w = cvt_pk_bf16(y1[2], y1[3]);
                *(u32x4*)(rowp + half) = z; }
    }
};
struct MoeOrder {
    int G, c, ntn, L0, Lend, hsplit; const PG8_LAS int* tend; const PG8_LAS int* cnt;
    __device__ __forceinline__ bool next(int i, Unit& u) const {
        int Lx = L0 + i * G + c; if (Lx >= Lend) return false;
        if (hsplit == 2) { const int x = c & 7, s = c >> 3; Lx = L0 + ((x >> 2) * (G >> 3) + s) * ntn + (x & 3); }
        const int L = hsplit == 1 ? Lx >> 1 : Lx;
        const int t = L / ntn; int e = 0;
#pragma unroll 1
        for (int k = 0; k < 32; ++k) e += (t >= tend[k]) ? 1 : 0;
        const int p0 = (t - (e ? tend[e - 1] : 0)) * BM, left = cnt[e] - p0;
        u.pm = t; u.pn = e * ntn + (L - t * ntn); u.inv0 = e * 8192 + p0; u.nvalid = left < BM ? left : BM; u.half = hsplit == 1 ? (Lx & 1) : -1; return true;
    }
    __device__ __forceinline__ void a_ready(const Unit&) const {}
    __device__ __forceinline__ void done(const Unit&) const {}
};
template <class Epi, class Sched, bool ALIGN_EPI = false, bool SP2 = false>
__device__ __forceinline__ void gemm_phase(PG8_LAS unsigned char* lds, const Gemm g, const Sched& S, const Epi& E) {
    const int tid = threadIdx.x, wid = __builtin_amdgcn_readfirstlane(tid >> 6), lane = tid & 63, wr = wid >> 2, wc = wid & 3, fr = lane & 15, fq = lane >> 4;
    const int K = g.K, nt = K / BK;
    unsigned voffA[2], voffB[2];
#pragma unroll
    for (int i = 0; i < 2; ++i) { int R, C; stage_rc(tid * 16 + i * 8192, R, C); const int Rb = Epi::PERM ? ((R & ~31) + perm32(R & 31)) : R;
        voffA[i] = (unsigned)(R * g.lda + C) * 2u; voffB[i] = (unsigned)(Rb * g.ldb + C) * 2u; }
    const size_t kstep = (size_t)(BK * 2);
    const size_t hstepA = (size_t)HALF * g.lda * 2, hstepB = (size_t)HALF * g.ldb * 2;
    const size_t tstepA = 2 * hstepA, tstepB = 2 * hstepB;
    const unsigned ldsw = (unsigned)wid * 1024u;
    const int aoff = lds_byte(wr * 64 + fr, fq * 8), boff = lds_byte(wc * 32 + fr, fq * 8);
#define PG8_SA(b, h) (((b) * 2 + (h)) * HTB)
#define PG8_SB(b, h) ((4 + (b) * 2 + (h)) * HTB)
#define PG8_STAGE(bufoff, gbase, voff) do { _Pragma("unroll") for (int _i = 0; _i < 2; ++_i) \
        __builtin_amdgcn_global_load_lds((const unsigned*)((const char*)(gbase) + (voff)[_i]), (PG8_LAS unsigned*)(lds + (bufoff) + ldsw + _i * 8192), 16, 0, 0); } while (0)
#define PG8_LDA(dst, b, h) do { _Pragma("unroll") for (int m = 0; m < 4; ++m) _Pragma("unroll") for (int k = 0; k < 2; ++k) dst[m][k] = *(const PG8_LAS bf16x8*)(lds + PG8_SA(b, h) + aoff + m * 2048 + k * 1024); } while (0)
#define PG8_LDB(dst, b, h) do { _Pragma("unroll") for (int n = 0; n < 2; ++n) _Pragma("unroll") for (int k = 0; k < 2; ++k) dst[n][k] = *(const PG8_LAS bf16x8*)(lds + PG8_SB(b, h) + boff + n * 2048 + k * 1024); } while (0)
#define PG8_MMA(ai, bj, At, Bt) do { __builtin_amdgcn_s_setprio(1); _Pragma("unroll") for (int m = 0; m < 4; ++m) _Pragma("unroll") for (int n = 0; n < 2; ++n) _Pragma("unroll") for (int k = 0; k < 2; ++k) \
        acc[ai][bj][m][n] = __builtin_amdgcn_mfma_f32_16x16x32_bf16(Bt[n][k], At[m][k], acc[ai][bj][m][n], 0, 0, 0); __builtin_amdgcn_s_setprio(0); } while (0)
#define PG8_WAIT_V(n) asm volatile("s_waitcnt vmcnt(" #n ")" ::: "memory")
#define PG8_WAIT_L(n) asm volatile("s_waitcnt lgkmcnt(" #n ")" ::: "memory")
#define PG8_BAR __builtin_amdgcn_s_barrier()
#define PG8_SCHED __builtin_amdgcn_sched_barrier(0)
    Unit cur, nxt; int ui = 0;
    if (!S.next(0, cur)) return;
    f32x4 acc[2][2][4][2];
#pragma unroll
    for (int a = 0; a < 2; ++a)
#pragma unroll
        for (int b = 0; b < 2; ++b)
#pragma unroll
            for (int m = 0; m < 4; ++m)
#pragma unroll
                for (int n = 0; n < 2; ++n) acc[a][b][m][n] = (f32x4){0.f, 0.f, 0.f, 0.f};
    bf16x8 At[4][2], B0[2][2], B1[2][2];
    const char* cA = (const char*)g.A + (size_t)cur.pm * tstepA; const char* cB = (const char*)g.Bt + (size_t)cur.pn * tstepB;
    S.a_ready(cur);
    if constexpr (SP2) {
        PG8_STAGE(PG8_SB(0, 0), cB, voffB); PG8_STAGE(PG8_SB(0, 1), cB + hstepB, voffB); PG8_STAGE(PG8_SA(0, 0), cA, voffA); PG8_STAGE(PG8_SA(0, 1), cA + hstepA, voffA);
        if (wr == 1) PG8_BAR;
        PG8_WAIT_V(2); PG8_BAR;
        PG8_STAGE(PG8_SB(1, 0), cB + kstep, voffB); PG8_STAGE(PG8_SA(1, 0), cA + kstep, voffA); PG8_STAGE(PG8_SB(1, 1), cB + hstepB + kstep, voffB);
        PG8_WAIT_V(6); PG8_BAR;
    } else {
        PG8_STAGE(PG8_SB(0, 0), cB, voffB); PG8_STAGE(PG8_SA(0, 0), cA, voffA); PG8_STAGE(PG8_SB(0, 1), cB + hstepB, voffB); PG8_STAGE(PG8_SA(0, 1), cA + hstepA, voffA);
        if (wr == 1) PG8_BAR;
        PG8_WAIT_V(4); PG8_BAR;
        PG8_STAGE(PG8_SB(1, 0), cB + kstep, voffB); PG8_STAGE(PG8_SA(1, 0), cA + kstep, voffA); PG8_STAGE(PG8_SB(1, 1), cB + hstepB + kstep, voffB);
        PG8_WAIT_V(6); PG8_BAR;
    }
    for (;;) {
        const bool has_next = S.next(ui + 1, nxt);
        const char* nA = has_next ? (const char*)g.A + (size_t)nxt.pm * tstepA : cA; const char* nB = has_next ? (const char*)g.Bt + (size_t)nxt.pn * tstepB : cB;
        for (int t = 0; t < nt; t += 2) {
            const bool last = (t == nt - 2);
            const char* a1 = cA + (size_t)(t + 1) * kstep;
            const char* a2 = last ? nA : cA + (size_t)(t + 2) * kstep; const char* b2 = last ? nB : cB + (size_t)(t + 2) * kstep;
            const char* a3 = a2 + kstep; const char* b3 = b2 + kstep;
            if (last && has_next) S.a_ready(nxt);
            if constexpr (SP2) {
            PG8_LDB(B0, 0, 0); PG8_LDB(B1, 0, 1); PG8_SCHED; PG8_LDA(At, 0, 0); PG8_STAGE(PG8_SA(1, 1), a1 + hstepA, voffA);
            PG8_WAIT_V(8); PG8_WAIT_L(0); PG8_BAR; PG8_MMA(0, 0, At, B0); PG8_MMA(0, 1, At, B1); PG8_BAR; PG8_SCHED;
            PG8_LDA(At, 0, 1); PG8_STAGE(PG8_SB(0, 0), b2, voffB); PG8_STAGE(PG8_SB(0, 1), b2 + hstepB, voffB); PG8_STAGE(PG8_SA(0, 0), a2, voffA);
            PG8_WAIT_V(8); PG8_WAIT_L(0); PG8_BAR; PG8_MMA(1, 0, At, B0); PG8_MMA(1, 1, At, B1); PG8_BAR; PG8_SCHED;
            PG8_LDB(B0, 1, 0); PG8_LDB(B1, 1, 1); PG8_SCHED; PG8_LDA(At, 1, 0); PG8_STAGE(PG8_SA(0, 1), a2 + hstepA, voffA);
            PG8_WAIT_V(8); PG8_WAIT_L(0); PG8_BAR; PG8_MMA(0, 0, At, B0); PG8_MMA(0, 1, At, B1); PG8_BAR; PG8_SCHED;
            PG8_LDA(At, 1, 1); PG8_STAGE(PG8_SB(1, 0), b3, voffB); PG8_STAGE(PG8_SB(1, 1), b3 + hstepB, voffB); PG8_STAGE(PG8_SA(1, 0), a3, voffA);
            PG8_WAIT_V(8); PG8_WAIT_L(0); PG8_BAR; PG8_MMA(1, 0, At, B0); PG8_MMA(1, 1, At, B1); PG8_BAR; PG8_SCHED;
            } else {
            PG8_LDB(B0, 0, 0); PG8_SCHED; PG8_LDA(At, 0, 0); PG8_STAGE(PG8_SA(1, 1), a1 + hstepA, voffA);
            PG8_WAIT_L(8); PG8_BAR; PG8_WAIT_L(0); PG8_MMA(0, 0, At, B0); PG8_BAR; PG8_SCHED;
            PG8_LDB(B1, 0, 1); PG8_STAGE(PG8_SB(0, 0), b2, voffB);
            PG8_BAR; PG8_WAIT_L(0); PG8_MMA(0, 1, At, B1); PG8_BAR;
            PG8_LDA(At, 0, 1); PG8_STAGE(PG8_SA(0, 0), a2, voffA);
            PG8_BAR; PG8_WAIT_L(0); PG8_MMA(1, 0, At, B0); PG8_BAR; PG8_SCHED;
            PG8_STAGE(PG8_SB(0, 1), b2 + hstepB, voffB);
            PG8_WAIT_V(6); PG8_BAR; PG8_MMA(1, 1, At, B1); PG8_BAR;
            PG8_LDB(B0, 1, 0); PG8_SCHED; PG8_LDA(At, 1, 0); PG8_STAGE(PG8_SA(0, 1), a2 + hstepA, voffA);
            PG8_WAIT_L(8); PG8_BAR; PG8_WAIT_L(0); PG8_MMA(0, 0, At, B0); PG8_BAR; PG8_SCHED;
            PG8_LDB(B1, 1, 1); PG8_STAGE(PG8_SB(1, 0), b3, voffB);
            PG8_BAR; PG8_WAIT_L(0); PG8_MMA(0, 1, At, B1); PG8_BAR;
            PG8_LDA(At, 1, 1); PG8_STAGE(PG8_SA(1, 0), a3, voffA);
            PG8_BAR; PG8_WAIT_L(0); PG8_MMA(1, 0, At, B0); PG8_BAR; PG8_SCHED;
            PG8_STAGE(PG8_SB(1, 1), b3 + hstepB, voffB);
            PG8_WAIT_V(6); PG8_BAR; PG8_MMA(1, 1, At, B1); PG8_BAR;
            }
        }
        if constexpr (ALIGN_EPI) { if (wr == 0) PG8_BAR; }
        if constexpr (!Epi::AFTER_DRAIN) { E(acc, cur, wr, wc, fr, fq); S.done(cur); }
        if (!has_next) break;
#pragma unroll
        for (int a = 0; a < 2; ++a)
#pragma unroll
            for (int b = 0; b < 2; ++b)
#pragma unroll
                for (int m = 0; m < 4; ++m)
#pragma unroll
                    for (int n = 0; n < 2; ++n) acc[a][b][m][n] = (f32x4){0.f, 0.f, 0.f, 0.f};
        cur = nxt; cA = nA; cB = nB; ++ui;
        if constexpr (ALIGN_EPI) { if (wr == 1) PG8_BAR; }
    }
    PG8_WAIT_V(0);
    if constexpr (!ALIGN_EPI) { if (wr == 0) PG8_BAR; }
    PG8_BAR;
    if constexpr (Epi::AFTER_DRAIN) { E.fused(acc, cur, wr, wc, fr, fq, lds, wid, lane); S.done(cur); }
#undef PG8_SA
#undef PG8_SB
#undef PG8_STAGE
#undef PG8_LDA
#undef PG8_LDB
#undef PG8_MMA
#undef PG8_WAIT_V
#undef PG8_WAIT_L
#undef PG8_BAR
#undef PG8_SCHED
}
template <class Epi, class Sched>
__device__ __forceinline__ void gemm_phase_g(PG8_LAS unsigned char* lds, const Gemm g, const Sched& S, const Epi& E, const int* inv) {
    constexpr bool ALIGN_EPI = true;
    const int tid = threadIdx.x, wid = __builtin_amdgcn_readfirstlane(tid >> 6), lane = tid & 63, wr = wid >> 2, wc = wid & 3, fr = lane & 15, fq = lane >> 4;
    const int K = g.K, nt = K / BK;
    unsigned voffA[2], voffB[2];
#pragma unroll
    for (int i = 0; i < 2; ++i) { int R, C; stage_rc(tid * 16 + i * 8192, R, C); const int Rb = Epi::PERM ? ((R & ~31) + perm32(R & 31)) : R;
        voffA[i] = (unsigned)(R * g.lda + C) * 2u; voffB[i] = (unsigned)(Rb * g.ldb + C) * 2u; }
    const size_t kstep = (size_t)(BK * 2);
    const size_t hstepA = (size_t)HALF * g.lda * 2, hstepB = (size_t)HALF * g.ldb * 2;
    const size_t tstepA = 2 * hstepA, tstepB = 2 * hstepB;
    const unsigned ldsw = (unsigned)wid * 1024u;
    const int aoff = lds_byte(wr * 64 + fr, fq * 8), boff = lds_byte(wc * 32 + fr, fq * 8);
#define PG8_SA(b, h) (((b) * 2 + (h)) * HTB)
#define PG8_SB(b, h) ((4 + (b) * 2 + (h)) * HTB)
#define PG8_STAGE(bufoff, gbase, voff) do { _Pragma("unroll") for (int _i = 0; _i < 2; ++_i) \
        __builtin_amdgcn_global_load_lds((const unsigned*)((const char*)(gbase) + (voff)[_i]), (PG8_LAS unsigned*)(lds + (bufoff) + ldsw + _i * 8192), 16, 0, 0); } while (0)
#define PG8_LDA(dst, b, h) do { _Pragma("unroll") for (int m = 0; m < 4; ++m) _Pragma("unroll") for (int k = 0; k < 2; ++k) dst[m][k] = *(const PG8_LAS bf16x8*)(lds + PG8_SA(b, h) + aoff + m * 2048 + k * 1024); } while (0)
#define PG8_LDB(dst, b, h) do { _Pragma("unroll") for (int n = 0; n < 2; ++n) _Pragma("unroll") for (int k = 0; k < 2; ++k) dst[n][k] = *(const PG8_LAS bf16x8*)(lds + PG8_SB(b, h) + boff + n * 2048 + k * 1024); } while (0)
#define PG8_MMA(ai, bj, At, Bt) do { __builtin_amdgcn_s_setprio(1); _Pragma("unroll") for (int m = 0; m < 4; ++m) _Pragma("unroll") for (int n = 0; n < 2; ++n) _Pragma("unroll") for (int k = 0; k < 2; ++k) \
        acc[ai][bj][m][n] = __builtin_amdgcn_mfma_f32_16x16x32_bf16(Bt[n][k], At[m][k], acc[ai][bj][m][n], 0, 0, 0); __builtin_amdgcn_s_setprio(0); } while (0)
#define PG8_WAIT_V(n) asm volatile("s_waitcnt vmcnt(" #n ")" ::: "memory")
#define PG8_WAIT_L(n) asm volatile("s_waitcnt lgkmcnt(" #n ")" ::: "memory")
#define PG8_BAR __builtin_amdgcn_s_barrier()
#define PG8_SCHED __builtin_amdgcn_sched_barrier(0)
    Unit cur, nxt; int ui = 0;
    if (!S.next(0, cur)) return;
    f32x4 acc[2][2][4][2];
#pragma unroll
    for (int a = 0; a < 2; ++a)
#pragma unroll
        for (int b = 0; b < 2; ++b)
#pragma unroll
            for (int m = 0; m < 4; ++m)
#pragma unroll
                for (int n = 0; n < 2; ++n) acc[a][b][m][n] = (f32x4){0.f, 0.f, 0.f, 0.f};
    bf16x8 At[4][2], B0[2][2], B1[2][2];
    const char* cA = (const char*)g.A; const char* cB = (const char*)g.Bt + (size_t)cur.pn * tstepB;
    S.a_ready(cur);
    unsigned vc[2][2], vn[2][2];
#define PG8_ROWS(u_, vo_) do { _Pragma("unroll") for (int h_ = 0; h_ < 2; ++h_) _Pragma("unroll") for (int i_ = 0; i_ < 2; ++i_) { int R_, C_; stage_rc(tid * 16 + i_ * 8192, R_, C_); const int r_ = h_ * HALF + R_; \
        const int tok_ = r_ < (u_).nvalid ? inv[(u_).inv0 + r_] : 0; vo_[h_][i_] = (unsigned)(tok_ * g.lda + C_) * 2u; } } while (0)
    PG8_ROWS(cur, vc);
    {
        PG8_STAGE(PG8_SB(0, 0), cB, voffB); PG8_STAGE(PG8_SB(0, 1), cB + hstepB, voffB); PG8_STAGE(PG8_SA(0, 0), cA, vc[0]); PG8_STAGE(PG8_SA(0, 1), cA, vc[1]);
        if (wr == 1) PG8_BAR;
        PG8_WAIT_V(2); PG8_BAR;
        PG8_STAGE(PG8_SB(1, 0), cB + kstep, voffB); PG8_STAGE(PG8_SA(1, 0), cA + kstep, vc[0]); PG8_STAGE(PG8_SB(1, 1), cB + hstepB + kstep, voffB);
        PG8_WAIT_V(6); PG8_BAR;
    }
    for (;;) {
        const bool has_next = S.next(ui + 1, nxt);
        if (has_next) { PG8_ROWS(nxt, vn); } else {
#pragma unroll
            for (int h_ = 0; h_ < 2; ++h_) { vn[h_][0] = vc[h_][0]; vn[h_][1] = vc[h_][1]; } }
        const char* nA = cA; const char* nB = has_next ? (const char*)g.Bt + (size_t)nxt.pn * tstepB : cB;
        const bool do0 = cur.half != 1, do1 = cur.half != 0;
        for (int t = 0; t < nt; t += 2) {
            const bool last = (t == nt - 2);
            unsigned v2[2][2];
#pragma unroll
            for (int h_ = 0; h_ < 2; ++h_) { v2[h_][0] = last ? vn[h_][0] : vc[h_][0]; v2[h_][1] = last ? vn[h_][1] : vc[h_][1]; }
            const char* a1 = cA + (size_t)(t + 1) * kstep;
            const char* a2 = last ? nA : cA + (size_t)(t + 2) * kstep; const char* b2 = last ? nB : cB + (size_t)(t + 2) * kstep;
            const char* a3 = a2 + kstep; const char* b3 = b2 + kstep;
            if (last && has_next) S.a_ready(nxt);
            {
            PG8_LDB(B0, 0, 0); PG8_LDB(B1, 0, 1); PG8_SCHED; if (do0) { PG8_LDA(At, 0, 0); } PG8_STAGE(PG8_SA(1, 1), a1, vc[1]);
            PG8_WAIT_V(8); PG8_WAIT_L(0); PG8_BAR; if (do0) { PG8_MMA(0, 0, At, B0); PG8_MMA(0, 1, At, B1); } PG8_BAR; PG8_SCHED;
            if (do1) { PG8_LDA(At, 0, 1); } PG8_STAGE(PG8_SB(0, 0), b2, voffB); PG8_STAGE(PG8_SB(0, 1), b2 + hstepB, voffB); PG8_STAGE(PG8_SA(0, 0), a2, v2[0]);
            PG8_WAIT_V(8); PG8_WAIT_L(0); PG8_BAR; if (do1) { PG8_MMA(1, 0, At, B0); PG8_MMA(1, 1, At, B1); } PG8_BAR; PG8_SCHED;
            PG8_LDB(B0, 1, 0); PG8_LDB(B1, 1, 1); PG8_SCHED; if (do0) { PG8_LDA(At, 1, 0); } PG8_STAGE(PG8_SA(0, 1), a2, v2[1]);
            PG8_WAIT_V(8); PG8_WAIT_L(0); PG8_BAR; if (do0) { PG8_MMA(0, 0, At, B0); PG8_MMA(0, 1, At, B1); } PG8_BAR; PG8_SCHED;
            if (do1) { PG8_LDA(At, 1, 1); } PG8_STAGE(PG8_SB(1, 0), b3, voffB); PG8_STAGE(PG8_SB(1, 1), b3 + hstepB, voffB); PG8_STAGE(PG8_SA(1, 0), a3, v2[0]);
            PG8_WAIT_V(8); PG8_WAIT_L(0); PG8_BAR; if (do1) { PG8_MMA(1, 0, At, B0); PG8_MMA(1, 1, At, B1); } PG8_BAR; PG8_SCHED;
            }
        }
        if constexpr (ALIGN_EPI) { if (wr == 0) PG8_BAR; }
        if constexpr (!Epi::AFTER_DRAIN) { E(acc, cur, wr, wc, fr, fq); S.done(cur); }
        if (!has_next) break;
#pragma unroll
        for (int a = 0; a < 2; ++a)
#pragma unroll
            for (int b = 0; b < 2; ++b)
#pragma unroll
                for (int m = 0; m < 4; ++m)
#pragma unroll
                    for (int n = 0; n < 2; ++n) acc[a][b][m][n] = (f32x4){0.f, 0.f, 0.f, 0.f};
        cur = nxt; cA = nA; cB = nB; ++ui;
#pragma unroll
        for (int h_ = 0; h_ < 2; ++h_) { vc[h_][0] = vn[h_][0]; vc[h_][1] = vn[h_][1]; }
        if constexpr (ALIGN_EPI) { if (wr == 1) PG8_BAR; }
    }
    PG8_WAIT_V(0);
    if constexpr (!ALIGN_EPI) { if (wr == 0) PG8_BAR; }
    PG8_BAR;
    if constexpr (Epi::AFTER_DRAIN) { E.fused(acc, cur, wr, wc, fr, fq, lds, wid, lane); S.done(cur); }
#undef PG8_ROWS
#undef PG8_SA
#undef PG8_SB
#undef PG8_STAGE
#undef PG8_LDA
#undef PG8_LDB
#undef PG8_MMA
#undef PG8_WAIT_V
#undef PG8_WAIT_L
#undef PG8_BAR
#undef PG8_SCHED
}
}
constexpr int BATCH = 2, SEQ = 4096, DM = 2048, MTOK = BATCH * SEQ;
constexpr int NE0 = 6168, NE1 = 4176;
constexpr int NP0 = 6144, NP1 = 4096;
constexpr float LN_EPS = 1e-5f;
constexpr float DN_ALPHA = 1.41421356237309515f;
constexpr float ATT_SCALE = 0.08838834764831845f;
constexpr int RPAD = 24576;
constexpr size_t MiB = 1u << 20;
constexpr size_t WS_CTL = 0, CTL_ZERO_BYTES = 1 * MiB;
constexpr size_t WS_ROPE = 1 * MiB;
constexpr size_t WS_WSM = 4 * MiB;
constexpr size_t WS_SK0 = 6 * MiB;
constexpr size_t WS_IK = 7 * MiB;
constexpr size_t WS_IW = 8 * MiB + 512 * 1024;
constexpr size_t WS_FBIAS = 10 * MiB;
constexpr size_t WS_ROUTE = 11 * MiB;
constexpr size_t WS_MASK = 12 * MiB;
constexpr size_t WS_WINA = 16 * MiB, WS_WOA = 40 * MiB, WS_WINC = 48 * MiB, WS_WOC = 64 * MiB;
constexpr size_t WS_WGU = 72 * MiB;
constexpr size_t WS_WD = 328 * MiB;
constexpr size_t WS_XB = 456 * MiB;
constexpr size_t WS_YB = 488 * MiB;
constexpr size_t WS_PROJ = 552 * MiB;
constexpr size_t WS_CST = 648 * MiB;
constexpr size_t WS_PREVT = 712 * MiB;
constexpr size_t WS_OMIX = 744 * MiB;
constexpr size_t WS_GB = 776 * MiB;
constexpr size_t WS_DEC = 792 * MiB;
constexpr size_t WS_ROWW = 793 * MiB;
constexpr size_t WS_SC = 800 * MiB;
constexpr size_t WS_INV = 800 * MiB;
constexpr size_t WS_WINV = 801 * MiB;
constexpr size_t WS_END = 928 * MiB;
constexpr int CW_CNT = 1024;
constexpr int CW_FILL = 2048;
constexpr int CW_BAR = 4096;

#define GAS __attribute__((address_space(1)))
#define LAS __attribute__((address_space(3)))
typedef unsigned short bf16;
typedef unsigned v4u __attribute__((ext_vector_type(4)));
typedef unsigned v2u __attribute__((ext_vector_type(2)));
typedef float f32x4 __attribute__((ext_vector_type(4)));
typedef short bf16x8 __attribute__((ext_vector_type(8)));
#define LDS_WAIT() asm volatile("s_waitcnt lgkmcnt(0)" ::: "memory")
#define VM_WAIT() asm volatile("s_waitcnt vmcnt(0)" ::: "memory")
__device__ __forceinline__ unsigned f2bf(float f) { unsigned u = __builtin_bit_cast(unsigned, f); return (u + 0x7fffu + ((u >> 16) & 1u)) >> 16; }
__device__ __forceinline__ unsigned pk2(float lo, float hi) { return f2bf(lo) | (f2bf(hi) << 16); }
__device__ __forceinline__ float bf2f(unsigned short b) { return __builtin_bit_cast(float, ((unsigned)b) << 16); }
__device__ __forceinline__ float wave_sum(float v) {
#pragma unroll
    for (int o = 1; o < 64; o <<= 1) v += __shfl_xor(v, o);
    return v;
}
__device__ __forceinline__ float logsigmoidf(float z) { return fminf(z, 0.f) - log1pf(__expf(-fabsf(z))); }
#define XB_TMO      128
#define XB_XCNT(j)  (256  + 64 * (j))
#define XB_XSUB(j)  (1280 + 64 * (j))
#define XB_XGEN(j)  (2304 + 64 * (j))
#define XB_TOP      3328
#define XB_TOPGEN   3392
#define XCD_BAR_WORDS 3456
#define XB_SPIN_CAP (1u << 21)

__device__ __forceinline__ unsigned xb_ld(unsigned* p)              { return __hip_atomic_load(p, __ATOMIC_RELAXED, __HIP_MEMORY_SCOPE_AGENT); }
__device__ __forceinline__ unsigned xb_add(unsigned* p, unsigned v) { return __hip_atomic_fetch_add(p, v, __ATOMIC_RELAXED, __HIP_MEMORY_SCOPE_AGENT); }
__device__ __forceinline__ unsigned xb_xcc_id() { return (unsigned)__builtin_amdgcn_s_getreg((3 << 11) | 20) & 0xFu; }
#define XB_SPIN(cond, bar) do { unsigned _sp = 0; while (cond) { __builtin_amdgcn_s_sleep(1); \
    if ((++_sp & 255u) == 0u) { if (xb_ld(&(bar)[XB_TMO])) break; if (_sp > XB_SPIN_CAP) { atomicAdd(&(bar)[XB_TMO], 1u); break; } } } } while (0)

struct XcdBarrier {
    unsigned* bar; unsigned x;
    volatile LAS unsigned* st;
};

__device__ __forceinline__ XcdBarrier xcd_barrier_post(unsigned* bar, volatile LAS unsigned* st) {
    XcdBarrier b; b.bar = bar; b.x = xb_xcc_id(); b.st = st;
    if (threadIdx.x == 0) (void)xb_add(&bar[XB_XCNT(b.x)], 1u);
    return b;
}
__device__ __forceinline__ void xcd_barrier_complete(unsigned* bar, unsigned x, unsigned& nloc, unsigned& nx) {
    const unsigned G = gridDim.x * gridDim.y * gridDim.z;
    unsigned sum, cnt, mine, sp = 0u;
    for (;;) {
        sum = 0u; cnt = 0u; mine = 0u;
#pragma unroll
        for (unsigned j = 0; j < 16; ++j) { const unsigned c = xb_ld(&bar[XB_XCNT(j)]); sum += c; cnt += (c > 0u) ? 1u : 0u; mine = (j == x) ? c : mine; }
        if (sum == G) break;
        __builtin_amdgcn_s_sleep(1);
        if ((++sp & 255u) == 0u) { if (xb_ld(&bar[XB_TMO])) break; if (sp > XB_SPIN_CAP) { atomicAdd(&bar[XB_TMO], 1u); break; } }
    }
    nloc = mine > 0u ? mine : 1u; nx = cnt > 0u ? cnt : 1u;
}

__device__ __forceinline__ void xcd_barrier(const XcdBarrier& b) {
    asm volatile("s_waitcnt vmcnt(0)" ::: "memory");
    __syncthreads();
    if (threadIdx.x == 0) {
        unsigned* bar = b.bar;
        __builtin_amdgcn_s_waitcnt(0);
        unsigned nloc = b.st[0], nx = b.st[1];
        if (nloc == 0u) { xcd_barrier_complete(bar, b.x, nloc, nx); b.st[0] = nloc; b.st[1] = nx; }
        const unsigned old = xb_add(&bar[XB_XSUB(b.x)], 1u);
        const unsigned gen = old / nloc;
        if (old + 1u == (gen + 1u) * nloc) {
            __builtin_amdgcn_fence(__ATOMIC_RELEASE, "agent");
            asm volatile("s_waitcnt vmcnt(0)" ::: "memory");
            const unsigned og = xb_add(&bar[XB_TOP], 1u);
            const unsigned tg = og / nx;
            if (og + 1u == (tg + 1u) * nx) xb_add(&bar[XB_TOPGEN], 1u);
            else XB_SPIN(xb_ld(&bar[XB_TOPGEN]) == tg, bar);
            __builtin_amdgcn_fence(__ATOMIC_ACQUIRE, "agent");
            xb_add(&bar[XB_XGEN(b.x)], 1u);
            asm volatile("s_waitcnt vmcnt(0)" ::: "memory");
        } else {
            XB_SPIN(xb_ld(&bar[XB_XGEN(b.x)]) == gen, bar);
            __builtin_amdgcn_fence(__ATOMIC_ACQUIRE, "agent");
            asm volatile("s_waitcnt vmcnt(0)" ::: "memory");
        }
    }
    __syncthreads();
}

constexpr int NWAVES = 8;
constexpr int RING_BYTES = 131072;
constexpr int LDSCTL_OFF = RING_BYTES;
constexpr int LDS_BYTES = 147456;
struct Frame {
    LAS unsigned char* lds; volatile LAS unsigned* MISC; unsigned* ctl;
    int tid, lane, wave, G, gw, NGW;
    unsigned char* ws;
};
struct Args { const float* in[20]; float* out; unsigned char* ws; int ph_lo, ph_hi, bar_region, pad; };

struct TrItem { const float* W; bf16* WT; int ldw, c0, c1, K, n0, k0; };
__device__ __forceinline__ void tr64_load(const TrItem& t, f32x4 (&r)[16], int lane) {
    const int nq = lane & 15, kr = lane >> 4;
    const float* src = t.W + (size_t)(t.k0 + 2 * kr) * t.ldw + (nq < 8 ? t.c0 : t.c1 - 32) + 4 * nq;
#pragma unroll
    for (int i = 0; i < 8; ++i) { r[2 * i] = __builtin_nontemporal_load((const f32x4*)(src + (size_t)(8 * i) * t.ldw)); r[2 * i + 1] = __builtin_nontemporal_load((const f32x4*)(src + (size_t)(8 * i + 1) * t.ldw)); }
}
__device__ __forceinline__ void tr64_store(const TrItem& t, const f32x4 (&r)[16], LAS bf16* T, int lane) {
    const int nq = lane & 15, kr = lane >> 4;
#pragma unroll
    for (int i = 0; i < 8; ++i) { const int kk = 8 * i + 2 * kr;
#pragma unroll
        for (int e = 0; e < 4; ++e) *(LAS unsigned*)(T + (4 * nq + e) * 68 + kk) = pg8::cvt_pk_bf16(r[2 * i][e], r[2 * i + 1][e]); }
    LDS_WAIT(); asm volatile("" ::: "memory");
    const int c = lane & 7;
#pragma unroll
    for (int j = 0; j < 8; ++j) { const int n = (lane >> 3) + 8 * j; const v2u lo = *(const LAS v2u*)(T + n * 68 + 8 * c), hi = *(const LAS v2u*)(T + n * 68 + 8 * c + 4);
        v4u o; o.x = lo.x; o.y = lo.y; o.z = hi.x; o.w = hi.y;
        *(v4u*)(t.WT + (size_t)(t.n0 + n) * t.K + t.k0 + 8 * c) = o; }
    LDS_WAIT(); asm volatile("" ::: "memory");
}
__device__ __forceinline__ void transpose_item64(const float* W, int ldw, int c0, int c1, int K, bf16* WT, int n0, int k0, LAS bf16* T, int lane) {
    const TrItem t{W, WT, ldw, c0, c1, K, n0, k0}; f32x4 r[16]; tr64_load(t, r, lane); tr64_store(t, r, T, lane);
}
__device__ __forceinline__ int l1_src_col(int n) {
    const int pn = n >> 8, j = n & 255, jh = j & 127, second = j >> 7;
    if (pn == 10 || pn == 11) return n;
    if (pn < 10) return pn * 256 + (jh >> 6) * 128 + second * 64 + (jh & 63);
    return 3072 + ((pn - 12) * 4 + (jh >> 5)) * 64 + second * 32 + (jh & 31);
}
constexpr int SK_ROUTE0 = 0, SK_ROUTE1 = 48, SK_SK0 = 96, SK_SK1 = 128, SK_NCOL = 208;
constexpr int SK_PART_OFF = 0, SK_LG_OFF = 65536;
template <int NT, bool USE_LO = true> __device__ __forceinline__ void skinny_partials(LAS unsigned char* ldsb, const bf16* X, const bf16* WH, const bf16* WL, int w, int lane) {
    const int tile = w >> 2, kq = w & 3, l15 = lane & 15, quad = lane >> 4;
    const bf16* xp = X + (size_t)(16 * tile + l15) * DM + kq * 512 + quad * 8;
    const bf16* hp = WH + (size_t)l15 * 2048 + kq * 512 + quad * 8; const bf16* lp = WL + (size_t)l15 * 2048 + kq * 512 + quad * 8;
    pg8::f32x4 acc[NT];
#pragma unroll
    for (int n = 0; n < NT; ++n) acc[n] = (pg8::f32x4){0.f, 0.f, 0.f, 0.f};
#pragma unroll 4
    for (int ks = 0; ks < 16; ++ks) {
        const bf16x8 ah = *(const bf16x8*)(xp + 32 * ks);
#pragma unroll
        for (int n = 0; n < NT; ++n) { const bf16x8 bh = *(const bf16x8*)(hp + (size_t)n * 16 * 2048 + 32 * ks);
            acc[n] = __builtin_amdgcn_mfma_f32_16x16x32_bf16(ah, bh, acc[n], 0, 0, 0);
            if constexpr (USE_LO) { const bf16x8 bl = *(const bf16x8*)(lp + (size_t)n * 16 * 2048 + 32 * ks); acc[n] = __builtin_amdgcn_mfma_f32_16x16x32_bf16(ah, bl, acc[n], 0, 0, 0); } }
    }
    LAS float* PART = (LAS float*)(ldsb + SK_PART_OFF);
#pragma unroll
    for (int n = 0; n < NT; ++n) *(LAS pg8::f32x4*)(PART + ((((tile * 4 + kq) * NT + n) * 64 + lane) * 4)) = acc[n];
}
template <int NT> __device__ __forceinline__ void skinny_reduce(LAS unsigned char* ldsb, int tid) {
    const LAS float* PART = (const LAS float*)(ldsb + SK_PART_OFF); LAS float* LG = (LAS float*)(ldsb + SK_LG_OFF);
    for (int idx = tid; idx < 32 * 16 * NT; idx += NWAVES * 64) { const int row = idx / (16 * NT), col = idx % (16 * NT), tile = row >> 4, rr = row & 15, ln = (rr >> 2) * 16 + (col & 15), n = col >> 4, j = rr & 3;
        float s = 0.f;
#pragma unroll
        for (int kq = 0; kq < 4; ++kq) s += PART[(((tile * 4 + kq) * NT + n) * 64 + ln) * 4 + j];
        LG[row * (16 * NT) + col] = s; }
}
__device__ __forceinline__ void ln_row(f32x4 (&v)[8], const float* g, const float* b, int lane) {
    float s = 0.f;
#pragma unroll
    for (int j = 0; j < 8; ++j) s += (v[j][0] + v[j][1]) + (v[j][2] + v[j][3]);
    const float mean = wave_sum(s) * (1.f / DM); float s2 = 0.f;
#pragma unroll
    for (int j = 0; j < 8; ++j) { v[j] = v[j] - mean; s2 += (v[j][0] * v[j][0] + v[j][1] * v[j][1]) + (v[j][2] * v[j][2] + v[j][3] * v[j][3]); }
    const float rstd = 1.f / sqrtf(wave_sum(s2) * (1.f / DM) + LN_EPS);
#pragma unroll
    for (int j = 0; j < 8; ++j) { const f32x4 gg = *(const f32x4*)(g + 256 * j + 4 * lane), bb = *(const f32x4*)(b + 256 * j + 4 * lane); v[j] = v[j] * rstd * gg + bb; }
}
__device__ __forceinline__ void load_row_bf16(const bf16* src, f32x4 (&v)[8], int lane) {
#pragma unroll
    for (int j = 0; j < 8; ++j) { const uint2 p = *(const uint2*)(src + 256 * j + 4 * lane); v[j][0] = bf2f(p.x & 0xffff); v[j][1] = bf2f(p.x >> 16); v[j][2] = bf2f(p.y & 0xffff); v[j][3] = bf2f(p.y >> 16); }
}
__device__ __forceinline__ void store_row_bf16(bf16* dst, const f32x4 (&v)[8], int lane) {
#pragma unroll
    for (int j = 0; j < 8; ++j) { uint2 o; o.x = pg8::cvt_pk_bf16(v[j][0], v[j][1]); o.y = pg8::cvt_pk_bf16(v[j][2], v[j][3]); *(uint2*)(dst + 256 * j + 4 * lane) = o; }
}
#define TK_FOR_VALID(...) _Pragma("unroll") for (int g_ = 0; g_ < 8; ++g_) { if (512 * g_ <= qpos) { _Pragma("unroll") for (int i = 8 * g_; i < 8 * g_ + 8; ++i) { __VA_ARGS__ } } }
__device__ __forceinline__ void topk_mask_row(const LAS float* sc, int qpos, unsigned long long* mrow, int lane, LAS unsigned* cbuf) {
    unsigned u[64];
#pragma unroll
    for (int i = 0; i < 64; ++i) { const int s = 64 * i + lane; const bool ok = s <= qpos; const float f = ok ? sc[s] : 0.f; const unsigned b = __builtin_bit_cast(unsigned, f);
        const unsigned key = b ^ ((b >> 31) ? 0xFFFFFFFFu : 0x80000000u); u[i] = ok ? key : 0u; }
    unsigned long long mword = 0ull;
    if (qpos + 1 <= 256) {
#pragma unroll
        for (int i = 0; i < 4; ++i) { const unsigned long long w = __ballot(64 * i + lane <= qpos); mword = (lane == i) ? w : mword; }
        mrow[lane] = mword; return;
    }
    const unsigned long long below = (1ull << lane) - 1ull;
    unsigned T = 0u;
#pragma unroll 1
    for (int bit = 31; bit >= 20; --bit) { const unsigned cand = T | (1u << bit); int cnt = 0;
        TK_FOR_VALID( cnt += __builtin_popcountll(__ballot(u[i] >= cand)); )
        if (cnt >= 256) T = cand; }
    const unsigned pre = T >> 20; int cgt = 0, nc = 0;
    TK_FOR_VALID( { const unsigned p_ = u[i] >> 20; const unsigned long long gm = __ballot(p_ > pre), em = __ballot(p_ == pre); cgt += __builtin_popcountll(gm);
        const int pos_ = nc + __builtin_popcountll(em & below); if (p_ == pre && pos_ < 256) cbuf[pos_] = u[i]; nc += __builtin_popcountll(em); } )
    int kneed = 256 - cgt;
    if (nc <= 256) {
        asm volatile("s_waitcnt lgkmcnt(0)" ::: "memory");
        unsigned c0 = lane < nc ? cbuf[lane] : 0u, c1 = 64 + lane < nc ? cbuf[64 + lane] : 0u, c2 = 128 + lane < nc ? cbuf[128 + lane] : 0u, c3 = 192 + lane < nc ? cbuf[192 + lane] : 0u;
#pragma unroll 1
        for (int bit = 19; bit >= 0; --bit) { const unsigned cand = T | (1u << bit);
            int cnt = __builtin_popcountll(__ballot(c0 >= cand));
            if (nc > 64) cnt += __builtin_popcountll(__ballot(c1 >= cand));
            if (nc > 128) cnt += __builtin_popcountll(__ballot(c2 >= cand)) + __builtin_popcountll(__ballot(c3 >= cand));
            if (cnt >= kneed) T = cand; }
        const int cg2 = __builtin_popcountll(__ballot(c0 > T)) + __builtin_popcountll(__ballot(c1 > T)) + __builtin_popcountll(__ballot(c2 > T)) + __builtin_popcountll(__ballot(c3 > T));
        kneed -= cg2;
    } else {
#pragma unroll 1
        for (int bit = 19; bit >= 0; --bit) { const unsigned cand = T | (1u << bit); int cnt = 0;
            TK_FOR_VALID( cnt += __builtin_popcountll(__ballot(u[i] >= cand)); )
            if (cnt >= 256) T = cand; }
        int cg2 = 0;
        TK_FOR_VALID( cg2 += __builtin_popcountll(__ballot(u[i] > T)); )
        kneed = 256 - cg2;
    }
    int run = 0;
#pragma unroll
    for (int i = 0; i < 64; ++i) { const bool gt = u[i] > T, eq = u[i] == T; const unsigned long long eqm = __ballot(eq);
        const int rank = run + __builtin_popcountll(eqm & below); const bool sel = gt || (eq && rank < kneed); run += __builtin_popcountll(eqm);
        const unsigned long long w = __ballot(sel); mword = (lane == i) ? w : mword; }
    mrow[lane] = mword;
}
#undef TK_FOR_VALID
constexpr int CONV_MOE_ITEMS = 32 * (32 * 16) + 32 * (8 * 32);
#ifndef CONV_STATIC_ITEMS
#define CONV_STATIC_ITEMS 0
#endif
constexpr int CONV_STATIC = CONV_STATIC_ITEMS;
constexpr int CONV_LATE_ITEMS = CONV_MOE_ITEMS + 32 * (NP1 / 64) + 32 * 32 + CONV_MOE_ITEMS;
#ifndef CONV_TAIL_ITEMS
#define CONV_TAIL_ITEMS 12288
#endif
#ifndef CONV_BIG_ITEMS
#define CONV_BIG_ITEMS 32768
#endif
constexpr int CONV_BIG = CONV_BIG_ITEMS;
constexpr int CONV_SPLIT = CONV_LATE_ITEMS - CONV_TAIL_ITEMS;
__device__ __forceinline__ TrItem conv_moe_desc(const Args& a, unsigned char* ws, int layer, int it) {
    if (it < 32 * 512) {
        const int ex = layer * 32 + it / 512, r = it % 512, blk = r >> 5, jj = r & 31, kb = (blk >> 2) * 8 + (jj >> 2), nb = (blk & 3) * 4 + (jj & 3), n0 = nb * 64, tile = n0 >> 8, j = n0 & 255;
        const float* W = (j < 128 ? a.in[17] : a.in[18]) + (size_t)ex * 2048 * 512;
        return TrItem{W, (bf16*)(ws + WS_WGU) + (size_t)ex * 1024 * 2048, 512, 128 * tile + (j & 127), 128 * tile + (j & 127) + 32, 2048, n0, kb * 64};
    }
    const int i2 = it - 32 * 512, ex = layer * 32 + i2 / 256, r = i2 % 256, blk = r >> 5, jj = r & 31, kb = jj >> 2, nb = blk * 4 + (jj & 3);
    return TrItem{a.in[19] + (size_t)ex * 512 * 2048, (bf16*)(ws + WS_WD) + (size_t)ex * 2048 * 512, 2048, nb * 64, nb * 64 + 32, 512, nb * 64, kb * 64};
}
__device__ __forceinline__ TrItem conv_late_desc(const Args& a, unsigned char* ws, int it) {
    if (it < CONV_MOE_ITEMS) return conv_moe_desc(a, ws, 0, it);
    it -= CONV_MOE_ITEMS;
    if (it < 32 * (NP1 / 64)) { const int kb = it / (NP1 / 64), nb = it % (NP1 / 64), n0 = nb * 64;
        return TrItem{a.in[7], (bf16*)(ws + WS_WINC), NE1, l1_src_col(n0), l1_src_col(n0 + 32), 2048, n0, kb * 64}; }
    it -= 32 * (NP1 / 64);
    if (it < 32 * 32) { const int kb = it / 32, nb = it % 32; return TrItem{a.in[8], (bf16*)(ws + WS_WOC), 2048, nb * 64, nb * 64 + 32, 2048, nb * 64, kb * 64}; }
    return conv_moe_desc(a, ws, 1, it - 32 * 32);
}
template <int CHUNK>
__device__ __forceinline__ void late_conv_items(Frame& F, const Args& a, const int lo, const int hi, const int ctr) {
    LAS bf16* T = (LAS bf16*)(F.lds + F.wave * 16384); volatile LAS int* slot = (volatile LAS int*)(F.lds + 131072 + 512);
    for (;;) {
        __syncthreads();
        if (F.tid == 0) *slot = lo + (int)atomicAdd(F.ctl + CW_FILL + 64 * ctr, (unsigned)CHUNK);
        __syncthreads();
        const int base = *slot;
        if (base >= hi) break;
        f32x4 rA[16], rB[16];
        TrItem tA = conv_late_desc(a, F.ws, base + F.wave), tB = tA; tr64_load(tA, rA, F.lane);
#pragma unroll 1
        for (int j = 0; j < CHUNK / 8; j += 2) {
            tB = conv_late_desc(a, F.ws, base + F.wave + 8 * (j + 1)); tr64_load(tB, rB, F.lane);
            tr64_store(tA, rA, T, F.lane);
            if (j + 2 < CHUNK / 8) { tA = conv_late_desc(a, F.ws, base + F.wave + 8 * (j + 2)); tr64_load(tA, rA, F.lane); }
            tr64_store(tB, rB, T, F.lane);
        }
    }
    __syncthreads();
}
static_assert(CONV_LATE_ITEMS % 64 == 0 && CONV_STATIC == 0 && CONV_BIG % 64 == 0 && CONV_SPLIT % 16 == 0 && CONV_BIG <= CONV_SPLIT, "filler chunks");
__device__ __forceinline__ void p0_prologue(Frame& F, const Args& a) {
    const int gw = F.gw, NGW = F.NGW, lane = F.lane;
    unsigned char* ws = F.ws;
    LAS bf16* T = (LAS bf16*)(F.lds + F.wave * 16384);
    {
        const float* W = a.in[1]; bf16* WT = (bf16*)(ws + WS_WINA);
        for (int it = gw; it < 32 * (NP0 / 64); it += NGW) { const int kb = it / (NP0 / 64), nb = it % (NP0 / 64), n0 = nb * 64; const int c0 = n0 < 3072 ? n0 : n0 + 16; transpose_item64(W, NE0, c0, c0 + 32, 2048, WT, n0, kb * 64, T, lane); }
    }
    {
        for (int it = gw; it < 32 * 32; it += NGW) { const int kb = it / 32, nb = it % 32; transpose_item64(a.in[6], 2048, nb * 64, nb * 64 + 32, 2048, (bf16*)(ws + WS_WOA), nb * 64, kb * 64, T, lane); }
    }
    for (int it = gw; it < CONV_STATIC; it += NGW) { const TrItem t = conv_late_desc(a, ws, it); f32x4 r16[16]; tr64_load(t, r16, lane); tr64_store(t, r16, T, lane); }
    const int gt = blockIdx.x * (NWAVES * 64) + F.tid, NGT = F.G * NWAVES * 64;
    {   float* c128 = (float*)(ws + WS_ROPE); float* s128 = c128 + 4096 * 64; float* c64 = s128 + 4096 * 64; float* s64 = c64 + 4096 * 32;
        for (int i = gt; i < 4096 * 96; i += NGT) { int pos, idx, half; float* cp; float* sp;
            if (i < 4096 * 64) { pos = i >> 6; idx = i & 63; half = 64; cp = c128 + i; sp = s128 + i; } else { const int r = i - 4096 * 64; pos = r >> 5; idx = r & 31; half = 32; cp = c64 + r; sp = s64 + r; }
            const float inv = exp2f(-(float)idx / (float)half * 13.287712379549449f);
            const float ang = (float)pos * inv;
            double rv = (double)ang * 0.15915494309189535; rv -= rint(rv);
            const float rf = (float)rv;
            *cp = __builtin_amdgcn_cosf(rf); *sp = __builtin_amdgcn_sinf(rf); }
    }
    {   bf16* SKH = (bf16*)(ws + WS_WSM); bf16* SKL = SKH + (size_t)SK_NCOL * 2048;
        for (int i = gt; i < 2048 * SK_NCOL; i += NGT) { const int k = i / SK_NCOL, c = i % SK_NCOL; float v = 0.f;
            if (c < 96) { const int l = c / 48, j = c % 48; if (j < 4) v = a.in[13][((size_t)l * 2048 + k) * 4 + j]; else if (j < 36) { const int g = (j - 4) >> 3, e = (j - 4) & 7; v = a.in[15][(((size_t)l * 4 + g) * 2048 + k) * 8 + e]; } }
            else if (c < 128) { const int j = c - 96; if (j < 16) v = a.in[1][(size_t)k * NE0 + 3072 + j]; else if (j < 24) v = a.in[1][(size_t)k * NE0 + 6160 + j - 16]; }
            else v = a.in[7][(size_t)k * NE1 + 4096 + c - 128];
            const unsigned h = f2bf(v); SKH[(size_t)c * 2048 + k] = (bf16)h; SKL[(size_t)c * 2048 + k] = (bf16)f2bf(v - bf2f((unsigned short)h)); }
    }
    {   const float* x = a.in[0]; bf16* XB = (bf16*)(ws + WS_XB);
        for (int m = gw; m < MTOK; m += NGW) { f32x4 v[8];
#pragma unroll
            for (int j = 0; j < 8; ++j) v[j] = *(const f32x4*)(x + (size_t)m * DM + 256 * j + 4 * lane);
            store_row_bf16(XB + (size_t)m * DM, v, lane); }
    }
}
__device__ __forceinline__ void p_skinny0(Frame& F, const Args& a) {
    const bf16* SKH = (const bf16*)(F.ws + WS_WSM) + (size_t)SK_SK0 * 2048; const bf16* SKL = SKH + (size_t)SK_NCOL * 2048; float* SK0 = (float*)(F.ws + WS_SK0);
    const LAS float* LG = (const LAS float*)(F.lds + SK_LG_OFF);
    for (int blk = blockIdx.x; blk < MTOK / 32; blk += F.G) { const int R0 = blk * 32;
        __syncthreads();
        skinny_partials<2>(F.lds, (const bf16*)(F.ws + WS_XB) + (size_t)R0 * DM, SKH, SKL, F.wave, F.lane);
        __syncthreads();
        skinny_reduce<2>(F.lds, F.tid);
        __syncthreads();
        for (int idx = F.tid; idx < 32 * 24; idx += NWAVES * 64) { const int row = idx / 24, c = idx % 24; SK0[(size_t)(R0 + row) * 24 + c] = LG[row * 32 + c]; }
    }
    __syncthreads();
}
__device__ __forceinline__ void p_fox_bias(Frame& F, const Args& a) {
    if (blockIdx.x >= 16) return;
    const int bh = blockIdx.x, b = bh >> 3, h = bh & 7, lane = F.lane, tid = F.tid; const float gb = a.in[5][h];
    const float* SK0 = (const float*)(F.ws + WS_SK0); float* FB = (float*)(F.ws + WS_FBIAS) + (size_t)bh * SEQ; LAS float* wt = (LAS float*)(F.lds + 120000);
    float lf[8], tot = 0.f;
#pragma unroll
    for (int i = 0; i < 8; ++i) lf[i] = SK0[(size_t)(b * SEQ + tid * 8 + i) * 24 + 16 + h];
#pragma unroll
    for (int i = 0; i < 8; ++i) { tot += logsigmoidf(lf[i] + gb); lf[i] = tot; }
    float incl = tot;
#pragma unroll
    for (int o = 1; o < 64; o <<= 1) { const float t = __shfl_up(incl, o); if (lane >= o) incl += t; }
    if (lane == 63) wt[F.wave] = incl;
    __syncthreads();
    float pre = incl - tot;
    for (int w = 0; w < F.wave; ++w) pre += wt[w];
#pragma unroll
    for (int i = 0; i < 8; ++i) FB[tid * 8 + i] = -(pre + lf[i]) * (1.0f / ATT_SCALE);
    __syncthreads();
}
__device__ __forceinline__ void p_ln_route(Frame& F, const Args& a, int layer) {
    const bf16* YB = (const bf16*)(F.ws + WS_YB); bf16* XB = (bf16*)(F.ws + WS_XB); const int lane = F.lane;
    const float* g = a.in[9] + layer * DM; const float* bb = a.in[10] + layer * DM;
    const bf16* SKH = (const bf16*)(F.ws + WS_WSM) + (size_t)(layer ? SK_ROUTE1 : SK_ROUTE0) * 2048; const bf16* SKL = SKH + (size_t)SK_NCOL * 2048;
    const float* bg = a.in[14] + layer * 4; const float* be = a.in[16] + layer * 32;
    int4* ROUTE = (int4*)(F.ws + WS_ROUTE); unsigned* cnt = F.ctl + CW_CNT + layer * 64; int* INV = (int*)(F.ws + WS_INV); float* WINV = (float*)(F.ws + WS_WINV);
    const LAS float* LG = (const LAS float*)(F.lds + SK_LG_OFF);
    for (int blk = blockIdx.x; blk < MTOK / 32; blk += F.G) { const int R0 = blk * 32;
#pragma unroll 1
        for (int i2 = 0; i2 < 4; i2 += 2) {
            f32x4 v[2][8];
#pragma unroll
            for (int i = 0; i < 2; ++i) load_row_bf16(YB + (size_t)(R0 + 4 * F.wave + i2 + i) * DM, v[i], lane);
#pragma unroll
            for (int i = 0; i < 2; ++i) ln_row(v[i], g, bb, lane);
#pragma unroll
            for (int i = 0; i < 2; ++i) store_row_bf16(XB + (size_t)(R0 + 4 * F.wave + i2 + i) * DM, v[i], lane);
        }
        __syncthreads();
        skinny_partials<3, false>(F.lds, XB + (size_t)R0 * DM, SKH, SKL, F.wave, lane);
        __syncthreads();
        skinny_reduce<3>(F.lds, F.tid);
        __syncthreads();
        if (F.tid < 32) { const int m = R0 + F.tid; const LAS float* l = LG + F.tid * 48;
            float gl[4];
#pragma unroll
            for (int i = 0; i < 4; ++i) gl[i] = l[i] + bg[i];
            int gi = 0; float gm = gl[0];
#pragma unroll
            for (int i = 1; i < 4; ++i) if (gl[i] > gm) { gm = gl[i]; gi = i; }
            float gs = 0.f;
#pragma unroll
            for (int i = 0; i < 4; ++i) gs += __expf(gl[i] - gm);
            const float gp = 1.0f / gs;
            float el[8];
#pragma unroll
            for (int e = 0; e < 8; ++e) el[e] = l[4 + 8 * gi + e] + be[gi * 8 + e];
            int e1 = 0; float v1 = el[0];
#pragma unroll
            for (int e = 1; e < 8; ++e) if (el[e] > v1) { v1 = el[e]; e1 = e; }
            int e2 = -1; float v2 = -3.0e38f;
#pragma unroll
            for (int e = 0; e < 8; ++e) if (e != e1 && el[e] > v2) { v2 = el[e]; e2 = e; }
            const float w1 = gp / (1.0f + __expf(v2 - v1)), w2 = gp - w1;
            const int ge1 = gi * 8 + e1, ge2 = gi * 8 + e2;
            LAS unsigned* hist = (LAS unsigned*)(F.lds + SK_LG_OFF + 32 * 48 * 4); LAS unsigned* ebase = hist + 32;
            hist[F.tid] = 0u;
            const unsigned r1 = __hip_atomic_fetch_add(hist + ge1, 1u, __ATOMIC_RELAXED, __HIP_MEMORY_SCOPE_WORKGROUP), r2 = __hip_atomic_fetch_add(hist + ge2, 1u, __ATOMIC_RELAXED, __HIP_MEMORY_SCOPE_WORKGROUP);
            const unsigned hc = hist[F.tid];
            ebase[F.tid] = hc ? atomicAdd(cnt + F.tid, hc) : 0u;
            const int p1 = (int)(ebase[ge1] + r1), p2 = (int)(ebase[ge2] + r2);
            ROUTE[(size_t)m * 2 + 0] = make_int4(ge1, p1, 0, 0); ROUTE[(size_t)m * 2 + 1] = make_int4(ge2, p2, 0, 0);
            INV[ge1 * 8192 + p1] = m; INV[ge2 * 8192 + p2] = m; WINV[ge1 * 8192 + p1] = w1; WINV[ge2 * 8192 + p2] = w2; }
    }
    __syncthreads();
}
__device__ __forceinline__ int moe_offsets(const unsigned* cnt, int lane, int* tiles_incl) {
    const int c = lane < 32 ? (int)cnt[lane] : 0; const int t = (c + 255) >> 8; int incl = t;
#pragma unroll
    for (int o = 1; o < 32; o <<= 1) { const int x = __shfl_up(incl, o); if ((lane & 31) >= o) incl += x; }
    *tiles_incl = incl; return (incl - t) * 256;
}
__device__ __forceinline__ void p_ln_ffn(Frame& F, const Args& a, int layer) {
    bf16* XB = (bf16*)(F.ws + WS_XB); const int lane = F.lane; const bf16* YG = (const bf16*)(F.ws + WS_CST);
    const float* g = a.in[11] + layer * DM; const float* bb = a.in[12] + layer * DM; const int4* ROUTE = (const int4*)(F.ws + WS_ROUTE);
    const bf16* SKH = (const bf16*)(F.ws + WS_WSM) + (size_t)SK_SK1 * 2048; const bf16* SKL = SKH + (size_t)SK_NCOL * 2048;
    const float* c64 = (const float*)(F.ws + WS_ROPE) + 2 * 4096 * 64; const float* s64 = c64 + 4096 * 32;
    bf16* IK = (bf16*)(F.ws + WS_IK); float* IW = (float*)(F.ws + WS_IW);
    const LAS float* LG = (const LAS float*)(F.lds + SK_LG_OFF);
    int ti_; const int eoff = moe_offsets(F.ctl + CW_CNT + layer * 64, lane, &ti_);
    for (int blk = blockIdx.x; blk < MTOK / 32; blk += F.G) { const int R0 = blk * 32;
#pragma unroll 2
        for (int i = 0; i < 4; ++i) { const int m = R0 + 4 * F.wave + i; f32x4 v[8];
            const int4 q0 = ROUTE[(size_t)m * 2], q1 = ROUTE[(size_t)m * 2 + 1]; const int r0 = __shfl(eoff, q0.x) + q0.y, r1 = __shfl(eoff, q1.x) + q1.y;
            load_row_bf16(XB + (size_t)m * DM, v, lane);
#pragma unroll
            for (int j = 0; j < 8; ++j) { v[j] = v[j] * DN_ALPHA;
                const uint2 y0 = *(const uint2*)(YG + (size_t)r0 * DM + 256 * j + 4 * lane), y1 = *(const uint2*)(YG + (size_t)r1 * DM + 256 * j + 4 * lane);
                v[j][0] += bf2f(y0.x & 0xffff) + bf2f(y1.x & 0xffff); v[j][1] += bf2f(y0.x >> 16) + bf2f(y1.x >> 16);
                v[j][2] += bf2f(y0.y & 0xffff) + bf2f(y1.y & 0xffff); v[j][3] += bf2f(y0.y >> 16) + bf2f(y1.y >> 16); }
            ln_row(v, g, bb, lane);
            if (layer == 0) store_row_bf16(XB + (size_t)m * DM, v, lane);
            else {
#pragma unroll
                for (int j = 0; j < 8; ++j) *(f32x4*)(a.out + (size_t)m * DM + 256 * j + 4 * lane) = v[j]; } }
        if (layer == 0) {
            __syncthreads();
            skinny_partials<5, false>(F.lds, XB + (size_t)R0 * DM, SKH, SKL, F.wave, lane);
            __syncthreads();
            skinny_reduce<5>(F.lds, F.tid);
            __syncthreads();
            for (int idx = F.tid; idx < 32 * 80; idx += NWAVES * 64) { const int row = idx / 80, c = idx % 80, m = R0 + row; const float v = LG[row * 80 + c];
                if (c < 64) { const float part = LG[row * 80 + (c ^ 32)]; const int pos = m & 4095, i = c & 31; const float cs = c64[pos * 32 + i], sn = s64[pos * 32 + i];
                    const int bq = m >> 12, sq = m & 4095; IK[((((size_t)bq * 128 + (sq >> 5)) * 4 + (c >> 4)) * 64 + ((c >> 3) & 1) * 32 + (sq & 31)) * 8 + (c & 7)] = (bf16)f2bf(c < 32 ? (v * cs - part * sn) : (v * cs + part * sn)); }
                else IW[(size_t)m * 16 + c - 64] = v * 0.25f * 0.125f; }
        }
    }
    __syncthreads();
}
__device__ __forceinline__ void ph_gla_b(Frame& F, const Args& a) {
    const float* SK0 = (const float*)(F.ws + WS_SK0); const float* w2 = a.in[2]; const float* gbias = a.in[3]; float* GB = (float*)(F.ws + WS_GB); float* DEC = (float*)(F.ws + WS_DEC);
    for (int u4 = blockIdx.x; u4 < 128; u4 += F.G) {
        const int unit = u4 * 4 + (F.tid >> 7), n = unit & 63, bh = unit >> 6, b = bh >> 2, h = bh & 3, d = F.tid & 127, t0 = b * SEQ + n * 64;
        float w[16];
#pragma unroll
        for (int r = 0; r < 16; ++r) w[r] = w2[r * 512 + h * 128 + d];
        const float gb = gbias[h * 128 + d]; float run = 0.f;
        for (int c = 0; c < 64; ++c) { const int t = t0 + c; float z = gb;
#pragma unroll
            for (int r = 0; r < 16; ++r) z += SK0[(size_t)t * 24 + r] * w[r];
            run += logsigmoidf(z) * (1.0f / 16.0f); GB[(size_t)t * 512 + h * 128 + d] = run; }
        DEC[unit * 128 + d] = __expf(run);
    }
}
__device__ __forceinline__ void ph_gla_state(Frame& F) {
    const bf16* PROJ = (const bf16*)(F.ws + WS_PROJ); const float* GB = (const float*)(F.ws + WS_GB); float* CST = (float*)(F.ws + WS_CST);
    for (int vb = blockIdx.x; vb < 512 * 64; vb += F.G) {
        const int unit = vb >> 6, d = (vb & 63) * 2 + (F.tid >> 8), v = F.tid & 255, n = unit & 63, bh = unit >> 6, b = bh >> 2, h = bh & 3, t0 = b * SEQ + n * 64;
        const float blast = GB[(size_t)(t0 + 63) * 512 + h * 128 + d]; float acc = 0.f;
        for (int c = 0; c < 64; ++c) { const size_t t = t0 + c; const float kk = bf2f(PROJ[t * NP0 + 512 + h * 128 + d]) * __expf(blast - GB[t * 512 + h * 128 + d]);
            acc += kk * bf2f(PROJ[t * NP0 + 1024 + h * 256 + v]); }
        CST[((size_t)unit * 256 + v) * 128 + d] = acc;
    }
}
__device__ __forceinline__ void ph_gla_scan(Frame& F) {
    const bf16* __restrict__ CST = (const bf16*)(F.ws + WS_CST); const float* __restrict__ DEC = (const float*)(F.ws + WS_DEC); bf16* __restrict__ PREVT = (bf16*)(F.ws + WS_PREVT);
    for (int idx = blockIdx.x * 512 + F.tid; idx < 8 * 16384; idx += F.G * 512) { const int bh = idx >> 14, vd = (idx & 16383) * 2, d = vd & 127; float S0 = 0.f, S1 = 0.f;
#pragma unroll 1
        for (int n0 = 0; n0 < 64; n0 += 8) { unsigned c[8]; float2 dc[8];
#pragma unroll
            for (int j = 0; j < 8; ++j) { const int unit = bh * 64 + n0 + j; c[j] = *(const unsigned*)(CST + (size_t)unit * 32768 + vd); dc[j] = *(const float2*)(DEC + unit * 128 + d); }
#pragma unroll
            for (int j = 0; j < 8; ++j) { const int unit = bh * 64 + n0 + j; *(unsigned*)(PREVT + (size_t)unit * 32768 + vd) = pk2(S0, S1);
                S0 = dc[j].x * S0 + bf2f(c[j] & 0xffff); S1 = dc[j].y * S1 + bf2f(c[j] >> 16); } } }
}
__device__ __forceinline__ void ph_gla_out(Frame& F, const Args& a) {
    const bf16* PROJ = (const bf16*)(F.ws + WS_PROJ); const float* GB = (const float*)(F.ws + WS_GB); const bf16* PREVT = (const bf16*)(F.ws + WS_PREVT); const float* normg = a.in[4]; bf16* OMIX = (bf16*)(F.ws + WS_OMIX);
    LAS float* qd = (LAS float*)F.lds; LAS float* ki = qd + 64 * 128; LAS float* sc = ki + 64 * 128; LAS float* red = sc + 64 * 64;
    const int tid = F.tid; const bool act = tid < 256;
    for (int unit = blockIdx.x; unit < 512; unit += F.G) {
        const int n = unit & 63, bh = unit >> 6, b = bh >> 2, h = bh & 3, t0 = b * SEQ + n * 64;
        __syncthreads();
        for (int i = tid; i < 64 * 128; i += 512) { const int c = i >> 7, d = i & 127; const size_t t = t0 + c; const float bb = GB[t * 512 + h * 128 + d];
            qd[i] = bf2f(PROJ[t * NP0 + h * 128 + d]) * ATT_SCALE * __expf(bb); ki[i] = bf2f(PROJ[t * NP0 + 512 + h * 128 + d]) * __expf(-bb); }
        __syncthreads();
        for (int p = tid; p < 64 * 64; p += 512) { const int i = p >> 6, j = p & 63; float s = 0.f;
            if (j <= i) for (int d = 0; d < 128; ++d) s += qd[i * 128 + d] * ki[j * 128 + d];
            sc[p] = s; }
        __syncthreads();
        const int v = tid & 255; const bf16* pv = PREVT + ((size_t)unit * 256 + v) * 128; const float gv = normg[v];
        for (int i = 0; i < 64; ++i) { float acc = 0.f;
            if (act) { for (int j = 0; j <= i; ++j) acc += sc[i * 64 + j] * bf2f(PROJ[(size_t)(t0 + j) * NP0 + 1024 + h * 256 + v]);
                for (int d = 0; d < 128; ++d) acc += qd[i * 128 + d] * bf2f(pv[d]);
                const float ss = wave_sum(acc * acc); if ((tid & 63) == 0) red[tid >> 6] = ss; }
            __syncthreads();
            const float ms = (red[0] + red[1] + red[2] + red[3]) * (1.0f / 256.0f); __syncthreads();
            if (act) { const float gr = bf2f(PROJ[(size_t)(t0 + i) * NP0 + 2048 + h * 256 + v]);
                const float o = acc * (1.0f / sqrtf(ms + LN_EPS)) * gv * (gr / (1.0f + __expf(-gr)));
                OMIX[(size_t)(t0 + i) * DM + h * 256 + v] = (bf16)f2bf(o); } }
    }
}
template <int MODE  >
__device__ __forceinline__ void ph_attn_naive(Frame& F, const bf16* Qb, int ldq, int qc0, const bf16* Kb, int ldk, int kc0, const bf16* Vb, int ldv, int vc0, int nheads, int group,
                                              const float* fbias, const unsigned long long* mask, bf16* O, int oc0) {
    const int half = F.tid >> 8, tid = F.tid & 255, qi = tid >> 2, part = tid & 3;
    LAS bf16* Ks = (LAS bf16*)(F.lds + half * 32768); LAS bf16* Vs = Ks + 64 * 128;
    const int nvb = (SEQ / 64) * (nheads / 2) * BATCH;
    for (int vb = blockIdx.x; vb < nvb; vb += F.G) {
        const int cc = vb >> 6, qb = ((vb & 63) + cc * 17) & 63, hp = cc % (nheads / 2), b = cc / (nheads / 2), h = hp * 2 + half, kvh = h / group;
        const int qpos = qb * 64 + qi; const size_t row = (size_t)b * SEQ + qpos;
        float qv[32], o[32];
#pragma unroll
        for (int d = 0; d < 32; ++d) { qv[d] = bf2f(Qb[row * ldq + qc0 + h * 128 + part * 32 + d]); o[d] = 0.f; }
        float mrun = -1e30f, l = 0.f;
        const float* fb = MODE == 0 ? fbias + (size_t)(b * 8 + h) * SEQ : nullptr;
        for (int kt = 0; kt <= qb; ++kt) {
            __syncthreads();
            for (int i = tid; i < 64 * 16; i += 256) { const int r = i >> 4, c8 = (i & 15) * 8; const size_t kr = (size_t)b * SEQ + kt * 64 + r;
                *(LAS v4u*)(Ks + r * 128 + c8) = *(const v4u*)(Kb + kr * ldk + kc0 + kvh * 128 + c8); *(LAS v4u*)(Vs + r * 128 + c8) = *(const v4u*)(Vb + kr * ldv + vc0 + kvh * 128 + c8); }
            __syncthreads();
            unsigned long long mw = ~0ull; if (MODE == 1) mw = mask[row * 64 + kt];
            for (int s = 0; s < 64; ++s) { const int key = kt * 64 + s; float p = 0.f;
#pragma unroll
                for (int d = 0; d < 32; ++d) p += qv[d] * bf2f(Ks[s * 128 + part * 32 + d]);
                p += __shfl_xor(p, 1); p += __shfl_xor(p, 2);
                const bool valid = key <= qpos && ((mw >> s) & 1ull);
                if (valid) { const float logit = (p + (MODE == 0 ? fb[key] : 0.f)) * ATT_SCALE; const float mn = fmaxf(mrun, logit), al = __expf(mrun - mn), pp = __expf(logit - mn);
                    l = l * al + pp; mrun = mn;
#pragma unroll
                    for (int d = 0; d < 32; ++d) o[d] = o[d] * al + pp * bf2f(Vs[s * 128 + part * 32 + d]); } }
        }
        const float il = 1.0f / l;
#pragma unroll
        for (int d = 0; d < 32; ++d) O[row * DM + oc0 + h * 128 + part * 32 + d] = (bf16)f2bf(o[d] * il);
    }
    __syncthreads();
}
__device__ __forceinline__ void ph_idx_scores(Frame& F) {
    const bf16* PROJ1 = (const bf16*)(F.ws + WS_PROJ); const bf16* IK = (const bf16*)(F.ws + WS_IK); const float* IW = (const float*)(F.ws + WS_IW); float* SC = (float*)(F.ws + WS_SC);
    LAS float* q = (LAS float*)F.lds; LAS float* w = q + 1024; const int tid = F.tid;
    for (int m = blockIdx.x; m < MTOK; m += F.G) { const int pos = m & 4095, b = m >> 12;
        __syncthreads();
        for (int i = tid; i < 1024; i += 512) q[i] = bf2f(PROJ1[(size_t)m * NP1 + 3072 + i]);
        if (tid < 16) w[tid] = IW[(size_t)m * 16 + tid];
        __syncthreads();
        for (int s = tid; s <= pos; s += 512) { const bf16* kr = IK + ((size_t)b * SEQ + s) * 64; float kk[64];
#pragma unroll
            for (int d = 0; d < 64; ++d) kk[d] = bf2f(kr[d]);
            float sc = 0.f;
#pragma unroll 1
            for (int hh = 0; hh < 16; ++hh) { float dsum = 0.f;
#pragma unroll
                for (int d = 0; d < 64; ++d) dsum += q[hh * 64 + d] * kk[d];
                sc += w[hh] * fmaxf(dsum, 0.f); }
            SC[(size_t)m * SEQ + s] = sc; }
    }
    __syncthreads();
}
namespace attn {
constexpr int D = 128, NW = 8, QBLK = 32, KVBLK = 64, QB = NW * QBLK;
constexpr int SHM_V = KVBLK * D * 2, SHM_K = KVBLK * D * 2;
constexpr int OFF_WS = 2 * SHM_V + 2 * SHM_K, OFF_BIAS = OFF_WS + NW * 64 * 4, LDS_NEED = OFF_BIAS + 2 * 16384;
constexpr float SCALE = 0.08838834764831845f, THR = 8.f;
typedef short s16x4 __attribute__((ext_vector_type(4)));
typedef float f32x16 __attribute__((ext_vector_type(16)));
typedef unsigned u32x4 __attribute__((ext_vector_type(4)));
#define KSWZ(row, colB) ((row) * 256 + ((colB) ^ (((row) & 7) << 4)))
#define SBAR() __builtin_amdgcn_sched_barrier(0)
__device__ __forceinline__ int v_st(int k, int c) { const int kk = (k & ~0xC) | ((k & 4) << 1) | ((k & 8) >> 1); return ((kk >> 3) * 4 + (c >> 5)) * 512 + ((kk & 7) * 32 + (c & 31)) * 2; }
__device__ __forceinline__ int v_rd_base(int lane) { return ((lane & 3) << 3) | (((lane >> 2) & 3) << 6) | (((lane >> 4) & 1) << 5) | (((lane >> 5) & 1) << 8); }
constexpr int v_rd_off(int d0, int ks, int half) { return d0 * 512 + ks * 4096 + half * 2048; }
__device__ __forceinline__ int crow(int r, int hi) { return (r & 3) + 8 * (r >> 2) + 4 * hi; }
__device__ __forceinline__ unsigned cvtpk(float lo, float hi) { unsigned r; asm volatile("v_cvt_pk_bf16_f32 %0, %1, %2" : "=v"(r) : "v"(lo), "v"(hi)); return r; }
__device__ __forceinline__ bf16x8 load8(const bf16* p) { return *reinterpret_cast<const bf16x8*>(p); }
__device__ __forceinline__ void mask_tile(f32x16& p0, f32x16& p1, int dq) {
    const float NEG = -__builtin_inff();
#pragma unroll
    for (int r = 0; r < 16; ++r) { const int c = (r & 3) + 8 * (r >> 2); if (dq - c < 0) p0[r] = NEG; if (dq - c - 32 < 0) p1[r] = NEG; }
}
__device__ __forceinline__ void mask_bits(f32x16& p0, f32x16& p1, unsigned w0, unsigned w1) {
#pragma unroll
    for (int r = 0; r < 16; ++r) { const unsigned c = (r & 3) + 8 * (r >> 2);
        const unsigned m0 = (unsigned)__builtin_amdgcn_sbfe((int)w0, c, 1), m1 = (unsigned)__builtin_amdgcn_sbfe((int)w1, c, 1);
        p0[r] = __uint_as_float((m0 & __float_as_uint(p0[r])) | (~m0 & 0xFF800000u)); p1[r] = __uint_as_float((m1 & __float_as_uint(p1[r])) | (~m1 & 0xFF800000u)); }
}
__device__ __forceinline__ void partialSM(f32x16& p0, f32x16& p1, float& m_reg, float& mn, float& alpha) {
    float pmax = p0[0]; for (int r = 1; r < 16; ++r) pmax = fmaxf(pmax, p0[r]); for (int r = 0; r < 16; ++r) pmax = fmaxf(pmax, p1[r]);
    { auto rr = __builtin_amdgcn_permlane32_swap(__float_as_uint(pmax), __float_as_uint(pmax), false, false);
      pmax = fmaxf(__uint_as_float(rr[0]), __uint_as_float(rr[1])); }
    constexpr float C2 = 1.4426950408889634f * SCALE;
    if (__builtin_expect(__all((pmax - m_reg) * SCALE <= THR), 1)) { mn = m_reg; alpha = 1.f; }
    else { mn = fmaxf(m_reg, pmax); alpha = __builtin_amdgcn_exp2f((m_reg - mn) * C2); m_reg = mn; }
    const float mnL = -mn * C2;
    for (int r = 0; r < 16; ++r) p0[r] = fmaf(p0[r], C2, mnL); for (int r = 0; r < 16; ++r) p1[r] = fmaf(p1[r], C2, mnL);
    for (int r = 0; r < 16; ++r) p0[r] = __builtin_amdgcn_exp2f(p0[r]);
}
__device__ __forceinline__ void finishSM(f32x16& p0, f32x16& p1, float alpha, float& l_reg, bf16x8& pa0, bf16x8& pa1, bf16x8& pa2, bf16x8& pa3) {
    for (int r = 0; r < 16; ++r) p1[r] = __builtin_amdgcn_exp2f(p1[r]);
    float ps = 0; for (int r = 0; r < 16; ++r) ps += p0[r]; for (int r = 0; r < 16; ++r) ps += p1[r];
    { auto rr = __builtin_amdgcn_permlane32_swap(__float_as_uint(ps), __float_as_uint(ps), false, false);
      ps = __uint_as_float(rr[0]) + __uint_as_float(rr[1]); }
    l_reg = l_reg * alpha + ps;
#define PK4(P, B_, OUT) do { unsigned a0 = cvtpk(P[B_+0], P[B_+1]), a1 = cvtpk(P[B_+2], P[B_+3]);                          \
        unsigned b0 = cvtpk(P[B_+4], P[B_+5]), b1 = cvtpk(P[B_+6], P[B_+7]);                                             \
        auto r0 = __builtin_amdgcn_permlane32_swap(a0, b0, false, false); auto r1 = __builtin_amdgcn_permlane32_swap(a1, b1, false, false); \
        u32x4 w = {r0[0], r1[0], r0[1], r1[1]}; OUT = *reinterpret_cast<bf16x8*>(&w); } while (0)
    PK4(p0, 0, pa0); PK4(p0, 8, pa1); PK4(p1, 0, pa2); PK4(p1, 8, pa3);
#undef PK4
}
template <int KB, bool BIAS>
__device__ __forceinline__ void qkt(f32x16& p0, f32x16& p1, const char* K_lds, int r32, int hi, const bf16x8* qr, const char* bl) {
    p0 = f32x16{}; p1 = f32x16{}; (void)bl;
    const char* kb[4];
#pragma unroll
    for (int dd = 0; dd < 4; ++dd) kb[dd] = K_lds + KB * SHM_K + KSWZ(r32, (dd * 16 + hi * 8) * 2);
#pragma unroll
    for (int d0 = 0; d0 < 8; ++d0) { const char* a = kb[d0 & 3] + (d0 >> 2) * 128;
        bf16x8 b0 = *reinterpret_cast<const bf16x8*>(a);
        bf16x8 b1 = *reinterpret_cast<const bf16x8*>(a + 32 * 256);
        p0 = __builtin_amdgcn_mfma_f32_32x32x16_bf16(b0, qr[d0], p0, 0, 0, 0);
        p1 = __builtin_amdgcn_mfma_f32_32x32x16_bf16(b1, qr[d0], p1, 0, 0, 0); }
}
template <int VB>
__device__ __forceinline__ void pv_tile(f32x16* o, int vb0, bf16x8 pa0, bf16x8 pa1, bf16x8 pa2, bf16x8 pa3) {
#define TRRD(dst, off) asm volatile("ds_read_b64_tr_b16 %0, %1 offset:%2" : "=&v"(dst) : "v"(vb0), "i"(off) : "memory")
#define PV_D0(d0) do { s16x4 l0, l1, l2, l3, h0, h1, h2, h3; constexpr int b_ = VB * SHM_V + v_rd_off(d0, 0, 0); \
        TRRD(l0, b_); TRRD(h0, b_ + 2048); TRRD(l1, b_ + 4096); TRRD(h1, b_ + 6144); TRRD(l2, b_ + 8192); TRRD(h2, b_ + 10240); TRRD(l3, b_ + 12288); TRRD(h3, b_ + 14336); \
        asm volatile("s_waitcnt lgkmcnt(0)" ::: "memory"); SBAR();   \
        o[d0] = __builtin_amdgcn_mfma_f32_32x32x16_bf16(pa0, (bf16x8){l0[0], l0[1], l0[2], l0[3], h0[0], h0[1], h0[2], h0[3]}, o[d0], 0, 0, 0);   \
        o[d0] = __builtin_amdgcn_mfma_f32_32x32x16_bf16(pa1, (bf16x8){l1[0], l1[1], l1[2], l1[3], h1[0], h1[1], h1[2], h1[3]}, o[d0], 0, 0, 0);   \
        o[d0] = __builtin_amdgcn_mfma_f32_32x32x16_bf16(pa2, (bf16x8){l2[0], l2[1], l2[2], l2[3], h2[0], h2[1], h2[2], h2[3]}, o[d0], 0, 0, 0);   \
        o[d0] = __builtin_amdgcn_mfma_f32_32x32x16_bf16(pa3, (bf16x8){l3[0], l3[1], l3[2], l3[3], h3[0], h3[1], h3[2], h3[3]}, o[d0], 0, 0, 0); } while (0)
    PV_D0(0); PV_D0(1); PV_D0(2); PV_D0(3);
#undef PV_D0
#undef TRRD
}
struct BlockRef { const bf16* Q; const bf16* K; const bf16* V; bf16* O; int P0; const float* fb; const unsigned long long* mrow; };
struct Seam { bf16x8 qr[8]; bf16x8 st_v0, st_v1, st_k0, st_k1; };
#define VMW() asm volatile("s_waitcnt vmcnt(0)" ::: "memory")
#define VMWN(n) asm volatile("s_waitcnt vmcnt(%0)" :: "i"(n) : "memory")
#define SLOAD_H(Kp, Vp, k0) do { const bf16* kt_ = (Kp) + (size_t)(k0) * KS; const bf16* vt_ = (Vp) + (size_t)(k0) * KS; S.st_v0 = load8(vt_ + koff); S.st_v1 = load8(vt_ + koff + 32 * KS); S.st_k0 = load8(kt_ + koff); S.st_k1 = load8(kt_ + koff + 32 * KS); } while (0)
#define SWRITE_HK(bf) do { *(bf16x8*)(K_lds + (bf) * SHM_K + kws) = S.st_k0; *(bf16x8*)(K_lds + (bf) * SHM_K + kws + 32 * 256) = S.st_k1; } while (0)
#define SWRITE_HV(bf) do { *(bf16x8*)(V_lds + (bf) * SHM_V + vst0) = S.st_v0; *(bf16x8*)(V_lds + (bf) * SHM_V + vst1) = S.st_v1; } while (0)
#define SWRITE_H(bf) do { SWRITE_HV(bf); SWRITE_HK(bf); } while (0)
template <bool BIAS, bool BITMASK, int QS, int KS, int OS>
__device__ __forceinline__ void attn_block(const BlockRef& cur, char* lds, LAS unsigned char* ldsl) {
    int tid_ = threadIdx.x; asm volatile("" : "+v"(tid_));
    const int tid = tid_, wid = __builtin_amdgcn_readfirstlane(tid >> 6), lane = tid & 63, r32 = lane & 31, hi = lane >> 5;
    const int NT = (cur.P0 + QB - 1) / KVBLK + 1;
    const int qlo = cur.P0 + wid * QBLK, qm = qlo + r32 - 4 * hi;
    char* V_lds = lds; char* K_lds = lds + 2 * SHM_V;
    float* ws = (float*)(lds + OFF_WS) + wid * 64; float* li_l = ws, * al_l = ws + 32;
    const LAS unsigned char* bl0 = ldsl + OFF_BIAS + hi * 16;
    float m_reg = -1e30f, l_reg = 0; f32x16 o[4] = {};
    const int sr = tid >> 4, sc = (tid & 15) * 8, vst0 = v_st(sr, sc), vst1 = v_st(32 + sr, sc), kws = KSWZ(sr, sc * 2);
    const int vb0 = (int)(uintptr_t)V_lds + v_rd_base(lane);
    const bf16* Kh = cur.K; const bf16* Vh = cur.V;
    const int moff = (wid * QBLK + r32) * 64, koff = sr * KS + sc, qoff = (wid * QBLK + r32) * QS + hi * 8;
    Seam S;
#pragma unroll
    for (int d0 = 0; d0 < 8; ++d0) S.qr[d0] = load8(cur.Q + qoff + d0 * 16);
    if constexpr (BIAS) { const f32x4 b0_ = *(const f32x4*)(cur.fb + tid * 8), b1_ = *(const f32x4*)(cur.fb + tid * 8 + 4);
        *(LAS f32x4*)(ldsl + OFF_BIAS + tid * 32) = b0_; *(LAS f32x4*)(ldsl + OFF_BIAS + tid * 32 + 16) = b1_; }
    SLOAD_H(Kh, Vh, 0); VMW(); SWRITE_HK(0); SWRITE_HV(0); SBAR();
#define RESC(a) do { if (__any((a) < 1.f)) { if (hi == 0) al_l[r32] = (a); asm volatile("s_waitcnt lgkmcnt(0)" ::: "memory");              \
                     for (int d_ = 0; d_ < 4; ++d_) for (int r = 0; r < 16; ++r) o[d_][r] *= al_l[crow(r, hi)]; } } while (0)
#define KBASE(t) ((t) * KVBLK)
#define MLOAD(MW, t) do { if constexpr (BITMASK) MW = (cur.mrow + (t))[moff]; } while (0)
#define MASKT(P0_, P1_, MW, t) do { if constexpr (BIAS) { const LAS unsigned char* bl_ = bl0 + KBASE(t) * 4; _Pragma("unroll") for (int g = 0; g < 4; ++g) { const f32x4 a_ = *(const LAS f32x4*)(bl_ + g * 32), b_ = *(const LAS f32x4*)(bl_ + 128 + g * 32); \
            P0_[4 * g] += a_[0]; P0_[4 * g + 1] += a_[1]; P0_[4 * g + 2] += a_[2]; P0_[4 * g + 3] += a_[3]; P1_[4 * g] += b_[0]; P1_[4 * g + 1] += b_[1]; P1_[4 * g + 2] += b_[2]; P1_[4 * g + 3] += b_[3]; } } \
        if constexpr (BITMASK) { mask_bits(P0_, P1_, (unsigned)(MW) >> (4 * hi), (unsigned)((MW) >> 32) >> (4 * hi)); } \
        else { const int kb_ = KBASE(t); if (kb_ + KVBLK - 1 > qlo) mask_tile(P0_, P1_, qm - kb_); } } while (0)
    f32x16 pA0, pA1, pB0, pB1; float mnA, mnB, alA, alB; bf16x8 pa0, pa1, pa2, pa3; unsigned long long mwA = 0, mwB = 0;
    MLOAD(mwA, 0);
    SLOAD_H(Kh, Vh, KBASE(1)); MLOAD(mwB, 1);
    __syncthreads();
    SBAR(); qkt<0, BIAS>(pA0, pA1, K_lds, r32, hi, S.qr, nullptr);
    MASKT(pA0, pA1, mwA, 0); partialSM(pA0, pA1, m_reg, mnA, alA);
    VMW(); SWRITE_H(1);
    __syncthreads();
#define HALF_STEP(PX0, PX1, mnX, alX, MWX, PY0, PY1, alY, MWY, t, KB, VB, SB) do {                                            \
        SBAR(); qkt<KB, BIAS>(PX0, PX1, K_lds, r32, hi, S.qr, nullptr);                                                       \
        finishSM(PY0, PY1, alY, l_reg, pa0, pa1, pa2, pa3); SBAR();                                                           \
        if ((t) + 1 < NT) { SLOAD_H(Kh, Vh, KBASE((t) + 1)); MLOAD(MWY, (t) + 1); SBAR(); }                                   \
        pv_tile<VB>(o, vb0, pa0, pa1, pa2, pa3); MASKT(PX0, PX1, MWX, (t)); partialSM(PX0, PX1, m_reg, mnX, alX);             \
        __syncthreads();                                                                                                      \
        if ((t) + 1 < NT) { VMW(); SWRITE_H(SB); }                                                                            \
        RESC(alX); __syncthreads(); } while (0)
    for (int t = 1; t + 1 < NT; t += 2) {
        HALF_STEP(pB0, pB1, mnB, alB, mwB, pA0, pA1, alA, mwA, t, 1, 0, 0);
        HALF_STEP(pA0, pA1, mnA, alA, mwA, pB0, pB1, alB, mwB, t + 1, 0, 1, 1);
    }
    SBAR(); qkt<1, BIAS>(pB0, pB1, K_lds, r32, hi, S.qr, nullptr); SBAR();
    finishSM(pA0, pA1, alA, l_reg, pa0, pa1, pa2, pa3); SBAR();
    pv_tile<0>(o, vb0, pa0, pa1, pa2, pa3);
    MASKT(pB0, pB1, mwB, NT - 1); partialSM(pB0, pB1, m_reg, mnB, alB); __syncthreads(); RESC(alB);
    finishSM(pB0, pB1, alB, l_reg, pa0, pa1, pa2, pa3); SBAR(); pv_tile<1>(o, vb0, pa0, pa1, pa2, pa3);
    SBAR();
    if (hi == 0) li_l[r32] = l_reg; asm volatile("s_waitcnt lgkmcnt(0)" ::: "memory");
    float rli[16];
#pragma unroll
    for (int r = 0; r < 16; ++r) rli[r] = __builtin_amdgcn_rcpf(li_l[crow(r, hi)]);
    int tid2_ = threadIdx.x; asm volatile("" : "+v"(tid2_));
    const int r32e = tid2_ & 31, hie = (tid2_ >> 5) & 1, ooff = (wid * QBLK + 4 * hie) * OS + r32e;
#pragma unroll
    for (int r = 0; r < 16; ++r) {
#pragma unroll
        for (int d0 = 0; d0 < 4; ++d0) { const float v = o[d0][r] * rli[r]; const float vn = __shfl_xor(v, 1);
            if ((r32e & 1) == 0) *(unsigned*)(cur.O + ((r & 3) + 8 * (r >> 2)) * OS + d0 * 32 + ooff) = cvtpk(v, vn); } }
    __syncthreads();
#undef RESC
#undef KBASE
#undef MLOAD
#undef MASKT
#undef HALF_STEP
}
#undef ROWK
#undef VMW
#undef VMWN
#undef SLOAD_H
#undef SWRITE_HK
#undef SWRITE_HV
#undef SWRITE_H
#undef KSWZ
#undef SBAR
template <bool BIAS, bool BITMASK, int NH, int GROUP, bool PAIR, int QS, int KS, int OS>
__device__ __forceinline__ void attn_phase(char* lds, LAS unsigned char* ldsl, const bf16* Q, const bf16* K, const bf16* V, bf16* O, const float* fbias, const unsigned long long* mask, int G, int bid) {
    constexpr int NBLK = BATCH * NH * 16, NITEM = PAIR ? NBLK / 2 : NBLK, PER = PAIR ? 8 : 16, SETH = BATCH * NH / 8;
    for (int L = bid; L < NITEM; L += G) {
#pragma unroll 1
        for (int pass = 0; pass < (PAIR ? 2 : 1); ++pass) {
            const int g = L & 7, k = L >> 3, hs = k / PER, x = k % PER; const int bh = g * SETH + hs, b = bh / NH, h = bh % NH;
            const int qb = PAIR ? (pass ? 15 - x : x) : 15 - x; BlockRef r; const size_t row0 = (size_t)b * SEQ + (size_t)qb * QB;
            r.Q = Q + row0 * QS + h * D; r.O = O + row0 * OS + h * D; r.K = K + (size_t)b * SEQ * KS + (h / GROUP) * D; r.V = V + (size_t)b * SEQ * KS + (h / GROUP) * D; r.P0 = qb * QB;
            r.fb = BIAS ? fbias + (size_t)bh * SEQ : nullptr; r.mrow = BITMASK ? mask + row0 * 64 : nullptr;
            attn_block<BIAS, BITMASK, QS, KS, OS>(r, lds, ldsl);
        }
    }
}
}
__device__ __forceinline__ float fast_silu(float g) { return g * __builtin_amdgcn_rcpf(1.0f + __expf(-g)); }
__device__ __forceinline__ void ph_gla_a(Frame& F, const Args& a) {
    const float* SK0 = (const float*)(F.ws + WS_SK0); const float* w2 = a.in[2]; const float* gbias = a.in[3]; float* GB = (float*)(F.ws + WS_GB); float* DEC = (float*)(F.ws + WS_DEC);
    const bf16* PROJ = (const bf16*)(F.ws + WS_PROJ); bf16* CST = (bf16*)(F.ws + WS_CST);
    LAS float* BSH = (LAS float*)F.lds; LAS float* TOT = BSH + 64 * 128; LAS bf16* VT = (LAS bf16*)(F.lds + 36864); LAS bf16* KET = (LAS bf16*)(F.lds + 73728);
    const int tid = F.tid, lane = F.lane, l15 = lane & 15, quad = lane >> 4, w = F.wave;
    for (int unit = blockIdx.x; unit < 512; unit += F.G) {
        const int n = unit & 63, bh = unit >> 6, b = bh >> 2, h = bh & 3, t0 = b * SEQ + n * 64;
        __syncthreads();
        {
            const int d = tid & 127, cg = tid >> 7; float wv[16];
#pragma unroll
            for (int r = 0; r < 16; ++r) wv[r] = w2[r * 512 + h * 128 + d];
            const float gb = gbias[h * 128 + d]; float run = 0.f;
            for (int cc = 0; cc < 16; ++cc) { const int c = cg * 16 + cc; const float* sk = SK0 + (size_t)(t0 + c) * 24; float z = gb;
#pragma unroll
                for (int r = 0; r < 16; ++r) z += sk[r] * wv[r];
                run += logsigmoidf(z) * (1.0f / 16.0f); BSH[c * 128 + d] = run; }
            TOT[cg * 128 + d] = run;
            __syncthreads();
            float pre = 0.f;
            for (int g = 0; g < cg; ++g) pre += TOT[g * 128 + d];
            for (int cc = 0; cc < 16; ++cc) { const int c = cg * 16 + cc; const float v = BSH[c * 128 + d] + pre; BSH[c * 128 + d] = v; GB[(size_t)(t0 + c) * 512 + h * 128 + d] = v; }
        }
        __syncthreads();
        {
            const int c = tid & 63, g8 = tid >> 6; const size_t t = (size_t)(t0 + c);
            const bf16* kp = PROJ + t * NP0 + 512 + h * 128 + g8 * 16;
            const v4u k0 = *(const v4u*)kp, k1 = *(const v4u*)(kp + 8);
            const unsigned kw[8] = {k0.x, k0.y, k0.z, k0.w, k1.x, k1.y, k1.z, k1.w};
#pragma unroll
            for (int i = 0; i < 8; ++i) { const int d = g8 * 16 + 2 * i; const float e0 = __expf(BSH[63 * 128 + d] - BSH[c * 128 + d]), e1 = __expf(BSH[63 * 128 + d + 1] - BSH[c * 128 + d + 1]);
                KET[d * 72 + c] = (bf16)f2bf(bf2f(kw[i] & 0xffff) * e0); KET[(d + 1) * 72 + c] = (bf16)f2bf(bf2f(kw[i] >> 16) * e1); }
            const bf16* vp = PROJ + t * NP0 + 1024 + h * 256 + g8 * 32;
#pragma unroll
            for (int q = 0; q < 4; ++q) { const v4u vv = *(const v4u*)(vp + 8 * q); const unsigned vw[4] = {vv.x, vv.y, vv.z, vv.w};
#pragma unroll
                for (int i = 0; i < 4; ++i) { const int v = g8 * 32 + q * 8 + 2 * i; VT[v * 72 + c] = (bf16)(vw[i] & 0xffff); VT[(v + 1) * 72 + c] = (bf16)(vw[i] >> 16); } }
            if (tid < 128) DEC[unit * 128 + tid] = __expf(BSH[63 * 128 + tid]);
        }
        __syncthreads();
        {
            pg8::f32x4 acc[2][8];
#pragma unroll
            for (int i = 0; i < 2; ++i)
#pragma unroll
                for (int nn = 0; nn < 8; ++nn) acc[i][nn] = (pg8::f32x4){0.f, 0.f, 0.f, 0.f};
#pragma unroll
            for (int kk = 0; kk < 64; kk += 32) {
                const bf16x8 a0 = *(const LAS bf16x8*)(VT + (32 * w + l15) * 72 + kk + quad * 8), a1 = *(const LAS bf16x8*)(VT + (32 * w + 16 + l15) * 72 + kk + quad * 8);
#pragma unroll
                for (int nn = 0; nn < 8; ++nn) { const bf16x8 bb = *(const LAS bf16x8*)(KET + (16 * nn + l15) * 72 + kk + quad * 8);
                    acc[0][nn] = __builtin_amdgcn_mfma_f32_16x16x32_bf16(bb, a0, acc[0][nn], 0, 0, 0); acc[1][nn] = __builtin_amdgcn_mfma_f32_16x16x32_bf16(bb, a1, acc[1][nn], 0, 0, 0); } }
            bf16* cp = CST + (size_t)unit * 32768;
#pragma unroll
            for (int i = 0; i < 2; ++i)
#pragma unroll
                for (int nn = 0; nn < 8; ++nn) { uint2 o; o.x = pk2(acc[i][nn][0], acc[i][nn][1]); o.y = pk2(acc[i][nn][2], acc[i][nn][3]);
                    *(uint2*)(cp + (32 * w + 16 * i + l15) * 128 + 16 * nn + quad * 4) = o; }
        }
    }
    __syncthreads();
}
__device__ __forceinline__ void ph_gla_c(Frame& F, const Args& a) {
    const bf16* PROJ = (const bf16*)(F.ws + WS_PROJ); const float* GB = (const float*)(F.ws + WS_GB); const bf16* PREVT = (const bf16*)(F.ws + WS_PREVT); const float* normg = a.in[4]; bf16* OMIX = (bf16*)(F.ws + WS_OMIX);
    LAS bf16* QD = (LAS bf16*)(F.lds + 32768); LAS bf16* KI = (LAS bf16*)(F.lds + 50176); LAS bf16* P = (LAS bf16*)(F.lds + 67584); LAS bf16* VT = (LAS bf16*)(F.lds + 76800); LAS float* RED = (LAS float*)(F.lds + 113664);
    const int tid = F.tid, lane = F.lane, l15 = lane & 15, quad = lane >> 4, w = F.wave;
    for (int unit = blockIdx.x; unit < 512; unit += F.G) {
        const int n = unit & 63, bh = unit >> 6, b = bh >> 2, h = bh & 3, t0 = b * SEQ + n * 64;
        __syncthreads();
        {
            const int c = tid >> 3, dg = tid & 7; const size_t t = (size_t)(t0 + c);
            const float* bp = GB + t * 512 + h * 128 + dg * 16; const bf16* qp = PROJ + t * NP0 + h * 128 + dg * 16; const bf16* kp = PROJ + t * NP0 + 512 + h * 128 + dg * 16;
#pragma unroll
            for (int q8 = 0; q8 < 2; ++q8) { const v4u qq = *(const v4u*)(qp + 8 * q8), kk = *(const v4u*)(kp + 8 * q8); const f32x4 b0 = *(const f32x4*)(bp + 8 * q8), b1 = *(const f32x4*)(bp + 8 * q8 + 4);
                const unsigned qw[4] = {qq.x, qq.y, qq.z, qq.w}, kw[4] = {kk.x, kk.y, kk.z, kk.w}; const float bv[8] = {b0[0], b0[1], b0[2], b0[3], b1[0], b1[1], b1[2], b1[3]};
                v4u oq, ok; unsigned* oqp = (unsigned*)&oq; unsigned* okp = (unsigned*)&ok;
#pragma unroll
                for (int i = 0; i < 4; ++i) { const float e0 = __expf(bv[2 * i]), e1 = __expf(bv[2 * i + 1]);
                    oqp[i] = pk2(bf2f(qw[i] & 0xffff) * ATT_SCALE * e0, bf2f(qw[i] >> 16) * ATT_SCALE * e1);
                    okp[i] = pk2(bf2f(kw[i] & 0xffff) * __builtin_amdgcn_rcpf(e0), bf2f(kw[i] >> 16) * __builtin_amdgcn_rcpf(e1)); }
                *(LAS v4u*)(QD + c * 136 + dg * 16 + 8 * q8) = oq; *(LAS v4u*)(KI + c * 136 + dg * 16 + 8 * q8) = ok; }
            const int c2 = tid & 63, g8 = tid >> 6; const bf16* vp = PROJ + (size_t)(t0 + c2) * NP0 + 1024 + h * 256 + g8 * 32;
#pragma unroll
            for (int q = 0; q < 4; ++q) { const v4u vv = *(const v4u*)(vp + 8 * q); const unsigned vw[4] = {vv.x, vv.y, vv.z, vv.w};
#pragma unroll
                for (int i = 0; i < 4; ++i) { const int v = g8 * 32 + q * 8 + 2 * i; VT[v * 72 + c2] = (bf16)(vw[i] & 0xffff); VT[(v + 1) * 72 + c2] = (bf16)(vw[i] >> 16); } }
        }
        __syncthreads();
        {
            const int ti = w >> 1;
#pragma unroll
            for (int s = 0; s < 2; ++s) { const int tj = 2 * (w & 1) + s; pg8::f32x4 acc = (pg8::f32x4){0.f, 0.f, 0.f, 0.f};
                if (tj <= ti) {
#pragma unroll
                    for (int kk = 0; kk < 128; kk += 32) { const bf16x8 aa = *(const LAS bf16x8*)(QD + (16 * ti + l15) * 136 + kk + quad * 8), bb = *(const LAS bf16x8*)(KI + (16 * tj + l15) * 136 + kk + quad * 8);
                        acc = __builtin_amdgcn_mfma_f32_16x16x32_bf16(aa, bb, acc, 0, 0, 0); } }
#pragma unroll
                for (int j = 0; j < 4; ++j) { const int i = 16 * ti + quad * 4 + j, jj = 16 * tj + l15; P[i * 72 + jj] = (bf16)f2bf(jj <= i ? acc[j] : 0.f); } }
        }
        __syncthreads();
        {
            const int ti = w >> 1, half = w & 1; pg8::f32x4 acc[8];
#pragma unroll
            for (int nn = 0; nn < 8; ++nn) acc[nn] = (pg8::f32x4){0.f, 0.f, 0.f, 0.f};
#pragma unroll
            for (int kk = 0; kk < 64; kk += 32) { const bf16x8 aa = *(const LAS bf16x8*)(P + (16 * ti + l15) * 72 + kk + quad * 8);
#pragma unroll
                for (int nn = 0; nn < 8; ++nn) { const bf16x8 bb = *(const LAS bf16x8*)(VT + (128 * half + 16 * nn + l15) * 72 + kk + quad * 8); acc[nn] = __builtin_amdgcn_mfma_f32_16x16x32_bf16(bb, aa, acc[nn], 0, 0, 0); } }
            const bf16* pv = PREVT + (size_t)unit * 32768 + (size_t)(128 * half + l15) * 128 + quad * 8;
#pragma unroll
            for (int kk = 0; kk < 128; kk += 32) { const bf16x8 aa = *(const LAS bf16x8*)(QD + (16 * ti + l15) * 136 + kk + quad * 8);
#pragma unroll
                for (int nn = 0; nn < 8; ++nn) { const bf16x8 bb = *(const bf16x8*)(pv + (size_t)(16 * nn) * 128 + kk); acc[nn] = __builtin_amdgcn_mfma_f32_16x16x32_bf16(bb, aa, acc[nn], 0, 0, 0); } }
            float s = 0.f;
#pragma unroll
            for (int nn = 0; nn < 8; ++nn) s += (acc[nn][0] * acc[nn][0] + acc[nn][1] * acc[nn][1]) + (acc[nn][2] * acc[nn][2] + acc[nn][3] * acc[nn][3]);
            s += __shfl_xor(s, 16); s += __shfl_xor(s, 32);
            if (quad == 0) RED[(16 * ti + l15) * 2 + half] = s;
            __syncthreads();
            const int i = 16 * ti + l15; const float ms = (RED[i * 2] + RED[i * 2 + 1]) * (1.0f / 256.0f); const float rs = 1.0f / sqrtf(ms + LN_EPS);
            const size_t t = (size_t)(t0 + i);
#pragma unroll
            for (int nn = 0; nn < 8; ++nn) { const int v = 128 * half + 16 * nn + quad * 4; const uint2 gr = *(const uint2*)(PROJ + t * NP0 + 2048 + h * 256 + v); const f32x4 ng = *(const f32x4*)(normg + v);
                uint2 o; o.x = pg8::cvt_pk_bf16(acc[nn][0] * rs * ng[0] * fast_silu(bf2f(gr.x & 0xffff)), acc[nn][1] * rs * ng[1] * fast_silu(bf2f(gr.x >> 16)));
                o.y = pg8::cvt_pk_bf16(acc[nn][2] * rs * ng[2] * fast_silu(bf2f(gr.y & 0xffff)), acc[nn][3] * rs * ng[3] * fast_silu(bf2f(gr.y >> 16)));
                *(uint2*)(OMIX + t * DM + h * 256 + v) = o; }
        }
    }
    __syncthreads();
}
__device__ __forceinline__ void ph_indexer(Frame& F, unsigned char* lds_generic) {
    typedef float f32x16 __attribute__((ext_vector_type(16)));
    const bf16* PROJ1 = (const bf16*)(F.ws + WS_PROJ); const bf16* IK = (const bf16*)(F.ws + WS_IK); const float* IW = (const float*)(F.ws + WS_IW); unsigned long long* MASK = (unsigned long long*)(F.ws + WS_MASK);
    LAS float* SCL = (LAS float*)F.lds;
    const int lane = F.lane, w = F.wave, c32 = lane & 31, hi = lane >> 5, rt = w & 3, kpar = w >> 2;
    for (int it = blockIdx.x; it < 512; it += F.G) {
#pragma unroll 1
        for (int pass = 0; pass < 2; ++pass) {
            const int unit = pass ? 1023 - it : it, m0 = unit * 8, b = m0 >> 12, qmax = (m0 & 4095) + 7;
            __syncthreads();
            {
                const int qa = m0 + 2 * rt + ((c32 >> 2) & 1), ha = (c32 & 3) + 4 * (c32 >> 3);
                const bf16* ap = PROJ1 + (size_t)qa * NP1 + 3072 + ha * 64 + 8 * hi;
                bf16x8 af[4];
#pragma unroll
                for (int ks = 0; ks < 4; ++ks) af[ks] = *(const bf16x8*)(ap + 16 * ks);
                const float* wp = IW + (size_t)(m0 + 2 * rt + hi) * 16; float wv[16];
#pragma unroll
                for (int q4 = 0; q4 < 4; ++q4) { const f32x4 t4 = *(const f32x4*)(wp + 4 * q4); wv[4 * q4] = t4[0]; wv[4 * q4 + 1] = t4[1]; wv[4 * q4 + 2] = t4[2]; wv[4 * q4 + 3] = t4[3]; }
                LAS float* srow = SCL + (2 * rt + hi) * 4096 + c32;
                const bf16* kbase = IK + (size_t)b * SEQ * 64 + (size_t)lane * 8;
                bf16x8 bn[4];
#pragma unroll
                for (int ks = 0; ks < 4; ++ks) bn[ks] = *(const bf16x8*)(kbase + (size_t)(kpar * 4 + ks) * 512);
                for (int t = kpar; t * 32 <= qmax; t += 2) {
                    bf16x8 bc[4];
#pragma unroll
                    for (int ks = 0; ks < 4; ++ks) bc[ks] = bn[ks];
                    const int tn = (t + 2) * 32 <= qmax ? t + 2 : t;
#pragma unroll
                    for (int ks = 0; ks < 4; ++ks) bn[ks] = *(const bf16x8*)(kbase + (size_t)(tn * 4 + ks) * 512);
                    f32x16 acc = {};
#pragma unroll
                    for (int ks = 0; ks < 4; ++ks) acc = __builtin_amdgcn_mfma_f32_32x32x16_bf16(af[ks], bc[ks], acc, 0, 0, 0);
                    float s = 0.f;
#pragma unroll
                    for (int r = 0; r < 16; ++r) s += wv[r] * fmaxf(acc[r], 0.f);
                    srow[t * 32] = s; }
            }
            __syncthreads();
            { const int m = m0 + w; topk_mask_row((const LAS float*)(F.lds + w * 16384), m & 4095, MASK + (size_t)m * 64, lane, (LAS unsigned*)(F.lds + LDSCTL_OFF + 4096 + w * 1024)); }
        }
    }
    __syncthreads();
}
#define IN(k) (lo <= (k) && (k) < hi)
#define SEAM(k) do { if (hi > (k) + 1) xcd_barrier(bar); } while (0)
template <int LAYER, int BASE>
__device__ __forceinline__ void common_phases(Frame& F, const Args& args, const int lo, const int hi, const XcdBarrier& bar) {
    unsigned char* ws = args.ws;
    if (IN(BASE + 0)) {
        pg8::Gemm g{(const bf16*)(ws + WS_OMIX), (const bf16*)(ws + (LAYER ? WS_WOC : WS_WOA)), MTOK, DM, DM, DM, DM}; pg8::StaticOrder S; S.init(MTOK, DM, F.G, (int)blockIdx.x);
        pg8::EpiResid E{(const bf16*)(ws + WS_XB), (bf16*)(ws + WS_YB), DN_ALPHA};
        pg8::gemm_phase<pg8::EpiResid, pg8::StaticOrder, true, true>(F.lds, g, S, E);
        SEAM(BASE + 0);
    }
    if (IN(BASE + 1)) { p_ln_route(F, args, LAYER); SEAM(BASE + 1); }
    if (IN(BASE + 3) || IN(BASE + 4) || IN(BASE + 5)) {
        if (F.wave == 0) { int ti; (void)moe_offsets(F.ctl + CW_CNT + LAYER * 64, F.lane, &ti); if (F.lane < 32) { F.MISC[64 + F.lane] = (unsigned)ti; F.MISC[160 + F.lane] = F.ctl[CW_CNT + LAYER * 64 + F.lane]; } if (F.lane == 31) F.MISC[96] = (unsigned)ti; }
        __syncthreads();
    }
    {
        const int Tm = (int)F.MISC[96], T1 = F.G / 4 < Tm ? F.G / 4 : Tm;
        const int n2 = (Tm - T1) * 4;
        const pg8::Gemm gU{(const bf16*)(ws + WS_XB), (const bf16*)(ws + WS_WGU) + (size_t)LAYER * 32 * 1024 * 2048, RPAD, 32 * 1024, DM, DM, DM};
        const pg8::Gemm gD{(const bf16*)(ws + WS_OMIX), (const bf16*)(ws + WS_WD) + (size_t)LAYER * 32 * 2048 * 512, RPAD, 32 * 2048, 512, 512, 512};
        const PG8_LAS int* tend = (const LAS int*)(F.lds + LDSCTL_OFF + 64 * 4); const PG8_LAS int* ecnt = (const LAS int*)(F.lds + LDSCTL_OFF + 160 * 4);
        const int* inv = (const int*)(ws + WS_INV);
        const pg8::EpiGLU EU{(bf16*)(ws + WS_OMIX), (const float*)(ws + WS_WINV)}; const pg8::EpiBf16Plain ED{(bf16*)(ws + WS_CST), DM, 7};
        if (IN(BASE + 3)) {
            pg8::MoeOrder S{F.G, (int)blockIdx.x, 4, 0, T1 * 4, (T1 * 4 == F.G && (F.G & 7) == 0) ? 2 : 0, tend, ecnt};
            pg8::gemm_phase_g<pg8::EpiGLU, pg8::MoeOrder>(F.lds, gU, S, EU, inv);
            SEAM(BASE + 3);
        }
        if (IN(BASE + 4)) {
            const int nt2 = Tm - T1, h0 = (nt2 + 1) >> 1, h1 = nt2 - h0, bx = (int)blockIdx.x, xc = bx & 7, sx = bx >> 3, hf = xc >> 2;
            const bool xok = (F.G & 7) == 0 && 8 * h0 <= F.G;
            const bool isU = xok ? sx < (hf ? h1 : h0) : bx < n2;
            const int cd = xok ? (bx >= 8 * h0 ? bx - 8 * h0 : (F.G - 8 * h0) + (xc - 4)) : bx - n2;
            if (isU) { const int L = xok ? T1 * 4 + ((hf ? h0 : 0) + sx) * 4 + (xc & 3) : T1 * 4 + bx;
                pg8::MoeOrder S{1 << 28, 0, 4, L, Tm * 4, 0, tend, ecnt}; pg8::gemm_phase_g<pg8::EpiGLU, pg8::MoeOrder>(F.lds, gU, S, EU, inv); }
            else { pg8::MoeOrder S{F.G - n2, cd, 8, 0, T1 * 8, 0, tend, ecnt}; pg8::gemm_phase<pg8::EpiBf16Plain, pg8::MoeOrder, true, true>(F.lds, gD, S, ED); }
            if (LAYER == 0) late_conv_items<16>(F, args, CONV_SPLIT, CONV_LATE_ITEMS, 1);
            SEAM(BASE + 4);
        }
        if (IN(BASE + 5)) {
            pg8::MoeOrder S{F.G, (int)blockIdx.x, 8, T1 * 8, Tm * 8, 0, tend, ecnt};
            pg8::gemm_phase<pg8::EpiBf16Plain, pg8::MoeOrder, true, true>(F.lds, gD, S, ED);
            if (LAYER == 0) late_conv_items<16>(F, args, CONV_SPLIT, CONV_LATE_ITEMS, 1);
            SEAM(BASE + 5);
        }
    }
    if (IN(BASE + 6)) { p_ln_ffn(F, args, LAYER); SEAM(BASE + 6); }
}
__global__ void __launch_bounds__(NWAVES * 64, 2) mk_fwd(Args args) {
    extern __shared__ __attribute__((aligned(16))) unsigned char lds[];
    Frame F;
    F.lds = (LAS unsigned char*)lds; F.MISC = (volatile LAS unsigned*)(F.lds + LDSCTL_OFF);
    F.tid = threadIdx.x; F.lane = F.tid & 63; F.wave = __builtin_amdgcn_readfirstlane(F.tid >> 6);
    F.G = gridDim.x; F.gw = blockIdx.x * NWAVES + F.wave; F.NGW = F.G * NWAVES;
    F.ws = args.ws; F.ctl = (unsigned*)(args.ws + WS_CTL);
    for (int u = F.tid; u < (LDS_BYTES - LDSCTL_OFF) / 4; u += NWAVES * 64) ((LAS unsigned*)(F.lds + LDSCTL_OFF))[u] = 0u;
    __syncthreads();
    const int lo = args.ph_lo, hi = args.ph_hi;
    XcdBarrier bar; bar.bar = F.ctl + CW_BAR + args.bar_region * XCD_BAR_WORDS; bar.x = 0; bar.st = nullptr;
    if (hi - lo > 1) bar = xcd_barrier_post(F.ctl + CW_BAR + args.bar_region * XCD_BAR_WORDS, F.MISC);
    unsigned char* ws = args.ws;

    if (IN(0)) { p0_prologue(F, args); SEAM(0); }
    if (IN(1)) {
        pg8::Gemm g{(const bf16*)(ws + WS_XB), (const bf16*)(ws + WS_WINA), MTOK, NP0, DM, DM, DM}; pg8::StaticOrder S; S.init(MTOK, NP0, F.G, (int)blockIdx.x);
        pg8::EpiBf16Plain E{(bf16*)(ws + WS_PROJ), NP0, 0x7fffffff};
        pg8::gemm_phase<pg8::EpiBf16Plain, pg8::StaticOrder, true, true>(F.lds, g, S, E);
        p_skinny0(F, args);
        SEAM(1);
    }
    if (IN(2)) { p_fox_bias(F, args); ph_gla_a(F, args); SEAM(2); }
    if (IN(4)) { ph_gla_scan(F); __syncthreads();
        attn::attn_phase<true, false, 8, 1, true, NP0, NP0, DM>((char*)lds, F.lds, (const bf16*)(ws + WS_PROJ) + 3072, (const bf16*)(ws + WS_PROJ) + 4096, (const bf16*)(ws + WS_PROJ) + 5120,
                                                               (bf16*)(ws + WS_OMIX) + 1024, (const float*)(ws + WS_FBIAS), (const unsigned long long*)nullptr, F.G, (int)blockIdx.x);
        late_conv_items<64>(F, args, 0, CONV_BIG, 0); late_conv_items<16>(F, args, CONV_BIG, CONV_SPLIT, 2);
        SEAM(4); }
    if (IN(5)) { ph_gla_c(F, args); SEAM(5); }
    common_phases<0, 6>(F, args, lo, hi, bar);
    if (IN(13)) {
        pg8::Gemm g{(const bf16*)(ws + WS_XB), (const bf16*)(ws + WS_WINC), MTOK, NP1, DM, DM, DM}; pg8::StaticOrder S; S.init(MTOK, NP1, F.G, (int)blockIdx.x);
        const float* c128 = (const float*)(ws + WS_ROPE);
        pg8::EpiRope E{(bf16*)(ws + WS_PROJ), c128, c128 + 4096 * 64, c128 + 2 * 4096 * 64, c128 + 2 * 4096 * 64 + 4096 * 32};
        pg8::gemm_phase<pg8::EpiRope, pg8::StaticOrder, true, true>(F.lds, g, S, E);
        SEAM(13);
    }
    if (IN(14)) { ph_indexer(F, lds); SEAM(14); }
    if (IN(16)) {
        attn::attn_phase<false, true, 16, 4, true, NP1, NP1, DM>((char*)lds, F.lds, (const bf16*)(ws + WS_PROJ), (const bf16*)(ws + WS_PROJ) + 2048, (const bf16*)(ws + WS_PROJ) + 2560,
                                                               (bf16*)(ws + WS_OMIX), (const float*)nullptr, (const unsigned long long*)(ws + WS_MASK), F.G, (int)blockIdx.x);
        SEAM(16); }
    common_phases<1, 17>(F, args, lo, hi, bar);
#ifdef PROBE_CONV
    if (IN(31)) {
        LAS bf16* T = (LAS bf16*)(F.lds + F.wave * 16384); bf16* dstb = (bf16*)(ws + WS_SC); float sink = 0.f;
        for (int it = F.gw; it < 32 * 256; it += F.NGW) {
            const int ex = 32 + it / 256, r = it % 256, kb = r / 8, nb = r % 8;
            TrItem t{args.in[17] + (size_t)ex * 2048 * 512, dstb + (size_t)(it / 256) * 512 * 2048, 512, nb * 64, nb * 64 + 32, 2048, nb * 64, kb * 64};
            f32x4 r16[16]; tr64_load(t, r16, F.lane);
            if (PROBE_CONV == 0) tr64_store(t, r16, T, F.lane);
            else if (PROBE_CONV == 1) {
#pragma unroll
                for (int i = 0; i < 8; ++i) { uint2 o; o.x = pg8::cvt_pk_bf16(r16[2 * i][0], r16[2 * i][1]); o.y = pg8::cvt_pk_bf16(r16[2 * i][2], r16[2 * i][3]); uint2 p; p.x = pg8::cvt_pk_bf16(r16[2 * i + 1][0], r16[2 * i + 1][1]); p.y = pg8::cvt_pk_bf16(r16[2 * i + 1][2], r16[2 * i + 1][3]);
                    bf16* d = dstb + (size_t)(it / 256) * 512 * 2048 + (size_t)(kb * 64 + 8 * i + 2 * (F.lane >> 4)) * 512 + nb * 64 + 4 * (F.lane & 15); *(uint2*)d = o; *(uint2*)(d + 512) = p; } }
            else {
#pragma unroll
                for (int i = 0; i < 16; ++i) sink += r16[i][0] + r16[i][3]; }
        }
        if (PROBE_CONV == 2 && sink == 12345.678f) dstb[F.tid] = 1;
    }
#endif
#ifdef PROBE_GEMM_K
    if (IN(30)) {
        pg8::Gemm g{(const bf16*)(ws + WS_XB), (const bf16*)(ws + WS_WINA), MTOK, NP0, PROBE_GEMM_K, PROBE_GEMM_LD, PROBE_GEMM_LD}; pg8::StaticOrder S; S.init(MTOK, NP0, F.G, (int)blockIdx.x);
        pg8::EpiBf16Plain E{(bf16*)(ws + WS_SC), NP0, 0x7fffffff};
        pg8::gemm_phase<pg8::EpiBf16Plain, pg8::StaticOrder, true, true>(F.lds, g, S, E);
    }
#endif
}
#undef IN
#undef SEAM
constexpr int N_PHASE_IDS = 24;
static void launch_mk(const Args& base, int lo, int hi, int grid, hipStream_t stream, int region = 0) {
    Args a = base; a.ph_lo = lo; a.ph_hi = hi; a.bar_region = region; a.pad = 0;
    hipLaunchKernelGGL(mk_fwd, dim3(grid), dim3(NWAVES * 64), LDS_BYTES, stream, a);
}
extern "C" void kernel_launch(void* const* d_in, const int* in_sizes, int n_in, void* d_out, int out_size, void* d_ws, size_t ws_size, hipStream_t stream) {
    static int grid = 0;
    if (grid == 0) {
        if (n_in != 20 || out_size != MTOK * DM || ws_size < WS_END) { fprintf(stderr, "kernel_launch: unexpected shapes (n_in %d, out %d, ws %zu < %zu)\n", n_in, out_size, ws_size, (size_t)WS_END); grid = -1; return; }
        int dev = 0, cus = 0, per_cu = 0;
        if (hipGetDevice(&dev) != hipSuccess || hipDeviceGetAttribute(&cus, hipDeviceAttributeMultiprocessorCount, dev) != hipSuccess) { grid = -1; return; }
        if (hipFuncSetAttribute((const void*)mk_fwd, hipFuncAttributeMaxDynamicSharedMemorySize, LDS_BYTES) != hipSuccess) { fprintf(stderr, "kernel_launch: hipFuncSetAttribute failed\n"); grid = -1; return; }
        if (hipOccupancyMaxActiveBlocksPerMultiprocessor(&per_cu, (const void*)mk_fwd, NWAVES * 64, LDS_BYTES) != hipSuccess || per_cu < 1) { fprintf(stderr, "kernel_launch: occupancy query reports %d workgroups per CU\n", per_cu); }
        (void)hipGetLastError();
        grid = cus;
    }
    if (grid < 0) return;
    (void)in_sizes;
    if (hipMemsetAsync((char*)d_ws + WS_CTL, 0, CTL_ZERO_BYTES, stream) != hipSuccess) return;
    Args a{};
    for (int i = 0; i < 20; ++i) a.in[i] = (const float*)d_in[i];
    a.out = (float*)d_out; a.ws = (unsigned char*)d_ws;
#ifdef PROBE_LO
    launch_mk(a, 0, PROBE_HI + 1, grid, stream, 0); launch_mk(a, PROBE_LO, N_PHASE_IDS, grid, stream, 1);
#else
    launch_mk(a, 0, N_PHASE_IDS, grid, stream);
#endif
#ifdef PROBE_GEMM_K
    launch_mk(a, 30, 31, grid, stream, 2);
#endif
#ifdef PROBE_CONV
    launch_mk(a, 31, 32, grid, stream, 2);
#endif
}
```

```cpp
#include <hip/hip_runtime.h>
#include <cstdio>
#include <cstdint>
namespace pg8 {
#define PG8_LAS __attribute__((address_space(3)))
typedef unsigned short bf16_t;
typedef short bf16x8 __attribute__((ext_vector_type(8)));
typedef float f32x4 __attribute__((ext_vector_type(4)));
typedef unsigned u32x4 __attribute__((ext_vector_type(4)));
constexpr int BM = 256, BK = 64, HALF = 128, HTB = HALF * BK * 2  , STAGE_BYTES = 8 * HTB, NXCD = 8, WGM = 8;

__host__ __device__ __forceinline__ int lds_byte(int r, int c) { const int st = (r >> 4) * 2 + (c >> 5), rr = r & 15, cc = c & 31, ob = rr * 64 + cc * 2; return st * 1024 + (ob ^ (((ob >> 9) & 1) << 5)); }
__host__ __device__ __forceinline__ void stage_rc(int b, int& R, int& C) { const int st = b / 1024, sb = b % 1024, swz = sb ^ (((sb >> 9) & 1) << 5); R = (st >> 1) * 16 + swz / 64; C = (st & 1) * 32 + (swz % 64) / 2; }
__host__ __device__ __forceinline__ int perm32(int rho) { const int n = rho >> 4, i = rho & 15; return 8 * (i >> 2) + 4 * n + (i & 3); }

struct Unit { int pm, pn, inv0, nvalid, half; };
struct Gemm { const bf16_t* A; const bf16_t* Bt; int M, N, K, lda, ldb; };

struct StaticOrder {
    int nM, nN, nwg, G, c;
    __host__ __device__ void init(int M, int N, int G_, int c_) { nM = M / BM; nN = N / BM; nwg = nM * nN; G = G_; c = c_; }
    __host__ __device__ bool next(int i, Unit& u) const {
        const long L = (long)i * G + c; if (L >= nwg) return false;
        int wgid = (int)L; { const int q = nwg / NXCD, r = nwg % NXCD, xcd = wgid % NXCD, off = wgid / NXCD; wgid = (xcd < r ? xcd * (q + 1) : r * (q + 1) + (xcd - r) * q) + off; }
        const int nig = WGM * nN, gid = wgid / nig, fm = gid * WGM, gsz = (nM - fm) < WGM ? (nM - fm) : WGM;
        u.pm = fm + ((wgid % nig) % gsz); u.pn = (wgid % nig) / gsz; return true;
    }
    __device__ __forceinline__ void a_ready(const Unit&) const {}
    __device__ __forceinline__ void done(const Unit&) const {}
};

__device__ __forceinline__ unsigned cvt_pk_bf16(float lo, float hi) { unsigned r; asm volatile("v_cvt_pk_bf16_f32 %0, %1, %2" : "=v"(r) : "v"(lo), "v"(hi)); return r; }
typedef float f32x2 __attribute__((ext_vector_type(2)));
struct EpiBf16Plain {
    static constexpr bool PERM = true, AFTER_DRAIN = false;
    bf16_t* O; int ldc; int pn_mask;
    __device__ __forceinline__ void operator()(const f32x4 (&acc)[2][2][4][2], const Unit& u, int wr, int wc, int fr, int fq) const {
        const int row0 = u.pm * BM + wr * 64 + fr, col0 = (u.pn & pn_mask) * BM + wc * 32 + 8 * fq;
#pragma unroll
        for (int ai = 0; ai < 2; ++ai)
#pragma unroll
            for (int m = 0; m < 4; ++m) { bf16_t* rowp = O + (size_t)(row0 + ai * HALF + m * 16) * ldc + col0;
#pragma unroll
                for (int bj = 0; bj < 2; ++bj) { const f32x4 v0 = acc[ai][bj][m][0], v1 = acc[ai][bj][m][1];
                    u32x4 w; w.x = cvt_pk_bf16(v0[0], v0[1]); w.y = cvt_pk_bf16(v0[2], v0[3]); w.z = cvt_pk_bf16(v1[0], v1[1]); w.w = cvt_pk_bf16(v1[2], v1[3]);
                    *(u32x4*)(rowp + bj * HALF) = w; } }
    }
};
struct EpiResid {
    static constexpr bool PERM = true, AFTER_DRAIN = false;
    const bf16_t* base; bf16_t* out; float alpha;
    __device__ __forceinline__ void operator()(const f32x4 (&acc)[2][2][4][2], const Unit& u, int wr, int wc, int fr, int fq) const {
        const int row0 = u.pm * BM + wr * 64 + fr, col0 = u.pn * BM + wc * 32 + 8 * fq;
#pragma unroll
        for (int ai = 0; ai < 2; ++ai)
#pragma unroll
            for (int m = 0; m < 4; ++m) { const size_t off = (size_t)(row0 + ai * HALF + m * 16) * 2048 + col0;
#pragma unroll
                for (int bj = 0; bj < 2; ++bj) { const u32x4 b = *(const u32x4*)(base + off + bj * HALF); const f32x4 v0 = acc[ai][bj][m][0], v1 = acc[ai][bj][m][1];
                    const unsigned bw[4] = {b.x, b.y, b.z, b.w}; u32x4 w; unsigned* wp = (unsigned*)&w;
#pragma unroll
                    for (int q = 0; q < 4; ++q) { const float lo = __builtin_bit_cast(float, bw[q] << 16), hi = __builtin_bit_cast(float, bw[q] & 0xffff0000u);
                        const float a0 = q < 2 ? v0[2 * q] : v1[2 * q - 4], a1 = q < 2 ? v0[2 * q + 1] : v1[2 * q - 3];
                        wp[q] = cvt_pk_bf16(lo * alpha + a0, hi * alpha + a1); }
                    *(u32x4*)(out + off + bj * HALF) = w; } }
    }
};
struct EpiGLU {
    static constexpr bool PERM = true, AFTER_DRAIN = false;
    bf16_t* H; const float* winv;
    __device__ __forceinline__ void operator()(const f32x4 (&acc)[2][2][4][2], const Unit& u, int wr, int wc, int fr, int fq) const {
        const int row0 = u.pm * BM + wr * 64 + fr, f0 = (u.pn & 3) * 128 + wc * 32 + 8 * fq;
#pragma unroll
        for (int ai = 0; ai < 2; ++ai) { if (u.half >= 0 && u.half != ai) continue;
#pragma unroll
            for (int m = 0; m < 4; ++m) { const int row = row0 + ai * HALF + m * 16; const float w = winv[u.inv0 + ai * HALF + wr * 64 + m * 16 + fr];
                float h[8];
#pragma unroll
                for (int n = 0; n < 2; ++n)
#pragma unroll
                    for (int e = 0; e < 4; ++e) { const float g = acc[ai][0][m][n][e], up = acc[ai][1][m][n][e]; h[n * 4 + e] = g * __builtin_amdgcn_rcpf(1.0f + __expf(-g)) * up * w; }
                u32x4 o; o.x = cvt_pk_bf16(h[0], h[1]); o.y = cvt_pk_bf16(h[2], h[3]); o.z = cvt_pk_bf16(h[4], h[5]); o.w = cvt_pk_bf16(h[6], h[7]);
                *(u32x4*)(H + (size_t)row * 512 + f0) = o; } }
    }
};
struct EpiRope {
    static constexpr bool PERM = true, AFTER_DRAIN = false;
    bf16_t* O; const float* c128; const float* s128; const float* c64; const float* s64;
    __device__ __forceinline__ void operator()(const f32x4 (&acc)[2][2][4][2], const Unit& u, int wr, int wc, int fr, int fq) const {
        const int row0 = u.pm * BM + wr * 64 + fr, jj = wc * 32 + 8 * fq;
        const int pn = u.pn;
        if (pn == 10 || pn == 11) {
#pragma unroll
            for (int ai = 0; ai < 2; ++ai)
#pragma unroll
                for (int m = 0; m < 4; ++m) { bf16_t* rowp = O + (size_t)(row0 + ai * HALF + m * 16) * 4096 + pn * 256 + jj;
#pragma unroll
                    for (int bj = 0; bj < 2; ++bj) { const f32x4 v0 = acc[ai][bj][m][0], v1 = acc[ai][bj][m][1];
                        u32x4 w; w.x = cvt_pk_bf16(v0[0], v0[1]); w.y = cvt_pk_bf16(v0[2], v0[3]); w.z = cvt_pk_bf16(v1[0], v1[1]); w.w = cvt_pk_bf16(v1[2], v1[3]);
                        *(u32x4*)(rowp + bj * HALF) = w; } }
            return;
        }
        const bool idx = pn >= 12;
        const int half = idx ? 32 : 64;
        const int hl = idx ? (jj >> 5) : (jj >> 6), i0 = jj & (half - 1);
        const int colbase = idx ? (3072 + ((pn - 12) * 4 + hl) * 64) : (pn * 256 + hl * 128);
        const float* ct = idx ? c64 : c128; const float* st = idx ? s64 : s128;
#pragma unroll
        for (int ai = 0; ai < 2; ++ai)
#pragma unroll
            for (int m = 0; m < 4; ++m) { const int row = row0 + ai * HALF + m * 16; const int pos = row & 4095;
                const float* cp = ct + (size_t)pos * half + i0; const float* sp = st + (size_t)pos * half + i0;
                const f32x4 c0 = *(const f32x4*)cp, c1 = *(const f32x4*)(cp + 4), s0 = *(const f32x4*)sp, s1 = *(const f32x4*)(sp + 4);
                const f32x4 a0 = acc[ai][0][m][0], a1 = acc[ai][0][m][1], b0 = acc[ai][1][m][0], b1 = acc[ai][1][m][1];
                const f32x4 x0 = a0 * c0 - b0 * s0, x1 = a1 * c1 - b1 * s1, y0 = b0 * c0 + a0 * s0, y1 = b1 * c1 + a1 * s1;
                bf16_t* rowp = O + (size_t)row * 4096 + colbase + i0;
                u32x4 w; w.x = cvt_pk_bf16(x0[0], x0[1]); w.y = cvt_pk_bf16(x0[2], x0[3]); w.z = cvt_pk_bf16(x1[0], x1[1]); w.w = cvt_pk_bf16(x1[2], x1[3]);
                *(u32x4*)rowp = w;
                u32x4 z; z.x = cvt_pk_bf16(y0[0], y0[1]); z.y = cvt_pk_bf16(y0[2], y0[3]); z.z = cvt_pk_bf16(y1[0], y1[1]); z.w = cvt_pk_bf16(y1[2], y1[3]);
                *(u32x4*)(rowp + half) = z; }
    }
};
struct MoeOrder {
    int G, c, ntn, L0, Lend, hsplit; const PG8_LAS int* tend; const PG8_LAS int* cnt;
    __device__ __forceinline__ bool next(int i, Unit& u) const {
        int Lx = L0 + i * G + c; if (Lx >= Lend) return false;
        if (hsplit == 2) { const int x = c & 7, s = c >> 3; Lx = L0 + (x * (G >> 5) + (s >> 2)) * ntn + (s & 3); }
        const int L = hsplit == 1 ? Lx >> 1 : Lx;
        const int t = L / ntn; int e = 0;
#pragma unroll 1
        for (int k = 0; k < 32; ++k) e += (t >= tend[k]) ? 1 : 0;
        const int p0 = (t - (e ? tend[e - 1] : 0)) * BM, left = cnt[e] - p0;
        u.pm = t; u.pn = e * ntn + (L - t * ntn); u.inv0 = e * 8192 + p0; u.nvalid = left < BM ? left : BM; u.half = hsplit == 1 ? (Lx & 1) : -1; return true;
    }
    __device__ __forceinline__ void a_ready(const Unit&) const {}
    __device__ __forceinline__ void done(const Unit&) const {}
};
struct MoeReadyOrder : MoeOrder {
    const unsigned* ready; unsigned need; int wave;
    __device__ __forceinline__ void a_ready(const Unit& u) const {
        if (wave == 0) {
            unsigned polls = 0;
            while ((unsigned)__builtin_amdgcn_readfirstlane(__hip_atomic_load(ready + 32 * u.pm, __ATOMIC_RELAXED, __HIP_MEMORY_SCOPE_AGENT)) < need) {
                if (++polls > (1u << 21)) break;
                __builtin_amdgcn_s_sleep(2); }
            __builtin_amdgcn_fence(__ATOMIC_ACQUIRE, "agent");
            asm volatile("s_waitcnt vmcnt(0)" ::: "memory");
        }
        asm volatile("" ::: "memory"); __builtin_amdgcn_s_barrier(); asm volatile("" ::: "memory");
    }
};
template <class Epi, class Sched, bool ALIGN_EPI = false, bool SP2 = false>
__device__ __forceinline__ void gemm_phase(PG8_LAS unsigned char* lds, const Gemm g, const Sched& S, const Epi& E, const int tid_in) {
    const int tid = tid_in, wid = __builtin_amdgcn_readfirstlane(tid >> 6), lane = tid & 63, wr = wid >> 2, wc = wid & 3, fr = lane & 15, fq = lane >> 4;
    const int K = g.K, nt = K / BK;
    unsigned voffA[2], voffB[2];
#pragma unroll
    for (int i = 0; i < 2; ++i) { int R, C; stage_rc(tid * 16 + i * 8192, R, C); const int Rb = Epi::PERM ? ((R & ~31) + perm32(R & 31)) : R;
        voffA[i] = (unsigned)(R * g.lda + C) * 2u; voffB[i] = (unsigned)(Rb * g.ldb + C) * 2u; }
    const size_t kstep = (size_t)(BK * 2);
    const size_t hstepA = (size_t)HALF * g.lda * 2, hstepB = (size_t)HALF * g.ldb * 2;
    const size_t tstepA = 2 * hstepA, tstepB = 2 * hstepB;
    const unsigned ldsw = (unsigned)wid * 1024u;
    const int aoff = lds_byte(wr * 64 + fr, fq * 8), boff = lds_byte(wc * 32 + fr, fq * 8);
#define PG8_SA(b, h) (((b) * 2 + (h)) * HTB)
#define PG8_SB(b, h) ((4 + (b) * 2 + (h)) * HTB)
#define PG8_STAGE(bufoff, gbase, voff) do { _Pragma("unroll") for (int _i = 0; _i < 2; ++_i) \
        __builtin_amdgcn_global_load_lds((const unsigned*)((const char*)(gbase) + (voff)[_i]), (PG8_LAS unsigned*)(lds + (bufoff) + ldsw + _i * 8192), 16, 0, 0); } while (0)
#define PG8_LDA(dst, b, h) do { _Pragma("unroll") for (int m = 0; m < 4; ++m) _Pragma("unroll") for (int k = 0; k < 2; ++k) dst[m][k] = *(const PG8_LAS bf16x8*)(lds + PG8_SA(b, h) + aoff + m * 2048 + k * 1024); } while (0)
#define PG8_LDB(dst, b, h) do { _Pragma("unroll") for (int n = 0; n < 2; ++n) _Pragma("unroll") for (int k = 0; k < 2; ++k) dst[n][k] = *(const PG8_LAS bf16x8*)(lds + PG8_SB(b, h) + boff + n * 2048 + k * 1024); } while (0)
#define PG8_MMA(ai, bj, At, Bt) do { __builtin_amdgcn_s_setprio(1); _Pragma("unroll") for (int m = 0; m < 4; ++m) _Pragma("unroll") for (int n = 0; n < 2; ++n) _Pragma("unroll") for (int k = 0; k < 2; ++k) \
        acc[ai][bj][m][n] = __builtin_amdgcn_mfma_f32_16x16x32_bf16(Bt[n][k], At[m][k], acc[ai][bj][m][n], 0, 0, 0); __builtin_amdgcn_s_setprio(0); } while (0)
#define PG8_WAIT_V(n) asm volatile("s_waitcnt vmcnt(" #n ")" ::: "memory")
#define PG8_WAIT_L(n) asm volatile("s_waitcnt lgkmcnt(" #n ")" ::: "memory")
#define PG8_BAR __builtin_amdgcn_s_barrier()
#define PG8_SCHED __builtin_amdgcn_sched_barrier(0)
    Unit cur, nxt; int ui = 0;
    if (!S.next(0, cur)) return;
    f32x4 acc[2][2][4][2];
#pragma unroll
    for (int a = 0; a < 2; ++a)
#pragma unroll
        for (int b = 0; b < 2; ++b)
#pragma unroll
            for (int m = 0; m < 4; ++m)
#pragma unroll
                for (int n = 0; n < 2; ++n) acc[a][b][m][n] = (f32x4){0.f, 0.f, 0.f, 0.f};
    bf16x8 At[4][2], B0[2][2], B1[2][2];
    const char* cA = (const char*)g.A + (size_t)cur.pm * tstepA; const char* cB = (const char*)g.Bt + (size_t)cur.pn * tstepB;
    S.a_ready(cur);
    if constexpr (SP2) {
        PG8_STAGE(PG8_SB(0, 0), cB, voffB); PG8_STAGE(PG8_SB(0, 1), cB + hstepB, voffB); PG8_STAGE(PG8_SA(0, 0), cA, voffA); PG8_STAGE(PG8_SA(0, 1), cA + hstepA, voffA);
        if (wr == 1) PG8_BAR;
        PG8_WAIT_V(2); PG8_BAR;
        PG8_STAGE(PG8_SB(1, 0), cB + kstep, voffB); PG8_STAGE(PG8_SA(1, 0), cA + kstep, voffA); PG8_STAGE(PG8_SB(1, 1), cB + hstepB + kstep, voffB);
        PG8_WAIT_V(6); PG8_BAR;
    } else {
        PG8_STAGE(PG8_SB(0, 0), cB, voffB); PG8_STAGE(PG8_SA(0, 0), cA, voffA); PG8_STAGE(PG8_SB(0, 1), cB + hstepB, voffB); PG8_STAGE(PG8_SA(0, 1), cA + hstepA, voffA);
        if (wr == 1) PG8_BAR;
        PG8_WAIT_V(4); PG8_BAR;
        PG8_STAGE(PG8_SB(1, 0), cB + kstep, voffB); PG8_STAGE(PG8_SA(1, 0), cA + kstep, voffA); PG8_STAGE(PG8_SB(1, 1), cB + hstepB + kstep, voffB);
        PG8_WAIT_V(6); PG8_BAR;
    }
    for (;;) {
        const bool has_next = S.next(ui + 1, nxt);
        const char* nA = has_next ? (const char*)g.A + (size_t)nxt.pm * tstepA : cA; const char* nB = has_next ? (const char*)g.Bt + (size_t)nxt.pn * tstepB : cB;
        for (int t = 0; t < nt; t += 2) {
            const bool last = (t == nt - 2);
            const char* a1 = cA + (size_t)(t + 1) * kstep;
            const char* a2 = last ? nA : cA + (size_t)(t + 2) * kstep; const char* b2 = last ? nB : cB + (size_t)(t + 2) * kstep;
            const char* a3 = a2 + kstep; const char* b3 = b2 + kstep;
            if (last && has_next) S.a_ready(nxt);
            if constexpr (SP2) {
            PG8_LDB(B0, 0, 0); PG8_LDB(B1, 0, 1); PG8_SCHED; PG8_LDA(At, 0, 0); PG8_STAGE(PG8_SA(1, 1), a1 + hstepA, voffA);
            PG8_WAIT_V(8); PG8_WAIT_L(0); PG8_BAR; PG8_MMA(0, 0, At, B0); PG8_MMA(0, 1, At, B1); PG8_BAR; PG8_SCHED;
            PG8_LDA(At, 0, 1); PG8_STAGE(PG8_SB(0, 0), b2, voffB); PG8_STAGE(PG8_SB(0, 1), b2 + hstepB, voffB); PG8_STAGE(PG8_SA(0, 0), a2, voffA);
            PG8_WAIT_V(8); PG8_WAIT_L(0); PG8_BAR; PG8_MMA(1, 0, At, B0); PG8_MMA(1, 1, At, B1); PG8_BAR; PG8_SCHED;
            PG8_LDB(B0, 1, 0); PG8_LDB(B1, 1, 1); PG8_SCHED; PG8_LDA(At, 1, 0); PG8_STAGE(PG8_SA(0, 1), a2 + hstepA, voffA);
            PG8_WAIT_V(8); PG8_WAIT_L(0); PG8_BAR; PG8_MMA(0, 0, At, B0); PG8_MMA(0, 1, At, B1); PG8_BAR; PG8_SCHED;
            PG8_LDA(At, 1, 1); PG8_STAGE(PG8_SB(1, 0), b3, voffB); PG8_STAGE(PG8_SB(1, 1), b3 + hstepB, voffB); PG8_STAGE(PG8_SA(1, 0), a3, voffA);
            PG8_WAIT_V(8); PG8_WAIT_L(0); PG8_BAR; PG8_MMA(1, 0, At, B0); PG8_MMA(1, 1, At, B1); PG8_BAR; PG8_SCHED;
            } else {
            PG8_LDB(B0, 0, 0); PG8_SCHED; PG8_LDA(At, 0, 0); PG8_STAGE(PG8_SA(1, 1), a1 + hstepA, voffA);
            PG8_WAIT_L(8); PG8_BAR; PG8_WAIT_L(0); PG8_MMA(0, 0, At, B0); PG8_BAR; PG8_SCHED;
            PG8_LDB(B1, 0, 1); PG8_STAGE(PG8_SB(0, 0), b2, voffB);
            PG8_BAR; PG8_WAIT_L(0); PG8_MMA(0, 1, At, B1); PG8_BAR;
            PG8_LDA(At, 0, 1); PG8_STAGE(PG8_SA(0, 0), a2, voffA);
            PG8_BAR; PG8_WAIT_L(0); PG8_MMA(1, 0, At, B0); PG8_BAR; PG8_SCHED;
            PG8_STAGE(PG8_SB(0, 1), b2 + hstepB, voffB);
            PG8_WAIT_V(6); PG8_BAR; PG8_MMA(1, 1, At, B1); PG8_BAR;
            PG8_LDB(B0, 1, 0); PG8_SCHED; PG8_LDA(At, 1, 0); PG8_STAGE(PG8_SA(0, 1), a2 + hstepA, voffA);
            PG8_WAIT_L(8); PG8_BAR; PG8_WAIT_L(0); PG8_MMA(0, 0, At, B0); PG8_BAR; PG8_SCHED;
            PG8_LDB(B1, 1, 1); PG8_STAGE(PG8_SB(1, 0), b3, voffB);
            PG8_BAR; PG8_WAIT_L(0); PG8_MMA(0, 1, At, B1); PG8_BAR;
            PG8_LDA(At, 1, 1); PG8_STAGE(PG8_SA(1, 0), a3, voffA);
            PG8_BAR; PG8_WAIT_L(0); PG8_MMA(1, 0, At, B0); PG8_BAR; PG8_SCHED;
            PG8_STAGE(PG8_SB(1, 1), b3 + hstepB, voffB);
            PG8_WAIT_V(6); PG8_BAR; PG8_MMA(1, 1, At, B1); PG8_BAR;
            }
        }
        if constexpr (ALIGN_EPI) { if (wr == 0) PG8_BAR; }
        if constexpr (!Epi::AFTER_DRAIN) { E(acc, cur, wr, wc, fr, fq); S.done(cur); }
        if (!has_next) break;
#pragma unroll
        for (int a = 0; a < 2; ++a)
#pragma unroll
            for (int b = 0; b < 2; ++b)
#pragma unroll
                for (int m = 0; m < 4; ++m)
#pragma unroll
                    for (int n = 0; n < 2; ++n) acc[a][b][m][n] = (f32x4){0.f, 0.f, 0.f, 0.f};
        cur = nxt; cA = nA; cB = nB; ++ui;
        if constexpr (ALIGN_EPI) { if (wr == 1) PG8_BAR; }
    }
    PG8_WAIT_V(0);
    if constexpr (!ALIGN_EPI) { if (wr == 0) PG8_BAR; }
    PG8_BAR;
    if constexpr (Epi::AFTER_DRAIN) { E.fused(acc, cur, wr, wc, fr, fq, lds, wid, lane); S.done(cur); }
#undef PG8_SA
#undef PG8_SB
#undef PG8_STAGE
#undef PG8_LDA
#undef PG8_LDB
#undef PG8_MMA
#undef PG8_WAIT_V
#undef PG8_WAIT_L
#undef PG8_BAR
#undef PG8_SCHED
}
template <class Epi, class Sched>
__device__ __forceinline__ void gemm_phase_g(PG8_LAS unsigned char* lds, const Gemm g, const Sched& S, const Epi& E, const int* inv, const int tid_in) {
    constexpr bool ALIGN_EPI = true;
    const int tid = tid_in, wid = __builtin_amdgcn_readfirstlane(tid >> 6), lane = tid & 63, wr = wid >> 2, wc = wid & 3, fr = lane & 15, fq = lane >> 4;
    const int K = g.K, nt = K / BK;
    unsigned voffA[2], voffB[2];
#pragma unroll
    for (int i = 0; i < 2; ++i) { int R, C; stage_rc(tid * 16 + i * 8192, R, C); const int Rb = Epi::PERM ? ((R & ~31) + perm32(R & 31)) : R;
        voffA[i] = (unsigned)(R * g.lda + C) * 2u; voffB[i] = (unsigned)(Rb * g.ldb + C) * 2u; }
    const size_t kstep = (size_t)(BK * 2);
    const size_t hstepA = (size_t)HALF * g.lda * 2, hstepB = (size_t)HALF * g.ldb * 2;
    const size_t tstepA = 2 * hstepA, tstepB = 2 * hstepB;
    const unsigned ldsw = (unsigned)wid * 1024u;
    const int aoff = lds_byte(wr * 64 + fr, fq * 8), boff = lds_byte(wc * 32 + fr, fq * 8);
#define PG8_SA(b, h) (((b) * 2 + (h)) * HTB)
#define PG8_SB(b, h) ((4 + (b) * 2 + (h)) * HTB)
#define PG8_STAGE(bufoff, gbase, voff) do { _Pragma("unroll") for (int _i = 0; _i < 2; ++_i) \
        __builtin_amdgcn_global_load_lds((const unsigned*)((const char*)(gbase) + (voff)[_i]), (PG8_LAS unsigned*)(lds + (bufoff) + ldsw + _i * 8192), 16, 0, 0); } while (0)
#define PG8_LDA(dst, b, h) do { _Pragma("unroll") for (int m = 0; m < 4; ++m) _Pragma("unroll") for (int k = 0; k < 2; ++k) dst[m][k] = *(const PG8_LAS bf16x8*)(lds + PG8_SA(b, h) + aoff + m * 2048 + k * 1024); } while (0)
#define PG8_LDB(dst, b, h) do { _Pragma("unroll") for (int n = 0; n < 2; ++n) _Pragma("unroll") for (int k = 0; k < 2; ++k) dst[n][k] = *(const PG8_LAS bf16x8*)(lds + PG8_SB(b, h) + boff + n * 2048 + k * 1024); } while (0)
#define PG8_MMA(ai, bj, At, Bt) do { __builtin_amdgcn_s_setprio(1); _Pragma("unroll") for (int m = 0; m < 4; ++m) _Pragma("unroll") for (int n = 0; n < 2; ++n) _Pragma("unroll") for (int k = 0; k < 2; ++k) \
        acc[ai][bj][m][n] = __builtin_amdgcn_mfma_f32_16x16x32_bf16(Bt[n][k], At[m][k], acc[ai][bj][m][n], 0, 0, 0); __builtin_amdgcn_s_setprio(0); } while (0)
#define PG8_WAIT_V(n) asm volatile("s_waitcnt vmcnt(" #n ")" ::: "memory")
#define PG8_WAIT_L(n) asm volatile("s_waitcnt lgkmcnt(" #n ")" ::: "memory")
#define PG8_BAR __builtin_amdgcn_s_barrier()
#define PG8_SCHED __builtin_amdgcn_sched_barrier(0)
    Unit cur, nxt; int ui = 0;
    if (!S.next(0, cur)) return;
    f32x4 acc[2][2][4][2];
#pragma unroll
    for (int a = 0; a < 2; ++a)
#pragma unroll
        for (int b = 0; b < 2; ++b)
#pragma unroll
            for (int m = 0; m < 4; ++m)
#pragma unroll
                for (int n = 0; n < 2; ++n) acc[a][b][m][n] = (f32x4){0.f, 0.f, 0.f, 0.f};
    bf16x8 At[4][2], B0[2][2], B1[2][2];
    const char* cA = (const char*)g.A; const char* cB = (const char*)g.Bt + (size_t)cur.pn * tstepB;
    S.a_ready(cur);
    unsigned vc[2][2], vn[2][2];
#define PG8_ROWS(u_, vo_) do { _Pragma("unroll") for (int h_ = 0; h_ < 2; ++h_) _Pragma("unroll") for (int i_ = 0; i_ < 2; ++i_) { int R_, C_; stage_rc(tid * 16 + i_ * 8192, R_, C_); const int r_ = h_ * HALF + R_; \
        const int tok_ = r_ < (u_).nvalid ? inv[(u_).inv0 + r_] : 0; vo_[h_][i_] = (unsigned)(tok_ * g.lda + C_) * 2u; } } while (0)
    PG8_ROWS(cur, vc);
    {
        PG8_STAGE(PG8_SB(0, 0), cB, voffB); PG8_STAGE(PG8_SB(0, 1), cB + hstepB, voffB); PG8_STAGE(PG8_SA(0, 0), cA, vc[0]); PG8_STAGE(PG8_SA(0, 1), cA, vc[1]);
        if (wr == 1) PG8_BAR;
        PG8_WAIT_V(2); PG8_BAR;
        PG8_STAGE(PG8_SB(1, 0), cB + kstep, voffB); PG8_STAGE(PG8_SA(1, 0), cA + kstep, vc[0]); PG8_STAGE(PG8_SB(1, 1), cB + hstepB + kstep, voffB);
        PG8_WAIT_V(6); PG8_BAR;
    }
    for (;;) {
        const bool has_next = S.next(ui + 1, nxt);
        if (has_next) { PG8_ROWS(nxt, vn); } else {
#pragma unroll
            for (int h_ = 0; h_ < 2; ++h_) { vn[h_][0] = vc[h_][0]; vn[h_][1] = vc[h_][1]; } }
        const char* nA = cA; const char* nB = has_next ? (const char*)g.Bt + (size_t)nxt.pn * tstepB : cB;
        const bool do0 = cur.half != 1, do1 = cur.half != 0;
        for (int t = 0; t < nt; t += 2) {
            const bool last = (t == nt - 2);
            unsigned v2[2][2];
#pragma unroll
            for (int h_ = 0; h_ < 2; ++h_) { v2[h_][0] = last ? vn[h_][0] : vc[h_][0]; v2[h_][1] = last ? vn[h_][1] : vc[h_][1]; }
            const char* a1 = cA + (size_t)(t + 1) * kstep;
            const char* a2 = last ? nA : cA + (size_t)(t + 2) * kstep; const char* b2 = last ? nB : cB + (size_t)(t + 2) * kstep;
            const char* a3 = a2 + kstep; const char* b3 = b2 + kstep;
            if (last && has_next) S.a_ready(nxt);
            {
            PG8_LDB(B0, 0, 0); PG8_LDB(B1, 0, 1); PG8_SCHED; if (do0) { PG8_LDA(At, 0, 0); } PG8_STAGE(PG8_SA(1, 1), a1, vc[1]);
            PG8_WAIT_V(8); PG8_WAIT_L(0); PG8_BAR; if (do0) { PG8_MMA(0, 0, At, B0); PG8_MMA(0, 1, At, B1); } PG8_BAR; PG8_SCHED;
            if (do1) { PG8_LDA(At, 0, 1); } PG8_STAGE(PG8_SB(0, 0), b2, voffB); PG8_STAGE(PG8_SB(0, 1), b2 + hstepB, voffB); PG8_STAGE(PG8_SA(0, 0), a2, v2[0]);
            PG8_WAIT_V(8); PG8_WAIT_L(0); PG8_BAR; if (do1) { PG8_MMA(1, 0, At, B0); PG8_MMA(1, 1, At, B1); } PG8_BAR; PG8_SCHED;
            PG8_LDB(B0, 1, 0); PG8_LDB(B1, 1, 1); PG8_SCHED; if (do0) { PG8_LDA(At, 1, 0); } PG8_STAGE(PG8_SA(0, 1), a2, v2[1]);
            PG8_WAIT_V(8); PG8_WAIT_L(0); PG8_BAR; if (do0) { PG8_MMA(0, 0, At, B0); PG8_MMA(0, 1, At, B1); } PG8_BAR; PG8_SCHED;
            if (do1) { PG8_LDA(At, 1, 1); } PG8_STAGE(PG8_SB(1, 0), b3, voffB); PG8_STAGE(PG8_SB(1, 1), b3 + hstepB, voffB); PG8_STAGE(PG8_SA(1, 0), a3, v2[0]);
            PG8_WAIT_V(8); PG8_WAIT_L(0); PG8_BAR; if (do1) { PG8_MMA(1, 0, At, B0); PG8_MMA(1, 1, At, B1); } PG8_BAR; PG8_SCHED;
            }
        }
        if constexpr (ALIGN_EPI) { if (wr == 0) PG8_BAR; }
        if constexpr (!Epi::AFTER_DRAIN) { E(acc, cur, wr, wc, fr, fq); S.done(cur); }
        if (!has_next) break;
#pragma unroll
        for (int a = 0; a < 2; ++a)
#pragma unroll
            for (int b = 0; b < 2; ++b)
#pragma unroll
                for (int m = 0; m < 4; ++m)
#pragma unroll
                    for (int n = 0; n < 2; ++n) acc[a][b][m][n] = (f32x4){0.f, 0.f, 0.f, 0.f};
        cur = nxt; cA = nA; cB = nB; ++ui;
#pragma unroll
        for (int h_ = 0; h_ < 2; ++h_) { vc[h_][0] = vn[h_][0]; vc[h_][1] = vn[h_][1]; }
        if constexpr (ALIGN_EPI) { if (wr == 1) PG8_BAR; }
    }
    PG8_WAIT_V(0);
    if constexpr (!ALIGN_EPI) { if (wr == 0) PG8_BAR; }
    PG8_BAR;
    if constexpr (Epi::AFTER_DRAIN) { E.fused(acc, cur, wr, wc, fr, fq, lds, wid, lane); S.done(cur); }
#undef PG8_ROWS
#undef PG8_SA
#undef PG8_SB
#undef PG8_STAGE
#undef PG8_LDA
#undef PG8_LDB
#undef PG8_MMA
#undef PG8_WAIT_V
#undef PG8_WAIT_L
#undef PG8_BAR
#undef PG8_SCHED
}
}
constexpr int BATCH = 2, SEQ = 4096, DM = 2048, MTOK = BATCH * SEQ;
constexpr int NE0 = 6168, NE1 = 4176;
constexpr int NP0 = 6144, NP1 = 4096;
constexpr float LN_EPS = 1e-5f;
constexpr float DN_ALPHA = 1.41421356237309515f;
constexpr float ATT_SCALE = 0.08838834764831845f;
constexpr int RPAD = 24576;
constexpr size_t MiB = 1u << 20;
constexpr size_t WS_CTL = 0, CTL_ZERO_BYTES = 128 * 1024;
constexpr size_t WS_ROPE = 1 * MiB;
constexpr size_t WS_WSM = 4 * MiB;
constexpr size_t WS_SK0 = 6 * MiB;
constexpr size_t WS_IK = 7 * MiB;
constexpr size_t WS_IW = 8 * MiB + 512 * 1024;
constexpr size_t WS_FBIAS = 10 * MiB;
constexpr size_t WS_ROUTE = 11 * MiB;
constexpr size_t WS_MASK = 12 * MiB;
constexpr size_t WS_WINA = 16 * MiB, WS_WOA = 40 * MiB, WS_WINC = 48 * MiB, WS_WOC = 64 * MiB;
constexpr size_t WS_WGU = 72 * MiB;
constexpr size_t WS_WD = 328 * MiB;
constexpr size_t WS_XB = 456 * MiB;
constexpr size_t WS_YB = 488 * MiB;
constexpr size_t WS_PROJ = 552 * MiB;
constexpr size_t WS_CST = 648 * MiB;
constexpr size_t WS_PREVT = 712 * MiB;
constexpr size_t WS_OMIX = 744 * MiB;
constexpr size_t WS_GB = 776 * MiB;
constexpr size_t WS_DEC = 792 * MiB;
constexpr size_t WS_ROWW = 793 * MiB;
constexpr size_t WS_SC = 800 * MiB;
constexpr size_t WS_INV = 800 * MiB;
constexpr size_t WS_WINV = 801 * MiB;
constexpr size_t WS_END = 928 * MiB;
constexpr int CW_CNT = 1024;
constexpr int CW_FILL = 2048;
constexpr int CW_RDY = 16384;
constexpr int CW_BAR = 4096;

#define GAS __attribute__((address_space(1)))
#define LAS __attribute__((address_space(3)))
typedef unsigned short bf16;
typedef unsigned v4u __attribute__((ext_vector_type(4)));
typedef unsigned v2u __attribute__((ext_vector_type(2)));
typedef float f32x4 __attribute__((ext_vector_type(4)));
typedef short bf16x8 __attribute__((ext_vector_type(8)));
#define LDS_WAIT() asm volatile("s_waitcnt lgkmcnt(0)" ::: "memory")
#define VM_WAIT() asm volatile("s_waitcnt vmcnt(0)" ::: "memory")
__device__ __forceinline__ unsigned f2bf(float f) { unsigned u = __builtin_bit_cast(unsigned, f); return (u + 0x7fffu + ((u >> 16) & 1u)) >> 16; }
__device__ __forceinline__ unsigned pk2(float lo, float hi) { return f2bf(lo) | (f2bf(hi) << 16); }
__device__ __forceinline__ float bf2f(unsigned short b) { return __builtin_bit_cast(float, ((unsigned)b) << 16); }
__device__ __forceinline__ float wave_sum(float v) {
#pragma unroll
    for (int o = 1; o < 64; o <<= 1) v += __shfl_xor(v, o);
    return v;
}
__device__ __forceinline__ float logsigmoidf(float z) { return fminf(z, 0.f) - log1pf(__expf(-fabsf(z))); }
#define XB_TMO      128
#define XB_XCNT(j)  (256  + 64 * (j))
#define XB_XSUB(j)  (1280 + 64 * (j))
#define XB_XGEN(j)  (2304 + 64 * (j))
#define XB_TOP      3328
#define XB_TOPGEN   3392
#define XCD_BAR_WORDS 3456
#define XB_SPIN_CAP (1u << 21)

__device__ __forceinline__ unsigned xb_ld(unsigned* p)              { return __hip_atomic_load(p, __ATOMIC_RELAXED, __HIP_MEMORY_SCOPE_AGENT); }
__device__ __forceinline__ unsigned xb_add(unsigned* p, unsigned v) { return __hip_atomic_fetch_add(p, v, __ATOMIC_RELAXED, __HIP_MEMORY_SCOPE_AGENT); }
__device__ __forceinline__ unsigned xb_xcc_id() { return (unsigned)__builtin_amdgcn_s_getreg((3 << 11) | 20) & 0xFu; }
#define XB_SPIN(cond, bar) do { unsigned _sp = 0; while (cond) { __builtin_amdgcn_s_sleep(1); \
    if ((++_sp & 255u) == 0u) { if (xb_ld(&(bar)[XB_TMO])) break; if (_sp > XB_SPIN_CAP) { atomicAdd(&(bar)[XB_TMO], 1u); break; } } } } while (0)

struct XcdBarrier {
    unsigned* bar; unsigned x;
    volatile LAS unsigned* st;
};

__device__ __forceinline__ XcdBarrier xcd_barrier_post(unsigned* bar, volatile LAS unsigned* st) {
    XcdBarrier b; b.bar = bar; b.x = xb_xcc_id(); b.st = st;
    if (threadIdx.x == 0) (void)xb_add(&bar[XB_XCNT(b.x)], 1u);
    return b;
}
__device__ __forceinline__ void xcd_barrier_complete(unsigned* bar, unsigned x, unsigned& nloc, unsigned& nx) {
    const unsigned G = gridDim.x * gridDim.y * gridDim.z;
    unsigned sum, cnt, mine, sp = 0u;
    for (;;) {
        sum = 0u; cnt = 0u; mine = 0u;
#pragma unroll
        for (unsigned j = 0; j < 16; ++j) { const unsigned c = xb_ld(&bar[XB_XCNT(j)]); sum += c; cnt += (c > 0u) ? 1u : 0u; mine = (j == x) ? c : mine; }
        if (sum == G) break;
        __builtin_amdgcn_s_sleep(1);
        if ((++sp & 255u) == 0u) { if (xb_ld(&bar[XB_TMO])) break; if (sp > XB_SPIN_CAP) { atomicAdd(&bar[XB_TMO], 1u); break; } }
    }
    nloc = mine > 0u ? mine : 1u; nx = cnt > 0u ? cnt : 1u;
}

__device__ __forceinline__ void xcd_barrier(const XcdBarrier& b, const int tid) {
    asm volatile("s_waitcnt vmcnt(0)" ::: "memory");
    __syncthreads();
    if (tid == 0) {
        unsigned* bar = b.bar;
        __builtin_amdgcn_s_waitcnt(0);
        unsigned nloc = b.st[0], nx = b.st[1];
        if (nloc == 0u) { xcd_barrier_complete(bar, b.x, nloc, nx); b.st[0] = nloc; b.st[1] = nx; }
        const unsigned old = xb_add(&bar[XB_XSUB(b.x)], 1u);
        const unsigned gen = old / nloc;
        if (old + 1u == (gen + 1u) * nloc) {
            __builtin_amdgcn_fence(__ATOMIC_RELEASE, "agent");
            asm volatile("s_waitcnt vmcnt(0)" ::: "memory");
            const unsigned og = xb_add(&bar[XB_TOP], 1u);
            const unsigned tg = og / nx;
            if (og + 1u == (tg + 1u) * nx) xb_add(&bar[XB_TOPGEN], 1u);
            else XB_SPIN(xb_ld(&bar[XB_TOPGEN]) == tg, bar);
            __builtin_amdgcn_fence(__ATOMIC_ACQUIRE, "agent");
            xb_add(&bar[XB_XGEN(b.x)], 1u);
            asm volatile("s_waitcnt vmcnt(0)" ::: "memory");
        } else {
            XB_SPIN(xb_ld(&bar[XB_XGEN(b.x)]) == gen, bar);
            __builtin_amdgcn_fence(__ATOMIC_ACQUIRE, "agent");
            asm volatile("s_waitcnt vmcnt(0)" ::: "memory");
        }
    }
    __syncthreads();
}

constexpr int NWAVES = 8;
constexpr int RING_BYTES = 131072;
constexpr int LDSCTL_OFF = RING_BYTES;
constexpr int LDS_BYTES = 147456;
struct Frame {
    LAS unsigned char* lds; volatile LAS unsigned* MISC; unsigned* ctl;
    int tid, lane, wave, G, gw, NGW;
    unsigned char* ws;
    __device__ __forceinline__ void refresh() { int l; asm volatile("v_mbcnt_lo_u32_b32 %0, -1, 0\n\tv_mbcnt_hi_u32_b32 %0, -1, %0" : "=v"(l)); lane = l; tid = wave * 64 + l; }
};
struct Args { const float* in[20]; float* out; unsigned char* ws; int ph_lo, ph_hi, bar_region, pad; };

struct TrItem { const float* W; bf16* WT; int ldw, c0, c1, K, n0, k0; };
__device__ __forceinline__ void tr64_load(const TrItem& t, f32x4 (&r)[16], int lane) {
    const int nq = lane & 15, kr = lane >> 4;
    const float* src = t.W + (size_t)(t.k0 + 2 * kr) * t.ldw + (nq < 8 ? t.c0 : t.c1 - 32) + 4 * nq;
#pragma unroll
    for (int i = 0; i < 8; ++i) { r[2 * i] = __builtin_nontemporal_load((const f32x4*)(src + (size_t)(8 * i) * t.ldw)); r[2 * i + 1] = __builtin_nontemporal_load((const f32x4*)(src + (size_t)(8 * i + 1) * t.ldw)); }
}
__device__ __forceinline__ void tr64_store(const TrItem& t, const f32x4 (&r)[16], LAS bf16* T, int lane) {
    const int nq = lane & 15, kr = lane >> 4;
#pragma unroll
    for (int i = 0; i < 8; ++i) { const int kk = 8 * i + 2 * kr;
#pragma unroll
        for (int e = 0; e < 4; ++e) *(LAS unsigned*)(T + (4 * nq + e) * 68 + kk) = pg8::cvt_pk_bf16(r[2 * i][e], r[2 * i + 1][e]); }
    LDS_WAIT(); asm volatile("" ::: "memory");
    const int c = lane & 7;
#pragma unroll
    for (int j = 0; j < 8; ++j) { const int n = (lane >> 3) + 8 * j; const v2u lo = *(const LAS v2u*)(T + n * 68 + 8 * c), hi = *(const LAS v2u*)(T + n * 68 + 8 * c + 4);
        v4u o; o.x = lo.x; o.y = lo.y; o.z = hi.x; o.w = hi.y;
        __builtin_nontemporal_store(o, (v4u*)(t.WT + (size_t)(t.n0 + n) * t.K + t.k0 + 8 * c)); }
    LDS_WAIT(); asm volatile("" ::: "memory");
}
__device__ __forceinline__ void transpose_item64(const float* W, int ldw, int c0, int c1, int K, bf16* WT, int n0, int k0, LAS bf16* T, int lane) {
    const TrItem t{W, WT, ldw, c0, c1, K, n0, k0}; f32x4 r[16]; tr64_load(t, r, lane); tr64_store(t, r, T, lane);
}
__device__ __forceinline__ int l1_src_col(int n) {
    const int pn = n >> 8, j = n & 255, jh = j & 127, second = j >> 7;
    if (pn == 10 || pn == 11) return n;
    if (pn < 10) return pn * 256 + (jh >> 6) * 128 + second * 64 + (jh & 63);
    return 3072 + ((pn - 12) * 4 + (jh >> 5)) * 64 + second * 32 + (jh & 31);
}
constexpr int SKU_ROUTE0 = 0, SKU_ROUTE1 = 3, SKU_SK0 = 6, SKU_SK1 = 10, SKU_TILES = 15;
constexpr int SK_PART_OFF = 0, SK_LG_OFF = 40960;
__host__ __device__ constexpr int sk_nbuf(int ntx) { return 120 / (8 * ntx) > 8 ? 8 : 120 / (8 * ntx); }
__device__ __forceinline__ size_t skf_off(int tile0, int ntx, int n, int k, int l15) { return (size_t)tile0 * 2048 * 16 + ((((size_t)(k >> 8) * ntx + n) * 8 + ((k >> 5) & 7)) * 64 + ((k >> 3) & 3) * 16 + l15) * 8 + (k & 7); }
template <int NTX> __device__ __forceinline__ void skinny_stage(LAS unsigned char* ldsb, const bf16* W, int chunk, int tid, int w) {
    const char* src = (const char*)(W + (size_t)chunk * NTX * 4096) + tid * 16; LAS unsigned char* dst = ldsb + (chunk % sk_nbuf(NTX)) * (NTX * 8192) + w * 1024;
#pragma unroll
    for (int i = 0; i < NTX; ++i) __builtin_amdgcn_global_load_lds((const unsigned*)(src + i * 8192), (LAS unsigned*)(dst + i * 8192), 16, 0, 0);
}
template <int NTX> __device__ __forceinline__ void skinny_prefetch(LAS unsigned char* ldsb, const bf16* W, int tid, int w) {
    asm volatile("" : "+v"(tid));
#pragma unroll
    for (int c = 0; c < sk_nbuf(NTX); ++c) skinny_stage<NTX>(ldsb, W, c, tid, w);
}
__device__ __forceinline__ void sk_bar() { asm volatile("" ::: "memory"); __builtin_amdgcn_s_barrier(); asm volatile("" ::: "memory"); }
template <int N> __device__ __forceinline__ void sk_wait_v() { asm volatile("" ::: "memory"); __builtin_amdgcn_s_waitcnt((N & 15) | (7 << 4) | (15 << 8) | ((N >> 4) << 14)); asm volatile("" ::: "memory"); }
template <int NTX, int NT> __device__ __forceinline__ void skinny_mm(LAS unsigned char* ldsb, const bf16* X, const bf16* W, int w, int lane, int tid) {
    constexpr int NBUF = sk_nbuf(NTX);
    asm volatile("" : "+v"(lane), "+v"(tid));
    const int tile = w >> 2, sub = w & 3, l15 = lane & 15, quad = lane >> 4;
    const bf16* xp = X + (size_t)(16 * tile + l15) * DM + sub * 64 + quad * 8;
    bf16x8 a[16];
#pragma unroll
    for (int c = 0; c < 8; ++c) { a[2 * c] = *(const bf16x8*)(xp + c * 256); a[2 * c + 1] = *(const bf16x8*)(xp + c * 256 + 32); }
    pg8::f32x4 acc[NTX];
#pragma unroll
    for (int n = 0; n < NTX; ++n) acc[n] = (pg8::f32x4){0.f, 0.f, 0.f, 0.f};
#pragma unroll
    for (int c = 0; c < 8; ++c) {
        const bool refill = c >= 1 && c - 1 + NBUF < 8;
        if (c == 0) { sk_wait_v<0>(); sk_bar(); }
        else if (c >= NBUF) {
            const int younger = 7 - c < NBUF - 2 ? 7 - c : NBUF - 2;
            if (younger <= 0) sk_wait_v<0>(); else if (younger == 1) sk_wait_v<NTX>(); else if (younger == 2) sk_wait_v<2 * NTX>(); else sk_wait_v<3 * NTX>();
            sk_bar(); }
        else if (refill) sk_bar();
        if (refill) skinny_stage<NTX>(ldsb, W, c - 1 + NBUF, tid, w);
        const LAS unsigned char* B = ldsb + (c % NBUF) * (NTX * 8192);
#pragma unroll
        for (int j = 0; j < 2; ++j)
#pragma unroll
            for (int n = 0; n < NTX; ++n) { const bf16x8 b = *(const LAS bf16x8*)(B + ((n * 8 + 2 * sub + j) * 64 + lane) * 16);
                acc[n] = __builtin_amdgcn_mfma_f32_16x16x32_bf16(a[2 * c + j], b, acc[n], 0, 0, 0); }
    }
    __syncthreads();
    LAS float* PART = (LAS float*)(ldsb + SK_PART_OFF);
#pragma unroll
    for (int n = 0; n < NT; ++n) { pg8::f32x4 r = acc[n]; if constexpr (NTX == 2 * NT) r = r + acc[n + NT];
        *(LAS pg8::f32x4*)(PART + ((((tile * 4 + sub) * NT + n) * 64 + lane) * 4)) = r; }
}
template <int NT> __device__ __forceinline__ void skinny_reduce(LAS unsigned char* ldsb, int tid) {
    const LAS float* PART = (const LAS float*)(ldsb + SK_PART_OFF); LAS float* LG = (LAS float*)(ldsb + SK_LG_OFF);
    for (int idx = tid; idx < 32 * 16 * NT; idx += NWAVES * 64) { const int row = idx / (16 * NT), col = idx % (16 * NT), tile = row >> 4, rr = row & 15, ln = (rr >> 2) * 16 + (col & 15), n = col >> 4, j = rr & 3;
        float s = 0.f;
#pragma unroll
        for (int kq = 0; kq < 4; ++kq) s += PART[(((tile * 4 + kq) * NT + n) * 64 + ln) * 4 + j];
        LG[row * (16 * NT) + col] = s; }
}
__device__ __forceinline__ void ln_row(f32x4 (&v)[8], const float* g, const float* b, int lane) {
    float s = 0.f;
#pragma unroll
    for (int j = 0; j < 8; ++j) s += (v[j][0] + v[j][1]) + (v[j][2] + v[j][3]);
    const float mean = wave_sum(s) * (1.f / DM); float s2 = 0.f;
#pragma unroll
    for (int j = 0; j < 8; ++j) { v[j] = v[j] - mean; s2 += (v[j][0] * v[j][0] + v[j][1] * v[j][1]) + (v[j][2] * v[j][2] + v[j][3] * v[j][3]); }
    const float rstd = 1.f / sqrtf(wave_sum(s2) * (1.f / DM) + LN_EPS);
#pragma unroll
    for (int j = 0; j < 8; ++j) { const f32x4 gg = *(const f32x4*)(g + 256 * j + 4 * lane), bb = *(const f32x4*)(b + 256 * j + 4 * lane); v[j] = v[j] * rstd * gg + bb; }
}
__device__ __forceinline__ void load_row_bf16(const bf16* src, f32x4 (&v)[8], int lane) {
#pragma unroll
    for (int j = 0; j < 8; ++j) { const uint2 p = *(const uint2*)(src + 256 * j + 4 * lane); v[j][0] = bf2f(p.x & 0xffff); v[j][1] = bf2f(p.x >> 16); v[j][2] = bf2f(p.y & 0xffff); v[j][3] = bf2f(p.y >> 16); }
}
__device__ __forceinline__ void store_row_bf16(bf16* dst, const f32x4 (&v)[8], int lane) {
#pragma unroll
    for (int j = 0; j < 8; ++j) { uint2 o; o.x = pg8::cvt_pk_bf16(v[j][0], v[j][1]); o.y = pg8::cvt_pk_bf16(v[j][2], v[j][3]); *(uint2*)(dst + 256 * j + 4 * lane) = o; }
}
#define TK_FOR_VALID(...) _Pragma("unroll") for (int g_ = 0; g_ < 8; ++g_) { if (512 * g_ <= qpos) { _Pragma("unroll") for (int i = 8 * g_; i < 8 * g_ + 8; ++i) { __VA_ARGS__ } } }
__device__ __forceinline__ void topk_mask_row(const LAS float* sc, int qpos, unsigned long long* mrow, int lane, LAS unsigned* cbuf) {
    unsigned u[64];
#pragma unroll
    for (int g_ = 0; g_ < 8; ++g_) {
        if (512 * g_ <= qpos) {
            const bool full = 512 * g_ + 511 <= qpos;
#pragma unroll
            for (int i = 8 * g_; i < 8 * g_ + 8; ++i) { const unsigned b = __builtin_bit_cast(unsigned, sc[64 * i + lane]);
                const unsigned key = b ^ ((unsigned)((int)b >> 31) | 0x80000000u);
                u[i] = (full || 64 * i + lane <= qpos) ? key : 0u; } }
        else {
#pragma unroll
            for (int i = 8 * g_; i < 8 * g_ + 8; ++i) u[i] = 0u; } }
    unsigned long long mword = 0ull;
    if (qpos + 1 <= 256) {
#pragma unroll
        for (int i = 0; i < 4; ++i) { const unsigned long long w = __ballot(64 * i + lane <= qpos); mword = (lane == i) ? w : mword; }
        mrow[lane] = mword; return;
    }
    const unsigned long long below = (1ull << lane) - 1ull;
    unsigned T = 0u;
#define TK_ROUNDS(NGRP) _Pragma("unroll 1") for (int bit = 31; bit >= 20; --bit) { const unsigned cand = T | (1u << bit); int c0_ = 0, c1_ = 0, c2_ = 0, c3_ = 0; \
        _Pragma("unroll") for (int g_ = 0; g_ < 2 * (NGRP); ++g_) { unsigned long long m_[4]; \
            _Pragma("unroll") for (int j_ = 0; j_ < 4; ++j_) m_[j_] = __ballot(u[4 * g_ + j_] >= cand); \
            c0_ += __builtin_popcountll(m_[0]); c1_ += __builtin_popcountll(m_[1]); c2_ += __builtin_popcountll(m_[2]); c3_ += __builtin_popcountll(m_[3]); } \
        if ((c0_ + c1_) + (c2_ + c3_) >= 256) T = cand; }
    if (qpos < 2048) { TK_ROUNDS(4) } else { TK_ROUNDS(8) }
#undef TK_ROUNDS
    const unsigned Tlo = T, Thi = T | 0xFFFFFu; int cgt = 0, nc = 0;
    TK_FOR_VALID( { const bool isgt = u[i] > Thi, isge = u[i] >= Tlo; const unsigned long long gm = __ballot(isgt), em = __ballot(isge) & ~gm; cgt += __builtin_popcountll(gm);
        if (em) {
            const int pos_ = nc + (int)__builtin_amdgcn_mbcnt_hi((unsigned)(em >> 32), __builtin_amdgcn_mbcnt_lo((unsigned)em, 0u));
            if (isge && !isgt && pos_ < 256) cbuf[pos_] = u[i]; nc += __builtin_popcountll(em); } } )
    int kneed = 256 - cgt;
    if (nc <= 256) {
        asm volatile("s_waitcnt lgkmcnt(0)" ::: "memory");
        unsigned c0 = lane < nc ? cbuf[lane] : 0u, c1 = 64 + lane < nc ? cbuf[64 + lane] : 0u, c2 = 128 + lane < nc ? cbuf[128 + lane] : 0u, c3 = 192 + lane < nc ? cbuf[192 + lane] : 0u;
#pragma unroll 1
        for (int bit = 19; bit >= 0; --bit) { const unsigned cand = T | (1u << bit);
            int cnt = __builtin_popcountll(__ballot(c0 >= cand));
            if (nc > 64) cnt += __builtin_popcountll(__ballot(c1 >= cand));
            if (nc > 128) cnt += __builtin_popcountll(__ballot(c2 >= cand)) + __builtin_popcountll(__ballot(c3 >= cand));
            if (cnt >= kneed) T = cand; }
        const int cg2 = __builtin_popcountll(__ballot(c0 > T)) + __builtin_popcountll(__ballot(c1 > T)) + __builtin_popcountll(__ballot(c2 > T)) + __builtin_popcountll(__ballot(c3 > T));
        kneed -= cg2;
    } else {
#pragma unroll 1
        for (int bit = 19; bit >= 0; --bit) { const unsigned cand = T | (1u << bit); int cnt = 0;
            TK_FOR_VALID( cnt += __builtin_popcountll(__ballot(u[i] >= cand)); )
            if (cnt >= 256) T = cand; }
        int cg2 = 0;
        TK_FOR_VALID( cg2 += __builtin_popcountll(__ballot(u[i] > T)); )
        kneed = 256 - cg2;
    }
    int run = 0;
    TK_FOR_VALID( { const bool eq = u[i] == T; unsigned long long w = __ballot(u[i] > T); const unsigned long long eqm = __ballot(eq);
        if (eqm) {
            const int rank = run + (int)__builtin_amdgcn_mbcnt_hi((unsigned)(eqm >> 32), __builtin_amdgcn_mbcnt_lo((unsigned)eqm, 0u));
            w |= __ballot(eq && rank < kneed); run += __builtin_popcountll(eqm); }
        mword = (lane == i) ? w : mword; } )
    mrow[lane] = mword;
}
#undef TK_FOR_VALID
constexpr int CONV_MOE_ITEMS = 32 * (32 * 16) + 32 * (8 * 32);
#ifndef CONV_STATIC_ITEMS
#define CONV_STATIC_ITEMS 0
#endif
constexpr int CONV_STATIC = CONV_STATIC_ITEMS;
constexpr int CONV_LATE_ITEMS = CONV_MOE_ITEMS + 32 * (NP1 / 64) + 32 * 32 + CONV_MOE_ITEMS;
#ifndef CONV_TAIL_ITEMS
#define CONV_TAIL_ITEMS 12288
#endif
#ifndef CONV_BIG_ITEMS
#define CONV_BIG_ITEMS 32768
#endif
constexpr int CONV_BIG = CONV_BIG_ITEMS;
constexpr int CONV_SPLIT = CONV_LATE_ITEMS - CONV_TAIL_ITEMS;
__device__ __forceinline__ TrItem conv_moe_desc(const Args& a, unsigned char* ws, int layer, int it) {
    if (it < 32 * 512) {
        const int ex = layer * 32 + it / 512, r = it % 512, blk = r >> 5, jj = r & 31, kb = (blk >> 2) * 8 + (jj >> 2), nb = (blk & 3) * 4 + (jj & 3), n0 = nb * 64, tile = n0 >> 8, j = n0 & 255;
        const float* W = (j < 128 ? a.in[17] : a.in[18]) + (size_t)ex * 2048 * 512;
        return TrItem{W, (bf16*)(ws + WS_WGU) + (size_t)ex * 1024 * 2048, 512, 128 * tile + (j & 127), 128 * tile + (j & 127) + 32, 2048, n0, kb * 64};
    }
    const int i2 = it - 32 * 512, ex = layer * 32 + i2 / 256, r = i2 % 256, blk = r >> 5, jj = r & 31, kb = jj >> 2, nb = blk * 4 + (jj & 3);
    return TrItem{a.in[19] + (size_t)ex * 512 * 2048, (bf16*)(ws + WS_WD) + (size_t)ex * 2048 * 512, 2048, nb * 64, nb * 64 + 32, 512, nb * 64, kb * 64};
}
__device__ __forceinline__ TrItem conv_late_desc(const Args& a, unsigned char* ws, int it) {
    if (it < CONV_MOE_ITEMS) return conv_moe_desc(a, ws, 0, it);
    it -= CONV_MOE_ITEMS;
    if (it < 32 * (NP1 / 64)) { const int kb = it / (NP1 / 64), nb = it % (NP1 / 64), n0 = nb * 64;
        return TrItem{a.in[7], (bf16*)(ws + WS_WINC), NE1, l1_src_col(n0), l1_src_col(n0 + 32), 2048, n0, kb * 64}; }
    it -= 32 * (NP1 / 64);
    if (it < 32 * 32) { const int kb = it / 32, nb = it % 32; return TrItem{a.in[8], (bf16*)(ws + WS_WOC), 2048, nb * 64, nb * 64 + 32, 2048, nb * 64, kb * 64}; }
    return conv_moe_desc(a, ws, 1, it - 32 * 32);
}
template <int CHUNK>
__device__ __forceinline__ void late_conv_items(Frame& F, const Args& a, const int lo, const int hi, const int ctr, const unsigned* stop = nullptr, const unsigned need = 0u) {
    LAS bf16* T = (LAS bf16*)(F.lds + F.wave * 16384); volatile LAS int* slot = (volatile LAS int*)(F.lds + 131072 + 512);
    for (;;) {
        __syncthreads();
        if (F.tid == 0) { const bool st = stop != nullptr && __hip_atomic_load(stop, __ATOMIC_RELAXED, __HIP_MEMORY_SCOPE_AGENT) >= need;
            *slot = st ? hi : lo + (int)atomicAdd(F.ctl + CW_FILL + 64 * ctr, (unsigned)CHUNK); }
        __syncthreads();
        const int base = *slot;
        if (base >= hi) break;
        f32x4 rA[16], rB[16];
        TrItem tA = conv_late_desc(a, F.ws, base + F.wave), tB = tA; tr64_load(tA, rA, F.lane);
#pragma unroll 1
        for (int j = 0; j < CHUNK / 8; j += 2) {
            tB = conv_late_desc(a, F.ws, base + F.wave + 8 * (j + 1)); tr64_load(tB, rB, F.lane);
            tr64_store(tA, rA, T, F.lane);
            if (j + 2 < CHUNK / 8) { tA = conv_late_desc(a, F.ws, base + F.wave + 8 * (j + 2)); tr64_load(tA, rA, F.lane); }
            tr64_store(tB, rB, T, F.lane);
        }
    }
    __syncthreads();
}
static_assert(CONV_LATE_ITEMS % 64 == 0 && CONV_STATIC == 0 && CONV_BIG % 64 == 0 && CONV_SPLIT % 16 == 0 && CONV_BIG <= CONV_SPLIT, "filler chunks");
__device__ __forceinline__ void p0_prologue(Frame& F, const Args& a) {
    const int gw = F.gw, NGW = F.NGW, lane = F.lane;
    unsigned char* ws = F.ws;
    LAS bf16* T = (LAS bf16*)(F.lds + F.wave * 16384);
    {
        const float* W = a.in[1]; bf16* WT = (bf16*)(ws + WS_WINA);
        for (int it = gw; it < 32 * (NP0 / 64); it += NGW) { const int kb = it / (NP0 / 64), nb = it % (NP0 / 64), n0 = nb * 64; const int c0 = n0 < 3072 ? n0 : n0 + 16; transpose_item64(W, NE0, c0, c0 + 32, 2048, WT, n0, kb * 64, T, lane); }
    }
    {
        for (int it = gw; it < 32 * 32; it += NGW) { const int kb = it / 32, nb = it % 32; transpose_item64(a.in[6], 2048, nb * 64, nb * 64 + 32, 2048, (bf16*)(ws + WS_WOA), nb * 64, kb * 64, T, lane); }
    }
    for (int it = gw; it < CONV_STATIC; it += NGW) { const TrItem t = conv_late_desc(a, ws, it); f32x4 r16[16]; tr64_load(t, r16, lane); tr64_store(t, r16, T, lane); }
    const int gt = blockIdx.x * (NWAVES * 64) + F.tid, NGT = F.G * NWAVES * 64;
    {   float* c128 = (float*)(ws + WS_ROPE); float* s128 = c128 + 4096 * 64; float* c64 = s128 + 4096 * 64; float* s64 = c64 + 4096 * 32;
        for (int i = gt; i < 4096 * 96; i += NGT) { int pos, idx, half; float* cp; float* sp;
            if (i < 4096 * 64) { pos = i >> 6; idx = i & 63; half = 64; cp = c128 + i; sp = s128 + i; } else { const int r = i - 4096 * 64; pos = r >> 5; idx = r & 31; half = 32; cp = c64 + r; sp = s64 + r; }
            const float inv = exp2f(-(float)idx / (float)half * 13.287712379549449f);
            const float ang = (float)pos * inv;
            double rv = (double)ang * 0.15915494309189535; rv -= rint(rv);
            const float rf = (float)rv;
            *cp = __builtin_amdgcn_cosf(rf); *sp = __builtin_amdgcn_sinf(rf); }
    }
    {   bf16* SKF = (bf16*)(ws + WS_WSM);
        for (int i = gt; i < 2048 * 208; i += NGT) { const int k = i / 208, c = i % 208; float v = 0.f;
            if (c < 96) { const int l = c / 48, j = c % 48; if (j < 4) v = a.in[13][((size_t)l * 2048 + k) * 4 + j]; else if (j < 36) { const int g = (j - 4) >> 3, e = (j - 4) & 7; v = a.in[15][(((size_t)l * 4 + g) * 2048 + k) * 8 + e]; } }
            else if (c < 128) { const int j = c - 96; if (j < 16) v = a.in[1][(size_t)k * NE0 + 3072 + j]; else if (j < 24) v = a.in[1][(size_t)k * NE0 + 6160 + j - 16]; }
            else v = a.in[7][(size_t)k * NE1 + 4096 + c - 128];
            const unsigned h = f2bf(v);
            if (c < 48) SKF[skf_off(SKU_ROUTE0, 3, c >> 4, k, c & 15)] = (bf16)h;
            else if (c < 96) SKF[skf_off(SKU_ROUTE1, 3, (c - 48) >> 4, k, c & 15)] = (bf16)h;
            else if (c < 128) { SKF[skf_off(SKU_SK0, 4, (c - 96) >> 4, k, c & 15)] = (bf16)h; SKF[skf_off(SKU_SK0, 4, 2 + ((c - 96) >> 4), k, c & 15)] = (bf16)f2bf(v - bf2f((unsigned short)h)); }
            else SKF[skf_off(SKU_SK1, 5, (c - 128) >> 4, k, c & 15)] = (bf16)h; }
    }
    {   const float* x = a.in[0]; bf16* XB = (bf16*)(ws + WS_XB);
        for (int m = gw; m < MTOK; m += NGW) { f32x4 v[8];
#pragma unroll
            for (int j = 0; j < 8; ++j) v[j] = __builtin_nontemporal_load((const f32x4*)(x + (size_t)m * DM + 256 * j + 4 * lane));
            store_row_bf16(XB + (size_t)m * DM, v, lane); }
    }
}
__device__ __forceinline__ void p_skinny0(Frame& F, const Args& a) {
    const bf16* W = (const bf16*)(F.ws + WS_WSM) + (size_t)SKU_SK0 * 2048 * 16; float* SK0 = (float*)(F.ws + WS_SK0);
    const LAS float* LG = (const LAS float*)(F.lds + SK_LG_OFF);
    for (int blk = blockIdx.x; blk < MTOK / 32; blk += F.G) { const int R0 = blk * 32;
        __syncthreads();
        skinny_prefetch<4>(F.lds, W, F.tid, F.wave);
        skinny_mm<4, 2>(F.lds, (const bf16*)(F.ws + WS_XB) + (size_t)R0 * DM, W, F.wave, F.lane, F.tid);
        __syncthreads();
        skinny_reduce<2>(F.lds, F.tid);
        __syncthreads();
        for (int idx = F.tid; idx < 32 * 24; idx += NWAVES * 64) { const int row = idx / 24, c = idx % 24; SK0[(size_t)(R0 + row) * 24 + c] = LG[row * 32 + c]; }
    }
    __syncthreads();
}
__device__ __forceinline__ void p_fox_bias(Frame& F, const Args& a) {
    if (blockIdx.x >= 16) return;
    const int bh = blockIdx.x, b = bh >> 3, h = bh & 7, lane = F.lane, tid = F.tid; const float gb = a.in[5][h];
    const float* SK0 = (const float*)(F.ws + WS_SK0); float* FB = (float*)(F.ws + WS_FBIAS) + (size_t)bh * SEQ; LAS float* wt = (LAS float*)(F.lds + 120000);
    float lf[8], tot = 0.f;
#pragma unroll
    for (int i = 0; i < 8; ++i) lf[i] = SK0[(size_t)(b * SEQ + tid * 8 + i) * 24 + 16 + h];
#pragma unroll
    for (int i = 0; i < 8; ++i) { tot += logsigmoidf(lf[i] + gb); lf[i] = tot; }
    float incl = tot;
#pragma unroll
    for (int o = 1; o < 64; o <<= 1) { const float t = __shfl_up(incl, o); if (lane >= o) incl += t; }
    if (lane == 63) wt[F.wave] = incl;
    __syncthreads();
    float pre = incl - tot;
    for (int w = 0; w < F.wave; ++w) pre += wt[w];
#pragma unroll
    for (int i = 0; i < 8; ++i) FB[tid * 8 + i] = -(pre + lf[i]) * (1.0f / ATT_SCALE);
    __syncthreads();
}
__device__ __forceinline__ void p_ln_route(Frame& F, const Args& a, int layer) {
    const bf16* YB = (const bf16*)(F.ws + WS_YB); bf16* XB = (bf16*)(F.ws + WS_XB); const int lane = F.lane;
    const float* g = a.in[9] + layer * DM; const float* bb = a.in[10] + layer * DM;
    const bf16* W = (const bf16*)(F.ws + WS_WSM) + (size_t)(layer ? SKU_ROUTE1 : SKU_ROUTE0) * 2048 * 16;
    const float* bg = a.in[14] + layer * 4; const float* be = a.in[16] + layer * 32;
    int4* ROUTE = (int4*)(F.ws + WS_ROUTE); unsigned* cnt = F.ctl + CW_CNT + layer * 64; int* INV = (int*)(F.ws + WS_INV); float* WINV = (float*)(F.ws + WS_WINV);
    const LAS float* LG = (const LAS float*)(F.lds + SK_LG_OFF);
    for (int blk = blockIdx.x; blk < MTOK / 32; blk += F.G) { const int R0 = blk * 32;
        __syncthreads();
        skinny_prefetch<3>(F.lds, W, F.tid, F.wave);
        {
            uint2 pk[4][8];
#pragma unroll
            for (int i = 0; i < 4; ++i)
#pragma unroll
                for (int j = 0; j < 8; ++j) { const v2u t_ = __builtin_nontemporal_load((const v2u*)(YB + (size_t)(R0 + 4 * F.wave + i) * DM + 256 * j + 4 * lane)); pk[i][j] = make_uint2(t_.x, t_.y); }
#pragma unroll
            for (int i2 = 0; i2 < 4; i2 += 2) {
                f32x4 v[2][8];
#pragma unroll
                for (int i = 0; i < 2; ++i)
#pragma unroll
                    for (int j = 0; j < 8; ++j) { const uint2 p = pk[i2 + i][j]; v[i][j][0] = bf2f(p.x & 0xffff); v[i][j][1] = bf2f(p.x >> 16); v[i][j][2] = bf2f(p.y & 0xffff); v[i][j][3] = bf2f(p.y >> 16); }
#pragma unroll
                for (int i = 0; i < 2; ++i) ln_row(v[i], g, bb, lane);
#pragma unroll
                for (int i = 0; i < 2; ++i) store_row_bf16(XB + (size_t)(R0 + 4 * F.wave + i2 + i) * DM, v[i], lane);
            }
        }
        __syncthreads();
        skinny_mm<3, 3>(F.lds, XB + (size_t)R0 * DM, W, F.wave, lane, F.tid);
        __syncthreads();
        skinny_reduce<3>(F.lds, F.tid);
        __syncthreads();
        if (F.tid < 32) { const int m = R0 + F.tid; const LAS float* l = LG + F.tid * 48;
            float gl[4];
#pragma unroll
            for (int i = 0; i < 4; ++i) gl[i] = l[i] + bg[i];
            int gi = 0; float gm = gl[0];
#pragma unroll
            for (int i = 1; i < 4; ++i) if (gl[i] > gm) { gm = gl[i]; gi = i; }
            float gs = 0.f;
#pragma unroll
            for (int i = 0; i < 4; ++i) gs += __expf(gl[i] - gm);
            const float gp = 1.0f / gs;
            float el[8];
#pragma unroll
            for (int e = 0; e < 8; ++e) el[e] = l[4 + 8 * gi + e] + be[gi * 8 + e];
            int e1 = 0; float v1 = el[0];
#pragma unroll
            for (int e = 1; e < 8; ++e) if (el[e] > v1) { v1 = el[e]; e1 = e; }
            int e2 = -1; float v2 = -3.0e38f;
#pragma unroll
            for (int e = 0; e < 8; ++e) if (e != e1 && el[e] > v2) { v2 = el[e]; e2 = e; }
            const float w1 = gp / (1.0f + __expf(v2 - v1)), w2 = gp - w1;
            const int ge1 = gi * 8 + e1, ge2 = gi * 8 + e2;
            LAS unsigned* hist = (LAS unsigned*)(F.lds + SK_LG_OFF + 32 * 48 * 4); LAS unsigned* ebase = hist + 32;
            hist[F.tid] = 0u;
            const unsigned r1 = __hip_atomic_fetch_add(hist + ge1, 1u, __ATOMIC_RELAXED, __HIP_MEMORY_SCOPE_WORKGROUP), r2 = __hip_atomic_fetch_add(hist + ge2, 1u, __ATOMIC_RELAXED, __HIP_MEMORY_SCOPE_WORKGROUP);
            const unsigned hc = hist[F.tid];
            ebase[F.tid] = hc ? atomicAdd(cnt + F.tid, hc) : 0u;
            const int p1 = (int)(ebase[ge1] + r1), p2 = (int)(ebase[ge2] + r2);
            ROUTE[(size_t)m * 2 + 0] = make_int4(ge1, p1, 0, 0); ROUTE[(size_t)m * 2 + 1] = make_int4(ge2, p2, 0, 0);
            INV[ge1 * 8192 + p1] = m; INV[ge2 * 8192 + p2] = m; WINV[ge1 * 8192 + p1] = w1; WINV[ge2 * 8192 + p2] = w2; }
    }
    __syncthreads();
}
__device__ __forceinline__ int moe_offsets(const unsigned* cnt, int lane, int* tiles_incl) {
    const int c = lane < 32 ? (int)cnt[lane] : 0; const int t = (c + 255) >> 8; int incl = t;
#pragma unroll
    for (int o = 1; o < 32; o <<= 1) { const int x = __shfl_up(incl, o); if ((lane & 31) >= o) incl += x; }
    *tiles_incl = incl; return (incl - t) * 256;
}
__device__ __forceinline__ void p_ln_ffn(Frame& F, const Args& a, int layer) {
    bf16* XB = (bf16*)(F.ws + WS_XB); const int lane = F.lane; const bf16* YG = (const bf16*)(F.ws + WS_CST);
    const float* g = a.in[11] + layer * DM; const float* bb = a.in[12] + layer * DM; const int4* ROUTE = (const int4*)(F.ws + WS_ROUTE);
    const bf16* W = (const bf16*)(F.ws + WS_WSM) + (size_t)SKU_SK1 * 2048 * 16;
    const float* c64 = (const float*)(F.ws + WS_ROPE) + 2 * 4096 * 64; const float* s64 = c64 + 4096 * 32;
    bf16* IK = (bf16*)(F.ws + WS_IK); float* IW = (float*)(F.ws + WS_IW);
    const LAS float* LG = (const LAS float*)(F.lds + SK_LG_OFF);
    int ti_; const int eoff = moe_offsets(F.ctl + CW_CNT + layer * 64, lane, &ti_);
    for (int blk = blockIdx.x; blk < MTOK / 32; blk += F.G) { const int R0 = blk * 32;
        if (layer == 0) { __syncthreads(); skinny_prefetch<5>(F.lds, W, F.tid, F.wave); }
        int r0s[4], r1s[4];
#pragma unroll
        for (int i = 0; i < 4; ++i) { const int m = R0 + 4 * F.wave + i; const int4 q0 = ROUTE[(size_t)m * 2], q1 = ROUTE[(size_t)m * 2 + 1]; r0s[i] = __shfl(eoff, q0.x) + q0.y; r1s[i] = __shfl(eoff, q1.x) + q1.y; }
#pragma unroll
        for (int i2 = 0; i2 < 4; i2 += 2) {
            f32x4 v[2][8]; uint2 ya[2][8], yb[2][8];
#pragma unroll
            for (int i = 0; i < 2; ++i) { load_row_bf16(XB + (size_t)(R0 + 4 * F.wave + i2 + i) * DM, v[i], lane);
#pragma unroll
                for (int j = 0; j < 8; ++j) { const v2u ta_ = __builtin_nontemporal_load((const v2u*)(YG + (size_t)r0s[i2 + i] * DM + 256 * j + 4 * lane)), tb_ = __builtin_nontemporal_load((const v2u*)(YG + (size_t)r1s[i2 + i] * DM + 256 * j + 4 * lane)); ya[i][j] = make_uint2(ta_.x, ta_.y); yb[i][j] = make_uint2(tb_.x, tb_.y); } }
#pragma unroll
            for (int i = 0; i < 2; ++i) {
#pragma unroll
                for (int j = 0; j < 8; ++j) { const uint2 y0 = ya[i][j], y1 = yb[i][j]; v[i][j] = v[i][j] * DN_ALPHA;
                    v[i][j][0] += bf2f(y0.x & 0xffff) + bf2f(y1.x & 0xffff); v[i][j][1] += bf2f(y0.x >> 16) + bf2f(y1.x >> 16);
                    v[i][j][2] += bf2f(y0.y & 0xffff) + bf2f(y1.y & 0xffff); v[i][j][3] += bf2f(y0.y >> 16) + bf2f(y1.y >> 16); }
                ln_row(v[i], g, bb, lane); }
#pragma unroll
            for (int i = 0; i < 2; ++i) { const int m = R0 + 4 * F.wave + i2 + i;
                if (layer == 0) store_row_bf16(XB + (size_t)m * DM, v[i], lane);
                else {
#pragma unroll
                    for (int j = 0; j < 8; ++j) __builtin_nontemporal_store(v[i][j], (f32x4*)(a.out + (size_t)m * DM + 256 * j + 4 * lane)); } }
        }
        if (layer == 0) {
            __syncthreads();
            skinny_mm<5, 5>(F.lds, XB + (size_t)R0 * DM, W, F.wave, lane, F.tid);
            __syncthreads();
            skinny_reduce<5>(F.lds, F.tid);
            __syncthreads();
            for (int idx = F.tid; idx < 32 * 80; idx += NWAVES * 64) { const int row = idx / 80, c = idx % 80, m = R0 + row; const float v = LG[row * 80 + c];
                if (c < 64) { const float part = LG[row * 80 + (c ^ 32)]; const int pos = m & 4095, i = c & 31; const float cs = c64[pos * 32 + i], sn = s64[pos * 32 + i];
                    const int bq = m >> 12, sq = m & 4095; IK[((((size_t)bq * 128 + (sq >> 5)) * 4 + (c >> 4)) * 64 + ((c >> 3) & 1) * 32 + (sq & 31)) * 8 + (c & 7)] = (bf16)f2bf(c < 32 ? (v * cs - part * sn) : (v * cs + part * sn)); }
                else IW[(size_t)m * 16 + c - 64] = v * 0.25f * 0.125f; }
        }
    }
    __syncthreads();
}
__device__ __forceinline__ void ph_gla_scan(Frame& F) {
    const bf16* __restrict__ CST = (const bf16*)(F.ws + WS_CST); const float* __restrict__ DEC = (const float*)(F.ws + WS_DEC); bf16* __restrict__ PREVT = (bf16*)(F.ws + WS_PREVT);
    for (int idx = blockIdx.x * 512 + F.tid; idx < 8 * 16384; idx += F.G * 512) { const int bh = idx >> 14, vd = (idx & 16383) * 2, d = vd & 127; float S0 = 0.f, S1 = 0.f;
#pragma unroll 1
        for (int n0 = 0; n0 < 64; n0 += 32) { unsigned c[32]; float2 dc[32];
#pragma unroll
            for (int j = 0; j < 32; ++j) { const int unit = bh * 64 + n0 + j; c[j] = __builtin_nontemporal_load((const unsigned*)(CST + (size_t)unit * 32768 + vd)); dc[j] = *(const float2*)(DEC + unit * 128 + d); }
#pragma unroll
            for (int j = 0; j < 32; ++j) { const int unit = bh * 64 + n0 + j; __builtin_nontemporal_store(pk2(S0, S1), (unsigned*)(PREVT + (size_t)unit * 32768 + vd));
                S0 = dc[j].x * S0 + bf2f(c[j] & 0xffff); S1 = dc[j].y * S1 + bf2f(c[j] >> 16); } } }
}
namespace attn {
constexpr int D = 128, NW = 8, QBLK = 32, KVBLK = 64, QB = NW * QBLK;
constexpr int SHM_V = KVBLK * D * 2, SHM_K = KVBLK * D * 2;
constexpr int OFF_WS = 2 * SHM_V + 2 * SHM_K, OFF_BIAS = OFF_WS + NW * 64 * 4, LDS_NEED = OFF_BIAS + 2 * 16384;
constexpr float SCALE = 0.08838834764831845f, THR = 8.f;
typedef short s16x4 __attribute__((ext_vector_type(4)));
typedef float f32x16 __attribute__((ext_vector_type(16)));
typedef unsigned u32x4 __attribute__((ext_vector_type(4)));
#define KSWZ(row, colB) ((row) * 256 + ((colB) ^ (((row) & 7) << 4)))
#define SBAR() __builtin_amdgcn_sched_barrier(0)
__device__ __forceinline__ int v_st(int k, int c) { const int kk = (k & ~0xC) | ((k & 4) << 1) | ((k & 8) >> 1); return ((kk >> 3) * 4 + (c >> 5)) * 512 + ((kk & 7) * 32 + (c & 31)) * 2; }
__device__ __forceinline__ int v_rd_base(int lane) { return ((lane & 3) << 3) | (((lane >> 2) & 3) << 6) | (((lane >> 4) & 1) << 5) | (((lane >> 5) & 1) << 8); }
constexpr int v_rd_off(int d0, int ks, int half) { return d0 * 512 + ks * 4096 + half * 2048; }
__device__ __forceinline__ int crow(int r, int hi) { return (r & 3) + 8 * (r >> 2) + 4 * hi; }
__device__ __forceinline__ unsigned cvtpk(float lo, float hi) { unsigned r; asm volatile("v_cvt_pk_bf16_f32 %0, %1, %2" : "=v"(r) : "v"(lo), "v"(hi)); return r; }
__device__ __forceinline__ bf16x8 load8(const bf16* p) { return *reinterpret_cast<const bf16x8*>(p); }
__device__ __forceinline__ void mask_tile(f32x16& p0, f32x16& p1, int dq) {
    const float NEG = -__builtin_inff();
#pragma unroll
    for (int r = 0; r < 16; ++r) { const int c = (r & 3) + 8 * (r >> 2); if (dq - c < 0) p0[r] = NEG; if (dq - c - 32 < 0) p1[r] = NEG; }
}
__device__ __forceinline__ void mask_bits(f32x16& p0, f32x16& p1, unsigned w0, unsigned w1) {
#pragma unroll
    for (int r = 0; r < 16; ++r) { const unsigned c = (r & 3) + 8 * (r >> 2);
        const unsigned m0 = (unsigned)__builtin_amdgcn_sbfe((int)w0, c, 1), m1 = (unsigned)__builtin_amdgcn_sbfe((int)w1, c, 1);
        p0[r] = __uint_as_float((m0 & __float_as_uint(p0[r])) | (~m0 & 0xFF800000u)); p1[r] = __uint_as_float((m1 & __float_as_uint(p1[r])) | (~m1 & 0xFF800000u)); }
}
__device__ __forceinline__ void partialSM(f32x16& p0, f32x16& p1, float& m_reg, float& mn, float& alpha) {
    float pmax = p0[0]; for (int r = 1; r < 16; ++r) pmax = fmaxf(pmax, p0[r]); for (int r = 0; r < 16; ++r) pmax = fmaxf(pmax, p1[r]);
    { auto rr = __builtin_amdgcn_permlane32_swap(__float_as_uint(pmax), __float_as_uint(pmax), false, false);
      pmax = fmaxf(__uint_as_float(rr[0]), __uint_as_float(rr[1])); }
    constexpr float C2 = 1.4426950408889634f * SCALE;
    if (__builtin_expect(__all((pmax - m_reg) * SCALE <= THR), 1)) { mn = m_reg; alpha = 1.f; }
    else { mn = fmaxf(m_reg, pmax); alpha = __builtin_amdgcn_exp2f((m_reg - mn) * C2); m_reg = mn; }
    const float mnL = -mn * C2;
    for (int r = 0; r < 16; ++r) p0[r] = fmaf(p0[r], C2, mnL); for (int r = 0; r < 16; ++r) p1[r] = fmaf(p1[r], C2, mnL);
    for (int r = 0; r < 16; ++r) p0[r] = __builtin_amdgcn_exp2f(p0[r]);
}
__device__ __forceinline__ void finishSM(f32x16& p0, f32x16& p1, float alpha, float& l_reg, bf16x8& pa0, bf16x8& pa1, bf16x8& pa2, bf16x8& pa3) {
    for (int r = 0; r < 16; ++r) p1[r] = __builtin_amdgcn_exp2f(p1[r]);
    float ps = 0; for (int r = 0; r < 16; ++r) ps += p0[r]; for (int r = 0; r < 16; ++r) ps += p1[r];
    { auto rr = __builtin_amdgcn_permlane32_swap(__float_as_uint(ps), __float_as_uint(ps), false, false);
      ps = __uint_as_float(rr[0]) + __uint_as_float(rr[1]); }
    l_reg = l_reg * alpha + ps;
#define PK4(P, B_, OUT) do { unsigned a0 = cvtpk(P[B_+0], P[B_+1]), a1 = cvtpk(P[B_+2], P[B_+3]);                          \
        unsigned b0 = cvtpk(P[B_+4], P[B_+5]), b1 = cvtpk(P[B_+6], P[B_+7]);                                             \
        auto r0 = __builtin_amdgcn_permlane32_swap(a0, b0, false, false); auto r1 = __builtin_amdgcn_permlane32_swap(a1, b1, false, false); \
        u32x4 w = {r0[0], r1[0], r0[1], r1[1]}; OUT = *reinterpret_cast<bf16x8*>(&w); } while (0)
    PK4(p0, 0, pa0); PK4(p0, 8, pa1); PK4(p1, 0, pa2); PK4(p1, 8, pa3);
#undef PK4
}
template <int KB, bool BIAS>
__device__ __forceinline__ void qkt(f32x16& p0, f32x16& p1, const char* K_lds, int r32, int hi, const bf16x8* qr, const char* bl) {
    p0 = f32x16{}; p1 = f32x16{}; (void)bl;
    const char* kb[4];
#pragma unroll
    for (int dd = 0; dd < 4; ++dd) kb[dd] = K_lds + KB * SHM_K + KSWZ(r32, (dd * 16 + hi * 8) * 2);
#pragma unroll
    for (int d0 = 0; d0 < 8; ++d0) { const char* a = kb[d0 & 3] + (d0 >> 2) * 128;
        bf16x8 b0 = *reinterpret_cast<const bf16x8*>(a);
        bf16x8 b1 = *reinterpret_cast<const bf16x8*>(a + 32 * 256);
        p0 = __builtin_amdgcn_mfma_f32_32x32x16_bf16(b0, qr[d0], p0, 0, 0, 0);
        p1 = __builtin_amdgcn_mfma_f32_32x32x16_bf16(b1, qr[d0], p1, 0, 0, 0); }
}
template <int VB>
__device__ __forceinline__ void pv_tile(f32x16* o, int vb0, bf16x8 pa0, bf16x8 pa1, bf16x8 pa2, bf16x8 pa3) {
#define TRRD(dst, off) asm volatile("ds_read_b64_tr_b16 %0, %1 offset:%2" : "=&v"(dst) : "v"(vb0), "i"(off) : "memory")
#define PV_D0(d0) do { s16x4 l0, l1, l2, l3, h0, h1, h2, h3; constexpr int b_ = VB * SHM_V + v_rd_off(d0, 0, 0); \
        TRRD(l0, b_); TRRD(h0, b_ + 2048); TRRD(l1, b_ + 4096); TRRD(h1, b_ + 6144); TRRD(l2, b_ + 8192); TRRD(h2, b_ + 10240); TRRD(l3, b_ + 12288); TRRD(h3, b_ + 14336); \
        asm volatile("s_waitcnt lgkmcnt(0)" ::: "memory"); SBAR();   \
        o[d0] = __builtin_amdgcn_mfma_f32_32x32x16_bf16(pa0, (bf16x8){l0[0], l0[1], l0[2], l0[3], h0[0], h0[1], h0[2], h0[3]}, o[d0], 0, 0, 0);   \
        o[d0] = __builtin_amdgcn_mfma_f32_32x32x16_bf16(pa1, (bf16x8){l1[0], l1[1], l1[2], l1[3], h1[0], h1[1], h1[2], h1[3]}, o[d0], 0, 0, 0);   \
        o[d0] = __builtin_amdgcn_mfma_f32_32x32x16_bf16(pa2, (bf16x8){l2[0], l2[1], l2[2], l2[3], h2[0], h2[1], h2[2], h2[3]}, o[d0], 0, 0, 0);   \
        o[d0] = __builtin_amdgcn_mfma_f32_32x32x16_bf16(pa3, (bf16x8){l3[0], l3[1], l3[2], l3[3], h3[0], h3[1], h3[2], h3[3]}, o[d0], 0, 0, 0); } while (0)
    PV_D0(0); PV_D0(1); PV_D0(2); PV_D0(3);
#undef PV_D0
#undef TRRD
}
struct BlockRef { const bf16* Q; const bf16* K; const bf16* V; bf16* O; int P0; const float* fb; const unsigned long long* mrow; };
struct Seam { bf16x8 qr[8]; bf16x8 st_v0, st_v1, st_k0, st_k1; };
#define VMW() asm volatile("s_waitcnt vmcnt(0)" ::: "memory")
#define VMWN(n) asm volatile("s_waitcnt vmcnt(%0)" :: "i"(n) : "memory")
#define SLOAD_H(Kp, Vp, k0) do { const bf16* kt_ = (Kp) + (size_t)(k0) * KS; const bf16* vt_ = (Vp) + (size_t)(k0) * KS; S.st_v0 = load8(vt_ + koff); S.st_v1 = load8(vt_ + koff + 32 * KS); S.st_k0 = load8(kt_ + koff); S.st_k1 = load8(kt_ + koff + 32 * KS); } while (0)
#define SWRITE_HK(bf) do { *(bf16x8*)(K_lds + (bf) * SHM_K + kws) = S.st_k0; *(bf16x8*)(K_lds + (bf) * SHM_K + kws + 32 * 256) = S.st_k1; } while (0)
#define SWRITE_HV(bf) do { *(bf16x8*)(V_lds + (bf) * SHM_V + vst0) = S.st_v0; *(bf16x8*)(V_lds + (bf) * SHM_V + vst0 + vst1d) = S.st_v1; } while (0)
#define SWRITE_H(bf) do { SWRITE_HV(bf); SWRITE_HK(bf); } while (0)
template <bool BIAS, bool BITMASK, int QS, int KS, int OS>
__device__ __forceinline__ void attn_block(const BlockRef& cur, char* lds, LAS unsigned char* ldsl, const int wv) {
    int lane_; asm volatile("v_mbcnt_lo_u32_b32 %0, -1, 0\n\tv_mbcnt_hi_u32_b32 %0, -1, %0" : "=v"(lane_));
    const int wid = wv, lane = lane_, tid = wid * 64 + lane, r32 = lane & 31, hi = lane >> 5;
    const int NT = (cur.P0 + QB - 1) / KVBLK + 1;
    const int qlo = cur.P0 + wid * QBLK, qm = qlo + r32 - 4 * hi;
    char* V_lds = lds; char* K_lds = lds + 2 * SHM_V;
    float* ws = (float*)(lds + OFF_WS) + wid * 64; float* li_l = ws, * al_l = ws + 32;
    const LAS unsigned char* bl0 = ldsl + OFF_BIAS + hi * 16;
    float m_reg = -1e30f, l_reg = 0; f32x16 o[4] = {};
    const int sr = tid >> 4, sc = (tid & 15) * 8, vst0 = v_st(sr, sc), kws = KSWZ(sr, sc * 2); constexpr int vst1d = 8192;
    const int vb0 = (int)(uintptr_t)V_lds + v_rd_base(lane);
    const bf16* Kh = cur.K; const bf16* Vh = cur.V;
    const int moff = (wid * QBLK + r32) * 64, koff = sr * KS + sc, qoff = (wid * QBLK + r32) * QS + hi * 8;
    Seam S;
#pragma unroll
    for (int d0 = 0; d0 < 8; ++d0) S.qr[d0] = load8(cur.Q + qoff + d0 * 16);
    if constexpr (BIAS) { const f32x4 b0_ = *(const f32x4*)(cur.fb + tid * 8), b1_ = *(const f32x4*)(cur.fb + tid * 8 + 4);
        *(LAS f32x4*)(ldsl + OFF_BIAS + tid * 32) = b0_; *(LAS f32x4*)(ldsl + OFF_BIAS + tid * 32 + 16) = b1_; }
    SLOAD_H(Kh, Vh, 0); VMW(); SWRITE_HK(0); SWRITE_HV(0); SBAR();
#define RESC(a) do { if (__any((a) < 1.f)) { if (hi == 0) al_l[r32] = (a); asm volatile("s_waitcnt lgkmcnt(0)" ::: "memory");              \
                     for (int d_ = 0; d_ < 4; ++d_) for (int r = 0; r < 16; ++r) o[d_][r] *= al_l[crow(r, hi)]; } } while (0)
#define KBASE(t) ((t) * KVBLK)
#define MLOAD(MW, t) do { if constexpr (BITMASK) MW = (cur.mrow + (t))[moff]; } while (0)
#define MASKT(P0_, P1_, MW, t) do { if constexpr (BIAS) { const LAS unsigned char* bl_ = bl0 + KBASE(t) * 4; _Pragma("unroll") for (int g = 0; g < 4; ++g) { const f32x4 a_ = *(const LAS f32x4*)(bl_ + g * 32), b_ = *(const LAS f32x4*)(bl_ + 128 + g * 32); \
            P0_[4 * g] += a_[0]; P0_[4 * g + 1] += a_[1]; P0_[4 * g + 2] += a_[2]; P0_[4 * g + 3] += a_[3]; P1_[4 * g] += b_[0]; P1_[4 * g + 1] += b_[1]; P1_[4 * g + 2] += b_[2]; P1_[4 * g + 3] += b_[3]; } } \
        if constexpr (BITMASK) { mask_bits(P0_, P1_, (unsigned)(MW) >> (4 * hi), (unsigned)((MW) >> 32) >> (4 * hi)); } \
        else { const int kb_ = KBASE(t); if (kb_ + KVBLK - 1 > qlo) mask_tile(P0_, P1_, qm - kb_); } } while (0)
    f32x16 pA0, pA1, pB0, pB1; float mnA, mnB, alA, alB; bf16x8 pa0, pa1, pa2, pa3; unsigned long long mwA = 0, mwB = 0;
    MLOAD(mwA, 0);
    SLOAD_H(Kh, Vh, KBASE(1)); MLOAD(mwB, 1);
    __syncthreads();
    SBAR(); qkt<0, BIAS>(pA0, pA1, K_lds, r32, hi, S.qr, nullptr);
    MASKT(pA0, pA1, mwA, 0); partialSM(pA0, pA1, m_reg, mnA, alA);
    VMW(); SWRITE_H(1);
    __syncthreads();
#define HALF_STEP(PX0, PX1, mnX, alX, MWX, PY0, PY1, alY, MWY, t, KB, VB, SB) do {                                            \
        SBAR(); qkt<KB, BIAS>(PX0, PX1, K_lds, r32, hi, S.qr, nullptr);                                                       \
        finishSM(PY0, PY1, alY, l_reg, pa0, pa1, pa2, pa3); SBAR();                                                           \
        if ((t) + 1 < NT) { SLOAD_H(Kh, Vh, KBASE((t) + 1)); MLOAD(MWY, (t) + 1); SBAR(); }                                   \
        pv_tile<VB>(o, vb0, pa0, pa1, pa2, pa3); MASKT(PX0, PX1, MWX, (t)); partialSM(PX0, PX1, m_reg, mnX, alX);             \
        __syncthreads();                                                                                                      \
        if ((t) + 1 < NT) { VMW(); SWRITE_H(SB); }                                                                            \
        RESC(alX); __syncthreads(); } while (0)
    for (int t = 1; t + 1 < NT; t += 2) {
        HALF_STEP(pB0, pB1, mnB, alB, mwB, pA0, pA1, alA, mwA, t, 1, 0, 0);
        HALF_STEP(pA0, pA1, mnA, alA, mwA, pB0, pB1, alB, mwB, t + 1, 0, 1, 1);
    }
    SBAR(); qkt<1, BIAS>(pB0, pB1, K_lds, r32, hi, S.qr, nullptr); SBAR();
    finishSM(pA0, pA1, alA, l_reg, pa0, pa1, pa2, pa3); SBAR();
    pv_tile<0>(o, vb0, pa0, pa1, pa2, pa3);
    MASKT(pB0, pB1, mwB, NT - 1); partialSM(pB0, pB1, m_reg, mnB, alB); __syncthreads(); RESC(alB);
    finishSM(pB0, pB1, alB, l_reg, pa0, pa1, pa2, pa3); SBAR(); pv_tile<1>(o, vb0, pa0, pa1, pa2, pa3);
    SBAR();
    if (hi == 0) li_l[r32] = l_reg; asm volatile("s_waitcnt lgkmcnt(0)" ::: "memory");
    float rli[16];
#pragma unroll
    for (int r = 0; r < 16; ++r) rli[r] = __builtin_amdgcn_rcpf(li_l[crow(r, hi)]);
    int tid2_; asm volatile("v_mbcnt_lo_u32_b32 %0, -1, 0\n\tv_mbcnt_hi_u32_b32 %0, -1, %0" : "=v"(tid2_));
    const int r32e = tid2_ & 31, hie = (tid2_ >> 5) & 1, ooff = (wid * QBLK + 4 * hie) * OS + r32e;
#pragma unroll
    for (int r = 0; r < 16; ++r) {
#pragma unroll
        for (int d0 = 0; d0 < 4; ++d0) { const float v = o[d0][r] * rli[r]; const float vn = __shfl_xor(v, 1);
            if ((r32e & 1) == 0) *(unsigned*)(cur.O + ((r & 3) + 8 * (r >> 2)) * OS + d0 * 32 + ooff) = cvtpk(v, vn); } }
    __syncthreads();
#undef RESC
#undef KBASE
#undef MLOAD
#undef MASKT
#undef HALF_STEP
}
#undef ROWK
#undef VMW
#undef VMWN
#undef SLOAD_H
#undef SWRITE_HK
#undef SWRITE_HV
#undef SWRITE_H
#undef KSWZ
#undef SBAR
template <bool BIAS, bool BITMASK, int NH, int GROUP, bool PAIR, int QS, int KS, int OS>
__device__ __forceinline__ void attn_phase(char* lds, LAS unsigned char* ldsl, const bf16* Q, const bf16* K, const bf16* V, bf16* O, const float* fbias, const unsigned long long* mask, int G, int bid, int wv) {
    constexpr int NBLK = BATCH * NH * 16, NITEM = PAIR ? NBLK / 2 : NBLK, PER = PAIR ? 8 : 16, SETH = BATCH * NH / 8;
    for (int L = bid; L < NITEM; L += G) {
#pragma unroll 1
        for (int pass = 0; pass < (PAIR ? 2 : 1); ++pass) {
            const int g = L & 7, k = L >> 3, hs = k / PER, x = k % PER; const int bh = g * SETH + hs, b = bh / NH, h = bh % NH;
            const int qb = PAIR ? (pass ? 15 - x : x) : 15 - x; BlockRef r; const size_t row0 = (size_t)b * SEQ + (size_t)qb * QB;
            r.Q = Q + row0 * QS + h * D; r.O = O + row0 * OS + h * D; r.K = K + (size_t)b * SEQ * KS + (h / GROUP) * D; r.V = V + (size_t)b * SEQ * KS + (h / GROUP) * D; r.P0 = qb * QB;
            r.fb = BIAS ? fbias + (size_t)bh * SEQ : nullptr; r.mrow = BITMASK ? mask + row0 * 64 : nullptr;
            attn_block<BIAS, BITMASK, QS, KS, OS>(r, lds, ldsl, wv);
        }
    }
}
}
__device__ __forceinline__ float fast_silu(float g) { return g * __builtin_amdgcn_rcpf(1.0f + __expf(-g)); }
__device__ __forceinline__ void ph_gla_a(Frame& F, const Args& a) {
    const float* SK0 = (const float*)(F.ws + WS_SK0); const float* w2 = a.in[2]; const float* gbias = a.in[3]; float* GB = (float*)(F.ws + WS_GB); float* DEC = (float*)(F.ws + WS_DEC);
    const bf16* PROJ = (const bf16*)(F.ws + WS_PROJ); bf16* CST = (bf16*)(F.ws + WS_CST);
    LAS float* BSH = (LAS float*)F.lds; LAS float* TOT = BSH + 128 * 65; LAS bf16* VT = (LAS bf16*)(F.lds + 36864); LAS bf16* KET = (LAS bf16*)(F.lds + 73728);
    const int tid = F.tid, lane = F.lane, l15 = lane & 15, quad = lane >> 4, w = F.wave;
    for (int unit = blockIdx.x; unit < 512; unit += F.G) {
        const int n = unit & 63, bh = unit >> 6, b = bh >> 2, h = bh & 3, t0 = b * SEQ + n * 64;
        __syncthreads();
        {
            LAS float* GLR = (LAS float*)(F.lds + 92160);
            if (tid < 256) *(LAS f32x4*)(GLR + 4 * tid) = *(const f32x4*)(SK0 + (size_t)(t0 + (tid >> 2)) * 24 + 4 * (tid & 3));
            const int d = tid & 127, cg = tid >> 7; float wv[16];
#pragma unroll
            for (int r = 0; r < 16; ++r) wv[r] = w2[r * 512 + h * 128 + d];
            const float gb = gbias[h * 128 + d]; float run = 0.f;
            __syncthreads();
            for (int cc = 0; cc < 16; ++cc) { const int c = cg * 16 + cc; const LAS float* sk = GLR + c * 16; float z = gb;
#pragma unroll
                for (int r = 0; r < 16; ++r) z += sk[r] * wv[r];
                run += logsigmoidf(z) * (1.0f / 16.0f); BSH[d * 65 + c] = run; }
            TOT[cg * 128 + d] = run;
            __syncthreads();
            float pre = 0.f;
            for (int g = 0; g < cg; ++g) pre += TOT[g * 128 + d];
            for (int cc = 0; cc < 16; ++cc) { const int c = cg * 16 + cc; const float v = BSH[d * 65 + c] + pre; BSH[d * 65 + c] = v; GB[(size_t)(t0 + c) * 512 + h * 128 + d] = v; }
        }
        __syncthreads();
        {
            const int c = tid & 63, g8 = tid >> 6; const size_t t = (size_t)(t0 + c);
            const bf16* kp = PROJ + t * NP0 + 512 + h * 128 + g8 * 16;
            const v4u k0 = *(const v4u*)kp, k1 = *(const v4u*)(kp + 8);
            const unsigned kw[8] = {k0.x, k0.y, k0.z, k0.w, k1.x, k1.y, k1.z, k1.w};
#pragma unroll
            for (int i = 0; i < 8; ++i) { const int d = g8 * 16 + 2 * i; const float e0 = __expf(BSH[d * 65 + 63] - BSH[d * 65 + c]), e1 = __expf(BSH[(d + 1) * 65 + 63] - BSH[(d + 1) * 65 + c]);
                KET[d * 72 + c] = (bf16)f2bf(bf2f(kw[i] & 0xffff) * e0); KET[(d + 1) * 72 + c] = (bf16)f2bf(bf2f(kw[i] >> 16) * e1); }
            const bf16* vp = PROJ + t * NP0 + 1024 + h * 256 + g8 * 32;
#pragma unroll
            for (int q = 0; q < 4; ++q) { const v4u vv = *(const v4u*)(vp + 8 * q); const unsigned vw[4] = {vv.x, vv.y, vv.z, vv.w};
#pragma unroll
                for (int i = 0; i < 4; ++i) { const int v = g8 * 32 + q * 8 + 2 * i; VT[v * 72 + c] = (bf16)(vw[i] & 0xffff); VT[(v + 1) * 72 + c] = (bf16)(vw[i] >> 16); } }
            if (tid < 128) DEC[unit * 128 + tid] = __expf(BSH[tid * 65 + 63]);
        }
        __syncthreads();
        {
            pg8::f32x4 acc[2][8];
#pragma unroll
            for (int i = 0; i < 2; ++i)
#pragma unroll
                for (int nn = 0; nn < 8; ++nn) acc[i][nn] = (pg8::f32x4){0.f, 0.f, 0.f, 0.f};
#pragma unroll
            for (int kk = 0; kk < 64; kk += 32) {
                const bf16x8 a0 = *(const LAS bf16x8*)(VT + (32 * w + l15) * 72 + kk + quad * 8), a1 = *(const LAS bf16x8*)(VT + (32 * w + 16 + l15) * 72 + kk + quad * 8);
#pragma unroll
                for (int nn = 0; nn < 8; ++nn) { const bf16x8 bb = *(const LAS bf16x8*)(KET + (16 * nn + l15) * 72 + kk + quad * 8);
                    acc[0][nn] = __builtin_amdgcn_mfma_f32_16x16x32_bf16(bb, a0, acc[0][nn], 0, 0, 0); acc[1][nn] = __builtin_amdgcn_mfma_f32_16x16x32_bf16(bb, a1, acc[1][nn], 0, 0, 0); } }
            bf16* cp = CST + (size_t)unit * 32768;
#pragma unroll
            for (int i = 0; i < 2; ++i)
#pragma unroll
                for (int nn = 0; nn < 8; ++nn) { uint2 o; o.x = pk2(acc[i][nn][0], acc[i][nn][1]); o.y = pk2(acc[i][nn][2], acc[i][nn][3]);
                    *(uint2*)(cp + (32 * w + 16 * i + l15) * 128 + 16 * nn + quad * 4) = o; }
        }
    }
    __syncthreads();
}
__device__ __forceinline__ void ph_gla_c(Frame& F, const Args& a) {
    const bf16* PROJ = (const bf16*)(F.ws + WS_PROJ); const float* GB = (const float*)(F.ws + WS_GB); const bf16* PREVT = (const bf16*)(F.ws + WS_PREVT); const float* normg = a.in[4]; bf16* OMIX = (bf16*)(F.ws + WS_OMIX);
    LAS bf16* QD = (LAS bf16*)(F.lds + 32768); LAS bf16* KI = (LAS bf16*)(F.lds + 50176); LAS bf16* P = (LAS bf16*)(F.lds + 67584); LAS bf16* VT = (LAS bf16*)(F.lds + 76800); LAS float* RED = (LAS float*)(F.lds + 113664);
    const int tid = F.tid, lane = F.lane, l15 = lane & 15, quad = lane >> 4, w = F.wave;
    for (int unit = blockIdx.x; unit < 512; unit += F.G) {
        const int n = unit & 63, bh = unit >> 6, b = bh >> 2, h = bh & 3, t0 = b * SEQ + n * 64;
        __syncthreads();
        {
            const int c = tid >> 3, dg = tid & 7; const size_t t = (size_t)(t0 + c);
            const float* bp = GB + t * 512 + h * 128 + dg * 16; const bf16* qp = PROJ + t * NP0 + h * 128 + dg * 16; const bf16* kp = PROJ + t * NP0 + 512 + h * 128 + dg * 16;
#pragma unroll
            for (int q8 = 0; q8 < 2; ++q8) { const v4u qq = *(const v4u*)(qp + 8 * q8), kk = *(const v4u*)(kp + 8 * q8); const f32x4 b0 = *(const f32x4*)(bp + 8 * q8), b1 = *(const f32x4*)(bp + 8 * q8 + 4);
                const unsigned qw[4] = {qq.x, qq.y, qq.z, qq.w}, kw[4] = {kk.x, kk.y, kk.z, kk.w}; const float bv[8] = {b0[0], b0[1], b0[2], b0[3], b1[0], b1[1], b1[2], b1[3]};
                v4u oq, ok; unsigned* oqp = (unsigned*)&oq; unsigned* okp = (unsigned*)&ok;
#pragma unroll
                for (int i = 0; i < 4; ++i) { const float e0 = __expf(bv[2 * i]), e1 = __expf(bv[2 * i + 1]);
                    oqp[i] = pk2(bf2f(qw[i] & 0xffff) * ATT_SCALE * e0, bf2f(qw[i] >> 16) * ATT_SCALE * e1);
                    okp[i] = pk2(bf2f(kw[i] & 0xffff) * __builtin_amdgcn_rcpf(e0), bf2f(kw[i] >> 16) * __builtin_amdgcn_rcpf(e1)); }
                *(LAS v4u*)(QD + c * 136 + dg * 16 + 8 * q8) = oq; *(LAS v4u*)(KI + c * 136 + dg * 16 + 8 * q8) = ok; }
            const int c2 = tid & 63, g8 = tid >> 6; const bf16* vp = PROJ + (size_t)(t0 + c2) * NP0 + 1024 + h * 256 + g8 * 32;
#pragma unroll
            for (int q = 0; q < 4; ++q) { const v4u vv = *(const v4u*)(vp + 8 * q); const unsigned vw[4] = {vv.x, vv.y, vv.z, vv.w};
#pragma unroll
                for (int i = 0; i < 4; ++i) { const int v = g8 * 32 + q * 8 + 2 * i; VT[v * 72 + c2] = (bf16)(vw[i] & 0xffff); VT[(v + 1) * 72 + c2] = (bf16)(vw[i] >> 16); } }
        }
        __syncthreads();
        bf16x8 pvf[32];
        { const bf16* pv0 = PREVT + (size_t)unit * 32768 + (size_t)(128 * (w & 1) + l15) * 128 + quad * 8;
#pragma unroll
          for (int kk4 = 0; kk4 < 4; ++kk4)
#pragma unroll
              for (int nn = 0; nn < 8; ++nn) pvf[kk4 * 8 + nn] = *(const bf16x8*)(pv0 + (size_t)(16 * nn) * 128 + 32 * kk4); }
        {
            const int ti = w >> 1;
#pragma unroll
            for (int s = 0; s < 2; ++s) { const int tj = 2 * (w & 1) + s; pg8::f32x4 acc = (pg8::f32x4){0.f, 0.f, 0.f, 0.f};
                if (tj <= ti) {
#pragma unroll
                    for (int kk = 0; kk < 128; kk += 32) { const bf16x8 aa = *(const LAS bf16x8*)(QD + (16 * ti + l15) * 136 + kk + quad * 8), bb = *(const LAS bf16x8*)(KI + (16 * tj + l15) * 136 + kk + quad * 8);
                        acc = __builtin_amdgcn_mfma_f32_16x16x32_bf16(aa, bb, acc, 0, 0, 0); } }
#pragma unroll
                for (int j = 0; j < 4; ++j) { const int i = 16 * ti + quad * 4 + j, jj = 16 * tj + l15; P[i * 72 + jj] = (bf16)f2bf(jj <= i ? acc[j] : 0.f); } }
        }
        __syncthreads();
        {
            const int ti = w >> 1, half = w & 1; pg8::f32x4 acc[8];
#pragma unroll
            for (int nn = 0; nn < 8; ++nn) acc[nn] = (pg8::f32x4){0.f, 0.f, 0.f, 0.f};
#pragma unroll
            for (int kk = 0; kk < 64; kk += 32) { const bf16x8 aa = *(const LAS bf16x8*)(P + (16 * ti + l15) * 72 + kk + quad * 8);
#pragma unroll
                for (int nn = 0; nn < 8; ++nn) { const bf16x8 bb = *(const LAS bf16x8*)(VT + (128 * half + 16 * nn + l15) * 72 + kk + quad * 8); acc[nn] = __builtin_amdgcn_mfma_f32_16x16x32_bf16(bb, aa, acc[nn], 0, 0, 0); } }
#pragma unroll
            for (int kk4 = 0; kk4 < 4; ++kk4) { const bf16x8 aa = *(const LAS bf16x8*)(QD + (16 * ti + l15) * 136 + 32 * kk4 + quad * 8);
#pragma unroll
                for (int nn = 0; nn < 8; ++nn) acc[nn] = __builtin_amdgcn_mfma_f32_16x16x32_bf16(pvf[kk4 * 8 + nn], aa, acc[nn], 0, 0, 0); }
            float s = 0.f;
#pragma unroll
            for (int nn = 0; nn < 8; ++nn) s += (acc[nn][0] * acc[nn][0] + acc[nn][1] * acc[nn][1]) + (acc[nn][2] * acc[nn][2] + acc[nn][3] * acc[nn][3]);
            s += __shfl_xor(s, 16); s += __shfl_xor(s, 32);
            if (quad == 0) RED[(16 * ti + l15) * 2 + half] = s;
            __syncthreads();
            const int i = 16 * ti + l15; const float ms = (RED[i * 2] + RED[i * 2 + 1]) * (1.0f / 256.0f); const float rs = 1.0f / sqrtf(ms + LN_EPS);
            const size_t t = (size_t)(t0 + i);
#pragma unroll
            for (int nn = 0; nn < 8; ++nn) { const int v = 128 * half + 16 * nn + quad * 4; const uint2 gr = *(const uint2*)(PROJ + t * NP0 + 2048 + h * 256 + v); const f32x4 ng = *(const f32x4*)(normg + v);
                uint2 o; o.x = pg8::cvt_pk_bf16(acc[nn][0] * rs * ng[0] * fast_silu(bf2f(gr.x & 0xffff)), acc[nn][1] * rs * ng[1] * fast_silu(bf2f(gr.x >> 16)));
                o.y = pg8::cvt_pk_bf16(acc[nn][2] * rs * ng[2] * fast_silu(bf2f(gr.y & 0xffff)), acc[nn][3] * rs * ng[3] * fast_silu(bf2f(gr.y >> 16)));
                *(uint2*)(OMIX + t * DM + h * 256 + v) = o; }
        }
    }
    __syncthreads();
}
__device__ __forceinline__ void ph_indexer(Frame& F, unsigned char* lds_generic) {
    typedef float f32x16 __attribute__((ext_vector_type(16)));
    const bf16* PROJ1 = (const bf16*)(F.ws + WS_PROJ); const bf16* IK = (const bf16*)(F.ws + WS_IK); const float* IW = (const float*)(F.ws + WS_IW); unsigned long long* MASK = (unsigned long long*)(F.ws + WS_MASK);
    LAS float* SCL = (LAS float*)F.lds;
    const int lane = F.lane, w = F.wave, c32 = lane & 31, hi = lane >> 5;
    for (int it = blockIdx.x; it < 512; it += F.G) {
#pragma unroll 1
        for (int pass = 0; pass < 2; ++pass) {
            const int unit = pass ? 1023 - it : it, m0 = unit * 8, b = m0 >> 12, qmax = (m0 & 4095) + 7;
            __syncthreads();
            {
                const int ha = (c32 & 3) + 4 * (c32 >> 3);
                bf16x8 af[4][4]; float wv[4][16];
#pragma unroll
                for (int rb = 0; rb < 4; ++rb) { const int qa = m0 + 2 * rb + ((c32 >> 2) & 1); const bf16* ap = PROJ1 + (size_t)qa * NP1 + 3072 + ha * 64 + 8 * hi;
#pragma unroll
                    for (int ks = 0; ks < 4; ++ks) af[rb][ks] = *(const bf16x8*)(ap + 16 * ks);
                    const float* wp = IW + (size_t)(m0 + 2 * rb + hi) * 16;
#pragma unroll
                    for (int q4 = 0; q4 < 4; ++q4) { const f32x4 t4 = *(const f32x4*)(wp + 4 * q4); wv[rb][4 * q4] = t4[0]; wv[rb][4 * q4 + 1] = t4[1]; wv[rb][4 * q4 + 2] = t4[2]; wv[rb][4 * q4 + 3] = t4[3]; } }
                LAS float* srow = SCL + hi * 4096 + c32;
                const bf16* kbase = IK + (size_t)b * SEQ * 64 + (size_t)lane * 8;
                const int tl = qmax >> 5, tlast = tl >= w ? tl - ((tl - w) & 7) : w - 8;
#define IDX_LOAD(dst, tt) do { const int tc_ = (tt) <= tlast ? (tt) : (tlast >= w ? tlast : w); _Pragma("unroll") for (int ks = 0; ks < 4; ++ks) dst[ks] = *(const bf16x8*)(kbase + (size_t)(tc_ * 4 + ks) * 512); } while (0)
#define IDX_TILE(src, tt) do { if ((tt) <= tlast) { _Pragma("unroll") for (int rb = 0; rb < 4; ++rb) { f32x16 acc = {}; _Pragma("unroll") for (int ks = 0; ks < 4; ++ks) acc = __builtin_amdgcn_mfma_f32_32x32x16_bf16(af[rb][ks], src[ks], acc, 0, 0, 0); \
                        float s = 0.f; _Pragma("unroll") for (int r = 0; r < 16; ++r) s += wv[rb][r] * fmaxf(acc[r], 0.f); srow[2 * rb * 4096 + (tt) * 32] = s; } } } while (0)
                bf16x8 b0[4], b1[4], b2[4];
                IDX_LOAD(b0, w); IDX_LOAD(b1, w + 8); IDX_LOAD(b2, w + 16);
                for (int t = w; t <= tlast; t += 24) {
                    IDX_TILE(b0, t);      IDX_LOAD(b0, t + 24);
                    IDX_TILE(b1, t + 8);  IDX_LOAD(b1, t + 32);
                    IDX_TILE(b2, t + 16); IDX_LOAD(b2, t + 40);
                }
#undef IDX_LOAD
#undef IDX_TILE
            }
            __syncthreads();
            { const int m = m0 + w; topk_mask_row((const LAS float*)(F.lds + w * 16384), m & 4095, MASK + (size_t)m * 64, lane, (LAS unsigned*)(F.lds + LDSCTL_OFF + 4096 + w * 1024)); }
        }
    }
    __syncthreads();
}
#define IN(k) (lo <= (k) && (k) < hi)
#define SEAM(k) do { if (hi > (k) + 1) { F.refresh(); xcd_barrier(bar, F.tid); } } while (0)
template <int LAYER, int BASE>
__device__ __forceinline__ void common_phases(Frame& F, const Args& args, const int lo, const int hi, const XcdBarrier& bar) {
    unsigned char* ws = args.ws;
    if (IN(BASE + 0)) { F.refresh();
        pg8::Gemm g{(const bf16*)(ws + WS_OMIX), (const bf16*)(ws + (LAYER ? WS_WOC : WS_WOA)), MTOK, DM, DM, DM, DM}; pg8::StaticOrder S; S.init(MTOK, DM, F.G, (int)blockIdx.x);
        pg8::EpiResid E{(const bf16*)(ws + WS_XB), (bf16*)(ws + WS_YB), DN_ALPHA};
        pg8::gemm_phase<pg8::EpiResid, pg8::StaticOrder, true, true>(F.lds, g, S, E, F.tid);
        SEAM(BASE + 0);
    }
    if (IN(BASE + 1)) { F.refresh(); p_ln_route(F, args, LAYER); SEAM(BASE + 1); }
    if (IN(BASE + 3) || IN(BASE + 4) || IN(BASE + 5)) { F.refresh();
        if (F.wave == 0) { int ti; (void)moe_offsets(F.ctl + CW_CNT + LAYER * 64, F.lane, &ti); if (F.lane < 32) { F.MISC[64 + F.lane] = (unsigned)ti; F.MISC[160 + F.lane] = F.ctl[CW_CNT + LAYER * 64 + F.lane]; } if (F.lane == 31) F.MISC[96] = (unsigned)ti; }
        __syncthreads();
    }
    {
        const int Tm = (int)F.MISC[96], T1 = F.G / 4 < Tm ? F.G / 4 : Tm;
        const int n2 = (Tm - T1) * 4;
        const pg8::Gemm gU{(const bf16*)(ws + WS_XB), (const bf16*)(ws + WS_WGU) + (size_t)LAYER * 32 * 1024 * 2048, RPAD, 32 * 1024, DM, DM, DM};
        const pg8::Gemm gD{(const bf16*)(ws + WS_OMIX), (const bf16*)(ws + WS_WD) + (size_t)LAYER * 32 * 2048 * 512, RPAD, 32 * 2048, 512, 512, 512};
        const PG8_LAS int* tend = (const LAS int*)(F.lds + LDSCTL_OFF + 64 * 4); const PG8_LAS int* ecnt = (const LAS int*)(F.lds + LDSCTL_OFF + 160 * 4);
        const int* inv = (const int*)(ws + WS_INV);
        const pg8::EpiGLU EU{(bf16*)(ws + WS_OMIX), (const float*)(ws + WS_WINV)}; const pg8::EpiBf16Plain ED{(bf16*)(ws + WS_CST), DM, 7};
        if (IN(BASE + 3)) {
            pg8::MoeOrder S{F.G, (int)blockIdx.x, 4, 0, T1 * 4, (T1 * 4 == F.G && (F.G & 31) == 0) ? 2 : 0, tend, ecnt};
            pg8::gemm_phase_g<pg8::EpiGLU, pg8::MoeOrder>(F.lds, gU, S, EU, inv, F.tid);
            SEAM(BASE + 3);
        }
        if (IN(BASE + 4)) {
            const int bx = (int)blockIdx.x, xc = bx & 7, sx = bx >> 3, per = (n2 + 7) >> 3;
            const bool xok = (F.G & 7) == 0 && 8 * per <= F.G;
            const int ju = xc * per + sx;
            const bool isU = xok ? (sx < per && ju < n2) : bx < n2;
            const bool isD = xok ? bx >= 8 * per : bx >= n2;
            const int cd = xok ? bx - 8 * per : bx - n2, ND = xok ? F.G - 8 * per : F.G - n2;
            const unsigned* rdy = F.ctl + CW_RDY + LAYER * 4096;
            if (isU) { const int L = xok ? T1 * 4 + ju : T1 * 4 + bx;
                pg8::MoeOrder S{1 << 28, 0, 4, L, Tm * 4, 0, tend, ecnt}; pg8::gemm_phase_g<pg8::EpiGLU, pg8::MoeOrder>(F.lds, gU, S, EU, inv, F.tid);
                if (F.tid == 0) { __builtin_amdgcn_fence(__ATOMIC_RELEASE, "agent"); asm volatile("s_waitcnt vmcnt(0)" ::: "memory");
                    (void)__hip_atomic_fetch_add((unsigned*)rdy + 32 * (L >> 2), 1u, __ATOMIC_RELAXED, __HIP_MEMORY_SCOPE_AGENT); } }
            else if (isD) { pg8::MoeOrder S{ND, cd, 8, 0, T1 * 8, 0, tend, ecnt}; pg8::gemm_phase<pg8::EpiBf16Plain, pg8::MoeOrder, true, true>(F.lds, gD, S, ED, F.tid);
                const int L3 = T1 * 8 + cd;
                if (L3 < Tm * 8) {
                    if (LAYER == 0) late_conv_items<16>(F, args, CONV_SPLIT, CONV_LATE_ITEMS, 1, rdy + 32 * (L3 >> 3), 4u);
                    pg8::MoeReadyOrder S3{{ND, cd, 8, T1 * 8, Tm * 8, 0, tend, ecnt}, rdy, 4u, F.wave};
                    pg8::gemm_phase<pg8::EpiBf16Plain, pg8::MoeReadyOrder, true, true>(F.lds, gD, S3, ED, F.tid); } }
            if (LAYER == 0) late_conv_items<16>(F, args, CONV_SPLIT, CONV_LATE_ITEMS, 1);
            SEAM(BASE + 4);
        }
    }
    if (IN(BASE + 6)) { F.refresh(); p_ln_ffn(F, args, LAYER); SEAM(BASE + 6); }
}
__global__ void __launch_bounds__(NWAVES * 64, 2) mk_fwd(Args args) {
    extern __shared__ __attribute__((aligned(16))) unsigned char lds[];
    Frame F;
    F.lds = (LAS unsigned char*)lds; F.MISC = (volatile LAS unsigned*)(F.lds + LDSCTL_OFF);
    F.wave = __builtin_amdgcn_readfirstlane((int)threadIdx.x >> 6); F.refresh();
    F.G = gridDim.x; F.gw = blockIdx.x * NWAVES + F.wave; F.NGW = F.G * NWAVES;
    F.ws = args.ws; F.ctl = (unsigned*)(args.ws + WS_CTL);
    for (int u = F.tid; u < (LDS_BYTES - LDSCTL_OFF) / 4; u += NWAVES * 64) ((LAS unsigned*)(F.lds + LDSCTL_OFF))[u] = 0u;
    __syncthreads();
    const int lo = args.ph_lo, hi = args.ph_hi;
    XcdBarrier bar; bar.bar = F.ctl + CW_BAR + args.bar_region * XCD_BAR_WORDS; bar.x = 0; bar.st = nullptr;
    if (hi - lo > 1) bar = xcd_barrier_post(F.ctl + CW_BAR + args.bar_region * XCD_BAR_WORDS, F.MISC);
    unsigned char* ws = args.ws;

    if (IN(0)) { p0_prologue(F, args); SEAM(0); }
    if (IN(1)) {
        pg8::Gemm g{(const bf16*)(ws + WS_XB), (const bf16*)(ws + WS_WINA), MTOK, NP0, DM, DM, DM}; pg8::StaticOrder S; S.init(MTOK, NP0, F.G, (int)blockIdx.x);
        pg8::EpiBf16Plain E{(bf16*)(ws + WS_PROJ), NP0, 0x7fffffff};
        pg8::gemm_phase<pg8::EpiBf16Plain, pg8::StaticOrder, true, true>(F.lds, g, S, E, F.tid);
        p_skinny0(F, args);
        SEAM(1);
    }
    if (IN(2)) { p_fox_bias(F, args); ph_gla_a(F, args); SEAM(2); }
    if (IN(4)) { ph_gla_scan(F); __syncthreads();
        attn::attn_phase<true, false, 8, 1, true, NP0, NP0, DM>((char*)lds, F.lds, (const bf16*)(ws + WS_PROJ) + 3072, (const bf16*)(ws + WS_PROJ) + 4096, (const bf16*)(ws + WS_PROJ) + 5120,
                                                               (bf16*)(ws + WS_OMIX) + 1024, (const float*)(ws + WS_FBIAS), (const unsigned long long*)nullptr, F.G, (int)blockIdx.x, F.wave);
        F.refresh();
        late_conv_items<64>(F, args, 0, CONV_BIG, 0); late_conv_items<16>(F, args, CONV_BIG, CONV_SPLIT, 2);
        SEAM(4); }
    if (IN(5)) { F.refresh(); ph_gla_c(F, args); SEAM(5); }
    common_phases<0, 6>(F, args, lo, hi, bar);
    if (IN(13)) {
        pg8::Gemm g{(const bf16*)(ws + WS_XB), (const bf16*)(ws + WS_WINC), MTOK, NP1, DM, DM, DM}; pg8::StaticOrder S; S.init(MTOK, NP1, F.G, (int)blockIdx.x);
        const float* c128 = (const float*)(ws + WS_ROPE);
        pg8::EpiRope E{(bf16*)(ws + WS_PROJ), c128, c128 + 4096 * 64, c128 + 2 * 4096 * 64, c128 + 2 * 4096 * 64 + 4096 * 32};
        pg8::gemm_phase<pg8::EpiRope, pg8::StaticOrder, true, true>(F.lds, g, S, E, F.tid);
        SEAM(13);
    }
    if (IN(14)) { F.refresh(); ph_indexer(F, lds); SEAM(14); }
    if (IN(16)) {
        attn::attn_phase<false, true, 16, 4, true, NP1, NP1, DM>((char*)lds, F.lds, (const bf16*)(ws + WS_PROJ), (const bf16*)(ws + WS_PROJ) + 2048, (const bf16*)(ws + WS_PROJ) + 2560,
                                                               (bf16*)(ws + WS_OMIX), (const float*)nullptr, (const unsigned long long*)(ws + WS_MASK), F.G, (int)blockIdx.x, F.wave);
        SEAM(16); }
    common_phases<1, 17>(F, args, lo, hi, bar);
#ifdef PROBE_CONV
    if (IN(31)) {
        LAS bf16* T = (LAS bf16*)(F.lds + F.wave * 16384); bf16* dstb = (bf16*)(ws + WS_SC); float sink = 0.f;
        for (int it = F.gw; it < 32 * 256; it += F.NGW) {
            const int ex = 32 + it / 256, r = it % 256, kb = r / 8, nb = r % 8;
            TrItem t{args.in[17] + (size_t)ex * 2048 * 512, dstb + (size_t)(it / 256) * 512 * 2048, 512, nb * 64, nb * 64 + 32, 2048, nb * 64, kb * 64};
            f32x4 r16[16]; tr64_load(t, r16, F.lane);
            if (PROBE_CONV == 0) tr64_store(t, r16, T, F.lane);
            else if (PROBE_CONV == 1) {
#pragma unroll
                for (int i = 0; i < 8; ++i) { uint2 o; o.x = pg8::cvt_pk_bf16(r16[2 * i][0], r16[2 * i][1]); o.y = pg8::cvt_pk_bf16(r16[2 * i][2], r16[2 * i][3]); uint2 p; p.x = pg8::cvt_pk_bf16(r16[2 * i + 1][0], r16[2 * i + 1][1]); p.y = pg8::cvt_pk_bf16(r16[2 * i + 1][2], r16[2 * i + 1][3]);
                    bf16* d = dstb + (size_t)(it / 256) * 512 * 2048 + (size_t)(kb * 64 + 8 * i + 2 * (F.lane >> 4)) * 512 + nb * 64 + 4 * (F.lane & 15); *(uint2*)d = o; *(uint2*)(d + 512) = p; } }
            else {
#pragma unroll
                for (int i = 0; i < 16; ++i) sink += r16[i][0] + r16[i][3]; }
        }
        if (PROBE_CONV == 2 && sink == 12345.678f) dstb[F.tid] = 1;
    }
#endif
#ifdef PROBE_GEMM_K
    if (IN(30)) {
        pg8::Gemm g{(const bf16*)(ws + WS_XB), (const bf16*)(ws + WS_WINA), MTOK, NP0, PROBE_GEMM_K, PROBE_GEMM_LD, PROBE_GEMM_LD}; pg8::StaticOrder S; S.init(MTOK, NP0, F.G, (int)blockIdx.x);
        pg8::EpiBf16Plain E{(bf16*)(ws + WS_SC), NP0, 0x7fffffff};
        pg8::gemm_phase<pg8::EpiBf16Plain, pg8::StaticOrder, true, true>(F.lds, g, S, E, F.tid);
    }
#endif
}
#undef IN
#undef SEAM
constexpr int N_PHASE_IDS = 24;
static void launch_mk(const Args& base, int lo, int hi, int grid, hipStream_t stream, int region = 0) {
    Args a = base; a.ph_lo = lo; a.ph_hi = hi; a.bar_region = region; a.pad = 0;
    hipLaunchKernelGGL(mk_fwd, dim3(grid), dim3(NWAVES * 64), LDS_BYTES, stream, a);
}
extern "C" void kernel_launch(void* const* d_in, const int* in_sizes, int n_in, void* d_out, int out_size, void* d_ws, size_t ws_size, hipStream_t stream) {
    static int grid = 0;
    if (grid == 0) {
        if (n_in != 20 || out_size != MTOK * DM || ws_size < WS_END) { fprintf(stderr, "kernel_launch: unexpected shapes (n_in %d, out %d, ws %zu < %zu)\n", n_in, out_size, ws_size, (size_t)WS_END); grid = -1; return; }
        int dev = 0, cus = 0, per_cu = 0;
        if (hipGetDevice(&dev) != hipSuccess || hipDeviceGetAttribute(&cus, hipDeviceAttributeMultiprocessorCount, dev) != hipSuccess) { grid = -1; return; }
        if (hipFuncSetAttribute((const void*)mk_fwd, hipFuncAttributeMaxDynamicSharedMemorySize, LDS_BYTES) != hipSuccess) { fprintf(stderr, "kernel_launch: hipFuncSetAttribute failed\n"); grid = -1; return; }
        if (hipOccupancyMaxActiveBlocksPerMultiprocessor(&per_cu, (const void*)mk_fwd, NWAVES * 64, LDS_BYTES) != hipSuccess || per_cu < 1) { fprintf(stderr, "kernel_launch: occupancy query reports %d workgroups per CU\n", per_cu); }
        (void)hipGetLastError();
        grid = cus;
    }
    if (grid < 0) return;
    (void)in_sizes;
    if (hipMemsetAsync((char*)d_ws + WS_CTL, 0, CTL_ZERO_BYTES, stream) != hipSuccess) return;
    Args a{};
    for (int i = 0; i < 20; ++i) a.in[i] = (const float*)d_in[i];
    a.out = (float*)d_out; a.ws = (unsigned char*)d_ws;
#ifdef PROBE_LO
    launch_mk(a, 0, PROBE_HI + 1, grid, stream, 0); launch_mk(a, PROBE_LO, N_PHASE_IDS, grid, stream, 1);
#else
    launch_mk(a, 0, N_PHASE_IDS, grid, stream);
#endif
#ifdef PROBE_GEMM_K
    launch_mk(a, 30, 31, grid, stream, 2);
#endif
#ifdef PROBE_CONV
    launch_mk(a, 31, 32, grid, stream, 2);
#endif
}
```
